# Optimizing an MI355X kernel written in HIP

```python
import math
import jax, jax.numpy as jnp
from jax import lax
import numpy as np

D_MODEL = 1024
BATCH = 16
SEQ = 2048
DEPTH = 2

D_MIX = D_MODEL
D_GMLP = D_MIX // 2
D_MLA = D_MIX - D_GMLP
GMLP_GROUPS = 8
GMLP_GROUP_DIM = D_GMLP // GMLP_GROUPS
CHUNK = 128
MLA_HEADS = 8
QK_NOPE_DIM = 64
QK_ROPE_DIM = 32
V_HEAD_DIM = D_MLA // MLA_HEADS
Q_RANK = D_MODEL // 4
KV_RANK = D_MODEL // 8
ROPE_THETA = 10000.0
Q_BLOCK = 128
D_FF = 4 * D_MODEL
N_MOD = 6
EPS = 1e-6
D_IN = 2 * D_GMLP + Q_RANK + KV_RANK + QK_ROPE_DIM

kernel_name = "hybrid_gmlp_mla_adaln_block"


def rmsnorm(x, g):
    xf = x.astype(jnp.float32)
    y = xf * lax.rsqrt(jnp.mean(xf * xf, axis=-1, keepdims=True) + EPS)
    return (y * g.astype(jnp.float32)).astype(x.dtype)


def layernorm_noaffine(x):
    xf = x.astype(jnp.float32)
    mu = jnp.mean(xf, axis=-1, keepdims=True)
    d = xf - mu
    y = d * lax.rsqrt(jnp.mean(d * d, axis=-1, keepdims=True) + EPS)
    return y.astype(x.dtype)


def rope_tables(positions, dim):
    freqs = ROPE_THETA ** (-jnp.arange(0, dim, 2, dtype=jnp.float32) / dim)
    ang = positions.astype(jnp.float32)[..., None] * freqs
    return jnp.cos(ang), jnp.sin(ang)


def apply_rope(x, cos, sin):
    half = x.shape[-1] // 2
    x1, x2 = x[..., :half], x[..., half:]
    cos = cos.astype(x.dtype)
    sin = sin.astype(x.dtype)
    return jnp.concatenate([x1 * cos - x2 * sin, x1 * sin + x2 * cos], axis=-1)


def gmlp_mixer(u, v, w_s, b_s):
    B, S, G, Dg = u.shape
    n_chunks = S // CHUNK
    u = jax.nn.gelu(u)
    v = layernorm_noaffine(jax.nn.gelu(v))
    causal = jnp.tril(jnp.ones((CHUNK, CHUNK), dtype=bool))
    w = jnp.where(causal[None], w_s, 0.0)
    vc = v.reshape(B, n_chunks, CHUNK, G, Dg)
    mixed = jnp.einsum('gts,bcsgd->bctgd', w, vc) + b_s.T[None, None, :, :, None]
    return u * mixed.reshape(B, S, G, Dg)


def mla_mixer(q_lat, kv_lat, k_rope_raw, cos, sin, g_q, g_kv, w_uq, w_ukv):
    B, S, _ = q_lat.shape
    c_q = rmsnorm(q_lat, g_q)
    q = (c_q @ w_uq).reshape(B, S, MLA_HEADS, QK_NOPE_DIM + QK_ROPE_DIM)
    q_nope, q_rope = q[..., :QK_NOPE_DIM], q[..., QK_NOPE_DIM:]
    q_rope = apply_rope(q_rope, cos[:, :, None, :], sin[:, :, None, :])
    c_kv = rmsnorm(kv_lat, g_kv)
    kv = (c_kv @ w_ukv).reshape(B, S, MLA_HEADS, QK_NOPE_DIM + V_HEAD_DIM)
    k_nope, v = kv[..., :QK_NOPE_DIM], kv[..., QK_NOPE_DIM:]
    k_rope = apply_rope(k_rope_raw, cos, sin)
    scale = (QK_NOPE_DIM + QK_ROPE_DIM) ** -0.5
    outs = []
    for i in range(S // Q_BLOCK):
        q0 = i * Q_BLOCK
        kend = q0 + Q_BLOCK
        s = (jnp.einsum('bqhd,bkhd->bhqk', q_nope[:, q0:kend], k_nope[:, :kend])
             + jnp.einsum('bqhr,bkr->bhqk', q_rope[:, q0:kend], k_rope[:, :kend]))
        s = s.astype(jnp.float32) * scale
        qpos = q0 + jnp.arange(Q_BLOCK)
        kpos = jnp.arange(kend)
        s = jnp.where(kpos[None, :] <= qpos[:, None], s, -1e30)
        p = jax.nn.softmax(s, axis=-1).astype(v.dtype)
        outs.append(jnp.einsum('bhqk,bkhd->bqhd', p, v[:, :kend]))
    o = jnp.concatenate(outs, axis=1)
    return o.reshape(B, S, MLA_HEADS * V_HEAD_DIM)


def setup_inputs(seed: int = 0) -> dict:
    key = jax.random.key(seed)
    ks = jax.random.split(key, 24)
    f32 = jnp.float32

    def nrm(k, shape, scale):
        return jax.random.normal(k, shape, f32) * scale

    def gain(k, shape):
        return 1.0 + 0.02 * jax.random.normal(k, shape, f32)

    x = jax.random.normal(ks[0], (BATCH, SEQ, D_MODEL), f32)
    c = jax.random.normal(ks[1], (BATCH, D_MODEL), f32)
    offset = jax.random.randint(ks[2], (BATCH, 1), 0, 1024, dtype=jnp.int32)
    positions = offset + jnp.arange(SEQ, dtype=jnp.int32)[None, :]
    return {
        "x": x,
        "c": c,
        "positions": positions,
        "w_ada": nrm(ks[3], (DEPTH, D_MODEL, N_MOD * D_MODEL), 0.02),
        "b_ada": nrm(ks[4], (DEPTH, N_MOD * D_MODEL), 0.01),
        "norm_mix_g": gain(ks[5], (DEPTH, D_MODEL)),
        "w_in": nrm(ks[6], (DEPTH, D_MODEL, D_IN), D_MODEL ** -0.5),
        "gmlp_ws": nrm(ks[7], (DEPTH, GMLP_GROUPS, CHUNK, CHUNK), CHUNK ** -0.5),
        "gmlp_bs": gain(ks[8], (DEPTH, GMLP_GROUPS, CHUNK)),
        "mla_q_norm_g": gain(ks[9], (DEPTH, Q_RANK)),
        "mla_kv_norm_g": gain(ks[10], (DEPTH, KV_RANK)),
        "mla_w_uq": nrm(ks[11], (DEPTH, Q_RANK, MLA_HEADS * (QK_NOPE_DIM + QK_ROPE_DIM)), Q_RANK ** -0.5),
        "mla_w_ukv": nrm(ks[12], (DEPTH, KV_RANK, MLA_HEADS * (QK_NOPE_DIM + V_HEAD_DIM)), KV_RANK ** -0.5),
        "out_norm_gmlp_g": gain(ks[13], (DEPTH, D_GMLP)),
        "out_norm_mla_g": gain(ks[14], (DEPTH, D_MLA)),
        "w_out": nrm(ks[15], (DEPTH, D_MIX, D_MODEL), D_MIX ** -0.5),
        "norm_ffn_g": gain(ks[16], (DEPTH, D_MODEL)),
        "w_ff1": nrm(ks[17], (DEPTH, D_MODEL, D_FF), D_MODEL ** -0.5),
        "w_ff2": nrm(ks[18], (DEPTH, D_FF, D_MODEL), D_FF ** -0.5),
        "final_norm_g": gain(ks[19], (D_MODEL,)),
    }


def reference(x, c, positions, w_ada, b_ada, norm_mix_g, w_in, gmlp_ws, gmlp_bs,
              mla_q_norm_g, mla_kv_norm_g, mla_w_uq, mla_w_ukv, out_norm_gmlp_g,
              out_norm_mla_g, w_out, norm_ffn_g, w_ff1, w_ff2, final_norm_g):
    B, S, _ = x.shape
    cos, sin = rope_tables(positions, QK_ROPE_DIM)
    c_act = jax.nn.silu(c)
    split_pts = [D_GMLP, 2 * D_GMLP, 2 * D_GMLP + Q_RANK, 2 * D_GMLP + Q_RANK + KV_RANK]
    for l in range(DEPTH):
        mod = c_act @ w_ada[l] + b_ada[l]
        shift1, scale1, gate1, shift2, scale2, gate2 = jnp.split(mod[:, None, :], N_MOD, axis=-1)

        h = rmsnorm(x, norm_mix_g[l]) * (1.0 + scale1) + shift1
        z = h @ w_in[l]
        u, v, q_lat, kv_lat, k_rope_raw = jnp.split(z, split_pts, axis=-1)
        y_g = gmlp_mixer(u.reshape(B, S, GMLP_GROUPS, GMLP_GROUP_DIM),
                         v.reshape(B, S, GMLP_GROUPS, GMLP_GROUP_DIM),
                         gmlp_ws[l], gmlp_bs[l]).reshape(B, S, D_GMLP)
        y_a = mla_mixer(q_lat, kv_lat, k_rope_raw, cos, sin, mla_q_norm_g[l],
                        mla_kv_norm_g[l], mla_w_uq[l], mla_w_ukv[l])
        y = jnp.concatenate([rmsnorm(y_g, out_norm_gmlp_g[l]), rmsnorm(y_a, out_norm_mla_g[l])], axis=-1)
        x = x + gate1 * (y @ w_out[l])

        h = rmsnorm(x, norm_ffn_g[l]) * (1.0 + scale2) + shift2
        f = jnp.square(jax.nn.relu(h @ w_ff1[l])) @ w_ff2[l]
        x = x + gate2 * f
    return rmsnorm(x, final_norm_g)
```

```cpp
#include <hip/hip_runtime.h>
#include <cstdint>
#include <cstdio>
#include <cmath>

typedef unsigned short bf16_t;
typedef short bf16x8 __attribute__((ext_vector_type(8)));
typedef float f32x4 __attribute__((ext_vector_type(4)));

constexpr int DM = 1024, NB = 16, SEQ = 2048, DEPTH = 2, T = NB * SEQ;
constexpr int DG = 512, NGRP = 8, GD = 64, CHUNK = 128, NH = 8, NOPE = 64, ROPE = 32, VD = 64;
constexpr int QR = 256, KVR = 128, DFF = 4096, DIN = 1440, NMOD = 6 * DM;
constexpr int NIN = 1536;
constexpr int NUP = 1792, KUP = 384;
constexpr float EPS = 1e-6f;
constexpr float QSCALE = 0.10206207261596577f * 1.4426950408889634f;

constexpr size_t MiB = 1u << 20;
constexpr size_t WS_CTL = 0;
constexpr size_t WS_MOD = 1 * MiB;
constexpr size_t WS_SHW1 = 2 * MiB;
constexpr size_t WS_SHW2 = 3 * MiB;
constexpr size_t WS_ROPE = 4 * MiB;
constexpr size_t WS_SSQ1 = 8 * MiB;
constexpr size_t WS_SSQ2 = 10 * MiB;
constexpr size_t WS_SSQY = 12 * MiB;
constexpr size_t WS_SSQQ = 14 * MiB;
constexpr size_t WS_GW = 15 * MiB;
constexpr size_t WS_W = 16 * MiB;
constexpr size_t WL_IN = 0, WL_UP = 3 * MiB, WL_OUT = 4 * MiB + MiB / 2, WL_1 = 6 * MiB + MiB / 2, WL_2 = 14 * MiB + MiB / 2, WL_STRIDE = 22 * MiB + MiB / 2;
constexpr size_t WS_A = 64 * MiB;
constexpr size_t WS_U = 128 * MiB;
constexpr size_t WS_VN = 160 * MiB;
constexpr size_t WS_CQKV = 192 * MiB;
constexpr size_t WS_KR = 216 * MiB;
constexpr size_t WS_Q = 218 * MiB;
constexpr size_t WS_KN = 266 * MiB;
constexpr size_t WS_V = 298 * MiB;
constexpr size_t WS_Y = 330 * MiB;
constexpr size_t WS_H = 128 * MiB;
constexpr size_t WS_GV = 394 * MiB;
constexpr size_t WS_ZL = 458 * MiB;
constexpr size_t WS_QRT = 394 * MiB;
constexpr size_t WS_END = 510 * MiB;

__device__ __forceinline__ bf16_t f2bf(float f) { unsigned u = __float_as_uint(f); return (bf16_t)((u + 0x7fffu + ((u >> 16) & 1u)) >> 16); }
__device__ __forceinline__ float bf2f(bf16_t h) { return __uint_as_float(((unsigned)h) << 16); }
__device__ __forceinline__ float gelu_tanh(float x) { const float y = 0.7978845608028654f * (x + 0.044715f * x * x * x); return x / (1.f + __expf(-2.f * y)); }
__device__ __forceinline__ float wave_sum(float v) {
#pragma unroll
    for (int o = 1; o < 64; o <<= 1) v += __shfl_xor(v, o);
    return v;
}
__host__ __device__ __forceinline__ int win_src(int p) {
    if (p < 512) return p;
    if (p < 1024) { const int q = p - 512, tile = q >> 8, r = q & 255, bj = r >> 7, wc = (r >> 5) & 3, j = r & 31; return 512 + tile * 256 + 64 * wc + 32 * bj + j; }
    if (p < 1408) return p;
    if (p < 1440) { const int j = p - 1408, fq = j >> 3, n = (j >> 2) & 1, i = j & 3; return 1408 + 16 * n + 4 * fq + i; }
    return -1;
}
__host__ __device__ __forceinline__ int wup_qcol(int p) {
    const int G = p >> 5, h = G / 3, gi = G - 3 * h, j = p & 31;
    if (gi < 2) return p;
    const int fq = j >> 3, n = (j >> 2) & 1, i = j & 3; return h * 96 + 64 + 16 * n + 4 * fq + i;
}

__global__ void k_rope_table(const int* pos, float* rope) {
    const int idx = blockIdx.x * blockDim.x + threadIdx.x; if (idx >= T * 16) return;
    const int t = idx >> 4, i = idx & 15;
    const float freq = powf(10000.0f, -(float)(2 * i) / 32.0f);
    const float ang = (float)pos[t] * freq;
    rope[t * 32 + i] = cosf(ang); rope[t * 32 + 16 + i] = sinf(ang);
}
__global__ void k_prep_w(const float* W, int K, int N, bf16_t* out, int Nphys, int mode) {
    const size_t idx = (size_t)blockIdx.x * blockDim.x + threadIdx.x; if (idx >= (size_t)Nphys * K) return;
    const int p = (int)(idx / K), k = (int)(idx % K);
    const int s = mode == 1 ? win_src(p) : p;
    out[idx] = (s >= 0 && s < N) ? f2bf(W[(size_t)k * N + s]) : (bf16_t)0;
}
__global__ void k_prep_wup(const float* wuq, const float* wukv, bf16_t* out) {
    const int idx = blockIdx.x * blockDim.x + threadIdx.x; if (idx >= NUP * KUP) return;
    const int p = idx / KUP, k = idx % KUP; float v = 0.f;
    if (p < 768) { if (k < 256) v = wuq[(size_t)k * 768 + wup_qcol(p)]; }
    else { if (k >= 256) v = wukv[(size_t)(k - 256) * 1024 + (p - 768)]; }
    out[idx] = f2bf(v);
}
__global__ void k_prep_gw(const float* ws, bf16_t* gw) {
    const int idx = blockIdx.x * blockDim.x + threadIdx.x; if (idx >= DEPTH * NGRP * CHUNK * CHUNK) return;
    const int s = idx & 127, t = (idx >> 7) & 127;
    gw[idx] = (s <= t) ? f2bf(ws[idx]) : (bf16_t)0;
}
__global__ __launch_bounds__(512) void k_smallm(const float* in, int in_stride, int act, const float* W, int ldw, int N, int mode, const float* bias, float* out, int out_stride, int Nphys) {
    __shared__ float sin_[1024 * 16];
    __shared__ float red[8 * 64 * 16];
    const int tid = threadIdx.x, lane = tid & 63, wave = tid >> 6;
    for (int e = tid; e < 16 * 1024; e += 512) { const int b = e >> 10, k = e & 1023; float v = in[(size_t)b * in_stride + k]; if (act) v = v / (1.f + __expf(-v)); sin_[k * 16 + b] = v; }
    __syncthreads();
    const int p = blockIdx.x * 64 + lane; const int s = (p < Nphys) ? (mode == 1 ? win_src(p) : p) : -1; const bool ok = (s >= 0 && s < N);
    float acc[16];
#pragma unroll
    for (int b = 0; b < 16; ++b) acc[b] = 0.f;
    for (int k = wave * 128; k < wave * 128 + 128; ++k) {
        const float w = ok ? W[(size_t)k * ldw + s] : 0.f;
        const f32x4* sp = (const f32x4*)(sin_ + k * 16);
#pragma unroll
        for (int q = 0; q < 4; ++q) { const f32x4 v = sp[q]; acc[4 * q] += v[0] * w; acc[4 * q + 1] += v[1] * w; acc[4 * q + 2] += v[2] * w; acc[4 * q + 3] += v[3] * w; }
    }
#pragma unroll
    for (int b = 0; b < 16; ++b) red[(wave * 64 + lane) * 16 + b] = acc[b];
    __syncthreads();
    for (int e = tid; e < 64 * 16; e += 512) { const int l = e >> 4, b = e & 15; float sum = 0.f;
#pragma unroll
        for (int w = 0; w < 8; ++w) sum += red[(w * 64 + l) * 16 + b];
        const int pp = blockIdx.x * 64 + l; if (pp < Nphys) out[(size_t)b * out_stride + pp] = sum + (bias ? bias[pp] : 0.f); }
}
__global__ __launch_bounds__(256) void k_modx(const float* x, const float* g, const float* sc  , int sc_stride, bf16_t* A, float* ssq) {
    const int row = blockIdx.x * 4 + (threadIdx.x >> 6), lane = threadIdx.x & 63; if (row >= T) return;
    const int b = row / SEQ; const f32x4* xr = (const f32x4*)(x + (size_t)row * DM); float s = 0.f;
#pragma unroll
    for (int j = 0; j < 4; ++j) { const f32x4 v = xr[lane + 64 * j]; s += v[0] * v[0] + v[1] * v[1] + v[2] * v[2] + v[3] * v[3];
        const int c = 4 * (lane + 64 * j); const f32x4 gv = *(const f32x4*)(g + c), sv = *(const f32x4*)(sc + (size_t)b * sc_stride + c);
        unsigned lo = f2bf(v[0] * gv[0] * (1.f + sv[0])) | ((unsigned)f2bf(v[1] * gv[1] * (1.f + sv[1])) << 16);
        unsigned hi = f2bf(v[2] * gv[2] * (1.f + sv[2])) | ((unsigned)f2bf(v[3] * gv[3] * (1.f + sv[3])) << 16);
        *(uint2*)(A + (size_t)row * DM + c) = make_uint2(lo, hi); }
    s = wave_sum(s);
    if (lane < 16) ssq[(size_t)row * 16 + lane] = (lane == 0) ? s : 0.f;
}
__global__ __launch_bounds__(256) void k_final(const float* x, const float* g, float* out) {
    const int row = blockIdx.x * 4 + (threadIdx.x >> 6), lane = threadIdx.x & 63; if (row >= T) return;
    const f32x4* xr = (const f32x4*)(x + (size_t)row * DM); f32x4 v[4]; float s = 0.f;
#pragma unroll
    for (int j = 0; j < 4; ++j) { v[j] = xr[lane + 64 * j]; s += v[j][0] * v[j][0] + v[j][1] * v[j][1] + v[j][2] * v[j][2] + v[j][3] * v[j][3]; }
    const float rstd = rsqrtf(wave_sum(s) * (1.f / DM) + EPS);
#pragma unroll
    for (int j = 0; j < 4; ++j) { const int c = 4 * (lane + 64 * j); const f32x4 gv = *(const f32x4*)(g + c); *(f32x4*)(out + (size_t)row * DM + c) = v[j] * rstd * gv; }
}

template <class Epi>
__global__ __launch_bounds__(256) void k_gemm_naive(const bf16_t* A, int lda, const bf16_t* Bt, int ldb, int K, Epi epi) {
    const int wave = threadIdx.x >> 6, lane = threadIdx.x & 63, fr = lane & 15, fq = lane >> 4;
    const int row0 = blockIdx.y * 64 + wave * 16, col0 = blockIdx.x * 64;
    f32x4 acc[4];
#pragma unroll
    for (int n = 0; n < 4; ++n) acc[n] = (f32x4){0.f, 0.f, 0.f, 0.f};
    const bf16_t* ap = A + (size_t)(row0 + fr) * lda + 8 * fq;
    const bf16_t* bp = Bt + (size_t)(col0 + fr) * ldb + 8 * fq;
    for (int k0 = 0; k0 < K; k0 += 32) {
        if (Epi::HAS_MID) { if (k0 == epi.ksplit) {
#pragma unroll
            for (int r = 0; r < 4; ++r) { const float m = epi.mid(row0 + 4 * fq + r);
#pragma unroll
                for (int n = 0; n < 4; ++n) acc[n][r] *= m; } } }
        const bf16x8 a = *(const bf16x8*)(ap + k0);
#pragma unroll
        for (int n = 0; n < 4; ++n) { const bf16x8 b = *(const bf16x8*)(bp + (size_t)n * 16 * ldb + k0); acc[n] = __builtin_amdgcn_mfma_f32_16x16x32_bf16(a, b, acc[n], 0, 0, 0); }
    }
#pragma unroll
    for (int r = 0; r < 4; ++r) { const int row = row0 + 4 * fq + r; const float rs = epi.rowscale(row);
#pragma unroll
        for (int n = 0; n < 4; ++n) epi(row, col0 + 16 * n + fr, acc[n][r], rs); }
}
__device__ __forceinline__ float sum16(const float* p) { float s = 0.f;
#pragma unroll
    for (int i = 0; i < 16; ++i) s += p[i]; return s; }
__device__ __forceinline__ float sum8(const float* p) { float s = 0.f;
#pragma unroll
    for (int i = 0; i < 8; ++i) s += p[i]; return s; }
__device__ __forceinline__ float sum4(const float* p) { return (p[0] + p[1]) + (p[2] + p[3]); }

struct EpiInNaive {
    static constexpr bool HAS_MID = false; int ksplit;
    const float* ssq1; const float* shw1; bf16_t* U; float* GV; float* ZL;
    __device__ float mid(int) const { return 1.f; }
    __device__ float rowscale(int row) const { return rsqrtf(sum16(ssq1 + (size_t)row * 16) * (1.f / DM) + EPS); }
    __device__ void operator()(int row, int p, float acc, float rs) const {
        const int L = win_src(p); if (L < 0) return;
        const float z = rs * acc + shw1[(row / SEQ) * NIN + p];
        if (L < 512) U[(size_t)row * 512 + L] = f2bf(gelu_tanh(z));
        else if (L < 1024) GV[(size_t)row * 512 + (L - 512)] = gelu_tanh(z);
        else ZL[(size_t)row * 416 + (L - 1024)] = z;
    }
};
struct EpiUpNaive {
    static constexpr bool HAS_MID = false; int ksplit;
    const float* ssqq; bf16_t* Q; float* QRT; bf16_t* KN; bf16_t* V;
    __device__ float mid(int) const { return 1.f; }
    __device__ float rowscale(int) const { return 1.f; }
    __device__ void operator()(int row, int p, float acc, float) const {
        if (p < 768) { const float rq = rsqrtf(sum4(ssqq + (size_t)row * 8) * (1.f / QR) + EPS); const float v = acc * rq * QSCALE;
            const int L = wup_qcol(p), h = L / 96, d = L - 96 * h;
            if (d < 64) Q[(size_t)row * 768 + L] = f2bf(v); else QRT[(size_t)row * 256 + h * 32 + (d - 64)] = v; }
        else { const float rk = rsqrtf(sum4(ssqq + (size_t)row * 8 + 4) * (1.f / KVR) + EPS); const float v = acc * rk;
            const int c = p - 768, h = c >> 7, d = c & 127;
            if (d < 64) KN[(size_t)row * 512 + h * 64 + d] = f2bf(v); else V[(size_t)row * 512 + h * 64 + (d - 64)] = f2bf(v); }
    }
};
struct EpiOutNaive {
    static constexpr bool HAS_MID = true; int ksplit;
    const float* ssqy; const float* xin; float* xout; const float* gate;
    __device__ float rg(int row) const { return rsqrtf(sum8(ssqy + (size_t)row * 16) * (1.f / 512) + EPS); }
    __device__ float ra(int row) const { return rsqrtf(sum8(ssqy + (size_t)row * 16 + 8) * (1.f / 512) + EPS); }
    __device__ float mid(int row) const { return rg(row) / ra(row); }
    __device__ float rowscale(int row) const { return ra(row); }
    __device__ void operator()(int row, int n, float acc, float rs) const {
        const size_t i = (size_t)row * DM + n; xout[i] = xin[i] + gate[(size_t)(row / SEQ) * NMOD + n] * (rs * acc);
    }
};
struct EpiFf1Naive {
    static constexpr bool HAS_MID = false; int ksplit;
    const float* ssq2; const float* shw2; bf16_t* H;
    __device__ float mid(int) const { return 1.f; }
    __device__ float rowscale(int row) const { return rsqrtf(sum16(ssq2 + (size_t)row * 16) * (1.f / DM) + EPS); }
    __device__ void operator()(int row, int n, float acc, float rs) const {
        const float z = rs * acc + shw2[(row / SEQ) * DFF + n]; const float r = fmaxf(z, 0.f); H[(size_t)row * DFF + n] = f2bf(r * r);
    }
};
struct EpiFf2Naive {
    static constexpr bool HAS_MID = false; int ksplit;
    float* x; const float* gate;
    __device__ float mid(int) const { return 1.f; }
    __device__ float rowscale(int) const { return 1.f; }
    __device__ void operator()(int row, int n, float acc, float) const {
        const size_t i = (size_t)row * DM + n; x[i] = x[i] + gate[(size_t)(row / SEQ) * NMOD + n] * acc;
    }
};

__global__ __launch_bounds__(256) void k_vn(const float* GV, bf16_t* VN) {
    const int w = blockIdx.x * 4 + (threadIdx.x >> 6), lane = threadIdx.x & 63; if (w >= T * NGRP) return;
    const int row = w >> 3, g = w & 7; const float v = GV[(size_t)row * 512 + g * 64 + lane];
    const float mu = wave_sum(v) * (1.f / 64); const float d = v - mu; const float var = wave_sum(d * d) * (1.f / 64);
    VN[(size_t)row * 512 + g * 64 + lane] = f2bf(d * rsqrtf(var + EPS));
}
__global__ __launch_bounds__(256) void k_lat(const float* ZL, const float* gq, const float* gkv, const float* rope, bf16_t* CQKV, float* ssqq, bf16_t* KR) {
    const int row = blockIdx.x * 4 + (threadIdx.x >> 6), lane = threadIdx.x & 63; if (row >= T) return;
    const float* z = ZL + (size_t)row * 416; float sq = 0.f, sk = 0.f;
#pragma unroll
    for (int j = 0; j < 4; ++j) { const int c = lane + 64 * j; const float v = z[c]; sq += v * v; CQKV[(size_t)row * KUP + c] = f2bf(v * gq[c]); }
#pragma unroll
    for (int j = 0; j < 2; ++j) { const int c = lane + 64 * j; const float v = z[256 + c]; sk += v * v; CQKV[(size_t)row * KUP + 256 + c] = f2bf(v * gkv[c]); }
    sq = wave_sum(sq); sk = wave_sum(sk);
    if (lane < 8) ssqq[(size_t)row * 8 + lane] = (lane == 0) ? sq : (lane == 4) ? sk : 0.f;
    if (lane < 16) { const float x1 = z[384 + lane], x2 = z[384 + 16 + lane], c = rope[(size_t)row * 32 + lane], s = rope[(size_t)row * 32 + 16 + lane];
        KR[(size_t)row * 32 + lane] = f2bf(x1 * c - x2 * s); KR[(size_t)row * 32 + 16 + lane] = f2bf(x1 * s + x2 * c); }
}
__global__ void k_rope_q(const float* QRT, const float* rope, bf16_t* Q) {
    const int idx = blockIdx.x * blockDim.x + threadIdx.x; if (idx >= T * NH * 16) return;
    const int r = idx & 15, h = (idx >> 4) & 7, row = idx >> 7;
    const float x1 = QRT[(size_t)row * 256 + h * 32 + r], x2 = QRT[(size_t)row * 256 + h * 32 + 16 + r], c = rope[(size_t)row * 32 + r], s = rope[(size_t)row * 32 + 16 + r];
    Q[(size_t)row * 768 + h * 96 + 64 + r] = f2bf(x1 * c - x2 * s); Q[(size_t)row * 768 + h * 96 + 80 + r] = f2bf(x1 * s + x2 * c);
}
__global__ __launch_bounds__(512) void k_gmlp_naive(const bf16_t* U, const bf16_t* VN, const bf16_t* GW  , const float* bs  , const float* gog, bf16_t* Y, float* ssqy) {
    const int row = blockIdx.x, g = threadIdx.x >> 6, d = threadIdx.x & 63, c = g * 64 + d;
    const int tt = row & 127, t0 = row - tt;
    const bf16_t* w = GW + ((size_t)g * CHUNK + tt) * CHUNK; float sum = 0.f;
    for (int s = 0; s <= tt; ++s) sum += bf2f(w[s]) * bf2f(VN[(size_t)(t0 + s) * 512 + c]);
    const float y = bf2f(U[(size_t)row * 512 + c]) * (sum + bs[g * CHUNK + tt]);
    Y[(size_t)row * DM + c] = f2bf(y * gog[c]);
    const float q = wave_sum(y * y); if (d == 0) ssqy[(size_t)row * 16 + g] = q;
}
__global__ __launch_bounds__(64) void k_attn_naive(const bf16_t* Q, const bf16_t* KN, const bf16_t* KR, const bf16_t* V, const float* goa, bf16_t* Y, float* ssqy) {
    const int h = blockIdx.y, row = blockIdx.x * 64 + threadIdx.x, b = row / SEQ, i = row - b * SEQ;
    const int iend = (blockIdx.x * 64 % SEQ) + 63;
    float q[96];
#pragma unroll
    for (int d8 = 0; d8 < 12; ++d8) { const bf16x8 v = *(const bf16x8*)(Q + (size_t)row * 768 + h * 96 + d8 * 8);
#pragma unroll
        for (int j = 0; j < 8; ++j) q[d8 * 8 + j] = bf2f((bf16_t)v[j]); }
    float o[64];
#pragma unroll
    for (int d = 0; d < 64; ++d) o[d] = 0.f;
    float m = -1e30f, l = 0.f;
    const size_t kb = (size_t)b * SEQ;
    for (int j = 0; j <= iend; ++j) {
        const bf16_t* kn = KN + (kb + j) * 512 + h * 64; const bf16_t* kr = KR + (kb + j) * 32; const bf16_t* vv = V + (kb + j) * 512 + h * 64;
        float s = 0.f;
#pragma unroll
        for (int d8 = 0; d8 < 8; ++d8) { const bf16x8 kv = *(const bf16x8*)(kn + d8 * 8);
#pragma unroll
            for (int jj = 0; jj < 8; ++jj) s += q[d8 * 8 + jj] * bf2f((bf16_t)kv[jj]); }
#pragma unroll
        for (int d8 = 0; d8 < 4; ++d8) { const bf16x8 kv = *(const bf16x8*)(kr + d8 * 8);
#pragma unroll
            for (int jj = 0; jj < 8; ++jj) s += q[64 + d8 * 8 + jj] * bf2f((bf16_t)kv[jj]); }
        if (j > i) s = -1e30f;
        const float mn = fmaxf(m, s), alpha = exp2f(m - mn), p = (j > i) ? 0.f : exp2f(s - mn);
        l = l * alpha + p; m = mn;
#pragma unroll
        for (int d8 = 0; d8 < 8; ++d8) { const bf16x8 v8 = *(const bf16x8*)(vv + d8 * 8);
#pragma unroll
            for (int jj = 0; jj < 8; ++jj) o[d8 * 8 + jj] = o[d8 * 8 + jj] * alpha + p * bf2f((bf16_t)v8[jj]); }
    }
    const float inv = 1.f / l; float sq = 0.f;
#pragma unroll
    for (int d8 = 0; d8 < 8; ++d8) { unsigned w[4];
#pragma unroll
        for (int jj = 0; jj < 8; jj += 2) { const float y0 = o[d8 * 8 + jj] * inv, y1 = o[d8 * 8 + jj + 1] * inv; sq += y0 * y0 + y1 * y1;
            w[jj >> 1] = f2bf(y0 * goa[h * 64 + d8 * 8 + jj]) | ((unsigned)f2bf(y1 * goa[h * 64 + d8 * 8 + jj + 1]) << 16); }
        *(uint4*)(Y + (size_t)row * DM + 512 + h * 64 + d8 * 8) = make_uint4(w[0], w[1], w[2], w[3]); }
    ssqy[(size_t)row * 16 + 8 + h] = sq;
}

template <class Epi> static void gemm_naive(hipStream_t st, const bf16_t* A, int lda, const bf16_t* Bt, int ldb, int M, int N, int K, const Epi& e) {
    hipLaunchKernelGGL((k_gemm_naive<Epi>), dim3(N / 64, M / 64), dim3(256), 0, st, A, lda, Bt, ldb, K, e);
}
extern "C" void kernel_launch(void* const* d_in, const int* in_sizes, int n_in, void* d_out, int out_size, void* d_ws, size_t ws_size, hipStream_t stream) {
    if (n_in != 20 || out_size != T * DM || ws_size < WS_END) { fprintf(stderr, "kernel_launch: unexpected sizes n_in %d out %d ws %zu\n", n_in, out_size, ws_size); return; }
    const float* x = (const float*)d_in[0]; const float* c = (const float*)d_in[1]; const int* pos = (const int*)d_in[2];
    const float* w_ada = (const float*)d_in[3]; const float* b_ada = (const float*)d_in[4]; const float* g_mix = (const float*)d_in[5];
    const float* w_in = (const float*)d_in[6]; const float* g_ws = (const float*)d_in[7]; const float* g_bs = (const float*)d_in[8];
    const float* g_q = (const float*)d_in[9]; const float* g_kv = (const float*)d_in[10]; const float* w_uq = (const float*)d_in[11]; const float* w_ukv = (const float*)d_in[12];
    const float* g_og = (const float*)d_in[13]; const float* g_oa = (const float*)d_in[14]; const float* w_out = (const float*)d_in[15];
    const float* g_ffn = (const float*)d_in[16]; const float* w_ff1 = (const float*)d_in[17]; const float* w_ff2 = (const float*)d_in[18]; const float* g_fin = (const float*)d_in[19];
    unsigned char* ws = (unsigned char*)d_ws; float* out = (float*)d_out;
    float* MOD = (float*)(ws + WS_MOD); float* SHW1 = (float*)(ws + WS_SHW1); float* SHW2 = (float*)(ws + WS_SHW2); float* RT = (float*)(ws + WS_ROPE);
    float* SSQ1 = (float*)(ws + WS_SSQ1); float* SSQ2 = (float*)(ws + WS_SSQ2); float* SSQY = (float*)(ws + WS_SSQY); float* SSQQ = (float*)(ws + WS_SSQQ);
    bf16_t* GW = (bf16_t*)(ws + WS_GW); bf16_t* A = (bf16_t*)(ws + WS_A); bf16_t* U = (bf16_t*)(ws + WS_U); bf16_t* VN = (bf16_t*)(ws + WS_VN);
    bf16_t* CQKV = (bf16_t*)(ws + WS_CQKV); bf16_t* KR = (bf16_t*)(ws + WS_KR); bf16_t* Q = (bf16_t*)(ws + WS_Q); bf16_t* KN = (bf16_t*)(ws + WS_KN); bf16_t* V = (bf16_t*)(ws + WS_V);
    bf16_t* Y = (bf16_t*)(ws + WS_Y); bf16_t* H = (bf16_t*)(ws + WS_H); float* GV = (float*)(ws + WS_GV); float* ZL = (float*)(ws + WS_ZL); float* QRT = (float*)(ws + WS_QRT);
    auto WL = [&](int l, size_t off) { return (bf16_t*)(ws + WS_W + (size_t)l * WL_STRIDE + off); };

    hipLaunchKernelGGL(k_rope_table, dim3(T * 16 / 256), dim3(256), 0, stream, pos, RT);
    hipLaunchKernelGGL(k_prep_gw, dim3(DEPTH * NGRP * CHUNK * CHUNK / 256), dim3(256), 0, stream, g_ws, GW);
    for (int l = 0; l < DEPTH; ++l) {
        hipLaunchKernelGGL(k_prep_w, dim3((NIN * DM + 255) / 256), dim3(256), 0, stream, w_in + (size_t)l * DM * DIN, DM, DIN, WL(l, WL_IN), NIN, 1);
        hipLaunchKernelGGL(k_prep_wup, dim3((NUP * KUP + 255) / 256), dim3(256), 0, stream, w_uq + (size_t)l * QR * 768, w_ukv + (size_t)l * KVR * 1024, WL(l, WL_UP));
        hipLaunchKernelGGL(k_prep_w, dim3(DM * DM / 256), dim3(256), 0, stream, w_out + (size_t)l * DM * DM, DM, DM, WL(l, WL_OUT), DM, 0);
        hipLaunchKernelGGL(k_prep_w, dim3(DFF * DM / 256), dim3(256), 0, stream, w_ff1 + (size_t)l * DM * DFF, DM, DFF, WL(l, WL_1), DFF, 0);
        hipLaunchKernelGGL(k_prep_w, dim3(DFF * DM / 256), dim3(256), 0, stream, w_ff2 + (size_t)l * DFF * DM, DFF, DM, WL(l, WL_2), DM, 0);
        hipLaunchKernelGGL(k_smallm, dim3(NMOD / 64), dim3(512), 0, stream, c, DM, 1, w_ada + (size_t)l * DM * NMOD, NMOD, NMOD, 0, b_ada + (size_t)l * NMOD, MOD + (size_t)l * NB * NMOD, NMOD, NMOD);
    }
    for (int l = 0; l < DEPTH; ++l) {
        hipLaunchKernelGGL(k_smallm, dim3(NIN / 64), dim3(512), 0, stream, MOD + (size_t)l * NB * NMOD + 0, NMOD, 0, w_in + (size_t)l * DM * DIN, DIN, DIN, 1, (const float*)nullptr, SHW1 + (size_t)l * NB * NIN, NIN, NIN);
        hipLaunchKernelGGL(k_smallm, dim3(DFF / 64), dim3(512), 0, stream, MOD + (size_t)l * NB * NMOD + 3 * DM, NMOD, 0, w_ff1 + (size_t)l * DM * DFF, DFF, DFF, 0, (const float*)nullptr, SHW2 + (size_t)l * NB * DFF, DFF, DFF);
    }
    hipLaunchKernelGGL(k_modx, dim3(T / 4), dim3(256), 0, stream, x, g_mix, MOD + 1 * DM, NMOD, A, SSQ1);

    for (int l = 0; l < DEPTH; ++l) {
        const float* modl = MOD + (size_t)l * NB * NMOD;
        { EpiInNaive e{0, SSQ1, SHW1 + (size_t)l * NB * NIN, U, GV, ZL}; gemm_naive(stream, A, DM, WL(l, WL_IN), DM, T, NIN, DM, e); }
        hipLaunchKernelGGL(k_vn, dim3(T * NGRP / 4), dim3(256), 0, stream, GV, VN);
        hipLaunchKernelGGL(k_lat, dim3(T / 4), dim3(256), 0, stream, ZL, g_q + l * QR, g_kv + l * KVR, RT, CQKV, SSQQ, KR);
        { EpiUpNaive e{0, SSQQ, Q, QRT, KN, V}; gemm_naive(stream, CQKV, KUP, WL(l, WL_UP), KUP, T, NUP, KUP, e); }
        hipLaunchKernelGGL(k_rope_q, dim3(T * NH * 16 / 256), dim3(256), 0, stream, QRT, RT, Q);
        hipLaunchKernelGGL(k_gmlp_naive, dim3(T), dim3(512), 0, stream, U, VN, GW + (size_t)l * NGRP * CHUNK * CHUNK, g_bs + l * NGRP * CHUNK, g_og + l * DG, Y, SSQY);
        hipLaunchKernelGGL(k_attn_naive, dim3(T / 64, NH), dim3(64), 0, stream, Q, KN, KR, V, g_oa + l * DG, Y, SSQY);
        { EpiOutNaive e{512, SSQY, l == 0 ? x : out, out, modl + 2 * DM}; gemm_naive(stream, Y, DM, WL(l, WL_OUT), DM, T, DM, DM, e); }
        hipLaunchKernelGGL(k_modx, dim3(T / 4), dim3(256), 0, stream, out, g_ffn + l * DM, modl + 4 * DM, NMOD, A, SSQ2);
        { EpiFf1Naive e{0, SSQ2, SHW2 + (size_t)l * NB * DFF, H}; gemm_naive(stream, A, DM, WL(l, WL_1), DM, T, DFF, DM, e); }
        { EpiFf2Naive e{0, out, modl + 5 * DM}; gemm_naive(stream, H, DFF, WL(l, WL_2), DFF, T, DM, DFF, e); }
        if (l + 1 < DEPTH) hipLaunchKernelGGL(k_modx, dim3(T / 4), dim3(256), 0, stream, out, g_mix + (l + 1) * DM, MOD + (size_t)(l + 1) * NB * NMOD + 1 * DM, NMOD, A, SSQ1);
    }
    hipLaunchKernelGGL(k_final, dim3(T / 4), dim3(256), 0, stream, out, g_fin, out);
}
```

```cpp
#include <hip/hip_runtime.h>
#include <cstdint>
#include <cstdio>
#include <cmath>

typedef unsigned short bf16_t;
typedef short bf16x8 __attribute__((ext_vector_type(8)));
typedef float f32x4 __attribute__((ext_vector_type(4)));

constexpr int DM = 1024, NB = 16, SEQ = 2048, DEPTH = 2, T = NB * SEQ;
constexpr int DG = 512, NGRP = 8, GD = 64, CHUNK = 128, NH = 8, NOPE = 64, ROPE = 32, VD = 64;
constexpr int QR = 256, KVR = 128, DFF = 4096, DIN = 1440, NMOD = 6 * DM;
constexpr int NIN = 1536;
constexpr int NUP = 1792, KUP = 384;
constexpr float EPS = 1e-6f;
constexpr float QSCALE = 0.10206207261596577f * 1.4426950408889634f;

constexpr size_t MiB = 1u << 20;
constexpr size_t WS_CTL = 0;
constexpr size_t WS_MOD = 1 * MiB;
constexpr size_t WS_SHW1 = 2 * MiB;
constexpr size_t WS_GM1 = 2 * MiB + 512 * 1024;
constexpr size_t WS_GM2 = 2 * MiB + 768 * 1024;
constexpr size_t WS_SHW2 = 3 * MiB;
constexpr size_t WS_ROPE = 4 * MiB;
constexpr size_t WS_SSQ1 = 8 * MiB;
constexpr size_t WS_SSQ2 = 10 * MiB;
constexpr size_t WS_SSQY = 12 * MiB;
constexpr size_t WS_SSQQ = 14 * MiB;
constexpr size_t WS_GW = 15 * MiB;
constexpr size_t WS_W = 16 * MiB;
constexpr size_t WL_IN = 0, WL_UP = 3 * MiB, WL_OUT = 4 * MiB + MiB / 2, WL_1 = 6 * MiB + MiB / 2, WL_2 = 14 * MiB + MiB / 2, WL_STRIDE = 22 * MiB + MiB / 2;
constexpr size_t WS_A = 64 * MiB;
constexpr size_t WS_U = 128 * MiB;
constexpr size_t WS_VN = 160 * MiB;
constexpr size_t WS_CQKV = 192 * MiB;
constexpr size_t WS_KR = 216 * MiB;
constexpr size_t WS_Q = 218 * MiB;
constexpr size_t WS_KN = 266 * MiB;
constexpr size_t WS_V = 298 * MiB;
constexpr size_t WS_Y = 330 * MiB;
constexpr size_t WS_H = 128 * MiB;
constexpr size_t WS_GV = 394 * MiB;
constexpr size_t WS_ZL = 458 * MiB;
constexpr size_t WS_QRT = 394 * MiB;
constexpr size_t WS_END = 510 * MiB;

__device__ __forceinline__ bf16_t f2bf(float f) { unsigned u = __float_as_uint(f); return (bf16_t)((u + 0x7fffu + ((u >> 16) & 1u)) >> 16); }
__device__ __forceinline__ float bf2f(bf16_t h) { return __uint_as_float(((unsigned)h) << 16); }
__device__ __forceinline__ float gelu_tanh(float x) { const float y2 = -2.302208198f * (x + 0.044715f * x * x * x); return x * __builtin_amdgcn_rcpf(1.f + __builtin_amdgcn_exp2f(y2)); }
__device__ __forceinline__ float wave_sum(float v) {
#pragma unroll
    for (int o = 1; o < 64; o <<= 1) v += __shfl_xor(v, o);
    return v;
}
__host__ __device__ __forceinline__ int win_src(int p) {
    if (p < 512) return p;
    if (p < 1024) { const int q = p - 512, tile = q >> 8, r = q & 255, bj = r >> 7, wc = (r >> 5) & 3, j = r & 31; return 512 + tile * 256 + 64 * wc + 32 * bj + j; }
    if (p < 1408) return p;
    if (p < 1440) { const int j = p - 1408, fq = j >> 3, n = (j >> 2) & 1, i = j & 3; return 1408 + 16 * n + 4 * fq + i; }
    return -1;
}
__host__ __device__ __forceinline__ int wup_qcol(int p) {
    const int G = p >> 5, h = G / 3, gi = G - 3 * h, j = p & 31;
    if (gi < 2) return p;
    const int fq = j >> 3, n = (j >> 2) & 1, i = j & 3; return h * 96 + 64 + 16 * n + 4 * fq + i;
}

__global__ void k_rope_table(const int* pos, float* rope) {
    const int idx = blockIdx.x * blockDim.x + threadIdx.x; if (idx >= T * 16) return;
    const int t = idx >> 4, i = idx & 15;
    const float freq = powf(10000.0f, -(float)(2 * i) / 32.0f);
    const float ang = (float)pos[t] * freq;
    rope[t * 32 + i] = cosf(ang); rope[t * 32 + 16 + i] = sinf(ang);
}
__global__ void k_prep_w(const float* W, int K, int N, bf16_t* out, int Nphys, int mode) {
    const size_t idx = (size_t)blockIdx.x * blockDim.x + threadIdx.x; if (idx >= (size_t)Nphys * K) return;
    const int p = (int)(idx / K), k = (int)(idx % K);
    const int s = mode == 1 ? win_src(p) : p;
    out[idx] = (s >= 0 && s < N) ? f2bf(W[(size_t)k * N + s]) : (bf16_t)0;
}
__global__ void k_prep_wup(const float* wuq, const float* wukv, bf16_t* out) {
    const int idx = blockIdx.x * blockDim.x + threadIdx.x; if (idx >= NUP * KUP) return;
    const int p = idx / KUP, k = idx % KUP; float v = 0.f;
    if (p < 768) { if (k < 256) v = wuq[(size_t)k * 768 + wup_qcol(p)]; }
    else { if (k >= 256) v = wukv[(size_t)(k - 256) * 1024 + (p - 768)]; }
    out[idx] = f2bf(v);
}
__global__ void k_prep_gw(const float* ws, bf16_t* gw) {
    const int idx = blockIdx.x * blockDim.x + threadIdx.x; if (idx >= DEPTH * NGRP * CHUNK * CHUNK) return;
    const int s = idx & 127, t = (idx >> 7) & 127;
    gw[idx] = (s <= t) ? f2bf(ws[idx]) : (bf16_t)0;
}
__global__ __launch_bounds__(512) void k_smallm(const float* in, int in_stride, int act, const float* W, int ldw, int N, int mode, const float* bias, float* out, int out_stride, int Nphys) {
    __shared__ float sin_[1024 * 16];
    __shared__ float red[8 * 64 * 16];
    const int tid = threadIdx.x, lane = tid & 63, wave = tid >> 6;
    for (int e = tid; e < 16 * 1024; e += 512) { const int b = e >> 10, k = e & 1023; float v = in[(size_t)b * in_stride + k]; if (act) v = v / (1.f + __expf(-v)); sin_[k * 16 + b] = v; }
    __syncthreads();
    const int p = blockIdx.x * 64 + lane; const int s = (p < Nphys) ? (mode == 1 ? win_src(p) : p) : -1; const bool ok = (s >= 0 && s < N);
    float acc[16];
#pragma unroll
    for (int b = 0; b < 16; ++b) acc[b] = 0.f;
    for (int k = wave * 128; k < wave * 128 + 128; ++k) {
        const float w = ok ? W[(size_t)k * ldw + s] : 0.f;
        const f32x4* sp = (const f32x4*)(sin_ + k * 16);
#pragma unroll
        for (int q = 0; q < 4; ++q) { const f32x4 v = sp[q]; acc[4 * q] += v[0] * w; acc[4 * q + 1] += v[1] * w; acc[4 * q + 2] += v[2] * w; acc[4 * q + 3] += v[3] * w; }
    }
#pragma unroll
    for (int b = 0; b < 16; ++b) red[(wave * 64 + lane) * 16 + b] = acc[b];
    __syncthreads();
    for (int e = tid; e < 64 * 16; e += 512) { const int l = e >> 4, b = e & 15; float sum = 0.f;
#pragma unroll
        for (int w = 0; w < 8; ++w) sum += red[(w * 64 + l) * 16 + b];
        const int pp = blockIdx.x * 64 + l; if (pp < Nphys) out[(size_t)b * out_stride + pp] = sum + (bias ? bias[pp] : 0.f); }
}
__global__ __launch_bounds__(256) void k_modx(const float* x, const float* g, const float* sc  , int sc_stride, bf16_t* A, float* ssq) {
    const int row = blockIdx.x * 4 + (threadIdx.x >> 6), lane = threadIdx.x & 63; if (row >= T) return;
    const int b = row / SEQ; const f32x4* xr = (const f32x4*)(x + (size_t)row * DM); float s = 0.f;
#pragma unroll
    for (int j = 0; j < 4; ++j) { const f32x4 v = xr[lane + 64 * j]; s += v[0] * v[0] + v[1] * v[1] + v[2] * v[2] + v[3] * v[3];
        const int c = 4 * (lane + 64 * j); const f32x4 gv = *(const f32x4*)(g + c), sv = *(const f32x4*)(sc + (size_t)b * sc_stride + c);
        unsigned lo = f2bf(v[0] * gv[0] * (1.f + sv[0])) | ((unsigned)f2bf(v[1] * gv[1] * (1.f + sv[1])) << 16);
        unsigned hi = f2bf(v[2] * gv[2] * (1.f + sv[2])) | ((unsigned)f2bf(v[3] * gv[3] * (1.f + sv[3])) << 16);
        *(uint2*)(A + (size_t)row * DM + c) = make_uint2(lo, hi); }
    s = wave_sum(s);
    if (lane < 16) ssq[(size_t)row * 16 + lane] = (lane == 0) ? s : 0.f;
}
__global__ __launch_bounds__(256) void k_final(const float* x, const float* g, float* out) {
    const int row = blockIdx.x * 4 + (threadIdx.x >> 6), lane = threadIdx.x & 63; if (row >= T) return;
    const f32x4* xr = (const f32x4*)(x + (size_t)row * DM); f32x4 v[4]; float s = 0.f;
#pragma unroll
    for (int j = 0; j < 4; ++j) { v[j] = xr[lane + 64 * j]; s += v[j][0] * v[j][0] + v[j][1] * v[j][1] + v[j][2] * v[j][2] + v[j][3] * v[j][3]; }
    const float rstd = rsqrtf(wave_sum(s) * (1.f / DM) + EPS);
#pragma unroll
    for (int j = 0; j < 4; ++j) { const int c = 4 * (lane + 64 * j); const f32x4 gv = *(const f32x4*)(g + c); *(f32x4*)(out + (size_t)row * DM + c) = v[j] * rstd * gv; }
}

template <class Epi>
__global__ __launch_bounds__(256) void k_gemm_naive(const bf16_t* A, int lda, const bf16_t* Bt, int ldb, int K, Epi epi) {
    const int wave = threadIdx.x >> 6, lane = threadIdx.x & 63, fr = lane & 15, fq = lane >> 4;
    const int row0 = blockIdx.y * 64 + wave * 16, col0 = blockIdx.x * 64;
    f32x4 acc[4];
#pragma unroll
    for (int n = 0; n < 4; ++n) acc[n] = (f32x4){0.f, 0.f, 0.f, 0.f};
    const bf16_t* ap = A + (size_t)(row0 + fr) * lda + 8 * fq;
    const bf16_t* bp = Bt + (size_t)(col0 + fr) * ldb + 8 * fq;
    for (int k0 = 0; k0 < K; k0 += 32) {
        if (Epi::HAS_MID) { if (k0 == epi.ksplit) {
#pragma unroll
            for (int r = 0; r < 4; ++r) { const float m = epi.mid(row0 + 4 * fq + r);
#pragma unroll
                for (int n = 0; n < 4; ++n) acc[n][r] *= m; } } }
        const bf16x8 a = *(const bf16x8*)(ap + k0);
#pragma unroll
        for (int n = 0; n < 4; ++n) { const bf16x8 b = *(const bf16x8*)(bp + (size_t)n * 16 * ldb + k0); acc[n] = __builtin_amdgcn_mfma_f32_16x16x32_bf16(a, b, acc[n], 0, 0, 0); }
    }
#pragma unroll
    for (int r = 0; r < 4; ++r) { const int row = row0 + 4 * fq + r; const float rs = epi.rowscale(row);
#pragma unroll
        for (int n = 0; n < 4; ++n) epi(row, col0 + 16 * n + fr, acc[n][r], rs); }
}
__device__ __forceinline__ float sum16(const float* p) { float s = 0.f;
#pragma unroll
    for (int i = 0; i < 16; ++i) s += p[i]; return s; }
__device__ __forceinline__ float sum8(const float* p) { float s = 0.f;
#pragma unroll
    for (int i = 0; i < 8; ++i) s += p[i]; return s; }
__device__ __forceinline__ float sum4(const float* p) { return (p[0] + p[1]) + (p[2] + p[3]); }

struct EpiInNaive {
    static constexpr bool HAS_MID = false; int ksplit;
    const float* ssq1; const float* shw1; bf16_t* U; float* GV; float* ZL;
    __device__ float mid(int) const { return 1.f; }
    __device__ float rowscale(int row) const { return rsqrtf(sum16(ssq1 + (size_t)row * 16) * (1.f / DM) + EPS); }
    __device__ void operator()(int row, int p, float acc, float rs) const {
        const int L = win_src(p); if (L < 0) return;
        const float z = rs * acc + shw1[(row / SEQ) * NIN + p];
        if (L < 512) U[(size_t)row * 512 + L] = f2bf(gelu_tanh(z));
        else if (L < 1024) GV[(size_t)row * 512 + (L - 512)] = gelu_tanh(z);
        else ZL[(size_t)row * 416 + (L - 1024)] = z;
    }
};
struct EpiUpNaive {
    static constexpr bool HAS_MID = false; int ksplit;
    const float* ssqq; bf16_t* Q; float* QRT; bf16_t* KN; bf16_t* V;
    __device__ float mid(int) const { return 1.f; }
    __device__ float rowscale(int) const { return 1.f; }
    __device__ void operator()(int row, int p, float acc, float) const {
        if (p < 768) { const float rq = rsqrtf(sum4(ssqq + (size_t)row * 8) * (1.f / QR) + EPS); const float v = acc * rq * QSCALE;
            const int L = wup_qcol(p), h = L / 96, d = L - 96 * h;
            if (d < 64) Q[(size_t)row * 768 + L] = f2bf(v); else QRT[(size_t)row * 256 + h * 32 + (d - 64)] = v; }
        else { const float rk = rsqrtf(sum4(ssqq + (size_t)row * 8 + 4) * (1.f / KVR) + EPS); const float v = acc * rk;
            const int c = p - 768, h = c >> 7, d = c & 127;
            if (d < 64) KN[(size_t)row * 512 + h * 64 + d] = f2bf(v); else V[(size_t)row * 512 + h * 64 + (d - 64)] = f2bf(v); }
    }
};
struct EpiOutNaive {
    static constexpr bool HAS_MID = true; int ksplit;
    const float* ssqy; const float* xin; float* xout; const float* gate;
    __device__ float rg(int row) const { return rsqrtf(sum8(ssqy + (size_t)row * 16) * (1.f / 512) + EPS); }
    __device__ float ra(int row) const { return rsqrtf(sum8(ssqy + (size_t)row * 16 + 8) * (1.f / 512) + EPS); }
    __device__ float mid(int row) const { return rg(row) / ra(row); }
    __device__ float rowscale(int row) const { return ra(row); }
    __device__ void operator()(int row, int n, float acc, float rs) const {
        const size_t i = (size_t)row * DM + n; xout[i] = xin[i] + gate[(size_t)(row / SEQ) * NMOD + n] * (rs * acc);
    }
};
struct EpiFf1Naive {
    static constexpr bool HAS_MID = false; int ksplit;
    const float* ssq2; const float* shw2; bf16_t* H;
    __device__ float mid(int) const { return 1.f; }
    __device__ float rowscale(int row) const { return rsqrtf(sum16(ssq2 + (size_t)row * 16) * (1.f / DM) + EPS); }
    __device__ void operator()(int row, int n, float acc, float rs) const {
        const float z = rs * acc + shw2[(row / SEQ) * DFF + n]; const float r = fmaxf(z, 0.f); H[(size_t)row * DFF + n] = f2bf(r * r);
    }
};
struct EpiFf2Naive {
    static constexpr bool HAS_MID = false; int ksplit;
    float* x; const float* gate;
    __device__ float mid(int) const { return 1.f; }
    __device__ float rowscale(int) const { return 1.f; }
    __device__ void operator()(int row, int n, float acc, float) const {
        const size_t i = (size_t)row * DM + n; x[i] = x[i] + gate[(size_t)(row / SEQ) * NMOD + n] * acc;
    }
};

__global__ __launch_bounds__(256) void k_vn(const float* GV, bf16_t* VN) {
    const int w = blockIdx.x * 4 + (threadIdx.x >> 6), lane = threadIdx.x & 63; if (w >= T * NGRP) return;
    const int row = w >> 3, g = w & 7; const float v = GV[(size_t)row * 512 + g * 64 + lane];
    const float mu = wave_sum(v) * (1.f / 64); const float d = v - mu; const float var = wave_sum(d * d) * (1.f / 64);
    VN[(size_t)row * 512 + g * 64 + lane] = f2bf(d * rsqrtf(var + EPS));
}
__global__ __launch_bounds__(256) void k_lat(const float* ZL, const float* gq, const float* gkv, const float* rope, bf16_t* CQKV, float* ssqq, bf16_t* KR) {
    const int row = blockIdx.x * 4 + (threadIdx.x >> 6), lane = threadIdx.x & 63; if (row >= T) return;
    const float* z = ZL + (size_t)row * 416; float sq = 0.f, sk = 0.f;
#pragma unroll
    for (int j = 0; j < 4; ++j) { const int c = lane + 64 * j; const float v = z[c]; sq += v * v; CQKV[(size_t)row * KUP + c] = f2bf(v * gq[c]); }
#pragma unroll
    for (int j = 0; j < 2; ++j) { const int c = lane + 64 * j; const float v = z[256 + c]; sk += v * v; CQKV[(size_t)row * KUP + 256 + c] = f2bf(v * gkv[c]); }
    sq = wave_sum(sq); sk = wave_sum(sk);
    if (lane < 8) ssqq[(size_t)row * 8 + lane] = (lane == 0) ? sq : (lane == 4) ? sk : 0.f;
    if (lane < 16) { const float x1 = z[384 + lane], x2 = z[384 + 16 + lane], c = rope[(size_t)row * 32 + lane], s = rope[(size_t)row * 32 + 16 + lane];
        KR[(size_t)row * 32 + lane] = f2bf(x1 * c - x2 * s); KR[(size_t)row * 32 + 16 + lane] = f2bf(x1 * s + x2 * c); }
}
__global__ void k_rope_q(const float* QRT, const float* rope, bf16_t* Q) {
    const int idx = blockIdx.x * blockDim.x + threadIdx.x; if (idx >= T * NH * 16) return;
    const int r = idx & 15, h = (idx >> 4) & 7, row = idx >> 7;
    const float x1 = QRT[(size_t)row * 256 + h * 32 + r], x2 = QRT[(size_t)row * 256 + h * 32 + 16 + r], c = rope[(size_t)row * 32 + r], s = rope[(size_t)row * 32 + 16 + r];
    Q[(size_t)row * 768 + h * 96 + 64 + r] = f2bf(x1 * c - x2 * s); Q[(size_t)row * 768 + h * 96 + 80 + r] = f2bf(x1 * s + x2 * c);
}
__global__ __launch_bounds__(512) void k_gmlp_naive(const bf16_t* U, const bf16_t* VN, const bf16_t* GW  , const float* bs  , const float* gog, bf16_t* Y, float* ssqy) {
    const int row = blockIdx.x, g = threadIdx.x >> 6, d = threadIdx.x & 63, c = g * 64 + d;
    const int tt = row & 127, t0 = row - tt;
    const bf16_t* w = GW + ((size_t)g * CHUNK + tt) * CHUNK; float sum = 0.f;
    for (int s = 0; s <= tt; ++s) sum += bf2f(w[s]) * bf2f(VN[(size_t)(t0 + s) * 512 + c]);
    const float y = bf2f(U[(size_t)row * 512 + c]) * (sum + bs[g * CHUNK + tt]);
    Y[(size_t)row * DM + c] = f2bf(y * gog[c]);
    const float q = wave_sum(y * y); if (d == 0) ssqy[(size_t)row * 16 + g] = q;
}
__global__ __launch_bounds__(64) void k_attn_naive(const bf16_t* Q, const bf16_t* KN, const bf16_t* KR, const bf16_t* V, const float* goa, bf16_t* Y, float* ssqy) {
    const int h = blockIdx.y, row = blockIdx.x * 64 + threadIdx.x, b = row / SEQ, i = row - b * SEQ;
    const int iend = (blockIdx.x * 64 % SEQ) + 63;
    float q[96];
#pragma unroll
    for (int d8 = 0; d8 < 12; ++d8) { const bf16x8 v = *(const bf16x8*)(Q + (size_t)row * 768 + h * 96 + d8 * 8);
#pragma unroll
        for (int j = 0; j < 8; ++j) q[d8 * 8 + j] = bf2f((bf16_t)v[j]); }
    float o[64];
#pragma unroll
    for (int d = 0; d < 64; ++d) o[d] = 0.f;
    float m = -1e30f, l = 0.f;
    const size_t kb = (size_t)b * SEQ;
    for (int j = 0; j <= iend; ++j) {
        const bf16_t* kn = KN + (kb + j) * 512 + h * 64; const bf16_t* kr = KR + (kb + j) * 32; const bf16_t* vv = V + (kb + j) * 512 + h * 64;
        float s = 0.f;
#pragma unroll
        for (int d8 = 0; d8 < 8; ++d8) { const bf16x8 kv = *(const bf16x8*)(kn + d8 * 8);
#pragma unroll
            for (int jj = 0; jj < 8; ++jj) s += q[d8 * 8 + jj] * bf2f((bf16_t)kv[jj]); }
#pragma unroll
        for (int d8 = 0; d8 < 4; ++d8) { const bf16x8 kv = *(const bf16x8*)(kr + d8 * 8);
#pragma unroll
            for (int jj = 0; jj < 8; ++jj) s += q[64 + d8 * 8 + jj] * bf2f((bf16_t)kv[jj]); }
        if (j > i) s = -1e30f;
        const float mn = fmaxf(m, s), alpha = exp2f(m - mn), p = (j > i) ? 0.f : exp2f(s - mn);
        l = l * alpha + p; m = mn;
#pragma unroll
        for (int d8 = 0; d8 < 8; ++d8) { const bf16x8 v8 = *(const bf16x8*)(vv + d8 * 8);
#pragma unroll
            for (int jj = 0; jj < 8; ++jj) o[d8 * 8 + jj] = o[d8 * 8 + jj] * alpha + p * bf2f((bf16_t)v8[jj]); }
    }
    const float inv = 1.f / l; float sq = 0.f;
#pragma unroll
    for (int d8 = 0; d8 < 8; ++d8) { unsigned w[4];
#pragma unroll
        for (int jj = 0; jj < 8; jj += 2) { const float y0 = o[d8 * 8 + jj] * inv, y1 = o[d8 * 8 + jj + 1] * inv; sq += y0 * y0 + y1 * y1;
            w[jj >> 1] = f2bf(y0 * goa[h * 64 + d8 * 8 + jj]) | ((unsigned)f2bf(y1 * goa[h * 64 + d8 * 8 + jj + 1]) << 16); }
        *(uint4*)(Y + (size_t)row * DM + 512 + h * 64 + d8 * 8) = make_uint4(w[0], w[1], w[2], w[3]); }
    ssqy[(size_t)row * 16 + 8 + h] = sq;
}

__global__ void k_gm(const float* g  , const float* mod, int chunk, float* gmt) {
    const int idx = blockIdx.x * blockDim.x + threadIdx.x; if (idx >= DEPTH * NB * DM) return;
    const int c = idx & 1023, b = (idx >> 10) & 15, l = idx >> 14;
    gmt[idx] = g[l * DM + c] * (1.f + mod[((size_t)l * NB + b) * NMOD + chunk * DM + c]);
}
__device__ __forceinline__ int lane_id() { int l; asm volatile("v_mbcnt_lo_u32_b32 %0, -1, 0\n\tv_mbcnt_hi_u32_b32 %0, -1, %0" : "=v"(l)); return l; }
__device__ __forceinline__ float swz_xor16(float v) { return __int_as_float(__builtin_amdgcn_ds_swizzle(__float_as_int(v), 0x401F)); }
__device__ __forceinline__ float swz_xor1(float v) { return __int_as_float(__builtin_amdgcn_ds_swizzle(__float_as_int(v), 0x041F)); }
namespace pg8 {
#define PG8_LAS __attribute__((address_space(3)))
typedef unsigned u32x4 __attribute__((ext_vector_type(4)));
typedef unsigned u32x2 __attribute__((ext_vector_type(2)));
constexpr int BM = 256, BK = 64, HALF = 128, HTB = HALF * BK * 2  , STAGE_BYTES = 8 * HTB, NXCD = 8, WGM = 8;

__host__ __device__ __forceinline__ int lds_byte(int r, int c) { const int st = (r >> 4) * 2 + (c >> 5), rr = r & 15, cc = c & 31, ob = rr * 64 + cc * 2; return st * 1024 + (ob ^ (((ob >> 9) & 1) << 5)); }
__host__ __device__ __forceinline__ void stage_rc(int b, int& R, int& C) { const int st = b / 1024, sb = b % 1024, swz = sb ^ (((sb >> 9) & 1) << 5); R = (st >> 1) * 16 + swz / 64; C = (st & 1) * 32 + (swz % 64) / 2; }
__host__ __device__ __forceinline__ int perm32(int rho) { const int n = rho >> 4, i = rho & 15; return 8 * (i >> 2) + 4 * n + (i & 3); }

struct Unit { int pm, pn; };
struct Gemm { const bf16_t* A; const bf16_t* Bt; int M, N, K; };

struct StaticOrder {
    int nM, nN, nwg, G, c;
    __host__ __device__ void init(int M, int N, int G_, int c_) { nM = M / BM; nN = N / BM; nwg = nM * nN; G = G_; c = c_; }
    __host__ __device__ bool next(int i, Unit& u) const {
        const long L = (long)i * G + c; if (L >= nwg) return false;
        int wgid = (int)L; { const int q = nwg / NXCD, r = nwg % NXCD, xcd = wgid % NXCD, off = wgid / NXCD; wgid = (xcd < r ? xcd * (q + 1) : r * (q + 1) + (xcd - r) * q) + off; }
        const int nig = WGM * nN, gid = wgid / nig, fm = gid * WGM, gsz = (nM - fm) < WGM ? (nM - fm) : WGM;
        u.pm = fm + ((wgid % nig) % gsz); u.pn = (wgid % nig) / gsz; return true;
    }
    __device__ __forceinline__ void a_ready(const Unit&) const {}
    __device__ __forceinline__ void done(const Unit&) const {}
};

__device__ __forceinline__ unsigned cvt_pk_bf16(float lo, float hi) { unsigned r; asm volatile("v_cvt_pk_bf16_f32 %0, %1, %2" : "=v"(r) : "v"(lo), "v"(hi)); return r; }
__device__ __forceinline__ u32x4 pack8(const f32x4& a, const f32x4& b) { u32x4 w; w.x = cvt_pk_bf16(a[0], a[1]); w.y = cvt_pk_bf16(a[2], a[3]); w.z = cvt_pk_bf16(b[0], b[1]); w.w = cvt_pk_bf16(b[2], b[3]); return w; }
__device__ __forceinline__ u32x2 pack4(const f32x4& a) { u32x2 w; w.x = cvt_pk_bf16(a[0], a[1]); w.y = cvt_pk_bf16(a[2], a[3]); return w; }
__device__ __forceinline__ float hsum4(const f32x4& a) { return (a[0] + a[1]) + (a[2] + a[3]); }
__device__ __forceinline__ float hsq4(const f32x4& a) { return (a[0] * a[0] + a[1] * a[1]) + (a[2] * a[2] + a[3] * a[3]); }
__device__ __forceinline__ float ld_sum16(const float* p) { const f32x4* q = (const f32x4*)p; return (hsum4(q[0]) + hsum4(q[1])) + (hsum4(q[2]) + hsum4(q[3])); }
__device__ __forceinline__ float ld_sum8(const float* p) { const f32x4* q = (const f32x4*)p; return hsum4(q[0]) + hsum4(q[1]); }
__device__ __forceinline__ float ld_sum4(const float* p) { return hsum4(*(const f32x4*)p); }
__device__ __forceinline__ float quad_sum(float s) { s += swz_xor16(s); auto rr = __builtin_amdgcn_permlane32_swap(__float_as_uint(s), __float_as_uint(s), false, false); return __uint_as_float(rr[0]) + __uint_as_float(rr[1]); }
__device__ __forceinline__ float row_sum16(const float* ssq, int row, int fq) { return quad_sum(hsum4(*(const f32x4*)(ssq + (size_t)row * 16 + 4 * fq))); }
__device__ __forceinline__ void row_sum8x2(const float* ssq, int row, int fq, float& sg, float& sa) {
    float s = hsum4(*(const f32x4*)(ssq + (size_t)row * 16 + 4 * fq)); s += swz_xor16(s);
    auto rr = __builtin_amdgcn_permlane32_swap(__float_as_uint(s), __float_as_uint(s), false, false); sg = __uint_as_float(rr[0]); sa = __uint_as_float(rr[1]); }
#define PG8_FENCE() asm volatile("" ::: "memory")
__device__ __forceinline__ f32x4 gelu4(const f32x4& v) { f32x4 o; o[0] = gelu_tanh(v[0]); o[1] = gelu_tanh(v[1]); o[2] = gelu_tanh(v[2]); o[3] = gelu_tanh(v[3]); return o; }

#define PG8_ROW(u, ai, m) ((u).pm * BM + (ai) * HALF + wr * 64 + (m) * 16 + fr)

struct EpiIn {
    static constexpr bool PERM = true, AFTER_DRAIN = false, HAS_MID = false; static constexpr int MID_T = -1;
    const float* ssq1; const float* shw1; const float* gq; const float* gkv; const float* rope;
    bf16_t* U; bf16_t* VN; bf16_t* CQKV; bf16_t* KR; float* ssqq;
    __device__ __forceinline__ void mid(f32x4 (&)[2][2][4][2], const Unit&, int, int) const {}
    __device__ __forceinline__ void operator()(const f32x4 (&acc)[2][2][4][2], const Unit& u, int wr, int wc, int fr, int fq) const {
        asm volatile("" : "+v"(fr), "+v"(fq));
        const int b = u.pm >> 3, pc0 = u.pn * BM + wc * 32 + 8 * fq;
        f32x4 sh[2][2];
#pragma unroll
        for (int bj = 0; bj < 2; ++bj)
#pragma unroll
            for (int n = 0; n < 2; ++n) sh[bj][n] = *(const f32x4*)(shw1 + (size_t)b * NIN + pc0 + bj * HALF + 4 * n);
        if (u.pn < 2) {
#pragma unroll
            for (int ai = 0; ai < 2; ++ai)
#pragma unroll
                for (int m = 0; m < 4; ++m) { PG8_FENCE(); const int row = PG8_ROW(u, ai, m); const float rs = rsqrtf(row_sum16(ssq1, row, fq) * (1.f / DM) + EPS);
#pragma unroll
                    for (int bj = 0; bj < 2; ++bj) { const f32x4 v0 = gelu4(acc[ai][bj][m][0] * rs + sh[bj][0]), v1 = gelu4(acc[ai][bj][m][1] * rs + sh[bj][1]);
                        *(u32x4*)(U + (size_t)row * 512 + pc0 + bj * HALF) = pack8(v0, v1); } }
        } else if (u.pn < 4) {
#pragma unroll
            for (int ai = 0; ai < 2; ++ai)
#pragma unroll
                for (int m = 0; m < 4; ++m) { PG8_FENCE(); const int row = PG8_ROW(u, ai, m); const float rs = rsqrtf(row_sum16(ssq1, row, fq) * (1.f / DM) + EPS);
                    f32x4 g[2][2]; float s = 0.f;
#pragma unroll
                    for (int bj = 0; bj < 2; ++bj)
#pragma unroll
                        for (int n = 0; n < 2; ++n) { g[bj][n] = gelu4(acc[ai][bj][m][n] * rs + sh[bj][n]); s += hsum4(g[bj][n]); }
                    const float mu = quad_sum(s) * (1.f / 64); float q = 0.f;
#pragma unroll
                    for (int bj = 0; bj < 2; ++bj)
#pragma unroll
                        for (int n = 0; n < 2; ++n) { g[bj][n] = g[bj][n] - mu; q += hsq4(g[bj][n]); }
                    const float rstd = rsqrtf(quad_sum(q) * (1.f / 64) + EPS);
#pragma unroll
                    for (int bj = 0; bj < 2; ++bj) *(u32x4*)(VN + (size_t)row * 512 + (u.pn - 2) * 256 + 64 * wc + 32 * bj + 8 * fq) = pack8(g[bj][0] * rstd, g[bj][1] * rstd); }
        } else if (u.pn == 4) {
            f32x4 gv[2][2];
#pragma unroll
            for (int bj = 0; bj < 2; ++bj)
#pragma unroll
                for (int n = 0; n < 2; ++n) gv[bj][n] = *(const f32x4*)(gq + bj * HALF + wc * 32 + 8 * fq + 4 * n);
#pragma unroll
            for (int ai = 0; ai < 2; ++ai)
#pragma unroll
                for (int m = 0; m < 4; ++m) { PG8_FENCE(); const int row = PG8_ROW(u, ai, m); const float rs = rsqrtf(row_sum16(ssq1, row, fq) * (1.f / DM) + EPS);
                    float ss = 0.f;
#pragma unroll
                    for (int bj = 0; bj < 2; ++bj) { const f32x4 v0 = acc[ai][bj][m][0] * rs + sh[bj][0], v1 = acc[ai][bj][m][1] * rs + sh[bj][1]; ss += hsq4(v0) + hsq4(v1);
                        *(u32x4*)(CQKV + (size_t)row * KUP + bj * HALF + wc * 32 + 8 * fq) = pack8(v0 * gv[bj][0], v1 * gv[bj][1]); }
                    ss = quad_sum(ss); if (fq == 0) ssqq[(size_t)row * 8 + wc] = ss; }
        } else {
            const f32x4 gk0 = *(const f32x4*)(gkv + wc * 32 + 8 * fq), gk1 = *(const f32x4*)(gkv + wc * 32 + 8 * fq + 4);
#pragma unroll
            for (int ai = 0; ai < 2; ++ai)
#pragma unroll
                for (int m = 0; m < 4; ++m) { PG8_FENCE(); const int row = PG8_ROW(u, ai, m); const float rs = rsqrtf(row_sum16(ssq1, row, fq) * (1.f / DM) + EPS);
                    const f32x4 v0 = acc[ai][0][m][0] * rs + sh[0][0], v1 = acc[ai][0][m][1] * rs + sh[0][1];
                    float ss = quad_sum(hsq4(v0) + hsq4(v1)); if (fq == 0) ssqq[(size_t)row * 8 + 4 + wc] = ss;
                    *(u32x4*)(CQKV + (size_t)row * KUP + 256 + wc * 32 + 8 * fq) = pack8(v0 * gk0, v1 * gk1);
                    if (wc == 0) { const f32x4 x1 = acc[ai][1][m][0] * rs + sh[1][0], x2 = acc[ai][1][m][1] * rs + sh[1][1];
                        const f32x4 c = *(const f32x4*)(rope + (size_t)row * 32 + 4 * fq), s = *(const f32x4*)(rope + (size_t)row * 32 + 16 + 4 * fq);
                        *(u32x2*)(KR + (size_t)row * 32 + 4 * fq) = pack4(x1 * c - x2 * s); *(u32x2*)(KR + (size_t)row * 32 + 16 + 4 * fq) = pack4(x1 * s + x2 * c); } }
        }
    }
};
struct EpiUp {
    static constexpr bool PERM = true, AFTER_DRAIN = false, HAS_MID = false; static constexpr int MID_T = -1;
    const float* ssqq; const float* rope; bf16_t* Q; bf16_t* KN; bf16_t* V;
    __device__ __forceinline__ void mid(f32x4 (&)[2][2][4][2], const Unit&, int, int) const {}
    __device__ __forceinline__ void operator()(const f32x4 (&acc)[2][2][4][2], const Unit& u, int wr, int wc, int fr, int fq) const {
        asm volatile("" : "+v"(fr), "+v"(fq));
        if (u.pn < 3) {
#pragma unroll
            for (int ai = 0; ai < 2; ++ai)
#pragma unroll
                for (int m = 0; m < 4; ++m) { PG8_FENCE(); const int row = PG8_ROW(u, ai, m); const float rq = rsqrtf(ld_sum4(ssqq + (size_t)row * 8) * (1.f / QR) + EPS) * QSCALE;
#pragma unroll
                    for (int bj = 0; bj < 2; ++bj) { const int G = 8 * u.pn + 4 * bj + wc, h = G / 3, gi = G - 3 * h;
                        const f32x4 v0 = acc[ai][bj][m][0] * rq, v1 = acc[ai][bj][m][1] * rq;
                        if (gi < 2) *(u32x4*)(Q + (size_t)row * 768 + 32 * G + 8 * fq) = pack8(v0, v1);
                        else { const f32x4 c = *(const f32x4*)(rope + (size_t)row * 32 + 4 * fq), s = *(const f32x4*)(rope + (size_t)row * 32 + 16 + 4 * fq);
                            *(u32x2*)(Q + (size_t)row * 768 + 96 * h + 64 + 4 * fq) = pack4(v0 * c - v1 * s); *(u32x2*)(Q + (size_t)row * 768 + 96 * h + 80 + 4 * fq) = pack4(v0 * s + v1 * c); } } }
        } else {
#pragma unroll
            for (int ai = 0; ai < 2; ++ai)
#pragma unroll
                for (int m = 0; m < 4; ++m) { PG8_FENCE(); const int row = PG8_ROW(u, ai, m); const float rk = rsqrtf(ld_sum4(ssqq + (size_t)row * 8 + 4) * (1.f / KVR) + EPS);
#pragma unroll
                    for (int bj = 0; bj < 2; ++bj) { const int h = 2 * (u.pn - 3) + bj;
                        bf16_t* dst = (wc < 2) ? KN + (size_t)row * 512 + 64 * h + 32 * wc + 8 * fq : V + (size_t)row * 512 + 64 * h + 32 * (wc - 2) + 8 * fq;
                        *(u32x4*)dst = pack8(acc[ai][bj][m][0] * rk, acc[ai][bj][m][1] * rk); } }
        }
    }
};
template <bool MIDS> struct EpiRes {
    static constexpr bool PERM = true, AFTER_DRAIN = false, HAS_MID = MIDS; static constexpr int MID_T = 8;
    const float* ssqy; const float* xin; float* xout; const float* gate  ; const float* gm  ; bf16_t* A; float* ssqo;
    __device__ __forceinline__ void mid(f32x4 (&acc)[2][2][4][2], const Unit& u, int wr, int fr) const {
        int fq = lane_id() >> 4; asm volatile("" : "+v"(fr), "+v"(fq));
#pragma unroll
        for (int ai = 0; ai < 2; ++ai)
#pragma unroll
            for (int m = 0; m < 4; ++m) { float sg, sa; row_sum8x2(ssqy, PG8_ROW(u, ai, m), fq, sg, sa);
                const float ratio = sqrtf((sa * (1.f / 512) + EPS) / (sg * (1.f / 512) + EPS));
#pragma unroll
                for (int bj = 0; bj < 2; ++bj)
#pragma unroll
                    for (int n = 0; n < 2; ++n) acc[ai][bj][m][n] = acc[ai][bj][m][n] * ratio;
                if (m & 1) PG8_FENCE(); }
    }
    __device__ __forceinline__ void operator()(const f32x4 (&acc)[2][2][4][2], const Unit& u, int wr, int wc, int fr, int fq) const {
        asm volatile("" : "+v"(fr), "+v"(fq));
        const int b = u.pm >> 3, c0 = u.pn * BM + wc * 32 + 8 * fq;
        float rs[2][4], ss[2][4];
#pragma unroll
        for (int ai = 0; ai < 2; ++ai)
#pragma unroll
            for (int m = 0; m < 4; ++m) { ss[ai][m] = 0.f; rs[ai][m] = 1.f;
                if (MIDS) { float sg, sa; row_sum8x2(ssqy, PG8_ROW(u, ai, m), fq, sg, sa); rs[ai][m] = rsqrtf(sa * (1.f / 512) + EPS); if (m & 1) PG8_FENCE(); } }
#pragma unroll
        for (int bj = 0; bj < 2; ++bj) { const int cb = c0 + bj * HALF;
            const f32x4 g0 = *(const f32x4*)(gate + (size_t)b * NMOD + cb), g1 = *(const f32x4*)(gate + (size_t)b * NMOD + cb + 4);
            f32x4 m0 = (f32x4){0.f, 0.f, 0.f, 0.f}, m1 = m0; if (gm) { m0 = *(const f32x4*)(gm + (size_t)b * DM + cb); m1 = *(const f32x4*)(gm + (size_t)b * DM + cb + 4); }
#pragma unroll
            for (int ai = 0; ai < 2; ++ai)
#pragma unroll
                for (int m = 0; m < 4; ++m) { PG8_FENCE(); const size_t off = (size_t)PG8_ROW(u, ai, m) * DM + cb;
                    const f32x4 x0 = *(const f32x4*)(xin + off) + g0 * (acc[ai][bj][m][0] * rs[ai][m]), x1 = *(const f32x4*)(xin + off + 4) + g1 * (acc[ai][bj][m][1] * rs[ai][m]);
                    *(f32x4*)(xout + off) = x0; *(f32x4*)(xout + off + 4) = x1;
                    if (gm) { ss[ai][m] += hsq4(x0) + hsq4(x1); *(u32x4*)(A + off) = pack8(x0 * m0, x1 * m1); } } }
        if (gm) {
#pragma unroll
            for (int ai = 0; ai < 2; ++ai)
#pragma unroll
                for (int m = 0; m < 4; ++m) { const float s = quad_sum(ss[ai][m]); if (fq == 0) ssqo[(size_t)PG8_ROW(u, ai, m) * 16 + u.pn * 4 + wc] = s; } }
    }
};
struct EpiFf1 {
    static constexpr bool PERM = true, AFTER_DRAIN = false, HAS_MID = false; static constexpr int MID_T = -1;
    const float* ssq2; const float* shw2; bf16_t* H;
    __device__ __forceinline__ void mid(f32x4 (&)[2][2][4][2], const Unit&, int, int) const {}
    __device__ __forceinline__ void operator()(const f32x4 (&acc)[2][2][4][2], const Unit& u, int wr, int wc, int fr, int fq) const {
        asm volatile("" : "+v"(fr), "+v"(fq));
        const int b = u.pm >> 3, c0 = u.pn * BM + wc * 32 + 8 * fq;
        f32x4 sh[2][2];
#pragma unroll
        for (int bj = 0; bj < 2; ++bj)
#pragma unroll
            for (int n = 0; n < 2; ++n) sh[bj][n] = *(const f32x4*)(shw2 + (size_t)b * DFF + c0 + bj * HALF + 4 * n);
        float rsv[2][4];
#pragma unroll
        for (int ai = 0; ai < 2; ++ai) {
#pragma unroll
            for (int m = 0; m < 4; ++m) rsv[ai][m] = rsqrtf(row_sum16(ssq2, PG8_ROW(u, ai, m), fq) * (1.f / DM) + EPS);
            PG8_FENCE(); }
#pragma unroll
        for (int ai = 0; ai < 2; ++ai)
#pragma unroll
            for (int m = 0; m < 4; ++m) { const int row = PG8_ROW(u, ai, m); const float rs = rsv[ai][m]; PG8_FENCE();
#pragma unroll
                for (int bj = 0; bj < 2; ++bj) { f32x4 v0 = acc[ai][bj][m][0] * rs + sh[bj][0], v1 = acc[ai][bj][m][1] * rs + sh[bj][1];
#pragma unroll
                    for (int i = 0; i < 4; ++i) { const float a = fmaxf(v0[i], 0.f), c = fmaxf(v1[i], 0.f); v0[i] = a * a; v1[i] = c * c; }
                    *(u32x4*)(H + (size_t)row * DFF + c0 + bj * HALF) = pack8(v0, v1); } }
    }
};

template <class Epi, class Sched, bool ALIGN_EPI = false, bool SP2 = false>
__device__ __forceinline__ void gemm_phase(PG8_LAS unsigned char* lds, const Gemm g, const Sched& S, const Epi& E, int wid0) {
    int tid_ = wid0 * 64 + lane_id(); asm volatile("" : "+v"(tid_));
    const int tid = tid_, wid = __builtin_amdgcn_readfirstlane(tid >> 6), lane = tid & 63, wr = wid >> 2, wc = wid & 3, fr = lane & 15, fq = lane >> 4;
    const int K = g.K, nt = K / BK;
    unsigned voffA[2], voffB[2];
#pragma unroll
    for (int i = 0; i < 2; ++i) { int R, C; stage_rc(tid * 16 + i * 8192, R, C); const int Rb = Epi::PERM ? ((R & ~31) + perm32(R & 31)) : R;
        voffA[i] = (unsigned)(R * K + C) * 2u; voffB[i] = (unsigned)(Rb * K + C) * 2u; }
    const size_t kstep = (size_t)(BK * 2);
    const size_t hstep = (size_t)HALF * K * 2;
    const size_t tstep = 2 * hstep;
    const unsigned ldsw = (unsigned)wid * 1024u;
    const int aoff = lds_byte(wr * 64 + fr, fq * 8), boff = lds_byte(wc * 32 + fr, fq * 8);
#define PG8_SA(b, h) (((b) * 2 + (h)) * HTB)
#define PG8_SB(b, h) ((4 + (b) * 2 + (h)) * HTB)
#define PG8_STAGE(bufoff, gbase, voff) do { _Pragma("unroll") for (int _i = 0; _i < 2; ++_i) \
        __builtin_amdgcn_global_load_lds((const unsigned*)((const char*)(gbase) + (voff)[_i]), (PG8_LAS unsigned*)(lds + (bufoff) + ldsw + _i * 8192), 16, 0, 0); } while (0)
#define PG8_LDA(dst, b, h) do { _Pragma("unroll") for (int m = 0; m < 4; ++m) _Pragma("unroll") for (int k = 0; k < 2; ++k) dst[m][k] = *(const PG8_LAS bf16x8*)(lds + PG8_SA(b, h) + aoff + m * 2048 + k * 1024); } while (0)
#define PG8_LDB(dst, b, h) do { _Pragma("unroll") for (int n = 0; n < 2; ++n) _Pragma("unroll") for (int k = 0; k < 2; ++k) dst[n][k] = *(const PG8_LAS bf16x8*)(lds + PG8_SB(b, h) + boff + n * 2048 + k * 1024); } while (0)
#define PG8_MMA(ai, bj, At, Bt) do { __builtin_amdgcn_s_setprio(1); _Pragma("unroll") for (int m = 0; m < 4; ++m) _Pragma("unroll") for (int n = 0; n < 2; ++n) _Pragma("unroll") for (int k = 0; k < 2; ++k) \
        acc[ai][bj][m][n] = __builtin_amdgcn_mfma_f32_16x16x32_bf16(Bt[n][k], At[m][k], acc[ai][bj][m][n], 0, 0, 0); __builtin_amdgcn_s_setprio(0); } while (0)
#define PG8_WAIT_V(n) asm volatile("s_waitcnt vmcnt(" #n ")" ::: "memory")
#define PG8_WAIT_L(n) asm volatile("s_waitcnt lgkmcnt(" #n ")" ::: "memory")
#define PG8_BAR __builtin_amdgcn_s_barrier()
#define PG8_SCHED __builtin_amdgcn_sched_barrier(0)
    Unit cur, nxt; int ui = 0;
    if (!S.next(0, cur)) return;
    f32x4 acc[2][2][4][2];
#pragma unroll
    for (int a = 0; a < 2; ++a)
#pragma unroll
        for (int b = 0; b < 2; ++b)
#pragma unroll
            for (int m = 0; m < 4; ++m)
#pragma unroll
                for (int n = 0; n < 2; ++n) acc[a][b][m][n] = (f32x4){0.f, 0.f, 0.f, 0.f};
    bf16x8 At[4][2], B0[2][2], B1[2][2];
    const char* cA = (const char*)g.A + (size_t)cur.pm * tstep; const char* cB = (const char*)g.Bt + (size_t)cur.pn * tstep;
    S.a_ready(cur);
    if constexpr (SP2) {
        PG8_STAGE(PG8_SB(0, 0), cB, voffB); PG8_STAGE(PG8_SB(0, 1), cB + hstep, voffB); PG8_STAGE(PG8_SA(0, 0), cA, voffA); PG8_STAGE(PG8_SA(0, 1), cA + hstep, voffA);
        if (wr == 1) PG8_BAR;
        PG8_WAIT_V(2); PG8_BAR;
        PG8_STAGE(PG8_SB(1, 0), cB + kstep, voffB); PG8_STAGE(PG8_SA(1, 0), cA + kstep, voffA); PG8_STAGE(PG8_SB(1, 1), cB + hstep + kstep, voffB);
        PG8_WAIT_V(6); PG8_BAR;
    } else {
        PG8_STAGE(PG8_SB(0, 0), cB, voffB); PG8_STAGE(PG8_SA(0, 0), cA, voffA); PG8_STAGE(PG8_SB(0, 1), cB + hstep, voffB); PG8_STAGE(PG8_SA(0, 1), cA + hstep, voffA);
        if (wr == 1) PG8_BAR;
        PG8_WAIT_V(4); PG8_BAR;
        PG8_STAGE(PG8_SB(1, 0), cB + kstep, voffB); PG8_STAGE(PG8_SA(1, 0), cA + kstep, voffA); PG8_STAGE(PG8_SB(1, 1), cB + hstep + kstep, voffB);
        PG8_WAIT_V(6); PG8_BAR;
    }
    for (;;) {
        const bool has_next = S.next(ui + 1, nxt);
        const char* nA = has_next ? (const char*)g.A + (size_t)nxt.pm * tstep : cA; const char* nB = has_next ? (const char*)g.Bt + (size_t)nxt.pn * tstep : cB;
        for (int t = 0; t < nt; t += 2) {
            const bool last = (t == nt - 2);
            const char* a1 = cA + (size_t)(t + 1) * kstep;
            const char* a2 = last ? nA : cA + (size_t)(t + 2) * kstep; const char* b2 = last ? nB : cB + (size_t)(t + 2) * kstep;
            const char* a3 = a2 + kstep; const char* b3 = b2 + kstep;
            if (last && has_next) S.a_ready(nxt);
            if constexpr (Epi::HAS_MID) { if (t == Epi::MID_T) E.mid(acc, cur, wr, fr); }
            if constexpr (SP2) {
            PG8_LDB(B0, 0, 0); PG8_LDB(B1, 0, 1); PG8_SCHED; PG8_LDA(At, 0, 0); PG8_STAGE(PG8_SA(1, 1), a1 + hstep, voffA);
            PG8_WAIT_V(8); PG8_WAIT_L(0); PG8_BAR; PG8_MMA(0, 0, At, B0); PG8_MMA(0, 1, At, B1); PG8_BAR; PG8_SCHED;
            PG8_LDA(At, 0, 1); PG8_STAGE(PG8_SB(0, 0), b2, voffB); PG8_STAGE(PG8_SB(0, 1), b2 + hstep, voffB); PG8_STAGE(PG8_SA(0, 0), a2, voffA);
            PG8_WAIT_V(8); PG8_WAIT_L(0); PG8_BAR; PG8_MMA(1, 0, At, B0); PG8_MMA(1, 1, At, B1); PG8_BAR; PG8_SCHED;
            PG8_LDB(B0, 1, 0); PG8_LDB(B1, 1, 1); PG8_SCHED; PG8_LDA(At, 1, 0); PG8_STAGE(PG8_SA(0, 1), a2 + hstep, voffA);
            PG8_WAIT_V(8); PG8_WAIT_L(0); PG8_BAR; PG8_MMA(0, 0, At, B0); PG8_MMA(0, 1, At, B1); PG8_BAR; PG8_SCHED;
            PG8_LDA(At, 1, 1); PG8_STAGE(PG8_SB(1, 0), b3, voffB); PG8_STAGE(PG8_SB(1, 1), b3 + hstep, voffB); PG8_STAGE(PG8_SA(1, 0), a3, voffA);
            PG8_WAIT_V(8); PG8_WAIT_L(0); PG8_BAR; PG8_MMA(1, 0, At, B0); PG8_MMA(1, 1, At, B1); PG8_BAR; PG8_SCHED;
            } else {
            PG8_LDB(B0, 0, 0); PG8_SCHED; PG8_LDA(At, 0, 0); PG8_STAGE(PG8_SA(1, 1), a1 + hstep, voffA);
            PG8_WAIT_L(8); PG8_BAR; PG8_WAIT_L(0); PG8_MMA(0, 0, At, B0); PG8_BAR; PG8_SCHED;
            PG8_LDB(B1, 0, 1); PG8_STAGE(PG8_SB(0, 0), b2, voffB);
            PG8_BAR; PG8_WAIT_L(0); PG8_MMA(0, 1, At, B1); PG8_BAR;
            PG8_LDA(At, 0, 1); PG8_STAGE(PG8_SA(0, 0), a2, voffA);
            PG8_BAR; PG8_WAIT_L(0); PG8_MMA(1, 0, At, B0); PG8_BAR; PG8_SCHED;
            PG8_STAGE(PG8_SB(0, 1), b2 + hstep, voffB);
            PG8_WAIT_V(6); PG8_BAR; PG8_MMA(1, 1, At, B1); PG8_BAR;
            PG8_LDB(B0, 1, 0); PG8_SCHED; PG8_LDA(At, 1, 0); PG8_STAGE(PG8_SA(0, 1), a2 + hstep, voffA);
            PG8_WAIT_L(8); PG8_BAR; PG8_WAIT_L(0); PG8_MMA(0, 0, At, B0); PG8_BAR; PG8_SCHED;
            PG8_LDB(B1, 1, 1); PG8_STAGE(PG8_SB(1, 0), b3, voffB);
            PG8_BAR; PG8_WAIT_L(0); PG8_MMA(0, 1, At, B1); PG8_BAR;
            PG8_LDA(At, 1, 1); PG8_STAGE(PG8_SA(1, 0), a3, voffA);
            PG8_BAR; PG8_WAIT_L(0); PG8_MMA(1, 0, At, B0); PG8_BAR; PG8_SCHED;
            PG8_STAGE(PG8_SB(1, 1), b3 + hstep, voffB);
            PG8_WAIT_V(6); PG8_BAR; PG8_MMA(1, 1, At, B1); PG8_BAR;
            }
        }
        if constexpr (ALIGN_EPI) { if (wr == 0) PG8_BAR; }
        if constexpr (!Epi::AFTER_DRAIN) { E(acc, cur, wr, wc, fr, fq); S.done(cur); }
        if (!has_next) break;
#pragma unroll
        for (int a = 0; a < 2; ++a)
#pragma unroll
            for (int b = 0; b < 2; ++b)
#pragma unroll
                for (int m = 0; m < 4; ++m)
#pragma unroll
                    for (int n = 0; n < 2; ++n) acc[a][b][m][n] = (f32x4){0.f, 0.f, 0.f, 0.f};
        cur = nxt; cA = nA; cB = nB; ++ui;
        if constexpr (ALIGN_EPI) { if (wr == 1) PG8_BAR; }
    }
    PG8_WAIT_V(0);
    if constexpr (!ALIGN_EPI) { if (wr == 0) PG8_BAR; }
    PG8_BAR;
    if constexpr (Epi::AFTER_DRAIN) { E.fused(acc, cur, wr, wc, fr, fq, lds, wid, lane); S.done(cur); }
#undef PG8_SA
#undef PG8_SB
#undef PG8_STAGE
#undef PG8_LDA
#undef PG8_LDB
#undef PG8_MMA
#undef PG8_WAIT_V
#undef PG8_WAIT_L
#undef PG8_BAR
#undef PG8_SCHED
}
}

namespace gm {
#define GM_LAS __attribute__((address_space(3)))
typedef short v4i16_t __attribute__((ext_vector_type(4)));
__device__ __forceinline__ int swz(int s) { return ((s >> 1) & 1) + 2 * ((s >> 3) & 1); }
__device__ __forceinline__ void gmlp_phase(GM_LAS unsigned char* lds, int wid0, int vcu, const bf16_t* U, const bf16_t* VN, const bf16_t* GW  , const float* bs  , const float* gog  , bf16_t* Y, float* ssqy) {
    int tid_ = wid0 * 64 + lane_id(); asm volatile("" : "+v"(tid_));
    const int tid = tid_, lane = tid & 63, wid = __builtin_amdgcn_readfirstlane(tid >> 6), fr = lane & 15, fq = lane >> 4;
    const int g = vcu & 7, nks = (wid >> 1) + 1;
    bf16x8 wf[4];
#pragma unroll
    for (int ks = 0; ks < 4; ++ks) wf[ks] = *(const bf16x8*)(GW + ((size_t)(g * CHUNK + 16 * wid + fr)) * CHUNK + 32 * ks + 8 * fq);
    const float bias = bs[g * CHUNK + 16 * wid + fr];
    f32x4 gv[4];
#pragma unroll
    for (int nt = 0; nt < 4; ++nt) gv[nt] = *(const f32x4*)(gog + g * 64 + 16 * nt + 4 * fq);
    for (int i = 0; i < 8; ++i) {
        const int un = (vcu >> 3) + 32 * i; const size_t t0 = (size_t)un * CHUNK;
        pg8::u32x4 st[2];
#pragma unroll
        for (int k = 0; k < 2; ++k) { const int idx = tid + 512 * k, s = idx >> 3, c16 = idx & 7; st[k] = *(const pg8::u32x4*)(VN + (t0 + s) * 512 + g * 64 + c16 * 8); }
        __syncthreads();
#pragma unroll
        for (int k = 0; k < 2; ++k) { const int idx = tid + 512 * k, s = idx >> 3, c16 = idx & 7; *(GM_LAS pg8::u32x4*)(lds + s * 128 + (((c16 >> 1) ^ swz(s)) * 32) + (c16 & 1) * 16) = st[k]; }
        __syncthreads();
        f32x4 acc[4];
#pragma unroll
        for (int nt = 0; nt < 4; ++nt) acc[nt] = (f32x4){0.f, 0.f, 0.f, 0.f};
#pragma unroll
        for (int ks = 0; ks < 4; ++ks) { if (ks < nks) {
#pragma unroll
            for (int nt = 0; nt < 4; ++nt) {
                const int q = fr >> 2, p = fr & 3;
                const int s0 = 32 * ks + 8 * fq + q, s1 = s0 + 4;
                const v4i16_t lo = __builtin_amdgcn_ds_read_tr16_b64_v4i16((GM_LAS v4i16_t*)(lds + s0 * 128 + ((nt ^ swz(s0)) * 32) + p * 8));
                const v4i16_t hi = __builtin_amdgcn_ds_read_tr16_b64_v4i16((GM_LAS v4i16_t*)(lds + s1 * 128 + ((nt ^ swz(s1)) * 32) + p * 8));
                const bf16x8 vf = (bf16x8){lo[0], lo[1], lo[2], lo[3], hi[0], hi[1], hi[2], hi[3]};
                acc[nt] = __builtin_amdgcn_mfma_f32_16x16x32_bf16(vf, wf[ks], acc[nt], 0, 0, 0);
            } } }
        const size_t row = t0 + 16 * wid + fr; float ss = 0.f;
#pragma unroll
        for (int nt = 0; nt < 4; ++nt) { const int c = g * 64 + 16 * nt + 4 * fq;
            const uint2 uu = *(const uint2*)(U + row * 512 + c);
            f32x4 y; y[0] = bf2f((bf16_t)(uu.x & 0xffff)) * (acc[nt][0] + bias); y[1] = bf2f((bf16_t)(uu.x >> 16)) * (acc[nt][1] + bias);
            y[2] = bf2f((bf16_t)(uu.y & 0xffff)) * (acc[nt][2] + bias); y[3] = bf2f((bf16_t)(uu.y >> 16)) * (acc[nt][3] + bias);
            ss += pg8::hsq4(y); *(pg8::u32x2*)(Y + row * DM + c) = pg8::pack4(y * gv[nt]); }
        ss = pg8::quad_sum(ss); if (fq == 0) ssqy[row * 16 + g] = ss;
    }
    __syncthreads();
}
}

namespace att {
#define AT_LAS __attribute__((address_space(3)))
using f32x16 = __attribute__((ext_vector_type(16))) float;
using s16x4 = __attribute__((ext_vector_type(4))) short;
using u32x4 = __attribute__((ext_vector_type(4))) unsigned;
constexpr int KVBLK = 64, NSLOT = 3, SLOTB = 20480, VOFF = 12288;
constexpr int LDS_WS = NSLOT * SLOTB  , LDS_OST = LDS_WS + 8 * 256  , OROW = 272, LDS_BYTES = LDS_OST + 8 * 32 * OROW  ;
__device__ __forceinline__ int crow(int r, int hi) { return (r & 3) + 8 * (r >> 2) + 4 * hi; }
__device__ __forceinline__ void glds16(const void* gsrc, unsigned lds_dst) { unsigned keep;
    asm volatile("s_mov_b32 %0, m0\n\ts_mov_b32 m0, %2\n\ts_nop 0\n\tglobal_load_lds_dwordx4 %1, off\n\ts_mov_b32 m0, %0" : "=&s"(keep) : "v"(gsrc), "s"(lds_dst) : "memory"); }
#define AT_WAIT_BAR(N) asm volatile("s_waitcnt vmcnt(" #N ") lgkmcnt(0)\n\ts_barrier" ::: "memory")
#define AT_SBAR() __builtin_amdgcn_sched_barrier(0)
typedef short v4i16_t __attribute__((ext_vector_type(4)));
__device__ __forceinline__ s16x4 vtr(AT_LAS const char* p) { return __builtin_bit_cast(s16x4, __builtin_amdgcn_ds_read_tr16_b64_v4i16((AT_LAS v4i16_t*)p)); }

template <int THRL>
__device__ __forceinline__ void attn_unit(int b, int h, int qb, const bf16_t* Q, const bf16_t* KN, const bf16_t* KR, const bf16_t* V, const float* goa  , bf16_t* Y, float* ssqy, AT_LAS char* shm, int wid0) {
    int tid_ = wid0 * 64 + lane_id(); asm volatile("" : "+v"(tid_));
    const int tid = tid_, lane = tid & 63, r32 = lane & 31, hi = lane >> 5; const int wid = __builtin_amdgcn_readfirstlane(tid >> 6);
    const size_t rowbase = (size_t)b * SEQ; const int q0 = qb * 256;
    const bf16_t* Qw = Q + (rowbase + q0 + wid * 32) * 768 + h * 96;
    const unsigned lds0 = (unsigned)(uintptr_t)shm;
    AT_LAS float* wsf = (AT_LAS float*)(shm + LDS_WS) + wid * 64;
    const bf16_t* ksrc = KN + (rowbase + lane) * 512 + h * 64 + wid * 8;
    const bf16_t* rsrc = KR + (rowbase + lane) * 32 + (wid & 3) * 8;
    const bf16_t* vsrc = V + (rowbase + 16 * (wid & 3) + (lane >> 2)) * 512 + h * 64 + (wid >> 2) * 32 + (lane & 3) * 8;
    const unsigned kdst = lds0 + wid * 1024, rdst = lds0 + (8 + (wid & 3)) * 1024, vdst = lds0 + VOFF + wid * 1024;
#define AT_DMA(t, slot) do { glds16(ksrc + (size_t)(t) * KVBLK * 512, (unsigned)__builtin_amdgcn_readfirstlane(kdst + (slot))); \
        glds16(rsrc + (size_t)(t) * KVBLK * 32, (unsigned)__builtin_amdgcn_readfirstlane(rdst + (slot))); \
        glds16(vsrc + (size_t)(t) * KVBLK * 512, (unsigned)__builtin_amdgcn_readfirstlane(vdst + (slot))); } while (0)
    const int NT = (q0 + 256) / KVBLK;
    bf16x8 qr[6];
#pragma unroll
    for (int d0 = 0; d0 < 6; ++d0) qr[d0] = *(const bf16x8*)(Qw + (size_t)r32 * 768 + d0 * 16 + hi * 8);
    AT_DMA(0, 0); AT_DMA(1, SLOTB);
    float mhat = 0.f, l_reg = 0.f; f32x16 o[2]; o[0] = f32x16{}; o[1] = f32x16{};
    const int qrel = wid * 32 + r32;
    int sl_cur = 0, sl_nn = 2 * SLOTB;
    AT_LAS const char* kp0 = shm + hi * 1024 + r32 * 16;
    AT_LAS const char* vp0 = shm + VOFF + ((lane >> 4) & 1) * 32 + (lane & 3) * 8 + (4 * hi + ((lane & 15) >> 2)) * 64;
    for (int t = 0; t < NT; ++t) {
        if (t + 1 < NT) { AT_WAIT_BAR(3); } else { AT_WAIT_BAR(0); }
        if (t + 2 < NT) AT_DMA(t + 2, sl_nn);
        const int jb = t - (NT - 4);
        if (jb <= (wid >> 1)) {
            f32x16 p0, p1;
            { AT_LAS const char* kb = kp0 + sl_cur;
#pragma unroll
              for (int d0 = 0; d0 < 6; ++d0) {
                const bf16x8 b0 = *(AT_LAS const bf16x8*)(kb + d0 * 2048), b1 = *(AT_LAS const bf16x8*)(kb + d0 * 2048 + 512);
                if (d0 == 0) { p0 = __builtin_amdgcn_mfma_f32_32x32x16_bf16(b0, qr[0], f32x16{}, 0, 0, 0); p1 = __builtin_amdgcn_mfma_f32_32x32x16_bf16(b1, qr[0], f32x16{}, 0, 0, 0); }
                else { p0 = __builtin_amdgcn_mfma_f32_32x32x16_bf16(b0, qr[d0], p0, 0, 0, 0); p1 = __builtin_amdgcn_mfma_f32_32x32x16_bf16(b1, qr[d0], p1, 0, 0, 0); } } }
            if (jb >= 0) { const int kb = 64 * jb + 4 * hi;
#pragma unroll
                for (int r = 0; r < 16; ++r) { const int kv = kb + (r & 3) + 8 * (r >> 2); if (kv > qrel) p0[r] = -INFINITY; if (kv + 32 > qrel) p1[r] = -INFINITY; } }
            float rm = fmaxf(p0[0], p1[0]);
#pragma unroll
            for (int r = 1; r < 16; ++r) rm = fmaxf(rm, fmaxf(p0[r], p1[r]));
            { auto rr = __builtin_amdgcn_permlane32_swap(__float_as_uint(rm), __float_as_uint(rm), false, false); rm = fmaxf(__uint_as_float(rr[0]), __uint_as_float(rr[1])); }
            const float grow = rm - mhat;
            if (t == 0 || __any(grow > (float)THRL)) {
                const float dl = (t == 0) ? rm : fmaxf(grow, 0.f); const float f = (t == 0) ? 0.f : __builtin_amdgcn_exp2f(-dl);
                mhat = (t == 0) ? rm : mhat + dl; l_reg *= f;
                if (t > 0) { if (hi == 0) wsf[r32] = f; asm volatile("s_waitcnt lgkmcnt(0)" ::: "memory");
#pragma unroll
                    for (int r = 0; r < 16; ++r) { const float fr_ = wsf[crow(r, hi)]; o[0][r] *= fr_; o[1][r] *= fr_; } }
            }
            float sacc = 0.f;
#pragma unroll
            for (int r = 0; r < 16; ++r) { p0[r] = __builtin_amdgcn_exp2f(p0[r] - mhat); p1[r] = __builtin_amdgcn_exp2f(p1[r] - mhat); sacc += p0[r] + p1[r]; }
            l_reg += sacc;
            u32x4 pw0, pw1, pw2, pw3;
#define AT_PK(P, B) pg8::cvt_pk_bf16(P[B], P[B + 1])
            pw0 = (u32x4){AT_PK(p0, 0), AT_PK(p0, 2), AT_PK(p0, 4), AT_PK(p0, 6)}; pw1 = (u32x4){AT_PK(p0, 8), AT_PK(p0, 10), AT_PK(p0, 12), AT_PK(p0, 14)};
            pw2 = (u32x4){AT_PK(p1, 0), AT_PK(p1, 2), AT_PK(p1, 4), AT_PK(p1, 6)}; pw3 = (u32x4){AT_PK(p1, 8), AT_PK(p1, 10), AT_PK(p1, 12), AT_PK(p1, 14)};
#undef AT_PK
            AT_LAS const char* vp = vp0 + sl_cur;
#pragma unroll
            for (int d0 = 0; d0 < 2; ++d0) { s16x4 lo[4], hh[4];
#pragma unroll
                for (int ks = 0; ks < 4; ++ks) { lo[ks] = vtr(vp + d0 * 4096 + ks * 1024); hh[ks] = vtr(vp + d0 * 4096 + ks * 1024 + 512); }
#define AT_VF(k) (bf16x8){lo[k][0], lo[k][1], lo[k][2], lo[k][3], hh[k][0], hh[k][1], hh[k][2], hh[k][3]}
                o[d0] = __builtin_amdgcn_mfma_f32_32x32x16_bf16(__builtin_bit_cast(bf16x8, pw0), AT_VF(0), o[d0], 0, 0, 0);
                o[d0] = __builtin_amdgcn_mfma_f32_32x32x16_bf16(__builtin_bit_cast(bf16x8, pw1), AT_VF(1), o[d0], 0, 0, 0);
                o[d0] = __builtin_amdgcn_mfma_f32_32x32x16_bf16(__builtin_bit_cast(bf16x8, pw2), AT_VF(2), o[d0], 0, 0, 0);
                o[d0] = __builtin_amdgcn_mfma_f32_32x32x16_bf16(__builtin_bit_cast(bf16x8, pw3), AT_VF(3), o[d0], 0, 0, 0);
#undef AT_VF
            }
        }
        sl_cur = (sl_cur == 2 * SLOTB) ? 0 : sl_cur + SLOTB; sl_nn = (sl_nn == 2 * SLOTB) ? 0 : sl_nn + SLOTB;
    }
    { auto rr = __builtin_amdgcn_permlane32_swap(__float_as_uint(l_reg), __float_as_uint(l_reg), false, false); l_reg = __uint_as_float(rr[0]) + __uint_as_float(rr[1]); }
    if (hi == 0) wsf[32 + r32] = __builtin_amdgcn_rcpf(l_reg);
    asm volatile("s_waitcnt lgkmcnt(0)" ::: "memory");
    AT_LAS char* stg = shm + LDS_OST + wid * (32 * OROW);
#pragma unroll
    for (int r = 0; r < 16; ++r) { const int orow = crow(r, hi); const float rl = wsf[32 + orow];
        *(AT_LAS float*)(stg + orow * OROW + r32 * 4) = o[0][r] * rl; *(AT_LAS float*)(stg + orow * OROW + 128 + r32 * 4) = o[1][r] * rl; }
    asm volatile("s_waitcnt lgkmcnt(0)" ::: "memory");
    { const int row = lane >> 1, half = lane & 1; const size_t grow = rowbase + q0 + wid * 32 + row; float ss = 0.f;
      const float* gp = goa + h * 64 + half * 32; bf16_t* yp = Y + grow * DM + 512 + h * 64 + half * 32;
#pragma unroll
      for (int i = 0; i < 4; ++i) { const f32x4 a = *(AT_LAS const f32x4*)(stg + row * OROW + half * 128 + i * 32), c = *(AT_LAS const f32x4*)(stg + row * OROW + half * 128 + i * 32 + 16);
          ss += pg8::hsq4(a) + pg8::hsq4(c);
          *(u32x4*)(yp + i * 8) = pg8::pack8(a * *(const f32x4*)(gp + i * 8), c * *(const f32x4*)(gp + i * 8 + 4)); }
      ss += swz_xor1(ss); if (half == 0) ssqy[grow * 16 + 8 + h] = ss; }
    asm volatile("s_waitcnt lgkmcnt(0)\n\ts_barrier" ::: "memory");
#undef AT_DMA
}
__device__ __forceinline__ void attn_phase(AT_LAS char* lds, int wid0, int vcu, const bf16_t* Q, const bf16_t* KN, const bf16_t* KR, const bf16_t* V, const float* goa, bf16_t* Y, float* ssqy) {
    const int bh = vcu >> 1, s = vcu & 1;
    for (int i = 0; i < 4; ++i) { const int qb = (i == 0) ? s : (i == 1) ? 7 - s : (i == 2) ? 2 + s : 5 - s;
        attn_unit<8>(bh >> 3, bh & 7, qb, Q, KN, KR, V, goa, Y, ssqy, lds, wid0); }
}
}

constexpr int NWAVES = 8;
constexpr int RING_BYTES = 131072;
constexpr int LDSCTL_OFF = 135168, MISC_OFF = LDSCTL_OFF + 320;
constexpr int LDS_BYTES = 147456;
static_assert(att::LDS_BYTES <= LDSCTL_OFF, "attention scratch below the control words");
constexpr int CW_BAR = 4096;
constexpr size_t CTL_ZERO_BYTES = 64 * 1024;

#define GAS __attribute__((address_space(1)))
#define LAS __attribute__((address_space(3)))
typedef GAS unsigned gu32;
#define RLX_AGENT __ATOMIC_RELAXED, __HIP_MEMORY_SCOPE_AGENT
#define XB_TMO      128
#define XB_XCNT(j)  (256  + 64 * (j))
#define XB_XSUB(j)  (1280 + 64 * (j))
#define XB_XGEN(j)  (2304 + 64 * (j))
#define XB_TOP      3328
#define XB_TOPGEN   3392
#define XCD_BAR_WORDS 3456
#define XB_SPIN_CAP (1u << 18)
__device__ __forceinline__ unsigned xb_ld(unsigned* p)              { return __hip_atomic_load(p, __ATOMIC_RELAXED, __HIP_MEMORY_SCOPE_AGENT); }
__device__ __forceinline__ unsigned xb_add(unsigned* p, unsigned v) { return __hip_atomic_fetch_add(p, v, __ATOMIC_RELAXED, __HIP_MEMORY_SCOPE_AGENT); }
__device__ __forceinline__ unsigned xb_xcc_id() { return (unsigned)__builtin_amdgcn_s_getreg((3 << 11) | 20) & 0xFu; }
#define XB_SPIN(cond, bar) do { unsigned _sp = 0; while (cond) { __builtin_amdgcn_s_sleep(1); \
    if ((++_sp & 255u) == 0u) { if (xb_ld(&(bar)[XB_TMO])) break; if (_sp > XB_SPIN_CAP) { atomicAdd(&(bar)[XB_TMO], 1u); break; } } } } while (0)
struct XcdBarrier { unsigned* bar; unsigned x; volatile LAS unsigned* st; };
__device__ __forceinline__ XcdBarrier xcd_barrier_post(unsigned* bar, volatile LAS unsigned* st) {
    XcdBarrier b; b.bar = bar; b.x = xb_xcc_id(); b.st = st;
    if (threadIdx.x == 0) (void)xb_add(&bar[XB_XCNT(b.x)], 1u);
    return b;
}
__device__ __forceinline__ void xcd_barrier_complete(unsigned* bar, unsigned x, unsigned& nloc, unsigned& nx) {
    const unsigned G = gridDim.x * gridDim.y * gridDim.z;
    unsigned sum, cnt, mine, sp = 0u;
    for (;;) {
        sum = 0u; cnt = 0u; mine = 0u;
#pragma unroll
        for (unsigned j = 0; j < 16; ++j) { const unsigned c = xb_ld(&bar[XB_XCNT(j)]); sum += c; cnt += (c > 0u) ? 1u : 0u; mine = (j == x) ? c : mine; }
        if (sum == G) break;
        __builtin_amdgcn_s_sleep(1);
        if ((++sp & 255u) == 0u) { if (xb_ld(&bar[XB_TMO])) break; if (sp > XB_SPIN_CAP) { atomicAdd(&bar[XB_TMO], 1u); break; } }
    }
    nloc = mine > 0u ? mine : 1u; nx = cnt > 0u ? cnt : 1u;
}
__device__ __forceinline__ void xcd_barrier(const XcdBarrier& b, int wid0) {
    asm volatile("s_waitcnt vmcnt(0)" ::: "memory");
    __syncthreads();
    if (wid0 == 0 && lane_id() == 0) {
        unsigned* bar = b.bar;
        __builtin_amdgcn_s_waitcnt(0);
        unsigned nloc = b.st[0], nx = b.st[1];
        if (nloc == 0u) { xcd_barrier_complete(bar, b.x, nloc, nx); b.st[0] = nloc; b.st[1] = nx; }
        const unsigned old = xb_add(&bar[XB_XSUB(b.x)], 1u);
        const unsigned gen = old / nloc;
        if (old + 1u == (gen + 1u) * nloc) {
            __builtin_amdgcn_fence(__ATOMIC_RELEASE, "agent");
            asm volatile("s_waitcnt vmcnt(0)" ::: "memory");
            const unsigned og = xb_add(&bar[XB_TOP], 1u);
            const unsigned tg = og / nx;
            if (og + 1u == (tg + 1u) * nx) xb_add(&bar[XB_TOPGEN], 1u);
            else XB_SPIN(xb_ld(&bar[XB_TOPGEN]) == tg, bar);
            __builtin_amdgcn_fence(__ATOMIC_ACQUIRE, "agent");
            xb_add(&bar[XB_XGEN(b.x)], 1u);
            asm volatile("s_waitcnt vmcnt(0)" ::: "memory");
        } else {
            XB_SPIN(xb_ld(&bar[XB_XGEN(b.x)]) == gen, bar);
            __builtin_amdgcn_fence(__ATOMIC_ACQUIRE, "agent");
            asm volatile("s_waitcnt vmcnt(0)" ::: "memory");
        }
    }
    __syncthreads();
}

#ifndef DBG_ONLY
#define DBG_K(i) (k == (i))
#else
#define DBG_K(i) (k == (i) && (i) == DBG_ONLY)
#endif
constexpr int PH_P0A = 0, PH_P0B = 1, PH_L0 = 2, PH_PER_LAYER = 7, PH_FINAL = PH_L0 + DEPTH * PH_PER_LAYER, PH_END = PH_FINAL + 1;
struct Args { const void* in[20]; float* out; unsigned char* ws; int ph_lo, ph_hi; };

__global__ void __launch_bounds__(NWAVES * 64, 2) mk_fwd(Args args) {
    extern __shared__ __attribute__((aligned(16))) unsigned char lds[];
    LAS unsigned char* L = (LAS unsigned char*)lds;
    volatile LAS unsigned* MISC = (volatile LAS unsigned*)(L + MISC_OFF);
    const int tid = threadIdx.x; const int wid0 = __builtin_amdgcn_readfirstlane(tid >> 6);
    const int G = gridDim.x, bx = blockIdx.x, vcu = (G % 8 == 0) ? (bx % 8) * (G / 8) + bx / 8 : bx;
    unsigned char* ws0 = args.ws;
    for (int u = tid; u < (LDS_BYTES - LDSCTL_OFF) / 4; u += NWAVES * 64) ((LAS unsigned*)(L + LDSCTL_OFF))[u] = 0u;
    __syncthreads();
    XcdBarrier bar; bar.bar = (unsigned*)(ws0 + WS_CTL) + CW_BAR; bar.x = 0; bar.st = nullptr;
    if (args.ph_hi - args.ph_lo > 1) bar = xcd_barrier_post((unsigned*)(ws0 + WS_CTL) + CW_BAR, MISC + 8);

    for (int ph = args.ph_lo; ph < args.ph_hi; ++ph) {
        int zi = 0; asm volatile("" : "+s"(zi));
        unsigned char* ws = args.ws + zi; float* out = args.out + zi;
#define INP(i) ((const float*)args.in[(i) + zi])
        const float* x = INP(0);
        float* MOD = (float*)(ws + WS_MOD); float* SHW1 = (float*)(ws + WS_SHW1); float* SHW2 = (float*)(ws + WS_SHW2); float* RT = (float*)(ws + WS_ROPE);
        float* GM1 = (float*)(ws + WS_GM1); float* GM2 = (float*)(ws + WS_GM2);
        float* SSQ1 = (float*)(ws + WS_SSQ1); float* SSQ2 = (float*)(ws + WS_SSQ2); float* SSQY = (float*)(ws + WS_SSQY); float* SSQQ = (float*)(ws + WS_SSQQ);
        bf16_t* GW = (bf16_t*)(ws + WS_GW); bf16_t* A = (bf16_t*)(ws + WS_A); bf16_t* U = (bf16_t*)(ws + WS_U); bf16_t* VN = (bf16_t*)(ws + WS_VN);
        bf16_t* CQKV = (bf16_t*)(ws + WS_CQKV); bf16_t* KR = (bf16_t*)(ws + WS_KR); bf16_t* Q = (bf16_t*)(ws + WS_Q); bf16_t* KN = (bf16_t*)(ws + WS_KN); bf16_t* V = (bf16_t*)(ws + WS_V);
        bf16_t* Y = (bf16_t*)(ws + WS_Y); bf16_t* H = (bf16_t*)(ws + WS_H);
        if (ph >= PH_L0 && ph < PH_FINAL) {
            const int l = (ph - PH_L0) / PH_PER_LAYER, k = (ph - PH_L0) % PH_PER_LAYER;
            const bf16_t* Wl = (const bf16_t*)(ws + WS_W + (size_t)l * WL_STRIDE);
            const float* modl = MOD + (size_t)l * NB * NMOD;
            if (DBG_K(0)) {
                pg8::Gemm g{A, (const bf16_t*)((const unsigned char*)Wl + WL_IN), T, NIN, DM}; pg8::StaticOrder S; S.init(T, NIN, G, bx);
                pg8::EpiIn E{SSQ1, SHW1 + (size_t)l * NB * NIN, INP(9) + l * QR, INP(10) + l * KVR, RT, U, VN, CQKV, KR, SSQQ};
                pg8::gemm_phase<pg8::EpiIn, pg8::StaticOrder, true, true>(L, g, S, E, wid0);
            } else if (DBG_K(1)) {
                pg8::Gemm g{CQKV, (const bf16_t*)((const unsigned char*)Wl + WL_UP), T, NUP, KUP}; pg8::StaticOrder S; S.init(T, NUP, G, bx);
                pg8::EpiUp E{SSQQ, RT, Q, KN, V};
                pg8::gemm_phase<pg8::EpiUp, pg8::StaticOrder, true, true>(L, g, S, E, wid0);
            } else if (DBG_K(2)) {
                gm::gmlp_phase(L, wid0, vcu, U, VN, GW + (size_t)l * NGRP * CHUNK * CHUNK, INP(8) + l * NGRP * CHUNK, INP(13) + l * DG, Y, SSQY);
            } else if (DBG_K(3)) {
                att::attn_phase((LAS char*)L, wid0, vcu, Q, KN, KR, V, INP(14) + l * DG, Y, SSQY);
            } else if (DBG_K(4)) {
                pg8::Gemm g{Y, (const bf16_t*)((const unsigned char*)Wl + WL_OUT), T, DM, DM}; pg8::StaticOrder S; S.init(T, DM, G, bx);
                pg8::EpiRes<true> E{SSQY, l == 0 ? x : out, out, modl + 2 * DM, GM2 + (size_t)l * NB * DM, A, SSQ2};
                pg8::gemm_phase<pg8::EpiRes<true>, pg8::StaticOrder, true, true>(L, g, S, E, wid0);
            } else if (DBG_K(5)) {
                pg8::Gemm g{A, (const bf16_t*)((const unsigned char*)Wl + WL_1), T, DFF, DM}; pg8::StaticOrder S; S.init(T, DFF, G, bx);
                pg8::EpiFf1 E{SSQ2, SHW2 + (size_t)l * NB * DFF, H};
                pg8::gemm_phase<pg8::EpiFf1, pg8::StaticOrder, true, true>(L, g, S, E, wid0);
            } else if (DBG_K(6)) {
                pg8::Gemm g{H, (const bf16_t*)((const unsigned char*)Wl + WL_2), T, DM, DFF}; pg8::StaticOrder S; S.init(T, DM, G, bx);
                pg8::EpiRes<false> E{nullptr, out, out, modl + 5 * DM, (l + 1 < DEPTH) ? GM1 + (size_t)(l + 1) * NB * DM : nullptr, A, SSQ1};
                pg8::gemm_phase<pg8::EpiRes<false>, pg8::StaticOrder, true, true>(L, g, S, E, wid0);
            }
        }
        if (ph + 1 < args.ph_hi) { const int k = (ph >= PH_L0 && ph < PH_FINAL) ? (ph - PH_L0) % PH_PER_LAYER : -1; if (k != 1) xcd_barrier(bar, wid0); }
    }
}

#ifndef MK_IN
#define MK_IN 1
#endif
#ifndef MK_UP
#define MK_UP 1
#endif
#ifndef MK_GMLP
#define MK_GMLP 1
#endif
#ifndef MK_ATTN
#define MK_ATTN 1
#endif
#ifndef MK_OUT
#define MK_OUT 1
#endif
#ifndef MK_FF1
#define MK_FF1 1
#endif
#ifndef MK_FF2
#define MK_FF2 1
#endif
template <class Epi> static void gemm_naive(hipStream_t st, const bf16_t* A, int lda, const bf16_t* Bt, int ldb, int M, int N, int K, const Epi& e) {
    hipLaunchKernelGGL((k_gemm_naive<Epi>), dim3(N / 64, M / 64), dim3(256), 0, st, A, lda, Bt, ldb, K, e);
}
static int g_grid = 0;
static void launch_mk(hipStream_t st, Args a, int lo, int hi) {
    a.ph_lo = lo; a.ph_hi = hi;
    hipLaunchKernelGGL(mk_fwd, dim3(g_grid), dim3(NWAVES * 64), LDS_BYTES, st, a);
}
extern "C" void kernel_launch(void* const* d_in, const int* in_sizes, int n_in, void* d_out, int out_size, void* d_ws, size_t ws_size, hipStream_t stream) {
    if (n_in != 20 || out_size != T * DM || ws_size < WS_END) { fprintf(stderr, "kernel_launch: unexpected sizes n_in %d out %d ws %zu\n", n_in, out_size, ws_size); return; }
    if (g_grid == 0) {
        int dev = 0, cus = 0; hipGetDevice(&dev); hipDeviceGetAttribute(&cus, hipDeviceAttributeMultiprocessorCount, dev);
        if (hipFuncSetAttribute((const void*)mk_fwd, hipFuncAttributeMaxDynamicSharedMemorySize, LDS_BYTES) != hipSuccess) fprintf(stderr, "kernel_launch: hipFuncSetAttribute failed\n");
        g_grid = cus > 0 ? cus : 256;
    }
    const float* x = (const float*)d_in[0]; const float* c = (const float*)d_in[1]; const int* pos = (const int*)d_in[2];
    const float* w_ada = (const float*)d_in[3]; const float* b_ada = (const float*)d_in[4]; const float* g_mix = (const float*)d_in[5];
    const float* w_in = (const float*)d_in[6]; const float* g_ws = (const float*)d_in[7]; const float* g_bs = (const float*)d_in[8];
    const float* g_q = (const float*)d_in[9]; const float* g_kv = (const float*)d_in[10]; const float* w_uq = (const float*)d_in[11]; const float* w_ukv = (const float*)d_in[12];
    const float* g_og = (const float*)d_in[13]; const float* g_oa = (const float*)d_in[14]; const float* w_out = (const float*)d_in[15];
    const float* g_ffn = (const float*)d_in[16]; const float* w_ff1 = (const float*)d_in[17]; const float* w_ff2 = (const float*)d_in[18]; const float* g_fin = (const float*)d_in[19];
    unsigned char* ws = (unsigned char*)d_ws; float* out = (float*)d_out;
    float* MOD = (float*)(ws + WS_MOD); float* SHW1 = (float*)(ws + WS_SHW1); float* SHW2 = (float*)(ws + WS_SHW2); float* RT = (float*)(ws + WS_ROPE);
    float* GM1 = (float*)(ws + WS_GM1); float* GM2 = (float*)(ws + WS_GM2);
    float* SSQ1 = (float*)(ws + WS_SSQ1); float* SSQ2 = (float*)(ws + WS_SSQ2); float* SSQY = (float*)(ws + WS_SSQY); float* SSQQ = (float*)(ws + WS_SSQQ);
    bf16_t* GW = (bf16_t*)(ws + WS_GW); bf16_t* A = (bf16_t*)(ws + WS_A); bf16_t* U = (bf16_t*)(ws + WS_U); bf16_t* VN = (bf16_t*)(ws + WS_VN);
    bf16_t* CQKV = (bf16_t*)(ws + WS_CQKV); bf16_t* KR = (bf16_t*)(ws + WS_KR); bf16_t* Q = (bf16_t*)(ws + WS_Q); bf16_t* KN = (bf16_t*)(ws + WS_KN); bf16_t* V = (bf16_t*)(ws + WS_V);
    bf16_t* Y = (bf16_t*)(ws + WS_Y); bf16_t* H = (bf16_t*)(ws + WS_H); float* GV = (float*)(ws + WS_GV); float* ZL = (float*)(ws + WS_ZL); float* QRT = (float*)(ws + WS_QRT);
    auto WL = [&](int l, size_t off) { return (bf16_t*)(ws + WS_W + (size_t)l * WL_STRIDE + off); };
    Args a{}; for (int i = 0; i < 20; ++i) a.in[i] = d_in[i]; a.out = out; a.ws = ws;
    hipMemsetAsync(ws + WS_CTL, 0, CTL_ZERO_BYTES, stream);

    hipLaunchKernelGGL(k_rope_table, dim3(T * 16 / 256), dim3(256), 0, stream, pos, RT);
    hipLaunchKernelGGL(k_prep_gw, dim3(DEPTH * NGRP * CHUNK * CHUNK / 256), dim3(256), 0, stream, g_ws, GW);
    for (int l = 0; l < DEPTH; ++l) {
        hipLaunchKernelGGL(k_prep_w, dim3((NIN * DM + 255) / 256), dim3(256), 0, stream, w_in + (size_t)l * DM * DIN, DM, DIN, WL(l, WL_IN), NIN, 1);
        hipLaunchKernelGGL(k_prep_wup, dim3((NUP * KUP + 255) / 256), dim3(256), 0, stream, w_uq + (size_t)l * QR * 768, w_ukv + (size_t)l * KVR * 1024, WL(l, WL_UP));
        hipLaunchKernelGGL(k_prep_w, dim3(DM * DM / 256), dim3(256), 0, stream, w_out + (size_t)l * DM * DM, DM, DM, WL(l, WL_OUT), DM, 0);
        hipLaunchKernelGGL(k_prep_w, dim3(DFF * DM / 256), dim3(256), 0, stream, w_ff1 + (size_t)l * DM * DFF, DM, DFF, WL(l, WL_1), DFF, 0);
        hipLaunchKernelGGL(k_prep_w, dim3(DFF * DM / 256), dim3(256), 0, stream, w_ff2 + (size_t)l * DFF * DM, DFF, DM, WL(l, WL_2), DM, 0);
        hipLaunchKernelGGL(k_smallm, dim3(NMOD / 64), dim3(512), 0, stream, c, DM, 1, w_ada + (size_t)l * DM * NMOD, NMOD, NMOD, 0, b_ada + (size_t)l * NMOD, MOD + (size_t)l * NB * NMOD, NMOD, NMOD);
    }
    for (int l = 0; l < DEPTH; ++l) {
        hipLaunchKernelGGL(k_smallm, dim3(NIN / 64), dim3(512), 0, stream, MOD + (size_t)l * NB * NMOD + 0, NMOD, 0, w_in + (size_t)l * DM * DIN, DIN, DIN, 1, (const float*)nullptr, SHW1 + (size_t)l * NB * NIN, NIN, NIN);
        hipLaunchKernelGGL(k_smallm, dim3(DFF / 64), dim3(512), 0, stream, MOD + (size_t)l * NB * NMOD + 3 * DM, NMOD, 0, w_ff1 + (size_t)l * DM * DFF, DFF, DFF, 0, (const float*)nullptr, SHW2 + (size_t)l * NB * DFF, DFF, DFF);
    }
    hipLaunchKernelGGL(k_gm, dim3(DEPTH * NB * DM / 256), dim3(256), 0, stream, g_mix, MOD, 1, GM1);
    hipLaunchKernelGGL(k_gm, dim3(DEPTH * NB * DM / 256), dim3(256), 0, stream, g_ffn, MOD, 4, GM2);
    hipLaunchKernelGGL(k_modx, dim3(T / 4), dim3(256), 0, stream, x, g_mix, MOD + 1 * DM, NMOD, A, SSQ1);

    for (int l = 0; l < DEPTH; ++l) {
        const float* modl = MOD + (size_t)l * NB * NMOD; const int P = PH_L0 + l * PH_PER_LAYER;
#if MK_IN
        launch_mk(stream, a, P + 0, P + 1);
#else
        { EpiInNaive e{0, SSQ1, SHW1 + (size_t)l * NB * NIN, U, GV, ZL}; gemm_naive(stream, A, DM, WL(l, WL_IN), DM, T, NIN, DM, e); }
        hipLaunchKernelGGL(k_vn, dim3(T * NGRP / 4), dim3(256), 0, stream, GV, VN);
        hipLaunchKernelGGL(k_lat, dim3(T / 4), dim3(256), 0, stream, ZL, g_q + l * QR, g_kv + l * KVR, RT, CQKV, SSQQ, KR);
#endif
#if MK_UP
        launch_mk(stream, a, P + 1, P + 2);
#else
        { EpiUpNaive e{0, SSQQ, Q, QRT, KN, V}; gemm_naive(stream, CQKV, KUP, WL(l, WL_UP), KUP, T, NUP, KUP, e); }
        hipLaunchKernelGGL(k_rope_q, dim3(T * NH * 16 / 256), dim3(256), 0, stream, QRT, RT, Q);
#endif
#if MK_GMLP
        launch_mk(stream, a, P + 2, P + 3);
#else
        hipLaunchKernelGGL(k_gmlp_naive, dim3(T), dim3(512), 0, stream, U, VN, GW + (size_t)l * NGRP * CHUNK * CHUNK, g_bs + l * NGRP * CHUNK, g_og + l * DG, Y, SSQY);
#endif
#if MK_ATTN
        launch_mk(stream, a, P + 3, P + 4);
#else
        hipLaunchKernelGGL(k_attn_naive, dim3(T / 64, NH), dim3(64), 0, stream, Q, KN, KR, V, g_oa + l * DG, Y, SSQY);
#endif
#if MK_OUT
        launch_mk(stream, a, P + 4, P + 5);
#else
        { EpiOutNaive e{512, SSQY, l == 0 ? x : out, out, modl + 2 * DM}; gemm_naive(stream, Y, DM, WL(l, WL_OUT), DM, T, DM, DM, e); }
        hipLaunchKernelGGL(k_modx, dim3(T / 4), dim3(256), 0, stream, out, g_ffn + l * DM, modl + 4 * DM, NMOD, A, SSQ2);
#endif
#if MK_FF1
        launch_mk(stream, a, P + 5, P + 6);
#else
        { EpiFf1Naive e{0, SSQ2, SHW2 + (size_t)l * NB * DFF, H}; gemm_naive(stream, A, DM, WL(l, WL_1), DM, T, DFF, DM, e); }
#endif
#if MK_FF2
        launch_mk(stream, a, P + 6, P + 7);
#else
        { EpiFf2Naive e{0, out, modl + 5 * DM}; gemm_naive(stream, H, DFF, WL(l, WL_2), DFF, T, DM, DFF, e); }
        if (l + 1 < DEPTH) hipLaunchKernelGGL(k_modx, dim3(T / 4), dim3(256), 0, stream, out, g_mix + (l + 1) * DM, MOD + (size_t)(l + 1) * NB * NMOD + 1 * DM, NMOD, A, SSQ1);
#endif
    }
    hipLaunchKernelGGL(k_final, dim3(T / 4), dim3(256), 0, stream, out, g_fin, out);
}
```

```cpp
#include <hip/hip_runtime.h>
#include <cstdint>
#include <cstdio>
#include <cmath>

typedef unsigned short bf16_t;
typedef short bf16x8 __attribute__((ext_vector_type(8)));
typedef float f32x4 __attribute__((ext_vector_type(4)));

constexpr int DM = 1024, NB = 16, SEQ = 2048, DEPTH = 2, T = NB * SEQ;
constexpr int DG = 512, NGRP = 8, GD = 64, CHUNK = 128, NH = 8, NOPE = 64, ROPE = 32, VD = 64;
constexpr int QR = 256, KVR = 128, DFF = 4096, DIN = 1440, NMOD = 6 * DM;
constexpr int NIN = 1536;
constexpr int NUP = 1792, KUP = 384;
constexpr float EPS = 1e-6f;
constexpr float QSCALE = 0.10206207261596577f * 1.4426950408889634f;

constexpr size_t MiB = 1u << 20;
constexpr size_t WS_CTL = 0;
constexpr size_t WS_MOD = 1 * MiB;
constexpr size_t WS_SHW1 = 2 * MiB;
constexpr size_t WS_GM1 = 2 * MiB + 512 * 1024;
constexpr size_t WS_GM2 = 2 * MiB + 768 * 1024;
constexpr size_t WS_SHW2 = 3 * MiB;
constexpr size_t WS_ROPE = 4 * MiB;
constexpr size_t WS_SSQ1 = 8 * MiB;
constexpr size_t WS_SSQ2 = 10 * MiB;
constexpr size_t WS_SSQY = 12 * MiB;
constexpr size_t WS_SSQQ = 14 * MiB;
constexpr size_t WS_GW = 15 * MiB;
constexpr size_t WS_W = 16 * MiB;
constexpr size_t WL_IN = 0, WL_UP = 3 * MiB, WL_OUT = 4 * MiB + MiB / 2, WL_1 = 6 * MiB + MiB / 2, WL_2 = 14 * MiB + MiB / 2, WL_STRIDE = 22 * MiB + MiB / 2;
constexpr size_t WS_A = 64 * MiB;
constexpr size_t WS_U = 128 * MiB;
constexpr size_t WS_VN = 160 * MiB;
constexpr size_t WS_CQKV = 192 * MiB;
constexpr size_t WS_KR = 216 * MiB;
constexpr size_t WS_Q = 218 * MiB;
constexpr size_t WS_KN = 266 * MiB;
constexpr size_t WS_V = 298 * MiB;
constexpr size_t WS_Y = 330 * MiB;
constexpr size_t WS_H = 128 * MiB;
constexpr size_t WS_GV = 394 * MiB;
constexpr size_t WS_ZL = 458 * MiB;
constexpr size_t WS_QRT = 394 * MiB;
constexpr size_t WS_END = 510 * MiB;

__device__ __forceinline__ bf16_t f2bf(float f) { unsigned u = __float_as_uint(f); return (bf16_t)((u + 0x7fffu + ((u >> 16) & 1u)) >> 16); }
__device__ __forceinline__ float bf2f(bf16_t h) { return __uint_as_float(((unsigned)h) << 16); }
__device__ __forceinline__ float gelu_tanh(float x) { const float y2 = -2.302208198f * (x + 0.044715f * x * x * x); return x * __builtin_amdgcn_rcpf(1.f + __builtin_amdgcn_exp2f(y2)); }
__device__ __forceinline__ float wave_sum(float v) {
#pragma unroll
    for (int o = 1; o < 64; o <<= 1) v += __shfl_xor(v, o);
    return v;
}
__host__ __device__ __forceinline__ int win_src(int p) {
    if (p < 512) return p;
    if (p < 1024) { const int q = p - 512, tile = q >> 8, r = q & 255, bj = r >> 7, wc = (r >> 5) & 3, j = r & 31; return 512 + tile * 256 + 64 * wc + 32 * bj + j; }
    if (p < 1408) return p;
    if (p < 1440) { const int j = p - 1408, fq = j >> 3, n = (j >> 2) & 1, i = j & 3; return 1408 + 16 * n + 4 * fq + i; }
    return -1;
}
__host__ __device__ __forceinline__ int wup_qcol(int p) {
    const int G = p >> 5, h = G / 3, gi = G - 3 * h, j = p & 31;
    if (gi < 2) return p;
    const int fq = j >> 3, n = (j >> 2) & 1, i = j & 3; return h * 96 + 64 + 16 * n + 4 * fq + i;
}

__global__ void k_rope_table(const int* pos, float* rope) {
    const int idx = blockIdx.x * blockDim.x + threadIdx.x; if (idx >= T * 16) return;
    const int t = idx >> 4, i = idx & 15;
    const float freq = powf(10000.0f, -(float)(2 * i) / 32.0f);
    const float ang = (float)pos[t] * freq;
    rope[t * 32 + i] = cosf(ang); rope[t * 32 + 16 + i] = sinf(ang);
}
__global__ void k_prep_w(const float* W, int K, int N, bf16_t* out, int Nphys, int mode) {
    const size_t idx = (size_t)blockIdx.x * blockDim.x + threadIdx.x; if (idx >= (size_t)Nphys * K) return;
    const int p = (int)(idx / K), k = (int)(idx % K);
    const int s = mode == 1 ? win_src(p) : p;
    out[idx] = (s >= 0 && s < N) ? f2bf(W[(size_t)k * N + s]) : (bf16_t)0;
}
__global__ void k_prep_wup(const float* wuq, const float* wukv, bf16_t* out) {
    const int idx = blockIdx.x * blockDim.x + threadIdx.x; if (idx >= NUP * KUP) return;
    const int p = idx / KUP, k = idx % KUP; float v = 0.f;
    if (p < 768) { if (k < 256) v = wuq[(size_t)k * 768 + wup_qcol(p)]; }
    else { if (k >= 256) v = wukv[(size_t)(k - 256) * 1024 + (p - 768)]; }
    out[idx] = f2bf(v);
}
__global__ void k_prep_gw(const float* ws, bf16_t* gw) {
    const int idx = blockIdx.x * blockDim.x + threadIdx.x; if (idx >= DEPTH * NGRP * CHUNK * CHUNK) return;
    const int s = idx & 127, t = (idx >> 7) & 127;
    gw[idx] = (s <= t) ? f2bf(ws[idx]) : (bf16_t)0;
}
__global__ __launch_bounds__(512) void k_smallm(const float* in, int in_stride, int act, const float* W, int ldw, int N, int mode, const float* bias, float* out, int out_stride, int Nphys) {
    __shared__ float sin_[1024 * 16];
    __shared__ float red[8 * 64 * 16];
    const int tid = threadIdx.x, lane = tid & 63, wave = tid >> 6;
    for (int e = tid; e < 16 * 1024; e += 512) { const int b = e >> 10, k = e & 1023; float v = in[(size_t)b * in_stride + k]; if (act) v = v / (1.f + __expf(-v)); sin_[k * 16 + b] = v; }
    __syncthreads();
    const int p = blockIdx.x * 64 + lane; const int s = (p < Nphys) ? (mode == 1 ? win_src(p) : p) : -1; const bool ok = (s >= 0 && s < N);
    float acc[16];
#pragma unroll
    for (int b = 0; b < 16; ++b) acc[b] = 0.f;
    for (int k = wave * 128; k < wave * 128 + 128; ++k) {
        const float w = ok ? W[(size_t)k * ldw + s] : 0.f;
        const f32x4* sp = (const f32x4*)(sin_ + k * 16);
#pragma unroll
        for (int q = 0; q < 4; ++q) { const f32x4 v = sp[q]; acc[4 * q] += v[0] * w; acc[4 * q + 1] += v[1] * w; acc[4 * q + 2] += v[2] * w; acc[4 * q + 3] += v[3] * w; }
    }
#pragma unroll
    for (int b = 0; b < 16; ++b) red[(wave * 64 + lane) * 16 + b] = acc[b];
    __syncthreads();
    for (int e = tid; e < 64 * 16; e += 512) { const int l = e >> 4, b = e & 15; float sum = 0.f;
#pragma unroll
        for (int w = 0; w < 8; ++w) sum += red[(w * 64 + l) * 16 + b];
        const int pp = blockIdx.x * 64 + l; if (pp < Nphys) out[(size_t)b * out_stride + pp] = sum + (bias ? bias[pp] : 0.f); }
}
__global__ __launch_bounds__(256) void k_modx(const float* x, const float* g, const float* sc  , int sc_stride, bf16_t* A, float* ssq) {
    const int row = blockIdx.x * 4 + (threadIdx.x >> 6), lane = threadIdx.x & 63; if (row >= T) return;
    const int b = row / SEQ; const f32x4* xr = (const f32x4*)(x + (size_t)row * DM); float s = 0.f;
#pragma unroll
    for (int j = 0; j < 4; ++j) { const f32x4 v = xr[lane + 64 * j]; s += v[0] * v[0] + v[1] * v[1] + v[2] * v[2] + v[3] * v[3];
        const int c = 4 * (lane + 64 * j); const f32x4 gv = *(const f32x4*)(g + c), sv = *(const f32x4*)(sc + (size_t)b * sc_stride + c);
        unsigned lo = f2bf(v[0] * gv[0] * (1.f + sv[0])) | ((unsigned)f2bf(v[1] * gv[1] * (1.f + sv[1])) << 16);
        unsigned hi = f2bf(v[2] * gv[2] * (1.f + sv[2])) | ((unsigned)f2bf(v[3] * gv[3] * (1.f + sv[3])) << 16);
        *(uint2*)(A + (size_t)row * DM + c) = make_uint2(lo, hi); }
    s = wave_sum(s);
    if (lane < 16) ssq[(size_t)row * 16 + lane] = (lane == 0) ? s : 0.f;
}
__global__ __launch_bounds__(256) void k_final(const float* x, const float* g, float* out) {
    const int row = blockIdx.x * 4 + (threadIdx.x >> 6), lane = threadIdx.x & 63; if (row >= T) return;
    const f32x4* xr = (const f32x4*)(x + (size_t)row * DM); f32x4 v[4]; float s = 0.f;
#pragma unroll
    for (int j = 0; j < 4; ++j) { v[j] = xr[lane + 64 * j]; s += v[j][0] * v[j][0] + v[j][1] * v[j][1] + v[j][2] * v[j][2] + v[j][3] * v[j][3]; }
    const float rstd = rsqrtf(wave_sum(s) * (1.f / DM) + EPS);
#pragma unroll
    for (int j = 0; j < 4; ++j) { const int c = 4 * (lane + 64 * j); const f32x4 gv = *(const f32x4*)(g + c); *(f32x4*)(out + (size_t)row * DM + c) = v[j] * rstd * gv; }
}

template <class Epi>
__global__ __launch_bounds__(256) void k_gemm_naive(const bf16_t* A, int lda, const bf16_t* Bt, int ldb, int K, Epi epi) {
    const int wave = threadIdx.x >> 6, lane = threadIdx.x & 63, fr = lane & 15, fq = lane >> 4;
    const int row0 = blockIdx.y * 64 + wave * 16, col0 = blockIdx.x * 64;
    f32x4 acc[4];
#pragma unroll
    for (int n = 0; n < 4; ++n) acc[n] = (f32x4){0.f, 0.f, 0.f, 0.f};
    const bf16_t* ap = A + (size_t)(row0 + fr) * lda + 8 * fq;
    const bf16_t* bp = Bt + (size_t)(col0 + fr) * ldb + 8 * fq;
    for (int k0 = 0; k0 < K; k0 += 32) {
        if (Epi::HAS_MID) { if (k0 == epi.ksplit) {
#pragma unroll
            for (int r = 0; r < 4; ++r) { const float m = epi.mid(row0 + 4 * fq + r);
#pragma unroll
                for (int n = 0; n < 4; ++n) acc[n][r] *= m; } } }
        const bf16x8 a = *(const bf16x8*)(ap + k0);
#pragma unroll
        for (int n = 0; n < 4; ++n) { const bf16x8 b = *(const bf16x8*)(bp + (size_t)n * 16 * ldb + k0); acc[n] = __builtin_amdgcn_mfma_f32_16x16x32_bf16(a, b, acc[n], 0, 0, 0); }
    }
#pragma unroll
    for (int r = 0; r < 4; ++r) { const int row = row0 + 4 * fq + r; const float rs = epi.rowscale(row);
#pragma unroll
        for (int n = 0; n < 4; ++n) epi(row, col0 + 16 * n + fr, acc[n][r], rs); }
}
__device__ __forceinline__ float sum16(const float* p) { float s = 0.f;
#pragma unroll
    for (int i = 0; i < 16; ++i) s += p[i]; return s; }
__device__ __forceinline__ float sum8(const float* p) { float s = 0.f;
#pragma unroll
    for (int i = 0; i < 8; ++i) s += p[i]; return s; }
__device__ __forceinline__ float sum4(const float* p) { return (p[0] + p[1]) + (p[2] + p[3]); }

struct EpiInNaive {
    static constexpr bool HAS_MID = false; int ksplit;
    const float* ssq1; const float* shw1; bf16_t* U; float* GV; float* ZL;
    __device__ float mid(int) const { return 1.f; }
    __device__ float rowscale(int row) const { return rsqrtf(sum16(ssq1 + (size_t)row * 16) * (1.f / DM) + EPS); }
    __device__ void operator()(int row, int p, float acc, float rs) const {
        const int L = win_src(p); if (L < 0) return;
        const float z = rs * acc + shw1[(row / SEQ) * NIN + p];
        if (L < 512) U[(size_t)row * 512 + L] = f2bf(gelu_tanh(z));
        else if (L < 1024) GV[(size_t)row * 512 + (L - 512)] = gelu_tanh(z);
        else ZL[(size_t)row * 416 + (L - 1024)] = z;
    }
};
struct EpiUpNaive {
    static constexpr bool HAS_MID = false; int ksplit;
    const float* ssqq; bf16_t* Q; float* QRT; bf16_t* KN; bf16_t* V;
    __device__ float mid(int) const { return 1.f; }
    __device__ float rowscale(int) const { return 1.f; }
    __device__ void operator()(int row, int p, float acc, float) const {
        if (p < 768) { const float rq = rsqrtf(sum4(ssqq + (size_t)row * 8) * (1.f / QR) + EPS); const float v = acc * rq * QSCALE;
            const int L = wup_qcol(p), h = L / 96, d = L - 96 * h;
            if (d < 64) Q[(size_t)row * 768 + L] = f2bf(v); else QRT[(size_t)row * 256 + h * 32 + (d - 64)] = v; }
        else { const float rk = rsqrtf(sum4(ssqq + (size_t)row * 8 + 4) * (1.f / KVR) + EPS); const float v = acc * rk;
            const int c = p - 768, h = c >> 7, d = c & 127;
            if (d < 64) KN[(size_t)row * 512 + h * 64 + d] = f2bf(v); else V[(size_t)row * 512 + h * 64 + (d - 64)] = f2bf(v); }
    }
};
struct EpiOutNaive {
    static constexpr bool HAS_MID = true; int ksplit;
    const float* ssqy; const float* xin; float* xout; const float* gate;
    __device__ float rg(int row) const { return rsqrtf(sum8(ssqy + (size_t)row * 16) * (1.f / 512) + EPS); }
    __device__ float ra(int row) const { return rsqrtf(sum8(ssqy + (size_t)row * 16 + 8) * (1.f / 512) + EPS); }
    __device__ float mid(int row) const { return rg(row) / ra(row); }
    __device__ float rowscale(int row) const { return ra(row); }
    __device__ void operator()(int row, int n, float acc, float rs) const {
        const size_t i = (size_t)row * DM + n; xout[i] = xin[i] + gate[(size_t)(row / SEQ) * NMOD + n] * (rs * acc);
    }
};
struct EpiFf1Naive {
    static constexpr bool HAS_MID = false; int ksplit;
    const float* ssq2; const float* shw2; bf16_t* H;
    __device__ float mid(int) const { return 1.f; }
    __device__ float rowscale(int row) const { return rsqrtf(sum16(ssq2 + (size_t)row * 16) * (1.f / DM) + EPS); }
    __device__ void operator()(int row, int n, float acc, float rs) const {
        const float z = rs * acc + shw2[(row / SEQ) * DFF + n]; const float r = fmaxf(z, 0.f); H[(size_t)row * DFF + n] = f2bf(r * r);
    }
};
struct EpiFf2Naive {
    static constexpr bool HAS_MID = false; int ksplit;
    float* x; const float* gate;
    __device__ float mid(int) const { return 1.f; }
    __device__ float rowscale(int) const { return 1.f; }
    __device__ void operator()(int row, int n, float acc, float) const {
        const size_t i = (size_t)row * DM + n; x[i] = x[i] + gate[(size_t)(row / SEQ) * NMOD + n] * acc;
    }
};

__global__ __launch_bounds__(256) void k_vn(const float* GV, bf16_t* VN) {
    const int w = blockIdx.x * 4 + (threadIdx.x >> 6), lane = threadIdx.x & 63; if (w >= T * NGRP) return;
    const int row = w >> 3, g = w & 7; const float v = GV[(size_t)row * 512 + g * 64 + lane];
    const float mu = wave_sum(v) * (1.f / 64); const float d = v - mu; const float var = wave_sum(d * d) * (1.f / 64);
    VN[(size_t)row * 512 + g * 64 + lane] = f2bf(d * rsqrtf(var + EPS));
}
__global__ __launch_bounds__(256) void k_lat(const float* ZL, const float* gq, const float* gkv, const float* rope, bf16_t* CQKV, float* ssqq, bf16_t* KR) {
    const int row = blockIdx.x * 4 + (threadIdx.x >> 6), lane = threadIdx.x & 63; if (row >= T) return;
    const float* z = ZL + (size_t)row * 416; float sq = 0.f, sk = 0.f;
#pragma unroll
    for (int j = 0; j < 4; ++j) { const int c = lane + 64 * j; const float v = z[c]; sq += v * v; CQKV[(size_t)row * KUP + c] = f2bf(v * gq[c]); }
#pragma unroll
    for (int j = 0; j < 2; ++j) { const int c = lane + 64 * j; const float v = z[256 + c]; sk += v * v; CQKV[(size_t)row * KUP + 256 + c] = f2bf(v * gkv[c]); }
    sq = wave_sum(sq); sk = wave_sum(sk);
    if (lane < 8) ssqq[(size_t)row * 8 + lane] = (lane == 0) ? sq : (lane == 4) ? sk : 0.f;
    if (lane < 16) { const float x1 = z[384 + lane], x2 = z[384 + 16 + lane], c = rope[(size_t)row * 32 + lane], s = rope[(size_t)row * 32 + 16 + lane];
        KR[(size_t)row * 32 + lane] = f2bf(x1 * c - x2 * s); KR[(size_t)row * 32 + 16 + lane] = f2bf(x1 * s + x2 * c); }
}
__global__ void k_rope_q(const float* QRT, const float* rope, bf16_t* Q) {
    const int idx = blockIdx.x * blockDim.x + threadIdx.x; if (idx >= T * NH * 16) return;
    const int r = idx & 15, h = (idx >> 4) & 7, row = idx >> 7;
    const float x1 = QRT[(size_t)row * 256 + h * 32 + r], x2 = QRT[(size_t)row * 256 + h * 32 + 16 + r], c = rope[(size_t)row * 32 + r], s = rope[(size_t)row * 32 + 16 + r];
    Q[(size_t)row * 768 + h * 96 + 64 + r] = f2bf(x1 * c - x2 * s); Q[(size_t)row * 768 + h * 96 + 80 + r] = f2bf(x1 * s + x2 * c);
}
__global__ __launch_bounds__(512) void k_gmlp_naive(const bf16_t* U, const bf16_t* VN, const bf16_t* GW  , const float* bs  , const float* gog, bf16_t* Y, float* ssqy) {
    const int row = blockIdx.x, g = threadIdx.x >> 6, d = threadIdx.x & 63, c = g * 64 + d;
    const int tt = row & 127, t0 = row - tt;
    const bf16_t* w = GW + ((size_t)g * CHUNK + tt) * CHUNK; float sum = 0.f;
    for (int s = 0; s <= tt; ++s) sum += bf2f(w[s]) * bf2f(VN[(size_t)(t0 + s) * 512 + c]);
    const float y = bf2f(U[(size_t)row * 512 + c]) * (sum + bs[g * CHUNK + tt]);
    Y[(size_t)row * DM + c] = f2bf(y * gog[c]);
    const float q = wave_sum(y * y); if (d == 0) ssqy[(size_t)row * 16 + g] = q;
}
__global__ __launch_bounds__(64) void k_attn_naive(const bf16_t* Q, const bf16_t* KN, const bf16_t* KR, const bf16_t* V, const float* goa, bf16_t* Y, float* ssqy) {
    const int h = blockIdx.y, row = blockIdx.x * 64 + threadIdx.x, b = row / SEQ, i = row - b * SEQ;
    const int iend = (blockIdx.x * 64 % SEQ) + 63;
    float q[96];
#pragma unroll
    for (int d8 = 0; d8 < 12; ++d8) { const bf16x8 v = *(const bf16x8*)(Q + (size_t)row * 768 + h * 96 + d8 * 8);
#pragma unroll
        for (int j = 0; j < 8; ++j) q[d8 * 8 + j] = bf2f((bf16_t)v[j]); }
    float o[64];
#pragma unroll
    for (int d = 0; d < 64; ++d) o[d] = 0.f;
    float m = -1e30f, l = 0.f;
    const size_t kb = (size_t)b * SEQ;
    for (int j = 0; j <= iend; ++j) {
        const bf16_t* kn = KN + (kb + j) * 512 + h * 64; const bf16_t* kr = KR + (kb + j) * 32; const bf16_t* vv = V + (kb + j) * 512 + h * 64;
        float s = 0.f;
#pragma unroll
        for (int d8 = 0; d8 < 8; ++d8) { const bf16x8 kv = *(const bf16x8*)(kn + d8 * 8);
#pragma unroll
            for (int jj = 0; jj < 8; ++jj) s += q[d8 * 8 + jj] * bf2f((bf16_t)kv[jj]); }
#pragma unroll
        for (int d8 = 0; d8 < 4; ++d8) { const bf16x8 kv = *(const bf16x8*)(kr + d8 * 8);
#pragma unroll
            for (int jj = 0; jj < 8; ++jj) s += q[64 + d8 * 8 + jj] * bf2f((bf16_t)kv[jj]); }
        if (j > i) s = -1e30f;
        const float mn = fmaxf(m, s), alpha = exp2f(m - mn), p = (j > i) ? 0.f : exp2f(s - mn);
        l = l * alpha + p; m = mn;
#pragma unroll
        for (int d8 = 0; d8 < 8; ++d8) { const bf16x8 v8 = *(const bf16x8*)(vv + d8 * 8);
#pragma unroll
            for (int jj = 0; jj < 8; ++jj) o[d8 * 8 + jj] = o[d8 * 8 + jj] * alpha + p * bf2f((bf16_t)v8[jj]); }
    }
    const float inv = 1.f / l; float sq = 0.f;
#pragma unroll
    for (int d8 = 0; d8 < 8; ++d8) { unsigned w[4];
#pragma unroll
        for (int jj = 0; jj < 8; jj += 2) { const float y0 = o[d8 * 8 + jj] * inv, y1 = o[d8 * 8 + jj + 1] * inv; sq += y0 * y0 + y1 * y1;
            w[jj >> 1] = f2bf(y0 * goa[h * 64 + d8 * 8 + jj]) | ((unsigned)f2bf(y1 * goa[h * 64 + d8 * 8 + jj + 1]) << 16); }
        *(uint4*)(Y + (size_t)row * DM + 512 + h * 64 + d8 * 8) = make_uint4(w[0], w[1], w[2], w[3]); }
    ssqy[(size_t)row * 16 + 8 + h] = sq;
}

__global__ void k_gm(const float* g  , const float* mod, int chunk, float* gmt) {
    const int idx = blockIdx.x * blockDim.x + threadIdx.x; if (idx >= DEPTH * NB * DM) return;
    const int c = idx & 1023, b = (idx >> 10) & 15, l = idx >> 14;
    gmt[idx] = g[l * DM + c] * (1.f + mod[((size_t)l * NB + b) * NMOD + chunk * DM + c]);
}
__device__ __forceinline__ int lane_id() { int l; asm volatile("v_mbcnt_lo_u32_b32 %0, -1, 0\n\tv_mbcnt_hi_u32_b32 %0, -1, %0" : "=v"(l)); return l; }
__device__ __forceinline__ float swz_xor16(float v) { return __int_as_float(__builtin_amdgcn_ds_swizzle(__float_as_int(v), 0x401F)); }
__device__ __forceinline__ float swz_xor1(float v) { return __int_as_float(__builtin_amdgcn_ds_swizzle(__float_as_int(v), 0x041F)); }
namespace pg8 {
#define PG8_LAS __attribute__((address_space(3)))
typedef unsigned u32x4 __attribute__((ext_vector_type(4)));
typedef unsigned u32x2 __attribute__((ext_vector_type(2)));
constexpr int BM = 256, BK = 64, HALF = 128, HTB = HALF * BK * 2  , STAGE_BYTES = 8 * HTB, NXCD = 8, WGM = 8;

__host__ __device__ __forceinline__ int lds_byte(int r, int c) { const int st = (r >> 4) * 2 + (c >> 5), rr = r & 15, cc = c & 31, ob = rr * 64 + cc * 2; return st * 1024 + (ob ^ (((ob >> 9) & 1) << 5)); }
__host__ __device__ __forceinline__ void stage_rc(int b, int& R, int& C) { const int st = b / 1024, sb = b % 1024, swz = sb ^ (((sb >> 9) & 1) << 5); R = (st >> 1) * 16 + swz / 64; C = (st & 1) * 32 + (swz % 64) / 2; }
__host__ __device__ __forceinline__ int perm32(int rho) { const int n = rho >> 4, i = rho & 15; return 8 * (i >> 2) + 4 * n + (i & 3); }

struct Unit { int pm, pn; };
struct Gemm { const bf16_t* A; const bf16_t* Bt; int M, N, K; };

struct StaticOrder {
    int nM, nN, nwg, G, c;
    __host__ __device__ void init(int M, int N, int G_, int c_) { nM = M / BM; nN = N / BM; nwg = nM * nN; G = G_; c = c_; }
    __host__ __device__ bool next(int i, Unit& u) const {
        const long L = (long)i * G + c; if (L >= nwg) return false;
        int wgid = (int)L; { const int q = nwg / NXCD, r = nwg % NXCD, xcd = wgid % NXCD, off = wgid / NXCD; wgid = (xcd < r ? xcd * (q + 1) : r * (q + 1) + (xcd - r) * q) + off; }
        const int nig = WGM * nN, gid = wgid / nig, fm = gid * WGM, gsz = (nM - fm) < WGM ? (nM - fm) : WGM;
        u.pm = fm + ((wgid % nig) % gsz); u.pn = (wgid % nig) / gsz; return true;
    }
    __device__ __forceinline__ void a_ready(const Unit&) const {}
    __device__ __forceinline__ void done(const Unit&) const {}
};

__device__ __forceinline__ unsigned cvt_pk_bf16(float lo, float hi) { unsigned r; asm volatile("v_cvt_pk_bf16_f32 %0, %1, %2" : "=v"(r) : "v"(lo), "v"(hi)); return r; }
__device__ __forceinline__ u32x4 pack8(const f32x4& a, const f32x4& b) { u32x4 w; w.x = cvt_pk_bf16(a[0], a[1]); w.y = cvt_pk_bf16(a[2], a[3]); w.z = cvt_pk_bf16(b[0], b[1]); w.w = cvt_pk_bf16(b[2], b[3]); return w; }
__device__ __forceinline__ u32x2 pack4(const f32x4& a) { u32x2 w; w.x = cvt_pk_bf16(a[0], a[1]); w.y = cvt_pk_bf16(a[2], a[3]); return w; }
__device__ __forceinline__ float hsum4(const f32x4& a) { return (a[0] + a[1]) + (a[2] + a[3]); }
__device__ __forceinline__ float hsq4(const f32x4& a) { return (a[0] * a[0] + a[1] * a[1]) + (a[2] * a[2] + a[3] * a[3]); }
__device__ __forceinline__ float ld_sum16(const float* p) { const f32x4* q = (const f32x4*)p; return (hsum4(q[0]) + hsum4(q[1])) + (hsum4(q[2]) + hsum4(q[3])); }
__device__ __forceinline__ float ld_sum8(const float* p) { const f32x4* q = (const f32x4*)p; return hsum4(q[0]) + hsum4(q[1]); }
__device__ __forceinline__ float ld_sum4(const float* p) { return hsum4(*(const f32x4*)p); }
__device__ __forceinline__ float quad_sum(float s) { s += swz_xor16(s); auto rr = __builtin_amdgcn_permlane32_swap(__float_as_uint(s), __float_as_uint(s), false, false); return __uint_as_float(rr[0]) + __uint_as_float(rr[1]); }
__device__ __forceinline__ float row_sum16(const float* ssq, int row, int fq) { return quad_sum(hsum4(*(const f32x4*)(ssq + (size_t)row * 16 + 4 * fq))); }
__device__ __forceinline__ void row_sum8x2(const float* ssq, int row, int fq, float& sg, float& sa) {
    float s = hsum4(*(const f32x4*)(ssq + (size_t)row * 16 + 4 * fq)); s += swz_xor16(s);
    auto rr = __builtin_amdgcn_permlane32_swap(__float_as_uint(s), __float_as_uint(s), false, false); sg = __uint_as_float(rr[0]); sa = __uint_as_float(rr[1]); }
#define PG8_FENCE() asm volatile("" ::: "memory")
__device__ __forceinline__ f32x4 gelu4(const f32x4& v) { f32x4 o; o[0] = gelu_tanh(v[0]); o[1] = gelu_tanh(v[1]); o[2] = gelu_tanh(v[2]); o[3] = gelu_tanh(v[3]); return o; }

#define PG8_ROW(u, ai, m) ((u).pm * BM + (ai) * HALF + wr * 64 + (m) * 16 + fr)

struct EpiIn {
    static constexpr bool PERM = true, AFTER_DRAIN = false, HAS_MID = false; static constexpr int MID_T = -1;
    const float* ssq1; const float* shw1; const float* gq; const float* gkv; const float* rope;
    bf16_t* U; bf16_t* VN; bf16_t* CQKV; bf16_t* KR; float* ssqq;
    __device__ __forceinline__ void mid(f32x4 (&)[2][2][4][2], const Unit&, int, int) const {}
    __device__ __forceinline__ void operator()(const f32x4 (&acc)[2][2][4][2], const Unit& u, int wr, int wc, int fr, int fq) const {
        asm volatile("" : "+v"(fr), "+v"(fq));
        const int b = u.pm >> 3, pc0 = u.pn * BM + wc * 32 + 8 * fq;
        f32x4 sh[2][2];
#pragma unroll
        for (int bj = 0; bj < 2; ++bj)
#pragma unroll
            for (int n = 0; n < 2; ++n) sh[bj][n] = *(const f32x4*)(shw1 + (size_t)b * NIN + pc0 + bj * HALF + 4 * n);
        if (u.pn < 2) {
#pragma unroll
            for (int ai = 0; ai < 2; ++ai)
#pragma unroll
                for (int m = 0; m < 4; ++m) { PG8_FENCE(); const int row = PG8_ROW(u, ai, m); const float rs = rsqrtf(row_sum16(ssq1, row, fq) * (1.f / DM) + EPS);
#pragma unroll
                    for (int bj = 0; bj < 2; ++bj) { const f32x4 v0 = gelu4(acc[ai][bj][m][0] * rs + sh[bj][0]), v1 = gelu4(acc[ai][bj][m][1] * rs + sh[bj][1]);
                        *(u32x4*)(U + (size_t)row * 512 + pc0 + bj * HALF) = pack8(v0, v1); } }
        } else if (u.pn < 4) {
#pragma unroll
            for (int ai = 0; ai < 2; ++ai)
#pragma unroll
                for (int m = 0; m < 4; ++m) { PG8_FENCE(); const int row = PG8_ROW(u, ai, m); const float rs = rsqrtf(row_sum16(ssq1, row, fq) * (1.f / DM) + EPS);
                    f32x4 g[2][2]; float s = 0.f;
#pragma unroll
                    for (int bj = 0; bj < 2; ++bj)
#pragma unroll
                        for (int n = 0; n < 2; ++n) { g[bj][n] = gelu4(acc[ai][bj][m][n] * rs + sh[bj][n]); s += hsum4(g[bj][n]); }
                    const float mu = quad_sum(s) * (1.f / 64); float q = 0.f;
#pragma unroll
                    for (int bj = 0; bj < 2; ++bj)
#pragma unroll
                        for (int n = 0; n < 2; ++n) { g[bj][n] = g[bj][n] - mu; q += hsq4(g[bj][n]); }
                    const float rstd = rsqrtf(quad_sum(q) * (1.f / 64) + EPS);
#pragma unroll
                    for (int bj = 0; bj < 2; ++bj) *(u32x4*)(VN + (size_t)row * 512 + (u.pn - 2) * 256 + 64 * wc + 32 * bj + 8 * fq) = pack8(g[bj][0] * rstd, g[bj][1] * rstd); }
        } else if (u.pn == 4) {
            f32x4 gv[2][2];
#pragma unroll
            for (int bj = 0; bj < 2; ++bj)
#pragma unroll
                for (int n = 0; n < 2; ++n) gv[bj][n] = *(const f32x4*)(gq + bj * HALF + wc * 32 + 8 * fq + 4 * n);
#pragma unroll
            for (int ai = 0; ai < 2; ++ai)
#pragma unroll
                for (int m = 0; m < 4; ++m) { PG8_FENCE(); const int row = PG8_ROW(u, ai, m); const float rs = rsqrtf(row_sum16(ssq1, row, fq) * (1.f / DM) + EPS);
                    float ss = 0.f;
#pragma unroll
                    for (int bj = 0; bj < 2; ++bj) { const f32x4 v0 = acc[ai][bj][m][0] * rs + sh[bj][0], v1 = acc[ai][bj][m][1] * rs + sh[bj][1]; ss += hsq4(v0) + hsq4(v1);
                        *(u32x4*)(CQKV + (size_t)row * KUP + bj * HALF + wc * 32 + 8 * fq) = pack8(v0 * gv[bj][0], v1 * gv[bj][1]); }
                    ss = quad_sum(ss); if (fq == 0) ssqq[(size_t)row * 8 + wc] = ss; }
        } else {
            const f32x4 gk0 = *(const f32x4*)(gkv + wc * 32 + 8 * fq), gk1 = *(const f32x4*)(gkv + wc * 32 + 8 * fq + 4);
#pragma unroll
            for (int ai = 0; ai < 2; ++ai)
#pragma unroll
                for (int m = 0; m < 4; ++m) { PG8_FENCE(); const int row = PG8_ROW(u, ai, m); const float rs = rsqrtf(row_sum16(ssq1, row, fq) * (1.f / DM) + EPS);
                    const f32x4 v0 = acc[ai][0][m][0] * rs + sh[0][0], v1 = acc[ai][0][m][1] * rs + sh[0][1];
                    float ss = quad_sum(hsq4(v0) + hsq4(v1)); if (fq == 0) ssqq[(size_t)row * 8 + 4 + wc] = ss;
                    *(u32x4*)(CQKV + (size_t)row * KUP + 256 + wc * 32 + 8 * fq) = pack8(v0 * gk0, v1 * gk1);
                    if (wc == 0) { const f32x4 x1 = acc[ai][1][m][0] * rs + sh[1][0], x2 = acc[ai][1][m][1] * rs + sh[1][1];
                        const f32x4 c = *(const f32x4*)(rope + (size_t)row * 32 + 4 * fq), s = *(const f32x4*)(rope + (size_t)row * 32 + 16 + 4 * fq);
                        *(u32x2*)(KR + (size_t)row * 32 + 4 * fq) = pack4(x1 * c - x2 * s); *(u32x2*)(KR + (size_t)row * 32 + 16 + 4 * fq) = pack4(x1 * s + x2 * c); } }
        }
    }
};
struct EpiUp {
    static constexpr bool PERM = true, AFTER_DRAIN = false, HAS_MID = false; static constexpr int MID_T = -1;
    const float* ssqq; const float* rope; bf16_t* Q; bf16_t* KN; bf16_t* V;
    __device__ __forceinline__ void mid(f32x4 (&)[2][2][4][2], const Unit&, int, int) const {}
    __device__ __forceinline__ void operator()(const f32x4 (&acc)[2][2][4][2], const Unit& u, int wr, int wc, int fr, int fq) const {
        asm volatile("" : "+v"(fr), "+v"(fq));
        if (u.pn < 3) {
#pragma unroll
            for (int ai = 0; ai < 2; ++ai)
#pragma unroll
                for (int m = 0; m < 4; ++m) { PG8_FENCE(); const int row = PG8_ROW(u, ai, m); const float rq = rsqrtf(ld_sum4(ssqq + (size_t)row * 8) * (1.f / QR) + EPS) * QSCALE;
#pragma unroll
                    for (int bj = 0; bj < 2; ++bj) { const int G = 8 * u.pn + 4 * bj + wc, h = G / 3, gi = G - 3 * h;
                        const f32x4 v0 = acc[ai][bj][m][0] * rq, v1 = acc[ai][bj][m][1] * rq;
                        if (gi < 2) *(u32x4*)(Q + (size_t)row * 768 + 32 * G + 8 * fq) = pack8(v0, v1);
                        else { const f32x4 c = *(const f32x4*)(rope + (size_t)row * 32 + 4 * fq), s = *(const f32x4*)(rope + (size_t)row * 32 + 16 + 4 * fq);
                            *(u32x2*)(Q + (size_t)row * 768 + 96 * h + 64 + 4 * fq) = pack4(v0 * c - v1 * s); *(u32x2*)(Q + (size_t)row * 768 + 96 * h + 80 + 4 * fq) = pack4(v0 * s + v1 * c); } } }
        } else {
#pragma unroll
            for (int ai = 0; ai < 2; ++ai)
#pragma unroll
                for (int m = 0; m < 4; ++m) { PG8_FENCE(); const int row = PG8_ROW(u, ai, m); const float rk = rsqrtf(ld_sum4(ssqq + (size_t)row * 8 + 4) * (1.f / KVR) + EPS);
#pragma unroll
                    for (int bj = 0; bj < 2; ++bj) { const int h = 2 * (u.pn - 3) + bj;
                        bf16_t* dst = (wc < 2) ? KN + (size_t)row * 512 + 64 * h + 32 * wc + 8 * fq : V + (size_t)row * 512 + 64 * h + 32 * (wc - 2) + 8 * fq;
                        *(u32x4*)dst = pack8(acc[ai][bj][m][0] * rk, acc[ai][bj][m][1] * rk); } }
        }
    }
};
template <bool MIDS> struct EpiRes {
    static constexpr bool PERM = true, AFTER_DRAIN = false, HAS_MID = MIDS; static constexpr int MID_T = 8;
    const float* ssqy; const float* xin; float* xout; const float* gate  ; const float* gm  ; bf16_t* A; float* ssqo;
    __device__ __forceinline__ void mid(f32x4 (&acc)[2][2][4][2], const Unit& u, int wr, int fr) const {
        int fq = lane_id() >> 4; asm volatile("" : "+v"(fr), "+v"(fq));
#pragma unroll
        for (int ai = 0; ai < 2; ++ai)
#pragma unroll
            for (int m = 0; m < 4; ++m) { float sg, sa; row_sum8x2(ssqy, PG8_ROW(u, ai, m), fq, sg, sa);
                const float ratio = sqrtf((sa * (1.f / 512) + EPS) / (sg * (1.f / 512) + EPS));
#pragma unroll
                for (int bj = 0; bj < 2; ++bj)
#pragma unroll
                    for (int n = 0; n < 2; ++n) acc[ai][bj][m][n] = acc[ai][bj][m][n] * ratio;
                if (m & 1) PG8_FENCE(); }
    }
    __device__ __forceinline__ void operator()(const f32x4 (&acc)[2][2][4][2], const Unit& u, int wr, int wc, int fr, int fq) const {
        asm volatile("" : "+v"(fr), "+v"(fq));
        const int b = u.pm >> 3, c0 = u.pn * BM + wc * 32 + 8 * fq;
        float rs[2][4], ss[2][4];
#pragma unroll
        for (int ai = 0; ai < 2; ++ai)
#pragma unroll
            for (int m = 0; m < 4; ++m) { ss[ai][m] = 0.f; rs[ai][m] = 1.f;
                if (MIDS) { float sg, sa; row_sum8x2(ssqy, PG8_ROW(u, ai, m), fq, sg, sa); rs[ai][m] = rsqrtf(sa * (1.f / 512) + EPS); if (m & 1) PG8_FENCE(); } }
#pragma unroll
        for (int bj = 0; bj < 2; ++bj) { const int cb = c0 + bj * HALF;
            const f32x4 g0 = *(const f32x4*)(gate + (size_t)b * NMOD + cb), g1 = *(const f32x4*)(gate + (size_t)b * NMOD + cb + 4);
            f32x4 m0 = (f32x4){0.f, 0.f, 0.f, 0.f}, m1 = m0; if (gm) { m0 = *(const f32x4*)(gm + (size_t)b * DM + cb); m1 = *(const f32x4*)(gm + (size_t)b * DM + cb + 4); }
#pragma unroll
            for (int ai = 0; ai < 2; ++ai)
#pragma unroll
                for (int m = 0; m < 4; ++m) { PG8_FENCE(); const size_t off = (size_t)PG8_ROW(u, ai, m) * DM + cb;
                    const f32x4 x0 = *(const f32x4*)(xin + off) + g0 * (acc[ai][bj][m][0] * rs[ai][m]), x1 = *(const f32x4*)(xin + off + 4) + g1 * (acc[ai][bj][m][1] * rs[ai][m]);
                    *(f32x4*)(xout + off) = x0; *(f32x4*)(xout + off + 4) = x1;
                    if (gm) { ss[ai][m] += hsq4(x0) + hsq4(x1); *(u32x4*)(A + off) = pack8(x0 * m0, x1 * m1); } } }
        if (gm) {
#pragma unroll
            for (int ai = 0; ai < 2; ++ai)
#pragma unroll
                for (int m = 0; m < 4; ++m) { const float s = quad_sum(ss[ai][m]); if (fq == 0) ssqo[(size_t)PG8_ROW(u, ai, m) * 16 + u.pn * 4 + wc] = s; } }
    }
};
struct EpiFf1 {
    static constexpr bool PERM = true, AFTER_DRAIN = false, HAS_MID = false; static constexpr int MID_T = -1;
    const float* ssq2; const float* shw2; bf16_t* H;
    __device__ __forceinline__ void mid(f32x4 (&)[2][2][4][2], const Unit&, int, int) const {}
    __device__ __forceinline__ void operator()(const f32x4 (&acc)[2][2][4][2], const Unit& u, int wr, int wc, int fr, int fq) const {
        asm volatile("" : "+v"(fr), "+v"(fq));
        const int b = u.pm >> 3, c0 = u.pn * BM + wc * 32 + 8 * fq;
        f32x4 sh[2][2];
#pragma unroll
        for (int bj = 0; bj < 2; ++bj)
#pragma unroll
            for (int n = 0; n < 2; ++n) sh[bj][n] = *(const f32x4*)(shw2 + (size_t)b * DFF + c0 + bj * HALF + 4 * n);
        float rsv[2][4];
#pragma unroll
        for (int ai = 0; ai < 2; ++ai) {
#pragma unroll
            for (int m = 0; m < 4; ++m) rsv[ai][m] = rsqrtf(row_sum16(ssq2, PG8_ROW(u, ai, m), fq) * (1.f / DM) + EPS);
            PG8_FENCE(); }
#pragma unroll
        for (int ai = 0; ai < 2; ++ai)
#pragma unroll
            for (int m = 0; m < 4; ++m) { const int row = PG8_ROW(u, ai, m); const float rs = rsv[ai][m]; PG8_FENCE();
#pragma unroll
                for (int bj = 0; bj < 2; ++bj) { f32x4 v0 = acc[ai][bj][m][0] * rs + sh[bj][0], v1 = acc[ai][bj][m][1] * rs + sh[bj][1];
#pragma unroll
                    for (int i = 0; i < 4; ++i) { const float a = fmaxf(v0[i], 0.f), c = fmaxf(v1[i], 0.f); v0[i] = a * a; v1[i] = c * c; }
                    *(u32x4*)(H + (size_t)row * DFF + c0 + bj * HALF) = pack8(v0, v1); } }
    }
};

template <class Epi, class Sched, bool ALIGN_EPI = false, bool SP2 = false>
__device__ __forceinline__ void gemm_phase(PG8_LAS unsigned char* lds, const Gemm g, const Sched& S, const Epi& E, int wid0) {
    int tid_ = wid0 * 64 + lane_id(); asm volatile("" : "+v"(tid_));
    const int tid = tid_, wid = __builtin_amdgcn_readfirstlane(tid >> 6), lane = tid & 63, wr = wid >> 2, wc = wid & 3, fr = lane & 15, fq = lane >> 4;
    const int K = g.K, nt = K / BK;
    unsigned voffA[2], voffB[2];
#pragma unroll
    for (int i = 0; i < 2; ++i) { int R, C; stage_rc(tid * 16 + i * 8192, R, C); const int Rb = Epi::PERM ? ((R & ~31) + perm32(R & 31)) : R;
        voffA[i] = (unsigned)(R * K + C) * 2u; voffB[i] = (unsigned)(Rb * K + C) * 2u; }
    const size_t kstep = (size_t)(BK * 2);
    const size_t hstep = (size_t)HALF * K * 2;
    const size_t tstep = 2 * hstep;
    const unsigned ldsw = (unsigned)wid * 1024u;
    const int aoff = lds_byte(wr * 64 + fr, fq * 8), boff = lds_byte(wc * 32 + fr, fq * 8);
#define PG8_SA(b, h) (((b) * 2 + (h)) * HTB)
#define PG8_SB(b, h) ((4 + (b) * 2 + (h)) * HTB)
#define PG8_STAGE(bufoff, gbase, voff) do { _Pragma("unroll") for (int _i = 0; _i < 2; ++_i) \
        __builtin_amdgcn_global_load_lds((const unsigned*)((const char*)(gbase) + (voff)[_i]), (PG8_LAS unsigned*)(lds + (bufoff) + ldsw + _i * 8192), 16, 0, 0); } while (0)
#define PG8_LDA(dst, b, h) do { _Pragma("unroll") for (int m = 0; m < 4; ++m) _Pragma("unroll") for (int k = 0; k < 2; ++k) dst[m][k] = *(const PG8_LAS bf16x8*)(lds + PG8_SA(b, h) + aoff + m * 2048 + k * 1024); } while (0)
#define PG8_LDB(dst, b, h) do { _Pragma("unroll") for (int n = 0; n < 2; ++n) _Pragma("unroll") for (int k = 0; k < 2; ++k) dst[n][k] = *(const PG8_LAS bf16x8*)(lds + PG8_SB(b, h) + boff + n * 2048 + k * 1024); } while (0)
#define PG8_MMA(ai, bj, At, Bt) do { __builtin_amdgcn_s_setprio(1); _Pragma("unroll") for (int m = 0; m < 4; ++m) _Pragma("unroll") for (int n = 0; n < 2; ++n) _Pragma("unroll") for (int k = 0; k < 2; ++k) \
        acc[ai][bj][m][n] = __builtin_amdgcn_mfma_f32_16x16x32_bf16(Bt[n][k], At[m][k], acc[ai][bj][m][n], 0, 0, 0); __builtin_amdgcn_s_setprio(0); } while (0)
#define PG8_WAIT_V(n) asm volatile("s_waitcnt vmcnt(" #n ")" ::: "memory")
#define PG8_WAIT_L(n) asm volatile("s_waitcnt lgkmcnt(" #n ")" ::: "memory")
#define PG8_BAR __builtin_amdgcn_s_barrier()
#define PG8_SCHED __builtin_amdgcn_sched_barrier(0)
    Unit cur, nxt; int ui = 0;
    if (!S.next(0, cur)) return;
    f32x4 acc[2][2][4][2];
#pragma unroll
    for (int a = 0; a < 2; ++a)
#pragma unroll
        for (int b = 0; b < 2; ++b)
#pragma unroll
            for (int m = 0; m < 4; ++m)
#pragma unroll
                for (int n = 0; n < 2; ++n) acc[a][b][m][n] = (f32x4){0.f, 0.f, 0.f, 0.f};
    bf16x8 At[4][2], B0[2][2], B1[2][2];
    const char* cA = (const char*)g.A + (size_t)cur.pm * tstep; const char* cB = (const char*)g.Bt + (size_t)cur.pn * tstep;
    S.a_ready(cur);
    if constexpr (SP2) {
        PG8_STAGE(PG8_SB(0, 0), cB, voffB); PG8_STAGE(PG8_SB(0, 1), cB + hstep, voffB); PG8_STAGE(PG8_SA(0, 0), cA, voffA); PG8_STAGE(PG8_SA(0, 1), cA + hstep, voffA);
        if (wr == 1) PG8_BAR;
        PG8_WAIT_V(2); PG8_BAR;
        PG8_STAGE(PG8_SB(1, 0), cB + kstep, voffB); PG8_STAGE(PG8_SA(1, 0), cA + kstep, voffA); PG8_STAGE(PG8_SB(1, 1), cB + hstep + kstep, voffB);
        PG8_WAIT_V(6); PG8_BAR;
    } else {
        PG8_STAGE(PG8_SB(0, 0), cB, voffB); PG8_STAGE(PG8_SA(0, 0), cA, voffA); PG8_STAGE(PG8_SB(0, 1), cB + hstep, voffB); PG8_STAGE(PG8_SA(0, 1), cA + hstep, voffA);
        if (wr == 1) PG8_BAR;
        PG8_WAIT_V(4); PG8_BAR;
        PG8_STAGE(PG8_SB(1, 0), cB + kstep, voffB); PG8_STAGE(PG8_SA(1, 0), cA + kstep, voffA); PG8_STAGE(PG8_SB(1, 1), cB + hstep + kstep, voffB);
        PG8_WAIT_V(6); PG8_BAR;
    }
    for (;;) {
        const bool has_next = S.next(ui + 1, nxt);
        const char* nA = has_next ? (const char*)g.A + (size_t)nxt.pm * tstep : cA; const char* nB = has_next ? (const char*)g.Bt + (size_t)nxt.pn * tstep : cB;
        for (int t = 0; t < nt; t += 2) {
            const bool last = (t == nt - 2);
            const char* a1 = cA + (size_t)(t + 1) * kstep;
            const char* a2 = last ? nA : cA + (size_t)(t + 2) * kstep; const char* b2 = last ? nB : cB + (size_t)(t + 2) * kstep;
            const char* a3 = a2 + kstep; const char* b3 = b2 + kstep;
            if (last && has_next) S.a_ready(nxt);
            if constexpr (Epi::HAS_MID) { if (t == Epi::MID_T) E.mid(acc, cur, wr, fr); }
            if constexpr (SP2) {
            PG8_LDB(B0, 0, 0); PG8_LDB(B1, 0, 1); PG8_SCHED; PG8_LDA(At, 0, 0); PG8_STAGE(PG8_SA(1, 1), a1 + hstep, voffA);
            PG8_WAIT_V(8); PG8_WAIT_L(0); PG8_BAR; PG8_MMA(0, 0, At, B0); PG8_MMA(0, 1, At, B1); PG8_BAR; PG8_SCHED;
            PG8_LDA(At, 0, 1); PG8_STAGE(PG8_SB(0, 0), b2, voffB); PG8_STAGE(PG8_SB(0, 1), b2 + hstep, voffB); PG8_STAGE(PG8_SA(0, 0), a2, voffA);
            PG8_WAIT_V(8); PG8_WAIT_L(0); PG8_BAR; PG8_MMA(1, 0, At, B0); PG8_MMA(1, 1, At, B1); PG8_BAR; PG8_SCHED;
            PG8_LDB(B0, 1, 0); PG8_LDB(B1, 1, 1); PG8_SCHED; PG8_LDA(At, 1, 0); PG8_STAGE(PG8_SA(0, 1), a2 + hstep, voffA);
            PG8_WAIT_V(8); PG8_WAIT_L(0); PG8_BAR; PG8_MMA(0, 0, At, B0); PG8_MMA(0, 1, At, B1); PG8_BAR; PG8_SCHED;
            PG8_LDA(At, 1, 1); PG8_STAGE(PG8_SB(1, 0), b3, voffB); PG8_STAGE(PG8_SB(1, 1), b3 + hstep, voffB); PG8_STAGE(PG8_SA(1, 0), a3, voffA);
            PG8_WAIT_V(8); PG8_WAIT_L(0); PG8_BAR; PG8_MMA(1, 0, At, B0); PG8_MMA(1, 1, At, B1); PG8_BAR; PG8_SCHED;
            } else {
            PG8_LDB(B0, 0, 0); PG8_SCHED; PG8_LDA(At, 0, 0); PG8_STAGE(PG8_SA(1, 1), a1 + hstep, voffA);
            PG8_WAIT_L(8); PG8_BAR; PG8_WAIT_L(0); PG8_MMA(0, 0, At, B0); PG8_BAR; PG8_SCHED;
            PG8_LDB(B1, 0, 1); PG8_STAGE(PG8_SB(0, 0), b2, voffB);
            PG8_BAR; PG8_WAIT_L(0); PG8_MMA(0, 1, At, B1); PG8_BAR;
            PG8_LDA(At, 0, 1); PG8_STAGE(PG8_SA(0, 0), a2, voffA);
            PG8_BAR; PG8_WAIT_L(0); PG8_MMA(1, 0, At, B0); PG8_BAR; PG8_SCHED;
            PG8_STAGE(PG8_SB(0, 1), b2 + hstep, voffB);
            PG8_WAIT_V(6); PG8_BAR; PG8_MMA(1, 1, At, B1); PG8_BAR;
            PG8_LDB(B0, 1, 0); PG8_SCHED; PG8_LDA(At, 1, 0); PG8_STAGE(PG8_SA(0, 1), a2 + hstep, voffA);
            PG8_WAIT_L(8); PG8_BAR; PG8_WAIT_L(0); PG8_MMA(0, 0, At, B0); PG8_BAR; PG8_SCHED;
            PG8_LDB(B1, 1, 1); PG8_STAGE(PG8_SB(1, 0), b3, voffB);
            PG8_BAR; PG8_WAIT_L(0); PG8_MMA(0, 1, At, B1); PG8_BAR;
            PG8_LDA(At, 1, 1); PG8_STAGE(PG8_SA(1, 0), a3, voffA);
            PG8_BAR; PG8_WAIT_L(0); PG8_MMA(1, 0, At, B0); PG8_BAR; PG8_SCHED;
            PG8_STAGE(PG8_SB(1, 1), b3 + hstep, voffB);
            PG8_WAIT_V(6); PG8_BAR; PG8_MMA(1, 1, At, B1); PG8_BAR;
            }
        }
        if constexpr (ALIGN_EPI) { if (wr == 0) PG8_BAR; }
        if constexpr (!Epi::AFTER_DRAIN) { E(acc, cur, wr, wc, fr, fq); S.done(cur); }
        if (!has_next) break;
#pragma unroll
        for (int a = 0; a < 2; ++a)
#pragma unroll
            for (int b = 0; b < 2; ++b)
#pragma unroll
                for (int m = 0; m < 4; ++m)
#pragma unroll
                    for (int n = 0; n < 2; ++n) acc[a][b][m][n] = (f32x4){0.f, 0.f, 0.f, 0.f};
        cur = nxt; cA = nA; cB = nB; ++ui;
        if constexpr (ALIGN_EPI) { if (wr == 1) PG8_BAR; }
    }
    PG8_WAIT_V(0);
    if constexpr (!ALIGN_EPI) { if (wr == 0) PG8_BAR; }
    PG8_BAR;
    if constexpr (Epi::AFTER_DRAIN) { E.fused(acc, cur, wr, wc, fr, fq, lds, wid, lane); S.done(cur); }
#undef PG8_SA
#undef PG8_SB
#undef PG8_STAGE
#undef PG8_LDA
#undef PG8_LDB
#undef PG8_MMA
#undef PG8_WAIT_V
#undef PG8_WAIT_L
#undef PG8_BAR
#undef PG8_SCHED
}
}

namespace gm {
#define GM_LAS __attribute__((address_space(3)))
typedef short v4i16_t __attribute__((ext_vector_type(4)));
__device__ __forceinline__ int swz(int s) { return ((s >> 1) & 1) + 2 * ((s >> 3) & 1); }
__device__ __forceinline__ void gmlp_phase(GM_LAS unsigned char* lds, int wid0, int vcu, const bf16_t* U, const bf16_t* VN, const bf16_t* GW  , const float* bs  , const float* gog  , bf16_t* Y, float* ssqy) {
    int tid_ = wid0 * 64 + lane_id(); asm volatile("" : "+v"(tid_));
    const int tid = tid_, lane = tid & 63, wid = __builtin_amdgcn_readfirstlane(tid >> 6), fr = lane & 15, fq = lane >> 4;
    const int g = vcu & 7, nks = (wid >> 1) + 1;
    bf16x8 wf[4];
#pragma unroll
    for (int ks = 0; ks < 4; ++ks) wf[ks] = *(const bf16x8*)(GW + ((size_t)(g * CHUNK + 16 * wid + fr)) * CHUNK + 32 * ks + 8 * fq);
    const float bias = bs[g * CHUNK + 16 * wid + fr];
    f32x4 gv[4];
#pragma unroll
    for (int nt = 0; nt < 4; ++nt) gv[nt] = *(const f32x4*)(gog + g * 64 + 16 * nt + 4 * fq);
    for (int i = 0; i < 8; ++i) {
        const int un = (vcu >> 3) + 32 * i; const size_t t0 = (size_t)un * CHUNK;
        pg8::u32x4 st[2];
#pragma unroll
        for (int k = 0; k < 2; ++k) { const int idx = tid + 512 * k, s = idx >> 3, c16 = idx & 7; st[k] = *(const pg8::u32x4*)(VN + (t0 + s) * 512 + g * 64 + c16 * 8); }
        __syncthreads();
#pragma unroll
        for (int k = 0; k < 2; ++k) { const int idx = tid + 512 * k, s = idx >> 3, c16 = idx & 7; *(GM_LAS pg8::u32x4*)(lds + s * 128 + (((c16 >> 1) ^ swz(s)) * 32) + (c16 & 1) * 16) = st[k]; }
        __syncthreads();
        f32x4 acc[4];
#pragma unroll
        for (int nt = 0; nt < 4; ++nt) acc[nt] = (f32x4){0.f, 0.f, 0.f, 0.f};
#pragma unroll
        for (int ks = 0; ks < 4; ++ks) { if (ks < nks) {
#pragma unroll
            for (int nt = 0; nt < 4; ++nt) {
                const int q = fr >> 2, p = fr & 3;
                const int s0 = 32 * ks + 8 * fq + q, s1 = s0 + 4;
                const v4i16_t lo = __builtin_amdgcn_ds_read_tr16_b64_v4i16((GM_LAS v4i16_t*)(lds + s0 * 128 + ((nt ^ swz(s0)) * 32) + p * 8));
                const v4i16_t hi = __builtin_amdgcn_ds_read_tr16_b64_v4i16((GM_LAS v4i16_t*)(lds + s1 * 128 + ((nt ^ swz(s1)) * 32) + p * 8));
                const bf16x8 vf = (bf16x8){lo[0], lo[1], lo[2], lo[3], hi[0], hi[1], hi[2], hi[3]};
                acc[nt] = __builtin_amdgcn_mfma_f32_16x16x32_bf16(vf, wf[ks], acc[nt], 0, 0, 0);
            } } }
        const size_t row = t0 + 16 * wid + fr; float ss = 0.f;
#pragma unroll
        for (int nt = 0; nt < 4; ++nt) { const int c = g * 64 + 16 * nt + 4 * fq;
            const uint2 uu = *(const uint2*)(U + row * 512 + c);
            f32x4 y; y[0] = bf2f((bf16_t)(uu.x & 0xffff)) * (acc[nt][0] + bias); y[1] = bf2f((bf16_t)(uu.x >> 16)) * (acc[nt][1] + bias);
            y[2] = bf2f((bf16_t)(uu.y & 0xffff)) * (acc[nt][2] + bias); y[3] = bf2f((bf16_t)(uu.y >> 16)) * (acc[nt][3] + bias);
            ss += pg8::hsq4(y); *(pg8::u32x2*)(Y + row * DM + c) = pg8::pack4(y * gv[nt]); }
        ss = pg8::quad_sum(ss); if (fq == 0) ssqy[row * 16 + g] = ss;
    }
    __syncthreads();
}
}

namespace att {
#define AT_LAS __attribute__((address_space(3)))
using f32x16 = __attribute__((ext_vector_type(16))) float;
using s16x4 = __attribute__((ext_vector_type(4))) short;
using u32x4 = __attribute__((ext_vector_type(4))) unsigned;
constexpr int KVBLK = 64, NSLOT = 3, SLOTB = 20480, VOFF = 12288;
constexpr int LDS_WS = NSLOT * SLOTB  , LDS_OST = LDS_WS + 8 * 256  , OROW = 272, LDS_BYTES = LDS_OST + 8 * 32 * OROW  ;
__device__ __forceinline__ int crow(int r, int hi) { return (r & 3) + 8 * (r >> 2) + 4 * hi; }
__device__ __forceinline__ void glds16(const void* gsrc, unsigned lds_dst) { unsigned keep;
    asm volatile("s_mov_b32 %0, m0\n\ts_mov_b32 m0, %2\n\ts_nop 0\n\tglobal_load_lds_dwordx4 %1, off\n\ts_mov_b32 m0, %0" : "=&s"(keep) : "v"(gsrc), "s"(lds_dst) : "memory"); }
#define AT_WAIT_BAR(N) asm volatile("s_waitcnt vmcnt(" #N ") lgkmcnt(0)\n\ts_barrier" ::: "memory")
#define AT_SBAR() __builtin_amdgcn_sched_barrier(0)
typedef short v4i16_t __attribute__((ext_vector_type(4)));
__device__ __forceinline__ s16x4 vtr(AT_LAS const char* p) { return __builtin_bit_cast(s16x4, __builtin_amdgcn_ds_read_tr16_b64_v4i16((AT_LAS v4i16_t*)p)); }

template <int THRL>
__device__ __forceinline__ void attn_unit(int b, int h, int qb, const bf16_t* Q, const bf16_t* KN, const bf16_t* KR, const bf16_t* V, const float* goa  , bf16_t* Y, float* ssqy, AT_LAS char* shm, int wid0) {
    int tid_ = wid0 * 64 + lane_id(); asm volatile("" : "+v"(tid_));
    const int tid = tid_, lane = tid & 63, r32 = lane & 31, hi = lane >> 5; const int wid = __builtin_amdgcn_readfirstlane(tid >> 6);
    const size_t rowbase = (size_t)b * SEQ; const int q0 = qb * 256;
    const bf16_t* Qw = Q + (rowbase + q0 + wid * 32) * 768 + h * 96;
    const unsigned lds0 = (unsigned)(uintptr_t)shm;
    AT_LAS float* wsf = (AT_LAS float*)(shm + LDS_WS) + wid * 64;
    const bf16_t* ksrc = KN + (rowbase + lane) * 512 + h * 64 + wid * 8;
    const bf16_t* rsrc = KR + (rowbase + lane) * 32 + (wid & 3) * 8;
    const bf16_t* vsrc = V + (rowbase + 16 * (wid & 3) + (lane >> 2)) * 512 + h * 64 + (wid >> 2) * 32 + (lane & 3) * 8;
    const unsigned kdst = lds0 + wid * 1024, rdst = lds0 + (8 + (wid & 3)) * 1024, vdst = lds0 + VOFF + wid * 1024;
#define AT_DMA(t, slot) do { glds16(ksrc + (size_t)(t) * KVBLK * 512, (unsigned)__builtin_amdgcn_readfirstlane(kdst + (slot))); \
        glds16(rsrc + (size_t)(t) * KVBLK * 32, (unsigned)__builtin_amdgcn_readfirstlane(rdst + (slot))); \
        glds16(vsrc + (size_t)(t) * KVBLK * 512, (unsigned)__builtin_amdgcn_readfirstlane(vdst + (slot))); } while (0)
    const int NT = (q0 + 256) / KVBLK;
    bf16x8 qr[6];
#pragma unroll
    for (int d0 = 0; d0 < 6; ++d0) qr[d0] = *(const bf16x8*)(Qw + (size_t)r32 * 768 + d0 * 16 + hi * 8);
    AT_DMA(0, 0); AT_DMA(1, SLOTB);
    float mhat = 0.f, l_reg = 0.f; f32x16 o[2]; o[0] = f32x16{}; o[1] = f32x16{};
    const int qrel = wid * 32 + r32;
    int sl_cur = 0, sl_nn = 2 * SLOTB;
    AT_LAS const char* kp0 = shm + hi * 1024 + r32 * 16;
    AT_LAS const char* vp0 = shm + VOFF + ((lane >> 4) & 1) * 32 + (lane & 3) * 8 + (4 * hi + ((lane & 15) >> 2)) * 64;
    for (int t = 0; t < NT; ++t) {
        if (t + 1 < NT) { AT_WAIT_BAR(3); } else { AT_WAIT_BAR(0); }
        if (t + 2 < NT) AT_DMA(t + 2, sl_nn);
        const int jb = t - (NT - 4);
        if (jb <= (wid >> 1)) {
            f32x16 p0, p1;
            { AT_LAS const char* kb = kp0 + sl_cur;
#pragma unroll
              for (int d0 = 0; d0 < 6; ++d0) {
                const bf16x8 b0 = *(AT_LAS const bf16x8*)(kb + d0 * 2048), b1 = *(AT_LAS const bf16x8*)(kb + d0 * 2048 + 512);
                if (d0 == 0) { p0 = __builtin_amdgcn_mfma_f32_32x32x16_bf16(b0, qr[0], f32x16{}, 0, 0, 0); p1 = __builtin_amdgcn_mfma_f32_32x32x16_bf16(b1, qr[0], f32x16{}, 0, 0, 0); }
                else { p0 = __builtin_amdgcn_mfma_f32_32x32x16_bf16(b0, qr[d0], p0, 0, 0, 0); p1 = __builtin_amdgcn_mfma_f32_32x32x16_bf16(b1, qr[d0], p1, 0, 0, 0); } } }
            if (jb >= 0) { const int kb = 64 * jb + 4 * hi;
#pragma unroll
                for (int r = 0; r < 16; ++r) { const int kv = kb + (r & 3) + 8 * (r >> 2); if (kv > qrel) p0[r] = -INFINITY; if (kv + 32 > qrel) p1[r] = -INFINITY; } }
            float rm = fmaxf(p0[0], p1[0]);
#pragma unroll
            for (int r = 1; r < 16; ++r) rm = fmaxf(rm, fmaxf(p0[r], p1[r]));
            { auto rr = __builtin_amdgcn_permlane32_swap(__float_as_uint(rm), __float_as_uint(rm), false, false); rm = fmaxf(__uint_as_float(rr[0]), __uint_as_float(rr[1])); }
            const float grow = rm - mhat;
            if (t == 0 || __any(grow > (float)THRL)) {
                const float dl = (t == 0) ? rm : fmaxf(grow, 0.f); const float f = (t == 0) ? 0.f : __builtin_amdgcn_exp2f(-dl);
                mhat = (t == 0) ? rm : mhat + dl; l_reg *= f;
                if (t > 0) { if (hi == 0) wsf[r32] = f; asm volatile("s_waitcnt lgkmcnt(0)" ::: "memory");
#pragma unroll
                    for (int r = 0; r < 16; ++r) { const float fr_ = wsf[crow(r, hi)]; o[0][r] *= fr_; o[1][r] *= fr_; } }
            }
            float sacc = 0.f;
#pragma unroll
            for (int r = 0; r < 16; ++r) { p0[r] = __builtin_amdgcn_exp2f(p0[r] - mhat); p1[r] = __builtin_amdgcn_exp2f(p1[r] - mhat); sacc += p0[r] + p1[r]; }
            l_reg += sacc;
            u32x4 pw0, pw1, pw2, pw3;
#define AT_PK(P, B) pg8::cvt_pk_bf16(P[B], P[B + 1])
            pw0 = (u32x4){AT_PK(p0, 0), AT_PK(p0, 2), AT_PK(p0, 4), AT_PK(p0, 6)}; pw1 = (u32x4){AT_PK(p0, 8), AT_PK(p0, 10), AT_PK(p0, 12), AT_PK(p0, 14)};
            pw2 = (u32x4){AT_PK(p1, 0), AT_PK(p1, 2), AT_PK(p1, 4), AT_PK(p1, 6)}; pw3 = (u32x4){AT_PK(p1, 8), AT_PK(p1, 10), AT_PK(p1, 12), AT_PK(p1, 14)};
#undef AT_PK
            AT_LAS const char* vp = vp0 + sl_cur;
#pragma unroll
            for (int d0 = 0; d0 < 2; ++d0) { s16x4 lo[4], hh[4];
#pragma unroll
                for (int ks = 0; ks < 4; ++ks) { lo[ks] = vtr(vp + d0 * 4096 + ks * 1024); hh[ks] = vtr(vp + d0 * 4096 + ks * 1024 + 512); }
#define AT_VF(k) (bf16x8){lo[k][0], lo[k][1], lo[k][2], lo[k][3], hh[k][0], hh[k][1], hh[k][2], hh[k][3]}
                o[d0] = __builtin_amdgcn_mfma_f32_32x32x16_bf16(__builtin_bit_cast(bf16x8, pw0), AT_VF(0), o[d0], 0, 0, 0);
                o[d0] = __builtin_amdgcn_mfma_f32_32x32x16_bf16(__builtin_bit_cast(bf16x8, pw1), AT_VF(1), o[d0], 0, 0, 0);
                o[d0] = __builtin_amdgcn_mfma_f32_32x32x16_bf16(__builtin_bit_cast(bf16x8, pw2), AT_VF(2), o[d0], 0, 0, 0);
                o[d0] = __builtin_amdgcn_mfma_f32_32x32x16_bf16(__builtin_bit_cast(bf16x8, pw3), AT_VF(3), o[d0], 0, 0, 0);
#undef AT_VF
            }
        }
        sl_cur = (sl_cur == 2 * SLOTB) ? 0 : sl_cur + SLOTB; sl_nn = (sl_nn == 2 * SLOTB) ? 0 : sl_nn + SLOTB;
    }
    { auto rr = __builtin_amdgcn_permlane32_swap(__float_as_uint(l_reg), __float_as_uint(l_reg), false, false); l_reg = __uint_as_float(rr[0]) + __uint_as_float(rr[1]); }
    if (hi == 0) wsf[32 + r32] = __builtin_amdgcn_rcpf(l_reg);
    asm volatile("s_waitcnt lgkmcnt(0)" ::: "memory");
    AT_LAS char* stg = shm + LDS_OST + wid * (32 * OROW);
#pragma unroll
    for (int r = 0; r < 16; ++r) { const int orow = crow(r, hi); const float rl = wsf[32 + orow];
        *(AT_LAS float*)(stg + orow * OROW + r32 * 4) = o[0][r] * rl; *(AT_LAS float*)(stg + orow * OROW + 128 + r32 * 4) = o[1][r] * rl; }
    asm volatile("s_waitcnt lgkmcnt(0)" ::: "memory");
    { const int row = lane >> 1, half = lane & 1; const size_t grow = rowbase + q0 + wid * 32 + row; float ss = 0.f;
      const float* gp = goa + h * 64 + half * 32; bf16_t* yp = Y + grow * DM + 512 + h * 64 + half * 32;
#pragma unroll
      for (int i = 0; i < 4; ++i) { const f32x4 a = *(AT_LAS const f32x4*)(stg + row * OROW + half * 128 + i * 32), c = *(AT_LAS const f32x4*)(stg + row * OROW + half * 128 + i * 32 + 16);
          ss += pg8::hsq4(a) + pg8::hsq4(c);
          *(u32x4*)(yp + i * 8) = pg8::pack8(a * *(const f32x4*)(gp + i * 8), c * *(const f32x4*)(gp + i * 8 + 4)); }
      ss += swz_xor1(ss); if (half == 0) ssqy[grow * 16 + 8 + h] = ss; }
    asm volatile("s_waitcnt lgkmcnt(0)\n\ts_barrier" ::: "memory");
#undef AT_DMA
}
__device__ __forceinline__ void attn_phase(AT_LAS char* lds, int wid0, int vcu, const bf16_t* Q, const bf16_t* KN, const bf16_t* KR, const bf16_t* V, const float* goa, bf16_t* Y, float* ssqy) {
    const int bh = vcu >> 1, s = vcu & 1;
    for (int i = 0; i < 4; ++i) { const int qb = (i == 0) ? s : (i == 1) ? 7 - s : (i == 2) ? 2 + s : 5 - s;
        attn_unit<8>(bh >> 3, bh & 7, qb, Q, KN, KR, V, goa, Y, ssqy, lds, wid0); }
}
}

constexpr int NWAVES = 8;
struct Args { const void* in[20]; float* out; unsigned char* ws; int ph_lo, ph_hi; };
namespace pro {
#define PR_LAS __attribute__((address_space(3)))
__device__ __forceinline__ unsigned pk2(float lo, float hi) { return (unsigned)f2bf(lo) | ((unsigned)f2bf(hi) << 16); }
template <int MODE  >
__device__ __forceinline__ void tr_item(const float* W, int ldw, bf16_t* WT, int out_ld, int out_koff, int nblk, PR_LAS float* scr, int item, int lane) {
    const int kb = item / nblk, nb = item - kb * nblk, k0 = 64 * kb, n0 = 32 * nb;
    const int pn = n0 + (lane & 31); const int sc = MODE == 0 ? pn : (MODE == 1 ? win_src(pn) : wup_qcol(pn));
#pragma unroll 8
    for (int i = 0; i < 32; ++i) { const int kk = 2 * i + (lane >> 5); scr[kk * 33 + (lane & 31)] = (sc >= 0) ? W[(size_t)(k0 + kk) * ldw + sc] : 0.f; }
    asm volatile("s_waitcnt lgkmcnt(0)" ::: "memory");
    const int c = lane & 7;
#pragma unroll
    for (int j = 0; j < 4; ++j) { const int n = (lane >> 3) + 8 * j; const PR_LAS float* s = scr + (8 * c) * 33 + n;
        pg8::u32x4 o; o.x = pk2(s[0 * 33], s[1 * 33]); o.y = pk2(s[2 * 33], s[3 * 33]); o.z = pk2(s[4 * 33], s[5 * 33]); o.w = pk2(s[6 * 33], s[7 * 33]);
        *(pg8::u32x4*)(WT + (size_t)(n0 + n) * out_ld + out_koff + k0 + 8 * c) = o; }
    asm volatile("s_waitcnt lgkmcnt(0)" ::: "memory");
}
__device__ __forceinline__ void smallm_unit(PR_LAS unsigned char* lds, int tid, const float* in, int in_stride, bool act, const float* W, int ldw, int N, bool winmap, const float* bias, float* out, int out_stride, int p0) {
    PR_LAS float* sin_ = (PR_LAS float*)lds; PR_LAS float* red = (PR_LAS float*)(lds + 65536);
    const int lane = tid & 63, wave = tid >> 6;
    for (int e = tid; e < 16 * 1024; e += 512) { const int b = e >> 10, k = e & 1023; float v = in[(size_t)b * in_stride + k]; if (act) v = v / (1.f + __expf(-v)); sin_[k * 16 + b] = v; }
    __syncthreads();
    const int p = p0 + lane; const int s = winmap ? win_src(p) : p; const bool ok = (s >= 0 && s < N);
    float acc[16];
#pragma unroll
    for (int b = 0; b < 16; ++b) acc[b] = 0.f;
#pragma unroll 4
    for (int k = wave * 128; k < wave * 128 + 128; ++k) {
        const float w = ok ? W[(size_t)k * ldw + s] : 0.f;
        const PR_LAS f32x4* sp = (const PR_LAS f32x4*)(sin_ + k * 16);
#pragma unroll
        for (int q = 0; q < 4; ++q) { const f32x4 v = sp[q]; acc[4 * q] += v[0] * w; acc[4 * q + 1] += v[1] * w; acc[4 * q + 2] += v[2] * w; acc[4 * q + 3] += v[3] * w; }
    }
#pragma unroll
    for (int b = 0; b < 16; ++b) red[(wave * 64 + lane) * 16 + b] = acc[b];
    __syncthreads();
    for (int e = tid; e < 64 * 16; e += 512) { const int l = e >> 4, b = e & 15; float sum = 0.f;
#pragma unroll
        for (int w = 0; w < 8; ++w) sum += red[(w * 64 + l) * 16 + b];
        out[(size_t)b * out_stride + p0 + l] = sum + (bias ? bias[p0 + l] : 0.f); }
    __syncthreads();
}
__device__ __forceinline__ float wsum(float v) {
    v += __int_as_float(__builtin_amdgcn_ds_swizzle(__float_as_int(v), 0x041F)); v += __int_as_float(__builtin_amdgcn_ds_swizzle(__float_as_int(v), 0x081F));
    v += __int_as_float(__builtin_amdgcn_ds_swizzle(__float_as_int(v), 0x101F)); v += __int_as_float(__builtin_amdgcn_ds_swizzle(__float_as_int(v), 0x201F));
    v += __int_as_float(__builtin_amdgcn_ds_swizzle(__float_as_int(v), 0x401F));
    auto rr = __builtin_amdgcn_permlane32_swap(__float_as_uint(v), __float_as_uint(v), false, false); return __uint_as_float(rr[0]) + __uint_as_float(rr[1]);
}
__device__ __forceinline__ void phase0a(PR_LAS unsigned char* lds, int wid0, int vcu, int G, const Args& args, int zi, unsigned char* ws) {
    int tid_ = wid0 * 64 + lane_id(); asm volatile("" : "+v"(tid_));
    const int tid = tid_, lane = tid & 63, wave = tid >> 6;
#define PIN(i) ((const float*)args.in[(i) + zi])
    for (int un = vcu; un < DEPTH * (NMOD / 64); un += G) { const int l = un / (NMOD / 64), p0 = (un % (NMOD / 64)) * 64;
        smallm_unit(lds, tid, PIN(1), DM, true, PIN(3) + (size_t)l * DM * NMOD, NMOD, NMOD, false, PIN(4) + (size_t)l * NMOD, (float*)(ws + WS_MOD) + (size_t)l * NB * NMOD, NMOD, p0); }
    { const int* pos = (const int*)args.in[2 + zi]; float* rope = (float*)(ws + WS_ROPE);
      for (int idx = vcu * 512 + tid; idx < T * 16; idx += G * 512) { const int t = idx >> 4, i = idx & 15;
          const float freq = exp2f(-(float)i * (13.287712379549449f / 16.0f)); const float ang = (float)pos[t] * freq;
          rope[t * 32 + i] = cosf(ang); rope[t * 32 + 16 + i] = sinf(ang); } }
    { const float* gws = PIN(7); bf16_t* gw = (bf16_t*)(ws + WS_GW);
      for (int idx = vcu * 512 + tid; idx < DEPTH * NGRP * CHUNK * CHUNK; idx += G * 512) { const int s = idx & 127, t = (idx >> 7) & 127; gw[idx] = (s <= t) ? f2bf(gws[idx]) : (bf16_t)0; } }
    PR_LAS float* scr = (PR_LAS float*)(lds + wave * 16384);
    const int gw_ = vcu * NWAVES + wave, NGW = G * NWAVES;
    constexpr int I_IN = (DM / 64) * (NIN / 32), I_UQ = (QR / 64) * (768 / 32), I_UKV = (KVR / 64) * (1024 / 32), I_OUT = (DM / 64) * (DM / 32), I_1 = (DM / 64) * (DFF / 32), I_2 = (DFF / 64) * (DM / 32);
    constexpr int I_LAYER = I_IN + I_UQ + I_UKV + I_OUT + I_1 + I_2;
    for (int it = gw_; it < DEPTH * I_LAYER; it += NGW) {
        const int l = it / I_LAYER; int r = it - l * I_LAYER; unsigned char* wl = ws + WS_W + (size_t)l * WL_STRIDE;
        if (r < I_IN) { tr_item<1>(PIN(6) + (size_t)l * DM * DIN, DIN, (bf16_t*)(wl + WL_IN), DM, 0, NIN / 32, scr, r, lane); continue; } r -= I_IN;
        if (r < I_UQ) { tr_item<2>(PIN(11) + (size_t)l * QR * 768, 768, (bf16_t*)(wl + WL_UP), KUP, 0, 768 / 32, scr, r, lane); continue; } r -= I_UQ;
        if (r < I_UKV) { tr_item<0>(PIN(12) + (size_t)l * KVR * 1024, 1024, (bf16_t*)(wl + WL_UP) + (size_t)768 * KUP, KUP, 256, 1024 / 32, scr, r, lane); continue; } r -= I_UKV;
        if (r < I_OUT) { tr_item<0>(PIN(15) + (size_t)l * DM * DM, DM, (bf16_t*)(wl + WL_OUT), DM, 0, DM / 32, scr, r, lane); continue; } r -= I_OUT;
        if (r < I_1) { tr_item<0>(PIN(17) + (size_t)l * DM * DFF, DFF, (bf16_t*)(wl + WL_1), DM, 0, DFF / 32, scr, r, lane); continue; } r -= I_1;
        tr_item<0>(PIN(18) + (size_t)l * DFF * DM, DM, (bf16_t*)(wl + WL_2), DFF, 0, DM / 32, scr, r, lane);
    }
    for (int idx = vcu * 512 + tid; idx < DEPTH * (768 * 16 + 1024 * 32); idx += G * 512) {
        const int l = idx / (768 * 16 + 1024 * 32); int r = idx - l * (768 * 16 + 1024 * 32); bf16_t* wup = (bf16_t*)(ws + WS_W + (size_t)l * WL_STRIDE + WL_UP);
        pg8::u32x4 z; z.x = 0u; z.y = 0u; z.z = 0u; z.w = 0u;
        if (r < 768 * 16) { const int row = r >> 4, c = r & 15; *(pg8::u32x4*)(wup + (size_t)row * KUP + 256 + 8 * c) = z; }
        else { r -= 768 * 16; const int row = 768 + (r >> 5), c = r & 31; *(pg8::u32x4*)(wup + (size_t)row * KUP + 8 * c) = z; } }
#undef PIN
}
__device__ __forceinline__ void phase0b(PR_LAS unsigned char* lds, int wid0, int vcu, int G, const Args& args, int zi, unsigned char* ws) {
    int tid_ = wid0 * 64 + lane_id(); asm volatile("" : "+v"(tid_));
    const int tid = tid_, lane = tid & 63, wave = tid >> 6;
#define PIN(i) ((const float*)args.in[(i) + zi])
    float* MOD = (float*)(ws + WS_MOD);
    constexpr int U1 = NIN / 64, U2 = DFF / 64;
    for (int un = vcu; un < DEPTH * (U1 + U2); un += G) { const int l = un / (U1 + U2), r = un % (U1 + U2); const float* modl = MOD + (size_t)l * NB * NMOD;
        if (r < U1) smallm_unit(lds, tid, modl, NMOD, false, PIN(6) + (size_t)l * DM * DIN, DIN, DIN, true, nullptr, (float*)(ws + WS_SHW1) + (size_t)l * NB * NIN, NIN, r * 64);
        else smallm_unit(lds, tid, modl + 3 * DM, NMOD, false, PIN(17) + (size_t)l * DM * DFF, DFF, DFF, false, nullptr, (float*)(ws + WS_SHW2) + (size_t)l * NB * DFF, DFF, (r - U1) * 64); }
    for (int idx = vcu * 512 + tid; idx < DEPTH * NB * DM; idx += G * 512) { const int c = idx & 1023, b = (idx >> 10) & 15, l = idx >> 14; const float* m = MOD + ((size_t)l * NB + b) * NMOD;
        ((float*)(ws + WS_GM1))[idx] = PIN(5)[l * DM + c] * (1.f + m[1 * DM + c]); ((float*)(ws + WS_GM2))[idx] = PIN(16)[l * DM + c] * (1.f + m[4 * DM + c]); }
    { const float* x = PIN(0); const float* g = PIN(5); bf16_t* A = (bf16_t*)(ws + WS_A); float* ssq = (float*)(ws + WS_SSQ1);
      for (int row = vcu * NWAVES + wave; row < T; row += G * NWAVES) { const int b = row / SEQ; const f32x4* xr = (const f32x4*)(x + (size_t)row * DM); const float* sc = MOD + (size_t)b * NMOD + DM; float s = 0.f;
#pragma unroll
          for (int j = 0; j < 4; ++j) { const f32x4 v = xr[lane + 64 * j]; s += pg8::hsq4(v); const int c = 4 * (lane + 64 * j); const f32x4 gv = *(const f32x4*)(g + c), sv = *(const f32x4*)(sc + c);
              *(pg8::u32x2*)(A + (size_t)row * DM + c) = pg8::pack4(v * gv * (sv + 1.f)); }
          s = wsum(s); if (lane < 16) ssq[(size_t)row * 16 + lane] = (lane == 0) ? s : 0.f; } }
#undef PIN
}
__device__ __forceinline__ void phase_final(int wid0, int vcu, int G, const float* g, float* out) {
    int tid_ = wid0 * 64 + lane_id(); asm volatile("" : "+v"(tid_));
    const int lane = tid_ & 63, wave = tid_ >> 6;
    for (int row = vcu * NWAVES + wave; row < T; row += G * NWAVES) { f32x4* xr = (f32x4*)(out + (size_t)row * DM); f32x4 v[4]; float s = 0.f;
#pragma unroll
        for (int j = 0; j < 4; ++j) { v[j] = xr[lane + 64 * j]; s += pg8::hsq4(v[j]); }
        const float rstd = rsqrtf(wsum(s) * (1.f / DM) + EPS);
#pragma unroll
        for (int j = 0; j < 4; ++j) { const f32x4 gv = *(const f32x4*)(g + 4 * (lane + 64 * j)); xr[lane + 64 * j] = v[j] * rstd * gv; } }
}
}

constexpr int RING_BYTES = 131072;
constexpr int LDSCTL_OFF = 135168, MISC_OFF = LDSCTL_OFF + 320;
constexpr int LDS_BYTES = 147456;
static_assert(att::LDS_BYTES <= LDSCTL_OFF, "attention scratch below the control words");
constexpr int CW_BAR = 4096;
constexpr size_t CTL_ZERO_BYTES = 64 * 1024;

#define GAS __attribute__((address_space(1)))
#define LAS __attribute__((address_space(3)))
typedef GAS unsigned gu32;
#define RLX_AGENT __ATOMIC_RELAXED, __HIP_MEMORY_SCOPE_AGENT
#define XB_TMO      128
#define XB_XCNT(j)  (256  + 64 * (j))
#define XB_XSUB(j)  (1280 + 64 * (j))
#define XB_XGEN(j)  (2304 + 64 * (j))
#define XB_TOP      3328
#define XB_TOPGEN   3392
#define XCD_BAR_WORDS 3456
#define XB_SPIN_CAP (1u << 18)
__device__ __forceinline__ unsigned xb_ld(unsigned* p)              { return __hip_atomic_load(p, __ATOMIC_RELAXED, __HIP_MEMORY_SCOPE_AGENT); }
__device__ __forceinline__ unsigned xb_add(unsigned* p, unsigned v) { return __hip_atomic_fetch_add(p, v, __ATOMIC_RELAXED, __HIP_MEMORY_SCOPE_AGENT); }
__device__ __forceinline__ unsigned xb_xcc_id() { return (unsigned)__builtin_amdgcn_s_getreg((3 << 11) | 20) & 0xFu; }
#define XB_SPIN(cond, bar) do { unsigned _sp = 0; while (cond) { __builtin_amdgcn_s_sleep(1); \
    if ((++_sp & 255u) == 0u) { if (xb_ld(&(bar)[XB_TMO])) break; if (_sp > XB_SPIN_CAP) { atomicAdd(&(bar)[XB_TMO], 1u); break; } } } } while (0)
struct XcdBarrier { unsigned* bar; unsigned x; volatile LAS unsigned* st; };
__device__ __forceinline__ XcdBarrier xcd_barrier_post(unsigned* bar, volatile LAS unsigned* st, int wid0) {
    XcdBarrier b; b.bar = bar; b.x = xb_xcc_id(); b.st = st;
    if (wid0 == 0 && lane_id() == 0) (void)xb_add(&bar[XB_XCNT(b.x)], 1u);
    return b;
}
__device__ __forceinline__ void xcd_barrier_complete(unsigned* bar, unsigned x, unsigned& nloc, unsigned& nx) {
    const unsigned G = gridDim.x * gridDim.y * gridDim.z;
    unsigned sum, cnt, mine, sp = 0u;
    for (;;) {
        sum = 0u; cnt = 0u; mine = 0u;
#pragma unroll
        for (unsigned j = 0; j < 16; ++j) { const unsigned c = xb_ld(&bar[XB_XCNT(j)]); sum += c; cnt += (c > 0u) ? 1u : 0u; mine = (j == x) ? c : mine; }
        if (sum == G) break;
        __builtin_amdgcn_s_sleep(1);
        if ((++sp & 255u) == 0u) { if (xb_ld(&bar[XB_TMO])) break; if (sp > XB_SPIN_CAP) { atomicAdd(&bar[XB_TMO], 1u); break; } }
    }
    nloc = mine > 0u ? mine : 1u; nx = cnt > 0u ? cnt : 1u;
}
__device__ __forceinline__ void xcd_barrier(const XcdBarrier& b, int wid0) {
    asm volatile("s_waitcnt vmcnt(0)" ::: "memory");
    __syncthreads();
    if (wid0 == 0 && lane_id() == 0) {
        unsigned zo = 0; asm volatile("" : "+s"(zo));
        unsigned* bar = b.bar + zo;
        __builtin_amdgcn_s_waitcnt(0);
        unsigned nloc = b.st[0], nx = b.st[1];
        if (nloc == 0u) { xcd_barrier_complete(bar, b.x, nloc, nx); b.st[0] = nloc; b.st[1] = nx; }
        const unsigned old = xb_add(&bar[XB_XSUB(b.x)], 1u);
        const unsigned gen = old / nloc;
        if (old + 1u == (gen + 1u) * nloc) {
            __builtin_amdgcn_fence(__ATOMIC_RELEASE, "agent");
            asm volatile("s_waitcnt vmcnt(0)" ::: "memory");
            const unsigned og = xb_add(&bar[XB_TOP], 1u);
            const unsigned tg = og / nx;
            if (og + 1u == (tg + 1u) * nx) xb_add(&bar[XB_TOPGEN], 1u);
            else XB_SPIN(xb_ld(&bar[XB_TOPGEN]) == tg, bar);
            __builtin_amdgcn_fence(__ATOMIC_ACQUIRE, "agent");
            xb_add(&bar[XB_XGEN(b.x)], 1u);
            asm volatile("s_waitcnt vmcnt(0)" ::: "memory");
        } else {
            XB_SPIN(xb_ld(&bar[XB_XGEN(b.x)]) == gen, bar);
            __builtin_amdgcn_fence(__ATOMIC_ACQUIRE, "agent");
            asm volatile("s_waitcnt vmcnt(0)" ::: "memory");
        }
    }
    __syncthreads();
}

constexpr int PH_P0A = 0, PH_P0B = 1, PH_L0 = 2, PH_PER_LAYER = 7, PH_FINAL = PH_L0 + DEPTH * PH_PER_LAYER, PH_END = PH_FINAL + 1;

#define MK_IN_(k) (lo <= (k) && (k) < hi)
#define MK_SEAM(k) do { if (MK_IN_(k) && MK_IN_((k) + 1)) xcd_barrier(bar, wid0); } while (0)
#define MK_PTRS() int zi = 0; asm volatile("" : "+s"(zi)); unsigned char* ws = args.ws + zi; float* out = args.out + zi; (void)out; (void)ws
#define INP(i) ((const float*)args.in[(i) + zi])
template <int l>
__device__ __forceinline__ void layer_phases(const Args& args, LAS unsigned char* L, const XcdBarrier& bar, int wid0, int vcu, int G, int bx, int lo, int hi) {
    constexpr int P = PH_L0 + l * PH_PER_LAYER;
    if (MK_IN_(P + 0)) { MK_PTRS();
        pg8::Gemm g{(bf16_t*)(ws + WS_A), (const bf16_t*)(ws + WS_W + (size_t)l * WL_STRIDE + WL_IN), T, NIN, DM}; pg8::StaticOrder S; S.init(T, NIN, G, bx);
        pg8::EpiIn E{(float*)(ws + WS_SSQ1), (float*)(ws + WS_SHW1) + (size_t)l * NB * NIN, INP(9) + l * QR, INP(10) + l * KVR, (float*)(ws + WS_ROPE), (bf16_t*)(ws + WS_U), (bf16_t*)(ws + WS_VN), (bf16_t*)(ws + WS_CQKV), (bf16_t*)(ws + WS_KR), (float*)(ws + WS_SSQQ)};
        pg8::gemm_phase<pg8::EpiIn, pg8::StaticOrder, true, true>(L, g, S, E, wid0); }
    MK_SEAM(P + 0);
    if (MK_IN_(P + 1)) { MK_PTRS();
        pg8::Gemm g{(bf16_t*)(ws + WS_CQKV), (const bf16_t*)(ws + WS_W + (size_t)l * WL_STRIDE + WL_UP), T, NUP, KUP}; pg8::StaticOrder S; S.init(T, NUP, G, bx);
        pg8::EpiUp E{(float*)(ws + WS_SSQQ), (float*)(ws + WS_ROPE), (bf16_t*)(ws + WS_Q), (bf16_t*)(ws + WS_KN), (bf16_t*)(ws + WS_V)};
        pg8::gemm_phase<pg8::EpiUp, pg8::StaticOrder, true, true>(L, g, S, E, wid0); }
    if (MK_IN_(P + 2)) { MK_PTRS();
        gm::gmlp_phase(L, wid0, vcu, (bf16_t*)(ws + WS_U), (bf16_t*)(ws + WS_VN), (bf16_t*)(ws + WS_GW) + (size_t)l * NGRP * CHUNK * CHUNK, INP(8) + l * NGRP * CHUNK, INP(13) + l * DG, (bf16_t*)(ws + WS_Y), (float*)(ws + WS_SSQY)); }
    MK_SEAM(P + 2);
    if (MK_IN_(P + 3)) { MK_PTRS();
        att::attn_phase((LAS char*)L, wid0, vcu, (bf16_t*)(ws + WS_Q), (bf16_t*)(ws + WS_KN), (bf16_t*)(ws + WS_KR), (bf16_t*)(ws + WS_V), INP(14) + l * DG, (bf16_t*)(ws + WS_Y), (float*)(ws + WS_SSQY)); }
    MK_SEAM(P + 3);
    if (MK_IN_(P + 4)) { MK_PTRS();
        pg8::Gemm g{(bf16_t*)(ws + WS_Y), (const bf16_t*)(ws + WS_W + (size_t)l * WL_STRIDE + WL_OUT), T, DM, DM}; pg8::StaticOrder S; S.init(T, DM, G, bx);
        pg8::EpiRes<true> E{(float*)(ws + WS_SSQY), l == 0 ? INP(0) : (const float*)out, out, (float*)(ws + WS_MOD) + (size_t)l * NB * NMOD + 2 * DM, (float*)(ws + WS_GM2) + (size_t)l * NB * DM, (bf16_t*)(ws + WS_A), (float*)(ws + WS_SSQ2)};
        pg8::gemm_phase<pg8::EpiRes<true>, pg8::StaticOrder, true, true>(L, g, S, E, wid0); }
    MK_SEAM(P + 4);
    if (MK_IN_(P + 5)) { MK_PTRS();
        pg8::Gemm g{(bf16_t*)(ws + WS_A), (const bf16_t*)(ws + WS_W + (size_t)l * WL_STRIDE + WL_1), T, DFF, DM}; pg8::StaticOrder S; S.init(T, DFF, G, bx);
        pg8::EpiFf1 E{(float*)(ws + WS_SSQ2), (float*)(ws + WS_SHW2) + (size_t)l * NB * DFF, (bf16_t*)(ws + WS_H)};
        pg8::gemm_phase<pg8::EpiFf1, pg8::StaticOrder, true, true>(L, g, S, E, wid0); }
    MK_SEAM(P + 5);
    if (MK_IN_(P + 6)) { MK_PTRS();
        pg8::Gemm g{(bf16_t*)(ws + WS_H), (const bf16_t*)(ws + WS_W + (size_t)l * WL_STRIDE + WL_2), T, DM, DFF}; pg8::StaticOrder S; S.init(T, DM, G, bx);
        pg8::EpiRes<false> E{nullptr, out, out, (float*)(ws + WS_MOD) + (size_t)l * NB * NMOD + 5 * DM, (l + 1 < DEPTH) ? (float*)(ws + WS_GM1) + (size_t)(l + 1) * NB * DM : nullptr, (bf16_t*)(ws + WS_A), (float*)(ws + WS_SSQ1)};
        pg8::gemm_phase<pg8::EpiRes<false>, pg8::StaticOrder, true, true>(L, g, S, E, wid0); }
    MK_SEAM(P + 6);
}
__global__ void __launch_bounds__(NWAVES * 64, 2) mk_fwd(Args args) {
    extern __shared__ __attribute__((aligned(16))) unsigned char lds[];
    LAS unsigned char* L = (LAS unsigned char*)lds;
    volatile LAS unsigned* MISC = (volatile LAS unsigned*)(L + MISC_OFF);
    const int wid0 = __builtin_amdgcn_readfirstlane((int)threadIdx.x >> 6);
    const int G = gridDim.x, bx = blockIdx.x, vcu = (G % 8 == 0) ? (bx % 8) * (G / 8) + bx / 8 : bx;
    { const int t0 = wid0 * 64 + lane_id(); for (int u = t0; u < (LDS_BYTES - LDSCTL_OFF) / 4; u += NWAVES * 64) ((LAS unsigned*)(L + LDSCTL_OFF))[u] = 0u; }
    __syncthreads();
    const int lo = __builtin_amdgcn_readfirstlane(args.ph_lo), hi = __builtin_amdgcn_readfirstlane(args.ph_hi);
    XcdBarrier bar; bar.bar = (unsigned*)(args.ws + WS_CTL) + CW_BAR; bar.x = 0; bar.st = nullptr;
    if (hi - lo > 1) bar = xcd_barrier_post((unsigned*)(args.ws + WS_CTL) + CW_BAR, MISC + 8, wid0);
    if (MK_IN_(PH_P0A)) { MK_PTRS(); pro::phase0a(L, wid0, vcu, G, args, zi, ws); }
    MK_SEAM(PH_P0A);
    if (MK_IN_(PH_P0B)) { MK_PTRS(); pro::phase0b(L, wid0, vcu, G, args, zi, ws); }
    MK_SEAM(PH_P0B);
    layer_phases<0>(args, L, bar, wid0, vcu, G, bx, lo, hi);
    layer_phases<1>(args, L, bar, wid0, vcu, G, bx, lo, hi);
    if (MK_IN_(PH_FINAL)) { MK_PTRS(); pro::phase_final(wid0, vcu, G, INP(19), out); }
}

#ifndef ONE_LAUNCH
#define ONE_LAUNCH 1
#endif
#ifndef MK_PRO
#define MK_PRO 1
#endif
#ifndef MK_IN
#define MK_IN 1
#endif
#ifndef MK_UP
#define MK_UP 1
#endif
#ifndef MK_GMLP
#define MK_GMLP 1
#endif
#ifndef MK_ATTN
#define MK_ATTN 1
#endif
#ifndef MK_OUT
#define MK_OUT 1
#endif
#ifndef MK_FF1
#define MK_FF1 1
#endif
#ifndef MK_FF2
#define MK_FF2 1
#endif
template <class Epi> static void gemm_naive(hipStream_t st, const bf16_t* A, int lda, const bf16_t* Bt, int ldb, int M, int N, int K, const Epi& e) {
    hipLaunchKernelGGL((k_gemm_naive<Epi>), dim3(N / 64, M / 64), dim3(256), 0, st, A, lda, Bt, ldb, K, e);
}
static int g_grid = 0;
static void launch_mk(hipStream_t st, Args a, int lo, int hi) {
    a.ph_lo = lo; a.ph_hi = hi;
    hipLaunchKernelGGL(mk_fwd, dim3(g_grid), dim3(NWAVES * 64), LDS_BYTES, st, a);
}
extern "C" void kernel_launch(void* const* d_in, const int* in_sizes, int n_in, void* d_out, int out_size, void* d_ws, size_t ws_size, hipStream_t stream) {
    if (n_in != 20 || out_size != T * DM || ws_size < WS_END) { fprintf(stderr, "kernel_launch: unexpected sizes n_in %d out %d ws %zu\n", n_in, out_size, ws_size); return; }
    if (g_grid == 0) {
        int dev = 0, cus = 0; hipGetDevice(&dev); hipDeviceGetAttribute(&cus, hipDeviceAttributeMultiprocessorCount, dev);
        if (hipFuncSetAttribute((const void*)mk_fwd, hipFuncAttributeMaxDynamicSharedMemorySize, LDS_BYTES) != hipSuccess) fprintf(stderr, "kernel_launch: hipFuncSetAttribute failed\n");
        g_grid = cus > 0 ? cus : 256;
    }
    const float* x = (const float*)d_in[0]; const float* c = (const float*)d_in[1]; const int* pos = (const int*)d_in[2];
    const float* w_ada = (const float*)d_in[3]; const float* b_ada = (const float*)d_in[4]; const float* g_mix = (const float*)d_in[5];
    const float* w_in = (const float*)d_in[6]; const float* g_ws = (const float*)d_in[7]; const float* g_bs = (const float*)d_in[8];
    const float* g_q = (const float*)d_in[9]; const float* g_kv = (const float*)d_in[10]; const float* w_uq = (const float*)d_in[11]; const float* w_ukv = (const float*)d_in[12];
    const float* g_og = (const float*)d_in[13]; const float* g_oa = (const float*)d_in[14]; const float* w_out = (const float*)d_in[15];
    const float* g_ffn = (const float*)d_in[16]; const float* w_ff1 = (const float*)d_in[17]; const float* w_ff2 = (const float*)d_in[18]; const float* g_fin = (const float*)d_in[19];
    unsigned char* ws = (unsigned char*)d_ws; float* out = (float*)d_out;
    float* MOD = (float*)(ws + WS_MOD); float* SHW1 = (float*)(ws + WS_SHW1); float* SHW2 = (float*)(ws + WS_SHW2); float* RT = (float*)(ws + WS_ROPE);
    float* GM1 = (float*)(ws + WS_GM1); float* GM2 = (float*)(ws + WS_GM2);
    float* SSQ1 = (float*)(ws + WS_SSQ1); float* SSQ2 = (float*)(ws + WS_SSQ2); float* SSQY = (float*)(ws + WS_SSQY); float* SSQQ = (float*)(ws + WS_SSQQ);
    bf16_t* GW = (bf16_t*)(ws + WS_GW); bf16_t* A = (bf16_t*)(ws + WS_A); bf16_t* U = (bf16_t*)(ws + WS_U); bf16_t* VN = (bf16_t*)(ws + WS_VN);
    bf16_t* CQKV = (bf16_t*)(ws + WS_CQKV); bf16_t* KR = (bf16_t*)(ws + WS_KR); bf16_t* Q = (bf16_t*)(ws + WS_Q); bf16_t* KN = (bf16_t*)(ws + WS_KN); bf16_t* V = (bf16_t*)(ws + WS_V);
    bf16_t* Y = (bf16_t*)(ws + WS_Y); bf16_t* H = (bf16_t*)(ws + WS_H); float* GV = (float*)(ws + WS_GV); float* ZL = (float*)(ws + WS_ZL); float* QRT = (float*)(ws + WS_QRT);
    auto WL = [&](int l, size_t off) { return (bf16_t*)(ws + WS_W + (size_t)l * WL_STRIDE + off); };
    Args a{}; for (int i = 0; i < 20; ++i) a.in[i] = d_in[i]; a.out = out; a.ws = ws;
    hipMemsetAsync(ws + WS_CTL, 0, CTL_ZERO_BYTES, stream);

#if ONE_LAUNCH
    launch_mk(stream, a, 0, PH_END);
    return;
#endif
#if MK_PRO
    launch_mk(stream, a, PH_P0A, PH_P0A + 1);
    launch_mk(stream, a, PH_P0B, PH_P0B + 1);
#else
    hipLaunchKernelGGL(k_rope_table, dim3(T * 16 / 256), dim3(256), 0, stream, pos, RT);
    hipLaunchKernelGGL(k_prep_gw, dim3(DEPTH * NGRP * CHUNK * CHUNK / 256), dim3(256), 0, stream, g_ws, GW);
    for (int l = 0; l < DEPTH; ++l) {
        hipLaunchKernelGGL(k_prep_w, dim3((NIN * DM + 255) / 256), dim3(256), 0, stream, w_in + (size_t)l * DM * DIN, DM, DIN, WL(l, WL_IN), NIN, 1);
        hipLaunchKernelGGL(k_prep_wup, dim3((NUP * KUP + 255) / 256), dim3(256), 0, stream, w_uq + (size_t)l * QR * 768, w_ukv + (size_t)l * KVR * 1024, WL(l, WL_UP));
        hipLaunchKernelGGL(k_prep_w, dim3(DM * DM / 256), dim3(256), 0, stream, w_out + (size_t)l * DM * DM, DM, DM, WL(l, WL_OUT), DM, 0);
        hipLaunchKernelGGL(k_prep_w, dim3(DFF * DM / 256), dim3(256), 0, stream, w_ff1 + (size_t)l * DM * DFF, DM, DFF, WL(l, WL_1), DFF, 0);
        hipLaunchKernelGGL(k_prep_w, dim3(DFF * DM / 256), dim3(256), 0, stream, w_ff2 + (size_t)l * DFF * DM, DFF, DM, WL(l, WL_2), DM, 0);
        hipLaunchKernelGGL(k_smallm, dim3(NMOD / 64), dim3(512), 0, stream, c, DM, 1, w_ada + (size_t)l * DM * NMOD, NMOD, NMOD, 0, b_ada + (size_t)l * NMOD, MOD + (size_t)l * NB * NMOD, NMOD, NMOD);
    }
    for (int l = 0; l < DEPTH; ++l) {
        hipLaunchKernelGGL(k_smallm, dim3(NIN / 64), dim3(512), 0, stream, MOD + (size_t)l * NB * NMOD + 0, NMOD, 0, w_in + (size_t)l * DM * DIN, DIN, DIN, 1, (const float*)nullptr, SHW1 + (size_t)l * NB * NIN, NIN, NIN);
        hipLaunchKernelGGL(k_smallm, dim3(DFF / 64), dim3(512), 0, stream, MOD + (size_t)l * NB * NMOD + 3 * DM, NMOD, 0, w_ff1 + (size_t)l * DM * DFF, DFF, DFF, 0, (const float*)nullptr, SHW2 + (size_t)l * NB * DFF, DFF, DFF);
    }
    hipLaunchKernelGGL(k_gm, dim3(DEPTH * NB * DM / 256), dim3(256), 0, stream, g_mix, MOD, 1, GM1);
    hipLaunchKernelGGL(k_gm, dim3(DEPTH * NB * DM / 256), dim3(256), 0, stream, g_ffn, MOD, 4, GM2);
    hipLaunchKernelGGL(k_modx, dim3(T / 4), dim3(256), 0, stream, x, g_mix, MOD + 1 * DM, NMOD, A, SSQ1);

#endif
    for (int l = 0; l < DEPTH; ++l) {
        const float* modl = MOD + (size_t)l * NB * NMOD; const int P = PH_L0 + l * PH_PER_LAYER;
#if MK_IN
        launch_mk(stream, a, P + 0, P + 1);
#else
        { EpiInNaive e{0, SSQ1, SHW1 + (size_t)l * NB * NIN, U, GV, ZL}; gemm_naive(stream, A, DM, WL(l, WL_IN), DM, T, NIN, DM, e); }
        hipLaunchKernelGGL(k_vn, dim3(T * NGRP / 4), dim3(256), 0, stream, GV, VN);
        hipLaunchKernelGGL(k_lat, dim3(T / 4), dim3(256), 0, stream, ZL, g_q + l * QR, g_kv + l * KVR, RT, CQKV, SSQQ, KR);
#endif
#if MK_UP
        launch_mk(stream, a, P + 1, P + 2);
#else
        { EpiUpNaive e{0, SSQQ, Q, QRT, KN, V}; gemm_naive(stream, CQKV, KUP, WL(l, WL_UP), KUP, T, NUP, KUP, e); }
        hipLaunchKernelGGL(k_rope_q, dim3(T * NH * 16 / 256), dim3(256), 0, stream, QRT, RT, Q);
#endif
#if MK_GMLP
        launch_mk(stream, a, P + 2, P + 3);
#else
        hipLaunchKernelGGL(k_gmlp_naive, dim3(T), dim3(512), 0, stream, U, VN, GW + (size_t)l * NGRP * CHUNK * CHUNK, g_bs + l * NGRP * CHUNK, g_og + l * DG, Y, SSQY);
#endif
#if MK_ATTN
        launch_mk(stream, a, P + 3, P + 4);
#else
        hipLaunchKernelGGL(k_attn_naive, dim3(T / 64, NH), dim3(64), 0, stream, Q, KN, KR, V, g_oa + l * DG, Y, SSQY);
#endif
#if MK_OUT
        launch_mk(stream, a, P + 4, P + 5);
#else
        { EpiOutNaive e{512, SSQY, l == 0 ? x : out, out, modl + 2 * DM}; gemm_naive(stream, Y, DM, WL(l, WL_OUT), DM, T, DM, DM, e); }
        hipLaunchKernelGGL(k_modx, dim3(T / 4), dim3(256), 0, stream, out, g_ffn + l * DM, modl + 4 * DM, NMOD, A, SSQ2);
#endif
#if MK_FF1
        launch_mk(stream, a, P + 5, P + 6);
#else
        { EpiFf1Naive e{0, SSQ2, SHW2 + (size_t)l * NB * DFF, H}; gemm_naive(stream, A, DM, WL(l, WL_1), DM, T, DFF, DM, e); }
#endif
#if MK_FF2
        launch_mk(stream, a, P + 6, P + 7);
#else
        { EpiFf2Naive e{0, out, modl + 5 * DM}; gemm_naive(stream, H, DFF, WL(l, WL_2), DFF, T, DM, DFF, e); }
        if (l + 1 < DEPTH) hipLaunchKernelGGL(k_modx, dim3(T / 4), dim3(256), 0, stream, out, g_mix + (l + 1) * DM, MOD + (size_t)(l + 1) * NB * NMOD + 1 * DM, NMOD, A, SSQ1);
#endif
    }
#if MK_PRO
    launch_mk(stream, a, PH_FINAL, PH_FINAL + 1);
#else
    hipLaunchKernelGGL(k_final, dim3(T / 4), dim3(256), 0, stream, out, g_fin, out);
#endif
}
```

```cpp
#include <hip/hip_runtime.h>
#define PROBE_MULT 8
#include <cstdint>
#include <cstdio>
#include <cmath>

typedef unsigned short bf16_t;
typedef short bf16x8 __attribute__((ext_vector_type(8)));
typedef float f32x4 __attribute__((ext_vector_type(4)));

constexpr int DM = 1024, NB = 16, SEQ = 2048, DEPTH = 2, T = NB * SEQ;
constexpr int DG = 512, NGRP = 8, GD = 64, CHUNK = 128, NH = 8, NOPE = 64, ROPE = 32, VD = 64;
constexpr int QR = 256, KVR = 128, DFF = 4096, DIN = 1440, NMOD = 6 * DM;
constexpr int NIN = 1536;
constexpr int NUP = 1792, KUP = 384;
constexpr float EPS = 1e-6f;
constexpr float QSCALE = 0.10206207261596577f * 1.4426950408889634f;

constexpr size_t MiB = 1u << 20;
constexpr size_t WS_CTL = 0;
constexpr size_t WS_MOD = 1 * MiB;
constexpr size_t WS_SHW1 = 2 * MiB;
constexpr size_t WS_GM1 = 2 * MiB + 512 * 1024;
constexpr size_t WS_GM2 = 2 * MiB + 768 * 1024;
constexpr size_t WS_SHW2 = 3 * MiB;
constexpr size_t WS_ROPE = 4 * MiB;
constexpr size_t WS_SSQ1 = 8 * MiB;
constexpr size_t WS_SSQ2 = 10 * MiB;
constexpr size_t WS_SSQY = 12 * MiB;
constexpr size_t WS_SSQQ = 14 * MiB;
constexpr size_t WS_GW = 15 * MiB;
constexpr size_t WS_W = 16 * MiB;
constexpr size_t WL_IN = 0, WL_UP = 3 * MiB, WL_OUT = 4 * MiB + MiB / 2, WL_1 = 6 * MiB + MiB / 2, WL_2 = 14 * MiB + MiB / 2, WL_STRIDE = 22 * MiB + MiB / 2;
constexpr size_t WS_A = 64 * MiB;
constexpr size_t WS_U = 128 * MiB;
constexpr size_t WS_VN = 160 * MiB;
constexpr size_t WS_CQKV = 192 * MiB;
constexpr size_t WS_KR = 216 * MiB;
constexpr size_t WS_Q = 218 * MiB;
constexpr size_t WS_KN = 266 * MiB;
constexpr size_t WS_V = 298 * MiB;
constexpr size_t WS_Y = 330 * MiB;
constexpr size_t WS_H = 128 * MiB;
constexpr size_t WS_GV = 394 * MiB;
constexpr size_t WS_ZL = 458 * MiB;
constexpr size_t WS_QRT = 394 * MiB;
constexpr size_t WS_DUMMY = 384 * MiB;
constexpr size_t WS_END = 512 * MiB;

__device__ __forceinline__ bf16_t f2bf(float f) { unsigned u = __float_as_uint(f); return (bf16_t)((u + 0x7fffu + ((u >> 16) & 1u)) >> 16); }
__device__ __forceinline__ float bf2f(bf16_t h) { return __uint_as_float(((unsigned)h) << 16); }
__device__ __forceinline__ float gelu_tanh(float x) { const float y2 = -2.302208198f * (x + 0.044715f * x * x * x); return x * __builtin_amdgcn_rcpf(1.f + __builtin_amdgcn_exp2f(y2)); }
__device__ __forceinline__ float wave_sum(float v) {
#pragma unroll
    for (int o = 1; o < 64; o <<= 1) v += __shfl_xor(v, o);
    return v;
}
__host__ __device__ __forceinline__ int win_src(int p) {
    if (p < 512) return p;
    if (p < 1024) { const int q = p - 512, tile = q >> 8, r = q & 255, bj = r >> 7, wc = (r >> 5) & 3, j = r & 31; return 512 + tile * 256 + 64 * wc + 32 * bj + j; }
    if (p < 1408) return p;
    if (p < 1440) { const int j = p - 1408, fq = j >> 3, n = (j >> 2) & 1, i = j & 3; return 1408 + 16 * n + 4 * fq + i; }
    return -1;
}
__host__ __device__ __forceinline__ int wup_qcol(int p) {
    const int G = p >> 5, h = G / 3, gi = G - 3 * h, j = p & 31;
    if (gi < 2) return p;
    const int fq = j >> 3, n = (j >> 2) & 1, i = j & 3; return h * 96 + 64 + 16 * n + 4 * fq + i;
}

__global__ void k_rope_table(const int* pos, float* rope) {
    const int idx = blockIdx.x * blockDim.x + threadIdx.x; if (idx >= T * 16) return;
    const int t = idx >> 4, i = idx & 15;
    const float freq = powf(10000.0f, -(float)(2 * i) / 32.0f);
    const float ang = (float)pos[t] * freq;
    rope[t * 32 + i] = cosf(ang); rope[t * 32 + 16 + i] = sinf(ang);
}
__global__ void k_prep_w(const float* W, int K, int N, bf16_t* out, int Nphys, int mode) {
    const size_t idx = (size_t)blockIdx.x * blockDim.x + threadIdx.x; if (idx >= (size_t)Nphys * K) return;
    const int p = (int)(idx / K), k = (int)(idx % K);
    const int s = mode == 1 ? win_src(p) : p;
    out[idx] = (s >= 0 && s < N) ? f2bf(W[(size_t)k * N + s]) : (bf16_t)0;
}
__global__ void k_prep_wup(const float* wuq, const float* wukv, bf16_t* out) {
    const int idx = blockIdx.x * blockDim.x + threadIdx.x; if (idx >= NUP * KUP) return;
    const int p = idx / KUP, k = idx % KUP; float v = 0.f;
    if (p < 768) { if (k < 256) v = wuq[(size_t)k * 768 + wup_qcol(p)]; }
    else { if (k >= 256) v = wukv[(size_t)(k - 256) * 1024 + (p - 768)]; }
    out[idx] = f2bf(v);
}
__global__ void k_prep_gw(const float* ws, bf16_t* gw) {
    const int idx = blockIdx.x * blockDim.x + threadIdx.x; if (idx >= DEPTH * NGRP * CHUNK * CHUNK) return;
    const int s = idx & 127, t = (idx >> 7) & 127;
    gw[idx] = (s <= t) ? f2bf(ws[idx]) : (bf16_t)0;
}
__global__ __launch_bounds__(512) void k_smallm(const float* in, int in_stride, int act, const float* W, int ldw, int N, int mode, const float* bias, float* out, int out_stride, int Nphys) {
    __shared__ float sin_[1024 * 16];
    __shared__ float red[8 * 64 * 16];
    const int tid = threadIdx.x, lane = tid & 63, wave = tid >> 6;
    for (int e = tid; e < 16 * 1024; e += 512) { const int b = e >> 10, k = e & 1023; float v = in[(size_t)b * in_stride + k]; if (act) v = v / (1.f + __expf(-v)); sin_[k * 16 + b] = v; }
    __syncthreads();
    const int p = blockIdx.x * 64 + lane; const int s = (p < Nphys) ? (mode == 1 ? win_src(p) : p) : -1; const bool ok = (s >= 0 && s < N);
    float acc[16];
#pragma unroll
    for (int b = 0; b < 16; ++b) acc[b] = 0.f;
    for (int k = wave * 128; k < wave * 128 + 128; ++k) {
        const float w = ok ? W[(size_t)k * ldw + s] : 0.f;
        const f32x4* sp = (const f32x4*)(sin_ + k * 16);
#pragma unroll
        for (int q = 0; q < 4; ++q) { const f32x4 v = sp[q]; acc[4 * q] += v[0] * w; acc[4 * q + 1] += v[1] * w; acc[4 * q + 2] += v[2] * w; acc[4 * q + 3] += v[3] * w; }
    }
#pragma unroll
    for (int b = 0; b < 16; ++b) red[(wave * 64 + lane) * 16 + b] = acc[b];
    __syncthreads();
    for (int e = tid; e < 64 * 16; e += 512) { const int l = e >> 4, b = e & 15; float sum = 0.f;
#pragma unroll
        for (int w = 0; w < 8; ++w) sum += red[(w * 64 + l) * 16 + b];
        const int pp = blockIdx.x * 64 + l; if (pp < Nphys) out[(size_t)b * out_stride + pp] = sum + (bias ? bias[pp] : 0.f); }
}
__global__ __launch_bounds__(256) void k_modx(const float* x, const float* g, const float* sc  , int sc_stride, bf16_t* A, float* ssq) {
    const int row = blockIdx.x * 4 + (threadIdx.x >> 6), lane = threadIdx.x & 63; if (row >= T) return;
    const int b = row / SEQ; const f32x4* xr = (const f32x4*)(x + (size_t)row * DM); float s = 0.f;
#pragma unroll
    for (int j = 0; j < 4; ++j) { const f32x4 v = xr[lane + 64 * j]; s += v[0] * v[0] + v[1] * v[1] + v[2] * v[2] + v[3] * v[3];
        const int c = 4 * (lane + 64 * j); const f32x4 gv = *(const f32x4*)(g + c), sv = *(const f32x4*)(sc + (size_t)b * sc_stride + c);
        unsigned lo = f2bf(v[0] * gv[0] * (1.f + sv[0])) | ((unsigned)f2bf(v[1] * gv[1] * (1.f + sv[1])) << 16);
        unsigned hi = f2bf(v[2] * gv[2] * (1.f + sv[2])) | ((unsigned)f2bf(v[3] * gv[3] * (1.f + sv[3])) << 16);
        *(uint2*)(A + (size_t)row * DM + c) = make_uint2(lo, hi); }
    s = wave_sum(s);
    if (lane < 16) ssq[(size_t)row * 16 + lane] = (lane == 0) ? s : 0.f;
}
__global__ __launch_bounds__(256) void k_final(const float* x, const float* g, float* out) {
    const int row = blockIdx.x * 4 + (threadIdx.x >> 6), lane = threadIdx.x & 63; if (row >= T) return;
    const f32x4* xr = (const f32x4*)(x + (size_t)row * DM); f32x4 v[4]; float s = 0.f;
#pragma unroll
    for (int j = 0; j < 4; ++j) { v[j] = xr[lane + 64 * j]; s += v[j][0] * v[j][0] + v[j][1] * v[j][1] + v[j][2] * v[j][2] + v[j][3] * v[j][3]; }
    const float rstd = rsqrtf(wave_sum(s) * (1.f / DM) + EPS);
#pragma unroll
    for (int j = 0; j < 4; ++j) { const int c = 4 * (lane + 64 * j); const f32x4 gv = *(const f32x4*)(g + c); *(f32x4*)(out + (size_t)row * DM + c) = v[j] * rstd * gv; }
}

template <class Epi>
__global__ __launch_bounds__(256) void k_gemm_naive(const bf16_t* A, int lda, const bf16_t* Bt, int ldb, int K, Epi epi) {
    const int wave = threadIdx.x >> 6, lane = threadIdx.x & 63, fr = lane & 15, fq = lane >> 4;
    const int row0 = blockIdx.y * 64 + wave * 16, col0 = blockIdx.x * 64;
    f32x4 acc[4];
#pragma unroll
    for (int n = 0; n < 4; ++n) acc[n] = (f32x4){0.f, 0.f, 0.f, 0.f};
    const bf16_t* ap = A + (size_t)(row0 + fr) * lda + 8 * fq;
    const bf16_t* bp = Bt + (size_t)(col0 + fr) * ldb + 8 * fq;
    for (int k0 = 0; k0 < K; k0 += 32) {
        if (Epi::HAS_MID) { if (k0 == epi.ksplit) {
#pragma unroll
            for (int r = 0; r < 4; ++r) { const float m = epi.mid(row0 + 4 * fq + r);
#pragma unroll
                for (int n = 0; n < 4; ++n) acc[n][r] *= m; } } }
        const bf16x8 a = *(const bf16x8*)(ap + k0);
#pragma unroll
        for (int n = 0; n < 4; ++n) { const bf16x8 b = *(const bf16x8*)(bp + (size_t)n * 16 * ldb + k0); acc[n] = __builtin_amdgcn_mfma_f32_16x16x32_bf16(a, b, acc[n], 0, 0, 0); }
    }
#pragma unroll
    for (int r = 0; r < 4; ++r) { const int row = row0 + 4 * fq + r; const float rs = epi.rowscale(row);
#pragma unroll
        for (int n = 0; n < 4; ++n) epi(row, col0 + 16 * n + fr, acc[n][r], rs); }
}
__device__ __forceinline__ float sum16(const float* p) { float s = 0.f;
#pragma unroll
    for (int i = 0; i < 16; ++i) s += p[i]; return s; }
__device__ __forceinline__ float sum8(const float* p) { float s = 0.f;
#pragma unroll
    for (int i = 0; i < 8; ++i) s += p[i]; return s; }
__device__ __forceinline__ float sum4(const float* p) { return (p[0] + p[1]) + (p[2] + p[3]); }

struct EpiInNaive {
    static constexpr bool HAS_MID = false; int ksplit;
    const float* ssq1; const float* shw1; bf16_t* U; float* GV; float* ZL;
    __device__ float mid(int) const { return 1.f; }
    __device__ float rowscale(int row) const { return rsqrtf(sum16(ssq1 + (size_t)row * 16) * (1.f / DM) + EPS); }
    __device__ void operator()(int row, int p, float acc, float rs) const {
        const int L = win_src(p); if (L < 0) return;
        const float z = rs * acc + shw1[(row / SEQ) * NIN + p];
        if (L < 512) U[(size_t)row * 512 + L] = f2bf(gelu_tanh(z));
        else if (L < 1024) GV[(size_t)row * 512 + (L - 512)] = gelu_tanh(z);
        else ZL[(size_t)row * 416 + (L - 1024)] = z;
    }
};
struct EpiUpNaive {
    static constexpr bool HAS_MID = false; int ksplit;
    const float* ssqq; bf16_t* Q; float* QRT; bf16_t* KN; bf16_t* V;
    __device__ float mid(int) const { return 1.f; }
    __device__ float rowscale(int) const { return 1.f; }
    __device__ void operator()(int row, int p, float acc, float) const {
        if (p < 768) { const float rq = rsqrtf(sum4(ssqq + (size_t)row * 8) * (1.f / QR) + EPS); const float v = acc * rq * QSCALE;
            const int L = wup_qcol(p), h = L / 96, d = L - 96 * h;
            if (d < 64) Q[(size_t)row * 768 + L] = f2bf(v); else QRT[(size_t)row * 256 + h * 32 + (d - 64)] = v; }
        else { const float rk = rsqrtf(sum4(ssqq + (size_t)row * 8 + 4) * (1.f / KVR) + EPS); const float v = acc * rk;
            const int c = p - 768, h = c >> 7, d = c & 127;
            if (d < 64) KN[(size_t)row * 512 + h * 64 + d] = f2bf(v); else V[(size_t)row * 512 + h * 64 + (d - 64)] = f2bf(v); }
    }
};
struct EpiOutNaive {
    static constexpr bool HAS_MID = true; int ksplit;
    const float* ssqy; const float* xin; float* xout; const float* gate;
    __device__ float rg(int row) const { return rsqrtf(sum8(ssqy + (size_t)row * 16) * (1.f / 512) + EPS); }
    __device__ float ra(int row) const { return rsqrtf(sum8(ssqy + (size_t)row * 16 + 8) * (1.f / 512) + EPS); }
    __device__ float mid(int row) const { return rg(row) / ra(row); }
    __device__ float rowscale(int row) const { return ra(row); }
    __device__ void operator()(int row, int n, float acc, float rs) const {
        const size_t i = (size_t)row * DM + n; xout[i] = xin[i] + gate[(size_t)(row / SEQ) * NMOD + n] * (rs * acc);
    }
};
struct EpiFf1Naive {
    static constexpr bool HAS_MID = false; int ksplit;
    const float* ssq2; const float* shw2; bf16_t* H;
    __device__ float mid(int) const { return 1.f; }
    __device__ float rowscale(int row) const { return rsqrtf(sum16(ssq2 + (size_t)row * 16) * (1.f / DM) + EPS); }
    __device__ void operator()(int row, int n, float acc, float rs) const {
        const float z = rs * acc + shw2[(row / SEQ) * DFF + n]; const float r = fmaxf(z, 0.f); H[(size_t)row * DFF + n] = f2bf(r * r);
    }
};
struct EpiFf2Naive {
    static constexpr bool HAS_MID = false; int ksplit;
    float* x; const float* gate;
    __device__ float mid(int) const { return 1.f; }
    __device__ float rowscale(int) const { return 1.f; }
    __device__ void operator()(int row, int n, float acc, float) const {
        const size_t i = (size_t)row * DM + n; x[i] = x[i] + gate[(size_t)(row / SEQ) * NMOD + n] * acc;
    }
};

__global__ __launch_bounds__(256) void k_vn(const float* GV, bf16_t* VN) {
    const int w = blockIdx.x * 4 + (threadIdx.x >> 6), lane = threadIdx.x & 63; if (w >= T * NGRP) return;
    const int row = w >> 3, g = w & 7; const float v = GV[(size_t)row * 512 + g * 64 + lane];
    const float mu = wave_sum(v) * (1.f / 64); const float d = v - mu; const float var = wave_sum(d * d) * (1.f / 64);
    VN[(size_t)row * 512 + g * 64 + lane] = f2bf(d * rsqrtf(var + EPS));
}
__global__ __launch_bounds__(256) void k_lat(const float* ZL, const float* gq, const float* gkv, const float* rope, bf16_t* CQKV, float* ssqq, bf16_t* KR) {
    const int row = blockIdx.x * 4 + (threadIdx.x >> 6), lane = threadIdx.x & 63; if (row >= T) return;
    const float* z = ZL + (size_t)row * 416; float sq = 0.f, sk = 0.f;
#pragma unroll
    for (int j = 0; j < 4; ++j) { const int c = lane + 64 * j; const float v = z[c]; sq += v * v; CQKV[(size_t)row * KUP + c] = f2bf(v * gq[c]); }
#pragma unroll
    for (int j = 0; j < 2; ++j) { const int c = lane + 64 * j; const float v = z[256 + c]; sk += v * v; CQKV[(size_t)row * KUP + 256 + c] = f2bf(v * gkv[c]); }
    sq = wave_sum(sq); sk = wave_sum(sk);
    if (lane < 8) ssqq[(size_t)row * 8 + lane] = (lane == 0) ? sq : (lane == 4) ? sk : 0.f;
    if (lane < 16) { const float x1 = z[384 + lane], x2 = z[384 + 16 + lane], c = rope[(size_t)row * 32 + lane], s = rope[(size_t)row * 32 + 16 + lane];
        KR[(size_t)row * 32 + lane] = f2bf(x1 * c - x2 * s); KR[(size_t)row * 32 + 16 + lane] = f2bf(x1 * s + x2 * c); }
}
__global__ void k_rope_q(const float* QRT, const float* rope, bf16_t* Q) {
    const int idx = blockIdx.x * blockDim.x + threadIdx.x; if (idx >= T * NH * 16) return;
    const int r = idx & 15, h = (idx >> 4) & 7, row = idx >> 7;
    const float x1 = QRT[(size_t)row * 256 + h * 32 + r], x2 = QRT[(size_t)row * 256 + h * 32 + 16 + r], c = rope[(size_t)row * 32 + r], s = rope[(size_t)row * 32 + 16 + r];
    Q[(size_t)row * 768 + h * 96 + 64 + r] = f2bf(x1 * c - x2 * s); Q[(size_t)row * 768 + h * 96 + 80 + r] = f2bf(x1 * s + x2 * c);
}
__global__ __launch_bounds__(512) void k_gmlp_naive(const bf16_t* U, const bf16_t* VN, const bf16_t* GW  , const float* bs  , const float* gog, bf16_t* Y, float* ssqy) {
    const int row = blockIdx.x, g = threadIdx.x >> 6, d = threadIdx.x & 63, c = g * 64 + d;
    const int tt = row & 127, t0 = row - tt;
    const bf16_t* w = GW + ((size_t)g * CHUNK + tt) * CHUNK; float sum = 0.f;
    for (int s = 0; s <= tt; ++s) sum += bf2f(w[s]) * bf2f(VN[(size_t)(t0 + s) * 512 + c]);
    const float y = bf2f(U[(size_t)row * 512 + c]) * (sum + bs[g * CHUNK + tt]);
    Y[(size_t)row * DM + c] = f2bf(y * gog[c]);
    const float q = wave_sum(y * y); if (d == 0) ssqy[(size_t)row * 16 + g] = q;
}
__global__ __launch_bounds__(64) void k_attn_naive(const bf16_t* Q, const bf16_t* KN, const bf16_t* KR, const bf16_t* V, const float* goa, bf16_t* Y, float* ssqy) {
    const int h = blockIdx.y, row = blockIdx.x * 64 + threadIdx.x, b = row / SEQ, i = row - b * SEQ;
    const int iend = (blockIdx.x * 64 % SEQ) + 63;
    float q[96];
#pragma unroll
    for (int d8 = 0; d8 < 12; ++d8) { const bf16x8 v = *(const bf16x8*)(Q + (size_t)row * 768 + h * 96 + d8 * 8);
#pragma unroll
        for (int j = 0; j < 8; ++j) q[d8 * 8 + j] = bf2f((bf16_t)v[j]); }
    float o[64];
#pragma unroll
    for (int d = 0; d < 64; ++d) o[d] = 0.f;
    float m = -1e30f, l = 0.f;
    const size_t kb = (size_t)b * SEQ;
    for (int j = 0; j <= iend; ++j) {
        const bf16_t* kn = KN + (kb + j) * 512 + h * 64; const bf16_t* kr = KR + (kb + j) * 32; const bf16_t* vv = V + (kb + j) * 512 + h * 64;
        float s = 0.f;
#pragma unroll
        for (int d8 = 0; d8 < 8; ++d8) { const bf16x8 kv = *(const bf16x8*)(kn + d8 * 8);
#pragma unroll
            for (int jj = 0; jj < 8; ++jj) s += q[d8 * 8 + jj] * bf2f((bf16_t)kv[jj]); }
#pragma unroll
        for (int d8 = 0; d8 < 4; ++d8) { const bf16x8 kv = *(const bf16x8*)(kr + d8 * 8);
#pragma unroll
            for (int jj = 0; jj < 8; ++jj) s += q[64 + d8 * 8 + jj] * bf2f((bf16_t)kv[jj]); }
        if (j > i) s = -1e30f;
        const float mn = fmaxf(m, s), alpha = exp2f(m - mn), p = (j > i) ? 0.f : exp2f(s - mn);
        l = l * alpha + p; m = mn;
#pragma unroll
        for (int d8 = 0; d8 < 8; ++d8) { const bf16x8 v8 = *(const bf16x8*)(vv + d8 * 8);
#pragma unroll
            for (int jj = 0; jj < 8; ++jj) o[d8 * 8 + jj] = o[d8 * 8 + jj] * alpha + p * bf2f((bf16_t)v8[jj]); }
    }
    const float inv = 1.f / l; float sq = 0.f;
#pragma unroll
    for (int d8 = 0; d8 < 8; ++d8) { unsigned w[4];
#pragma unroll
        for (int jj = 0; jj < 8; jj += 2) { const float y0 = o[d8 * 8 + jj] * inv, y1 = o[d8 * 8 + jj + 1] * inv; sq += y0 * y0 + y1 * y1;
            w[jj >> 1] = f2bf(y0 * goa[h * 64 + d8 * 8 + jj]) | ((unsigned)f2bf(y1 * goa[h * 64 + d8 * 8 + jj + 1]) << 16); }
        *(uint4*)(Y + (size_t)row * DM + 512 + h * 64 + d8 * 8) = make_uint4(w[0], w[1], w[2], w[3]); }
    ssqy[(size_t)row * 16 + 8 + h] = sq;
}

__global__ void k_gm(const float* g  , const float* mod, int chunk, float* gmt) {
    const int idx = blockIdx.x * blockDim.x + threadIdx.x; if (idx >= DEPTH * NB * DM) return;
    const int c = idx & 1023, b = (idx >> 10) & 15, l = idx >> 14;
    gmt[idx] = g[l * DM + c] * (1.f + mod[((size_t)l * NB + b) * NMOD + chunk * DM + c]);
}
__device__ __forceinline__ int lane_id() { int l; asm volatile("v_mbcnt_lo_u32_b32 %0, -1, 0\n\tv_mbcnt_hi_u32_b32 %0, -1, %0" : "=v"(l)); return l; }
__device__ __forceinline__ float swz_xor16(float v) { return __int_as_float(__builtin_amdgcn_ds_swizzle(__float_as_int(v), 0x401F)); }
__device__ __forceinline__ float swz_xor1(float v) { return __int_as_float(__builtin_amdgcn_ds_swizzle(__float_as_int(v), 0x041F)); }
namespace pg8 {
#define PG8_LAS __attribute__((address_space(3)))
typedef unsigned u32x4 __attribute__((ext_vector_type(4)));
typedef unsigned u32x2 __attribute__((ext_vector_type(2)));
constexpr int BM = 256, BK = 64, HALF = 128, HTB = HALF * BK * 2  , STAGE_BYTES = 8 * HTB, NXCD = 8, WGM = 8;

__host__ __device__ __forceinline__ int lds_byte(int r, int c) { const int st = (r >> 4) * 2 + (c >> 5), rr = r & 15, cc = c & 31, ob = rr * 64 + cc * 2; return st * 1024 + (ob ^ (((ob >> 9) & 1) << 5)); }
__host__ __device__ __forceinline__ void stage_rc(int b, int& R, int& C) { const int st = b / 1024, sb = b % 1024, swz = sb ^ (((sb >> 9) & 1) << 5); R = (st >> 1) * 16 + swz / 64; C = (st & 1) * 32 + (swz % 64) / 2; }
__host__ __device__ __forceinline__ int perm32(int rho) { const int n = rho >> 4, i = rho & 15; return 8 * (i >> 2) + 4 * n + (i & 3); }

struct Unit { int pm, pn; };
struct Gemm { const bf16_t* A; const bf16_t* Bt; int M, N, K; };

struct StaticOrder {
    int nM, nN, nwg, G, c;
    __host__ __device__ void init(int M, int N, int G_, int c_) { nM = M / BM; nN = N / BM; nwg = nM * nN; G = G_; c = c_; }
    __host__ __device__ bool next(int i, Unit& u) const {
        const long L = (long)i * G + c; if (L >= nwg) return false;
        int wgid = (int)L; { const int q = nwg / NXCD, r = nwg % NXCD, xcd = wgid % NXCD, off = wgid / NXCD; wgid = (xcd < r ? xcd * (q + 1) : r * (q + 1) + (xcd - r) * q) + off; }
        const int nig = WGM * nN, gid = wgid / nig, fm = gid * WGM, gsz = (nM - fm) < WGM ? (nM - fm) : WGM;
        u.pm = fm + ((wgid % nig) % gsz); u.pn = (wgid % nig) / gsz; return true;
    }
    __device__ __forceinline__ void a_ready(const Unit&) const {}
    __device__ __forceinline__ void done(const Unit&) const {}
};

__device__ __forceinline__ unsigned cvt_pk_bf16(float lo, float hi) { unsigned r; asm volatile("v_cvt_pk_bf16_f32 %0, %1, %2" : "=v"(r) : "v"(lo), "v"(hi)); return r; }
__device__ __forceinline__ u32x4 pack8(const f32x4& a, const f32x4& b) { u32x4 w; w.x = cvt_pk_bf16(a[0], a[1]); w.y = cvt_pk_bf16(a[2], a[3]); w.z = cvt_pk_bf16(b[0], b[1]); w.w = cvt_pk_bf16(b[2], b[3]); return w; }
__device__ __forceinline__ u32x2 pack4(const f32x4& a) { u32x2 w; w.x = cvt_pk_bf16(a[0], a[1]); w.y = cvt_pk_bf16(a[2], a[3]); return w; }
__device__ __forceinline__ float hsum4(const f32x4& a) { return (a[0] + a[1]) + (a[2] + a[3]); }
__device__ __forceinline__ float hsq4(const f32x4& a) { return (a[0] * a[0] + a[1] * a[1]) + (a[2] * a[2] + a[3] * a[3]); }
__device__ __forceinline__ float ld_sum16(const float* p) { const f32x4* q = (const f32x4*)p; return (hsum4(q[0]) + hsum4(q[1])) + (hsum4(q[2]) + hsum4(q[3])); }
__device__ __forceinline__ float ld_sum8(const float* p) { const f32x4* q = (const f32x4*)p; return hsum4(q[0]) + hsum4(q[1]); }
__device__ __forceinline__ float ld_sum4(const float* p) { return hsum4(*(const f32x4*)p); }
__device__ __forceinline__ float quad_sum(float s) { s += swz_xor16(s); auto rr = __builtin_amdgcn_permlane32_swap(__float_as_uint(s), __float_as_uint(s), false, false); return __uint_as_float(rr[0]) + __uint_as_float(rr[1]); }
__device__ __forceinline__ float row_sum16(const float* ssq, int row, int fq) { return quad_sum(hsum4(*(const f32x4*)(ssq + (size_t)row * 16 + 4 * fq))); }
__device__ __forceinline__ void row_sum8x2(const float* ssq, int row, int fq, float& sg, float& sa) {
    float s = hsum4(*(const f32x4*)(ssq + (size_t)row * 16 + 4 * fq)); s += swz_xor16(s);
    auto rr = __builtin_amdgcn_permlane32_swap(__float_as_uint(s), __float_as_uint(s), false, false); sg = __uint_as_float(rr[0]); sa = __uint_as_float(rr[1]); }
#define PG8_FENCE() asm volatile("" ::: "memory")
#define PG8_RSTD8(rsv, ssqp, invn) do { f32x4 q_[2][4]; \
    _Pragma("unroll") for (int ai = 0; ai < 2; ++ai) _Pragma("unroll") for (int m = 0; m < 4; ++m) q_[ai][m] = *(const f32x4*)((ssqp) + (size_t)PG8_ROW(u, ai, m) * 16 + 4 * fq); \
    _Pragma("unroll") for (int ai = 0; ai < 2; ++ai) _Pragma("unroll") for (int m = 0; m < 4; ++m) rsv[ai][m] = rsqrtf(quad_sum(hsum4(q_[ai][m])) * (invn) + EPS); \
    PG8_FENCE(); } while (0)
__device__ __forceinline__ f32x4 gelu4(const f32x4& v) { f32x4 o; o[0] = gelu_tanh(v[0]); o[1] = gelu_tanh(v[1]); o[2] = gelu_tanh(v[2]); o[3] = gelu_tanh(v[3]); return o; }

#define PG8_ROW(u, ai, m) ((u).pm * BM + (ai) * HALF + wr * 64 + (m) * 16 + fr)

template <class V, class P> __device__ __forceinline__ V ldb(const P* p, unsigned boff) { return *(const V*)((const char*)p + boff); }
template <class V, class P> __device__ __forceinline__ void stb(P* p, unsigned boff, const V& v) { *(V*)((char*)p + boff) = v; }
#undef PG8_RSTD8
#define PG8_RSTD8(rsv, ssqp, invn) do { f32x4 q_[2][4]; \
    _Pragma("unroll") for (int ai = 0; ai < 2; ++ai) _Pragma("unroll") for (int m = 0; m < 4; ++m) q_[ai][m] = ldb<f32x4>((ssqp), (unsigned)(PG8_ROW(u, ai, m) * 64 + 16 * fq)); \
    _Pragma("unroll") for (int ai = 0; ai < 2; ++ai) _Pragma("unroll") for (int m = 0; m < 4; ++m) rsv[ai][m] = rsqrtf(quad_sum(hsum4(q_[ai][m])) * (invn) + EPS); \
    PG8_FENCE(); } while (0)

struct EpiIn {
    static constexpr bool PERM = true, AFTER_DRAIN = false, HAS_MID = false; static constexpr int MID_T = -1;
    const float* ssq1; const float* shw1; const float* gq; const float* gkv; const float* rope;
    bf16_t* U; bf16_t* VN; bf16_t* CQKV; bf16_t* KR; float* ssqq;
    __device__ __forceinline__ void mid(f32x4 (&)[2][2][4][2], const Unit&, int, int) const {}
    __device__ __forceinline__ void operator()(const f32x4 (&acc)[2][2][4][2], const Unit& u, int wr, int wc, int fr, int fq) const {
        { const int l_ = lane_id(); fr = l_ & 15; fq = l_ >> 4; }
        const int b = u.pm >> 3, pc0 = u.pn * BM + wc * 32 + 8 * fq;
        f32x4 sh[2][2];
#pragma unroll
        for (int bj = 0; bj < 2; ++bj)
#pragma unroll
            for (int n = 0; n < 2; ++n) sh[bj][n] = ldb<f32x4>(shw1, (unsigned)((b * NIN + pc0 + bj * HALF + 4 * n) * 4));
        float rsv[2][4]; PG8_RSTD8(rsv, ssq1, 1.f / DM);
        if (u.pn < 2) {
#pragma unroll
            for (int ai = 0; ai < 2; ++ai)
#pragma unroll
                for (int m = 0; m < 4; ++m) { const int row = PG8_ROW(u, ai, m); const float rs = rsv[ai][m];
#pragma unroll
                    for (int bj = 0; bj < 2; ++bj) { const f32x4 v0 = gelu4(acc[ai][bj][m][0] * rs + sh[bj][0]), v1 = gelu4(acc[ai][bj][m][1] * rs + sh[bj][1]);
                        stb(U, (unsigned)((row * 512 + pc0 + bj * HALF) * 2), pack8(v0, v1)); } }
        } else if (u.pn < 4) {
#pragma unroll
            for (int ai = 0; ai < 2; ++ai)
#pragma unroll
                for (int m = 0; m < 4; ++m) { const int row = PG8_ROW(u, ai, m); const float rs = rsv[ai][m];
                    f32x4 g[2][2]; float s = 0.f;
#pragma unroll
                    for (int bj = 0; bj < 2; ++bj)
#pragma unroll
                        for (int n = 0; n < 2; ++n) { g[bj][n] = gelu4(acc[ai][bj][m][n] * rs + sh[bj][n]); s += hsum4(g[bj][n]); }
                    const float mu = quad_sum(s) * (1.f / 64); float q = 0.f;
#pragma unroll
                    for (int bj = 0; bj < 2; ++bj)
#pragma unroll
                        for (int n = 0; n < 2; ++n) { g[bj][n] = g[bj][n] - mu; q += hsq4(g[bj][n]); }
                    const float rstd = rsqrtf(quad_sum(q) * (1.f / 64) + EPS);
#pragma unroll
                    for (int bj = 0; bj < 2; ++bj) stb(VN, (unsigned)((row * 512 + (u.pn - 2) * 256 + 64 * wc + 32 * bj + 8 * fq) * 2), pack8(g[bj][0] * rstd, g[bj][1] * rstd)); }
        } else if (u.pn == 4) {
            f32x4 gv[2][2];
#pragma unroll
            for (int bj = 0; bj < 2; ++bj)
#pragma unroll
                for (int n = 0; n < 2; ++n) gv[bj][n] = ldb<f32x4>(gq, (unsigned)((bj * HALF + wc * 32 + 8 * fq + 4 * n) * 4));
#pragma unroll
            for (int ai = 0; ai < 2; ++ai)
#pragma unroll
                for (int m = 0; m < 4; ++m) { const int row = PG8_ROW(u, ai, m); const float rs = rsv[ai][m];
                    float ss = 0.f;
#pragma unroll
                    for (int bj = 0; bj < 2; ++bj) { const f32x4 v0 = acc[ai][bj][m][0] * rs + sh[bj][0], v1 = acc[ai][bj][m][1] * rs + sh[bj][1]; ss += hsq4(v0) + hsq4(v1);
                        stb(CQKV, (unsigned)((row * KUP + bj * HALF + wc * 32 + 8 * fq) * 2), pack8(v0 * gv[bj][0], v1 * gv[bj][1])); }
                    ss = quad_sum(ss); if (fq == 0) stb(ssqq, (unsigned)((row * 8 + wc) * 4), ss); }
        } else {
            const f32x4 gk0 = ldb<f32x4>(gkv, (unsigned)((wc * 32 + 8 * fq) * 4)), gk1 = ldb<f32x4>(gkv, (unsigned)((wc * 32 + 8 * fq + 4) * 4));
#pragma unroll
            for (int ai = 0; ai < 2; ++ai)
#pragma unroll
                for (int m = 0; m < 4; ++m) { const int row = PG8_ROW(u, ai, m); const float rs = rsv[ai][m];
                    const f32x4 v0 = acc[ai][0][m][0] * rs + sh[0][0], v1 = acc[ai][0][m][1] * rs + sh[0][1];
                    float ss = quad_sum(hsq4(v0) + hsq4(v1)); if (fq == 0) stb(ssqq, (unsigned)((row * 8 + 4 + wc) * 4), ss);
                    stb(CQKV, (unsigned)((row * KUP + 256 + wc * 32 + 8 * fq) * 2), pack8(v0 * gk0, v1 * gk1));
                    if (wc == 0) { const f32x4 x1 = acc[ai][1][m][0] * rs + sh[1][0], x2 = acc[ai][1][m][1] * rs + sh[1][1];
                        const f32x4 c = ldb<f32x4>(rope, (unsigned)((row * 32 + 4 * fq) * 4)), s = ldb<f32x4>(rope, (unsigned)((row * 32 + 16 + 4 * fq) * 4));
                        stb(KR, (unsigned)((row * 32 + 4 * fq) * 2), pack4(x1 * c - x2 * s)); stb(KR, (unsigned)((row * 32 + 16 + 4 * fq) * 2), pack4(x1 * s + x2 * c)); } }
        }
    }
};
struct EpiUp {
    static constexpr bool PERM = true, AFTER_DRAIN = false, HAS_MID = false; static constexpr int MID_T = -1;
    const float* ssqq; const float* rope; bf16_t* Q; bf16_t* KN; bf16_t* V;
    __device__ __forceinline__ void mid(f32x4 (&)[2][2][4][2], const Unit&, int, int) const {}
    __device__ __forceinline__ void operator()(const f32x4 (&acc)[2][2][4][2], const Unit& u, int wr, int wc, int fr, int fq) const {
        { const int l_ = lane_id(); fr = l_ & 15; fq = l_ >> 4; }
        float sq[2][4];
        { f32x4 q_[2][4];
#pragma unroll
        for (int ai = 0; ai < 2; ++ai)
#pragma unroll
            for (int m = 0; m < 4; ++m) q_[ai][m] = ldb<f32x4>(ssqq, (unsigned)((PG8_ROW(u, ai, m) * 8 + (u.pn < 3 ? 0 : 4)) * 4));
#pragma unroll
        for (int ai = 0; ai < 2; ++ai)
#pragma unroll
            for (int m = 0; m < 4; ++m) sq[ai][m] = hsum4(q_[ai][m]);
        PG8_FENCE(); }
        if (u.pn < 3) {
#pragma unroll
            for (int ai = 0; ai < 2; ++ai)
#pragma unroll
                for (int m = 0; m < 4; ++m) { const int row = PG8_ROW(u, ai, m); const float rq = rsqrtf(sq[ai][m] * (1.f / QR) + EPS) * QSCALE;
#pragma unroll
                    for (int bj = 0; bj < 2; ++bj) { const int G = 8 * u.pn + 4 * bj + wc, h = G / 3, gi = G - 3 * h;
                        const f32x4 v0 = acc[ai][bj][m][0] * rq, v1 = acc[ai][bj][m][1] * rq;
                        if (gi < 2) stb(Q, (unsigned)((row * 768 + 32 * G + 8 * fq) * 2), pack8(v0, v1));
                        else { const f32x4 c = ldb<f32x4>(rope, (unsigned)((row * 32 + 4 * fq) * 4)), s = ldb<f32x4>(rope, (unsigned)((row * 32 + 16 + 4 * fq) * 4));
                            stb(Q, (unsigned)((row * 768 + 96 * h + 64 + 4 * fq) * 2), pack4(v0 * c - v1 * s)); stb(Q, (unsigned)((row * 768 + 96 * h + 80 + 4 * fq) * 2), pack4(v0 * s + v1 * c)); } } }
        } else {
#pragma unroll
            for (int ai = 0; ai < 2; ++ai)
#pragma unroll
                for (int m = 0; m < 4; ++m) { const int row = PG8_ROW(u, ai, m); const float rk = rsqrtf(sq[ai][m] * (1.f / KVR) + EPS);
#pragma unroll
                    for (int bj = 0; bj < 2; ++bj) { const int h = 2 * (u.pn - 3) + bj;
                        const u32x4 w = pack8(acc[ai][bj][m][0] * rk, acc[ai][bj][m][1] * rk);
                        if (wc < 2) stb(KN, (unsigned)((row * 512 + 64 * h + 32 * wc + 8 * fq) * 2), w); else stb(V, (unsigned)((row * 512 + 64 * h + 32 * (wc - 2) + 8 * fq) * 2), w); } }
        }
    }
};
template <bool MIDS> struct EpiRes {
    static constexpr bool PERM = true, AFTER_DRAIN = false, HAS_MID = MIDS; static constexpr int MID_T = 8;
    const float* ssqy; const float* xin; float* xout; const float* gate  ; const float* gm  ; bf16_t* A; float* ssqo;
    __device__ __forceinline__ void mid(f32x4 (&acc)[2][2][4][2], const Unit& u, int wr, int fr) const {
        const int l_ = lane_id(); fr = l_ & 15; const int fq = l_ >> 4;
        f32x4 q_[2][4];
#pragma unroll
        for (int ai = 0; ai < 2; ++ai)
#pragma unroll
            for (int m = 0; m < 4; ++m) q_[ai][m] = ldb<f32x4>(ssqy, (unsigned)(PG8_ROW(u, ai, m) * 64 + 16 * fq));
#pragma unroll
        for (int ai = 0; ai < 2; ++ai)
#pragma unroll
            for (int m = 0; m < 4; ++m) { float s = hsum4(q_[ai][m]); s += swz_xor16(s);
                auto rr = __builtin_amdgcn_permlane32_swap(__float_as_uint(s), __float_as_uint(s), false, false); const float sg = __uint_as_float(rr[0]), sa = __uint_as_float(rr[1]);
                const float ratio = sqrtf((sa * (1.f / 512) + EPS) / (sg * (1.f / 512) + EPS));
#pragma unroll
                for (int bj = 0; bj < 2; ++bj)
#pragma unroll
                    for (int n = 0; n < 2; ++n) acc[ai][bj][m][n] = acc[ai][bj][m][n] * ratio; }
    }
    __device__ __forceinline__ void operator()(const f32x4 (&acc)[2][2][4][2], const Unit& u, int wr, int wc, int fr, int fq) const {
        { const int l_ = lane_id(); fr = l_ & 15; fq = l_ >> 4; }
        const int b = u.pm >> 3, c0 = u.pn * BM + wc * 32 + 8 * fq;
        float rs[2][4], ss[2][4];
#pragma unroll
        for (int ai = 0; ai < 2; ++ai)
#pragma unroll
            for (int m = 0; m < 4; ++m) { ss[ai][m] = 0.f; rs[ai][m] = 1.f; }
        if (MIDS) { f32x4 q_[2][4];
#pragma unroll
            for (int ai = 0; ai < 2; ++ai)
#pragma unroll
                for (int m = 0; m < 4; ++m) q_[ai][m] = ldb<f32x4>(ssqy, (unsigned)(PG8_ROW(u, ai, m) * 64 + 32 + 16 * (fq & 1)));
#pragma unroll
            for (int ai = 0; ai < 2; ++ai)
#pragma unroll
                for (int m = 0; m < 4; ++m) { float s = hsum4(q_[ai][m]); s += swz_xor16(s); rs[ai][m] = rsqrtf(s * (1.f / 512) + EPS); }
            PG8_FENCE(); }
#pragma unroll
        for (int bj = 0; bj < 2; ++bj) { const int cb = c0 + bj * HALF;
            const f32x4 g0 = ldb<f32x4>(gate, (unsigned)((b * NMOD + cb) * 4)), g1 = ldb<f32x4>(gate, (unsigned)((b * NMOD + cb + 4) * 4));
            f32x4 m0 = (f32x4){0.f, 0.f, 0.f, 0.f}, m1 = m0; if (gm) { m0 = ldb<f32x4>(gm, (unsigned)((b * DM + cb) * 4)); m1 = ldb<f32x4>(gm, (unsigned)((b * DM + cb + 4) * 4)); }
#pragma unroll
            for (int ai = 0; ai < 2; ++ai) {
                f32x4 xv[4][2];
#pragma unroll
                for (int m = 0; m < 4; ++m) { const unsigned off = (unsigned)((PG8_ROW(u, ai, m) * DM + cb) * 4); xv[m][0] = ldb<f32x4>(xin, off); xv[m][1] = ldb<f32x4>(xin, off + 16); }
                PG8_FENCE();
#pragma unroll
                for (int m = 0; m < 4; ++m) { const unsigned off = (unsigned)((PG8_ROW(u, ai, m) * DM + cb) * 4);
                    const f32x4 x0 = xv[m][0] + g0 * (acc[ai][bj][m][0] * rs[ai][m]), x1 = xv[m][1] + g1 * (acc[ai][bj][m][1] * rs[ai][m]);
                    stb(xout, off, x0); stb(xout, off + 16, x1);
                    if (gm) { ss[ai][m] += hsq4(x0) + hsq4(x1); stb(A, off >> 1, pack8(x0 * m0, x1 * m1)); } }
                PG8_FENCE(); } }
        if (gm) {
#pragma unroll
            for (int ai = 0; ai < 2; ++ai)
#pragma unroll
                for (int m = 0; m < 4; ++m) { const float s = quad_sum(ss[ai][m]); if (fq == 0) stb(ssqo, (unsigned)((PG8_ROW(u, ai, m) * 16 + u.pn * 4 + wc) * 4), s); } }
    }
};
struct EpiFf1 {
    static constexpr bool PERM = true, AFTER_DRAIN = false, HAS_MID = false; static constexpr int MID_T = -1;
    const float* ssq2; const float* shw2; bf16_t* H;
    __device__ __forceinline__ void mid(f32x4 (&)[2][2][4][2], const Unit&, int, int) const {}
    __device__ __forceinline__ void operator()(const f32x4 (&acc)[2][2][4][2], const Unit& u, int wr, int wc, int fr, int fq) const {
        { const int l_ = lane_id(); fr = l_ & 15; fq = l_ >> 4; }
        const int b = u.pm >> 3, c0 = u.pn * BM + wc * 32 + 8 * fq;
        f32x4 sh[2][2];
#pragma unroll
        for (int bj = 0; bj < 2; ++bj)
#pragma unroll
            for (int n = 0; n < 2; ++n) sh[bj][n] = ldb<f32x4>(shw2, (unsigned)((b * DFF + c0 + bj * HALF + 4 * n) * 4));
        float rsv[2][4]; PG8_RSTD8(rsv, ssq2, 1.f / DM);
#pragma unroll
        for (int ai = 0; ai < 2; ++ai)
#pragma unroll
            for (int m = 0; m < 4; ++m) { const int row = PG8_ROW(u, ai, m); const float rs = rsv[ai][m];
#pragma unroll
                for (int bj = 0; bj < 2; ++bj) { f32x4 v0 = acc[ai][bj][m][0] * rs + sh[bj][0], v1 = acc[ai][bj][m][1] * rs + sh[bj][1];
#pragma unroll
                    for (int i = 0; i < 4; ++i) { const float a = fmaxf(v0[i], 0.f), c = fmaxf(v1[i], 0.f); v0[i] = a * a; v1[i] = c * c; }
                    stb(H, (unsigned)((row * DFF + c0 + bj * HALF) * 2), pack8(v0, v1)); } }
    }
};

template <class Epi, class Sched, bool ALIGN_EPI = false, bool SP2 = false>
__device__ __forceinline__ void gemm_phase(PG8_LAS unsigned char* lds, const Gemm g, const Sched& S, const Epi& E, int wid0) {
    int tid_ = wid0 * 64 + lane_id(); asm volatile("" : "+v"(tid_));
    const int tid = tid_, wid = __builtin_amdgcn_readfirstlane(tid >> 6), lane = tid & 63, wr = wid >> 2, wc = wid & 3, fr = lane & 15, fq = lane >> 4;
    const int K = g.K, nt = K / BK;
    unsigned voffA[2], voffB[2];
#pragma unroll
    for (int i = 0; i < 2; ++i) { int R, C; stage_rc(tid * 16 + i * 8192, R, C); const int Rb = Epi::PERM ? ((R & ~31) + perm32(R & 31)) : R;
        voffA[i] = (unsigned)(R * K + C) * 2u; voffB[i] = (unsigned)(Rb * K + C) * 2u; }
    const size_t kstep = (size_t)(BK * 2);
    const size_t hstep = (size_t)HALF * K * 2;
    const size_t tstep = 2 * hstep;
    const unsigned ldsw = (unsigned)wid * 1024u;
    const int aoff = lds_byte(wr * 64 + fr, fq * 8), boff = lds_byte(wc * 32 + fr, fq * 8);
#define PG8_SA(b, h) (((b) * 2 + (h)) * HTB)
#define PG8_SB(b, h) ((4 + (b) * 2 + (h)) * HTB)
#define PG8_STAGE(bufoff, gbase, voff) do { _Pragma("unroll") for (int _i = 0; _i < 2; ++_i) \
        __builtin_amdgcn_global_load_lds((const unsigned*)((const char*)(gbase) + (voff)[_i]), (PG8_LAS unsigned*)(lds + (bufoff) + ldsw + _i * 8192), 16, 0, 0); } while (0)
#define PG8_LDA(dst, b, h) do { _Pragma("unroll") for (int m = 0; m < 4; ++m) _Pragma("unroll") for (int k = 0; k < 2; ++k) dst[m][k] = *(const PG8_LAS bf16x8*)(lds + PG8_SA(b, h) + aoff + m * 2048 + k * 1024); } while (0)
#define PG8_LDB(dst, b, h) do { _Pragma("unroll") for (int n = 0; n < 2; ++n) _Pragma("unroll") for (int k = 0; k < 2; ++k) dst[n][k] = *(const PG8_LAS bf16x8*)(lds + PG8_SB(b, h) + boff + n * 2048 + k * 1024); } while (0)
#define PG8_MMA(ai, bj, At, Bt) do { __builtin_amdgcn_s_setprio(1); _Pragma("unroll") for (int m = 0; m < 4; ++m) _Pragma("unroll") for (int n = 0; n < 2; ++n) _Pragma("unroll") for (int k = 0; k < 2; ++k) \
        acc[ai][bj][m][n] = __builtin_amdgcn_mfma_f32_16x16x32_bf16(Bt[n][k], At[m][k], acc[ai][bj][m][n], 0, 0, 0); __builtin_amdgcn_s_setprio(0); } while (0)
#define PG8_WAIT_V(n) asm volatile("s_waitcnt vmcnt(" #n ")" ::: "memory")
#define PG8_WAIT_L(n) asm volatile("s_waitcnt lgkmcnt(" #n ")" ::: "memory")
#define PG8_BAR __builtin_amdgcn_s_barrier()
#define PG8_SCHED __builtin_amdgcn_sched_barrier(0)
    Unit cur, nxt; int ui = 0;
    if (!S.next(0, cur)) return;
    f32x4 acc[2][2][4][2];
#pragma unroll
    for (int a = 0; a < 2; ++a)
#pragma unroll
        for (int b = 0; b < 2; ++b)
#pragma unroll
            for (int m = 0; m < 4; ++m)
#pragma unroll
                for (int n = 0; n < 2; ++n) acc[a][b][m][n] = (f32x4){0.f, 0.f, 0.f, 0.f};
    bf16x8 At[4][2], B0[2][2], B1[2][2];
    const char* cA = (const char*)g.A + (size_t)cur.pm * tstep; const char* cB = (const char*)g.Bt + (size_t)cur.pn * tstep;
    S.a_ready(cur);
    if constexpr (SP2) {
        PG8_STAGE(PG8_SB(0, 0), cB, voffB); PG8_STAGE(PG8_SB(0, 1), cB + hstep, voffB); PG8_STAGE(PG8_SA(0, 0), cA, voffA); PG8_STAGE(PG8_SA(0, 1), cA + hstep, voffA);
        if (wr == 1) PG8_BAR;
        PG8_WAIT_V(2); PG8_BAR;
        PG8_STAGE(PG8_SB(1, 0), cB + kstep, voffB); PG8_STAGE(PG8_SA(1, 0), cA + kstep, voffA); PG8_STAGE(PG8_SB(1, 1), cB + hstep + kstep, voffB);
        PG8_WAIT_V(6); PG8_BAR;
    } else {
        PG8_STAGE(PG8_SB(0, 0), cB, voffB); PG8_STAGE(PG8_SA(0, 0), cA, voffA); PG8_STAGE(PG8_SB(0, 1), cB + hstep, voffB); PG8_STAGE(PG8_SA(0, 1), cA + hstep, voffA);
        if (wr == 1) PG8_BAR;
        PG8_WAIT_V(4); PG8_BAR;
        PG8_STAGE(PG8_SB(1, 0), cB + kstep, voffB); PG8_STAGE(PG8_SA(1, 0), cA + kstep, voffA); PG8_STAGE(PG8_SB(1, 1), cB + hstep + kstep, voffB);
        PG8_WAIT_V(6); PG8_BAR;
    }
    for (;;) {
        const bool has_next = S.next(ui + 1, nxt);
        const char* nA = has_next ? (const char*)g.A + (size_t)nxt.pm * tstep : cA; const char* nB = has_next ? (const char*)g.Bt + (size_t)nxt.pn * tstep : cB;
        for (int t = 0; t < nt; t += 2) {
            const bool last = (t == nt - 2);
            const char* a1 = cA + (size_t)(t + 1) * kstep;
            const char* a2 = last ? nA : cA + (size_t)(t + 2) * kstep; const char* b2 = last ? nB : cB + (size_t)(t + 2) * kstep;
            const char* a3 = a2 + kstep; const char* b3 = b2 + kstep;
            if (last && has_next) S.a_ready(nxt);
            if constexpr (Epi::HAS_MID) { if (t == Epi::MID_T) E.mid(acc, cur, wr, fr); }
            if constexpr (SP2) {
            PG8_LDB(B0, 0, 0); PG8_LDB(B1, 0, 1); PG8_SCHED; PG8_LDA(At, 0, 0); PG8_STAGE(PG8_SA(1, 1), a1 + hstep, voffA);
            PG8_WAIT_V(8); PG8_WAIT_L(0); PG8_BAR; PG8_MMA(0, 0, At, B0); PG8_MMA(0, 1, At, B1); PG8_BAR; PG8_SCHED;
            PG8_LDA(At, 0, 1); PG8_STAGE(PG8_SB(0, 0), b2, voffB); PG8_STAGE(PG8_SB(0, 1), b2 + hstep, voffB); PG8_STAGE(PG8_SA(0, 0), a2, voffA);
            PG8_WAIT_V(8); PG8_WAIT_L(0); PG8_BAR; PG8_MMA(1, 0, At, B0); PG8_MMA(1, 1, At, B1); PG8_BAR; PG8_SCHED;
            PG8_LDB(B0, 1, 0); PG8_LDB(B1, 1, 1); PG8_SCHED; PG8_LDA(At, 1, 0); PG8_STAGE(PG8_SA(0, 1), a2 + hstep, voffA);
            PG8_WAIT_V(8); PG8_WAIT_L(0); PG8_BAR; PG8_MMA(0, 0, At, B0); PG8_MMA(0, 1, At, B1); PG8_BAR; PG8_SCHED;
            PG8_LDA(At, 1, 1); PG8_STAGE(PG8_SB(1, 0), b3, voffB); PG8_STAGE(PG8_SB(1, 1), b3 + hstep, voffB); PG8_STAGE(PG8_SA(1, 0), a3, voffA);
            PG8_WAIT_V(8); PG8_WAIT_L(0); PG8_BAR; PG8_MMA(1, 0, At, B0); PG8_MMA(1, 1, At, B1); PG8_BAR; PG8_SCHED;
            } else {
            PG8_LDB(B0, 0, 0); PG8_SCHED; PG8_LDA(At, 0, 0); PG8_STAGE(PG8_SA(1, 1), a1 + hstep, voffA);
            PG8_WAIT_L(8); PG8_BAR; PG8_WAIT_L(0); PG8_MMA(0, 0, At, B0); PG8_BAR; PG8_SCHED;
            PG8_LDB(B1, 0, 1); PG8_STAGE(PG8_SB(0, 0), b2, voffB);
            PG8_BAR; PG8_WAIT_L(0); PG8_MMA(0, 1, At, B1); PG8_BAR;
            PG8_LDA(At, 0, 1); PG8_STAGE(PG8_SA(0, 0), a2, voffA);
            PG8_BAR; PG8_WAIT_L(0); PG8_MMA(1, 0, At, B0); PG8_BAR; PG8_SCHED;
            PG8_STAGE(PG8_SB(0, 1), b2 + hstep, voffB);
            PG8_WAIT_V(6); PG8_BAR; PG8_MMA(1, 1, At, B1); PG8_BAR;
            PG8_LDB(B0, 1, 0); PG8_SCHED; PG8_LDA(At, 1, 0); PG8_STAGE(PG8_SA(0, 1), a2 + hstep, voffA);
            PG8_WAIT_L(8); PG8_BAR; PG8_WAIT_L(0); PG8_MMA(0, 0, At, B0); PG8_BAR; PG8_SCHED;
            PG8_LDB(B1, 1, 1); PG8_STAGE(PG8_SB(1, 0), b3, voffB);
            PG8_BAR; PG8_WAIT_L(0); PG8_MMA(0, 1, At, B1); PG8_BAR;
            PG8_LDA(At, 1, 1); PG8_STAGE(PG8_SA(1, 0), a3, voffA);
            PG8_BAR; PG8_WAIT_L(0); PG8_MMA(1, 0, At, B0); PG8_BAR; PG8_SCHED;
            PG8_STAGE(PG8_SB(1, 1), b3 + hstep, voffB);
            PG8_WAIT_V(6); PG8_BAR; PG8_MMA(1, 1, At, B1); PG8_BAR;
            }
        }
        if constexpr (ALIGN_EPI) { if (wr == 0) PG8_BAR; }
        if constexpr (!Epi::AFTER_DRAIN) { E(acc, cur, wr, wc, fr, fq); S.done(cur); }
        if (!has_next) break;
#pragma unroll
        for (int a = 0; a < 2; ++a)
#pragma unroll
            for (int b = 0; b < 2; ++b)
#pragma unroll
                for (int m = 0; m < 4; ++m)
#pragma unroll
                    for (int n = 0; n < 2; ++n) acc[a][b][m][n] = (f32x4){0.f, 0.f, 0.f, 0.f};
        cur = nxt; cA = nA; cB = nB; ++ui;
        if constexpr (ALIGN_EPI) { if (wr == 1) PG8_BAR; }
    }
    PG8_WAIT_V(0);
    if constexpr (!ALIGN_EPI) { if (wr == 0) PG8_BAR; }
    PG8_BAR;
    if constexpr (Epi::AFTER_DRAIN) { E.fused(acc, cur, wr, wc, fr, fq, lds, wid, lane); S.done(cur); }
#undef PG8_SA
#undef PG8_SB
#undef PG8_STAGE
#undef PG8_LDA
#undef PG8_LDB
#undef PG8_MMA
#undef PG8_WAIT_V
#undef PG8_WAIT_L
#undef PG8_BAR
#undef PG8_SCHED
}
}

namespace gm {
#define GM_LAS __attribute__((address_space(3)))
typedef short v4i16_t __attribute__((ext_vector_type(4)));
__device__ __forceinline__ int swz(int s) { return ((s >> 1) & 1) + 2 * ((s >> 3) & 1); }
__device__ __forceinline__ void gmlp_phase(GM_LAS unsigned char* lds, int wid0, int vcu, const bf16_t* U, const bf16_t* VN, const bf16_t* GW  , const float* bs  , const float* gog  , bf16_t* Y, float* ssqy) {
    int tid_ = wid0 * 64 + lane_id(); asm volatile("" : "+v"(tid_));
    const int tid = tid_, lane = tid & 63, wid = __builtin_amdgcn_readfirstlane(tid >> 6), fr = lane & 15, fq = lane >> 4;
    const int g = vcu & 7, nks = (wid >> 1) + 1;
    bf16x8 wf[4];
#pragma unroll
    for (int ks = 0; ks < 4; ++ks) wf[ks] = *(const bf16x8*)(GW + ((size_t)(g * CHUNK + 16 * wid + fr)) * CHUNK + 32 * ks + 8 * fq);
    const float bias = bs[g * CHUNK + 16 * wid + fr];
    f32x4 gv[4];
#pragma unroll
    for (int nt = 0; nt < 4; ++nt) gv[nt] = *(const f32x4*)(gog + g * 64 + 16 * nt + 4 * fq);
    for (int i = 0; i < 8; ++i) {
        const int un = (vcu >> 3) + 32 * i; const size_t t0 = (size_t)un * CHUNK;
        pg8::u32x4 st[2];
#pragma unroll
        for (int k = 0; k < 2; ++k) { const int idx = tid + 512 * k, s = idx >> 3, c16 = idx & 7; st[k] = *(const pg8::u32x4*)(VN + (t0 + s) * 512 + g * 64 + c16 * 8); }
        __syncthreads();
#pragma unroll
        for (int k = 0; k < 2; ++k) { const int idx = tid + 512 * k, s = idx >> 3, c16 = idx & 7; *(GM_LAS pg8::u32x4*)(lds + s * 128 + (((c16 >> 1) ^ swz(s)) * 32) + (c16 & 1) * 16) = st[k]; }
        __syncthreads();
        f32x4 acc[4];
#pragma unroll
        for (int nt = 0; nt < 4; ++nt) acc[nt] = (f32x4){0.f, 0.f, 0.f, 0.f};
#pragma unroll
        for (int ks = 0; ks < 4; ++ks) { if (ks < nks) {
#pragma unroll
            for (int nt = 0; nt < 4; ++nt) {
                const int q = fr >> 2, p = fr & 3;
                const int s0 = 32 * ks + 8 * fq + q, s1 = s0 + 4;
                const v4i16_t lo = __builtin_amdgcn_ds_read_tr16_b64_v4i16((GM_LAS v4i16_t*)(lds + s0 * 128 + ((nt ^ swz(s0)) * 32) + p * 8));
                const v4i16_t hi = __builtin_amdgcn_ds_read_tr16_b64_v4i16((GM_LAS v4i16_t*)(lds + s1 * 128 + ((nt ^ swz(s1)) * 32) + p * 8));
                const bf16x8 vf = (bf16x8){lo[0], lo[1], lo[2], lo[3], hi[0], hi[1], hi[2], hi[3]};
                acc[nt] = __builtin_amdgcn_mfma_f32_16x16x32_bf16(vf, wf[ks], acc[nt], 0, 0, 0);
            } } }
        const size_t row = t0 + 16 * wid + fr; float ss = 0.f;
#pragma unroll
        for (int nt = 0; nt < 4; ++nt) { const int c = g * 64 + 16 * nt + 4 * fq;
            const uint2 uu = *(const uint2*)(U + row * 512 + c);
            f32x4 y; y[0] = bf2f((bf16_t)(uu.x & 0xffff)) * (acc[nt][0] + bias); y[1] = bf2f((bf16_t)(uu.x >> 16)) * (acc[nt][1] + bias);
            y[2] = bf2f((bf16_t)(uu.y & 0xffff)) * (acc[nt][2] + bias); y[3] = bf2f((bf16_t)(uu.y >> 16)) * (acc[nt][3] + bias);
            ss += pg8::hsq4(y); *(pg8::u32x2*)(Y + row * DM + c) = pg8::pack4(y * gv[nt]); }
        ss = pg8::quad_sum(ss); if (fq == 0) ssqy[row * 16 + g] = ss;
    }
    __syncthreads();
}
}

namespace att {
#define AT_LAS __attribute__((address_space(3)))
using f32x16 = __attribute__((ext_vector_type(16))) float;
using s16x4 = __attribute__((ext_vector_type(4))) short;
using u32x4 = __attribute__((ext_vector_type(4))) unsigned;
constexpr int KVBLK = 64, NSLOT = 3, SLOTB = 20480, VOFF = 12288;
constexpr int LDS_WS = NSLOT * SLOTB  , LDS_OST = LDS_WS + 8 * 256  , OROW = 272, LDS_BYTES = LDS_OST + 8 * 32 * OROW  ;
__device__ __forceinline__ int crow(int r, int hi) { return (r & 3) + 8 * (r >> 2) + 4 * hi; }
__device__ __forceinline__ void glds16(const void* gsrc, unsigned lds_dst) { unsigned keep;
    asm volatile("s_mov_b32 %0, m0\n\ts_mov_b32 m0, %2\n\ts_nop 0\n\tglobal_load_lds_dwordx4 %1, off\n\ts_mov_b32 m0, %0" : "=&s"(keep) : "v"(gsrc), "s"(lds_dst) : "memory"); }
#define AT_WAIT_BAR(N) asm volatile("s_waitcnt vmcnt(" #N ") lgkmcnt(0)\n\ts_barrier" ::: "memory")
#define AT_SBAR() __builtin_amdgcn_sched_barrier(0)
typedef short v4i16_t __attribute__((ext_vector_type(4)));
__device__ __forceinline__ s16x4 vtr(AT_LAS const char* p) { return __builtin_bit_cast(s16x4, __builtin_amdgcn_ds_read_tr16_b64_v4i16((AT_LAS v4i16_t*)p)); }

template <int THRL>
__device__ __forceinline__ void attn_unit(int b, int h, int qb, const bf16_t* Q, const bf16_t* KN, const bf16_t* KR, const bf16_t* V, const float* goa  , bf16_t* Y, float* ssqy, AT_LAS char* shm, int wid0) {
    int tid_ = wid0 * 64 + lane_id(); asm volatile("" : "+v"(tid_));
    const int tid = tid_, lane = tid & 63, r32 = lane & 31, hi = lane >> 5; const int wid = __builtin_amdgcn_readfirstlane(tid >> 6);
    const size_t rowbase = (size_t)b * SEQ; const int q0 = qb * 256;
    const bf16_t* Qw = Q + (rowbase + q0 + wid * 32) * 768 + h * 96;
    const unsigned lds0 = (unsigned)(uintptr_t)shm;
    AT_LAS float* wsf = (AT_LAS float*)(shm + LDS_WS) + wid * 64;
    const bf16_t* ksrc = KN + (rowbase + lane) * 512 + h * 64 + wid * 8;
    const bf16_t* rsrc = KR + (rowbase + lane) * 32 + (wid & 3) * 8;
    const bf16_t* vsrc = V + (rowbase + 16 * (wid & 3) + (lane >> 2)) * 512 + h * 64 + (wid >> 2) * 32 + (lane & 3) * 8;
    const unsigned kdst = lds0 + wid * 1024, rdst = lds0 + (8 + (wid & 3)) * 1024, vdst = lds0 + VOFF + wid * 1024;
#define AT_DMA(t, slot) do { glds16(ksrc + (size_t)(t) * KVBLK * 512, (unsigned)__builtin_amdgcn_readfirstlane(kdst + (slot))); \
        glds16(rsrc + (size_t)(t) * KVBLK * 32, (unsigned)__builtin_amdgcn_readfirstlane(rdst + (slot))); \
        glds16(vsrc + (size_t)(t) * KVBLK * 512, (unsigned)__builtin_amdgcn_readfirstlane(vdst + (slot))); } while (0)
    const int NT = (q0 + 256) / KVBLK;
    bf16x8 qr[6];
#pragma unroll
    for (int d0 = 0; d0 < 6; ++d0) qr[d0] = *(const bf16x8*)(Qw + (size_t)r32 * 768 + d0 * 16 + hi * 8);
    AT_DMA(0, 0); AT_DMA(1, SLOTB);
    float mhat = 0.f, l_reg = 0.f; f32x16 o[2]; o[0] = f32x16{}; o[1] = f32x16{};
    const int qrel = wid * 32 + r32;
    int sl_cur = 0, sl_nn = 2 * SLOTB;
    AT_LAS const char* kp0 = shm + hi * 1024 + r32 * 16;
    AT_LAS const char* vp0 = shm + VOFF + ((lane >> 4) & 1) * 32 + (lane & 3) * 8 + (4 * hi + ((lane & 15) >> 2)) * 64;
    for (int t = 0; t < NT; ++t) {
        if (t + 1 < NT) { AT_WAIT_BAR(3); } else { AT_WAIT_BAR(0); }
        if (t + 2 < NT) AT_DMA(t + 2, sl_nn);
        const int jb = t - (NT - 4);
        if (jb <= (wid >> 1)) {
            f32x16 p0, p1;
            { AT_LAS const char* kb = kp0 + sl_cur;
#pragma unroll
              for (int d0 = 0; d0 < 6; ++d0) {
                const bf16x8 b0 = *(AT_LAS const bf16x8*)(kb + d0 * 2048), b1 = *(AT_LAS const bf16x8*)(kb + d0 * 2048 + 512);
                if (d0 == 0) { p0 = __builtin_amdgcn_mfma_f32_32x32x16_bf16(b0, qr[0], f32x16{}, 0, 0, 0); p1 = __builtin_amdgcn_mfma_f32_32x32x16_bf16(b1, qr[0], f32x16{}, 0, 0, 0); }
                else { p0 = __builtin_amdgcn_mfma_f32_32x32x16_bf16(b0, qr[d0], p0, 0, 0, 0); p1 = __builtin_amdgcn_mfma_f32_32x32x16_bf16(b1, qr[d0], p1, 0, 0, 0); } } }
            if (jb >= 0) { const int kb = 64 * jb + 4 * hi;
#pragma unroll
                for (int r = 0; r < 16; ++r) { const int kv = kb + (r & 3) + 8 * (r >> 2); if (kv > qrel) p0[r] = -INFINITY; if (kv + 32 > qrel) p1[r] = -INFINITY; } }
            float rm = fmaxf(p0[0], p1[0]);
#pragma unroll
            for (int r = 1; r < 16; ++r) rm = fmaxf(rm, fmaxf(p0[r], p1[r]));
            { auto rr = __builtin_amdgcn_permlane32_swap(__float_as_uint(rm), __float_as_uint(rm), false, false); rm = fmaxf(__uint_as_float(rr[0]), __uint_as_float(rr[1])); }
            const float grow = rm - mhat;
            if (t == 0 || __any(grow > (float)THRL)) {
                const float dl = (t == 0) ? rm : fmaxf(grow, 0.f); const float f = (t == 0) ? 0.f : __builtin_amdgcn_exp2f(-dl);
                mhat = (t == 0) ? rm : mhat + dl; l_reg *= f;
                if (t > 0) { if (hi == 0) wsf[r32] = f; asm volatile("s_waitcnt lgkmcnt(0)" ::: "memory");
#pragma unroll
                    for (int r = 0; r < 16; ++r) { const float fr_ = wsf[crow(r, hi)]; o[0][r] *= fr_; o[1][r] *= fr_; } }
            }
            float sacc = 0.f;
#pragma unroll
            for (int r = 0; r < 16; ++r) { p0[r] = __builtin_amdgcn_exp2f(p0[r] - mhat); p1[r] = __builtin_amdgcn_exp2f(p1[r] - mhat); sacc += p0[r] + p1[r]; }
            l_reg += sacc;
            u32x4 pw0, pw1, pw2, pw3;
#define AT_PK(P, B) pg8::cvt_pk_bf16(P[B], P[B + 1])
            pw0 = (u32x4){AT_PK(p0, 0), AT_PK(p0, 2), AT_PK(p0, 4), AT_PK(p0, 6)}; pw1 = (u32x4){AT_PK(p0, 8), AT_PK(p0, 10), AT_PK(p0, 12), AT_PK(p0, 14)};
            pw2 = (u32x4){AT_PK(p1, 0), AT_PK(p1, 2), AT_PK(p1, 4), AT_PK(p1, 6)}; pw3 = (u32x4){AT_PK(p1, 8), AT_PK(p1, 10), AT_PK(p1, 12), AT_PK(p1, 14)};
#undef AT_PK
            AT_LAS const char* vp = vp0 + sl_cur;
#pragma unroll
            for (int d0 = 0; d0 < 2; ++d0) { s16x4 lo[4], hh[4];
#pragma unroll
                for (int ks = 0; ks < 4; ++ks) { lo[ks] = vtr(vp + d0 * 4096 + ks * 1024); hh[ks] = vtr(vp + d0 * 4096 + ks * 1024 + 512); }
#define AT_VF(k) (bf16x8){lo[k][0], lo[k][1], lo[k][2], lo[k][3], hh[k][0], hh[k][1], hh[k][2], hh[k][3]}
                o[d0] = __builtin_amdgcn_mfma_f32_32x32x16_bf16(__builtin_bit_cast(bf16x8, pw0), AT_VF(0), o[d0], 0, 0, 0);
                o[d0] = __builtin_amdgcn_mfma_f32_32x32x16_bf16(__builtin_bit_cast(bf16x8, pw1), AT_VF(1), o[d0], 0, 0, 0);
                o[d0] = __builtin_amdgcn_mfma_f32_32x32x16_bf16(__builtin_bit_cast(bf16x8, pw2), AT_VF(2), o[d0], 0, 0, 0);
                o[d0] = __builtin_amdgcn_mfma_f32_32x32x16_bf16(__builtin_bit_cast(bf16x8, pw3), AT_VF(3), o[d0], 0, 0, 0);
#undef AT_VF
            }
        }
        sl_cur = (sl_cur == 2 * SLOTB) ? 0 : sl_cur + SLOTB; sl_nn = (sl_nn == 2 * SLOTB) ? 0 : sl_nn + SLOTB;
    }
    { auto rr = __builtin_amdgcn_permlane32_swap(__float_as_uint(l_reg), __float_as_uint(l_reg), false, false); l_reg = __uint_as_float(rr[0]) + __uint_as_float(rr[1]); }
    if (hi == 0) wsf[32 + r32] = __builtin_amdgcn_rcpf(l_reg);
    asm volatile("s_waitcnt lgkmcnt(0)" ::: "memory");
    AT_LAS char* stg = shm + LDS_OST + wid * (32 * OROW);
#pragma unroll
    for (int r = 0; r < 16; ++r) { const int orow = crow(r, hi); const float rl = wsf[32 + orow];
        *(AT_LAS float*)(stg + orow * OROW + r32 * 4) = o[0][r] * rl; *(AT_LAS float*)(stg + orow * OROW + 128 + r32 * 4) = o[1][r] * rl; }
    asm volatile("s_waitcnt lgkmcnt(0)" ::: "memory");
    { const int row = lane >> 1, half = lane & 1; const size_t grow = rowbase + q0 + wid * 32 + row; float ss = 0.f;
      const float* gp = goa + h * 64 + half * 32; bf16_t* yp = Y + grow * DM + 512 + h * 64 + half * 32;
#pragma unroll
      for (int i = 0; i < 4; ++i) { const f32x4 a = *(AT_LAS const f32x4*)(stg + row * OROW + half * 128 + i * 32), c = *(AT_LAS const f32x4*)(stg + row * OROW + half * 128 + i * 32 + 16);
          ss += pg8::hsq4(a) + pg8::hsq4(c);
          *(u32x4*)(yp + i * 8) = pg8::pack8(a * *(const f32x4*)(gp + i * 8), c * *(const f32x4*)(gp + i * 8 + 4)); }
      ss += swz_xor1(ss); if (half == 0) ssqy[grow * 16 + 8 + h] = ss; }
    asm volatile("s_waitcnt lgkmcnt(0)\n\ts_barrier" ::: "memory");
#undef AT_DMA
}
__device__ __forceinline__ void attn_phase(AT_LAS char* lds, int wid0, int vcu, const bf16_t* Q, const bf16_t* KN, const bf16_t* KR, const bf16_t* V, const float* goa, bf16_t* Y, float* ssqy) {
    const int bh = vcu >> 1, s = vcu & 1;
    for (int i = 0; i < 4; ++i) { const int qb = (i == 0) ? s : (i == 1) ? 7 - s : (i == 2) ? 2 + s : 5 - s;
        attn_unit<8>(bh >> 3, bh & 7, qb, Q, KN, KR, V, goa, Y, ssqy, lds, wid0); }
}
}

constexpr int NWAVES = 8;
struct Args { const void* in[20]; float* out; unsigned char* ws; int ph_lo, ph_hi, li, flags; };
namespace pro {
#define PR_LAS __attribute__((address_space(3)))
__device__ __forceinline__ unsigned pk2(float lo, float hi) { return (unsigned)f2bf(lo) | ((unsigned)f2bf(hi) << 16); }
template <int MODE  >
__device__ __forceinline__ void tr_item(const float* W, int ldw, bf16_t* WT, int out_ld, int out_koff, int nblk, PR_LAS float* scr, int item, int lane) {
    const int kb = item / nblk, nb = item - kb * nblk, k0 = 64 * kb, n0 = 32 * nb;
    const int pn = n0 + (lane & 31); const int sc0 = MODE == 0 ? pn : (MODE == 1 ? win_src(pn) : wup_qcol(pn));
    const int sc = sc0 >= 0 ? sc0 : 0; const float msk = sc0 >= 0 ? 1.f : 0.f;
    const float* wp = W + (size_t)(k0 + (lane >> 5)) * ldw + sc;
    float v[32];
#pragma unroll
    for (int i = 0; i < 32; ++i) v[i] = wp[(size_t)(2 * i) * ldw];
#pragma unroll
    for (int i = 0; i < 32; ++i) scr[(2 * i + (lane >> 5)) * 33 + (lane & 31)] = v[i] * msk;
    asm volatile("s_waitcnt lgkmcnt(0)" ::: "memory");
    const int c = lane & 7;
#pragma unroll
    for (int j = 0; j < 4; ++j) { const int n = (lane >> 3) + 8 * j; const PR_LAS float* s = scr + (8 * c) * 33 + n;
        pg8::u32x4 o; o.x = pk2(s[0 * 33], s[1 * 33]); o.y = pk2(s[2 * 33], s[3 * 33]); o.z = pk2(s[4 * 33], s[5 * 33]); o.w = pk2(s[6 * 33], s[7 * 33]);
        *(pg8::u32x4*)(WT + (size_t)(n0 + n) * out_ld + out_koff + k0 + 8 * c) = o; }
    asm volatile("s_waitcnt lgkmcnt(0)" ::: "memory");
}
__device__ __forceinline__ void smallm_unit(PR_LAS unsigned char* lds, int tid, const float* in, int in_stride, bool act, const float* W, int ldw, int N, bool winmap, const float* bias, float* out, int out_stride, int p0, int ucols) {
    PR_LAS float* sin_ = (PR_LAS float*)lds; PR_LAS float* red = (PR_LAS float*)(lds + 65536);
    const int lane = tid & 63, wave = tid >> 6;
#pragma unroll 8
    for (int e = tid; e < 16 * 1024; e += 512) { const int b = e >> 10, k = e & 1023; float v = in[(size_t)b * in_stride + k]; if (act) v = v * __builtin_amdgcn_rcpf(1.f + __expf(-v)); sin_[k * 16 + b] = v; }
    __syncthreads();
    const int p = p0 + lane; const int s0 = winmap ? win_src(p) : p; const bool ok = (lane < ucols && s0 >= 0 && s0 < N);
    const int sc = ok ? s0 : 0; const float msk = ok ? 1.f : 0.f;
    const float* wp = W + (size_t)(wave * 128) * ldw + sc;
    float acc[16];
#pragma unroll
    for (int b = 0; b < 16; ++b) acc[b] = 0.f;
    for (int k0 = 0; k0 < 128; k0 += 16) {
        float w[16];
#pragma unroll
        for (int j = 0; j < 16; ++j) w[j] = wp[(size_t)(k0 + j) * ldw];
#pragma unroll
        for (int j = 0; j < 16; ++j) { const PR_LAS f32x4* sp = (const PR_LAS f32x4*)(sin_ + (wave * 128 + k0 + j) * 16);
#pragma unroll
            for (int q = 0; q < 4; ++q) { const f32x4 v = sp[q]; acc[4 * q] += v[0] * w[j]; acc[4 * q + 1] += v[1] * w[j]; acc[4 * q + 2] += v[2] * w[j]; acc[4 * q + 3] += v[3] * w[j]; } }
    }
#pragma unroll
    for (int b = 0; b < 16; ++b) red[(wave * 64 + lane) * 16 + b] = acc[b] * msk;
    __syncthreads();
    for (int e = tid; e < 64 * 16; e += 512) { const int l = e >> 4, b = e & 15; float sum = 0.f;
#pragma unroll
        for (int w = 0; w < 8; ++w) sum += red[(w * 64 + l) * 16 + b];
        if (l < ucols) out[(size_t)b * out_stride + p0 + l] = sum + (bias ? bias[p0 + l] : 0.f); }
    __syncthreads();
}
__device__ __forceinline__ float wsum(float v) {
    v += __int_as_float(__builtin_amdgcn_ds_swizzle(__float_as_int(v), 0x041F)); v += __int_as_float(__builtin_amdgcn_ds_swizzle(__float_as_int(v), 0x081F));
    v += __int_as_float(__builtin_amdgcn_ds_swizzle(__float_as_int(v), 0x101F)); v += __int_as_float(__builtin_amdgcn_ds_swizzle(__float_as_int(v), 0x201F));
    v += __int_as_float(__builtin_amdgcn_ds_swizzle(__float_as_int(v), 0x401F));
    auto rr = __builtin_amdgcn_permlane32_swap(__float_as_uint(v), __float_as_uint(v), false, false); return __uint_as_float(rr[0]) + __uint_as_float(rr[1]);
}
__device__ __forceinline__ void phase0a(PR_LAS unsigned char* lds, int wid0, int vcu, int G, const Args& args, int zi, unsigned char* ws) {
    int tid_ = wid0 * 64 + lane_id(); asm volatile("" : "+v"(tid_));
    const int tid = tid_, lane = tid & 63, wave = tid >> 6;
#define PIN(i) ((const float*)args.in[(i) + zi])
    for (int un = vcu; un < DEPTH * (NMOD / 48); un += G) { const int l = un / (NMOD / 48), p0 = (un % (NMOD / 48)) * 48;
        smallm_unit(lds, tid, PIN(1), DM, true, PIN(3) + (size_t)l * DM * NMOD, NMOD, NMOD, false, PIN(4) + (size_t)l * NMOD, (float*)(ws + WS_MOD) + (size_t)l * NB * NMOD, NMOD, p0, 48); }
    { const int* pos = (const int*)args.in[2 + zi]; float* rope = (float*)(ws + WS_ROPE);
      for (int idx = vcu * 512 + tid; idx < T * 16; idx += G * 512) { const int t = idx >> 4, i = idx & 15;
          const float freq = exp2f(-(float)i * (13.287712379549449f / 16.0f)); const float ang = (float)pos[t] * freq;
          rope[t * 32 + i] = cosf(ang); rope[t * 32 + 16 + i] = sinf(ang); } }
    { const float* gws = PIN(7); bf16_t* gw = (bf16_t*)(ws + WS_GW);
      for (int idx = vcu * 512 + tid; idx < DEPTH * NGRP * CHUNK * CHUNK; idx += G * 512) { const int s = idx & 127, t = (idx >> 7) & 127; gw[idx] = (s <= t) ? f2bf(gws[idx]) : (bf16_t)0; } }
    PR_LAS float* scr = (PR_LAS float*)(lds + wave * 16384);
    const int gw_ = vcu * NWAVES + wave, NGW = G * NWAVES;
    constexpr int I_IN = (DM / 64) * (NIN / 32), I_UQ = (QR / 64) * (768 / 32), I_UKV = (KVR / 64) * (1024 / 32), I_OUT = (DM / 64) * (DM / 32), I_1 = (DM / 64) * (DFF / 32), I_2 = (DFF / 64) * (DM / 32);
    constexpr int I_LAYER = I_IN + I_UQ + I_UKV + I_OUT + I_1 + I_2;
    for (int it = gw_; it < DEPTH * I_LAYER; it += NGW) {
        const int l = it / I_LAYER; int r = it - l * I_LAYER; unsigned char* wl = ws + WS_W + (size_t)l * WL_STRIDE;
        if (r < I_IN) { tr_item<1>(PIN(6) + (size_t)l * DM * DIN, DIN, (bf16_t*)(wl + WL_IN), DM, 0, NIN / 32, scr, r, lane); continue; } r -= I_IN;
        if (r < I_UQ) { tr_item<2>(PIN(11) + (size_t)l * QR * 768, 768, (bf16_t*)(wl + WL_UP), KUP, 0, 768 / 32, scr, r, lane); continue; } r -= I_UQ;
        if (r < I_UKV) { tr_item<0>(PIN(12) + (size_t)l * KVR * 1024, 1024, (bf16_t*)(wl + WL_UP) + (size_t)768 * KUP, KUP, 256, 1024 / 32, scr, r, lane); continue; } r -= I_UKV;
        if (r < I_OUT) { tr_item<0>(PIN(15) + (size_t)l * DM * DM, DM, (bf16_t*)(wl + WL_OUT), DM, 0, DM / 32, scr, r, lane); continue; } r -= I_OUT;
        if (r < I_1) { tr_item<0>(PIN(17) + (size_t)l * DM * DFF, DFF, (bf16_t*)(wl + WL_1), DM, 0, DFF / 32, scr, r, lane); continue; } r -= I_1;
        tr_item<0>(PIN(18) + (size_t)l * DFF * DM, DM, (bf16_t*)(wl + WL_2), DFF, 0, DM / 32, scr, r, lane);
    }
    for (int idx = vcu * 512 + tid; idx < DEPTH * (768 * 16 + 1024 * 32); idx += G * 512) {
        const int l = idx / (768 * 16 + 1024 * 32); int r = idx - l * (768 * 16 + 1024 * 32); bf16_t* wup = (bf16_t*)(ws + WS_W + (size_t)l * WL_STRIDE + WL_UP);
        pg8::u32x4 z; z.x = 0u; z.y = 0u; z.z = 0u; z.w = 0u;
        if (r < 768 * 16) { const int row = r >> 4, c = r & 15; *(pg8::u32x4*)(wup + (size_t)row * KUP + 256 + 8 * c) = z; }
        else { r -= 768 * 16; const int row = 768 + (r >> 5), c = r & 31; *(pg8::u32x4*)(wup + (size_t)row * KUP + 8 * c) = z; } }
#undef PIN
}
__device__ __forceinline__ void phase0b(PR_LAS unsigned char* lds, int wid0, int vcu, int G, const Args& args, int zi, unsigned char* ws) {
    int tid_ = wid0 * 64 + lane_id(); asm volatile("" : "+v"(tid_));
    const int tid = tid_, lane = tid & 63, wave = tid >> 6;
#define PIN(i) ((const float*)args.in[(i) + zi])
    float* MOD = (float*)(ws + WS_MOD);
    constexpr int U1 = NIN / 48, U2 = DFF / 64, NUNITS = DEPTH * (U1 + U2);
    for (int un = vcu; un < NUNITS; un += G) { const int l = un / (U1 + U2), r = un % (U1 + U2); const float* modl = MOD + (size_t)l * NB * NMOD;
        if (r < U1) smallm_unit(lds, tid, modl, NMOD, false, PIN(6) + (size_t)l * DM * DIN, DIN, DIN, true, nullptr, (float*)(ws + WS_SHW1) + (size_t)l * NB * NIN, NIN, r * 48, 48);
        else smallm_unit(lds, tid, modl + 3 * DM, NMOD, false, PIN(17) + (size_t)l * DM * DFF, DFF, DFF, false, nullptr, (float*)(ws + WS_SHW2) + (size_t)l * NB * DFF, DFF, (r - U1) * 64, 64); }
    for (int idx = vcu * 512 + tid; idx < DEPTH * NB * DM; idx += G * 512) { const int c = idx & 1023, b = (idx >> 10) & 15, l = idx >> 14; const float* m = MOD + ((size_t)l * NB + b) * NMOD;
        ((float*)(ws + WS_GM1))[idx] = PIN(5)[l * DM + c] * (1.f + m[1 * DM + c]); ((float*)(ws + WS_GM2))[idx] = PIN(16)[l * DM + c] * (1.f + m[4 * DM + c]); }
    { const float* x = PIN(0); const float* g = PIN(5); bf16_t* A = (bf16_t*)(ws + WS_A); float* ssq = (float*)(ws + WS_SSQ1);
      const int nun = NUNITS < G ? NUNITS : G; const int wgt = vcu < nun ? 7 : 12, slot0 = vcu < nun ? 7 * vcu : 7 * nun + 12 * (vcu - nun), nslot = 7 * nun + 12 * (G - nun);
      for (int sl = 0; sl < wgt; ++sl)
      for (int row = (slot0 + sl) * NWAVES + wave; row < T; row += nslot * NWAVES) { const int b = row / SEQ; const f32x4* xr = (const f32x4*)(x + (size_t)row * DM); const float* sc = MOD + (size_t)b * NMOD + DM; float s = 0.f;
#pragma unroll
          for (int j = 0; j < 4; ++j) { const f32x4 v = xr[lane + 64 * j]; s += pg8::hsq4(v); const int c = 4 * (lane + 64 * j); const f32x4 gv = *(const f32x4*)(g + c), sv = *(const f32x4*)(sc + c);
              *(pg8::u32x2*)(A + (size_t)row * DM + c) = pg8::pack4(v * gv * (sv + 1.f)); }
          s = wsum(s); if (lane < 16) ssq[(size_t)row * 16 + lane] = (lane == 0) ? s : 0.f; } }
#undef PIN
}
__device__ __forceinline__ void phase_final(int wid0, int vcu, int G, const float* g, float* out, float* dst) {
    int tid_ = wid0 * 64 + lane_id(); asm volatile("" : "+v"(tid_));
    const int lane = tid_ & 63, wave = tid_ >> 6;
    for (int row = vcu * NWAVES + wave; row < T; row += G * NWAVES) { const f32x4* xr = (const f32x4*)(out + (size_t)row * DM); f32x4* yr = (f32x4*)(dst + (size_t)row * DM); f32x4 v[4]; float s = 0.f;
#pragma unroll
        for (int j = 0; j < 4; ++j) { v[j] = xr[lane + 64 * j]; s += pg8::hsq4(v[j]); }
        const float rstd = rsqrtf(wsum(s) * (1.f / DM) + EPS);
#pragma unroll
        for (int j = 0; j < 4; ++j) { const f32x4 gv = *(const f32x4*)(g + 4 * (lane + 64 * j)); yr[lane + 64 * j] = v[j] * rstd * gv; } }
}
}

constexpr int RING_BYTES = 131072;
constexpr int LDSCTL_OFF = 135168, MISC_OFF = LDSCTL_OFF + 320;
constexpr int LDS_BYTES = 147456;
static_assert(att::LDS_BYTES <= LDSCTL_OFF, "attention scratch below the control words");
constexpr int CW_BAR = 4096;
constexpr size_t CTL_ZERO_BYTES = 64 * 1024;

#define GAS __attribute__((address_space(1)))
#define LAS __attribute__((address_space(3)))
typedef GAS unsigned gu32;
#define RLX_AGENT __ATOMIC_RELAXED, __HIP_MEMORY_SCOPE_AGENT
#define XB_TMO      128
#define XB_XCNT(j)  (256  + 64 * (j))
#define XB_XSUB(j)  (1280 + 64 * (j))
#define XB_XGEN(j)  (2304 + 64 * (j))
#define XB_TOP      3328
#define XB_TOPGEN   3392
#define XCD_BAR_WORDS 3456
#define XB_SPIN_CAP (1u << 18)
__device__ __forceinline__ unsigned xb_ld(unsigned* p)              { return __hip_atomic_load(p, __ATOMIC_RELAXED, __HIP_MEMORY_SCOPE_AGENT); }
__device__ __forceinline__ unsigned xb_add(unsigned* p, unsigned v) { return __hip_atomic_fetch_add(p, v, __ATOMIC_RELAXED, __HIP_MEMORY_SCOPE_AGENT); }
__device__ __forceinline__ unsigned xb_xcc_id() { return (unsigned)__builtin_amdgcn_s_getreg((3 << 11) | 20) & 0xFu; }
#define XB_SPIN(cond, bar) do { unsigned _sp = 0; while (cond) { __builtin_amdgcn_s_sleep(1); \
    if ((++_sp & 255u) == 0u) { if (xb_ld(&(bar)[XB_TMO])) break; if (_sp > XB_SPIN_CAP) { atomicAdd(&(bar)[XB_TMO], 1u); break; } } } } while (0)
struct XcdBarrier { unsigned* bar; unsigned x; volatile LAS unsigned* st; };
__device__ __forceinline__ XcdBarrier xcd_barrier_post(unsigned* bar, volatile LAS unsigned* st, int wid0) {
    XcdBarrier b; b.bar = bar; b.x = xb_xcc_id(); b.st = st;
    if (wid0 == 0 && lane_id() == 0) (void)xb_add(&bar[XB_XCNT(b.x)], 1u);
    return b;
}
__device__ __forceinline__ void xcd_barrier_complete(unsigned* bar, unsigned x, unsigned& nloc, unsigned& nx) {
    const unsigned G = gridDim.x * gridDim.y * gridDim.z;
    unsigned sum, cnt, mine, sp = 0u;
    for (;;) {
        sum = 0u; cnt = 0u; mine = 0u;
#pragma unroll
        for (unsigned j = 0; j < 16; ++j) { const unsigned c = xb_ld(&bar[XB_XCNT(j)]); sum += c; cnt += (c > 0u) ? 1u : 0u; mine = (j == x) ? c : mine; }
        if (sum == G) break;
        __builtin_amdgcn_s_sleep(1);
        if ((++sp & 255u) == 0u) { if (xb_ld(&bar[XB_TMO])) break; if (sp > XB_SPIN_CAP) { atomicAdd(&bar[XB_TMO], 1u); break; } }
    }
    nloc = mine > 0u ? mine : 1u; nx = cnt > 0u ? cnt : 1u;
}
__device__ __forceinline__ void xcd_barrier(const XcdBarrier& b, int wid0) {
    asm volatile("s_waitcnt vmcnt(0)" ::: "memory");
    __syncthreads();
    if (wid0 == 0 && lane_id() == 0) {
        unsigned zo = 0; asm volatile("" : "+s"(zo));
        unsigned* bar = b.bar + zo;
        __builtin_amdgcn_s_waitcnt(0);
        unsigned nloc = b.st[0], nx = b.st[1];
        if (nloc == 0u) { xcd_barrier_complete(bar, b.x, nloc, nx); b.st[0] = nloc; b.st[1] = nx; }
        const unsigned old = xb_add(&bar[XB_XSUB(b.x)], 1u);
        const unsigned gen = old / nloc;
        if (old + 1u == (gen + 1u) * nloc) {
            __builtin_amdgcn_fence(__ATOMIC_RELEASE, "agent");
            asm volatile("s_waitcnt vmcnt(0)" ::: "memory");
            const unsigned og = xb_add(&bar[XB_TOP], 1u);
            const unsigned tg = og / nx;
            if (og + 1u == (tg + 1u) * nx) xb_add(&bar[XB_TOPGEN], 1u);
            else XB_SPIN(xb_ld(&bar[XB_TOPGEN]) == tg, bar);
            __builtin_amdgcn_fence(__ATOMIC_ACQUIRE, "agent");
            xb_add(&bar[XB_XGEN(b.x)], 1u);
            asm volatile("s_waitcnt vmcnt(0)" ::: "memory");
        } else {
            XB_SPIN(xb_ld(&bar[XB_XGEN(b.x)]) == gen, bar);
            __builtin_amdgcn_fence(__ATOMIC_ACQUIRE, "agent");
            asm volatile("s_waitcnt vmcnt(0)" ::: "memory");
        }
    }
    __syncthreads();
}

constexpr int PH_P0A = 0, PH_P0B = 1, PH_L0 = 2, PH_PER_LAYER = 7, PH_FINAL = PH_L0 + DEPTH * PH_PER_LAYER, PH_END = PH_FINAL + 1;

#ifdef PROBE_SEL
#define MK_STAMP(i) do { if (wid0 == 0 && lane_id() == 0) ((volatile LAS unsigned long long*)(L + LDSCTL_OFF + 1024))[(i)] = __builtin_amdgcn_s_memrealtime(); } while (0)
#else
#define MK_STAMP(i) do {} while (0)
#endif
#define MK_IN_(k) (lo <= (k) && (k) < hi)
#define MK_SEAM(k) do { if (MK_IN_(k) && MK_IN_((k) + 1)) xcd_barrier(bar, wid0); } while (0)
#define MK_PTRS() int zi = 0; asm volatile("" : "+s"(zi)); unsigned char* ws = args.ws + zi; float* out = args.out + zi; (void)out; (void)ws
#define INP(i) ((const float*)args.in[(i) + zi])
template <int l>
__device__ __forceinline__ void layer_phases(const Args& args, LAS unsigned char* L, const XcdBarrier& bar, int wid0, int vcu, int G, int bx, int lo, int hi) {
    constexpr int P = PH_L0 + l * PH_PER_LAYER;
    if (MK_IN_(P + 0)) { MK_STAMP(2 * (P + 0)); MK_PTRS();
        pg8::Gemm g{(bf16_t*)(ws + WS_A), (const bf16_t*)(ws + WS_W + (size_t)l * WL_STRIDE + WL_IN), T, NIN, DM}; pg8::StaticOrder S; S.init(T, NIN, G, bx);
        pg8::EpiIn E{(float*)(ws + WS_SSQ1), (float*)(ws + WS_SHW1) + (size_t)l * NB * NIN, INP(9) + l * QR, INP(10) + l * KVR, (float*)(ws + WS_ROPE), (bf16_t*)(ws + WS_U), (bf16_t*)(ws + WS_VN), (bf16_t*)(ws + WS_CQKV), (bf16_t*)(ws + WS_KR), (float*)(ws + WS_SSQQ)};
        pg8::gemm_phase<pg8::EpiIn, pg8::StaticOrder, true, true>(L, g, S, E, wid0); }
    MK_STAMP(2 * (P + 0) + 1); MK_SEAM(P + 0);
    if (MK_IN_(P + 1)) { MK_STAMP(2 * (P + 1)); MK_PTRS();
        pg8::Gemm g{(bf16_t*)(ws + WS_CQKV), (const bf16_t*)(ws + WS_W + (size_t)l * WL_STRIDE + WL_UP), T, NUP, KUP}; pg8::StaticOrder S; S.init(T, NUP, G, bx);
        pg8::EpiUp E{(float*)(ws + WS_SSQQ), (float*)(ws + WS_ROPE), (bf16_t*)(ws + WS_Q), (bf16_t*)(ws + WS_KN), (bf16_t*)(ws + WS_V)};
        pg8::gemm_phase<pg8::EpiUp, pg8::StaticOrder, true, true>(L, g, S, E, wid0); MK_STAMP(2 * (P + 1) + 1); }
    if (MK_IN_(P + 2)) { MK_STAMP(2 * (P + 2)); MK_PTRS();
        gm::gmlp_phase(L, wid0, vcu, (bf16_t*)(ws + WS_U), (bf16_t*)(ws + WS_VN), (bf16_t*)(ws + WS_GW) + (size_t)l * NGRP * CHUNK * CHUNK, INP(8) + l * NGRP * CHUNK, INP(13) + l * DG, (bf16_t*)(ws + WS_Y), (float*)(ws + WS_SSQY)); }
    MK_STAMP(2 * (P + 2) + 1); MK_SEAM(P + 2);
    if (MK_IN_(P + 3)) { MK_STAMP(2 * (P + 3)); MK_PTRS();
        att::attn_phase((LAS char*)L, wid0, vcu, (bf16_t*)(ws + WS_Q), (bf16_t*)(ws + WS_KN), (bf16_t*)(ws + WS_KR), (bf16_t*)(ws + WS_V), INP(14) + l * DG, (bf16_t*)(ws + WS_Y), (float*)(ws + WS_SSQY)); }
    MK_STAMP(2 * (P + 3) + 1); MK_SEAM(P + 3);
    if (MK_IN_(P + 4)) { MK_STAMP(2 * (P + 4)); MK_PTRS();
        pg8::Gemm g{(bf16_t*)(ws + WS_Y), (const bf16_t*)(ws + WS_W + (size_t)l * WL_STRIDE + WL_OUT), T, DM, DM}; pg8::StaticOrder S; S.init(T, DM, G, bx);
        pg8::EpiRes<true> E{(float*)(ws + WS_SSQY), l == 0 ? INP(0) : (const float*)out, out, (float*)(ws + WS_MOD) + (size_t)l * NB * NMOD + 2 * DM, (float*)(ws + WS_GM2) + (size_t)l * NB * DM, (bf16_t*)(ws + WS_A), (float*)(ws + WS_SSQ2)};
        pg8::gemm_phase<pg8::EpiRes<true>, pg8::StaticOrder, true, true>(L, g, S, E, wid0); }
    MK_STAMP(2 * (P + 4) + 1); MK_SEAM(P + 4);
    if (MK_IN_(P + 5)) { MK_STAMP(2 * (P + 5)); MK_PTRS();
        pg8::Gemm g{(bf16_t*)(ws + WS_A), (const bf16_t*)(ws + WS_W + (size_t)l * WL_STRIDE + WL_1), T, DFF, DM}; pg8::StaticOrder S; S.init(T, DFF, G, bx);
        pg8::EpiFf1 E{(float*)(ws + WS_SSQ2), (float*)(ws + WS_SHW2) + (size_t)l * NB * DFF, (bf16_t*)(ws + WS_H)};
        pg8::gemm_phase<pg8::EpiFf1, pg8::StaticOrder, true, true>(L, g, S, E, wid0); }
    MK_STAMP(2 * (P + 5) + 1); MK_SEAM(P + 5);
    if (MK_IN_(P + 6)) { MK_STAMP(2 * (P + 6)); MK_PTRS();
        pg8::Gemm g{(bf16_t*)(ws + WS_H), (const bf16_t*)(ws + WS_W + (size_t)l * WL_STRIDE + WL_2), T, DM, DFF}; pg8::StaticOrder S; S.init(T, DM, G, bx);
        float* xo = out; if (l == DEPTH - 1) { if (__builtin_amdgcn_readfirstlane(args.flags) & 1) xo = (float*)(ws + WS_DUMMY); }
        pg8::EpiRes<false> E{nullptr, out, xo, (float*)(ws + WS_MOD) + (size_t)l * NB * NMOD + 5 * DM, (l + 1 < DEPTH) ? (float*)(ws + WS_GM1) + (size_t)(l + 1) * NB * DM : nullptr, (bf16_t*)(ws + WS_A), (float*)(ws + WS_SSQ1)};
        pg8::gemm_phase<pg8::EpiRes<false>, pg8::StaticOrder, true, true>(L, g, S, E, wid0); }
    MK_STAMP(2 * (P + 6) + 1); MK_SEAM(P + 6);
}
__global__ void __launch_bounds__(NWAVES * 64, 2) mk_fwd(Args args) {
    extern __shared__ __attribute__((aligned(16))) unsigned char lds[];
    LAS unsigned char* L = (LAS unsigned char*)lds;
    volatile LAS unsigned* MISC = (volatile LAS unsigned*)(L + MISC_OFF);
    const int wid0 = __builtin_amdgcn_readfirstlane((int)threadIdx.x >> 6);
    const int G = gridDim.x, bx = blockIdx.x, vcu = (G % 8 == 0) ? (bx % 8) * (G / 8) + bx / 8 : bx;
    { const int t0 = wid0 * 64 + lane_id(); for (int u = t0; u < (LDS_BYTES - LDSCTL_OFF) / 4; u += NWAVES * 64) ((LAS unsigned*)(L + LDSCTL_OFF))[u] = 0u; }
    __syncthreads();
    const int lo = __builtin_amdgcn_readfirstlane(args.ph_lo), hi = __builtin_amdgcn_readfirstlane(args.ph_hi);
    unsigned* barw = (unsigned*)(args.ws + WS_CTL) + CW_BAR + __builtin_amdgcn_readfirstlane(args.li) * XCD_BAR_WORDS;
    XcdBarrier bar; bar.bar = barw; bar.x = 0; bar.st = nullptr;
    if (hi - lo > 1) bar = xcd_barrier_post(barw, MISC + 8, wid0);
    if (MK_IN_(PH_P0A)) { MK_STAMP(2 * (PH_P0A)); MK_PTRS(); pro::phase0a(L, wid0, vcu, G, args, zi, ws); }
    MK_STAMP(2 * PH_P0A + 1); MK_SEAM(PH_P0A);
    if (MK_IN_(PH_P0B)) { MK_STAMP(2 * (PH_P0B)); MK_PTRS(); pro::phase0b(L, wid0, vcu, G, args, zi, ws); }
    MK_STAMP(2 * PH_P0B + 1); MK_SEAM(PH_P0B);
    layer_phases<0>(args, L, bar, wid0, vcu, G, bx, lo, hi);
    layer_phases<1>(args, L, bar, wid0, vcu, G, bx, lo, hi);
    if (MK_IN_(PH_FINAL)) { MK_STAMP(2 * (PH_FINAL)); MK_PTRS(); pro::phase_final(wid0, vcu, G, INP(19), out, (__builtin_amdgcn_readfirstlane(args.flags) & 2) ? (float*)(ws + WS_DUMMY) : out); }
    MK_STAMP(2 * PH_FINAL + 1);
#ifdef PROBE_SEL
    if (bx == 0 && wid0 == 0 && lane_id() == 0) {
        volatile LAS unsigned long long* st = (volatile LAS unsigned long long*)(L + LDSCTL_OFF + 1024); unsigned long long sel = 0;
        if (PROBE_SEL >= 0) sel = st[2 * PROBE_SEL + 1] - st[2 * PROBE_SEL];
        else { for (int k = 0; k < PH_FINAL; ++k) if (k != PH_L0 + 1 && k != PH_L0 + PH_PER_LAYER + 1) { int nx = k + 1; sel += st[2 * nx] - st[2 * k + 1]; } }
        const unsigned long long t0 = __builtin_amdgcn_s_memrealtime(), t1 = t0 + PROBE_MULT * sel;
        while (__builtin_amdgcn_s_memrealtime() < t1) __builtin_amdgcn_s_sleep(8);
    }
#endif
}

#ifndef ONE_LAUNCH
#define ONE_LAUNCH 1
#endif
#ifndef MK_PRO
#define MK_PRO 1
#endif
#ifndef MK_IN
#define MK_IN 1
#endif
#ifndef MK_UP
#define MK_UP 1
#endif
#ifndef MK_GMLP
#define MK_GMLP 1
#endif
#ifndef MK_ATTN
#define MK_ATTN 1
#endif
#ifndef MK_OUT
#define MK_OUT 1
#endif
#ifndef MK_FF1
#define MK_FF1 1
#endif
#ifndef MK_FF2
#define MK_FF2 1
#endif
template <class Epi> static void gemm_naive(hipStream_t st, const bf16_t* A, int lda, const bf16_t* Bt, int ldb, int M, int N, int K, const Epi& e) {
    hipLaunchKernelGGL((k_gemm_naive<Epi>), dim3(N / 64, M / 64), dim3(256), 0, st, A, lda, Bt, ldb, K, e);
}
static int g_grid = 0;
static void launch_mk(hipStream_t st, Args a, int lo, int hi, int li = 0, int flags = 0) {
    a.ph_lo = lo; a.ph_hi = hi; a.li = li; a.flags = flags;
    hipLaunchKernelGGL(mk_fwd, dim3(g_grid), dim3(NWAVES * 64), LDS_BYTES, st, a);
}
extern "C" void kernel_launch(void* const* d_in, const int* in_sizes, int n_in, void* d_out, int out_size, void* d_ws, size_t ws_size, hipStream_t stream) {
    if (n_in != 20 || out_size != T * DM || ws_size < WS_END) { fprintf(stderr, "kernel_launch: unexpected sizes n_in %d out %d ws %zu\n", n_in, out_size, ws_size); return; }
    if (g_grid == 0) {
        int dev = 0, cus = 0; hipGetDevice(&dev); hipDeviceGetAttribute(&cus, hipDeviceAttributeMultiprocessorCount, dev);
        if (hipFuncSetAttribute((const void*)mk_fwd, hipFuncAttributeMaxDynamicSharedMemorySize, LDS_BYTES) != hipSuccess) fprintf(stderr, "kernel_launch: hipFuncSetAttribute failed\n");
        g_grid = cus > 0 ? cus : 256;
    }
    const float* x = (const float*)d_in[0]; const float* c = (const float*)d_in[1]; const int* pos = (const int*)d_in[2];
    const float* w_ada = (const float*)d_in[3]; const float* b_ada = (const float*)d_in[4]; const float* g_mix = (const float*)d_in[5];
    const float* w_in = (const float*)d_in[6]; const float* g_ws = (const float*)d_in[7]; const float* g_bs = (const float*)d_in[8];
    const float* g_q = (const float*)d_in[9]; const float* g_kv = (const float*)d_in[10]; const float* w_uq = (const float*)d_in[11]; const float* w_ukv = (const float*)d_in[12];
    const float* g_og = (const float*)d_in[13]; const float* g_oa = (const float*)d_in[14]; const float* w_out = (const float*)d_in[15];
    const float* g_ffn = (const float*)d_in[16]; const float* w_ff1 = (const float*)d_in[17]; const float* w_ff2 = (const float*)d_in[18]; const float* g_fin = (const float*)d_in[19];
    unsigned char* ws = (unsigned char*)d_ws; float* out = (float*)d_out;
    float* MOD = (float*)(ws + WS_MOD); float* SHW1 = (float*)(ws + WS_SHW1); float* SHW2 = (float*)(ws + WS_SHW2); float* RT = (float*)(ws + WS_ROPE);
    float* GM1 = (float*)(ws + WS_GM1); float* GM2 = (float*)(ws + WS_GM2);
    float* SSQ1 = (float*)(ws + WS_SSQ1); float* SSQ2 = (float*)(ws + WS_SSQ2); float* SSQY = (float*)(ws + WS_SSQY); float* SSQQ = (float*)(ws + WS_SSQQ);
    bf16_t* GW = (bf16_t*)(ws + WS_GW); bf16_t* A = (bf16_t*)(ws + WS_A); bf16_t* U = (bf16_t*)(ws + WS_U); bf16_t* VN = (bf16_t*)(ws + WS_VN);
    bf16_t* CQKV = (bf16_t*)(ws + WS_CQKV); bf16_t* KR = (bf16_t*)(ws + WS_KR); bf16_t* Q = (bf16_t*)(ws + WS_Q); bf16_t* KN = (bf16_t*)(ws + WS_KN); bf16_t* V = (bf16_t*)(ws + WS_V);
    bf16_t* Y = (bf16_t*)(ws + WS_Y); bf16_t* H = (bf16_t*)(ws + WS_H); float* GV = (float*)(ws + WS_GV); float* ZL = (float*)(ws + WS_ZL); float* QRT = (float*)(ws + WS_QRT);
    auto WL = [&](int l, size_t off) { return (bf16_t*)(ws + WS_W + (size_t)l * WL_STRIDE + off); };
    Args a{}; for (int i = 0; i < 20; ++i) a.in[i] = d_in[i]; a.out = out; a.ws = ws;
    hipMemsetAsync(ws + WS_CTL, 0, CTL_ZERO_BYTES, stream);

#if ONE_LAUNCH
#ifdef PROBE_DUP
    launch_mk(stream, a, 0, PROBE_DUP + 1, 0); launch_mk(stream, a, PROBE_DUP, PROBE_DUP + 1, 1); launch_mk(stream, a, PROBE_DUP + 1, PH_END, 2);
#elif defined(PROBE_FFN2)
    launch_mk(stream, a, 0, PH_FINAL, 0); launch_mk(stream, a, PH_FINAL - 1, PH_FINAL, 1, 1); launch_mk(stream, a, PH_FINAL, PH_END, 2);
#elif defined(PROBE_FINAL)
    launch_mk(stream, a, 0, PH_FINAL, 0); launch_mk(stream, a, PH_FINAL, PH_END, 1, 2); launch_mk(stream, a, PH_FINAL, PH_END, 2);
#else
    launch_mk(stream, a, 0, PH_END);
#endif
    return;
#endif
#if MK_PRO
    launch_mk(stream, a, PH_P0A, PH_P0A + 1);
    launch_mk(stream, a, PH_P0B, PH_P0B + 1);
#else
    hipLaunchKernelGGL(k_rope_table, dim3(T * 16 / 256), dim3(256), 0, stream, pos, RT);
    hipLaunchKernelGGL(k_prep_gw, dim3(DEPTH * NGRP * CHUNK * CHUNK / 256), dim3(256), 0, stream, g_ws, GW);
    for (int l = 0; l < DEPTH; ++l) {
        hipLaunchKernelGGL(k_prep_w, dim3((NIN * DM + 255) / 256), dim3(256), 0, stream, w_in + (size_t)l * DM * DIN, DM, DIN, WL(l, WL_IN), NIN, 1);
        hipLaunchKernelGGL(k_prep_wup, dim3((NUP * KUP + 255) / 256), dim3(256), 0, stream, w_uq + (size_t)l * QR * 768, w_ukv + (size_t)l * KVR * 1024, WL(l, WL_UP));
        hipLaunchKernelGGL(k_prep_w, dim3(DM * DM / 256), dim3(256), 0, stream, w_out + (size_t)l * DM * DM, DM, DM, WL(l, WL_OUT), DM, 0);
        hipLaunchKernelGGL(k_prep_w, dim3(DFF * DM / 256), dim3(256), 0, stream, w_ff1 + (size_t)l * DM * DFF, DM, DFF, WL(l, WL_1), DFF, 0);
        hipLaunchKernelGGL(k_prep_w, dim3(DFF * DM / 256), dim3(256), 0, stream, w_ff2 + (size_t)l * DFF * DM, DFF, DM, WL(l, WL_2), DM, 0);
        hipLaunchKernelGGL(k_smallm, dim3(NMOD / 64), dim3(512), 0, stream, c, DM, 1, w_ada + (size_t)l * DM * NMOD, NMOD, NMOD, 0, b_ada + (size_t)l * NMOD, MOD + (size_t)l * NB * NMOD, NMOD, NMOD);
    }
    for (int l = 0; l < DEPTH; ++l) {
        hipLaunchKernelGGL(k_smallm, dim3(NIN / 64), dim3(512), 0, stream, MOD + (size_t)l * NB * NMOD + 0, NMOD, 0, w_in + (size_t)l * DM * DIN, DIN, DIN, 1, (const float*)nullptr, SHW1 + (size_t)l * NB * NIN, NIN, NIN);
        hipLaunchKernelGGL(k_smallm, dim3(DFF / 64), dim3(512), 0, stream, MOD + (size_t)l * NB * NMOD + 3 * DM, NMOD, 0, w_ff1 + (size_t)l * DM * DFF, DFF, DFF, 0, (const float*)nullptr, SHW2 + (size_t)l * NB * DFF, DFF, DFF);
    }
    hipLaunchKernelGGL(k_gm, dim3(DEPTH * NB * DM / 256), dim3(256), 0, stream, g_mix, MOD, 1, GM1);
    hipLaunchKernelGGL(k_gm, dim3(DEPTH * NB * DM / 256), dim3(256), 0, stream, g_ffn, MOD, 4, GM2);
    hipLaunchKernelGGL(k_modx, dim3(T / 4), dim3(256), 0, stream, x, g_mix, MOD + 1 * DM, NMOD, A, SSQ1);

#endif
    for (int l = 0; l < DEPTH; ++l) {
        const float* modl = MOD + (size_t)l * NB * NMOD; const int P = PH_L0 + l * PH_PER_LAYER;
#if MK_IN
        launch_mk(stream, a, P + 0, P + 1);
#else
        { EpiInNaive e{0, SSQ1, SHW1 + (size_t)l * NB * NIN, U, GV, ZL}; gemm_naive(stream, A, DM, WL(l, WL_IN), DM, T, NIN, DM, e); }
        hipLaunchKernelGGL(k_vn, dim3(T * NGRP / 4), dim3(256), 0, stream, GV, VN);
        hipLaunchKernelGGL(k_lat, dim3(T / 4), dim3(256), 0, stream, ZL, g_q + l * QR, g_kv + l * KVR, RT, CQKV, SSQQ, KR);
#endif
#if MK_UP
        launch_mk(stream, a, P + 1, P + 2);
#else
        { EpiUpNaive e{0, SSQQ, Q, QRT, KN, V}; gemm_naive(stream, CQKV, KUP, WL(l, WL_UP), KUP, T, NUP, KUP, e); }
        hipLaunchKernelGGL(k_rope_q, dim3(T * NH * 16 / 256), dim3(256), 0, stream, QRT, RT, Q);
#endif
#if MK_GMLP
        launch_mk(stream, a, P + 2, P + 3);
#else
        hipLaunchKernelGGL(k_gmlp_naive, dim3(T), dim3(512), 0, stream, U, VN, GW + (size_t)l * NGRP * CHUNK * CHUNK, g_bs + l * NGRP * CHUNK, g_og + l * DG, Y, SSQY);
#endif
#if MK_ATTN
        launch_mk(stream, a, P + 3, P + 4);
#else
        hipLaunchKernelGGL(k_attn_naive, dim3(T / 64, NH), dim3(64), 0, stream, Q, KN, KR, V, g_oa + l * DG, Y, SSQY);
#endif
#if MK_OUT
        launch_mk(stream, a, P + 4, P + 5);
#else
        { EpiOutNaive e{512, SSQY, l == 0 ? x : out, out, modl + 2 * DM}; gemm_naive(stream, Y, DM, WL(l, WL_OUT), DM, T, DM, DM, e); }
        hipLaunchKernelGGL(k_modx, dim3(T / 4), dim3(256), 0, stream, out, g_ffn + l * DM, modl + 4 * DM, NMOD, A, SSQ2);
#endif
#if MK_FF1
        launch_mk(stream, a, P + 5, P + 6);
#else
        { EpiFf1Naive e{0, SSQ2, SHW2 + (size_t)l * NB * DFF, H}; gemm_naive(stream, A, DM, WL(l, WL_1), DM, T, DFF, DM, e); }
#endif
#if MK_FF2
        launch_mk(stream, a, P + 6, P + 7);
#else
        { EpiFf2Naive e{0, out, modl + 5 * DM}; gemm_naive(stream, H, DFF, WL(l, WL_2), DFF, T, DM, DFF, e); }
        if (l + 1 < DEPTH) hipLaunchKernelGGL(k_modx, dim3(T / 4), dim3(256), 0, stream, out, g_mix + (l + 1) * DM, MOD + (size_t)(l + 1) * NB * NMOD + 1 * DM, NMOD, A, SSQ1);
#endif
    }
#if MK_PRO
    launch_mk(stream, a, PH_FINAL, PH_FINAL + 1);
#else
    hipLaunchKernelGGL(k_final, dim3(T / 4), dim3(256), 0, stream, out, g_fin, out);
#endif
}
```

```cpp
#include <hip/hip_runtime.h>
#define PROBE_MULT 8
#include <cstdint>
#include <cstdio>
#include <cmath>

typedef unsigned short bf16_t;
typedef short bf16x8 __attribute__((ext_vector_type(8)));
typedef float f32x4 __attribute__((ext_vector_type(4)));

constexpr int DM = 1024, NB = 16, SEQ = 2048, DEPTH = 2, T = NB * SEQ;
constexpr int DG = 512, NGRP = 8, GD = 64, CHUNK = 128, NH = 8, NOPE = 64, ROPE = 32, VD = 64;
constexpr int QR = 256, KVR = 128, DFF = 4096, DIN = 1440, NMOD = 6 * DM;
constexpr int NIN = 1536;
constexpr int NUP = 1792, KUP = 384;
constexpr float EPS = 1e-6f;
constexpr float QSCALE = 0.10206207261596577f * 1.4426950408889634f;

constexpr size_t MiB = 1u << 20;
constexpr size_t WS_CTL = 0;
constexpr size_t WS_MOD = 1 * MiB;
constexpr size_t WS_SHW1 = 2 * MiB;
constexpr size_t WS_GM1 = 2 * MiB + 512 * 1024;
constexpr size_t WS_GM2 = 2 * MiB + 768 * 1024;
constexpr size_t WS_SHW2 = 3 * MiB;
constexpr size_t WS_ROPE = 4 * MiB;
constexpr size_t WS_SSQ1 = 8 * MiB;
constexpr size_t WS_SSQ2 = 10 * MiB;
constexpr size_t WS_SSQY = 12 * MiB;
constexpr size_t WS_SSQQ = 14 * MiB;
constexpr size_t WS_GW = 15 * MiB;
constexpr size_t WS_W = 16 * MiB;
constexpr size_t WL_IN = 0, WL_UP = 3 * MiB, WL_OUT = 4 * MiB + MiB / 2, WL_1 = 6 * MiB + MiB / 2, WL_2 = 14 * MiB + MiB / 2, WL_STRIDE = 22 * MiB + MiB / 2;
constexpr size_t WS_A = 64 * MiB;
constexpr size_t WS_U = 128 * MiB;
constexpr size_t WS_VN = 160 * MiB;
constexpr size_t WS_CQKV = 192 * MiB;
constexpr size_t WS_KR = 216 * MiB;
constexpr size_t WS_Q = 218 * MiB;
constexpr size_t WS_KN = 266 * MiB;
constexpr size_t WS_V = 298 * MiB;
constexpr size_t WS_Y = 330 * MiB;
constexpr size_t WS_H = 128 * MiB;
constexpr size_t WS_GV = 394 * MiB;
constexpr size_t WS_ZL = 458 * MiB;
constexpr size_t WS_QRT = 394 * MiB;
constexpr size_t WS_DUMMY = 448 * MiB;
constexpr size_t WS_END = 512 * MiB;

__device__ __forceinline__ bf16_t f2bf(float f) { unsigned u = __float_as_uint(f); return (bf16_t)((u + 0x7fffu + ((u >> 16) & 1u)) >> 16); }
__device__ __forceinline__ float bf2f(bf16_t h) { return __uint_as_float(((unsigned)h) << 16); }
__device__ __forceinline__ float gelu_tanh(float x) { const float y2 = -2.302208198f * (x + 0.044715f * x * x * x); return x * __builtin_amdgcn_rcpf(1.f + __builtin_amdgcn_exp2f(y2)); }
__device__ __forceinline__ float wave_sum(float v) {
#pragma unroll
    for (int o = 1; o < 64; o <<= 1) v += __shfl_xor(v, o);
    return v;
}
__host__ __device__ __forceinline__ int win_src(int p) {
    if (p < 512) return p;
    if (p < 1024) { const int q = p - 512, tile = q >> 8, r = q & 255, bj = r >> 7, wc = (r >> 5) & 3, j = r & 31; return 512 + tile * 256 + 64 * wc + 32 * bj + j; }
    if (p < 1408) return p;
    if (p < 1440) { const int j = p - 1408, fq = j >> 3, n = (j >> 2) & 1, i = j & 3; return 1408 + 16 * n + 4 * fq + i; }
    return -1;
}
__host__ __device__ __forceinline__ int wup_qcol(int p) {
    const int G = p >> 5, h = G / 3, gi = G - 3 * h, j = p & 31;
    if (gi < 2) return p;
    const int fq = j >> 3, n = (j >> 2) & 1, i = j & 3; return h * 96 + 64 + 16 * n + 4 * fq + i;
}

__global__ void k_rope_table(const int* pos, float* rope) {
    const int idx = blockIdx.x * blockDim.x + threadIdx.x; if (idx >= T * 16) return;
    const int t = idx >> 4, i = idx & 15;
    const float freq = powf(10000.0f, -(float)(2 * i) / 32.0f);
    const float ang = (float)pos[t] * freq;
    rope[t * 32 + i] = cosf(ang); rope[t * 32 + 16 + i] = sinf(ang);
}
__global__ void k_prep_w(const float* W, int K, int N, bf16_t* out, int Nphys, int mode) {
    const size_t idx = (size_t)blockIdx.x * blockDim.x + threadIdx.x; if (idx >= (size_t)Nphys * K) return;
    const int p = (int)(idx / K), k = (int)(idx % K);
    const int s = mode == 1 ? win_src(p) : p;
    out[idx] = (s >= 0 && s < N) ? f2bf(W[(size_t)k * N + s]) : (bf16_t)0;
}
__global__ void k_prep_wup(const float* wuq, const float* wukv, bf16_t* out) {
    const int idx = blockIdx.x * blockDim.x + threadIdx.x; if (idx >= NUP * KUP) return;
    const int p = idx / KUP, k = idx % KUP; float v = 0.f;
    if (p < 768) { if (k < 256) v = wuq[(size_t)k * 768 + wup_qcol(p)]; }
    else { if (k >= 256) v = wukv[(size_t)(k - 256) * 1024 + (p - 768)]; }
    out[idx] = f2bf(v);
}
__global__ void k_prep_gw(const float* ws, bf16_t* gw) {
    const int idx = blockIdx.x * blockDim.x + threadIdx.x; if (idx >= DEPTH * NGRP * CHUNK * CHUNK) return;
    const int s = idx & 127, t = (idx >> 7) & 127;
    gw[idx] = (s <= t) ? f2bf(ws[idx]) : (bf16_t)0;
}
__global__ __launch_bounds__(512) void k_smallm(const float* in, int in_stride, int act, const float* W, int ldw, int N, int mode, const float* bias, float* out, int out_stride, int Nphys) {
    __shared__ float sin_[1024 * 16];
    __shared__ float red[8 * 64 * 16];
    const int tid = threadIdx.x, lane = tid & 63, wave = tid >> 6;
    for (int e = tid; e < 16 * 1024; e += 512) { const int b = e >> 10, k = e & 1023; float v = in[(size_t)b * in_stride + k]; if (act) v = v / (1.f + __expf(-v)); sin_[k * 16 + b] = v; }
    __syncthreads();
    const int p = blockIdx.x * 64 + lane; const int s = (p < Nphys) ? (mode == 1 ? win_src(p) : p) : -1; const bool ok = (s >= 0 && s < N);
    float acc[16];
#pragma unroll
    for (int b = 0; b < 16; ++b) acc[b] = 0.f;
    for (int k = wave * 128; k < wave * 128 + 128; ++k) {
        const float w = ok ? W[(size_t)k * ldw + s] : 0.f;
        const f32x4* sp = (const f32x4*)(sin_ + k * 16);
#pragma unroll
        for (int q = 0; q < 4; ++q) { const f32x4 v = sp[q]; acc[4 * q] += v[0] * w; acc[4 * q + 1] += v[1] * w; acc[4 * q + 2] += v[2] * w; acc[4 * q + 3] += v[3] * w; }
    }
#pragma unroll
    for (int b = 0; b < 16; ++b) red[(wave * 64 + lane) * 16 + b] = acc[b];
    __syncthreads();
    for (int e = tid; e < 64 * 16; e += 512) { const int l = e >> 4, b = e & 15; float sum = 0.f;
#pragma unroll
        for (int w = 0; w < 8; ++w) sum += red[(w * 64 + l) * 16 + b];
        const int pp = blockIdx.x * 64 + l; if (pp < Nphys) out[(size_t)b * out_stride + pp] = sum + (bias ? bias[pp] : 0.f); }
}
__global__ __launch_bounds__(256) void k_modx(const float* x, const float* g, const float* sc  , int sc_stride, bf16_t* A, float* ssq) {
    const int row = blockIdx.x * 4 + (threadIdx.x >> 6), lane = threadIdx.x & 63; if (row >= T) return;
    const int b = row / SEQ; const f32x4* xr = (const f32x4*)(x + (size_t)row * DM); float s = 0.f;
#pragma unroll
    for (int j = 0; j < 4; ++j) { const f32x4 v = xr[lane + 64 * j]; s += v[0] * v[0] + v[1] * v[1] + v[2] * v[2] + v[3] * v[3];
        const int c = 4 * (lane + 64 * j); const f32x4 gv = *(const f32x4*)(g + c), sv = *(const f32x4*)(sc + (size_t)b * sc_stride + c);
        unsigned lo = f2bf(v[0] * gv[0] * (1.f + sv[0])) | ((unsigned)f2bf(v[1] * gv[1] * (1.f + sv[1])) << 16);
        unsigned hi = f2bf(v[2] * gv[2] * (1.f + sv[2])) | ((unsigned)f2bf(v[3] * gv[3] * (1.f + sv[3])) << 16);
        *(uint2*)(A + (size_t)row * DM + c) = make_uint2(lo, hi); }
    s = wave_sum(s);
    if (lane < 16) ssq[(size_t)row * 16 + lane] = (lane == 0) ? s : 0.f;
}
__global__ __launch_bounds__(256) void k_final(const float* x, const float* g, float* out) {
    const int row = blockIdx.x * 4 + (threadIdx.x >> 6), lane = threadIdx.x & 63; if (row >= T) return;
    const f32x4* xr = (const f32x4*)(x + (size_t)row * DM); f32x4 v[4]; float s = 0.f;
#pragma unroll
    for (int j = 0; j < 4; ++j) { v[j] = xr[lane + 64 * j]; s += v[j][0] * v[j][0] + v[j][1] * v[j][1] + v[j][2] * v[j][2] + v[j][3] * v[j][3]; }
    const float rstd = rsqrtf(wave_sum(s) * (1.f / DM) + EPS);
#pragma unroll
    for (int j = 0; j < 4; ++j) { const int c = 4 * (lane + 64 * j); const f32x4 gv = *(const f32x4*)(g + c); *(f32x4*)(out + (size_t)row * DM + c) = v[j] * rstd * gv; }
}

template <class Epi>
__global__ __launch_bounds__(256) void k_gemm_naive(const bf16_t* A, int lda, const bf16_t* Bt, int ldb, int K, Epi epi) {
    const int wave = threadIdx.x >> 6, lane = threadIdx.x & 63, fr = lane & 15, fq = lane >> 4;
    const int row0 = blockIdx.y * 64 + wave * 16, col0 = blockIdx.x * 64;
    f32x4 acc[4];
#pragma unroll
    for (int n = 0; n < 4; ++n) acc[n] = (f32x4){0.f, 0.f, 0.f, 0.f};
    const bf16_t* ap = A + (size_t)(row0 + fr) * lda + 8 * fq;
    const bf16_t* bp = Bt + (size_t)(col0 + fr) * ldb + 8 * fq;
    for (int k0 = 0; k0 < K; k0 += 32) {
        if (Epi::HAS_MID) { if (k0 == epi.ksplit) {
#pragma unroll
            for (int r = 0; r < 4; ++r) { const float m = epi.mid(row0 + 4 * fq + r);
#pragma unroll
                for (int n = 0; n < 4; ++n) acc[n][r] *= m; } } }
        const bf16x8 a = *(const bf16x8*)(ap + k0);
#pragma unroll
        for (int n = 0; n < 4; ++n) { const bf16x8 b = *(const bf16x8*)(bp + (size_t)n * 16 * ldb + k0); acc[n] = __builtin_amdgcn_mfma_f32_16x16x32_bf16(a, b, acc[n], 0, 0, 0); }
    }
#pragma unroll
    for (int r = 0; r < 4; ++r) { const int row = row0 + 4 * fq + r; const float rs = epi.rowscale(row);
#pragma unroll
        for (int n = 0; n < 4; ++n) epi(row, col0 + 16 * n + fr, acc[n][r], rs); }
}
__device__ __forceinline__ float sum16(const float* p) { float s = 0.f;
#pragma unroll
    for (int i = 0; i < 16; ++i) s += p[i]; return s; }
__device__ __forceinline__ float sum8(const float* p) { float s = 0.f;
#pragma unroll
    for (int i = 0; i < 8; ++i) s += p[i]; return s; }
__device__ __forceinline__ float sum4(const float* p) { return (p[0] + p[1]) + (p[2] + p[3]); }

struct EpiInNaive {
    static constexpr bool HAS_MID = false; int ksplit;
    const float* ssq1; const float* shw1; bf16_t* U; float* GV; float* ZL;
    __device__ float mid(int) const { return 1.f; }
    __device__ float rowscale(int row) const { return rsqrtf(sum16(ssq1 + (size_t)row * 16) * (1.f / DM) + EPS); }
    __device__ void operator()(int row, int p, float acc, float rs) const {
        const int L = win_src(p); if (L < 0) return;
        const float z = rs * acc + shw1[(row / SEQ) * NIN + p];
        if (L < 512) U[(size_t)row * 512 + L] = f2bf(gelu_tanh(z));
        else if (L < 1024) GV[(size_t)row * 512 + (L - 512)] = gelu_tanh(z);
        else ZL[(size_t)row * 416 + (L - 1024)] = z;
    }
};
struct EpiUpNaive {
    static constexpr bool HAS_MID = false; int ksplit;
    const float* ssqq; bf16_t* Q; float* QRT; bf16_t* KN; bf16_t* V;
    __device__ float mid(int) const { return 1.f; }
    __device__ float rowscale(int) const { return 1.f; }
    __device__ void operator()(int row, int p, float acc, float) const {
        if (p < 768) { const float rq = rsqrtf(sum4(ssqq + (size_t)row * 8) * (1.f / QR) + EPS); const float v = acc * rq * QSCALE;
            const int L = wup_qcol(p), h = L / 96, d = L - 96 * h;
            if (d < 64) Q[(size_t)row * 768 + L] = f2bf(v); else QRT[(size_t)row * 256 + h * 32 + (d - 64)] = v; }
        else { const float rk = rsqrtf(sum4(ssqq + (size_t)row * 8 + 4) * (1.f / KVR) + EPS); const float v = acc * rk;
            const int c = p - 768, h = c >> 7, d = c & 127;
            if (d < 64) KN[(size_t)row * 512 + h * 64 + d] = f2bf(v); else V[(size_t)row * 512 + h * 64 + (d - 64)] = f2bf(v); }
    }
};
struct EpiOutNaive {
    static constexpr bool HAS_MID = true; int ksplit;
    const float* ssqy; const float* xin; float* xout; const float* gate;
    __device__ float rg(int row) const { return rsqrtf(sum8(ssqy + (size_t)row * 16) * (1.f / 512) + EPS); }
    __device__ float ra(int row) const { return rsqrtf(sum8(ssqy + (size_t)row * 16 + 8) * (1.f / 512) + EPS); }
    __device__ float mid(int row) const { return rg(row) / ra(row); }
    __device__ float rowscale(int row) const { return ra(row); }
    __device__ void operator()(int row, int n, float acc, float rs) const {
        const size_t i = (size_t)row * DM + n; xout[i] = xin[i] + gate[(size_t)(row / SEQ) * NMOD + n] * (rs * acc);
    }
};
struct EpiFf1Naive {
    static constexpr bool HAS_MID = false; int ksplit;
    const float* ssq2; const float* shw2; bf16_t* H;
    __device__ float mid(int) const { return 1.f; }
    __device__ float rowscale(int row) const { return rsqrtf(sum16(ssq2 + (size_t)row * 16) * (1.f / DM) + EPS); }
    __device__ void operator()(int row, int n, float acc, float rs) const {
        const float z = rs * acc + shw2[(row / SEQ) * DFF + n]; const float r = fmaxf(z, 0.f); H[(size_t)row * DFF + n] = f2bf(r * r);
    }
};
struct EpiFf2Naive {
    static constexpr bool HAS_MID = false; int ksplit;
    float* x; const float* gate;
    __device__ float mid(int) const { return 1.f; }
    __device__ float rowscale(int) const { return 1.f; }
    __device__ void operator()(int row, int n, float acc, float) const {
        const size_t i = (size_t)row * DM + n; x[i] = x[i] + gate[(size_t)(row / SEQ) * NMOD + n] * acc;
    }
};

__global__ __launch_bounds__(256) void k_vn(const float* GV, bf16_t* VN) {
    const int w = blockIdx.x * 4 + (threadIdx.x >> 6), lane = threadIdx.x & 63; if (w >= T * NGRP) return;
    const int row = w >> 3, g = w & 7; const float v = GV[(size_t)row * 512 + g * 64 + lane];
    const float mu = wave_sum(v) * (1.f / 64); const float d = v - mu; const float var = wave_sum(d * d) * (1.f / 64);
    VN[(size_t)row * 512 + g * 64 + lane] = f2bf(d * rsqrtf(var + EPS));
}
__global__ __launch_bounds__(256) void k_lat(const float* ZL, const float* gq, const float* gkv, const float* rope, bf16_t* CQKV, float* ssqq, bf16_t* KR) {
    const int row = blockIdx.x * 4 + (threadIdx.x >> 6), lane = threadIdx.x & 63; if (row >= T) return;
    const float* z = ZL + (size_t)row * 416; float sq = 0.f, sk = 0.f;
#pragma unroll
    for (int j = 0; j < 4; ++j) { const int c = lane + 64 * j; const float v = z[c]; sq += v * v; CQKV[(size_t)row * KUP + c] = f2bf(v * gq[c]); }
#pragma unroll
    for (int j = 0; j < 2; ++j) { const int c = lane + 64 * j; const float v = z[256 + c]; sk += v * v; CQKV[(size_t)row * KUP + 256 + c] = f2bf(v * gkv[c]); }
    sq = wave_sum(sq); sk = wave_sum(sk);
    if (lane < 8) ssqq[(size_t)row * 8 + lane] = (lane == 0) ? sq : (lane == 4) ? sk : 0.f;
    if (lane < 16) { const float x1 = z[384 + lane], x2 = z[384 + 16 + lane], c = rope[(size_t)row * 32 + lane], s = rope[(size_t)row * 32 + 16 + lane];
        KR[(size_t)row * 32 + lane] = f2bf(x1 * c - x2 * s); KR[(size_t)row * 32 + 16 + lane] = f2bf(x1 * s + x2 * c); }
}
__global__ void k_rope_q(const float* QRT, const float* rope, bf16_t* Q) {
    const int idx = blockIdx.x * blockDim.x + threadIdx.x; if (idx >= T * NH * 16) return;
    const int r = idx & 15, h = (idx >> 4) & 7, row = idx >> 7;
    const float x1 = QRT[(size_t)row * 256 + h * 32 + r], x2 = QRT[(size_t)row * 256 + h * 32 + 16 + r], c = rope[(size_t)row * 32 + r], s = rope[(size_t)row * 32 + 16 + r];
    Q[(size_t)row * 768 + h * 96 + 64 + r] = f2bf(x1 * c - x2 * s); Q[(size_t)row * 768 + h * 96 + 80 + r] = f2bf(x1 * s + x2 * c);
}
__global__ __launch_bounds__(512) void k_gmlp_naive(const bf16_t* U, const bf16_t* VN, const bf16_t* GW  , const float* bs  , const float* gog, bf16_t* Y, float* ssqy) {
    const int row = blockIdx.x, g = threadIdx.x >> 6, d = threadIdx.x & 63, c = g * 64 + d;
    const int tt = row & 127, t0 = row - tt;
    const bf16_t* w = GW + ((size_t)g * CHUNK + tt) * CHUNK; float sum = 0.f;
    for (int s = 0; s <= tt; ++s) sum += bf2f(w[s]) * bf2f(VN[(size_t)(t0 + s) * 512 + c]);
    const float y = bf2f(U[(size_t)row * 512 + c]) * (sum + bs[g * CHUNK + tt]);
    Y[(size_t)row * DM + c] = f2bf(y * gog[c]);
    const float q = wave_sum(y * y); if (d == 0) ssqy[(size_t)row * 16 + g] = q;
}
__global__ __launch_bounds__(64) void k_attn_naive(const bf16_t* Q, const bf16_t* KN, const bf16_t* KR, const bf16_t* V, const float* goa, bf16_t* Y, float* ssqy) {
    const int h = blockIdx.y, row = blockIdx.x * 64 + threadIdx.x, b = row / SEQ, i = row - b * SEQ;
    const int iend = (blockIdx.x * 64 % SEQ) + 63;
    float q[96];
#pragma unroll
    for (int d8 = 0; d8 < 12; ++d8) { const bf16x8 v = *(const bf16x8*)(Q + (size_t)row * 768 + h * 96 + d8 * 8);
#pragma unroll
        for (int j = 0; j < 8; ++j) q[d8 * 8 + j] = bf2f((bf16_t)v[j]); }
    float o[64];
#pragma unroll
    for (int d = 0; d < 64; ++d) o[d] = 0.f;
    float m = -1e30f, l = 0.f;
    const size_t kb = (size_t)b * SEQ;
    for (int j = 0; j <= iend; ++j) {
        const bf16_t* kn = KN + (kb + j) * 512 + h * 64; const bf16_t* kr = KR + (kb + j) * 32; const bf16_t* vv = V + (kb + j) * 512 + h * 64;
        float s = 0.f;
#pragma unroll
        for (int d8 = 0; d8 < 8; ++d8) { const bf16x8 kv = *(const bf16x8*)(kn + d8 * 8);
#pragma unroll
            for (int jj = 0; jj < 8; ++jj) s += q[d8 * 8 + jj] * bf2f((bf16_t)kv[jj]); }
#pragma unroll
        for (int d8 = 0; d8 < 4; ++d8) { const bf16x8 kv = *(const bf16x8*)(kr + d8 * 8);
#pragma unroll
            for (int jj = 0; jj < 8; ++jj) s += q[64 + d8 * 8 + jj] * bf2f((bf16_t)kv[jj]); }
        if (j > i) s = -1e30f;
        const float mn = fmaxf(m, s), alpha = exp2f(m - mn), p = (j > i) ? 0.f : exp2f(s - mn);
        l = l * alpha + p; m = mn;
#pragma unroll
        for (int d8 = 0; d8 < 8; ++d8) { const bf16x8 v8 = *(const bf16x8*)(vv + d8 * 8);
#pragma unroll
            for (int jj = 0; jj < 8; ++jj) o[d8 * 8 + jj] = o[d8 * 8 + jj] * alpha + p * bf2f((bf16_t)v8[jj]); }
    }
    const float inv = 1.f / l; float sq = 0.f;
#pragma unroll
    for (int d8 = 0; d8 < 8; ++d8) { unsigned w[4];
#pragma unroll
        for (int jj = 0; jj < 8; jj += 2) { const float y0 = o[d8 * 8 + jj] * inv, y1 = o[d8 * 8 + jj + 1] * inv; sq += y0 * y0 + y1 * y1;
            w[jj >> 1] = f2bf(y0 * goa[h * 64 + d8 * 8 + jj]) | ((unsigned)f2bf(y1 * goa[h * 64 + d8 * 8 + jj + 1]) << 16); }
        *(uint4*)(Y + (size_t)row * DM + 512 + h * 64 + d8 * 8) = make_uint4(w[0], w[1], w[2], w[3]); }
    ssqy[(size_t)row * 16 + 8 + h] = sq;
}

__global__ void k_gm(const float* g  , const float* mod, int chunk, float* gmt) {
    const int idx = blockIdx.x * blockDim.x + threadIdx.x; if (idx >= DEPTH * NB * DM) return;
    const int c = idx & 1023, b = (idx >> 10) & 15, l = idx >> 14;
    gmt[idx] = g[l * DM + c] * (1.f + mod[((size_t)l * NB + b) * NMOD + chunk * DM + c]);
}
__device__ __forceinline__ int lane_id() { int l; asm volatile("v_mbcnt_lo_u32_b32 %0, -1, 0\n\tv_mbcnt_hi_u32_b32 %0, -1, %0" : "=v"(l)); return l; }
__device__ __forceinline__ float swz_xor16(float v) { return __int_as_float(__builtin_amdgcn_ds_swizzle(__float_as_int(v), 0x401F)); }
__device__ __forceinline__ float swz_xor1(float v) { return __int_as_float(__builtin_amdgcn_ds_swizzle(__float_as_int(v), 0x041F)); }
namespace pg8 {
#define PG8_LAS __attribute__((address_space(3)))
typedef unsigned u32x4 __attribute__((ext_vector_type(4)));
typedef unsigned u32x2 __attribute__((ext_vector_type(2)));
constexpr int BM = 256, BK = 64, HALF = 128, HTB = HALF * BK * 2  , STAGE_BYTES = 8 * HTB, NXCD = 8, WGM = 8;

__host__ __device__ __forceinline__ int lds_byte(int r, int c) { const int st = (r >> 4) * 2 + (c >> 5), rr = r & 15, cc = c & 31, ob = rr * 64 + cc * 2; return st * 1024 + (ob ^ (((ob >> 9) & 1) << 5)); }
__host__ __device__ __forceinline__ void stage_rc(int b, int& R, int& C) { const int st = b / 1024, sb = b % 1024, swz = sb ^ (((sb >> 9) & 1) << 5); R = (st >> 1) * 16 + swz / 64; C = (st & 1) * 32 + (swz % 64) / 2; }
__host__ __device__ __forceinline__ int perm32(int rho) { const int n = rho >> 4, i = rho & 15; return 8 * (i >> 2) + 4 * n + (i & 3); }

struct Unit { int pm, pn; };
struct Gemm { const bf16_t* A; const bf16_t* Bt; int M, N, K; };

struct StaticOrder {
    int nM, nN, nwg, G, c;
    __host__ __device__ void init(int M, int N, int G_, int c_) { nM = M / BM; nN = N / BM; nwg = nM * nN; G = G_; c = c_; }
    __host__ __device__ bool next(int i, Unit& u) const {
        const long L = (long)i * G + c; if (L >= nwg) return false;
        int wgid = (int)L; { const int q = nwg / NXCD, r = nwg % NXCD, xcd = wgid % NXCD, off = wgid / NXCD; wgid = (xcd < r ? xcd * (q + 1) : r * (q + 1) + (xcd - r) * q) + off; }
        const int nig = WGM * nN, gid = wgid / nig, fm = gid * WGM, gsz = (nM - fm) < WGM ? (nM - fm) : WGM;
        u.pm = fm + ((wgid % nig) % gsz); u.pn = (wgid % nig) / gsz; return true;
    }
    __device__ __forceinline__ void a_ready(const Unit&) const {}
    __device__ __forceinline__ void done(const Unit&) const {}
};

__device__ __forceinline__ unsigned cvt_pk_bf16(float lo, float hi) { unsigned r; asm volatile("v_cvt_pk_bf16_f32 %0, %1, %2" : "=v"(r) : "v"(lo), "v"(hi)); return r; }
__device__ __forceinline__ u32x4 pack8(const f32x4& a, const f32x4& b) { u32x4 w; w.x = cvt_pk_bf16(a[0], a[1]); w.y = cvt_pk_bf16(a[2], a[3]); w.z = cvt_pk_bf16(b[0], b[1]); w.w = cvt_pk_bf16(b[2], b[3]); return w; }
__device__ __forceinline__ u32x2 pack4(const f32x4& a) { u32x2 w; w.x = cvt_pk_bf16(a[0], a[1]); w.y = cvt_pk_bf16(a[2], a[3]); return w; }
__device__ __forceinline__ float hsum4(const f32x4& a) { return (a[0] + a[1]) + (a[2] + a[3]); }
__device__ __forceinline__ float hsq4(const f32x4& a) { return (a[0] * a[0] + a[1] * a[1]) + (a[2] * a[2] + a[3] * a[3]); }
__device__ __forceinline__ float ld_sum16(const float* p) { const f32x4* q = (const f32x4*)p; return (hsum4(q[0]) + hsum4(q[1])) + (hsum4(q[2]) + hsum4(q[3])); }
__device__ __forceinline__ float ld_sum8(const float* p) { const f32x4* q = (const f32x4*)p; return hsum4(q[0]) + hsum4(q[1]); }
__device__ __forceinline__ float ld_sum4(const float* p) { return hsum4(*(const f32x4*)p); }
__device__ __forceinline__ float quad_sum(float s) { s += swz_xor16(s); auto rr = __builtin_amdgcn_permlane32_swap(__float_as_uint(s), __float_as_uint(s), false, false); return __uint_as_float(rr[0]) + __uint_as_float(rr[1]); }
__device__ __forceinline__ float row_sum16(const float* ssq, int row, int fq) { return quad_sum(hsum4(*(const f32x4*)(ssq + (size_t)row * 16 + 4 * fq))); }
__device__ __forceinline__ void row_sum8x2(const float* ssq, int row, int fq, float& sg, float& sa) {
    float s = hsum4(*(const f32x4*)(ssq + (size_t)row * 16 + 4 * fq)); s += swz_xor16(s);
    auto rr = __builtin_amdgcn_permlane32_swap(__float_as_uint(s), __float_as_uint(s), false, false); sg = __uint_as_float(rr[0]); sa = __uint_as_float(rr[1]); }
#define PG8_FENCE() asm volatile("" ::: "memory")
#define PG8_RSTD8(rsv, ssqp, invn) do { f32x4 q_[2][4]; \
    _Pragma("unroll") for (int ai = 0; ai < 2; ++ai) _Pragma("unroll") for (int m = 0; m < 4; ++m) q_[ai][m] = *(const f32x4*)((ssqp) + (size_t)PG8_ROW(u, ai, m) * 16 + 4 * fq); \
    _Pragma("unroll") for (int ai = 0; ai < 2; ++ai) _Pragma("unroll") for (int m = 0; m < 4; ++m) rsv[ai][m] = rsqrtf(quad_sum(hsum4(q_[ai][m])) * (invn) + EPS); \
    PG8_FENCE(); } while (0)
__device__ __forceinline__ f32x4 gelu4(const f32x4& v) { f32x4 o; o[0] = gelu_tanh(v[0]); o[1] = gelu_tanh(v[1]); o[2] = gelu_tanh(v[2]); o[3] = gelu_tanh(v[3]); return o; }

#define PG8_ROW(u, ai, m) ((u).pm * BM + (ai) * HALF + wr * 64 + (m) * 16 + fr)

template <class V, class P> __device__ __forceinline__ V ldb(const P* p, unsigned boff) { return *(const V*)((const char*)p + boff); }
template <class V, class P> __device__ __forceinline__ void stb(P* p, unsigned boff, const V& v) { *(V*)((char*)p + boff) = v; }
#undef PG8_RSTD8
#define PG8_RSTD8(rsv, ssqp, invn) do { f32x4 q_[2][4]; \
    _Pragma("unroll") for (int ai = 0; ai < 2; ++ai) _Pragma("unroll") for (int m = 0; m < 4; ++m) q_[ai][m] = ldb<f32x4>((ssqp), (unsigned)(PG8_ROW(u, ai, m) * 64 + 16 * fq)); \
    _Pragma("unroll") for (int ai = 0; ai < 2; ++ai) _Pragma("unroll") for (int m = 0; m < 4; ++m) rsv[ai][m] = rsqrtf(quad_sum(hsum4(q_[ai][m])) * (invn) + EPS); \
    PG8_FENCE(); } while (0)

struct EpiIn {
    static constexpr bool PERM = true, AFTER_DRAIN = false, HAS_MID = false; static constexpr int MID_T = -1;
    const float* ssq1; const float* shw1; const float* gq; const float* gkv; const float* rope;
    bf16_t* U; bf16_t* VN; bf16_t* CQKV; bf16_t* KR; float* ssqq;
    __device__ __forceinline__ void mid(f32x4 (&)[2][2][4][2], const Unit&, int, int) const {}
    __device__ __forceinline__ void operator()(const f32x4 (&acc)[2][2][4][2], const Unit& u, int wr, int wc, int fr, int fq) const {
        { const int l_ = lane_id(); fr = l_ & 15; fq = l_ >> 4; }
        const int b = u.pm >> 3, pc0 = u.pn * BM + wc * 32 + 8 * fq;
        f32x4 sh[2][2];
#pragma unroll
        for (int bj = 0; bj < 2; ++bj)
#pragma unroll
            for (int n = 0; n < 2; ++n) sh[bj][n] = ldb<f32x4>(shw1, (unsigned)((b * NIN + pc0 + bj * HALF + 4 * n) * 4));
        float rsv[2][4]; PG8_RSTD8(rsv, ssq1, 1.f / DM);
        if (u.pn < 2) {
#pragma unroll
            for (int ai = 0; ai < 2; ++ai)
#pragma unroll
                for (int m = 0; m < 4; ++m) { const int row = PG8_ROW(u, ai, m); const float rs = rsv[ai][m];
#pragma unroll
                    for (int bj = 0; bj < 2; ++bj) { const f32x4 v0 = gelu4(acc[ai][bj][m][0] * rs + sh[bj][0]), v1 = gelu4(acc[ai][bj][m][1] * rs + sh[bj][1]);
                        stb(U, (unsigned)((row * 512 + pc0 + bj * HALF) * 2), pack8(v0, v1)); } }
        } else if (u.pn < 4) {
#pragma unroll
            for (int ai = 0; ai < 2; ++ai)
#pragma unroll
                for (int m = 0; m < 4; ++m) { const int row = PG8_ROW(u, ai, m); const float rs = rsv[ai][m];
                    f32x4 g[2][2]; float s = 0.f;
#pragma unroll
                    for (int bj = 0; bj < 2; ++bj)
#pragma unroll
                        for (int n = 0; n < 2; ++n) { g[bj][n] = gelu4(acc[ai][bj][m][n] * rs + sh[bj][n]); s += hsum4(g[bj][n]); }
                    const float mu = quad_sum(s) * (1.f / 64); float q = 0.f;
#pragma unroll
                    for (int bj = 0; bj < 2; ++bj)
#pragma unroll
                        for (int n = 0; n < 2; ++n) { g[bj][n] = g[bj][n] - mu; q += hsq4(g[bj][n]); }
                    const float rstd = rsqrtf(quad_sum(q) * (1.f / 64) + EPS);
#pragma unroll
                    for (int bj = 0; bj < 2; ++bj) stb(VN, (unsigned)((row * 512 + (u.pn - 2) * 256 + 64 * wc + 32 * bj + 8 * fq) * 2), pack8(g[bj][0] * rstd, g[bj][1] * rstd)); }
        } else if (u.pn == 4) {
            f32x4 gv[2][2];
#pragma unroll
            for (int bj = 0; bj < 2; ++bj)
#pragma unroll
                for (int n = 0; n < 2; ++n) gv[bj][n] = ldb<f32x4>(gq, (unsigned)((bj * HALF + wc * 32 + 8 * fq + 4 * n) * 4));
#pragma unroll
            for (int ai = 0; ai < 2; ++ai)
#pragma unroll
                for (int m = 0; m < 4; ++m) { const int row = PG8_ROW(u, ai, m); const float rs = rsv[ai][m];
                    float ss = 0.f;
#pragma unroll
                    for (int bj = 0; bj < 2; ++bj) { const f32x4 v0 = acc[ai][bj][m][0] * rs + sh[bj][0], v1 = acc[ai][bj][m][1] * rs + sh[bj][1]; ss += hsq4(v0) + hsq4(v1);
                        stb(CQKV, (unsigned)((row * KUP + bj * HALF + wc * 32 + 8 * fq) * 2), pack8(v0 * gv[bj][0], v1 * gv[bj][1])); }
                    ss = quad_sum(ss); if (fq == 0) stb(ssqq, (unsigned)((row * 8 + wc) * 4), ss); }
        } else {
            const f32x4 gk0 = ldb<f32x4>(gkv, (unsigned)((wc * 32 + 8 * fq) * 4)), gk1 = ldb<f32x4>(gkv, (unsigned)((wc * 32 + 8 * fq + 4) * 4));
#pragma unroll
            for (int ai = 0; ai < 2; ++ai)
#pragma unroll
                for (int m = 0; m < 4; ++m) { const int row = PG8_ROW(u, ai, m); const float rs = rsv[ai][m];
                    const f32x4 v0 = acc[ai][0][m][0] * rs + sh[0][0], v1 = acc[ai][0][m][1] * rs + sh[0][1];
                    float ss = quad_sum(hsq4(v0) + hsq4(v1)); if (fq == 0) stb(ssqq, (unsigned)((row * 8 + 4 + wc) * 4), ss);
                    stb(CQKV, (unsigned)((row * KUP + 256 + wc * 32 + 8 * fq) * 2), pack8(v0 * gk0, v1 * gk1));
                    if (wc == 0) { const f32x4 x1 = acc[ai][1][m][0] * rs + sh[1][0], x2 = acc[ai][1][m][1] * rs + sh[1][1];
                        const f32x4 c = ldb<f32x4>(rope, (unsigned)((row * 32 + 4 * fq) * 4)), s = ldb<f32x4>(rope, (unsigned)((row * 32 + 16 + 4 * fq) * 4));
                        stb(KR, (unsigned)((row * 32 + 4 * fq) * 2), pack4(x1 * c - x2 * s)); stb(KR, (unsigned)((row * 32 + 16 + 4 * fq) * 2), pack4(x1 * s + x2 * c)); } }
        }
    }
};
struct EpiUp {
    static constexpr bool PERM = true, AFTER_DRAIN = false, HAS_MID = false; static constexpr int MID_T = -1;
    const float* ssqq; const float* rope; bf16_t* Q; bf16_t* KN; bf16_t* V;
    __device__ __forceinline__ void mid(f32x4 (&)[2][2][4][2], const Unit&, int, int) const {}
    __device__ __forceinline__ void operator()(const f32x4 (&acc)[2][2][4][2], const Unit& u, int wr, int wc, int fr, int fq) const {
        { const int l_ = lane_id(); fr = l_ & 15; fq = l_ >> 4; }
        float sq[2][4];
        { f32x4 q_[2][4];
#pragma unroll
        for (int ai = 0; ai < 2; ++ai)
#pragma unroll
            for (int m = 0; m < 4; ++m) q_[ai][m] = ldb<f32x4>(ssqq, (unsigned)((PG8_ROW(u, ai, m) * 8 + (u.pn < 3 ? 0 : 4)) * 4));
#pragma unroll
        for (int ai = 0; ai < 2; ++ai)
#pragma unroll
            for (int m = 0; m < 4; ++m) sq[ai][m] = hsum4(q_[ai][m]);
        PG8_FENCE(); }
        if (u.pn < 3) {
#pragma unroll
            for (int ai = 0; ai < 2; ++ai)
#pragma unroll
                for (int m = 0; m < 4; ++m) { const int row = PG8_ROW(u, ai, m); const float rq = rsqrtf(sq[ai][m] * (1.f / QR) + EPS) * QSCALE;
#pragma unroll
                    for (int bj = 0; bj < 2; ++bj) { const int G = 8 * u.pn + 4 * bj + wc, h = G / 3, gi = G - 3 * h;
                        const f32x4 v0 = acc[ai][bj][m][0] * rq, v1 = acc[ai][bj][m][1] * rq;
                        if (gi < 2) stb(Q, (unsigned)((row * 768 + 32 * G + 8 * fq) * 2), pack8(v0, v1));
                        else { const f32x4 c = ldb<f32x4>(rope, (unsigned)((row * 32 + 4 * fq) * 4)), s = ldb<f32x4>(rope, (unsigned)((row * 32 + 16 + 4 * fq) * 4));
                            stb(Q, (unsigned)((row * 768 + 96 * h + 64 + 4 * fq) * 2), pack4(v0 * c - v1 * s)); stb(Q, (unsigned)((row * 768 + 96 * h + 80 + 4 * fq) * 2), pack4(v0 * s + v1 * c)); } } }
        } else {
#pragma unroll
            for (int ai = 0; ai < 2; ++ai)
#pragma unroll
                for (int m = 0; m < 4; ++m) { const int row = PG8_ROW(u, ai, m); const float rk = rsqrtf(sq[ai][m] * (1.f / KVR) + EPS);
#pragma unroll
                    for (int bj = 0; bj < 2; ++bj) { const int h = 2 * (u.pn - 3) + bj;
                        const u32x4 w = pack8(acc[ai][bj][m][0] * rk, acc[ai][bj][m][1] * rk);
                        if (wc < 2) stb(KN, (unsigned)((row * 512 + 64 * h + 32 * wc + 8 * fq) * 2), w); else stb(V, (unsigned)((row * 512 + 64 * h + 32 * (wc - 2) + 8 * fq) * 2), w); } }
        }
    }
};
__device__ __forceinline__ f32x4 bf_lo4(const u32x4& w) { f32x4 r; r[0] = __uint_as_float(w.x << 16); r[1] = __uint_as_float(w.x & 0xffff0000u); r[2] = __uint_as_float(w.y << 16); r[3] = __uint_as_float(w.y & 0xffff0000u); return r; }
__device__ __forceinline__ f32x4 bf_hi4(const u32x4& w) { f32x4 r; r[0] = __uint_as_float(w.z << 16); r[1] = __uint_as_float(w.z & 0xffff0000u); r[2] = __uint_as_float(w.w << 16); r[3] = __uint_as_float(w.w & 0xffff0000u); return r; }
template <bool MIDS, bool XF32> struct EpiRes {
    static constexpr bool PROBE2 = false;
    static constexpr bool PERM = true, AFTER_DRAIN = false, HAS_MID = MIDS; static constexpr int MID_T = 8;
    const float* ssqy; const void* xin; bf16_t* xout; const float* gate  ; const float* gm  ; bf16_t* A; float* ssqo;
    __device__ __forceinline__ void mid(f32x4 (&acc)[2][2][4][2], const Unit& u, int wr, int fr) const {
        const int l_ = lane_id(); fr = l_ & 15; const int fq = l_ >> 4;
        f32x4 q_[2][4];
#pragma unroll
        for (int ai = 0; ai < 2; ++ai)
#pragma unroll
            for (int m = 0; m < 4; ++m) q_[ai][m] = ldb<f32x4>(ssqy, (unsigned)(PG8_ROW(u, ai, m) * 64 + 16 * fq));
#pragma unroll
        for (int ai = 0; ai < 2; ++ai)
#pragma unroll
            for (int m = 0; m < 4; ++m) { float s = hsum4(q_[ai][m]); s += swz_xor16(s);
                auto rr = __builtin_amdgcn_permlane32_swap(__float_as_uint(s), __float_as_uint(s), false, false); const float sg = __uint_as_float(rr[0]), sa = __uint_as_float(rr[1]);
                const float ratio = sqrtf((sa * (1.f / 512) + EPS) / (sg * (1.f / 512) + EPS));
#pragma unroll
                for (int bj = 0; bj < 2; ++bj)
#pragma unroll
                    for (int n = 0; n < 2; ++n) acc[ai][bj][m][n] = acc[ai][bj][m][n] * ratio; }
    }
    __device__ __forceinline__ void operator()(const f32x4 (&acc)[2][2][4][2], const Unit& u, int wr, int wc, int fr, int fq) const {
        { const int l_ = lane_id(); fr = l_ & 15; fq = l_ >> 4; }
        const int b = u.pm >> 3, c0 = u.pn * BM + wc * 32 + 8 * fq;
        float rs[2][4], ss[2][4];
#pragma unroll
        for (int ai = 0; ai < 2; ++ai)
#pragma unroll
            for (int m = 0; m < 4; ++m) { ss[ai][m] = 0.f; rs[ai][m] = 1.f; }
        if (MIDS) { f32x4 q_[2][4];
#pragma unroll
            for (int ai = 0; ai < 2; ++ai)
#pragma unroll
                for (int m = 0; m < 4; ++m) q_[ai][m] = ldb<f32x4>(ssqy, (unsigned)(PG8_ROW(u, ai, m) * 64 + 32 + 16 * (fq & 1)));
#pragma unroll
            for (int ai = 0; ai < 2; ++ai)
#pragma unroll
                for (int m = 0; m < 4; ++m) { float s = hsum4(q_[ai][m]); s += swz_xor16(s); rs[ai][m] = rsqrtf(s * (1.f / 512) + EPS); }
            PG8_FENCE(); }
#pragma unroll
        for (int bj = 0; bj < 2; ++bj) { const int cb = c0 + bj * HALF;
            const f32x4 g0 = ldb<f32x4>(gate, (unsigned)((b * NMOD + cb) * 4)), g1 = ldb<f32x4>(gate, (unsigned)((b * NMOD + cb + 4) * 4));
            f32x4 m0 = (f32x4){0.f, 0.f, 0.f, 0.f}, m1 = m0; if (gm) { m0 = ldb<f32x4>(gm, (unsigned)((b * DM + cb) * 4)); m1 = ldb<f32x4>(gm, (unsigned)((b * DM + cb + 4) * 4)); }
            if (XF32) {
#pragma unroll
                for (int ai = 0; ai < 2; ++ai) {
                    f32x4 xv[4][2];
#pragma unroll
                    for (int m = 0; m < 4; ++m) { const unsigned off = (unsigned)((PG8_ROW(u, ai, m) * DM + cb) * 4); xv[m][0] = ldb<f32x4>(xin, off); xv[m][1] = ldb<f32x4>(xin, off + 16); }
                    PG8_FENCE();
#pragma unroll
                    for (int m = 0; m < 4; ++m) { const unsigned off = (unsigned)((PG8_ROW(u, ai, m) * DM + cb) * 2), offx = (unsigned)(PG8_ROW(u, ai, m) * (DM * 4) + DM * 2 + cb * 2);
                        const f32x4 x0 = xv[m][0] + g0 * (acc[ai][bj][m][0] * rs[ai][m]), x1 = xv[m][1] + g1 * (acc[ai][bj][m][1] * rs[ai][m]);
                        stb(xout, offx, pack8(x0, x1));
                        if (gm) { ss[ai][m] += hsq4(x0) + hsq4(x1); stb(A, off, pack8(x0 * m0, x1 * m1)); } }
                    PG8_FENCE(); }
            } else {
                u32x4 xw[2][4];
#pragma unroll
                for (int ai = 0; ai < 2; ++ai)
#pragma unroll
                    for (int m = 0; m < 4; ++m) xw[ai][m] = ldb<u32x4>(xin, (unsigned)(PG8_ROW(u, ai, m) * (DM * 4) + DM * 2 + cb * 2));
                PG8_FENCE();
#pragma unroll
                for (int ai = 0; ai < 2; ++ai)
#pragma unroll
                    for (int m = 0; m < 4; ++m) { const unsigned off = (unsigned)((PG8_ROW(u, ai, m) * DM + cb) * 2), offx = (unsigned)(PG8_ROW(u, ai, m) * (DM * 4) + DM * 2 + cb * 2);
                        const f32x4 x0 = bf_lo4(xw[ai][m]) + g0 * (acc[ai][bj][m][0] * rs[ai][m]), x1 = bf_hi4(xw[ai][m]) + g1 * (acc[ai][bj][m][1] * rs[ai][m]);
                        stb(xout, offx, pack8(x0, x1));
                        if (gm) { ss[ai][m] += hsq4(x0) + hsq4(x1); stb(A, off, pack8(x0 * m0, x1 * m1)); } }
                PG8_FENCE(); } }
        if (gm) {
#pragma unroll
            for (int ai = 0; ai < 2; ++ai)
#pragma unroll
                for (int m = 0; m < 4; ++m) { const float s = quad_sum(ss[ai][m]); if (fq == 0) stb(ssqo, (unsigned)((PG8_ROW(u, ai, m) * 16 + u.pn * 4 + wc) * 4), s); } }
    }
};
struct EpiFf1 {
    static constexpr bool PERM = true, AFTER_DRAIN = false, HAS_MID = false; static constexpr int MID_T = -1;
    const float* ssq2; const float* shw2; bf16_t* H;
    __device__ __forceinline__ void mid(f32x4 (&)[2][2][4][2], const Unit&, int, int) const {}
    __device__ __forceinline__ void operator()(const f32x4 (&acc)[2][2][4][2], const Unit& u, int wr, int wc, int fr, int fq) const {
        { const int l_ = lane_id(); fr = l_ & 15; fq = l_ >> 4; }
        const int b = u.pm >> 3, c0 = u.pn * BM + wc * 32 + 8 * fq;
        f32x4 sh[2][2];
#pragma unroll
        for (int bj = 0; bj < 2; ++bj)
#pragma unroll
            for (int n = 0; n < 2; ++n) sh[bj][n] = ldb<f32x4>(shw2, (unsigned)((b * DFF + c0 + bj * HALF + 4 * n) * 4));
        float rsv[2][4]; PG8_RSTD8(rsv, ssq2, 1.f / DM);
#pragma unroll
        for (int ai = 0; ai < 2; ++ai)
#pragma unroll
            for (int m = 0; m < 4; ++m) { const int row = PG8_ROW(u, ai, m); const float rs = rsv[ai][m];
#pragma unroll
                for (int bj = 0; bj < 2; ++bj) { f32x4 v0 = acc[ai][bj][m][0] * rs + sh[bj][0], v1 = acc[ai][bj][m][1] * rs + sh[bj][1];
#pragma unroll
                    for (int i = 0; i < 4; ++i) { const float a = fmaxf(v0[i], 0.f), c = fmaxf(v1[i], 0.f); v0[i] = a * a; v1[i] = c * c; }
                    stb(H, (unsigned)((row * DFF + c0 + bj * HALF) * 2), pack8(v0, v1)); } }
    }
};

template <class Epi, class Sched, bool ALIGN_EPI = false, bool SP2 = false>
__device__ __forceinline__ void gemm_phase(PG8_LAS unsigned char* lds, const Gemm g, const Sched& S, const Epi& E, int wid0) {
    int tid_ = wid0 * 64 + lane_id(); asm volatile("" : "+v"(tid_));
    const int tid = tid_, wid = __builtin_amdgcn_readfirstlane(tid >> 6), lane = tid & 63, wr = wid >> 2, wc = wid & 3, fr = lane & 15, fq = lane >> 4;
    const int K = g.K, nt = K / BK;
    unsigned voffA[2], voffB[2];
#pragma unroll
    for (int i = 0; i < 2; ++i) { int R, C; stage_rc(tid * 16 + i * 8192, R, C); const int Rb = Epi::PERM ? ((R & ~31) + perm32(R & 31)) : R;
        voffA[i] = (unsigned)(R * K + C) * 2u; voffB[i] = (unsigned)(Rb * K + C) * 2u; }
    const size_t kstep = (size_t)(BK * 2);
    const size_t hstep = (size_t)HALF * K * 2;
    const size_t tstep = 2 * hstep;
    const unsigned ldsw = (unsigned)wid * 1024u;
    const int aoff = lds_byte(wr * 64 + fr, fq * 8), boff = lds_byte(wc * 32 + fr, fq * 8);
#define PG8_SA(b, h) (((b) * 2 + (h)) * HTB)
#define PG8_SB(b, h) ((4 + (b) * 2 + (h)) * HTB)
#define PG8_STAGE(bufoff, gbase, voff) do { _Pragma("unroll") for (int _i = 0; _i < 2; ++_i) \
        __builtin_amdgcn_global_load_lds((const unsigned*)((const char*)(gbase) + (voff)[_i]), (PG8_LAS unsigned*)(lds + (bufoff) + ldsw + _i * 8192), 16, 0, 0); } while (0)
#define PG8_LDA(dst, b, h) do { _Pragma("unroll") for (int m = 0; m < 4; ++m) _Pragma("unroll") for (int k = 0; k < 2; ++k) dst[m][k] = *(const PG8_LAS bf16x8*)(lds + PG8_SA(b, h) + aoff + m * 2048 + k * 1024); } while (0)
#define PG8_LDB(dst, b, h) do { _Pragma("unroll") for (int n = 0; n < 2; ++n) _Pragma("unroll") for (int k = 0; k < 2; ++k) dst[n][k] = *(const PG8_LAS bf16x8*)(lds + PG8_SB(b, h) + boff + n * 2048 + k * 1024); } while (0)
#define PG8_MMA(ai, bj, At, Bt) do { __builtin_amdgcn_s_setprio(1); _Pragma("unroll") for (int m = 0; m < 4; ++m) _Pragma("unroll") for (int n = 0; n < 2; ++n) _Pragma("unroll") for (int k = 0; k < 2; ++k) \
        acc[ai][bj][m][n] = __builtin_amdgcn_mfma_f32_16x16x32_bf16(Bt[n][k], At[m][k], acc[ai][bj][m][n], 0, 0, 0); __builtin_amdgcn_s_setprio(0); } while (0)
#define PG8_WAIT_V(n) asm volatile("s_waitcnt vmcnt(" #n ")" ::: "memory")
#define PG8_WAIT_L(n) asm volatile("s_waitcnt lgkmcnt(" #n ")" ::: "memory")
#define PG8_BAR __builtin_amdgcn_s_barrier()
#define PG8_SCHED __builtin_amdgcn_sched_barrier(0)
    Unit cur, nxt; int ui = 0;
    if (!S.next(0, cur)) return;
    f32x4 acc[2][2][4][2];
#pragma unroll
    for (int a = 0; a < 2; ++a)
#pragma unroll
        for (int b = 0; b < 2; ++b)
#pragma unroll
            for (int m = 0; m < 4; ++m)
#pragma unroll
                for (int n = 0; n < 2; ++n) acc[a][b][m][n] = (f32x4){0.f, 0.f, 0.f, 0.f};
    bf16x8 At[4][2], B0[2][2], B1[2][2];
    const char* cA = (const char*)g.A + (size_t)cur.pm * tstep; const char* cB = (const char*)g.Bt + (size_t)cur.pn * tstep;
    S.a_ready(cur);
    if constexpr (SP2) {
        PG8_STAGE(PG8_SB(0, 0), cB, voffB); PG8_STAGE(PG8_SB(0, 1), cB + hstep, voffB); PG8_STAGE(PG8_SA(0, 0), cA, voffA); PG8_STAGE(PG8_SA(0, 1), cA + hstep, voffA);
        if (wr == 1) PG8_BAR;
        PG8_WAIT_V(2); PG8_BAR;
        PG8_STAGE(PG8_SB(1, 0), cB + kstep, voffB); PG8_STAGE(PG8_SA(1, 0), cA + kstep, voffA); PG8_STAGE(PG8_SB(1, 1), cB + hstep + kstep, voffB);
        PG8_WAIT_V(6); PG8_BAR;
    } else {
        PG8_STAGE(PG8_SB(0, 0), cB, voffB); PG8_STAGE(PG8_SA(0, 0), cA, voffA); PG8_STAGE(PG8_SB(0, 1), cB + hstep, voffB); PG8_STAGE(PG8_SA(0, 1), cA + hstep, voffA);
        if (wr == 1) PG8_BAR;
        PG8_WAIT_V(4); PG8_BAR;
        PG8_STAGE(PG8_SB(1, 0), cB + kstep, voffB); PG8_STAGE(PG8_SA(1, 0), cA + kstep, voffA); PG8_STAGE(PG8_SB(1, 1), cB + hstep + kstep, voffB);
        PG8_WAIT_V(6); PG8_BAR;
    }
    for (;;) {
        const bool has_next = S.next(ui + 1, nxt);
        const char* nA = has_next ? (const char*)g.A + (size_t)nxt.pm * tstep : cA; const char* nB = has_next ? (const char*)g.Bt + (size_t)nxt.pn * tstep : cB;
        for (int t = 0; t < nt; t += 2) {
            const bool last = (t == nt - 2);
            const char* a1 = cA + (size_t)(t + 1) * kstep;
            const char* a2 = last ? nA : cA + (size_t)(t + 2) * kstep; const char* b2 = last ? nB : cB + (size_t)(t + 2) * kstep;
            const char* a3 = a2 + kstep; const char* b3 = b2 + kstep;
            if (last && has_next) S.a_ready(nxt);
            if constexpr (Epi::HAS_MID) { if (t == Epi::MID_T) E.mid(acc, cur, wr, fr); }
            if constexpr (SP2) {
            PG8_LDB(B0, 0, 0); PG8_LDB(B1, 0, 1); PG8_SCHED; PG8_LDA(At, 0, 0); PG8_STAGE(PG8_SA(1, 1), a1 + hstep, voffA);
            PG8_WAIT_V(8); PG8_WAIT_L(0); PG8_BAR; PG8_MMA(0, 0, At, B0); PG8_MMA(0, 1, At, B1); PG8_BAR; PG8_SCHED;
            PG8_LDA(At, 0, 1); PG8_STAGE(PG8_SB(0, 0), b2, voffB); PG8_STAGE(PG8_SB(0, 1), b2 + hstep, voffB); PG8_STAGE(PG8_SA(0, 0), a2, voffA);
            PG8_WAIT_V(8); PG8_WAIT_L(0); PG8_BAR; PG8_MMA(1, 0, At, B0); PG8_MMA(1, 1, At, B1); PG8_BAR; PG8_SCHED;
            PG8_LDB(B0, 1, 0); PG8_LDB(B1, 1, 1); PG8_SCHED; PG8_LDA(At, 1, 0); PG8_STAGE(PG8_SA(0, 1), a2 + hstep, voffA);
            PG8_WAIT_V(8); PG8_WAIT_L(0); PG8_BAR; PG8_MMA(0, 0, At, B0); PG8_MMA(0, 1, At, B1); PG8_BAR; PG8_SCHED;
            PG8_LDA(At, 1, 1); PG8_STAGE(PG8_SB(1, 0), b3, voffB); PG8_STAGE(PG8_SB(1, 1), b3 + hstep, voffB); PG8_STAGE(PG8_SA(1, 0), a3, voffA);
            PG8_WAIT_V(8); PG8_WAIT_L(0); PG8_BAR; PG8_MMA(1, 0, At, B0); PG8_MMA(1, 1, At, B1); PG8_BAR; PG8_SCHED;
            } else {
            PG8_LDB(B0, 0, 0); PG8_SCHED; PG8_LDA(At, 0, 0); PG8_STAGE(PG8_SA(1, 1), a1 + hstep, voffA);
            PG8_WAIT_L(8); PG8_BAR; PG8_WAIT_L(0); PG8_MMA(0, 0, At, B0); PG8_BAR; PG8_SCHED;
            PG8_LDB(B1, 0, 1); PG8_STAGE(PG8_SB(0, 0), b2, voffB);
            PG8_BAR; PG8_WAIT_L(0); PG8_MMA(0, 1, At, B1); PG8_BAR;
            PG8_LDA(At, 0, 1); PG8_STAGE(PG8_SA(0, 0), a2, voffA);
            PG8_BAR; PG8_WAIT_L(0); PG8_MMA(1, 0, At, B0); PG8_BAR; PG8_SCHED;
            PG8_STAGE(PG8_SB(0, 1), b2 + hstep, voffB);
            PG8_WAIT_V(6); PG8_BAR; PG8_MMA(1, 1, At, B1); PG8_BAR;
            PG8_LDB(B0, 1, 0); PG8_SCHED; PG8_LDA(At, 1, 0); PG8_STAGE(PG8_SA(0, 1), a2 + hstep, voffA);
            PG8_WAIT_L(8); PG8_BAR; PG8_WAIT_L(0); PG8_MMA(0, 0, At, B0); PG8_BAR; PG8_SCHED;
            PG8_LDB(B1, 1, 1); PG8_STAGE(PG8_SB(1, 0), b3, voffB);
            PG8_BAR; PG8_WAIT_L(0); PG8_MMA(0, 1, At, B1); PG8_BAR;
            PG8_LDA(At, 1, 1); PG8_STAGE(PG8_SA(1, 0), a3, voffA);
            PG8_BAR; PG8_WAIT_L(0); PG8_MMA(1, 0, At, B0); PG8_BAR; PG8_SCHED;
            PG8_STAGE(PG8_SB(1, 1), b3 + hstep, voffB);
            PG8_WAIT_V(6); PG8_BAR; PG8_MMA(1, 1, At, B1); PG8_BAR;
            }
        }
        if constexpr (ALIGN_EPI) { if (wr == 0) PG8_BAR; }
        if constexpr (!Epi::AFTER_DRAIN) { E(acc, cur, wr, wc, fr, fq); S.done(cur); }
        if (!has_next) break;
#pragma unroll
        for (int a = 0; a < 2; ++a)
#pragma unroll
            for (int b = 0; b < 2; ++b)
#pragma unroll
                for (int m = 0; m < 4; ++m)
#pragma unroll
                    for (int n = 0; n < 2; ++n) acc[a][b][m][n] = (f32x4){0.f, 0.f, 0.f, 0.f};
        cur = nxt; cA = nA; cB = nB; ++ui;
        if constexpr (ALIGN_EPI) { if (wr == 1) PG8_BAR; }
    }
    PG8_WAIT_V(0);
    if constexpr (!ALIGN_EPI) { if (wr == 0) PG8_BAR; }
    PG8_BAR;
    if constexpr (Epi::AFTER_DRAIN) { E.fused(acc, cur, wr, wc, fr, fq, lds, wid, lane); S.done(cur); }
#undef PG8_SA
#undef PG8_SB
#undef PG8_STAGE
#undef PG8_LDA
#undef PG8_LDB
#undef PG8_MMA
#undef PG8_WAIT_V
#undef PG8_WAIT_L
#undef PG8_BAR
#undef PG8_SCHED
}
}

namespace gm {
#define GM_LAS __attribute__((address_space(3)))
typedef short v4i16_t __attribute__((ext_vector_type(4)));
__device__ __forceinline__ int swz(int s) { return ((s >> 1) & 1) + 2 * ((s >> 3) & 1); }
__device__ __forceinline__ void gmlp_phase(GM_LAS unsigned char* lds, int wid0, int vcu, const bf16_t* U, const bf16_t* VN, const bf16_t* GW  , const float* bs  , const float* gog  , bf16_t* Y, float* ssqy) {
    int tid_ = wid0 * 64 + lane_id(); asm volatile("" : "+v"(tid_));
    const int tid = tid_, lane = tid & 63, wid = __builtin_amdgcn_readfirstlane(tid >> 6), fr = lane & 15, fq = lane >> 4;
    const int g = vcu & 7, nks = (wid >> 1) + 1;
    bf16x8 wf[4];
#pragma unroll
    for (int ks = 0; ks < 4; ++ks) wf[ks] = *(const bf16x8*)(GW + ((size_t)(g * CHUNK + 16 * wid + fr)) * CHUNK + 32 * ks + 8 * fq);
    const float bias = bs[g * CHUNK + 16 * wid + fr];
    f32x4 gv[4];
#pragma unroll
    for (int nt = 0; nt < 4; ++nt) gv[nt] = *(const f32x4*)(gog + g * 64 + 16 * nt + 4 * fq);
    for (int i = 0; i < 8; ++i) {
        const int un = (vcu >> 3) + 32 * i; const size_t t0 = (size_t)un * CHUNK;
        pg8::u32x4 st[2];
#pragma unroll
        for (int k = 0; k < 2; ++k) { const int idx = tid + 512 * k, s = idx >> 3, c16 = idx & 7; st[k] = *(const pg8::u32x4*)(VN + (t0 + s) * 512 + g * 64 + c16 * 8); }
        __syncthreads();
#pragma unroll
        for (int k = 0; k < 2; ++k) { const int idx = tid + 512 * k, s = idx >> 3, c16 = idx & 7; *(GM_LAS pg8::u32x4*)(lds + s * 128 + (((c16 >> 1) ^ swz(s)) * 32) + (c16 & 1) * 16) = st[k]; }
        __syncthreads();
        f32x4 acc[4];
#pragma unroll
        for (int nt = 0; nt < 4; ++nt) acc[nt] = (f32x4){0.f, 0.f, 0.f, 0.f};
#pragma unroll
        for (int ks = 0; ks < 4; ++ks) { if (ks < nks) {
#pragma unroll
            for (int nt = 0; nt < 4; ++nt) {
                const int q = fr >> 2, p = fr & 3;
                const int s0 = 32 * ks + 8 * fq + q, s1 = s0 + 4;
                const v4i16_t lo = __builtin_amdgcn_ds_read_tr16_b64_v4i16((GM_LAS v4i16_t*)(lds + s0 * 128 + ((nt ^ swz(s0)) * 32) + p * 8));
                const v4i16_t hi = __builtin_amdgcn_ds_read_tr16_b64_v4i16((GM_LAS v4i16_t*)(lds + s1 * 128 + ((nt ^ swz(s1)) * 32) + p * 8));
                const bf16x8 vf = (bf16x8){lo[0], lo[1], lo[2], lo[3], hi[0], hi[1], hi[2], hi[3]};
                acc[nt] = __builtin_amdgcn_mfma_f32_16x16x32_bf16(vf, wf[ks], acc[nt], 0, 0, 0);
            } } }
        const size_t row = t0 + 16 * wid + fr; float ss = 0.f;
#pragma unroll
        for (int nt = 0; nt < 4; ++nt) { const int c = g * 64 + 16 * nt + 4 * fq;
            const uint2 uu = *(const uint2*)(U + row * 512 + c);
            f32x4 y; y[0] = bf2f((bf16_t)(uu.x & 0xffff)) * (acc[nt][0] + bias); y[1] = bf2f((bf16_t)(uu.x >> 16)) * (acc[nt][1] + bias);
            y[2] = bf2f((bf16_t)(uu.y & 0xffff)) * (acc[nt][2] + bias); y[3] = bf2f((bf16_t)(uu.y >> 16)) * (acc[nt][3] + bias);
            ss += pg8::hsq4(y); *(pg8::u32x2*)(Y + row * DM + c) = pg8::pack4(y * gv[nt]); }
        ss = pg8::quad_sum(ss); if (fq == 0) ssqy[row * 16 + g] = ss;
    }
    __syncthreads();
}
}

namespace att {
#define AT_LAS __attribute__((address_space(3)))
using f32x16 = __attribute__((ext_vector_type(16))) float;
using s16x4 = __attribute__((ext_vector_type(4))) short;
using u32x4 = __attribute__((ext_vector_type(4))) unsigned;
constexpr int KVBLK = 64, NSLOT = 3, SLOTB = 20480, VOFF = 12288;
constexpr int LDS_WS = NSLOT * SLOTB  , LDS_OST = LDS_WS + 8 * 256  , OROW = 272, LDS_BYTES = LDS_OST + 8 * 32 * OROW  ;
__device__ __forceinline__ int crow(int r, int hi) { return (r & 3) + 8 * (r >> 2) + 4 * hi; }
__device__ __forceinline__ void glds16(const void* gsrc, unsigned lds_dst) { unsigned keep;
    asm volatile("s_mov_b32 %0, m0\n\ts_mov_b32 m0, %2\n\ts_nop 0\n\tglobal_load_lds_dwordx4 %1, off\n\ts_mov_b32 m0, %0" : "=&s"(keep) : "v"(gsrc), "s"(lds_dst) : "memory"); }
#define AT_WAIT_BAR(N) asm volatile("s_waitcnt vmcnt(" #N ") lgkmcnt(0)\n\ts_barrier" ::: "memory")
#define AT_SBAR() __builtin_amdgcn_sched_barrier(0)
typedef short v4i16_t __attribute__((ext_vector_type(4)));
__device__ __forceinline__ s16x4 vtr(AT_LAS const char* p) { return __builtin_bit_cast(s16x4, __builtin_amdgcn_ds_read_tr16_b64_v4i16((AT_LAS v4i16_t*)p)); }

template <int THRL>
__device__ __forceinline__ void attn_unit(int b, int h, int qb, const bf16_t* Q, const bf16_t* KN, const bf16_t* KR, const bf16_t* V, const float* goa  , bf16_t* Y, float* ssqy, AT_LAS char* shm, int wid0) {
    int tid_ = wid0 * 64 + lane_id(); asm volatile("" : "+v"(tid_));
    const int tid = tid_, lane = tid & 63, r32 = lane & 31, hi = lane >> 5; const int wid = __builtin_amdgcn_readfirstlane(tid >> 6);
    const size_t rowbase = (size_t)b * SEQ; const int q0 = qb * 256;
    const bf16_t* Qw = Q + (rowbase + q0 + wid * 32) * 768 + h * 96;
    const unsigned lds0 = (unsigned)(uintptr_t)shm;
    AT_LAS float* wsf = (AT_LAS float*)(shm + LDS_WS) + wid * 64;
    const bf16_t* ksrc = KN + (rowbase + lane) * 512 + h * 64 + wid * 8;
    const bf16_t* rsrc = KR + (rowbase + lane) * 32 + (wid & 3) * 8;
    const bf16_t* vsrc = V + (rowbase + 16 * (wid & 3) + (lane >> 2)) * 512 + h * 64 + (wid >> 2) * 32 + (lane & 3) * 8;
    const unsigned kdst = lds0 + wid * 1024, rdst = lds0 + (8 + (wid & 3)) * 1024, vdst = lds0 + VOFF + wid * 1024;
#define AT_DMA(t, slot) do { glds16(ksrc + (size_t)(t) * KVBLK * 512, (unsigned)__builtin_amdgcn_readfirstlane(kdst + (slot))); \
        glds16(rsrc + (size_t)(t) * KVBLK * 32, (unsigned)__builtin_amdgcn_readfirstlane(rdst + (slot))); \
        glds16(vsrc + (size_t)(t) * KVBLK * 512, (unsigned)__builtin_amdgcn_readfirstlane(vdst + (slot))); } while (0)
    const int NT = (q0 + 256) / KVBLK;
    bf16x8 qr[6];
#pragma unroll
    for (int d0 = 0; d0 < 6; ++d0) qr[d0] = *(const bf16x8*)(Qw + (size_t)r32 * 768 + d0 * 16 + hi * 8);
    AT_DMA(0, 0); AT_DMA(1, SLOTB);
    float mhat = 0.f, l_reg = 0.f; f32x16 o[2]; o[0] = f32x16{}; o[1] = f32x16{};
    const int qrel = wid * 32 + r32;
    int sl_cur = 0, sl_nn = 2 * SLOTB;
    AT_LAS const char* kp0 = shm + hi * 1024 + r32 * 16;
    AT_LAS const char* vp0 = shm + VOFF + ((lane >> 4) & 1) * 32 + (lane & 3) * 8 + (4 * hi + ((lane & 15) >> 2)) * 64;
    for (int t = 0; t < NT; ++t) {
        if (t + 1 < NT) { AT_WAIT_BAR(3); } else { AT_WAIT_BAR(0); }
        if (t + 2 < NT) AT_DMA(t + 2, sl_nn);
        const int jb = t - (NT - 4);
        if (jb <= (wid >> 1)) {
            f32x16 p0, p1;
            { AT_LAS const char* kb = kp0 + sl_cur;
#pragma unroll
              for (int d0 = 0; d0 < 6; ++d0) {
                const bf16x8 b0 = *(AT_LAS const bf16x8*)(kb + d0 * 2048), b1 = *(AT_LAS const bf16x8*)(kb + d0 * 2048 + 512);
                if (d0 == 0) { p0 = __builtin_amdgcn_mfma_f32_32x32x16_bf16(b0, qr[0], f32x16{}, 0, 0, 0); p1 = __builtin_amdgcn_mfma_f32_32x32x16_bf16(b1, qr[0], f32x16{}, 0, 0, 0); }
                else { p0 = __builtin_amdgcn_mfma_f32_32x32x16_bf16(b0, qr[d0], p0, 0, 0, 0); p1 = __builtin_amdgcn_mfma_f32_32x32x16_bf16(b1, qr[d0], p1, 0, 0, 0); } } }
            if (jb >= 0) { const int kb = 64 * jb + 4 * hi;
#pragma unroll
                for (int r = 0; r < 16; ++r) { const int kv = kb + (r & 3) + 8 * (r >> 2); if (kv > qrel) p0[r] = -INFINITY; if (kv + 32 > qrel) p1[r] = -INFINITY; } }
            float rm = fmaxf(p0[0], p1[0]);
#pragma unroll
            for (int r = 1; r < 16; ++r) rm = fmaxf(rm, fmaxf(p0[r], p1[r]));
            { auto rr = __builtin_amdgcn_permlane32_swap(__float_as_uint(rm), __float_as_uint(rm), false, false); rm = fmaxf(__uint_as_float(rr[0]), __uint_as_float(rr[1])); }
            const float grow = rm - mhat;
            if (t == 0 || __any(grow > (float)THRL)) {
                const float dl = (t == 0) ? rm : fmaxf(grow, 0.f); const float f = (t == 0) ? 0.f : __builtin_amdgcn_exp2f(-dl);
                mhat = (t == 0) ? rm : mhat + dl; l_reg *= f;
                if (t > 0) { if (hi == 0) wsf[r32] = f; asm volatile("s_waitcnt lgkmcnt(0)" ::: "memory");
#pragma unroll
                    for (int r = 0; r < 16; ++r) { const float fr_ = wsf[crow(r, hi)]; o[0][r] *= fr_; o[1][r] *= fr_; } }
            }
            float sacc = 0.f;
#pragma unroll
            for (int r = 0; r < 16; ++r) { p0[r] = __builtin_amdgcn_exp2f(p0[r] - mhat); p1[r] = __builtin_amdgcn_exp2f(p1[r] - mhat); sacc += p0[r] + p1[r]; }
            l_reg += sacc;
            u32x4 pw0, pw1, pw2, pw3;
#define AT_PK(P, B) pg8::cvt_pk_bf16(P[B], P[B + 1])
            pw0 = (u32x4){AT_PK(p0, 0), AT_PK(p0, 2), AT_PK(p0, 4), AT_PK(p0, 6)}; pw1 = (u32x4){AT_PK(p0, 8), AT_PK(p0, 10), AT_PK(p0, 12), AT_PK(p0, 14)};
            pw2 = (u32x4){AT_PK(p1, 0), AT_PK(p1, 2), AT_PK(p1, 4), AT_PK(p1, 6)}; pw3 = (u32x4){AT_PK(p1, 8), AT_PK(p1, 10), AT_PK(p1, 12), AT_PK(p1, 14)};
#undef AT_PK
            AT_LAS const char* vp = vp0 + sl_cur;
#pragma unroll
            for (int d0 = 0; d0 < 2; ++d0) { s16x4 lo[4], hh[4];
#pragma unroll
                for (int ks = 0; ks < 4; ++ks) { lo[ks] = vtr(vp + d0 * 4096 + ks * 1024); hh[ks] = vtr(vp + d0 * 4096 + ks * 1024 + 512); }
#define AT_VF(k) (bf16x8){lo[k][0], lo[k][1], lo[k][2], lo[k][3], hh[k][0], hh[k][1], hh[k][2], hh[k][3]}
                o[d0] = __builtin_amdgcn_mfma_f32_32x32x16_bf16(__builtin_bit_cast(bf16x8, pw0), AT_VF(0), o[d0], 0, 0, 0);
                o[d0] = __builtin_amdgcn_mfma_f32_32x32x16_bf16(__builtin_bit_cast(bf16x8, pw1), AT_VF(1), o[d0], 0, 0, 0);
                o[d0] = __builtin_amdgcn_mfma_f32_32x32x16_bf16(__builtin_bit_cast(bf16x8, pw2), AT_VF(2), o[d0], 0, 0, 0);
                o[d0] = __builtin_amdgcn_mfma_f32_32x32x16_bf16(__builtin_bit_cast(bf16x8, pw3), AT_VF(3), o[d0], 0, 0, 0);
#undef AT_VF
            }
        }
        sl_cur = (sl_cur == 2 * SLOTB) ? 0 : sl_cur + SLOTB; sl_nn = (sl_nn == 2 * SLOTB) ? 0 : sl_nn + SLOTB;
    }
    { auto rr = __builtin_amdgcn_permlane32_swap(__float_as_uint(l_reg), __float_as_uint(l_reg), false, false); l_reg = __uint_as_float(rr[0]) + __uint_as_float(rr[1]); }
    if (hi == 0) wsf[32 + r32] = __builtin_amdgcn_rcpf(l_reg);
    asm volatile("s_waitcnt lgkmcnt(0)" ::: "memory");
    AT_LAS char* stg = shm + LDS_OST + wid * (32 * OROW);
#pragma unroll
    for (int r = 0; r < 16; ++r) { const int orow = crow(r, hi); const float rl = wsf[32 + orow];
        *(AT_LAS float*)(stg + orow * OROW + r32 * 4) = o[0][r] * rl; *(AT_LAS float*)(stg + orow * OROW + 128 + r32 * 4) = o[1][r] * rl; }
    asm volatile("s_waitcnt lgkmcnt(0)" ::: "memory");
    { const int row = lane >> 1, half = lane & 1; const size_t grow = rowbase + q0 + wid * 32 + row; float ss = 0.f;
      const float* gp = goa + h * 64 + half * 32; bf16_t* yp = Y + grow * DM + 512 + h * 64 + half * 32;
#pragma unroll
      for (int i = 0; i < 4; ++i) { const f32x4 a = *(AT_LAS const f32x4*)(stg + row * OROW + half * 128 + i * 32), c = *(AT_LAS const f32x4*)(stg + row * OROW + half * 128 + i * 32 + 16);
          ss += pg8::hsq4(a) + pg8::hsq4(c);
          *(u32x4*)(yp + i * 8) = pg8::pack8(a * *(const f32x4*)(gp + i * 8), c * *(const f32x4*)(gp + i * 8 + 4)); }
      ss += swz_xor1(ss); if (half == 0) ssqy[grow * 16 + 8 + h] = ss; }
    asm volatile("s_waitcnt lgkmcnt(0)\n\ts_barrier" ::: "memory");
#undef AT_DMA
}
__device__ __forceinline__ void attn_phase(AT_LAS char* lds, int wid0, int vcu, const bf16_t* Q, const bf16_t* KN, const bf16_t* KR, const bf16_t* V, const float* goa, bf16_t* Y, float* ssqy) {
    const int bh = vcu >> 1, s = vcu & 1;
    for (int i = 0; i < 4; ++i) { const int qb = (i == 0) ? s : (i == 1) ? 7 - s : (i == 2) ? 2 + s : 5 - s;
        attn_unit<8>(bh >> 3, bh & 7, qb, Q, KN, KR, V, goa, Y, ssqy, lds, wid0); }
}
}

constexpr int NWAVES = 8;
struct Args { const void* in[20]; float* out; unsigned char* ws; int ph_lo, ph_hi, li, flags; };
namespace pro {
#define PR_LAS __attribute__((address_space(3)))
__device__ __forceinline__ unsigned pk2(float lo, float hi) { return (unsigned)f2bf(lo) | ((unsigned)f2bf(hi) << 16); }
template <int MODE  >
__device__ __forceinline__ void tr_item(const float* W, int ldw, bf16_t* WT, int out_ld, int out_koff, int nblk, PR_LAS float* scr, int item, int lane) {
    const int kb = item / nblk, nb = item - kb * nblk, k0 = 64 * kb, n0 = 32 * nb;
    const int pn = n0 + (lane & 31); const int sc0 = MODE == 0 ? pn : (MODE == 1 ? win_src(pn) : wup_qcol(pn));
    const int sc = sc0 >= 0 ? sc0 : 0; const float msk = sc0 >= 0 ? 1.f : 0.f;
    const float* wp = W + (size_t)(k0 + (lane >> 5)) * ldw + sc;
    float v[32];
#pragma unroll
    for (int i = 0; i < 32; ++i) v[i] = wp[(size_t)(2 * i) * ldw];
#pragma unroll
    for (int i = 0; i < 32; ++i) scr[(2 * i + (lane >> 5)) * 33 + (lane & 31)] = v[i] * msk;
    asm volatile("s_waitcnt lgkmcnt(0)" ::: "memory");
    const int c = lane & 7;
#pragma unroll
    for (int j = 0; j < 4; ++j) { const int n = (lane >> 3) + 8 * j; const PR_LAS float* s = scr + (8 * c) * 33 + n;
        pg8::u32x4 o; o.x = pk2(s[0 * 33], s[1 * 33]); o.y = pk2(s[2 * 33], s[3 * 33]); o.z = pk2(s[4 * 33], s[5 * 33]); o.w = pk2(s[6 * 33], s[7 * 33]);
        *(pg8::u32x4*)(WT + (size_t)(n0 + n) * out_ld + out_koff + k0 + 8 * c) = o; }
    asm volatile("s_waitcnt lgkmcnt(0)" ::: "memory");
}
__device__ __forceinline__ void smallm_unit(PR_LAS unsigned char* lds, int tid, const float* in, int in_stride, bool act, const float* W, int ldw, int N, bool winmap, const float* bias, float* out, int out_stride, int p0, int ucols) {
    PR_LAS float* sin_ = (PR_LAS float*)lds; PR_LAS float* red = (PR_LAS float*)(lds + 65536);
    const int lane = tid & 63, wave = tid >> 6;
#pragma unroll 8
    for (int e = tid; e < 16 * 1024; e += 512) { const int b = e >> 10, k = e & 1023; float v = in[(size_t)b * in_stride + k]; if (act) v = v * __builtin_amdgcn_rcpf(1.f + __expf(-v)); sin_[k * 16 + b] = v; }
    __syncthreads();
    const int p = p0 + lane; const int s0 = winmap ? win_src(p) : p; const bool ok = (lane < ucols && s0 >= 0 && s0 < N);
    const int sc = ok ? s0 : 0; const float msk = ok ? 1.f : 0.f;
    const float* wp = W + (size_t)(wave * 128) * ldw + sc;
    float acc[16];
#pragma unroll
    for (int b = 0; b < 16; ++b) acc[b] = 0.f;
    for (int k0 = 0; k0 < 128; k0 += 16) {
        float w[16];
#pragma unroll
        for (int j = 0; j < 16; ++j) w[j] = wp[(size_t)(k0 + j) * ldw];
#pragma unroll
        for (int j = 0; j < 16; ++j) { const PR_LAS f32x4* sp = (const PR_LAS f32x4*)(sin_ + (wave * 128 + k0 + j) * 16);
#pragma unroll
            for (int q = 0; q < 4; ++q) { const f32x4 v = sp[q]; acc[4 * q] += v[0] * w[j]; acc[4 * q + 1] += v[1] * w[j]; acc[4 * q + 2] += v[2] * w[j]; acc[4 * q + 3] += v[3] * w[j]; } }
    }
#pragma unroll
    for (int b = 0; b < 16; ++b) red[(wave * 64 + lane) * 16 + b] = acc[b] * msk;
    __syncthreads();
    for (int e = tid; e < 64 * 16; e += 512) { const int l = e >> 4, b = e & 15; float sum = 0.f;
#pragma unroll
        for (int w = 0; w < 8; ++w) sum += red[(w * 64 + l) * 16 + b];
        if (l < ucols) out[(size_t)b * out_stride + p0 + l] = sum + (bias ? bias[p0 + l] : 0.f); }
    __syncthreads();
}
__device__ __forceinline__ float wsum(float v) {
    v += __int_as_float(__builtin_amdgcn_ds_swizzle(__float_as_int(v), 0x041F)); v += __int_as_float(__builtin_amdgcn_ds_swizzle(__float_as_int(v), 0x081F));
    v += __int_as_float(__builtin_amdgcn_ds_swizzle(__float_as_int(v), 0x101F)); v += __int_as_float(__builtin_amdgcn_ds_swizzle(__float_as_int(v), 0x201F));
    v += __int_as_float(__builtin_amdgcn_ds_swizzle(__float_as_int(v), 0x401F));
    auto rr = __builtin_amdgcn_permlane32_swap(__float_as_uint(v), __float_as_uint(v), false, false); return __uint_as_float(rr[0]) + __uint_as_float(rr[1]);
}
__device__ __forceinline__ void phase0a(PR_LAS unsigned char* lds, int wid0, int vcu, int G, const Args& args, int zi, unsigned char* ws) {
    int tid_ = wid0 * 64 + lane_id(); asm volatile("" : "+v"(tid_));
    const int tid = tid_, lane = tid & 63, wave = tid >> 6;
#define PIN(i) ((const float*)args.in[(i) + zi])
    for (int un = vcu; un < DEPTH * (NMOD / 48); un += G) { const int l = un / (NMOD / 48), p0 = (un % (NMOD / 48)) * 48;
        smallm_unit(lds, tid, PIN(1), DM, true, PIN(3) + (size_t)l * DM * NMOD, NMOD, NMOD, false, PIN(4) + (size_t)l * NMOD, (float*)(ws + WS_MOD) + (size_t)l * NB * NMOD, NMOD, p0, 48); }
    { const int* pos = (const int*)args.in[2 + zi]; float* rope = (float*)(ws + WS_ROPE);
      for (int idx = vcu * 512 + tid; idx < T * 16; idx += G * 512) { const int t = idx >> 4, i = idx & 15;
          const float freq = exp2f(-(float)i * (13.287712379549449f / 16.0f)); const float ang = (float)pos[t] * freq;
          rope[t * 32 + i] = cosf(ang); rope[t * 32 + 16 + i] = sinf(ang); } }
    { const float* gws = PIN(7); bf16_t* gw = (bf16_t*)(ws + WS_GW);
      for (int idx = vcu * 512 + tid; idx < DEPTH * NGRP * CHUNK * CHUNK; idx += G * 512) { const int s = idx & 127, t = (idx >> 7) & 127; gw[idx] = (s <= t) ? f2bf(gws[idx]) : (bf16_t)0; } }
    PR_LAS float* scr = (PR_LAS float*)(lds + wave * 16384);
    const int gw_ = vcu * NWAVES + wave, NGW = G * NWAVES;
    constexpr int I_IN = (DM / 64) * (NIN / 32), I_UQ = (QR / 64) * (768 / 32), I_UKV = (KVR / 64) * (1024 / 32), I_OUT = (DM / 64) * (DM / 32), I_1 = (DM / 64) * (DFF / 32), I_2 = (DFF / 64) * (DM / 32);
    constexpr int I_LAYER = I_IN + I_UQ + I_UKV + I_OUT + I_1 + I_2;
    for (int it = gw_; it < DEPTH * I_LAYER; it += NGW) {
        const int l = it / I_LAYER; int r = it - l * I_LAYER; unsigned char* wl = ws + WS_W + (size_t)l * WL_STRIDE;
        if (r < I_IN) { tr_item<1>(PIN(6) + (size_t)l * DM * DIN, DIN, (bf16_t*)(wl + WL_IN), DM, 0, NIN / 32, scr, r, lane); continue; } r -= I_IN;
        if (r < I_UQ) { tr_item<2>(PIN(11) + (size_t)l * QR * 768, 768, (bf16_t*)(wl + WL_UP), KUP, 0, 768 / 32, scr, r, lane); continue; } r -= I_UQ;
        if (r < I_UKV) { tr_item<0>(PIN(12) + (size_t)l * KVR * 1024, 1024, (bf16_t*)(wl + WL_UP) + (size_t)768 * KUP, KUP, 256, 1024 / 32, scr, r, lane); continue; } r -= I_UKV;
        if (r < I_OUT) { tr_item<0>(PIN(15) + (size_t)l * DM * DM, DM, (bf16_t*)(wl + WL_OUT), DM, 0, DM / 32, scr, r, lane); continue; } r -= I_OUT;
        if (r < I_1) { tr_item<0>(PIN(17) + (size_t)l * DM * DFF, DFF, (bf16_t*)(wl + WL_1), DM, 0, DFF / 32, scr, r, lane); continue; } r -= I_1;
        tr_item<0>(PIN(18) + (size_t)l * DFF * DM, DM, (bf16_t*)(wl + WL_2), DFF, 0, DM / 32, scr, r, lane);
    }
    for (int idx = vcu * 512 + tid; idx < DEPTH * (768 * 16 + 1024 * 32); idx += G * 512) {
        const int l = idx / (768 * 16 + 1024 * 32); int r = idx - l * (768 * 16 + 1024 * 32); bf16_t* wup = (bf16_t*)(ws + WS_W + (size_t)l * WL_STRIDE + WL_UP);
        pg8::u32x4 z; z.x = 0u; z.y = 0u; z.z = 0u; z.w = 0u;
        if (r < 768 * 16) { const int row = r >> 4, c = r & 15; *(pg8::u32x4*)(wup + (size_t)row * KUP + 256 + 8 * c) = z; }
        else { r -= 768 * 16; const int row = 768 + (r >> 5), c = r & 31; *(pg8::u32x4*)(wup + (size_t)row * KUP + 8 * c) = z; } }
#undef PIN
}
__device__ __forceinline__ void phase0b(PR_LAS unsigned char* lds, int wid0, int vcu, int G, const Args& args, int zi, unsigned char* ws) {
    int tid_ = wid0 * 64 + lane_id(); asm volatile("" : "+v"(tid_));
    const int tid = tid_, lane = tid & 63, wave = tid >> 6;
#define PIN(i) ((const float*)args.in[(i) + zi])
    float* MOD = (float*)(ws + WS_MOD);
    constexpr int U1 = NIN / 48, U2 = DFF / 64, NUNITS = DEPTH * (U1 + U2);
    for (int un = vcu; un < NUNITS; un += G) { const int l = un / (U1 + U2), r = un % (U1 + U2); const float* modl = MOD + (size_t)l * NB * NMOD;
        if (r < U1) smallm_unit(lds, tid, modl, NMOD, false, PIN(6) + (size_t)l * DM * DIN, DIN, DIN, true, nullptr, (float*)(ws + WS_SHW1) + (size_t)l * NB * NIN, NIN, r * 48, 48);
        else smallm_unit(lds, tid, modl + 3 * DM, NMOD, false, PIN(17) + (size_t)l * DM * DFF, DFF, DFF, false, nullptr, (float*)(ws + WS_SHW2) + (size_t)l * NB * DFF, DFF, (r - U1) * 64, 64); }
    for (int idx = vcu * 512 + tid; idx < DEPTH * NB * DM; idx += G * 512) { const int c = idx & 1023, b = (idx >> 10) & 15, l = idx >> 14; const float* m = MOD + ((size_t)l * NB + b) * NMOD;
        ((float*)(ws + WS_GM1))[idx] = PIN(5)[l * DM + c] * (1.f + m[1 * DM + c]); ((float*)(ws + WS_GM2))[idx] = PIN(16)[l * DM + c] * (1.f + m[4 * DM + c]); }
    { const float* x = PIN(0); const float* g = PIN(5); bf16_t* A = (bf16_t*)(ws + WS_A); float* ssq = (float*)(ws + WS_SSQ1);
      const int nun = NUNITS < G ? NUNITS : G; const int wgt = vcu < nun ? 7 : 12, slot0 = vcu < nun ? 7 * vcu : 7 * nun + 12 * (vcu - nun), nslot = 7 * nun + 12 * (G - nun);
      for (int sl = 0; sl < wgt; ++sl)
      for (int row = (slot0 + sl) * NWAVES + wave; row < T; row += nslot * NWAVES) { const int b = row / SEQ; const f32x4* xr = (const f32x4*)(x + (size_t)row * DM); const float* sc = MOD + (size_t)b * NMOD + DM; float s = 0.f;
#pragma unroll
          for (int j = 0; j < 4; ++j) { const f32x4 v = xr[lane + 64 * j]; s += pg8::hsq4(v); const int c = 4 * (lane + 64 * j); const f32x4 gv = *(const f32x4*)(g + c), sv = *(const f32x4*)(sc + c);
              *(pg8::u32x2*)(A + (size_t)row * DM + c) = pg8::pack4(v * gv * (sv + 1.f)); }
          s = wsum(s); if (lane < 16) ssq[(size_t)row * 16 + lane] = (lane == 0) ? s : 0.f; } }
#undef PIN
}
__device__ __forceinline__ void phase_final(int wid0, int vcu, int G, const float* g, const bf16_t* xb, float* dst) {
    int tid_ = wid0 * 64 + lane_id(); asm volatile("" : "+v"(tid_));
    const int lane = tid_ & 63, wave = tid_ >> 6;
    for (int row = vcu * NWAVES + wave; row < T; row += G * NWAVES) { const pg8::u32x4* xr = (const pg8::u32x4*)(xb + (size_t)row * (2 * DM) + DM); f32x4* yr = (f32x4*)(dst + (size_t)row * DM); f32x4 v[4]; float s = 0.f;
#pragma unroll
        for (int j = 0; j < 2; ++j) { const pg8::u32x4 w = xr[lane + 64 * j]; v[2 * j] = pg8::bf_lo4(w); v[2 * j + 1] = pg8::bf_hi4(w); s += pg8::hsq4(v[2 * j]) + pg8::hsq4(v[2 * j + 1]); }
        const float rstd = rsqrtf(wsum(s) * (1.f / DM) + EPS);
#pragma unroll
        for (int j = 0; j < 2; ++j) { const int c = 8 * (lane + 64 * j); const f32x4 g0 = *(const f32x4*)(g + c), g1 = *(const f32x4*)(g + c + 4); yr[2 * (lane + 64 * j)] = v[2 * j] * rstd * g0; yr[2 * (lane + 64 * j) + 1] = v[2 * j + 1] * rstd * g1; } }
}
}

constexpr int RING_BYTES = 131072;
constexpr int LDSCTL_OFF = 135168, MISC_OFF = LDSCTL_OFF + 320;
constexpr int LDS_BYTES = 147456;
static_assert(att::LDS_BYTES <= LDSCTL_OFF, "attention scratch below the control words");
constexpr int CW_BAR = 4096;
constexpr size_t CTL_ZERO_BYTES = 64 * 1024;

#define GAS __attribute__((address_space(1)))
#define LAS __attribute__((address_space(3)))
typedef GAS unsigned gu32;
#define RLX_AGENT __ATOMIC_RELAXED, __HIP_MEMORY_SCOPE_AGENT
#define XB_TMO      128
#define XB_XCNT(j)  (256  + 64 * (j))
#define XB_XSUB(j)  (1280 + 64 * (j))
#define XB_XGEN(j)  (2304 + 64 * (j))
#define XB_TOP      3328
#define XB_TOPGEN   3392
#define XCD_BAR_WORDS 3456
#define XB_SPIN_CAP (1u << 18)
__device__ __forceinline__ unsigned xb_ld(unsigned* p)              { return __hip_atomic_load(p, __ATOMIC_RELAXED, __HIP_MEMORY_SCOPE_AGENT); }
__device__ __forceinline__ unsigned xb_add(unsigned* p, unsigned v) { return __hip_atomic_fetch_add(p, v, __ATOMIC_RELAXED, __HIP_MEMORY_SCOPE_AGENT); }
__device__ __forceinline__ unsigned xb_xcc_id() { return (unsigned)__builtin_amdgcn_s_getreg((3 << 11) | 20) & 0xFu; }
#define XB_SPIN(cond, bar) do { unsigned _sp = 0; while (cond) { __builtin_amdgcn_s_sleep(1); \
    if ((++_sp & 255u) == 0u) { if (xb_ld(&(bar)[XB_TMO])) break; if (_sp > XB_SPIN_CAP) { atomicAdd(&(bar)[XB_TMO], 1u); break; } } } } while (0)
struct XcdBarrier { unsigned* bar; unsigned x; volatile LAS unsigned* st; };
__device__ __forceinline__ XcdBarrier xcd_barrier_post(unsigned* bar, volatile LAS unsigned* st, int wid0) {
    XcdBarrier b; b.bar = bar; b.x = xb_xcc_id(); b.st = st;
    if (wid0 == 0 && lane_id() == 0) (void)xb_add(&bar[XB_XCNT(b.x)], 1u);
    return b;
}
__device__ __forceinline__ void xcd_barrier_complete(unsigned* bar, unsigned x, unsigned& nloc, unsigned& nx) {
    const unsigned G = gridDim.x * gridDim.y * gridDim.z;
    unsigned sum, cnt, mine, sp = 0u;
    for (;;) {
        sum = 0u; cnt = 0u; mine = 0u;
#pragma unroll
        for (unsigned j = 0; j < 16; ++j) { const unsigned c = xb_ld(&bar[XB_XCNT(j)]); sum += c; cnt += (c > 0u) ? 1u : 0u; mine = (j == x) ? c : mine; }
        if (sum == G) break;
        __builtin_amdgcn_s_sleep(1);
        if ((++sp & 255u) == 0u) { if (xb_ld(&bar[XB_TMO])) break; if (sp > XB_SPIN_CAP) { atomicAdd(&bar[XB_TMO], 1u); break; } }
    }
    nloc = mine > 0u ? mine : 1u; nx = cnt > 0u ? cnt : 1u;
}
__device__ __forceinline__ void xcd_barrier(const XcdBarrier& b, int wid0) {
    asm volatile("s_waitcnt vmcnt(0)" ::: "memory");
    __syncthreads();
    if (wid0 == 0 && lane_id() == 0) {
        unsigned zo = 0; asm volatile("" : "+s"(zo));
        unsigned* bar = b.bar + zo;
        __builtin_amdgcn_s_waitcnt(0);
        unsigned nloc = b.st[0], nx = b.st[1];
        if (nloc == 0u) { xcd_barrier_complete(bar, b.x, nloc, nx); b.st[0] = nloc; b.st[1] = nx; }
        const unsigned old = xb_add(&bar[XB_XSUB(b.x)], 1u);
        const unsigned gen = old / nloc;
        if (old + 1u == (gen + 1u) * nloc) {
            __builtin_amdgcn_fence(__ATOMIC_RELEASE, "agent");
            asm volatile("s_waitcnt vmcnt(0)" ::: "memory");
            const unsigned og = xb_add(&bar[XB_TOP], 1u);
            const unsigned tg = og / nx;
            if (og + 1u == (tg + 1u) * nx) xb_add(&bar[XB_TOPGEN], 1u);
            else XB_SPIN(xb_ld(&bar[XB_TOPGEN]) == tg, bar);
            __builtin_amdgcn_fence(__ATOMIC_ACQUIRE, "agent");
            xb_add(&bar[XB_XGEN(b.x)], 1u);
            asm volatile("s_waitcnt vmcnt(0)" ::: "memory");
        } else {
            XB_SPIN(xb_ld(&bar[XB_XGEN(b.x)]) == gen, bar);
            __builtin_amdgcn_fence(__ATOMIC_ACQUIRE, "agent");
            asm volatile("s_waitcnt vmcnt(0)" ::: "memory");
        }
    }
    __syncthreads();
}

constexpr int PH_P0A = 0, PH_P0B = 1, PH_L0 = 2, PH_PER_LAYER = 7, PH_FINAL = PH_L0 + DEPTH * PH_PER_LAYER, PH_END = PH_FINAL + 1;

#ifdef PROBE_SEL
#define MK_STAMP(i) do { if (wid0 == 0 && lane_id() == 0) ((volatile LAS unsigned long long*)(L + LDSCTL_OFF + 1024))[(i)] = __builtin_amdgcn_s_memrealtime(); } while (0)
#else
#define MK_STAMP(i) do {} while (0)
#endif
#define MK_IN_(k) (lo <= (k) && (k) < hi)
#define MK_SEAM(k) do { if (MK_IN_(k) && MK_IN_((k) + 1)) xcd_barrier(bar, wid0); } while (0)
#define MK_PTRS() int zi = 0; asm volatile("" : "+s"(zi)); unsigned char* ws = args.ws + zi; float* out = args.out + zi; (void)out; (void)ws
#define INP(i) ((const float*)args.in[(i) + zi])
template <int l>
__device__ __forceinline__ void layer_phases(const Args& args, LAS unsigned char* L, const XcdBarrier& bar, int wid0, int vcu, int G, int bx, int lo, int hi) {
    constexpr int P = PH_L0 + l * PH_PER_LAYER;
    if (MK_IN_(P + 0)) { MK_STAMP(2 * (P + 0)); MK_PTRS();
        pg8::Gemm g{(bf16_t*)(ws + WS_A), (const bf16_t*)(ws + WS_W + (size_t)l * WL_STRIDE + WL_IN), T, NIN, DM}; pg8::StaticOrder S; S.init(T, NIN, G, bx);
        pg8::EpiIn E{(float*)(ws + WS_SSQ1), (float*)(ws + WS_SHW1) + (size_t)l * NB * NIN, INP(9) + l * QR, INP(10) + l * KVR, (float*)(ws + WS_ROPE), (bf16_t*)(ws + WS_U), (bf16_t*)(ws + WS_VN), (bf16_t*)(ws + WS_CQKV), (bf16_t*)(ws + WS_KR), (float*)(ws + WS_SSQQ)};
        pg8::gemm_phase<pg8::EpiIn, pg8::StaticOrder, true, true>(L, g, S, E, wid0); }
    MK_STAMP(2 * (P + 0) + 1); MK_SEAM(P + 0);
    if (MK_IN_(P + 1)) { MK_STAMP(2 * (P + 1)); MK_PTRS();
        pg8::Gemm g{(bf16_t*)(ws + WS_CQKV), (const bf16_t*)(ws + WS_W + (size_t)l * WL_STRIDE + WL_UP), T, NUP, KUP}; pg8::StaticOrder S; S.init(T, NUP, G, bx);
        pg8::EpiUp E{(float*)(ws + WS_SSQQ), (float*)(ws + WS_ROPE), (bf16_t*)(ws + WS_Q), (bf16_t*)(ws + WS_KN), (bf16_t*)(ws + WS_V)};
        pg8::gemm_phase<pg8::EpiUp, pg8::StaticOrder, true, true>(L, g, S, E, wid0); MK_STAMP(2 * (P + 1) + 1); }
    if (MK_IN_(P + 2)) { MK_STAMP(2 * (P + 2)); MK_PTRS();
        gm::gmlp_phase(L, wid0, vcu, (bf16_t*)(ws + WS_U), (bf16_t*)(ws + WS_VN), (bf16_t*)(ws + WS_GW) + (size_t)l * NGRP * CHUNK * CHUNK, INP(8) + l * NGRP * CHUNK, INP(13) + l * DG, (bf16_t*)(ws + WS_Y), (float*)(ws + WS_SSQY)); }
    MK_STAMP(2 * (P + 2) + 1); MK_SEAM(P + 2);
    if (MK_IN_(P + 3)) { MK_STAMP(2 * (P + 3)); MK_PTRS();
        att::attn_phase((LAS char*)L, wid0, vcu, (bf16_t*)(ws + WS_Q), (bf16_t*)(ws + WS_KN), (bf16_t*)(ws + WS_KR), (bf16_t*)(ws + WS_V), INP(14) + l * DG, (bf16_t*)(ws + WS_Y), (float*)(ws + WS_SSQY)); }
    MK_STAMP(2 * (P + 3) + 1); MK_SEAM(P + 3);
    if (MK_IN_(P + 4)) { MK_STAMP(2 * (P + 4)); MK_PTRS();
        pg8::Gemm g{(bf16_t*)(ws + WS_Y), (const bf16_t*)(ws + WS_W + (size_t)l * WL_STRIDE + WL_OUT), T, DM, DM}; pg8::StaticOrder S; S.init(T, DM, G, bx);
        pg8::EpiRes<true, l == 0> E{(float*)(ws + WS_SSQY), l == 0 ? (const void*)INP(0) : (const void*)out, (bf16_t*)out, (float*)(ws + WS_MOD) + (size_t)l * NB * NMOD + 2 * DM, (float*)(ws + WS_GM2) + (size_t)l * NB * DM, (bf16_t*)(ws + WS_A), (float*)(ws + WS_SSQ2)};
        pg8::gemm_phase<pg8::EpiRes<true, l == 0>, pg8::StaticOrder, true, true>(L, g, S, E, wid0); }
    MK_STAMP(2 * (P + 4) + 1); MK_SEAM(P + 4);
    if (MK_IN_(P + 5)) { MK_STAMP(2 * (P + 5)); MK_PTRS();
        pg8::Gemm g{(bf16_t*)(ws + WS_A), (const bf16_t*)(ws + WS_W + (size_t)l * WL_STRIDE + WL_1), T, DFF, DM}; pg8::StaticOrder S; S.init(T, DFF, G, bx);
        pg8::EpiFf1 E{(float*)(ws + WS_SSQ2), (float*)(ws + WS_SHW2) + (size_t)l * NB * DFF, (bf16_t*)(ws + WS_H)};
        pg8::gemm_phase<pg8::EpiFf1, pg8::StaticOrder, true, true>(L, g, S, E, wid0); }
    MK_STAMP(2 * (P + 5) + 1); MK_SEAM(P + 5);
    if (MK_IN_(P + 6)) { MK_STAMP(2 * (P + 6)); MK_PTRS();
        pg8::Gemm g{(bf16_t*)(ws + WS_H), (const bf16_t*)(ws + WS_W + (size_t)l * WL_STRIDE + WL_2), T, DM, DFF}; pg8::StaticOrder S; S.init(T, DM, G, bx);
        pg8::EpiRes<false, false> E{nullptr, (const void*)out, (bf16_t*)out, (float*)(ws + WS_MOD) + (size_t)l * NB * NMOD + 5 * DM, (l + 1 < DEPTH) ? (float*)(ws + WS_GM1) + (size_t)(l + 1) * NB * DM : nullptr, (bf16_t*)(ws + WS_A), (float*)(ws + WS_SSQ1)};
        pg8::gemm_phase<pg8::EpiRes<false, false>, pg8::StaticOrder, true, true>(L, g, S, E, wid0); }
    MK_STAMP(2 * (P + 6) + 1); MK_SEAM(P + 6);
}
__global__ void __launch_bounds__(NWAVES * 64, 2) mk_fwd(Args args) {
    extern __shared__ __attribute__((aligned(16))) unsigned char lds[];
    LAS unsigned char* L = (LAS unsigned char*)lds;
    volatile LAS unsigned* MISC = (volatile LAS unsigned*)(L + MISC_OFF);
    const int wid0 = __builtin_amdgcn_readfirstlane((int)threadIdx.x >> 6);
    const int G = gridDim.x, bx = blockIdx.x, vcu = (G % 8 == 0) ? (bx % 8) * (G / 8) + bx / 8 : bx;
    { const int t0 = wid0 * 64 + lane_id(); for (int u = t0; u < (LDS_BYTES - LDSCTL_OFF) / 4; u += NWAVES * 64) ((LAS unsigned*)(L + LDSCTL_OFF))[u] = 0u; }
    __syncthreads();
    const int lo = __builtin_amdgcn_readfirstlane(args.ph_lo), hi = __builtin_amdgcn_readfirstlane(args.ph_hi);
    unsigned* barw = (unsigned*)(args.ws + WS_CTL) + CW_BAR + __builtin_amdgcn_readfirstlane(args.li) * XCD_BAR_WORDS;
    XcdBarrier bar; bar.bar = barw; bar.x = 0; bar.st = nullptr;
    if (hi - lo > 1) bar = xcd_barrier_post(barw, MISC + 8, wid0);
    if (MK_IN_(PH_P0A)) { MK_STAMP(2 * (PH_P0A)); MK_PTRS(); pro::phase0a(L, wid0, vcu, G, args, zi, ws); }
    MK_STAMP(2 * PH_P0A + 1); MK_SEAM(PH_P0A);
    if (MK_IN_(PH_P0B)) { MK_STAMP(2 * (PH_P0B)); MK_PTRS(); pro::phase0b(L, wid0, vcu, G, args, zi, ws); }
    MK_STAMP(2 * PH_P0B + 1); MK_SEAM(PH_P0B);
    layer_phases<0>(args, L, bar, wid0, vcu, G, bx, lo, hi);
    layer_phases<1>(args, L, bar, wid0, vcu, G, bx, lo, hi);
    if (MK_IN_(PH_FINAL)) { MK_STAMP(2 * (PH_FINAL)); MK_PTRS(); pro::phase_final(wid0, vcu, G, INP(19), (const bf16_t*)out, out); }
    MK_STAMP(2 * PH_FINAL + 1);
#ifdef PROBE_SEL
    if (bx == 0 && wid0 == 0 && lane_id() == 0) {
        volatile LAS unsigned long long* st = (volatile LAS unsigned long long*)(L + LDSCTL_OFF + 1024); unsigned long long sel = 0;
        if (PROBE_SEL >= 0) sel = st[2 * PROBE_SEL + 1] - st[2 * PROBE_SEL];
        else { for (int k = 0; k < PH_FINAL; ++k) if (k != PH_L0 + 1 && k != PH_L0 + PH_PER_LAYER + 1) { int nx = k + 1; sel += st[2 * nx] - st[2 * k + 1]; } }
        const unsigned long long t0 = __builtin_amdgcn_s_memrealtime(), t1 = t0 + PROBE_MULT * sel;
        while (__builtin_amdgcn_s_memrealtime() < t1) __builtin_amdgcn_s_sleep(8);
    }
#endif
}

#ifndef ONE_LAUNCH
#define ONE_LAUNCH 1
#endif
#ifndef MK_PRO
#define MK_PRO 1
#endif
#ifndef MK_IN
#define MK_IN 1
#endif
#ifndef MK_UP
#define MK_UP 1
#endif
#ifndef MK_GMLP
#define MK_GMLP 1
#endif
#ifndef MK_ATTN
#define MK_ATTN 1
#endif
#ifndef MK_OUT
#define MK_OUT 1
#endif
#ifndef MK_FF1
#define MK_FF1 1
#endif
#ifndef MK_FF2
#define MK_FF2 1
#endif
template <class Epi> static void gemm_naive(hipStream_t st, const bf16_t* A, int lda, const bf16_t* Bt, int ldb, int M, int N, int K, const Epi& e) {
    hipLaunchKernelGGL((k_gemm_naive<Epi>), dim3(N / 64, M / 64), dim3(256), 0, st, A, lda, Bt, ldb, K, e);
}
static int g_grid = 0;
static void launch_mk(hipStream_t st, Args a, int lo, int hi, int li = 0, int flags = 0) {
    a.ph_lo = lo; a.ph_hi = hi; a.li = li; a.flags = flags;
    hipLaunchKernelGGL(mk_fwd, dim3(g_grid), dim3(NWAVES * 64), LDS_BYTES, st, a);
}
extern "C" void kernel_launch(void* const* d_in, const int* in_sizes, int n_in, void* d_out, int out_size, void* d_ws, size_t ws_size, hipStream_t stream) {
    if (n_in != 20 || out_size != T * DM || ws_size < WS_END) { fprintf(stderr, "kernel_launch: unexpected sizes n_in %d out %d ws %zu\n", n_in, out_size, ws_size); return; }
    if (g_grid == 0) {
        int dev = 0, cus = 0; hipGetDevice(&dev); hipDeviceGetAttribute(&cus, hipDeviceAttributeMultiprocessorCount, dev);
        if (hipFuncSetAttribute((const void*)mk_fwd, hipFuncAttributeMaxDynamicSharedMemorySize, LDS_BYTES) != hipSuccess) fprintf(stderr, "kernel_launch: hipFuncSetAttribute failed\n");
        g_grid = cus > 0 ? cus : 256;
    }
    const float* x = (const float*)d_in[0]; const float* c = (const float*)d_in[1]; const int* pos = (const int*)d_in[2];
    const float* w_ada = (const float*)d_in[3]; const float* b_ada = (const float*)d_in[4]; const float* g_mix = (const float*)d_in[5];
    const float* w_in = (const float*)d_in[6]; const float* g_ws = (const float*)d_in[7]; const float* g_bs = (const float*)d_in[8];
    const float* g_q = (const float*)d_in[9]; const float* g_kv = (const float*)d_in[10]; const float* w_uq = (const float*)d_in[11]; const float* w_ukv = (const float*)d_in[12];
    const float* g_og = (const float*)d_in[13]; const float* g_oa = (const float*)d_in[14]; const float* w_out = (const float*)d_in[15];
    const float* g_ffn = (const float*)d_in[16]; const float* w_ff1 = (const float*)d_in[17]; const float* w_ff2 = (const float*)d_in[18]; const float* g_fin = (const float*)d_in[19];
    unsigned char* ws = (unsigned char*)d_ws; float* out = (float*)d_out;
    float* MOD = (float*)(ws + WS_MOD); float* SHW1 = (float*)(ws + WS_SHW1); float* SHW2 = (float*)(ws + WS_SHW2); float* RT = (float*)(ws + WS_ROPE);
    float* GM1 = (float*)(ws + WS_GM1); float* GM2 = (float*)(ws + WS_GM2);
    float* SSQ1 = (float*)(ws + WS_SSQ1); float* SSQ2 = (float*)(ws + WS_SSQ2); float* SSQY = (float*)(ws + WS_SSQY); float* SSQQ = (float*)(ws + WS_SSQQ);
    bf16_t* GW = (bf16_t*)(ws + WS_GW); bf16_t* A = (bf16_t*)(ws + WS_A); bf16_t* U = (bf16_t*)(ws + WS_U); bf16_t* VN = (bf16_t*)(ws + WS_VN);
    bf16_t* CQKV = (bf16_t*)(ws + WS_CQKV); bf16_t* KR = (bf16_t*)(ws + WS_KR); bf16_t* Q = (bf16_t*)(ws + WS_Q); bf16_t* KN = (bf16_t*)(ws + WS_KN); bf16_t* V = (bf16_t*)(ws + WS_V);
    bf16_t* Y = (bf16_t*)(ws + WS_Y); bf16_t* H = (bf16_t*)(ws + WS_H); float* GV = (float*)(ws + WS_GV); float* ZL = (float*)(ws + WS_ZL); float* QRT = (float*)(ws + WS_QRT);
    auto WL = [&](int l, size_t off) { return (bf16_t*)(ws + WS_W + (size_t)l * WL_STRIDE + off); };
    Args a{}; for (int i = 0; i < 20; ++i) a.in[i] = d_in[i]; a.out = out; a.ws = ws;
    hipMemsetAsync(ws + WS_CTL, 0, CTL_ZERO_BYTES, stream);

#if ONE_LAUNCH
#ifdef PROBE_DUP
    launch_mk(stream, a, 0, PROBE_DUP + 1, 0); launch_mk(stream, a, PROBE_DUP, PROBE_DUP + 1, 1); launch_mk(stream, a, PROBE_DUP + 1, PH_END, 2);
#elif defined(PROBE_FFN2)
    launch_mk(stream, a, 0, PH_FINAL, 0); launch_mk(stream, a, PH_FINAL - 1, PH_FINAL, 1, 1); launch_mk(stream, a, PH_FINAL, PH_END, 2);
#elif defined(PROBE_FINAL)
    launch_mk(stream, a, 0, PH_FINAL, 0); launch_mk(stream, a, PH_FINAL, PH_END, 1, 2); launch_mk(stream, a, PH_FINAL, PH_END, 2);
#else
    launch_mk(stream, a, 0, PH_END);
#endif
    return;
#endif
#if MK_PRO
    launch_mk(stream, a, PH_P0A, PH_P0A + 1);
    launch_mk(stream, a, PH_P0B, PH_P0B + 1);
#else
    hipLaunchKernelGGL(k_rope_table, dim3(T * 16 / 256), dim3(256), 0, stream, pos, RT);
    hipLaunchKernelGGL(k_prep_gw, dim3(DEPTH * NGRP * CHUNK * CHUNK / 256), dim3(256), 0, stream, g_ws, GW);
    for (int l = 0; l < DEPTH; ++l) {
        hipLaunchKernelGGL(k_prep_w, dim3((NIN * DM + 255) / 256), dim3(256), 0, stream, w_in + (size_t)l * DM * DIN, DM, DIN, WL(l, WL_IN), NIN, 1);
        hipLaunchKernelGGL(k_prep_wup, dim3((NUP * KUP + 255) / 256), dim3(256), 0, stream, w_uq + (size_t)l * QR * 768, w_ukv + (size_t)l * KVR * 1024, WL(l, WL_UP));
        hipLaunchKernelGGL(k_prep_w, dim3(DM * DM / 256), dim3(256), 0, stream, w_out + (size_t)l * DM * DM, DM, DM, WL(l, WL_OUT), DM, 0);
        hipLaunchKernelGGL(k_prep_w, dim3(DFF * DM / 256), dim3(256), 0, stream, w_ff1 + (size_t)l * DM * DFF, DM, DFF, WL(l, WL_1), DFF, 0);
        hipLaunchKernelGGL(k_prep_w, dim3(DFF * DM / 256), dim3(256), 0, stream, w_ff2 + (size_t)l * DFF * DM, DFF, DM, WL(l, WL_2), DM, 0);
        hipLaunchKernelGGL(k_smallm, dim3(NMOD / 64), dim3(512), 0, stream, c, DM, 1, w_ada + (size_t)l * DM * NMOD, NMOD, NMOD, 0, b_ada + (size_t)l * NMOD, MOD + (size_t)l * NB * NMOD, NMOD, NMOD);
    }
    for (int l = 0; l < DEPTH; ++l) {
        hipLaunchKernelGGL(k_smallm, dim3(NIN / 64), dim3(512), 0, stream, MOD + (size_t)l * NB * NMOD + 0, NMOD, 0, w_in + (size_t)l * DM * DIN, DIN, DIN, 1, (const float*)nullptr, SHW1 + (size_t)l * NB * NIN, NIN, NIN);
        hipLaunchKernelGGL(k_smallm, dim3(DFF / 64), dim3(512), 0, stream, MOD + (size_t)l * NB * NMOD + 3 * DM, NMOD, 0, w_ff1 + (size_t)l * DM * DFF, DFF, DFF, 0, (const float*)nullptr, SHW2 + (size_t)l * NB * DFF, DFF, DFF);
    }
    hipLaunchKernelGGL(k_gm, dim3(DEPTH * NB * DM / 256), dim3(256), 0, stream, g_mix, MOD, 1, GM1);
    hipLaunchKernelGGL(k_gm, dim3(DEPTH * NB * DM / 256), dim3(256), 0, stream, g_ffn, MOD, 4, GM2);
    hipLaunchKernelGGL(k_modx, dim3(T / 4), dim3(256), 0, stream, x, g_mix, MOD + 1 * DM, NMOD, A, SSQ1);

#endif
    for (int l = 0; l < DEPTH; ++l) {
        const float* modl = MOD + (size_t)l * NB * NMOD; const int P = PH_L0 + l * PH_PER_LAYER;
#if MK_IN
        launch_mk(stream, a, P + 0, P + 1);
#else
        { EpiInNaive e{0, SSQ1, SHW1 + (size_t)l * NB * NIN, U, GV, ZL}; gemm_naive(stream, A, DM, WL(l, WL_IN), DM, T, NIN, DM, e); }
        hipLaunchKernelGGL(k_vn, dim3(T * NGRP / 4), dim3(256), 0, stream, GV, VN);
        hipLaunchKernelGGL(k_lat, dim3(T / 4), dim3(256), 0, stream, ZL, g_q + l * QR, g_kv + l * KVR, RT, CQKV, SSQQ, KR);
#endif
#if MK_UP
        launch_mk(stream, a, P + 1, P + 2);
#else
        { EpiUpNaive e{0, SSQQ, Q, QRT, KN, V}; gemm_naive(stream, CQKV, KUP, WL(l, WL_UP), KUP, T, NUP, KUP, e); }
        hipLaunchKernelGGL(k_rope_q, dim3(T * NH * 16 / 256), dim3(256), 0, stream, QRT, RT, Q);
#endif
#if MK_GMLP
        launch_mk(stream, a, P + 2, P + 3);
#else
        hipLaunchKernelGGL(k_gmlp_naive, dim3(T), dim3(512), 0, stream, U, VN, GW + (size_t)l * NGRP * CHUNK * CHUNK, g_bs + l * NGRP * CHUNK, g_og + l * DG, Y, SSQY);
#endif
#if MK_ATTN
        launch_mk(stream, a, P + 3, P + 4);
#else
        hipLaunchKernelGGL(k_attn_naive, dim3(T / 64, NH), dim3(64), 0, stream, Q, KN, KR, V, g_oa + l * DG, Y, SSQY);
#endif
#if MK_OUT
        launch_mk(stream, a, P + 4, P + 5);
#else
        { EpiOutNaive e{512, SSQY, l == 0 ? x : out, out, modl + 2 * DM}; gemm_naive(stream, Y, DM, WL(l, WL_OUT), DM, T, DM, DM, e); }
        hipLaunchKernelGGL(k_modx, dim3(T / 4), dim3(256), 0, stream, out, g_ffn + l * DM, modl + 4 * DM, NMOD, A, SSQ2);
#endif
#if MK_FF1
        launch_mk(stream, a, P + 5, P + 6);
#else
        { EpiFf1Naive e{0, SSQ2, SHW2 + (size_t)l * NB * DFF, H}; gemm_naive(stream, A, DM, WL(l, WL_1), DM, T, DFF, DM, e); }
#endif
#if MK_FF2
        launch_mk(stream, a, P + 6, P + 7);
#else
        { EpiFf2Naive e{0, out, modl + 5 * DM}; gemm_naive(stream, H, DFF, WL(l, WL_2), DFF, T, DM, DFF, e); }
        if (l + 1 < DEPTH) hipLaunchKernelGGL(k_modx, dim3(T / 4), dim3(256), 0, stream, out, g_mix + (l + 1) * DM, MOD + (size_t)(l + 1) * NB * NMOD + 1 * DM, NMOD, A, SSQ1);
#endif
    }
#if MK_PRO
    launch_mk(stream, a, PH_FINAL, PH_FINAL + 1);
#else
    hipLaunchKernelGGL(k_final, dim3(T / 4), dim3(256), 0, stream, out, g_fin, out);
#endif
}
```

```cpp
#include <hip/hip_runtime.h>
#define PROBE_MULT 8
#include <cstdint>
#include <cstdio>
#include <cmath>

typedef unsigned short bf16_t;
typedef short bf16x8 __attribute__((ext_vector_type(8)));
typedef float f32x4 __attribute__((ext_vector_type(4)));

constexpr int DM = 1024, NB = 16, SEQ = 2048, DEPTH = 2, T = NB * SEQ;
constexpr int DG = 512, NGRP = 8, GD = 64, CHUNK = 128, NH = 8, NOPE = 64, ROPE = 32, VD = 64;
constexpr int QR = 256, KVR = 128, DFF = 4096, DIN = 1440, NMOD = 6 * DM;
constexpr int NIN = 1536;
constexpr int NUP = 1792, KUP = 384;
constexpr float EPS = 1e-6f;
constexpr float QSCALE = 0.10206207261596577f * 1.4426950408889634f;

constexpr size_t MiB = 1u << 20;
constexpr size_t WS_CTL = 0;
constexpr size_t WS_MOD = 1 * MiB;
constexpr size_t WS_SHW1 = 2 * MiB;
constexpr size_t WS_GM1 = 2 * MiB + 512 * 1024;
constexpr size_t WS_GM2 = 2 * MiB + 768 * 1024;
constexpr size_t WS_SHW2 = 3 * MiB;
constexpr size_t WS_ROPE = 4 * MiB;
constexpr size_t WS_SSQ1 = 8 * MiB;
constexpr size_t WS_SSQ2 = 10 * MiB;
constexpr size_t WS_SSQY = 12 * MiB;
constexpr size_t WS_SSQQ = 14 * MiB;
constexpr size_t WS_GW = 15 * MiB;
constexpr size_t WS_W = 16 * MiB;
constexpr size_t WL_IN = 0, WL_UP = 3 * MiB, WL_OUT = 4 * MiB + MiB / 2, WL_1 = 6 * MiB + MiB / 2, WL_2 = 14 * MiB + MiB / 2, WL_STRIDE = 22 * MiB + MiB / 2;
constexpr size_t WS_A = 64 * MiB;
constexpr size_t WS_U = 128 * MiB;
constexpr size_t WS_VN = 160 * MiB;
constexpr size_t WS_CQKV = 192 * MiB;
constexpr size_t WS_CQ = 192 * MiB;
constexpr size_t WS_CKV = 208 * MiB;
constexpr size_t WL_UQ = 3 * MiB, WL_UKV = 3 * MiB + MiB / 2;
constexpr size_t WS_KR = 216 * MiB;
constexpr size_t WS_Q = 218 * MiB;
constexpr size_t WS_KN = 266 * MiB;
constexpr size_t WS_V = 298 * MiB;
constexpr size_t WS_Y = 330 * MiB;
constexpr size_t WS_H = 128 * MiB;
constexpr size_t WS_GV = 394 * MiB;
constexpr size_t WS_ZL = 458 * MiB;
constexpr size_t WS_QRT = 394 * MiB;
constexpr size_t WS_DUMMY = 448 * MiB;
constexpr size_t WS_END = 512 * MiB;

__device__ __forceinline__ bf16_t f2bf(float f) { unsigned u = __float_as_uint(f); return (bf16_t)((u + 0x7fffu + ((u >> 16) & 1u)) >> 16); }
__device__ __forceinline__ float bf2f(bf16_t h) { return __uint_as_float(((unsigned)h) << 16); }
__device__ __forceinline__ float gelu_tanh(float x) { const float y2 = -2.302208198f * (x + 0.044715f * x * x * x); return x * __builtin_amdgcn_rcpf(1.f + __builtin_amdgcn_exp2f(y2)); }
__device__ __forceinline__ float wave_sum(float v) {
#pragma unroll
    for (int o = 1; o < 64; o <<= 1) v += __shfl_xor(v, o);
    return v;
}
__host__ __device__ __forceinline__ int win_src(int p) {
    if (p < 512) return p;
    if (p < 1024) { const int q = p - 512, tile = q >> 8, r = q & 255, bj = r >> 7, wc = (r >> 5) & 3, j = r & 31; return 512 + tile * 256 + 64 * wc + 32 * bj + j; }
    if (p < 1408) return p;
    if (p < 1440) { const int j = p - 1408, fq = j >> 3, n = (j >> 2) & 1, i = j & 3; return 1408 + 16 * n + 4 * fq + i; }
    return -1;
}
__host__ __device__ __forceinline__ int wup_qcol(int p) {
    const int G = p >> 5, h = G / 3, gi = G - 3 * h, j = p & 31;
    if (gi < 2) return p;
    const int fq = j >> 3, n = (j >> 2) & 1, i = j & 3; return h * 96 + 64 + 16 * n + 4 * fq + i;
}

__global__ void k_rope_table(const int* pos, float* rope) {
    const int idx = blockIdx.x * blockDim.x + threadIdx.x; if (idx >= T * 16) return;
    const int t = idx >> 4, i = idx & 15;
    const float freq = powf(10000.0f, -(float)(2 * i) / 32.0f);
    const float ang = (float)pos[t] * freq;
    rope[t * 32 + i] = cosf(ang); rope[t * 32 + 16 + i] = sinf(ang);
}
__global__ void k_prep_w(const float* W, int K, int N, bf16_t* out, int Nphys, int mode) {
    const size_t idx = (size_t)blockIdx.x * blockDim.x + threadIdx.x; if (idx >= (size_t)Nphys * K) return;
    const int p = (int)(idx / K), k = (int)(idx % K);
    const int s = mode == 1 ? win_src(p) : p;
    out[idx] = (s >= 0 && s < N) ? f2bf(W[(size_t)k * N + s]) : (bf16_t)0;
}
__global__ void k_prep_wup(const float* wuq, const float* wukv, bf16_t* out) {
    const int idx = blockIdx.x * blockDim.x + threadIdx.x; if (idx >= NUP * KUP) return;
    const int p = idx / KUP, k = idx % KUP; float v = 0.f;
    if (p < 768) { if (k < 256) v = wuq[(size_t)k * 768 + wup_qcol(p)]; }
    else { if (k >= 256) v = wukv[(size_t)(k - 256) * 1024 + (p - 768)]; }
    out[idx] = f2bf(v);
}
__global__ void k_prep_gw(const float* ws, bf16_t* gw) {
    const int idx = blockIdx.x * blockDim.x + threadIdx.x; if (idx >= DEPTH * NGRP * CHUNK * CHUNK) return;
    const int s = idx & 127, t = (idx >> 7) & 127;
    gw[idx] = (s <= t) ? f2bf(ws[idx]) : (bf16_t)0;
}
__global__ __launch_bounds__(512) void k_smallm(const float* in, int in_stride, int act, const float* W, int ldw, int N, int mode, const float* bias, float* out, int out_stride, int Nphys) {
    __shared__ float sin_[1024 * 16];
    __shared__ float red[8 * 64 * 16];
    const int tid = threadIdx.x, lane = tid & 63, wave = tid >> 6;
    for (int e = tid; e < 16 * 1024; e += 512) { const int b = e >> 10, k = e & 1023; float v = in[(size_t)b * in_stride + k]; if (act) v = v / (1.f + __expf(-v)); sin_[k * 16 + b] = v; }
    __syncthreads();
    const int p = blockIdx.x * 64 + lane; const int s = (p < Nphys) ? (mode == 1 ? win_src(p) : p) : -1; const bool ok = (s >= 0 && s < N);
    float acc[16];
#pragma unroll
    for (int b = 0; b < 16; ++b) acc[b] = 0.f;
    for (int k = wave * 128; k < wave * 128 + 128; ++k) {
        const float w = ok ? W[(size_t)k * ldw + s] : 0.f;
        const f32x4* sp = (const f32x4*)(sin_ + k * 16);
#pragma unroll
        for (int q = 0; q < 4; ++q) { const f32x4 v = sp[q]; acc[4 * q] += v[0] * w; acc[4 * q + 1] += v[1] * w; acc[4 * q + 2] += v[2] * w; acc[4 * q + 3] += v[3] * w; }
    }
#pragma unroll
    for (int b = 0; b < 16; ++b) red[(wave * 64 + lane) * 16 + b] = acc[b];
    __syncthreads();
    for (int e = tid; e < 64 * 16; e += 512) { const int l = e >> 4, b = e & 15; float sum = 0.f;
#pragma unroll
        for (int w = 0; w < 8; ++w) sum += red[(w * 64 + l) * 16 + b];
        const int pp = blockIdx.x * 64 + l; if (pp < Nphys) out[(size_t)b * out_stride + pp] = sum + (bias ? bias[pp] : 0.f); }
}
__global__ __launch_bounds__(256) void k_modx(const float* x, const float* g, const float* sc  , int sc_stride, bf16_t* A, float* ssq) {
    const int row = blockIdx.x * 4 + (threadIdx.x >> 6), lane = threadIdx.x & 63; if (row >= T) return;
    const int b = row / SEQ; const f32x4* xr = (const f32x4*)(x + (size_t)row * DM); float s = 0.f;
#pragma unroll
    for (int j = 0; j < 4; ++j) { const f32x4 v = xr[lane + 64 * j]; s += v[0] * v[0] + v[1] * v[1] + v[2] * v[2] + v[3] * v[3];
        const int c = 4 * (lane + 64 * j); const f32x4 gv = *(const f32x4*)(g + c), sv = *(const f32x4*)(sc + (size_t)b * sc_stride + c);
        unsigned lo = f2bf(v[0] * gv[0] * (1.f + sv[0])) | ((unsigned)f2bf(v[1] * gv[1] * (1.f + sv[1])) << 16);
        unsigned hi = f2bf(v[2] * gv[2] * (1.f + sv[2])) | ((unsigned)f2bf(v[3] * gv[3] * (1.f + sv[3])) << 16);
        *(uint2*)(A + (size_t)row * DM + c) = make_uint2(lo, hi); }
    s = wave_sum(s);
    if (lane < 16) ssq[(size_t)row * 16 + lane] = (lane == 0) ? s : 0.f;
}
__global__ __launch_bounds__(256) void k_final(const float* x, const float* g, float* out) {
    const int row = blockIdx.x * 4 + (threadIdx.x >> 6), lane = threadIdx.x & 63; if (row >= T) return;
    const f32x4* xr = (const f32x4*)(x + (size_t)row * DM); f32x4 v[4]; float s = 0.f;
#pragma unroll
    for (int j = 0; j < 4; ++j) { v[j] = xr[lane + 64 * j]; s += v[j][0] * v[j][0] + v[j][1] * v[j][1] + v[j][2] * v[j][2] + v[j][3] * v[j][3]; }
    const float rstd = rsqrtf(wave_sum(s) * (1.f / DM) + EPS);
#pragma unroll
    for (int j = 0; j < 4; ++j) { const int c = 4 * (lane + 64 * j); const f32x4 gv = *(const f32x4*)(g + c); *(f32x4*)(out + (size_t)row * DM + c) = v[j] * rstd * gv; }
}

template <class Epi>
__global__ __launch_bounds__(256) void k_gemm_naive(const bf16_t* A, int lda, const bf16_t* Bt, int ldb, int K, Epi epi) {
    const int wave = threadIdx.x >> 6, lane = threadIdx.x & 63, fr = lane & 15, fq = lane >> 4;
    const int row0 = blockIdx.y * 64 + wave * 16, col0 = blockIdx.x * 64;
    f32x4 acc[4];
#pragma unroll
    for (int n = 0; n < 4; ++n) acc[n] = (f32x4){0.f, 0.f, 0.f, 0.f};
    const bf16_t* ap = A + (size_t)(row0 + fr) * lda + 8 * fq;
    const bf16_t* bp = Bt + (size_t)(col0 + fr) * ldb + 8 * fq;
    for (int k0 = 0; k0 < K; k0 += 32) {
        if (Epi::HAS_MID) { if (k0 == epi.ksplit) {
#pragma unroll
            for (int r = 0; r < 4; ++r) { const float m = epi.mid(row0 + 4 * fq + r);
#pragma unroll
                for (int n = 0; n < 4; ++n) acc[n][r] *= m; } } }
        const bf16x8 a = *(const bf16x8*)(ap + k0);
#pragma unroll
        for (int n = 0; n < 4; ++n) { const bf16x8 b = *(const bf16x8*)(bp + (size_t)n * 16 * ldb + k0); acc[n] = __builtin_amdgcn_mfma_f32_16x16x32_bf16(a, b, acc[n], 0, 0, 0); }
    }
#pragma unroll
    for (int r = 0; r < 4; ++r) { const int row = row0 + 4 * fq + r; const float rs = epi.rowscale(row);
#pragma unroll
        for (int n = 0; n < 4; ++n) epi(row, col0 + 16 * n + fr, acc[n][r], rs); }
}
__device__ __forceinline__ float sum16(const float* p) { float s = 0.f;
#pragma unroll
    for (int i = 0; i < 16; ++i) s += p[i]; return s; }
__device__ __forceinline__ float sum8(const float* p) { float s = 0.f;
#pragma unroll
    for (int i = 0; i < 8; ++i) s += p[i]; return s; }
__device__ __forceinline__ float sum4(const float* p) { return (p[0] + p[1]) + (p[2] + p[3]); }

struct EpiInNaive {
    static constexpr bool HAS_MID = false; int ksplit;
    const float* ssq1; const float* shw1; bf16_t* U; float* GV; float* ZL;
    __device__ float mid(int) const { return 1.f; }
    __device__ float rowscale(int row) const { return rsqrtf(sum16(ssq1 + (size_t)row * 16) * (1.f / DM) + EPS); }
    __device__ void operator()(int row, int p, float acc, float rs) const {
        const int L = win_src(p); if (L < 0) return;
        const float z = rs * acc + shw1[(row / SEQ) * NIN + p];
        if (L < 512) U[(size_t)row * 512 + L] = f2bf(gelu_tanh(z));
        else if (L < 1024) GV[(size_t)row * 512 + (L - 512)] = gelu_tanh(z);
        else ZL[(size_t)row * 416 + (L - 1024)] = z;
    }
};
struct EpiUpNaive {
    static constexpr bool HAS_MID = false; int ksplit;
    const float* ssqq; bf16_t* Q; float* QRT; bf16_t* KN; bf16_t* V;
    __device__ float mid(int) const { return 1.f; }
    __device__ float rowscale(int) const { return 1.f; }
    __device__ void operator()(int row, int p, float acc, float) const {
        if (p < 768) { const float rq = rsqrtf(sum4(ssqq + (size_t)row * 8) * (1.f / QR) + EPS); const float v = acc * rq * QSCALE;
            const int L = wup_qcol(p), h = L / 96, d = L - 96 * h;
            if (d < 64) Q[(size_t)row * 768 + L] = f2bf(v); else QRT[(size_t)row * 256 + h * 32 + (d - 64)] = v; }
        else { const float rk = rsqrtf(sum4(ssqq + (size_t)row * 8 + 4) * (1.f / KVR) + EPS); const float v = acc * rk;
            const int c = p - 768, h = c >> 7, d = c & 127;
            if (d < 64) KN[(size_t)row * 512 + h * 64 + d] = f2bf(v); else V[(size_t)row * 512 + h * 64 + (d - 64)] = f2bf(v); }
    }
};
struct EpiOutNaive {
    static constexpr bool HAS_MID = true; int ksplit;
    const float* ssqy; const float* xin; float* xout; const float* gate;
    __device__ float rg(int row) const { return rsqrtf(sum8(ssqy + (size_t)row * 16) * (1.f / 512) + EPS); }
    __device__ float ra(int row) const { return rsqrtf(sum8(ssqy + (size_t)row * 16 + 8) * (1.f / 512) + EPS); }
    __device__ float mid(int row) const { return rg(row) / ra(row); }
    __device__ float rowscale(int row) const { return ra(row); }
    __device__ void operator()(int row, int n, float acc, float rs) const {
        const size_t i = (size_t)row * DM + n; xout[i] = xin[i] + gate[(size_t)(row / SEQ) * NMOD + n] * (rs * acc);
    }
};
struct EpiFf1Naive {
    static constexpr bool HAS_MID = false; int ksplit;
    const float* ssq2; const float* shw2; bf16_t* H;
    __device__ float mid(int) const { return 1.f; }
    __device__ float rowscale(int row) const { return rsqrtf(sum16(ssq2 + (size_t)row * 16) * (1.f / DM) + EPS); }
    __device__ void operator()(int row, int n, float acc, float rs) const {
        const float z = rs * acc + shw2[(row / SEQ) * DFF + n]; const float r = fmaxf(z, 0.f); H[(size_t)row * DFF + n] = f2bf(r * r);
    }
};
struct EpiFf2Naive {
    static constexpr bool HAS_MID = false; int ksplit;
    float* x; const float* gate;
    __device__ float mid(int) const { return 1.f; }
    __device__ float rowscale(int) const { return 1.f; }
    __device__ void operator()(int row, int n, float acc, float) const {
        const size_t i = (size_t)row * DM + n; x[i] = x[i] + gate[(size_t)(row / SEQ) * NMOD + n] * acc;
    }
};

__global__ __launch_bounds__(256) void k_vn(const float* GV, bf16_t* VN) {
    const int w = blockIdx.x * 4 + (threadIdx.x >> 6), lane = threadIdx.x & 63; if (w >= T * NGRP) return;
    const int row = w >> 3, g = w & 7; const float v = GV[(size_t)row * 512 + g * 64 + lane];
    const float mu = wave_sum(v) * (1.f / 64); const float d = v - mu; const float var = wave_sum(d * d) * (1.f / 64);
    VN[(size_t)row * 512 + g * 64 + lane] = f2bf(d * rsqrtf(var + EPS));
}
__global__ __launch_bounds__(256) void k_lat(const float* ZL, const float* gq, const float* gkv, const float* rope, bf16_t* CQKV, float* ssqq, bf16_t* KR) {
    const int row = blockIdx.x * 4 + (threadIdx.x >> 6), lane = threadIdx.x & 63; if (row >= T) return;
    const float* z = ZL + (size_t)row * 416; float sq = 0.f, sk = 0.f;
#pragma unroll
    for (int j = 0; j < 4; ++j) { const int c = lane + 64 * j; const float v = z[c]; sq += v * v; CQKV[(size_t)row * KUP + c] = f2bf(v * gq[c]); }
#pragma unroll
    for (int j = 0; j < 2; ++j) { const int c = lane + 64 * j; const float v = z[256 + c]; sk += v * v; CQKV[(size_t)row * KUP + 256 + c] = f2bf(v * gkv[c]); }
    sq = wave_sum(sq); sk = wave_sum(sk);
    if (lane < 8) ssqq[(size_t)row * 8 + lane] = (lane == 0) ? sq : (lane == 4) ? sk : 0.f;
    if (lane < 16) { const float x1 = z[384 + lane], x2 = z[384 + 16 + lane], c = rope[(size_t)row * 32 + lane], s = rope[(size_t)row * 32 + 16 + lane];
        KR[(size_t)row * 32 + lane] = f2bf(x1 * c - x2 * s); KR[(size_t)row * 32 + 16 + lane] = f2bf(x1 * s + x2 * c); }
}
__global__ void k_rope_q(const float* QRT, const float* rope, bf16_t* Q) {
    const int idx = blockIdx.x * blockDim.x + threadIdx.x; if (idx >= T * NH * 16) return;
    const int r = idx & 15, h = (idx >> 4) & 7, row = idx >> 7;
    const float x1 = QRT[(size_t)row * 256 + h * 32 + r], x2 = QRT[(size_t)row * 256 + h * 32 + 16 + r], c = rope[(size_t)row * 32 + r], s = rope[(size_t)row * 32 + 16 + r];
    Q[(size_t)row * 768 + h * 96 + 64 + r] = f2bf(x1 * c - x2 * s); Q[(size_t)row * 768 + h * 96 + 80 + r] = f2bf(x1 * s + x2 * c);
}
__global__ __launch_bounds__(512) void k_gmlp_naive(const bf16_t* U, const bf16_t* VN, const bf16_t* GW  , const float* bs  , const float* gog, bf16_t* Y, float* ssqy) {
    const int row = blockIdx.x, g = threadIdx.x >> 6, d = threadIdx.x & 63, c = g * 64 + d;
    const int tt = row & 127, t0 = row - tt;
    const bf16_t* w = GW + ((size_t)g * CHUNK + tt) * CHUNK; float sum = 0.f;
    for (int s = 0; s <= tt; ++s) sum += bf2f(w[s]) * bf2f(VN[(size_t)(t0 + s) * 512 + c]);
    const float y = bf2f(U[(size_t)row * 512 + c]) * (sum + bs[g * CHUNK + tt]);
    Y[(size_t)row * DM + c] = f2bf(y * gog[c]);
    const float q = wave_sum(y * y); if (d == 0) ssqy[(size_t)row * 16 + g] = q;
}
__global__ __launch_bounds__(64) void k_attn_naive(const bf16_t* Q, const bf16_t* KN, const bf16_t* KR, const bf16_t* V, const float* goa, bf16_t* Y, float* ssqy) {
    const int h = blockIdx.y, row = blockIdx.x * 64 + threadIdx.x, b = row / SEQ, i = row - b * SEQ;
    const int iend = (blockIdx.x * 64 % SEQ) + 63;
    float q[96];
#pragma unroll
    for (int d8 = 0; d8 < 12; ++d8) { const bf16x8 v = *(const bf16x8*)(Q + (size_t)row * 768 + h * 96 + d8 * 8);
#pragma unroll
        for (int j = 0; j < 8; ++j) q[d8 * 8 + j] = bf2f((bf16_t)v[j]); }
    float o[64];
#pragma unroll
    for (int d = 0; d < 64; ++d) o[d] = 0.f;
    float m = -1e30f, l = 0.f;
    const size_t kb = (size_t)b * SEQ;
    for (int j = 0; j <= iend; ++j) {
        const bf16_t* kn = KN + (kb + j) * 512 + h * 64; const bf16_t* kr = KR + (kb + j) * 32; const bf16_t* vv = V + (kb + j) * 512 + h * 64;
        float s = 0.f;
#pragma unroll
        for (int d8 = 0; d8 < 8; ++d8) { const bf16x8 kv = *(const bf16x8*)(kn + d8 * 8);
#pragma unroll
            for (int jj = 0; jj < 8; ++jj) s += q[d8 * 8 + jj] * bf2f((bf16_t)kv[jj]); }
#pragma unroll
        for (int d8 = 0; d8 < 4; ++d8) { const bf16x8 kv = *(const bf16x8*)(kr + d8 * 8);
#pragma unroll
            for (int jj = 0; jj < 8; ++jj) s += q[64 + d8 * 8 + jj] * bf2f((bf16_t)kv[jj]); }
        if (j > i) s = -1e30f;
        const float mn = fmaxf(m, s), alpha = exp2f(m - mn), p = (j > i) ? 0.f : exp2f(s - mn);
        l = l * alpha + p; m = mn;
#pragma unroll
        for (int d8 = 0; d8 < 8; ++d8) { const bf16x8 v8 = *(const bf16x8*)(vv + d8 * 8);
#pragma unroll
            for (int jj = 0; jj < 8; ++jj) o[d8 * 8 + jj] = o[d8 * 8 + jj] * alpha + p * bf2f((bf16_t)v8[jj]); }
    }
    const float inv = 1.f / l; float sq = 0.f;
#pragma unroll
    for (int d8 = 0; d8 < 8; ++d8) { unsigned w[4];
#pragma unroll
        for (int jj = 0; jj < 8; jj += 2) { const float y0 = o[d8 * 8 + jj] * inv, y1 = o[d8 * 8 + jj + 1] * inv; sq += y0 * y0 + y1 * y1;
            w[jj >> 1] = f2bf(y0 * goa[h * 64 + d8 * 8 + jj]) | ((unsigned)f2bf(y1 * goa[h * 64 + d8 * 8 + jj + 1]) << 16); }
        *(uint4*)(Y + (size_t)row * DM + 512 + h * 64 + d8 * 8) = make_uint4(w[0], w[1], w[2], w[3]); }
    ssqy[(size_t)row * 16 + 8 + h] = sq;
}

__global__ void k_gm(const float* g  , const float* mod, int chunk, float* gmt) {
    const int idx = blockIdx.x * blockDim.x + threadIdx.x; if (idx >= DEPTH * NB * DM) return;
    const int c = idx & 1023, b = (idx >> 10) & 15, l = idx >> 14;
    gmt[idx] = g[l * DM + c] * (1.f + mod[((size_t)l * NB + b) * NMOD + chunk * DM + c]);
}
__device__ __forceinline__ int lane_id() { int l; asm volatile("v_mbcnt_lo_u32_b32 %0, -1, 0\n\tv_mbcnt_hi_u32_b32 %0, -1, %0" : "=v"(l)); return l; }
__device__ __forceinline__ float swz_xor16(float v) { return __int_as_float(__builtin_amdgcn_ds_swizzle(__float_as_int(v), 0x401F)); }
__device__ __forceinline__ float swz_xor1(float v) { return __int_as_float(__builtin_amdgcn_ds_swizzle(__float_as_int(v), 0x041F)); }
namespace pg8 {
#define PG8_LAS __attribute__((address_space(3)))
typedef unsigned u32x4 __attribute__((ext_vector_type(4)));
typedef unsigned u32x2 __attribute__((ext_vector_type(2)));
constexpr int BM = 256, BK = 64, HALF = 128, HTB = HALF * BK * 2  , STAGE_BYTES = 8 * HTB, NXCD = 8, WGM = 8;

__host__ __device__ __forceinline__ int lds_byte(int r, int c) { const int st = (r >> 4) * 2 + (c >> 5), rr = r & 15, cc = c & 31, ob = rr * 64 + cc * 2; return st * 1024 + (ob ^ (((ob >> 9) & 1) << 5)); }
__host__ __device__ __forceinline__ void stage_rc(int b, int& R, int& C) { const int st = b / 1024, sb = b % 1024, swz = sb ^ (((sb >> 9) & 1) << 5); R = (st >> 1) * 16 + swz / 64; C = (st & 1) * 32 + (swz % 64) / 2; }
__host__ __device__ __forceinline__ int perm32(int rho) { const int n = rho >> 4, i = rho & 15; return 8 * (i >> 2) + 4 * n + (i & 3); }

struct Unit { int pm, pn; };
struct Gemm { const bf16_t* A; const bf16_t* Bt; int M, N, K; };

struct StaticOrder {
    int nM, nN, nwg, G, c;
    __host__ __device__ void init(int M, int N, int G_, int c_) { nM = M / BM; nN = N / BM; nwg = nM * nN; G = G_; c = c_; }
    __host__ __device__ bool next(int i, Unit& u) const {
        const long L = (long)i * G + c; if (L >= nwg) return false;
        int wgid = (int)L; { const int q = nwg / NXCD, r = nwg % NXCD, xcd = wgid % NXCD, off = wgid / NXCD; wgid = (xcd < r ? xcd * (q + 1) : r * (q + 1) + (xcd - r) * q) + off; }
        const int nig = WGM * nN, gid = wgid / nig, fm = gid * WGM, gsz = (nM - fm) < WGM ? (nM - fm) : WGM;
        u.pm = fm + ((wgid % nig) % gsz); u.pn = (wgid % nig) / gsz; return true;
    }
    __device__ __forceinline__ void a_ready(const Unit&) const {}
    __device__ __forceinline__ void done(const Unit&) const {}
};

struct KvOrder : StaticOrder {
    __host__ __device__ bool next(int i, Unit& u) const {
        if (G != 256 || nwg != 512) return StaticOrder::next(i, u);
        StaticOrder t = *this; t.G = 1 << 30;
        if (c < 128) { if (i > 0) return false; t.c = c; } else { if (i > 2) return false; t.c = (i == 0) ? c : 256 + 2 * (c - 128) + (i - 1); }
        return t.next(0, u);
    }
};
__device__ __forceinline__ unsigned cvt_pk_bf16(float lo, float hi) { unsigned r; asm volatile("v_cvt_pk_bf16_f32 %0, %1, %2" : "=v"(r) : "v"(lo), "v"(hi)); return r; }
__device__ __forceinline__ u32x4 pack8(const f32x4& a, const f32x4& b) { u32x4 w; w.x = cvt_pk_bf16(a[0], a[1]); w.y = cvt_pk_bf16(a[2], a[3]); w.z = cvt_pk_bf16(b[0], b[1]); w.w = cvt_pk_bf16(b[2], b[3]); return w; }
__device__ __forceinline__ u32x2 pack4(const f32x4& a) { u32x2 w; w.x = cvt_pk_bf16(a[0], a[1]); w.y = cvt_pk_bf16(a[2], a[3]); return w; }
__device__ __forceinline__ float hsum4(const f32x4& a) { return (a[0] + a[1]) + (a[2] + a[3]); }
__device__ __forceinline__ float hsq4(const f32x4& a) { return (a[0] * a[0] + a[1] * a[1]) + (a[2] * a[2] + a[3] * a[3]); }
__device__ __forceinline__ float ld_sum16(const float* p) { const f32x4* q = (const f32x4*)p; return (hsum4(q[0]) + hsum4(q[1])) + (hsum4(q[2]) + hsum4(q[3])); }
__device__ __forceinline__ float ld_sum8(const float* p) { const f32x4* q = (const f32x4*)p; return hsum4(q[0]) + hsum4(q[1]); }
__device__ __forceinline__ float ld_sum4(const float* p) { return hsum4(*(const f32x4*)p); }
__device__ __forceinline__ float quad_sum(float s) { s += swz_xor16(s); auto rr = __builtin_amdgcn_permlane32_swap(__float_as_uint(s), __float_as_uint(s), false, false); return __uint_as_float(rr[0]) + __uint_as_float(rr[1]); }
__device__ __forceinline__ float row_sum16(const float* ssq, int row, int fq) { return quad_sum(hsum4(*(const f32x4*)(ssq + (size_t)row * 16 + 4 * fq))); }
__device__ __forceinline__ void row_sum8x2(const float* ssq, int row, int fq, float& sg, float& sa) {
    float s = hsum4(*(const f32x4*)(ssq + (size_t)row * 16 + 4 * fq)); s += swz_xor16(s);
    auto rr = __builtin_amdgcn_permlane32_swap(__float_as_uint(s), __float_as_uint(s), false, false); sg = __uint_as_float(rr[0]); sa = __uint_as_float(rr[1]); }
#define PG8_FENCE() asm volatile("" ::: "memory")
#define PG8_RSTD8(rsv, ssqp, invn) do { f32x4 q_[2][4]; \
    _Pragma("unroll") for (int ai = 0; ai < 2; ++ai) _Pragma("unroll") for (int m = 0; m < 4; ++m) q_[ai][m] = *(const f32x4*)((ssqp) + (size_t)PG8_ROW(u, ai, m) * 16 + 4 * fq); \
    _Pragma("unroll") for (int ai = 0; ai < 2; ++ai) _Pragma("unroll") for (int m = 0; m < 4; ++m) rsv[ai][m] = rsqrtf(quad_sum(hsum4(q_[ai][m])) * (invn) + EPS); \
    PG8_FENCE(); } while (0)
__device__ __forceinline__ f32x4 gelu4(const f32x4& v) { f32x4 o; o[0] = gelu_tanh(v[0]); o[1] = gelu_tanh(v[1]); o[2] = gelu_tanh(v[2]); o[3] = gelu_tanh(v[3]); return o; }

#define PG8_ROW(u, ai, m) ((u).pm * BM + (ai) * HALF + wr * 64 + (m) * 16 + fr)

template <class V, class P> __device__ __forceinline__ V ldb(const P* p, unsigned boff) { return *(const V*)((const char*)p + boff); }
template <class V, class P> __device__ __forceinline__ void stb(P* p, unsigned boff, const V& v) { *(V*)((char*)p + boff) = v; }
#undef PG8_RSTD8
#define PG8_RSTD8(rsv, ssqp, invn) do { f32x4 q_[2][4]; \
    _Pragma("unroll") for (int ai = 0; ai < 2; ++ai) _Pragma("unroll") for (int m = 0; m < 4; ++m) q_[ai][m] = ldb<f32x4>((ssqp), (unsigned)(PG8_ROW(u, ai, m) * 64 + 16 * fq)); \
    _Pragma("unroll") for (int ai = 0; ai < 2; ++ai) _Pragma("unroll") for (int m = 0; m < 4; ++m) rsv[ai][m] = rsqrtf(quad_sum(hsum4(q_[ai][m])) * (invn) + EPS); \
    PG8_FENCE(); } while (0)

struct EpiIn {
    static constexpr bool PERM = true, AFTER_DRAIN = false, HAS_MID = false; static constexpr int MID_T = -1;
    const float* ssq1; const float* shw1; const float* gq; const float* gkv; const float* rope;
    bf16_t* U; bf16_t* VN; bf16_t* CQ; bf16_t* CKV; bf16_t* KR; float* ssqq;
    __device__ __forceinline__ void mid(f32x4 (&)[2][2][4][2], const Unit&, int, int) const {}
    __device__ __forceinline__ void operator()(const f32x4 (&acc)[2][2][4][2], const Unit& u, int wr, int wc, int fr, int fq) const {
        { const int l_ = lane_id(); fr = l_ & 15; fq = l_ >> 4; }
        const int b = u.pm >> 3, pc0 = u.pn * BM + wc * 32 + 8 * fq;
        f32x4 sh[2][2];
#pragma unroll
        for (int bj = 0; bj < 2; ++bj)
#pragma unroll
            for (int n = 0; n < 2; ++n) sh[bj][n] = ldb<f32x4>(shw1, (unsigned)((b * NIN + pc0 + bj * HALF + 4 * n) * 4));
        float rsv[2][4]; PG8_RSTD8(rsv, ssq1, 1.f / DM);
        if (u.pn < 2) {
#pragma unroll
            for (int ai = 0; ai < 2; ++ai)
#pragma unroll
                for (int m = 0; m < 4; ++m) { const int row = PG8_ROW(u, ai, m); const float rs = rsv[ai][m];
#pragma unroll
                    for (int bj = 0; bj < 2; ++bj) { const f32x4 v0 = gelu4(acc[ai][bj][m][0] * rs + sh[bj][0]), v1 = gelu4(acc[ai][bj][m][1] * rs + sh[bj][1]);
                        stb(U, (unsigned)((row * 512 + pc0 + bj * HALF) * 2), pack8(v0, v1)); } }
        } else if (u.pn < 4) {
#pragma unroll
            for (int ai = 0; ai < 2; ++ai)
#pragma unroll
                for (int m = 0; m < 4; ++m) { const int row = PG8_ROW(u, ai, m); const float rs = rsv[ai][m];
                    f32x4 g[2][2]; float s = 0.f;
#pragma unroll
                    for (int bj = 0; bj < 2; ++bj)
#pragma unroll
                        for (int n = 0; n < 2; ++n) { g[bj][n] = gelu4(acc[ai][bj][m][n] * rs + sh[bj][n]); s += hsum4(g[bj][n]); }
                    const float mu = quad_sum(s) * (1.f / 64); float q = 0.f;
#pragma unroll
                    for (int bj = 0; bj < 2; ++bj)
#pragma unroll
                        for (int n = 0; n < 2; ++n) { g[bj][n] = g[bj][n] - mu; q += hsq4(g[bj][n]); }
                    const float rstd = rsqrtf(quad_sum(q) * (1.f / 64) + EPS);
#pragma unroll
                    for (int bj = 0; bj < 2; ++bj) stb(VN, (unsigned)((row * 512 + (u.pn - 2) * 256 + 64 * wc + 32 * bj + 8 * fq) * 2), pack8(g[bj][0] * rstd, g[bj][1] * rstd)); }
        } else if (u.pn == 4) {
            f32x4 gv[2][2];
#pragma unroll
            for (int bj = 0; bj < 2; ++bj)
#pragma unroll
                for (int n = 0; n < 2; ++n) gv[bj][n] = ldb<f32x4>(gq, (unsigned)((bj * HALF + wc * 32 + 8 * fq + 4 * n) * 4));
#pragma unroll
            for (int ai = 0; ai < 2; ++ai)
#pragma unroll
                for (int m = 0; m < 4; ++m) { const int row = PG8_ROW(u, ai, m); const float rs = rsv[ai][m];
                    float ss = 0.f;
#pragma unroll
                    for (int bj = 0; bj < 2; ++bj) { const f32x4 v0 = acc[ai][bj][m][0] * rs + sh[bj][0], v1 = acc[ai][bj][m][1] * rs + sh[bj][1]; ss += hsq4(v0) + hsq4(v1);
                        stb(CQ, (unsigned)((row * QR + bj * HALF + wc * 32 + 8 * fq) * 2), pack8(v0 * gv[bj][0], v1 * gv[bj][1])); }
                    ss = quad_sum(ss); if (fq == 0) stb(ssqq, (unsigned)((row * 8 + wc) * 4), ss); }
        } else {
            const f32x4 gk0 = ldb<f32x4>(gkv, (unsigned)((wc * 32 + 8 * fq) * 4)), gk1 = ldb<f32x4>(gkv, (unsigned)((wc * 32 + 8 * fq + 4) * 4));
#pragma unroll
            for (int ai = 0; ai < 2; ++ai)
#pragma unroll
                for (int m = 0; m < 4; ++m) { const int row = PG8_ROW(u, ai, m); const float rs = rsv[ai][m];
                    const f32x4 v0 = acc[ai][0][m][0] * rs + sh[0][0], v1 = acc[ai][0][m][1] * rs + sh[0][1];
                    float ss = quad_sum(hsq4(v0) + hsq4(v1)); if (fq == 0) stb(ssqq, (unsigned)((row * 8 + 4 + wc) * 4), ss);
                    stb(CKV, (unsigned)((row * KVR + wc * 32 + 8 * fq) * 2), pack8(v0 * gk0, v1 * gk1));
                    if (wc == 0) { const f32x4 x1 = acc[ai][1][m][0] * rs + sh[1][0], x2 = acc[ai][1][m][1] * rs + sh[1][1];
                        const f32x4 c = ldb<f32x4>(rope, (unsigned)((row * 32 + 4 * fq) * 4)), s = ldb<f32x4>(rope, (unsigned)((row * 32 + 16 + 4 * fq) * 4));
                        stb(KR, (unsigned)((row * 32 + 4 * fq) * 2), pack4(x1 * c - x2 * s)); stb(KR, (unsigned)((row * 32 + 16 + 4 * fq) * 2), pack4(x1 * s + x2 * c)); } }
        }
    }
};
template <bool KVP> struct EpiUp {
    static constexpr bool PROBE2 = false;
    static constexpr bool PERM = true, AFTER_DRAIN = false, HAS_MID = false; static constexpr int MID_T = -1;
    const float* ssqq; const float* rope; bf16_t* Q; bf16_t* KN; bf16_t* V;
    __device__ __forceinline__ void mid(f32x4 (&)[2][2][4][2], const Unit&, int, int) const {}
    __device__ __forceinline__ void operator()(const f32x4 (&acc)[2][2][4][2], const Unit& u, int wr, int wc, int fr, int fq) const {
        { const int l_ = lane_id(); fr = l_ & 15; fq = l_ >> 4; }
        float sq[2][4];
        { f32x4 q_[2][4];
#pragma unroll
        for (int ai = 0; ai < 2; ++ai)
#pragma unroll
            for (int m = 0; m < 4; ++m) q_[ai][m] = ldb<f32x4>(ssqq, (unsigned)((PG8_ROW(u, ai, m) * 8 + (KVP ? 4 : 0)) * 4));
#pragma unroll
        for (int ai = 0; ai < 2; ++ai)
#pragma unroll
            for (int m = 0; m < 4; ++m) sq[ai][m] = hsum4(q_[ai][m]);
        PG8_FENCE(); }
        if (!KVP) {
#pragma unroll
            for (int ai = 0; ai < 2; ++ai)
#pragma unroll
                for (int m = 0; m < 4; ++m) { const int row = PG8_ROW(u, ai, m); const float rq = rsqrtf(sq[ai][m] * (1.f / QR) + EPS) * QSCALE;
#pragma unroll
                    for (int bj = 0; bj < 2; ++bj) { const int G = 8 * u.pn + 4 * bj + wc, h = G / 3, gi = G - 3 * h;
                        const f32x4 v0 = acc[ai][bj][m][0] * rq, v1 = acc[ai][bj][m][1] * rq;
                        if (gi < 2) stb(Q, (unsigned)((row * 768 + 32 * G + 8 * fq) * 2), pack8(v0, v1));
                        else { const f32x4 c = ldb<f32x4>(rope, (unsigned)((row * 32 + 4 * fq) * 4)), s = ldb<f32x4>(rope, (unsigned)((row * 32 + 16 + 4 * fq) * 4));
                            stb(Q, (unsigned)((row * 768 + 96 * h + 64 + 4 * fq) * 2), pack4(v0 * c - v1 * s)); stb(Q, (unsigned)((row * 768 + 96 * h + 80 + 4 * fq) * 2), pack4(v0 * s + v1 * c)); } } }
        } else {
#pragma unroll
            for (int ai = 0; ai < 2; ++ai)
#pragma unroll
                for (int m = 0; m < 4; ++m) { const int row = PG8_ROW(u, ai, m); const float rk = rsqrtf(sq[ai][m] * (1.f / KVR) + EPS);
#pragma unroll
                    for (int bj = 0; bj < 2; ++bj) { const int h = 2 * u.pn + bj;
                        const u32x4 w = pack8(acc[ai][bj][m][0] * rk, acc[ai][bj][m][1] * rk);
                        if (wc < 2) stb(KN, (unsigned)((row * 512 + 64 * h + 32 * wc + 8 * fq) * 2), w); else stb(V, (unsigned)((row * 512 + 64 * h + 32 * (wc - 2) + 8 * fq) * 2), w); } }
        }
    }
};
__device__ __forceinline__ f32x4 bf_lo4(const u32x4& w) { f32x4 r; r[0] = __uint_as_float(w.x << 16); r[1] = __uint_as_float(w.x & 0xffff0000u); r[2] = __uint_as_float(w.y << 16); r[3] = __uint_as_float(w.y & 0xffff0000u); return r; }
__device__ __forceinline__ f32x4 bf_hi4(const u32x4& w) { f32x4 r; r[0] = __uint_as_float(w.z << 16); r[1] = __uint_as_float(w.z & 0xffff0000u); r[2] = __uint_as_float(w.w << 16); r[3] = __uint_as_float(w.w & 0xffff0000u); return r; }
template <bool MIDS, bool XF32> struct EpiRes {
    static constexpr bool PROBE2 = false;
    static constexpr bool PERM = true, AFTER_DRAIN = false, HAS_MID = MIDS; static constexpr int MID_T = 8;
    const float* ssqy; const void* xin; bf16_t* xout; const float* gate  ; const float* gm  ; bf16_t* A; float* ssqo;
    __device__ __forceinline__ void mid(f32x4 (&acc)[2][2][4][2], const Unit& u, int wr, int fr) const {
        const int l_ = lane_id(); fr = l_ & 15; const int fq = l_ >> 4;
        f32x4 q_[2][4];
#pragma unroll
        for (int ai = 0; ai < 2; ++ai)
#pragma unroll
            for (int m = 0; m < 4; ++m) q_[ai][m] = ldb<f32x4>(ssqy, (unsigned)(PG8_ROW(u, ai, m) * 64 + 16 * fq));
#pragma unroll
        for (int ai = 0; ai < 2; ++ai)
#pragma unroll
            for (int m = 0; m < 4; ++m) { float s = hsum4(q_[ai][m]); s += swz_xor16(s);
                auto rr = __builtin_amdgcn_permlane32_swap(__float_as_uint(s), __float_as_uint(s), false, false); const float sg = __uint_as_float(rr[0]), sa = __uint_as_float(rr[1]);
                const float ratio = sqrtf((sa * (1.f / 512) + EPS) / (sg * (1.f / 512) + EPS));
#pragma unroll
                for (int bj = 0; bj < 2; ++bj)
#pragma unroll
                    for (int n = 0; n < 2; ++n) acc[ai][bj][m][n] = acc[ai][bj][m][n] * ratio; }
    }
    __device__ __forceinline__ void operator()(const f32x4 (&acc)[2][2][4][2], const Unit& u, int wr, int wc, int fr, int fq) const {
        { const int l_ = lane_id(); fr = l_ & 15; fq = l_ >> 4; }
        const int b = u.pm >> 3, c0 = u.pn * BM + wc * 32 + 8 * fq;
        float rs[2][4], ss[2][4];
#pragma unroll
        for (int ai = 0; ai < 2; ++ai)
#pragma unroll
            for (int m = 0; m < 4; ++m) { ss[ai][m] = 0.f; rs[ai][m] = 1.f; }
        if (MIDS) { f32x4 q_[2][4];
#pragma unroll
            for (int ai = 0; ai < 2; ++ai)
#pragma unroll
                for (int m = 0; m < 4; ++m) q_[ai][m] = ldb<f32x4>(ssqy, (unsigned)(PG8_ROW(u, ai, m) * 64 + 32 + 16 * (fq & 1)));
#pragma unroll
            for (int ai = 0; ai < 2; ++ai)
#pragma unroll
                for (int m = 0; m < 4; ++m) { float s = hsum4(q_[ai][m]); s += swz_xor16(s); rs[ai][m] = rsqrtf(s * (1.f / 512) + EPS); }
            PG8_FENCE(); }
#pragma unroll
        for (int bj = 0; bj < 2; ++bj) { const int cb = c0 + bj * HALF;
            const f32x4 g0 = ldb<f32x4>(gate, (unsigned)((b * NMOD + cb) * 4)), g1 = ldb<f32x4>(gate, (unsigned)((b * NMOD + cb + 4) * 4));
            f32x4 m0 = (f32x4){0.f, 0.f, 0.f, 0.f}, m1 = m0; if (gm) { m0 = ldb<f32x4>(gm, (unsigned)((b * DM + cb) * 4)); m1 = ldb<f32x4>(gm, (unsigned)((b * DM + cb + 4) * 4)); }
            if (XF32) {
#pragma unroll
                for (int ai = 0; ai < 2; ++ai) {
                    f32x4 xv[4][2];
#pragma unroll
                    for (int m = 0; m < 4; ++m) { const unsigned off = (unsigned)((PG8_ROW(u, ai, m) * DM + cb) * 4); xv[m][0] = ldb<f32x4>(xin, off); xv[m][1] = ldb<f32x4>(xin, off + 16); }
                    PG8_FENCE();
#pragma unroll
                    for (int m = 0; m < 4; ++m) { const unsigned off = (unsigned)((PG8_ROW(u, ai, m) * DM + cb) * 2), offx = (unsigned)(PG8_ROW(u, ai, m) * (DM * 4) + DM * 2 + cb * 2);
                        const f32x4 x0 = xv[m][0] + g0 * (acc[ai][bj][m][0] * rs[ai][m]), x1 = xv[m][1] + g1 * (acc[ai][bj][m][1] * rs[ai][m]);
                        stb(xout, offx, pack8(x0, x1));
                        if (gm) { ss[ai][m] += hsq4(x0) + hsq4(x1); stb(A, off, pack8(x0 * m0, x1 * m1)); } }
                    PG8_FENCE(); }
            } else {
                u32x4 xw[2][4];
#pragma unroll
                for (int ai = 0; ai < 2; ++ai)
#pragma unroll
                    for (int m = 0; m < 4; ++m) xw[ai][m] = ldb<u32x4>(xin, (unsigned)(PG8_ROW(u, ai, m) * (DM * 4) + DM * 2 + cb * 2));
                PG8_FENCE();
#pragma unroll
                for (int ai = 0; ai < 2; ++ai)
#pragma unroll
                    for (int m = 0; m < 4; ++m) { const unsigned off = (unsigned)((PG8_ROW(u, ai, m) * DM + cb) * 2), offx = (unsigned)(PG8_ROW(u, ai, m) * (DM * 4) + DM * 2 + cb * 2);
                        const f32x4 x0 = bf_lo4(xw[ai][m]) + g0 * (acc[ai][bj][m][0] * rs[ai][m]), x1 = bf_hi4(xw[ai][m]) + g1 * (acc[ai][bj][m][1] * rs[ai][m]);
                        stb(xout, offx, pack8(x0, x1));
                        if (gm) { ss[ai][m] += hsq4(x0) + hsq4(x1); stb(A, off, pack8(x0 * m0, x1 * m1)); } }
                PG8_FENCE(); } }
        if (gm) {
#pragma unroll
            for (int ai = 0; ai < 2; ++ai)
#pragma unroll
                for (int m = 0; m < 4; ++m) { const float s = quad_sum(ss[ai][m]); if (fq == 0) stb(ssqo, (unsigned)((PG8_ROW(u, ai, m) * 16 + u.pn * 4 + wc) * 4), s); } }
    }
};
struct EpiFf1 {
    static constexpr bool PERM = true, AFTER_DRAIN = false, HAS_MID = false; static constexpr int MID_T = -1;
    const float* ssq2; const float* shw2; bf16_t* H;
    __device__ __forceinline__ void mid(f32x4 (&)[2][2][4][2], const Unit&, int, int) const {}
    __device__ __forceinline__ void operator()(const f32x4 (&acc)[2][2][4][2], const Unit& u, int wr, int wc, int fr, int fq) const {
        { const int l_ = lane_id(); fr = l_ & 15; fq = l_ >> 4; }
        const int b = u.pm >> 3, c0 = u.pn * BM + wc * 32 + 8 * fq;
        f32x4 sh[2][2];
#pragma unroll
        for (int bj = 0; bj < 2; ++bj)
#pragma unroll
            for (int n = 0; n < 2; ++n) sh[bj][n] = ldb<f32x4>(shw2, (unsigned)((b * DFF + c0 + bj * HALF + 4 * n) * 4));
        float rsv[2][4]; PG8_RSTD8(rsv, ssq2, 1.f / DM);
#pragma unroll
        for (int ai = 0; ai < 2; ++ai)
#pragma unroll
            for (int m = 0; m < 4; ++m) { const int row = PG8_ROW(u, ai, m); const float rs = rsv[ai][m];
#pragma unroll
                for (int bj = 0; bj < 2; ++bj) { f32x4 v0 = acc[ai][bj][m][0] * rs + sh[bj][0], v1 = acc[ai][bj][m][1] * rs + sh[bj][1];
#pragma unroll
                    for (int i = 0; i < 4; ++i) { const float a = fmaxf(v0[i], 0.f), c = fmaxf(v1[i], 0.f); v0[i] = a * a; v1[i] = c * c; }
                    stb(H, (unsigned)((row * DFF + c0 + bj * HALF) * 2), pack8(v0, v1)); } }
    }
};

template <class Epi, class Sched, bool ALIGN_EPI = false, bool SP2 = false>
__device__ __forceinline__ void gemm_phase(PG8_LAS unsigned char* lds, const Gemm g, const Sched& S, const Epi& E, int wid0) {
    int tid_ = wid0 * 64 + lane_id(); asm volatile("" : "+v"(tid_));
    const int tid = tid_, wid = __builtin_amdgcn_readfirstlane(tid >> 6), lane = tid & 63, wr = wid >> 2, wc = wid & 3, fr = lane & 15, fq = lane >> 4;
    const int K = g.K, nt = K / BK;
    unsigned voffA[2], voffB[2];
#pragma unroll
    for (int i = 0; i < 2; ++i) { int R, C; stage_rc(tid * 16 + i * 8192, R, C); const int Rb = Epi::PERM ? ((R & ~31) + perm32(R & 31)) : R;
        voffA[i] = (unsigned)(R * K + C) * 2u; voffB[i] = (unsigned)(Rb * K + C) * 2u; }
    const size_t kstep = (size_t)(BK * 2);
    const size_t hstep = (size_t)HALF * K * 2;
    const size_t tstep = 2 * hstep;
    const unsigned ldsw = (unsigned)wid * 1024u;
    const int aoff = lds_byte(wr * 64 + fr, fq * 8), boff = lds_byte(wc * 32 + fr, fq * 8);
#define PG8_SA(b, h) (((b) * 2 + (h)) * HTB)
#define PG8_SB(b, h) ((4 + (b) * 2 + (h)) * HTB)
#define PG8_STAGE(bufoff, gbase, voff) do { _Pragma("unroll") for (int _i = 0; _i < 2; ++_i) \
        __builtin_amdgcn_global_load_lds((const unsigned*)((const char*)(gbase) + (voff)[_i]), (PG8_LAS unsigned*)(lds + (bufoff) + ldsw + _i * 8192), 16, 0, 0); } while (0)
#define PG8_LDA(dst, b, h) do { _Pragma("unroll") for (int m = 0; m < 4; ++m) _Pragma("unroll") for (int k = 0; k < 2; ++k) dst[m][k] = *(const PG8_LAS bf16x8*)(lds + PG8_SA(b, h) + aoff + m * 2048 + k * 1024); } while (0)
#define PG8_LDB(dst, b, h) do { _Pragma("unroll") for (int n = 0; n < 2; ++n) _Pragma("unroll") for (int k = 0; k < 2; ++k) dst[n][k] = *(const PG8_LAS bf16x8*)(lds + PG8_SB(b, h) + boff + n * 2048 + k * 1024); } while (0)
#define PG8_MMA(ai, bj, At, Bt) do { __builtin_amdgcn_s_setprio(1); _Pragma("unroll") for (int m = 0; m < 4; ++m) _Pragma("unroll") for (int n = 0; n < 2; ++n) _Pragma("unroll") for (int k = 0; k < 2; ++k) \
        acc[ai][bj][m][n] = __builtin_amdgcn_mfma_f32_16x16x32_bf16(Bt[n][k], At[m][k], acc[ai][bj][m][n], 0, 0, 0); __builtin_amdgcn_s_setprio(0); } while (0)
#define PG8_WAIT_V(n) asm volatile("s_waitcnt vmcnt(" #n ")" ::: "memory")
#define PG8_WAIT_L(n) asm volatile("s_waitcnt lgkmcnt(" #n ")" ::: "memory")
#define PG8_BAR __builtin_amdgcn_s_barrier()
#define PG8_SCHED __builtin_amdgcn_sched_barrier(0)
    Unit cur, nxt; int ui = 0;
    if (!S.next(0, cur)) return;
    f32x4 acc[2][2][4][2];
#pragma unroll
    for (int a = 0; a < 2; ++a)
#pragma unroll
        for (int b = 0; b < 2; ++b)
#pragma unroll
            for (int m = 0; m < 4; ++m)
#pragma unroll
                for (int n = 0; n < 2; ++n) acc[a][b][m][n] = (f32x4){0.f, 0.f, 0.f, 0.f};
    bf16x8 At[4][2], B0[2][2], B1[2][2];
    const char* cA = (const char*)g.A + (size_t)cur.pm * tstep; const char* cB = (const char*)g.Bt + (size_t)cur.pn * tstep;
    S.a_ready(cur);
    if constexpr (SP2) {
        PG8_STAGE(PG8_SB(0, 0), cB, voffB); PG8_STAGE(PG8_SB(0, 1), cB + hstep, voffB); PG8_STAGE(PG8_SA(0, 0), cA, voffA); PG8_STAGE(PG8_SA(0, 1), cA + hstep, voffA);
        if (wr == 1) PG8_BAR;
        PG8_WAIT_V(2); PG8_BAR;
        PG8_STAGE(PG8_SB(1, 0), cB + kstep, voffB); PG8_STAGE(PG8_SA(1, 0), cA + kstep, voffA); PG8_STAGE(PG8_SB(1, 1), cB + hstep + kstep, voffB);
        PG8_WAIT_V(6); PG8_BAR;
    } else {
        PG8_STAGE(PG8_SB(0, 0), cB, voffB); PG8_STAGE(PG8_SA(0, 0), cA, voffA); PG8_STAGE(PG8_SB(0, 1), cB + hstep, voffB); PG8_STAGE(PG8_SA(0, 1), cA + hstep, voffA);
        if (wr == 1) PG8_BAR;
        PG8_WAIT_V(4); PG8_BAR;
        PG8_STAGE(PG8_SB(1, 0), cB + kstep, voffB); PG8_STAGE(PG8_SA(1, 0), cA + kstep, voffA); PG8_STAGE(PG8_SB(1, 1), cB + hstep + kstep, voffB);
        PG8_WAIT_V(6); PG8_BAR;
    }
    for (;;) {
        const bool has_next = S.next(ui + 1, nxt);
        const char* nA = has_next ? (const char*)g.A + (size_t)nxt.pm * tstep : cA; const char* nB = has_next ? (const char*)g.Bt + (size_t)nxt.pn * tstep : cB;
        for (int t = 0; t < nt; t += 2) {
            const bool last = (t == nt - 2);
            const char* a1 = cA + (size_t)(t + 1) * kstep;
            const char* a2 = last ? nA : cA + (size_t)(t + 2) * kstep; const char* b2 = last ? nB : cB + (size_t)(t + 2) * kstep;
            const char* a3 = a2 + kstep; const char* b3 = b2 + kstep;
            if (last && has_next) S.a_ready(nxt);
            if constexpr (Epi::HAS_MID) { if (t == Epi::MID_T) E.mid(acc, cur, wr, fr); }
            if constexpr (SP2) {
            PG8_LDB(B0, 0, 0); PG8_LDB(B1, 0, 1); PG8_SCHED; PG8_LDA(At, 0, 0); PG8_STAGE(PG8_SA(1, 1), a1 + hstep, voffA);
            PG8_WAIT_V(8); PG8_WAIT_L(0); PG8_BAR; PG8_MMA(0, 0, At, B0); PG8_MMA(0, 1, At, B1); PG8_BAR; PG8_SCHED;
            PG8_LDA(At, 0, 1); PG8_STAGE(PG8_SB(0, 0), b2, voffB); PG8_STAGE(PG8_SB(0, 1), b2 + hstep, voffB); PG8_STAGE(PG8_SA(0, 0), a2, voffA);
            PG8_WAIT_V(8); PG8_WAIT_L(0); PG8_BAR; PG8_MMA(1, 0, At, B0); PG8_MMA(1, 1, At, B1); PG8_BAR; PG8_SCHED;
            PG8_LDB(B0, 1, 0); PG8_LDB(B1, 1, 1); PG8_SCHED; PG8_LDA(At, 1, 0); PG8_STAGE(PG8_SA(0, 1), a2 + hstep, voffA);
            PG8_WAIT_V(8); PG8_WAIT_L(0); PG8_BAR; PG8_MMA(0, 0, At, B0); PG8_MMA(0, 1, At, B1); PG8_BAR; PG8_SCHED;
            PG8_LDA(At, 1, 1); PG8_STAGE(PG8_SB(1, 0), b3, voffB); PG8_STAGE(PG8_SB(1, 1), b3 + hstep, voffB); PG8_STAGE(PG8_SA(1, 0), a3, voffA);
            PG8_WAIT_V(8); PG8_WAIT_L(0); PG8_BAR; PG8_MMA(1, 0, At, B0); PG8_MMA(1, 1, At, B1); PG8_BAR; PG8_SCHED;
            } else {
            PG8_LDB(B0, 0, 0); PG8_SCHED; PG8_LDA(At, 0, 0); PG8_STAGE(PG8_SA(1, 1), a1 + hstep, voffA);
            PG8_WAIT_L(8); PG8_BAR; PG8_WAIT_L(0); PG8_MMA(0, 0, At, B0); PG8_BAR; PG8_SCHED;
            PG8_LDB(B1, 0, 1); PG8_STAGE(PG8_SB(0, 0), b2, voffB);
            PG8_BAR; PG8_WAIT_L(0); PG8_MMA(0, 1, At, B1); PG8_BAR;
            PG8_LDA(At, 0, 1); PG8_STAGE(PG8_SA(0, 0), a2, voffA);
            PG8_BAR; PG8_WAIT_L(0); PG8_MMA(1, 0, At, B0); PG8_BAR; PG8_SCHED;
            PG8_STAGE(PG8_SB(0, 1), b2 + hstep, voffB);
            PG8_WAIT_V(6); PG8_BAR; PG8_MMA(1, 1, At, B1); PG8_BAR;
            PG8_LDB(B0, 1, 0); PG8_SCHED; PG8_LDA(At, 1, 0); PG8_STAGE(PG8_SA(0, 1), a2 + hstep, voffA);
            PG8_WAIT_L(8); PG8_BAR; PG8_WAIT_L(0); PG8_MMA(0, 0, At, B0); PG8_BAR; PG8_SCHED;
            PG8_LDB(B1, 1, 1); PG8_STAGE(PG8_SB(1, 0), b3, voffB);
            PG8_BAR; PG8_WAIT_L(0); PG8_MMA(0, 1, At, B1); PG8_BAR;
            PG8_LDA(At, 1, 1); PG8_STAGE(PG8_SA(1, 0), a3, voffA);
            PG8_BAR; PG8_WAIT_L(0); PG8_MMA(1, 0, At, B0); PG8_BAR; PG8_SCHED;
            PG8_STAGE(PG8_SB(1, 1), b3 + hstep, voffB);
            PG8_WAIT_V(6); PG8_BAR; PG8_MMA(1, 1, At, B1); PG8_BAR;
            }
        }
        if constexpr (ALIGN_EPI) { if (wr == 0) PG8_BAR; }
        if constexpr (!Epi::AFTER_DRAIN) { E(acc, cur, wr, wc, fr, fq); S.done(cur); }
        if (!has_next) break;
#pragma unroll
        for (int a = 0; a < 2; ++a)
#pragma unroll
            for (int b = 0; b < 2; ++b)
#pragma unroll
                for (int m = 0; m < 4; ++m)
#pragma unroll
                    for (int n = 0; n < 2; ++n) acc[a][b][m][n] = (f32x4){0.f, 0.f, 0.f, 0.f};
        cur = nxt; cA = nA; cB = nB; ++ui;
        if constexpr (ALIGN_EPI) { if (wr == 1) PG8_BAR; }
    }
    PG8_WAIT_V(0);
    if constexpr (!ALIGN_EPI) { if (wr == 0) PG8_BAR; }
    PG8_BAR;
    if constexpr (Epi::AFTER_DRAIN) { E.fused(acc, cur, wr, wc, fr, fq, lds, wid, lane); S.done(cur); }
#undef PG8_SA
#undef PG8_SB
#undef PG8_STAGE
#undef PG8_LDA
#undef PG8_LDB
#undef PG8_MMA
#undef PG8_WAIT_V
#undef PG8_WAIT_L
#undef PG8_BAR
#undef PG8_SCHED
}
}

namespace gm {
#define GM_LAS __attribute__((address_space(3)))
typedef short v4i16_t __attribute__((ext_vector_type(4)));
__device__ __forceinline__ int swz(int s) { return ((s >> 1) & 1) + 2 * ((s >> 3) & 1); }
__device__ __forceinline__ void gmlp_phase(GM_LAS unsigned char* lds, int wid0, int vcu, const bf16_t* U, const bf16_t* VN, const bf16_t* GW  , const float* bs  , const float* gog  , bf16_t* Y, float* ssqy) {
    int tid_ = wid0 * 64 + lane_id(); asm volatile("" : "+v"(tid_));
    const int tid = tid_, lane = tid & 63, wid = __builtin_amdgcn_readfirstlane(tid >> 6), fr = lane & 15, fq = lane >> 4;
    const int g = vcu & 7, nks = (wid >> 1) + 1;
    bf16x8 wf[4];
#pragma unroll
    for (int ks = 0; ks < 4; ++ks) wf[ks] = *(const bf16x8*)(GW + ((size_t)(g * CHUNK + 16 * wid + fr)) * CHUNK + 32 * ks + 8 * fq);
    const float bias = bs[g * CHUNK + 16 * wid + fr];
    f32x4 gv[4];
#pragma unroll
    for (int nt = 0; nt < 4; ++nt) gv[nt] = *(const f32x4*)(gog + g * 64 + 16 * nt + 4 * fq);
    for (int i = 0; i < 8; ++i) {
        const int un = (vcu >> 3) + 32 * i; const size_t t0 = (size_t)un * CHUNK;
        pg8::u32x4 st[2];
#pragma unroll
        for (int k = 0; k < 2; ++k) { const int idx = tid + 512 * k, s = idx >> 3, c16 = idx & 7; st[k] = *(const pg8::u32x4*)(VN + (t0 + s) * 512 + g * 64 + c16 * 8); }
        __syncthreads();
#pragma unroll
        for (int k = 0; k < 2; ++k) { const int idx = tid + 512 * k, s = idx >> 3, c16 = idx & 7; *(GM_LAS pg8::u32x4*)(lds + s * 128 + (((c16 >> 1) ^ swz(s)) * 32) + (c16 & 1) * 16) = st[k]; }
        __syncthreads();
        f32x4 acc[4];
#pragma unroll
        for (int nt = 0; nt < 4; ++nt) acc[nt] = (f32x4){0.f, 0.f, 0.f, 0.f};
#pragma unroll
        for (int ks = 0; ks < 4; ++ks) { if (ks < nks) {
#pragma unroll
            for (int nt = 0; nt < 4; ++nt) {
                const int q = fr >> 2, p = fr & 3;
                const int s0 = 32 * ks + 8 * fq + q, s1 = s0 + 4;
                const v4i16_t lo = __builtin_amdgcn_ds_read_tr16_b64_v4i16((GM_LAS v4i16_t*)(lds + s0 * 128 + ((nt ^ swz(s0)) * 32) + p * 8));
                const v4i16_t hi = __builtin_amdgcn_ds_read_tr16_b64_v4i16((GM_LAS v4i16_t*)(lds + s1 * 128 + ((nt ^ swz(s1)) * 32) + p * 8));
                const bf16x8 vf = (bf16x8){lo[0], lo[1], lo[2], lo[3], hi[0], hi[1], hi[2], hi[3]};
                acc[nt] = __builtin_amdgcn_mfma_f32_16x16x32_bf16(vf, wf[ks], acc[nt], 0, 0, 0);
            } } }
        const size_t row = t0 + 16 * wid + fr; float ss = 0.f;
#pragma unroll
        for (int nt = 0; nt < 4; ++nt) { const int c = g * 64 + 16 * nt + 4 * fq;
            const uint2 uu = *(const uint2*)(U + row * 512 + c);
            f32x4 y; y[0] = bf2f((bf16_t)(uu.x & 0xffff)) * (acc[nt][0] + bias); y[1] = bf2f((bf16_t)(uu.x >> 16)) * (acc[nt][1] + bias);
            y[2] = bf2f((bf16_t)(uu.y & 0xffff)) * (acc[nt][2] + bias); y[3] = bf2f((bf16_t)(uu.y >> 16)) * (acc[nt][3] + bias);
            ss += pg8::hsq4(y); *(pg8::u32x2*)(Y + row * DM + c) = pg8::pack4(y * gv[nt]); }
        ss = pg8::quad_sum(ss); if (fq == 0) ssqy[row * 16 + g] = ss;
    }
    __syncthreads();
}
}

namespace att {
#define AT_LAS __attribute__((address_space(3)))
using f32x16 = __attribute__((ext_vector_type(16))) float;
using s16x4 = __attribute__((ext_vector_type(4))) short;
using u32x4 = __attribute__((ext_vector_type(4))) unsigned;
constexpr int KVBLK = 64, KSLOTB = 12288, VSLOTB = 8192, NKS = 3, NVS = 4;
constexpr int LDS_V = NKS * KSLOTB  , LDS_WS = LDS_V + NVS * VSLOTB  , LDS_OST = LDS_WS + 8 * 256  , OROW = 144, LDS_BYTES = LDS_OST + 8 * 32 * OROW  ;
__device__ __forceinline__ int crow(int r, int hi) { return (r & 3) + 8 * (r >> 2) + 4 * hi; }
__device__ __forceinline__ void glds16(const void* gsrc, unsigned lds_dst) { unsigned keep;
    asm volatile("s_mov_b32 %0, m0\n\ts_mov_b32 m0, %2\n\ts_nop 0\n\tglobal_load_lds_dwordx4 %1, off\n\ts_mov_b32 m0, %0" : "=&s"(keep) : "v"(gsrc), "s"(lds_dst) : "memory"); }
__device__ __forceinline__ float max3f(float a, float b, float c) { float r; asm("v_max3_f32 %0, %1, %2, %3" : "=v"(r) : "v"(a), "v"(b), "v"(c)); return r; }
#define AT_WAIT_BAR(N) asm volatile("s_waitcnt vmcnt(" #N ") lgkmcnt(0)\n\ts_barrier" ::: "memory")
typedef short v4i16_t __attribute__((ext_vector_type(4)));
__device__ __forceinline__ s16x4 vtr(AT_LAS const char* p) { return __builtin_bit_cast(s16x4, __builtin_amdgcn_ds_read_tr16_b64_v4i16((AT_LAS v4i16_t*)p)); }
__device__ __forceinline__ void pv(f32x16 (&o)[2], AT_LAS const char* vp, const u32x4& pw0, const u32x4& pw1, const u32x4& pw2, const u32x4& pw3) {
#pragma unroll
    for (int d0 = 0; d0 < 2; ++d0) { s16x4 lo[4], hh[4];
#pragma unroll
        for (int ks = 0; ks < 4; ++ks) { lo[ks] = vtr(vp + d0 * 4096 + ks * 1024); hh[ks] = vtr(vp + d0 * 4096 + ks * 1024 + 512); }
#define AT_VF(k) (bf16x8){lo[k][0], lo[k][1], lo[k][2], lo[k][3], hh[k][0], hh[k][1], hh[k][2], hh[k][3]}
        o[d0] = __builtin_amdgcn_mfma_f32_32x32x16_bf16(__builtin_bit_cast(bf16x8, pw0), AT_VF(0), o[d0], 0, 0, 0);
        o[d0] = __builtin_amdgcn_mfma_f32_32x32x16_bf16(__builtin_bit_cast(bf16x8, pw1), AT_VF(1), o[d0], 0, 0, 0);
        o[d0] = __builtin_amdgcn_mfma_f32_32x32x16_bf16(__builtin_bit_cast(bf16x8, pw2), AT_VF(2), o[d0], 0, 0, 0);
        o[d0] = __builtin_amdgcn_mfma_f32_32x32x16_bf16(__builtin_bit_cast(bf16x8, pw3), AT_VF(3), o[d0], 0, 0, 0);
#undef AT_VF
    }
}
template <int THRL>
__device__ __forceinline__ void attn_unit(int b, int h, int qb, const bf16_t* Q, const bf16_t* KN, const bf16_t* KR, const bf16_t* V, const float* goa  , bf16_t* Y, float* ssqy, AT_LAS char* shm, int wid0) {
    int tid_ = wid0 * 64 + lane_id(); asm volatile("" : "+v"(tid_));
    const int tid = tid_, lane = tid & 63, r32 = lane & 31, hi = lane >> 5; const int wid = __builtin_amdgcn_readfirstlane(tid >> 6);
    const bool late = wid >= 4;
    const size_t rowbase = (size_t)b * SEQ; const int q0 = qb * 256;
    const bf16_t* Qw = Q + (rowbase + q0 + wid * 32) * 768 + h * 96;
    const unsigned lds0 = (unsigned)(uintptr_t)shm;
    AT_LAS float* wsf = (AT_LAS float*)(shm + LDS_WS) + wid * 64;
    const bf16_t* ksrc = KN + (rowbase + lane) * 512 + h * 64 + wid * 8;
    const bf16_t* rsrc = KR + (rowbase + lane) * 32 + (wid & 3) * 8;
    const bf16_t* vsrc = V + (rowbase + 16 * (wid & 3) + (lane >> 2)) * 512 + h * 64 + (wid >> 2) * 32 + (lane & 3) * 8;
    const unsigned kdst = lds0 + wid * 1024, rdst = lds0 + (8 + (wid & 3)) * 1024, vdst = lds0 + LDS_V + wid * 1024;
#define AT_DMA(t, ks, vs) do { glds16(ksrc + (size_t)(t) * KVBLK * 512, (unsigned)__builtin_amdgcn_readfirstlane(kdst + (ks))); \
        glds16(rsrc + (size_t)(t) * KVBLK * 32, (unsigned)__builtin_amdgcn_readfirstlane(rdst + (ks))); \
        glds16(vsrc + (size_t)(t) * KVBLK * 512, (unsigned)__builtin_amdgcn_readfirstlane(vdst + (vs))); } while (0)
    const int NT = (q0 + 256) / KVBLK;
    bf16x8 qr[6];
#pragma unroll
    for (int d0 = 0; d0 < 6; ++d0) qr[d0] = *(const bf16x8*)(Qw + (size_t)r32 * 768 + d0 * 16 + hi * 8);
    AT_DMA(0, 0, 0); AT_DMA(1, KSLOTB, VSLOTB);
    float mhat = 0.f, l_reg = 0.f; f32x16 o[2]; o[0] = f32x16{}; o[1] = f32x16{};
    f32x16 negm = f32x16{}; asm volatile("" : "+v"(negm));
    const int qrel = wid * 32 + r32;
    int ks_cur = 0, ks_nn = 2 * KSLOTB, vs_cur = 0, vs_prev = 0, vs_nn = 2 * VSLOTB;
    AT_LAS const char* kp0 = shm + hi * 1024 + r32 * 16;
    AT_LAS const char* vp0 = shm + LDS_V + ((lane >> 4) & 1) * 32 + (lane & 3) * 8 + (4 * hi + ((lane & 15) >> 2)) * 64;
    u32x4 pw0 = u32x4{}, pw1 = u32x4{}, pw2 = u32x4{}, pw3 = u32x4{}; bool have = false;
    for (int t = 0; t < NT; ++t) {
        if (t + 1 < NT) { AT_WAIT_BAR(3); } else { AT_WAIT_BAR(0); }
        if (t + 2 < NT) AT_DMA(t + 2, ks_nn, vs_nn);
        if (late && have) pv(o, vp0 + vs_prev, pw0, pw1, pw2, pw3);
        have = false;
        const int jb = t - (NT - 4);
        if (jb <= (wid >> 1)) {
            f32x16 p0, p1;
            { AT_LAS const char* kb = kp0 + ks_cur;
#pragma unroll
              for (int d0 = 0; d0 < 6; ++d0) {
                const bf16x8 b0 = *(AT_LAS const bf16x8*)(kb + d0 * 2048), b1 = *(AT_LAS const bf16x8*)(kb + d0 * 2048 + 512);
                if (d0 == 0) { p0 = __builtin_amdgcn_mfma_f32_32x32x16_bf16(b0, qr[0], negm, 0, 0, 0); p1 = __builtin_amdgcn_mfma_f32_32x32x16_bf16(b1, qr[0], negm, 0, 0, 0); }
                else { p0 = __builtin_amdgcn_mfma_f32_32x32x16_bf16(b0, qr[d0], p0, 0, 0, 0); p1 = __builtin_amdgcn_mfma_f32_32x32x16_bf16(b1, qr[d0], p1, 0, 0, 0); } } }
            if (jb == (wid >> 1)) { const int kb = 64 * jb + 4 * hi;
#pragma unroll
                for (int r = 0; r < 16; ++r) { const int kv = kb + (r & 3) + 8 * (r >> 2); if (kv > qrel) p0[r] = -INFINITY; if (kv + 32 > qrel) p1[r] = -INFINITY; } }
            float ma = max3f(p0[0], p0[1], p1[0]), mb = max3f(p0[2], p0[3], p1[1]); ma = max3f(ma, p1[2], p1[3]);
#pragma unroll
            for (int r = 4; r < 16; r += 4) { ma = max3f(ma, p0[r], p0[r + 1]); mb = max3f(mb, p0[r + 2], p0[r + 3]); ma = max3f(ma, p1[r], p1[r + 1]); mb = max3f(mb, p1[r + 2], p1[r + 3]); }
            float rm = fmaxf(ma, mb);
            { auto rr = __builtin_amdgcn_permlane32_swap(__float_as_uint(rm), __float_as_uint(rm), false, false); rm = fmaxf(__uint_as_float(rr[0]), __uint_as_float(rr[1])); }
            if (t == 0 || __any(rm > (float)THRL)) {
                const float dl = (t == 0) ? rm : fmaxf(rm, 0.f); mhat += dl;
#pragma unroll
                for (int r = 0; r < 16; ++r) { p0[r] -= dl; p1[r] -= dl; negm[r] = -mhat; }
                asm volatile("" : "+v"(negm));
                if (t > 0) { const float f = __builtin_amdgcn_exp2f(-dl); l_reg *= f; if (hi == 0) wsf[r32] = f; asm volatile("s_waitcnt lgkmcnt(0)" ::: "memory");
#pragma unroll
                    for (int r = 0; r < 16; ++r) { const float fr_ = wsf[crow(r, hi)]; o[0][r] *= fr_; o[1][r] *= fr_; } }
            }
            float sacc = 0.f;
#pragma unroll
            for (int r = 0; r < 16; ++r) { p0[r] = __builtin_amdgcn_exp2f(p0[r]); p1[r] = __builtin_amdgcn_exp2f(p1[r]); sacc += p0[r] + p1[r]; }
            l_reg += sacc;
#define AT_PK(P, B) pg8::cvt_pk_bf16(P[B], P[B + 1])
            pw0 = (u32x4){AT_PK(p0, 0), AT_PK(p0, 2), AT_PK(p0, 4), AT_PK(p0, 6)}; pw1 = (u32x4){AT_PK(p0, 8), AT_PK(p0, 10), AT_PK(p0, 12), AT_PK(p0, 14)};
            pw2 = (u32x4){AT_PK(p1, 0), AT_PK(p1, 2), AT_PK(p1, 4), AT_PK(p1, 6)}; pw3 = (u32x4){AT_PK(p1, 8), AT_PK(p1, 10), AT_PK(p1, 12), AT_PK(p1, 14)};
#undef AT_PK
            if (!late) pv(o, vp0 + vs_cur, pw0, pw1, pw2, pw3); else have = true;
        }
        ks_cur = (ks_cur == (NKS - 1) * KSLOTB) ? 0 : ks_cur + KSLOTB; ks_nn = (ks_nn == (NKS - 1) * KSLOTB) ? 0 : ks_nn + KSLOTB;
        vs_prev = vs_cur; vs_cur = (vs_cur == (NVS - 1) * VSLOTB) ? 0 : vs_cur + VSLOTB; vs_nn = (vs_nn == (NVS - 1) * VSLOTB) ? 0 : vs_nn + VSLOTB;
    }
    if (late && have) pv(o, vp0 + vs_prev, pw0, pw1, pw2, pw3);
    { auto rr = __builtin_amdgcn_permlane32_swap(__float_as_uint(l_reg), __float_as_uint(l_reg), false, false); l_reg = __uint_as_float(rr[0]) + __uint_as_float(rr[1]); }
    if (hi == 0) wsf[32 + r32] = __builtin_amdgcn_rcpf(l_reg);
    asm volatile("s_waitcnt lgkmcnt(0)" ::: "memory");
    AT_LAS char* stg = shm + LDS_OST + wid * (32 * OROW);
    { const int row = lane >> 1, half = lane & 1; const size_t grow = rowbase + q0 + wid * 32 + row; float ss = 0.f;
#pragma unroll
      for (int d0 = 0; d0 < 2; ++d0) {
#pragma unroll
        for (int r = 0; r < 16; ++r) { const int orow = crow(r, hi); *(AT_LAS float*)(stg + orow * OROW + r32 * 4) = o[d0][r] * wsf[32 + orow]; }
        asm volatile("s_waitcnt lgkmcnt(0)" ::: "memory");
        const float* gp = goa + h * 64 + d0 * 32 + half * 16; bf16_t* yp = Y + grow * DM + 512 + h * 64 + d0 * 32 + half * 16;
#pragma unroll
        for (int i = 0; i < 2; ++i) { const f32x4 a = *(AT_LAS const f32x4*)(stg + row * OROW + half * 64 + i * 32), c = *(AT_LAS const f32x4*)(stg + row * OROW + half * 64 + i * 32 + 16);
            ss += pg8::hsq4(a) + pg8::hsq4(c);
            *(u32x4*)(yp + i * 8) = pg8::pack8(a * *(const f32x4*)(gp + i * 8), c * *(const f32x4*)(gp + i * 8 + 4)); }
        asm volatile("s_waitcnt lgkmcnt(0)" ::: "memory"); }
      ss += swz_xor1(ss); if (half == 0) ssqy[grow * 16 + 8 + h] = ss; }
    asm volatile("s_waitcnt lgkmcnt(0)\n\ts_barrier" ::: "memory");
#undef AT_DMA
}
__device__ __forceinline__ void attn_phase(AT_LAS char* lds, int wid0, int vcu, const bf16_t* Q, const bf16_t* KN, const bf16_t* KR, const bf16_t* V, const float* goa, bf16_t* Y, float* ssqy) {
    const int bh = vcu >> 1, s = vcu & 1;
    for (int i = 0; i < 4; ++i) { const int qb = (i == 0) ? s : (i == 1) ? 7 - s : (i == 2) ? 2 + s : 5 - s;
        attn_unit<8>(bh >> 3, bh & 7, qb, Q, KN, KR, V, goa, Y, ssqy, lds, wid0); }
}
}

constexpr int NWAVES = 8;
struct Args { const void* in[20]; float* out; unsigned char* ws; int ph_lo, ph_hi, li, flags; };
namespace pro {
#define PR_LAS __attribute__((address_space(3)))
__device__ __forceinline__ unsigned pk2(float lo, float hi) { return (unsigned)f2bf(lo) | ((unsigned)f2bf(hi) << 16); }
template <int MODE  >
__device__ __forceinline__ void tr_item(const float* W, int ldw, bf16_t* WT, int out_ld, int out_koff, int nblk, PR_LAS float* scr, int item, int lane) {
    const int kb = item / nblk, nb = item - kb * nblk, k0 = 64 * kb, n0 = 32 * nb;
    const int pn = n0 + (lane & 31); const int sc0 = MODE == 0 ? pn : (MODE == 1 ? win_src(pn) : wup_qcol(pn));
    const int sc = sc0 >= 0 ? sc0 : 0; const float msk = sc0 >= 0 ? 1.f : 0.f;
    const float* wp = W + (size_t)(k0 + (lane >> 5)) * ldw + sc;
    float v[32];
#pragma unroll
    for (int i = 0; i < 32; ++i) v[i] = wp[(size_t)(2 * i) * ldw];
#pragma unroll
    for (int i = 0; i < 32; ++i) scr[(2 * i + (lane >> 5)) * 33 + (lane & 31)] = v[i] * msk;
    asm volatile("s_waitcnt lgkmcnt(0)" ::: "memory");
    const int c = lane & 7;
#pragma unroll
    for (int j = 0; j < 4; ++j) { const int n = (lane >> 3) + 8 * j; const PR_LAS float* s = scr + (8 * c) * 33 + n;
        pg8::u32x4 o; o.x = pk2(s[0 * 33], s[1 * 33]); o.y = pk2(s[2 * 33], s[3 * 33]); o.z = pk2(s[4 * 33], s[5 * 33]); o.w = pk2(s[6 * 33], s[7 * 33]);
        *(pg8::u32x4*)(WT + (size_t)(n0 + n) * out_ld + out_koff + k0 + 8 * c) = o; }
    asm volatile("s_waitcnt lgkmcnt(0)" ::: "memory");
}
__device__ __forceinline__ void smallm_unit(PR_LAS unsigned char* lds, int tid, const float* in, int in_stride, bool act, const float* W, int ldw, int N, bool winmap, const float* bias, float* out, int out_stride, int p0, int ucols) {
    PR_LAS float* sin_ = (PR_LAS float*)lds; PR_LAS float* red = (PR_LAS float*)(lds + 65536);
    const int lane = tid & 63, wave = tid >> 6;
#pragma unroll 8
    for (int e = tid; e < 16 * 1024; e += 512) { const int b = e >> 10, k = e & 1023; float v = in[(size_t)b * in_stride + k]; if (act) v = v * __builtin_amdgcn_rcpf(1.f + __expf(-v)); sin_[k * 16 + b] = v; }
    __syncthreads();
    const int p = p0 + lane; const int s0 = winmap ? win_src(p) : p; const bool ok = (lane < ucols && s0 >= 0 && s0 < N);
    const int sc = ok ? s0 : 0; const float msk = ok ? 1.f : 0.f;
    const float* wp = W + (size_t)(wave * 128) * ldw + sc;
    float acc[16];
#pragma unroll
    for (int b = 0; b < 16; ++b) acc[b] = 0.f;
    for (int k0 = 0; k0 < 128; k0 += 16) {
        float w[16];
#pragma unroll
        for (int j = 0; j < 16; ++j) w[j] = wp[(size_t)(k0 + j) * ldw];
#pragma unroll
        for (int j = 0; j < 16; ++j) { const PR_LAS f32x4* sp = (const PR_LAS f32x4*)(sin_ + (wave * 128 + k0 + j) * 16);
#pragma unroll
            for (int q = 0; q < 4; ++q) { const f32x4 v = sp[q]; acc[4 * q] += v[0] * w[j]; acc[4 * q + 1] += v[1] * w[j]; acc[4 * q + 2] += v[2] * w[j]; acc[4 * q + 3] += v[3] * w[j]; } }
    }
#pragma unroll
    for (int b = 0; b < 16; ++b) red[(wave * 64 + lane) * 16 + b] = acc[b] * msk;
    __syncthreads();
    for (int e = tid; e < 64 * 16; e += 512) { const int l = e >> 4, b = e & 15; float sum = 0.f;
#pragma unroll
        for (int w = 0; w < 8; ++w) sum += red[(w * 64 + l) * 16 + b];
        if (l < ucols) out[(size_t)b * out_stride + p0 + l] = sum + (bias ? bias[p0 + l] : 0.f); }
    __syncthreads();
}
__device__ __forceinline__ float wsum(float v) {
    v += __int_as_float(__builtin_amdgcn_ds_swizzle(__float_as_int(v), 0x041F)); v += __int_as_float(__builtin_amdgcn_ds_swizzle(__float_as_int(v), 0x081F));
    v += __int_as_float(__builtin_amdgcn_ds_swizzle(__float_as_int(v), 0x101F)); v += __int_as_float(__builtin_amdgcn_ds_swizzle(__float_as_int(v), 0x201F));
    v += __int_as_float(__builtin_amdgcn_ds_swizzle(__float_as_int(v), 0x401F));
    auto rr = __builtin_amdgcn_permlane32_swap(__float_as_uint(v), __float_as_uint(v), false, false); return __uint_as_float(rr[0]) + __uint_as_float(rr[1]);
}
__device__ __forceinline__ void phase0a(PR_LAS unsigned char* lds, int wid0, int vcu, int G, const Args& args, int zi, unsigned char* ws) {
    int tid_ = wid0 * 64 + lane_id(); asm volatile("" : "+v"(tid_));
    const int tid = tid_, lane = tid & 63, wave = tid >> 6;
#define PIN(i) ((const float*)args.in[(i) + zi])
    for (int un = vcu; un < DEPTH * (NMOD / 48); un += G) { const int l = un / (NMOD / 48), p0 = (un % (NMOD / 48)) * 48;
        smallm_unit(lds, tid, PIN(1), DM, true, PIN(3) + (size_t)l * DM * NMOD, NMOD, NMOD, false, PIN(4) + (size_t)l * NMOD, (float*)(ws + WS_MOD) + (size_t)l * NB * NMOD, NMOD, p0, 48); }
    { const int* pos = (const int*)args.in[2 + zi]; float* rope = (float*)(ws + WS_ROPE);
      for (int idx = vcu * 512 + tid; idx < T * 16; idx += G * 512) { const int t = idx >> 4, i = idx & 15;
          const float freq = exp2f(-(float)i * (13.287712379549449f / 16.0f)); const float ang = (float)pos[t] * freq;
          rope[t * 32 + i] = cosf(ang); rope[t * 32 + 16 + i] = sinf(ang); } }
    { const float* gws = PIN(7); bf16_t* gw = (bf16_t*)(ws + WS_GW);
      for (int idx = vcu * 512 + tid; idx < DEPTH * NGRP * CHUNK * CHUNK; idx += G * 512) { const int s = idx & 127, t = (idx >> 7) & 127; gw[idx] = (s <= t) ? f2bf(gws[idx]) : (bf16_t)0; } }
    PR_LAS float* scr = (PR_LAS float*)(lds + wave * 16384);
    const int gw_ = vcu * NWAVES + wave, NGW = G * NWAVES;
    constexpr int I_IN = (DM / 64) * (NIN / 32), I_UQ = (QR / 64) * (768 / 32), I_UKV = (KVR / 64) * (1024 / 32), I_OUT = (DM / 64) * (DM / 32), I_1 = (DM / 64) * (DFF / 32), I_2 = (DFF / 64) * (DM / 32);
    constexpr int I_LAYER = I_IN + I_UQ + I_UKV + I_OUT + I_1 + I_2;
    for (int it = gw_; it < DEPTH * I_LAYER; it += NGW) {
        const int l = it / I_LAYER; int r = it - l * I_LAYER; unsigned char* wl = ws + WS_W + (size_t)l * WL_STRIDE;
        if (r < I_IN) { tr_item<1>(PIN(6) + (size_t)l * DM * DIN, DIN, (bf16_t*)(wl + WL_IN), DM, 0, NIN / 32, scr, r, lane); continue; } r -= I_IN;
        if (r < I_UQ) { tr_item<2>(PIN(11) + (size_t)l * QR * 768, 768, (bf16_t*)(wl + WL_UQ), QR, 0, 768 / 32, scr, r, lane); continue; } r -= I_UQ;
        if (r < I_UKV) { tr_item<0>(PIN(12) + (size_t)l * KVR * 1024, 1024, (bf16_t*)(wl + WL_UKV), KVR, 0, 1024 / 32, scr, r, lane); continue; } r -= I_UKV;
        if (r < I_OUT) { tr_item<0>(PIN(15) + (size_t)l * DM * DM, DM, (bf16_t*)(wl + WL_OUT), DM, 0, DM / 32, scr, r, lane); continue; } r -= I_OUT;
        if (r < I_1) { tr_item<0>(PIN(17) + (size_t)l * DM * DFF, DFF, (bf16_t*)(wl + WL_1), DM, 0, DFF / 32, scr, r, lane); continue; } r -= I_1;
        tr_item<0>(PIN(18) + (size_t)l * DFF * DM, DM, (bf16_t*)(wl + WL_2), DFF, 0, DM / 32, scr, r, lane);
    }
#undef PIN
}
__device__ __forceinline__ void phase0b(PR_LAS unsigned char* lds, int wid0, int vcu, int G, const Args& args, int zi, unsigned char* ws) {
    int tid_ = wid0 * 64 + lane_id(); asm volatile("" : "+v"(tid_));
    const int tid = tid_, lane = tid & 63, wave = tid >> 6;
#define PIN(i) ((const float*)args.in[(i) + zi])
    float* MOD = (float*)(ws + WS_MOD);
    constexpr int U1 = NIN / 48, U2 = DFF / 64, NUNITS = DEPTH * (U1 + U2);
    for (int un = vcu; un < NUNITS; un += G) { const int l = un / (U1 + U2), r = un % (U1 + U2); const float* modl = MOD + (size_t)l * NB * NMOD;
        if (r < U1) smallm_unit(lds, tid, modl, NMOD, false, PIN(6) + (size_t)l * DM * DIN, DIN, DIN, true, nullptr, (float*)(ws + WS_SHW1) + (size_t)l * NB * NIN, NIN, r * 48, 48);
        else smallm_unit(lds, tid, modl + 3 * DM, NMOD, false, PIN(17) + (size_t)l * DM * DFF, DFF, DFF, false, nullptr, (float*)(ws + WS_SHW2) + (size_t)l * NB * DFF, DFF, (r - U1) * 64, 64); }
    for (int idx = vcu * 512 + tid; idx < DEPTH * NB * DM; idx += G * 512) { const int c = idx & 1023, b = (idx >> 10) & 15, l = idx >> 14; const float* m = MOD + ((size_t)l * NB + b) * NMOD;
        ((float*)(ws + WS_GM1))[idx] = PIN(5)[l * DM + c] * (1.f + m[1 * DM + c]); ((float*)(ws + WS_GM2))[idx] = PIN(16)[l * DM + c] * (1.f + m[4 * DM + c]); }
    { const float* x = PIN(0); const float* g = PIN(5); bf16_t* A = (bf16_t*)(ws + WS_A); float* ssq = (float*)(ws + WS_SSQ1);
      const int nun = NUNITS < G ? NUNITS : G; const int wgt = vcu < nun ? 7 : 12, slot0 = vcu < nun ? 7 * vcu : 7 * nun + 12 * (vcu - nun), nslot = 7 * nun + 12 * (G - nun);
      for (int sl = 0; sl < wgt; ++sl)
      for (int row = (slot0 + sl) * NWAVES + wave; row < T; row += nslot * NWAVES) { const int b = row / SEQ; const f32x4* xr = (const f32x4*)(x + (size_t)row * DM); const float* sc = MOD + (size_t)b * NMOD + DM; float s = 0.f;
#pragma unroll
          for (int j = 0; j < 4; ++j) { const f32x4 v = xr[lane + 64 * j]; s += pg8::hsq4(v); const int c = 4 * (lane + 64 * j); const f32x4 gv = *(const f32x4*)(g + c), sv = *(const f32x4*)(sc + c);
              *(pg8::u32x2*)(A + (size_t)row * DM + c) = pg8::pack4(v * gv * (sv + 1.f)); }
          s = wsum(s); if (lane < 16) ssq[(size_t)row * 16 + lane] = (lane == 0) ? s : 0.f; } }
#undef PIN
}
__device__ __forceinline__ void phase_final(int wid0, int vcu, int G, const float* g, const bf16_t* xb, float* dst) {
    int tid_ = wid0 * 64 + lane_id(); asm volatile("" : "+v"(tid_));
    const int lane = tid_ & 63, wave = tid_ >> 6;
    for (int row = vcu * NWAVES + wave; row < T; row += G * NWAVES) { const pg8::u32x4* xr = (const pg8::u32x4*)(xb + (size_t)row * (2 * DM) + DM); f32x4* yr = (f32x4*)(dst + (size_t)row * DM); f32x4 v[4]; float s = 0.f;
#pragma unroll
        for (int j = 0; j < 2; ++j) { const pg8::u32x4 w = xr[lane + 64 * j]; v[2 * j] = pg8::bf_lo4(w); v[2 * j + 1] = pg8::bf_hi4(w); s += pg8::hsq4(v[2 * j]) + pg8::hsq4(v[2 * j + 1]); }
        const float rstd = rsqrtf(wsum(s) * (1.f / DM) + EPS);
#pragma unroll
        for (int j = 0; j < 2; ++j) { const int c = 8 * (lane + 64 * j); const f32x4 g0 = *(const f32x4*)(g + c), g1 = *(const f32x4*)(g + c + 4); yr[2 * (lane + 64 * j)] = v[2 * j] * rstd * g0; yr[2 * (lane + 64 * j) + 1] = v[2 * j + 1] * rstd * g1; } }
}
}

constexpr int RING_BYTES = 131072;
constexpr int LDSCTL_OFF = 135168, MISC_OFF = LDSCTL_OFF + 320;
constexpr int LDS_BYTES = 147456;
static_assert(att::LDS_BYTES <= LDSCTL_OFF, "attention scratch below the control words");
constexpr int CW_BAR = 4096;
constexpr size_t CTL_ZERO_BYTES = 64 * 1024;

#define GAS __attribute__((address_space(1)))
#define LAS __attribute__((address_space(3)))
typedef GAS unsigned gu32;
#define RLX_AGENT __ATOMIC_RELAXED, __HIP_MEMORY_SCOPE_AGENT
#define XB_TMO      128
#define XB_XCNT(j)  (256  + 64 * (j))
#define XB_XSUB(j)  (1280 + 64 * (j))
#define XB_XGEN(j)  (2304 + 64 * (j))
#define XB_TOP      3328
#define XB_TOPGEN   3392
#define XCD_BAR_WORDS 3456
#define XB_SPIN_CAP (1u << 18)
__device__ __forceinline__ unsigned xb_ld(unsigned* p)              { return __hip_atomic_load(p, __ATOMIC_RELAXED, __HIP_MEMORY_SCOPE_AGENT); }
__device__ __forceinline__ unsigned xb_add(unsigned* p, unsigned v) { return __hip_atomic_fetch_add(p, v, __ATOMIC_RELAXED, __HIP_MEMORY_SCOPE_AGENT); }
__device__ __forceinline__ unsigned xb_xcc_id() { return (unsigned)__builtin_amdgcn_s_getreg((3 << 11) | 20) & 0xFu; }
#define XB_SPIN(cond, bar) do { unsigned _sp = 0; while (cond) { __builtin_amdgcn_s_sleep(1); \
    if ((++_sp & 255u) == 0u) { if (xb_ld(&(bar)[XB_TMO])) break; if (_sp > XB_SPIN_CAP) { atomicAdd(&(bar)[XB_TMO], 1u); break; } } } } while (0)
struct XcdBarrier { unsigned* bar; unsigned x; volatile LAS unsigned* st; };
__device__ __forceinline__ XcdBarrier xcd_barrier_post(unsigned* bar, volatile LAS unsigned* st, int wid0) {
    XcdBarrier b; b.bar = bar; b.x = xb_xcc_id(); b.st = st;
    if (wid0 == 0 && lane_id() == 0) (void)xb_add(&bar[XB_XCNT(b.x)], 1u);
    return b;
}
__device__ __forceinline__ void xcd_barrier_complete(unsigned* bar, unsigned x, unsigned& nloc, unsigned& nx) {
    const unsigned G = gridDim.x * gridDim.y * gridDim.z;
    unsigned sum, cnt, mine, sp = 0u;
    for (;;) {
        sum = 0u; cnt = 0u; mine = 0u;
#pragma unroll
        for (unsigned j = 0; j < 16; ++j) { const unsigned c = xb_ld(&bar[XB_XCNT(j)]); sum += c; cnt += (c > 0u) ? 1u : 0u; mine = (j == x) ? c : mine; }
        if (sum == G) break;
        __builtin_amdgcn_s_sleep(1);
        if ((++sp & 255u) == 0u) { if (xb_ld(&bar[XB_TMO])) break; if (sp > XB_SPIN_CAP) { atomicAdd(&bar[XB_TMO], 1u); break; } }
    }
    nloc = mine > 0u ? mine : 1u; nx = cnt > 0u ? cnt : 1u;
}
__device__ __forceinline__ void xcd_barrier(const XcdBarrier& b, int wid0) {
    asm volatile("s_waitcnt vmcnt(0)" ::: "memory");
    __syncthreads();
    if (wid0 == 0 && lane_id() == 0) {
        unsigned zo = 0; asm volatile("" : "+s"(zo));
        unsigned* bar = b.bar + zo;
        __builtin_amdgcn_s_waitcnt(0);
        unsigned nloc = b.st[0], nx = b.st[1];
        if (nloc == 0u) { xcd_barrier_complete(bar, b.x, nloc, nx); b.st[0] = nloc; b.st[1] = nx; }
        const unsigned old = xb_add(&bar[XB_XSUB(b.x)], 1u);
        const unsigned gen = old / nloc;
        if (old + 1u == (gen + 1u) * nloc) {
            __builtin_amdgcn_fence(__ATOMIC_RELEASE, "agent");
            asm volatile("s_waitcnt vmcnt(0)" ::: "memory");
            const unsigned og = xb_add(&bar[XB_TOP], 1u);
            const unsigned tg = og / nx;
            if (og + 1u == (tg + 1u) * nx) xb_add(&bar[XB_TOPGEN], 1u);
            else XB_SPIN(xb_ld(&bar[XB_TOPGEN]) == tg, bar);
            __builtin_amdgcn_fence(__ATOMIC_ACQUIRE, "agent");
            xb_add(&bar[XB_XGEN(b.x)], 1u);
            asm volatile("s_waitcnt vmcnt(0)" ::: "memory");
        } else {
            XB_SPIN(xb_ld(&bar[XB_XGEN(b.x)]) == gen, bar);
            __builtin_amdgcn_fence(__ATOMIC_ACQUIRE, "agent");
            asm volatile("s_waitcnt vmcnt(0)" ::: "memory");
        }
    }
    __syncthreads();
}

constexpr int PH_P0A = 0, PH_P0B = 1, PH_L0 = 2, PH_PER_LAYER = 7, PH_FINAL = PH_L0 + DEPTH * PH_PER_LAYER, PH_END = PH_FINAL + 1;

#ifdef PROBE_SEL
#define MK_STAMP(i) do { if (wid0 == 0 && lane_id() == 0) ((volatile LAS unsigned long long*)(L + LDSCTL_OFF + 1024))[(i)] = __builtin_amdgcn_s_memrealtime(); } while (0)
#else
#define MK_STAMP(i) do {} while (0)
#endif
#define MK_IN_(k) (lo <= (k) && (k) < hi)
#define MK_SEAM(k) do { if (MK_IN_(k) && MK_IN_((k) + 1)) xcd_barrier(bar, wid0); } while (0)
#define MK_PTRS() int zi = 0; asm volatile("" : "+s"(zi)); unsigned char* ws = args.ws + zi; float* out = args.out + zi; (void)out; (void)ws
#define INP(i) ((const float*)args.in[(i) + zi])
template <int l>
__device__ __forceinline__ void layer_phases(const Args& args, LAS unsigned char* L, const XcdBarrier& bar, int wid0, int vcu, int G, int bx, int lo, int hi) {
    constexpr int P = PH_L0 + l * PH_PER_LAYER;
    if (MK_IN_(P + 0)) { MK_STAMP(2 * (P + 0)); MK_PTRS();
        pg8::Gemm g{(bf16_t*)(ws + WS_A), (const bf16_t*)(ws + WS_W + (size_t)l * WL_STRIDE + WL_IN), T, NIN, DM}; pg8::StaticOrder S; S.init(T, NIN, G, bx);
        pg8::EpiIn E{(float*)(ws + WS_SSQ1), (float*)(ws + WS_SHW1) + (size_t)l * NB * NIN, INP(9) + l * QR, INP(10) + l * KVR, (float*)(ws + WS_ROPE), (bf16_t*)(ws + WS_U), (bf16_t*)(ws + WS_VN), (bf16_t*)(ws + WS_CQ), (bf16_t*)(ws + WS_CKV), (bf16_t*)(ws + WS_KR), (float*)(ws + WS_SSQQ)};
        pg8::gemm_phase<pg8::EpiIn, pg8::StaticOrder, true, true>(L, g, S, E, wid0); }
    MK_STAMP(2 * (P + 0) + 1); MK_SEAM(P + 0);
    if (MK_IN_(P + 1)) { MK_STAMP(2 * (P + 1)); MK_PTRS();
        { pg8::Gemm g{(bf16_t*)(ws + WS_CQ), (const bf16_t*)(ws + WS_W + (size_t)l * WL_STRIDE + WL_UQ), T, 768, QR}; pg8::StaticOrder S; S.init(T, 768, G, bx);
          pg8::EpiUp<false> E{(float*)(ws + WS_SSQQ), (float*)(ws + WS_ROPE), (bf16_t*)(ws + WS_Q), (bf16_t*)(ws + WS_KN), (bf16_t*)(ws + WS_V)};
          pg8::gemm_phase<pg8::EpiUp<false>, pg8::StaticOrder, true, true>(L, g, S, E, wid0); }
        { pg8::Gemm g{(bf16_t*)(ws + WS_CKV), (const bf16_t*)(ws + WS_W + (size_t)l * WL_STRIDE + WL_UKV), T, 1024, KVR}; pg8::KvOrder S; S.init(T, 1024, G, bx);
          pg8::EpiUp<true> E{(float*)(ws + WS_SSQQ), (float*)(ws + WS_ROPE), (bf16_t*)(ws + WS_Q), (bf16_t*)(ws + WS_KN), (bf16_t*)(ws + WS_V)};
          pg8::gemm_phase<pg8::EpiUp<true>, pg8::KvOrder, true, true>(L, g, S, E, wid0); }
        MK_STAMP(2 * (P + 1) + 1); }
    if (MK_IN_(P + 2)) { MK_STAMP(2 * (P + 2)); MK_PTRS();
        gm::gmlp_phase(L, wid0, vcu, (bf16_t*)(ws + WS_U), (bf16_t*)(ws + WS_VN), (bf16_t*)(ws + WS_GW) + (size_t)l * NGRP * CHUNK * CHUNK, INP(8) + l * NGRP * CHUNK, INP(13) + l * DG, (bf16_t*)(ws + WS_Y), (float*)(ws + WS_SSQY)); }
    MK_STAMP(2 * (P + 2) + 1); MK_SEAM(P + 2);
    if (MK_IN_(P + 3)) { MK_STAMP(2 * (P + 3)); MK_PTRS();
        att::attn_phase((LAS char*)L, wid0, vcu, (bf16_t*)(ws + WS_Q), (bf16_t*)(ws + WS_KN), (bf16_t*)(ws + WS_KR), (bf16_t*)(ws + WS_V), INP(14) + l * DG, (bf16_t*)(ws + WS_Y), (float*)(ws + WS_SSQY)); }
    MK_STAMP(2 * (P + 3) + 1); MK_SEAM(P + 3);
    if (MK_IN_(P + 4)) { MK_STAMP(2 * (P + 4)); MK_PTRS();
        pg8::Gemm g{(bf16_t*)(ws + WS_Y), (const bf16_t*)(ws + WS_W + (size_t)l * WL_STRIDE + WL_OUT), T, DM, DM}; pg8::StaticOrder S; S.init(T, DM, G, bx);
        pg8::EpiRes<true, l == 0> E{(float*)(ws + WS_SSQY), l == 0 ? (const void*)INP(0) : (const void*)out, (bf16_t*)out, (float*)(ws + WS_MOD) + (size_t)l * NB * NMOD + 2 * DM, (float*)(ws + WS_GM2) + (size_t)l * NB * DM, (bf16_t*)(ws + WS_A), (float*)(ws + WS_SSQ2)};
        pg8::gemm_phase<pg8::EpiRes<true, l == 0>, pg8::StaticOrder, true, true>(L, g, S, E, wid0); }
    MK_STAMP(2 * (P + 4) + 1); MK_SEAM(P + 4);
    if (MK_IN_(P + 5)) { MK_STAMP(2 * (P + 5)); MK_PTRS();
        pg8::Gemm g{(bf16_t*)(ws + WS_A), (const bf16_t*)(ws + WS_W + (size_t)l * WL_STRIDE + WL_1), T, DFF, DM}; pg8::StaticOrder S; S.init(T, DFF, G, bx);
        pg8::EpiFf1 E{(float*)(ws + WS_SSQ2), (float*)(ws + WS_SHW2) + (size_t)l * NB * DFF, (bf16_t*)(ws + WS_H)};
        pg8::gemm_phase<pg8::EpiFf1, pg8::StaticOrder, true, true>(L, g, S, E, wid0); }
    MK_STAMP(2 * (P + 5) + 1); MK_SEAM(P + 5);
    if (MK_IN_(P + 6)) { MK_STAMP(2 * (P + 6)); MK_PTRS();
        pg8::Gemm g{(bf16_t*)(ws + WS_H), (const bf16_t*)(ws + WS_W + (size_t)l * WL_STRIDE + WL_2), T, DM, DFF}; pg8::StaticOrder S; S.init(T, DM, G, bx);
        pg8::EpiRes<false, false> E{nullptr, (const void*)out, (bf16_t*)out, (float*)(ws + WS_MOD) + (size_t)l * NB * NMOD + 5 * DM, (l + 1 < DEPTH) ? (float*)(ws + WS_GM1) + (size_t)(l + 1) * NB * DM : nullptr, (bf16_t*)(ws + WS_A), (float*)(ws + WS_SSQ1)};
        pg8::gemm_phase<pg8::EpiRes<false, false>, pg8::StaticOrder, true, true>(L, g, S, E, wid0); }
    MK_STAMP(2 * (P + 6) + 1); MK_SEAM(P + 6);
}
__global__ void __launch_bounds__(NWAVES * 64, 2) mk_fwd(Args args) {
    extern __shared__ __attribute__((aligned(16))) unsigned char lds[];
    LAS unsigned char* L = (LAS unsigned char*)lds;
    volatile LAS unsigned* MISC = (volatile LAS unsigned*)(L + MISC_OFF);
    const int wid0 = __builtin_amdgcn_readfirstlane((int)threadIdx.x >> 6);
    const int G = gridDim.x, bx = blockIdx.x, vcu = (G % 8 == 0) ? (bx % 8) * (G / 8) + bx / 8 : bx;
    { const int t0 = wid0 * 64 + lane_id(); for (int u = t0; u < (LDS_BYTES - LDSCTL_OFF) / 4; u += NWAVES * 64) ((LAS unsigned*)(L + LDSCTL_OFF))[u] = 0u; }
    __syncthreads();
    const int lo = __builtin_amdgcn_readfirstlane(args.ph_lo), hi = __builtin_amdgcn_readfirstlane(args.ph_hi);
    unsigned* barw = (unsigned*)(args.ws + WS_CTL) + CW_BAR + __builtin_amdgcn_readfirstlane(args.li) * XCD_BAR_WORDS;
    XcdBarrier bar; bar.bar = barw; bar.x = 0; bar.st = nullptr;
    if (hi - lo > 1) bar = xcd_barrier_post(barw, MISC + 8, wid0);
    if (MK_IN_(PH_P0A)) { MK_STAMP(2 * (PH_P0A)); MK_PTRS(); pro::phase0a(L, wid0, vcu, G, args, zi, ws); }
    MK_STAMP(2 * PH_P0A + 1); MK_SEAM(PH_P0A);
    if (MK_IN_(PH_P0B)) { MK_STAMP(2 * (PH_P0B)); MK_PTRS(); pro::phase0b(L, wid0, vcu, G, args, zi, ws); }
    MK_STAMP(2 * PH_P0B + 1); MK_SEAM(PH_P0B);
    layer_phases<0>(args, L, bar, wid0, vcu, G, bx, lo, hi);
    layer_phases<1>(args, L, bar, wid0, vcu, G, bx, lo, hi);
    if (MK_IN_(PH_FINAL)) { MK_STAMP(2 * (PH_FINAL)); MK_PTRS(); pro::phase_final(wid0, vcu, G, INP(19), (const bf16_t*)out, out); }
    MK_STAMP(2 * PH_FINAL + 1);
#ifdef PROBE_SEL
    if (bx == 0 && wid0 == 0 && lane_id() == 0) {
        volatile LAS unsigned long long* st = (volatile LAS unsigned long long*)(L + LDSCTL_OFF + 1024); unsigned long long sel = 0;
        if (PROBE_SEL >= 0) sel = st[2 * PROBE_SEL + 1] - st[2 * PROBE_SEL];
        else { for (int k = 0; k < PH_FINAL; ++k) if (k != PH_L0 + 1 && k != PH_L0 + PH_PER_LAYER + 1) { int nx = k + 1; sel += st[2 * nx] - st[2 * k + 1]; } }
        const unsigned long long t0 = __builtin_amdgcn_s_memrealtime(), t1 = t0 + PROBE_MULT * sel;
        while (__builtin_amdgcn_s_memrealtime() < t1) __builtin_amdgcn_s_sleep(8);
    }
#endif
}

#ifndef ONE_LAUNCH
#define ONE_LAUNCH 1
#endif
#ifndef MK_PRO
#define MK_PRO 1
#endif
#ifndef MK_IN
#define MK_IN 1
#endif
#ifndef MK_UP
#define MK_UP 1
#endif
#ifndef MK_GMLP
#define MK_GMLP 1
#endif
#ifndef MK_ATTN
#define MK_ATTN 1
#endif
#ifndef MK_OUT
#define MK_OUT 1
#endif
#ifndef MK_FF1
#define MK_FF1 1
#endif
#ifndef MK_FF2
#define MK_FF2 1
#endif
template <class Epi> static void gemm_naive(hipStream_t st, const bf16_t* A, int lda, const bf16_t* Bt, int ldb, int M, int N, int K, const Epi& e) {
    hipLaunchKernelGGL((k_gemm_naive<Epi>), dim3(N / 64, M / 64), dim3(256), 0, st, A, lda, Bt, ldb, K, e);
}
static int g_grid = 0;
static void launch_mk(hipStream_t st, Args a, int lo, int hi, int li = 0, int flags = 0) {
    a.ph_lo = lo; a.ph_hi = hi; a.li = li; a.flags = flags;
    hipLaunchKernelGGL(mk_fwd, dim3(g_grid), dim3(NWAVES * 64), LDS_BYTES, st, a);
}
extern "C" void kernel_launch(void* const* d_in, const int* in_sizes, int n_in, void* d_out, int out_size, void* d_ws, size_t ws_size, hipStream_t stream) {
    if (n_in != 20 || out_size != T * DM || ws_size < WS_END) { fprintf(stderr, "kernel_launch: unexpected sizes n_in %d out %d ws %zu\n", n_in, out_size, ws_size); return; }
    if (g_grid == 0) {
        int dev = 0, cus = 0; hipGetDevice(&dev); hipDeviceGetAttribute(&cus, hipDeviceAttributeMultiprocessorCount, dev);
        if (hipFuncSetAttribute((const void*)mk_fwd, hipFuncAttributeMaxDynamicSharedMemorySize, LDS_BYTES) != hipSuccess) fprintf(stderr, "kernel_launch: hipFuncSetAttribute failed\n");
        g_grid = cus > 0 ? cus : 256;
    }
    const float* x = (const float*)d_in[0]; const float* c = (const float*)d_in[1]; const int* pos = (const int*)d_in[2];
    const float* w_ada = (const float*)d_in[3]; const float* b_ada = (const float*)d_in[4]; const float* g_mix = (const float*)d_in[5];
    const float* w_in = (const float*)d_in[6]; const float* g_ws = (const float*)d_in[7]; const float* g_bs = (const float*)d_in[8];
    const float* g_q = (const float*)d_in[9]; const float* g_kv = (const float*)d_in[10]; const float* w_uq = (const float*)d_in[11]; const float* w_ukv = (const float*)d_in[12];
    const float* g_og = (const float*)d_in[13]; const float* g_oa = (const float*)d_in[14]; const float* w_out = (const float*)d_in[15];
    const float* g_ffn = (const float*)d_in[16]; const float* w_ff1 = (const float*)d_in[17]; const float* w_ff2 = (const float*)d_in[18]; const float* g_fin = (const float*)d_in[19];
    unsigned char* ws = (unsigned char*)d_ws; float* out = (float*)d_out;
    float* MOD = (float*)(ws + WS_MOD); float* SHW1 = (float*)(ws + WS_SHW1); float* SHW2 = (float*)(ws + WS_SHW2); float* RT = (float*)(ws + WS_ROPE);
    float* GM1 = (float*)(ws + WS_GM1); float* GM2 = (float*)(ws + WS_GM2);
    float* SSQ1 = (float*)(ws + WS_SSQ1); float* SSQ2 = (float*)(ws + WS_SSQ2); float* SSQY = (float*)(ws + WS_SSQY); float* SSQQ = (float*)(ws + WS_SSQQ);
    bf16_t* GW = (bf16_t*)(ws + WS_GW); bf16_t* A = (bf16_t*)(ws + WS_A); bf16_t* U = (bf16_t*)(ws + WS_U); bf16_t* VN = (bf16_t*)(ws + WS_VN);
    bf16_t* CQKV = (bf16_t*)(ws + WS_CQKV); bf16_t* KR = (bf16_t*)(ws + WS_KR); bf16_t* Q = (bf16_t*)(ws + WS_Q); bf16_t* KN = (bf16_t*)(ws + WS_KN); bf16_t* V = (bf16_t*)(ws + WS_V);
    bf16_t* Y = (bf16_t*)(ws + WS_Y); bf16_t* H = (bf16_t*)(ws + WS_H); float* GV = (float*)(ws + WS_GV); float* ZL = (float*)(ws + WS_ZL); float* QRT = (float*)(ws + WS_QRT);
    auto WL = [&](int l, size_t off) { return (bf16_t*)(ws + WS_W + (size_t)l * WL_STRIDE + off); };
    Args a{}; for (int i = 0; i < 20; ++i) a.in[i] = d_in[i]; a.out = out; a.ws = ws;
    hipMemsetAsync(ws + WS_CTL, 0, CTL_ZERO_BYTES, stream);

#if ONE_LAUNCH
#ifdef PROBE_DUP
    launch_mk(stream, a, 0, PROBE_DUP + 1, 0); launch_mk(stream, a, PROBE_DUP, PROBE_DUP + 1, 1); launch_mk(stream, a, PROBE_DUP + 1, PH_END, 2);
#elif defined(PROBE_FFN2)
    launch_mk(stream, a, 0, PH_FINAL, 0); launch_mk(stream, a, PH_FINAL - 1, PH_FINAL, 1, 1); launch_mk(stream, a, PH_FINAL, PH_END, 2);
#elif defined(PROBE_FINAL)
    launch_mk(stream, a, 0, PH_FINAL, 0); launch_mk(stream, a, PH_FINAL, PH_END, 1, 2); launch_mk(stream, a, PH_FINAL, PH_END, 2);
#else
    launch_mk(stream, a, 0, PH_END);
#endif
    return;
#endif
#if MK_PRO
    launch_mk(stream, a, PH_P0A, PH_P0A + 1);
    launch_mk(stream, a, PH_P0B, PH_P0B + 1);
#else
    hipLaunchKernelGGL(k_rope_table, dim3(T * 16 / 256), dim3(256), 0, stream, pos, RT);
    hipLaunchKernelGGL(k_prep_gw, dim3(DEPTH * NGRP * CHUNK * CHUNK / 256), dim3(256), 0, stream, g_ws, GW);
    for (int l = 0; l < DEPTH; ++l) {
        hipLaunchKernelGGL(k_prep_w, dim3((NIN * DM + 255) / 256), dim3(256), 0, stream, w_in + (size_t)l * DM * DIN, DM, DIN, WL(l, WL_IN), NIN, 1);
        hipLaunchKernelGGL(k_prep_wup, dim3((NUP * KUP + 255) / 256), dim3(256), 0, stream, w_uq + (size_t)l * QR * 768, w_ukv + (size_t)l * KVR * 1024, WL(l, WL_UP));
        hipLaunchKernelGGL(k_prep_w, dim3(DM * DM / 256), dim3(256), 0, stream, w_out + (size_t)l * DM * DM, DM, DM, WL(l, WL_OUT), DM, 0);
        hipLaunchKernelGGL(k_prep_w, dim3(DFF * DM / 256), dim3(256), 0, stream, w_ff1 + (size_t)l * DM * DFF, DM, DFF, WL(l, WL_1), DFF, 0);
        hipLaunchKernelGGL(k_prep_w, dim3(DFF * DM / 256), dim3(256), 0, stream, w_ff2 + (size_t)l * DFF * DM, DFF, DM, WL(l, WL_2), DM, 0);
        hipLaunchKernelGGL(k_smallm, dim3(NMOD / 64), dim3(512), 0, stream, c, DM, 1, w_ada + (size_t)l * DM * NMOD, NMOD, NMOD, 0, b_ada + (size_t)l * NMOD, MOD + (size_t)l * NB * NMOD, NMOD, NMOD);
    }
    for (int l = 0; l < DEPTH; ++l) {
        hipLaunchKernelGGL(k_smallm, dim3(NIN / 64), dim3(512), 0, stream, MOD + (size_t)l * NB * NMOD + 0, NMOD, 0, w_in + (size_t)l * DM * DIN, DIN, DIN, 1, (const float*)nullptr, SHW1 + (size_t)l * NB * NIN, NIN, NIN);
        hipLaunchKernelGGL(k_smallm, dim3(DFF / 64), dim3(512), 0, stream, MOD + (size_t)l * NB * NMOD + 3 * DM, NMOD, 0, w_ff1 + (size_t)l * DM * DFF, DFF, DFF, 0, (const float*)nullptr, SHW2 + (size_t)l * NB * DFF, DFF, DFF);
    }
    hipLaunchKernelGGL(k_gm, dim3(DEPTH * NB * DM / 256), dim3(256), 0, stream, g_mix, MOD, 1, GM1);
    hipLaunchKernelGGL(k_gm, dim3(DEPTH * NB * DM / 256), dim3(256), 0, stream, g_ffn, MOD, 4, GM2);
    hipLaunchKernelGGL(k_modx, dim3(T / 4), dim3(256), 0, stream, x, g_mix, MOD + 1 * DM, NMOD, A, SSQ1);

#endif
    for (int l = 0; l < DEPTH; ++l) {
        const float* modl = MOD + (size_t)l * NB * NMOD; const int P = PH_L0 + l * PH_PER_LAYER;
#if MK_IN
        launch_mk(stream, a, P + 0, P + 1);
#else
        { EpiInNaive e{0, SSQ1, SHW1 + (size_t)l * NB * NIN, U, GV, ZL}; gemm_naive(stream, A, DM, WL(l, WL_IN), DM, T, NIN, DM, e); }
        hipLaunchKernelGGL(k_vn, dim3(T * NGRP / 4), dim3(256), 0, stream, GV, VN);
        hipLaunchKernelGGL(k_lat, dim3(T / 4), dim3(256), 0, stream, ZL, g_q + l * QR, g_kv + l * KVR, RT, CQKV, SSQQ, KR);
#endif
#if MK_UP
        launch_mk(stream, a, P + 1, P + 2);
#else
        { EpiUpNaive e{0, SSQQ, Q, QRT, KN, V}; gemm_naive(stream, CQKV, KUP, WL(l, WL_UP), KUP, T, NUP, KUP, e); }
        hipLaunchKernelGGL(k_rope_q, dim3(T * NH * 16 / 256), dim3(256), 0, stream, QRT, RT, Q);
#endif
#if MK_GMLP
        launch_mk(stream, a, P + 2, P + 3);
#else
        hipLaunchKernelGGL(k_gmlp_naive, dim3(T), dim3(512), 0, stream, U, VN, GW + (size_t)l * NGRP * CHUNK * CHUNK, g_bs + l * NGRP * CHUNK, g_og + l * DG, Y, SSQY);
#endif
#if MK_ATTN
        launch_mk(stream, a, P + 3, P + 4);
#else
        hipLaunchKernelGGL(k_attn_naive, dim3(T / 64, NH), dim3(64), 0, stream, Q, KN, KR, V, g_oa + l * DG, Y, SSQY);
#endif
#if MK_OUT
        launch_mk(stream, a, P + 4, P + 5);
#else
        { EpiOutNaive e{512, SSQY, l == 0 ? x : out, out, modl + 2 * DM}; gemm_naive(stream, Y, DM, WL(l, WL_OUT), DM, T, DM, DM, e); }
        hipLaunchKernelGGL(k_modx, dim3(T / 4), dim3(256), 0, stream, out, g_ffn + l * DM, modl + 4 * DM, NMOD, A, SSQ2);
#endif
#if MK_FF1
        launch_mk(stream, a, P + 5, P + 6);
#else
        { EpiFf1Naive e{0, SSQ2, SHW2 + (size_t)l * NB * DFF, H}; gemm_naive(stream, A, DM, WL(l, WL_1), DM, T, DFF, DM, e); }
#endif
#if MK_FF2
        launch_mk(stream, a, P + 6, P + 7);
#else
        { EpiFf2Naive e{0, out, modl + 5 * DM}; gemm_naive(stream, H, DFF, WL(l, WL_2), DFF, T, DM, DFF, e); }
        if (l + 1 < DEPTH) hipLaunchKernelGGL(k_modx, dim3(T / 4), dim3(256), 0, stream, out, g_mix + (l + 1) * DM, MOD + (size_t)(l + 1) * NB * NMOD + 1 * DM, NMOD, A, SSQ1);
#endif
    }
#if MK_PRO
    launch_mk(stream, a, PH_FINAL, PH_FINAL + 1);
#else
    hipLaunchKernelGGL(k_final, dim3(T / 4), dim3(256), 0, stream, out, g_fin, out);
#endif
}
```

```cpp
#include <hip/hip_runtime.h>
#define PROBE_MULT 8
#include <cstdint>
#include <cstdio>
#include <cmath>

typedef unsigned short bf16_t;
typedef short bf16x8 __attribute__((ext_vector_type(8)));
typedef float f32x4 __attribute__((ext_vector_type(4)));

constexpr int DM = 1024, NB = 16, SEQ = 2048, DEPTH = 2, T = NB * SEQ;
constexpr int DG = 512, NGRP = 8, GD = 64, CHUNK = 128, NH = 8, NOPE = 64, ROPE = 32, VD = 64;
constexpr int QR = 256, KVR = 128, DFF = 4096, DIN = 1440, NMOD = 6 * DM;
constexpr int NIN = 1536;
constexpr int NUP = 1792, KUP = 384;
constexpr float EPS = 1e-6f;
constexpr int YLD = 2 * DM;
constexpr float QSCALE = 0.10206207261596577f * 1.4426950408889634f;

constexpr size_t MiB = 1u << 20;
constexpr size_t WS_CTL = 0;
constexpr size_t WS_MOD = 1 * MiB;
constexpr size_t WS_SHW1 = 2 * MiB;
constexpr size_t WS_GM1 = 2 * MiB + 512 * 1024;
constexpr size_t WS_GM2 = 2 * MiB + 768 * 1024;
constexpr size_t WS_SHW2 = 3 * MiB;
constexpr size_t WS_ROPE = 4 * MiB;
constexpr size_t WS_SSQ1 = 8 * MiB;
constexpr size_t WS_SSQ2 = 10 * MiB;
constexpr size_t WS_SSQY = 12 * MiB;
constexpr size_t WS_SSQQ = 14 * MiB;
constexpr size_t WS_GW = 15 * MiB;
constexpr size_t WS_W = 16 * MiB;
constexpr size_t WL_IN = 0, WL_UP = 3 * MiB, WL_OUT = 4 * MiB + MiB / 2, WL_1 = 6 * MiB + MiB / 2, WL_2 = 14 * MiB + MiB / 2, WL_STRIDE = 22 * MiB + MiB / 2;
constexpr size_t WS_A = 64 * MiB;
constexpr size_t WS_U = 128 * MiB;
constexpr size_t WS_VN = 160 * MiB;
constexpr size_t WS_CQKV = 192 * MiB;
constexpr size_t WS_CQ = 192 * MiB;
constexpr size_t WS_CKV = 208 * MiB;
constexpr size_t WL_UQ = 3 * MiB, WL_UKV = 3 * MiB + MiB / 2;
constexpr size_t WS_KR = 216 * MiB;
constexpr size_t WS_Q = 218 * MiB;
constexpr size_t WS_KN = 266 * MiB;
constexpr size_t WS_V = 298 * MiB;
constexpr size_t WS_Y = 330 * MiB;
constexpr size_t WS_H = 128 * MiB;
constexpr size_t WS_GV = 394 * MiB;
constexpr size_t WS_ZL = 458 * MiB;
constexpr size_t WS_QRT = 394 * MiB;
constexpr size_t WS_DUMMY = 448 * MiB;
constexpr size_t WS_END = 512 * MiB;

__device__ __forceinline__ bf16_t f2bf(float f) { unsigned u = __float_as_uint(f); return (bf16_t)((u + 0x7fffu + ((u >> 16) & 1u)) >> 16); }
__device__ __forceinline__ float bf2f(bf16_t h) { return __uint_as_float(((unsigned)h) << 16); }
__device__ __forceinline__ float gelu_tanh(float x) { const float y2 = -2.302208198f * (x + 0.044715f * x * x * x); return x * __builtin_amdgcn_rcpf(1.f + __builtin_amdgcn_exp2f(y2)); }
__device__ __forceinline__ float wave_sum(float v) {
#pragma unroll
    for (int o = 1; o < 64; o <<= 1) v += __shfl_xor(v, o);
    return v;
}
__host__ __device__ __forceinline__ int win_src(int p) {
    if (p < 512) return p;
    if (p < 1024) { const int q = p - 512, tile = q >> 8, r = q & 255, bj = r >> 7, wc = (r >> 5) & 3, j = r & 31; return 512 + tile * 256 + 64 * wc + 32 * bj + j; }
    if (p < 1408) return p;
    if (p < 1440) { const int j = p - 1408, fq = j >> 3, n = (j >> 2) & 1, i = j & 3; return 1408 + 16 * n + 4 * fq + i; }
    return -1;
}
__host__ __device__ __forceinline__ int wup_qcol(int p) {
    const int G = p >> 5, h = G / 3, gi = G - 3 * h, j = p & 31;
    if (gi < 2) return p;
    const int fq = j >> 3, n = (j >> 2) & 1, i = j & 3; return h * 96 + 64 + 16 * n + 4 * fq + i;
}

__global__ void k_rope_table(const int* pos, float* rope) {
    const int idx = blockIdx.x * blockDim.x + threadIdx.x; if (idx >= T * 16) return;
    const int t = idx >> 4, i = idx & 15;
    const float freq = powf(10000.0f, -(float)(2 * i) / 32.0f);
    const float ang = (float)pos[t] * freq;
    rope[t * 32 + i] = cosf(ang); rope[t * 32 + 16 + i] = sinf(ang);
}
__global__ void k_prep_w(const float* W, int K, int N, bf16_t* out, int Nphys, int mode) {
    const size_t idx = (size_t)blockIdx.x * blockDim.x + threadIdx.x; if (idx >= (size_t)Nphys * K) return;
    const int p = (int)(idx / K), k = (int)(idx % K);
    const int s = mode == 1 ? win_src(p) : p;
    out[idx] = (s >= 0 && s < N) ? f2bf(W[(size_t)k * N + s]) : (bf16_t)0;
}
__global__ void k_prep_wup(const float* wuq, const float* wukv, bf16_t* out) {
    const int idx = blockIdx.x * blockDim.x + threadIdx.x; if (idx >= NUP * KUP) return;
    const int p = idx / KUP, k = idx % KUP; float v = 0.f;
    if (p < 768) { if (k < 256) v = wuq[(size_t)k * 768 + wup_qcol(p)]; }
    else { if (k >= 256) v = wukv[(size_t)(k - 256) * 1024 + (p - 768)]; }
    out[idx] = f2bf(v);
}
__global__ void k_prep_gw(const float* ws, bf16_t* gw) {
    const int idx = blockIdx.x * blockDim.x + threadIdx.x; if (idx >= DEPTH * NGRP * CHUNK * CHUNK) return;
    const int s = idx & 127, t = (idx >> 7) & 127;
    gw[idx] = (s <= t) ? f2bf(ws[idx]) : (bf16_t)0;
}
__global__ __launch_bounds__(512) void k_smallm(const float* in, int in_stride, int act, const float* W, int ldw, int N, int mode, const float* bias, float* out, int out_stride, int Nphys) {
    __shared__ float sin_[1024 * 16];
    __shared__ float red[8 * 64 * 16];
    const int tid = threadIdx.x, lane = tid & 63, wave = tid >> 6;
    for (int e = tid; e < 16 * 1024; e += 512) { const int b = e >> 10, k = e & 1023; float v = in[(size_t)b * in_stride + k]; if (act) v = v / (1.f + __expf(-v)); sin_[k * 16 + b] = v; }
    __syncthreads();
    const int p = blockIdx.x * 64 + lane; const int s = (p < Nphys) ? (mode == 1 ? win_src(p) : p) : -1; const bool ok = (s >= 0 && s < N);
    float acc[16];
#pragma unroll
    for (int b = 0; b < 16; ++b) acc[b] = 0.f;
    for (int k = wave * 128; k < wave * 128 + 128; ++k) {
        const float w = ok ? W[(size_t)k * ldw + s] : 0.f;
        const f32x4* sp = (const f32x4*)(sin_ + k * 16);
#pragma unroll
        for (int q = 0; q < 4; ++q) { const f32x4 v = sp[q]; acc[4 * q] += v[0] * w; acc[4 * q + 1] += v[1] * w; acc[4 * q + 2] += v[2] * w; acc[4 * q + 3] += v[3] * w; }
    }
#pragma unroll
    for (int b = 0; b < 16; ++b) red[(wave * 64 + lane) * 16 + b] = acc[b];
    __syncthreads();
    for (int e = tid; e < 64 * 16; e += 512) { const int l = e >> 4, b = e & 15; float sum = 0.f;
#pragma unroll
        for (int w = 0; w < 8; ++w) sum += red[(w * 64 + l) * 16 + b];
        const int pp = blockIdx.x * 64 + l; if (pp < Nphys) out[(size_t)b * out_stride + pp] = sum + (bias ? bias[pp] : 0.f); }
}
__global__ __launch_bounds__(256) void k_modx(const float* x, const float* g, const float* sc  , int sc_stride, bf16_t* A, float* ssq) {
    const int row = blockIdx.x * 4 + (threadIdx.x >> 6), lane = threadIdx.x & 63; if (row >= T) return;
    const int b = row / SEQ; const f32x4* xr = (const f32x4*)(x + (size_t)row * DM); float s = 0.f;
#pragma unroll
    for (int j = 0; j < 4; ++j) { const f32x4 v = xr[lane + 64 * j]; s += v[0] * v[0] + v[1] * v[1] + v[2] * v[2] + v[3] * v[3];
        const int c = 4 * (lane + 64 * j); const f32x4 gv = *(const f32x4*)(g + c), sv = *(const f32x4*)(sc + (size_t)b * sc_stride + c);
        unsigned lo = f2bf(v[0] * gv[0] * (1.f + sv[0])) | ((unsigned)f2bf(v[1] * gv[1] * (1.f + sv[1])) << 16);
        unsigned hi = f2bf(v[2] * gv[2] * (1.f + sv[2])) | ((unsigned)f2bf(v[3] * gv[3] * (1.f + sv[3])) << 16);
        *(uint2*)(A + (size_t)row * DM + c) = make_uint2(lo, hi); }
    s = wave_sum(s);
    if (lane < 16) ssq[(size_t)row * 16 + lane] = (lane == 0) ? s : 0.f;
}
__global__ __launch_bounds__(256) void k_final(const float* x, const float* g, float* out) {
    const int row = blockIdx.x * 4 + (threadIdx.x >> 6), lane = threadIdx.x & 63; if (row >= T) return;
    const f32x4* xr = (const f32x4*)(x + (size_t)row * DM); f32x4 v[4]; float s = 0.f;
#pragma unroll
    for (int j = 0; j < 4; ++j) { v[j] = xr[lane + 64 * j]; s += v[j][0] * v[j][0] + v[j][1] * v[j][1] + v[j][2] * v[j][2] + v[j][3] * v[j][3]; }
    const float rstd = rsqrtf(wave_sum(s) * (1.f / DM) + EPS);
#pragma unroll
    for (int j = 0; j < 4; ++j) { const int c = 4 * (lane + 64 * j); const f32x4 gv = *(const f32x4*)(g + c); *(f32x4*)(out + (size_t)row * DM + c) = v[j] * rstd * gv; }
}

template <class Epi>
__global__ __launch_bounds__(256) void k_gemm_naive(const bf16_t* A, int lda, const bf16_t* Bt, int ldb, int K, Epi epi) {
    const int wave = threadIdx.x >> 6, lane = threadIdx.x & 63, fr = lane & 15, fq = lane >> 4;
    const int row0 = blockIdx.y * 64 + wave * 16, col0 = blockIdx.x * 64;
    f32x4 acc[4];
#pragma unroll
    for (int n = 0; n < 4; ++n) acc[n] = (f32x4){0.f, 0.f, 0.f, 0.f};
    const bf16_t* ap = A + (size_t)(row0 + fr) * lda + 8 * fq;
    const bf16_t* bp = Bt + (size_t)(col0 + fr) * ldb + 8 * fq;
    for (int k0 = 0; k0 < K; k0 += 32) {
        if (Epi::HAS_MID) { if (k0 == epi.ksplit) {
#pragma unroll
            for (int r = 0; r < 4; ++r) { const float m = epi.mid(row0 + 4 * fq + r);
#pragma unroll
                for (int n = 0; n < 4; ++n) acc[n][r] *= m; } } }
        const bf16x8 a = *(const bf16x8*)(ap + k0);
#pragma unroll
        for (int n = 0; n < 4; ++n) { const bf16x8 b = *(const bf16x8*)(bp + (size_t)n * 16 * ldb + k0); acc[n] = __builtin_amdgcn_mfma_f32_16x16x32_bf16(a, b, acc[n], 0, 0, 0); }
    }
#pragma unroll
    for (int r = 0; r < 4; ++r) { const int row = row0 + 4 * fq + r; const float rs = epi.rowscale(row);
#pragma unroll
        for (int n = 0; n < 4; ++n) epi(row, col0 + 16 * n + fr, acc[n][r], rs); }
}
__device__ __forceinline__ float sum16(const float* p) { float s = 0.f;
#pragma unroll
    for (int i = 0; i < 16; ++i) s += p[i]; return s; }
__device__ __forceinline__ float sum8(const float* p) { float s = 0.f;
#pragma unroll
    for (int i = 0; i < 8; ++i) s += p[i]; return s; }
__device__ __forceinline__ float sum4(const float* p) { return (p[0] + p[1]) + (p[2] + p[3]); }

struct EpiInNaive {
    static constexpr bool HAS_MID = false; int ksplit;
    const float* ssq1; const float* shw1; bf16_t* U; float* GV; float* ZL;
    __device__ float mid(int) const { return 1.f; }
    __device__ float rowscale(int row) const { return rsqrtf(sum16(ssq1 + (size_t)row * 16) * (1.f / DM) + EPS); }
    __device__ void operator()(int row, int p, float acc, float rs) const {
        const int L = win_src(p); if (L < 0) return;
        const float z = rs * acc + shw1[(row / SEQ) * NIN + p];
        if (L < 512) U[(size_t)row * 512 + L] = f2bf(gelu_tanh(z));
        else if (L < 1024) GV[(size_t)row * 512 + (L - 512)] = gelu_tanh(z);
        else ZL[(size_t)row * 416 + (L - 1024)] = z;
    }
};
struct EpiUpNaive {
    static constexpr bool HAS_MID = false; int ksplit;
    const float* ssqq; bf16_t* Q; float* QRT; bf16_t* KN; bf16_t* V;
    __device__ float mid(int) const { return 1.f; }
    __device__ float rowscale(int) const { return 1.f; }
    __device__ void operator()(int row, int p, float acc, float) const {
        if (p < 768) { const float rq = rsqrtf(sum4(ssqq + (size_t)row * 8) * (1.f / QR) + EPS); const float v = acc * rq * QSCALE;
            const int L = wup_qcol(p), h = L / 96, d = L - 96 * h;
            if (d < 64) Q[(size_t)row * 768 + L] = f2bf(v); else QRT[(size_t)row * 256 + h * 32 + (d - 64)] = v; }
        else { const float rk = rsqrtf(sum4(ssqq + (size_t)row * 8 + 4) * (1.f / KVR) + EPS); const float v = acc * rk;
            const int c = p - 768, h = c >> 7, d = c & 127;
            if (d < 64) KN[(size_t)row * 512 + h * 64 + d] = f2bf(v); else V[(size_t)row * 512 + h * 64 + (d - 64)] = f2bf(v); }
    }
};
struct EpiOutNaive {
    static constexpr bool HAS_MID = true; int ksplit;
    const float* ssqy; const float* xin; float* xout; const float* gate;
    __device__ float rg(int row) const { return rsqrtf(sum8(ssqy + (size_t)row * 16) * (1.f / 512) + EPS); }
    __device__ float ra(int row) const { return rsqrtf(sum8(ssqy + (size_t)row * 16 + 8) * (1.f / 512) + EPS); }
    __device__ float mid(int row) const { return rg(row) / ra(row); }
    __device__ float rowscale(int row) const { return ra(row); }
    __device__ void operator()(int row, int n, float acc, float rs) const {
        const size_t i = (size_t)row * DM + n; xout[i] = xin[i] + gate[(size_t)(row / SEQ) * NMOD + n] * (rs * acc);
    }
};
struct EpiFf1Naive {
    static constexpr bool HAS_MID = false; int ksplit;
    const float* ssq2; const float* shw2; bf16_t* H;
    __device__ float mid(int) const { return 1.f; }
    __device__ float rowscale(int row) const { return rsqrtf(sum16(ssq2 + (size_t)row * 16) * (1.f / DM) + EPS); }
    __device__ void operator()(int row, int n, float acc, float rs) const {
        const float z = rs * acc + shw2[(row / SEQ) * DFF + n]; const float r = fmaxf(z, 0.f); H[(size_t)row * DFF + n] = f2bf(r * r);
    }
};
struct EpiFf2Naive {
    static constexpr bool HAS_MID = false; int ksplit;
    float* x; const float* gate;
    __device__ float mid(int) const { return 1.f; }
    __device__ float rowscale(int) const { return 1.f; }
    __device__ void operator()(int row, int n, float acc, float) const {
        const size_t i = (size_t)row * DM + n; x[i] = x[i] + gate[(size_t)(row / SEQ) * NMOD + n] * acc;
    }
};

__global__ __launch_bounds__(256) void k_vn(const float* GV, bf16_t* VN) {
    const int w = blockIdx.x * 4 + (threadIdx.x >> 6), lane = threadIdx.x & 63; if (w >= T * NGRP) return;
    const int row = w >> 3, g = w & 7; const float v = GV[(size_t)row * 512 + g * 64 + lane];
    const float mu = wave_sum(v) * (1.f / 64); const float d = v - mu; const float var = wave_sum(d * d) * (1.f / 64);
    VN[(size_t)row * 512 + g * 64 + lane] = f2bf(d * rsqrtf(var + EPS));
}
__global__ __launch_bounds__(256) void k_lat(const float* ZL, const float* gq, const float* gkv, const float* rope, bf16_t* CQKV, float* ssqq, bf16_t* KR) {
    const int row = blockIdx.x * 4 + (threadIdx.x >> 6), lane = threadIdx.x & 63; if (row >= T) return;
    const float* z = ZL + (size_t)row * 416; float sq = 0.f, sk = 0.f;
#pragma unroll
    for (int j = 0; j < 4; ++j) { const int c = lane + 64 * j; const float v = z[c]; sq += v * v; CQKV[(size_t)row * KUP + c] = f2bf(v * gq[c]); }
#pragma unroll
    for (int j = 0; j < 2; ++j) { const int c = lane + 64 * j; const float v = z[256 + c]; sk += v * v; CQKV[(size_t)row * KUP + 256 + c] = f2bf(v * gkv[c]); }
    sq = wave_sum(sq); sk = wave_sum(sk);
    if (lane < 8) ssqq[(size_t)row * 8 + lane] = (lane == 0) ? sq : (lane == 4) ? sk : 0.f;
    if (lane < 16) { const float x1 = z[384 + lane], x2 = z[384 + 16 + lane], c = rope[(size_t)row * 32 + lane], s = rope[(size_t)row * 32 + 16 + lane];
        KR[(size_t)row * 32 + lane] = f2bf(x1 * c - x2 * s); KR[(size_t)row * 32 + 16 + lane] = f2bf(x1 * s + x2 * c); }
}
__global__ void k_rope_q(const float* QRT, const float* rope, bf16_t* Q) {
    const int idx = blockIdx.x * blockDim.x + threadIdx.x; if (idx >= T * NH * 16) return;
    const int r = idx & 15, h = (idx >> 4) & 7, row = idx >> 7;
    const float x1 = QRT[(size_t)row * 256 + h * 32 + r], x2 = QRT[(size_t)row * 256 + h * 32 + 16 + r], c = rope[(size_t)row * 32 + r], s = rope[(size_t)row * 32 + 16 + r];
    Q[(size_t)row * 768 + h * 96 + 64 + r] = f2bf(x1 * c - x2 * s); Q[(size_t)row * 768 + h * 96 + 80 + r] = f2bf(x1 * s + x2 * c);
}
__global__ __launch_bounds__(512) void k_gmlp_naive(const bf16_t* U, const bf16_t* VN, const bf16_t* GW  , const float* bs  , const float* gog, bf16_t* Y, float* ssqy) {
    const int row = blockIdx.x, g = threadIdx.x >> 6, d = threadIdx.x & 63, c = g * 64 + d;
    const int tt = row & 127, t0 = row - tt;
    const bf16_t* w = GW + ((size_t)g * CHUNK + tt) * CHUNK; float sum = 0.f;
    for (int s = 0; s <= tt; ++s) sum += bf2f(w[s]) * bf2f(VN[(size_t)(t0 + s) * 512 + c]);
    const float y = bf2f(U[(size_t)row * 512 + c]) * (sum + bs[g * CHUNK + tt]);
    Y[(size_t)row * DM + c] = f2bf(y * gog[c]);
    const float q = wave_sum(y * y); if (d == 0) ssqy[(size_t)row * 16 + g] = q;
}
__global__ __launch_bounds__(64) void k_attn_naive(const bf16_t* Q, const bf16_t* KN, const bf16_t* KR, const bf16_t* V, const float* goa, bf16_t* Y, float* ssqy) {
    const int h = blockIdx.y, row = blockIdx.x * 64 + threadIdx.x, b = row / SEQ, i = row - b * SEQ;
    const int iend = (blockIdx.x * 64 % SEQ) + 63;
    float q[96];
#pragma unroll
    for (int d8 = 0; d8 < 12; ++d8) { const bf16x8 v = *(const bf16x8*)(Q + (size_t)row * 768 + h * 96 + d8 * 8);
#pragma unroll
        for (int j = 0; j < 8; ++j) q[d8 * 8 + j] = bf2f((bf16_t)v[j]); }
    float o[64];
#pragma unroll
    for (int d = 0; d < 64; ++d) o[d] = 0.f;
    float m = -1e30f, l = 0.f;
    const size_t kb = (size_t)b * SEQ;
    for (int j = 0; j <= iend; ++j) {
        const bf16_t* kn = KN + (kb + j) * 512 + h * 64; const bf16_t* kr = KR + (kb + j) * 32; const bf16_t* vv = V + (kb + j) * 512 + h * 64;
        float s = 0.f;
#pragma unroll
        for (int d8 = 0; d8 < 8; ++d8) { const bf16x8 kv = *(const bf16x8*)(kn + d8 * 8);
#pragma unroll
            for (int jj = 0; jj < 8; ++jj) s += q[d8 * 8 + jj] * bf2f((bf16_t)kv[jj]); }
#pragma unroll
        for (int d8 = 0; d8 < 4; ++d8) { const bf16x8 kv = *(const bf16x8*)(kr + d8 * 8);
#pragma unroll
            for (int jj = 0; jj < 8; ++jj) s += q[64 + d8 * 8 + jj] * bf2f((bf16_t)kv[jj]); }
        if (j > i) s = -1e30f;
        const float mn = fmaxf(m, s), alpha = exp2f(m - mn), p = (j > i) ? 0.f : exp2f(s - mn);
        l = l * alpha + p; m = mn;
#pragma unroll
        for (int d8 = 0; d8 < 8; ++d8) { const bf16x8 v8 = *(const bf16x8*)(vv + d8 * 8);
#pragma unroll
            for (int jj = 0; jj < 8; ++jj) o[d8 * 8 + jj] = o[d8 * 8 + jj] * alpha + p * bf2f((bf16_t)v8[jj]); }
    }
    const float inv = 1.f / l; float sq = 0.f;
#pragma unroll
    for (int d8 = 0; d8 < 8; ++d8) { unsigned w[4];
#pragma unroll
        for (int jj = 0; jj < 8; jj += 2) { const float y0 = o[d8 * 8 + jj] * inv, y1 = o[d8 * 8 + jj + 1] * inv; sq += y0 * y0 + y1 * y1;
            w[jj >> 1] = f2bf(y0 * goa[h * 64 + d8 * 8 + jj]) | ((unsigned)f2bf(y1 * goa[h * 64 + d8 * 8 + jj + 1]) << 16); }
        *(uint4*)(Y + (size_t)row * DM + 512 + h * 64 + d8 * 8) = make_uint4(w[0], w[1], w[2], w[3]); }
    ssqy[(size_t)row * 16 + 8 + h] = sq;
}

__global__ void k_gm(const float* g  , const float* mod, int chunk, float* gmt) {
    const int idx = blockIdx.x * blockDim.x + threadIdx.x; if (idx >= DEPTH * NB * DM) return;
    const int c = idx & 1023, b = (idx >> 10) & 15, l = idx >> 14;
    gmt[idx] = g[l * DM + c] * (1.f + mod[((size_t)l * NB + b) * NMOD + chunk * DM + c]);
}
__device__ __forceinline__ int lane_id() { int l; asm volatile("v_mbcnt_lo_u32_b32 %0, -1, 0\n\tv_mbcnt_hi_u32_b32 %0, -1, %0" : "=v"(l)); return l; }
__device__ __forceinline__ float swz_xor16(float v) { return __int_as_float(__builtin_amdgcn_ds_swizzle(__float_as_int(v), 0x401F)); }
__device__ __forceinline__ float swz_xor1(float v) { return __int_as_float(__builtin_amdgcn_ds_swizzle(__float_as_int(v), 0x041F)); }
namespace pg8 {
#define PG8_LAS __attribute__((address_space(3)))
typedef unsigned u32x4 __attribute__((ext_vector_type(4)));
typedef unsigned u32x2 __attribute__((ext_vector_type(2)));
constexpr int BM = 256, BK = 64, HALF = 128, HTB = HALF * BK * 2  , STAGE_BYTES = 8 * HTB, NXCD = 8, WGM = 8;

__host__ __device__ __forceinline__ int lds_byte(int r, int c) { const int st = (r >> 4) * 2 + (c >> 5), rr = r & 15, cc = c & 31, ob = rr * 64 + cc * 2; return st * 1024 + (ob ^ (((ob >> 9) & 1) << 5)); }
__host__ __device__ __forceinline__ void stage_rc(int b, int& R, int& C) { const int st = b / 1024, sb = b % 1024, swz = sb ^ (((sb >> 9) & 1) << 5); R = (st >> 1) * 16 + swz / 64; C = (st & 1) * 32 + (swz % 64) / 2; }
__host__ __device__ __forceinline__ int perm32(int rho) { const int n = rho >> 4, i = rho & 15; return 8 * (i >> 2) + 4 * n + (i & 3); }

struct Unit { int pm, pn; };
struct Gemm { const bf16_t* A; const bf16_t* Bt; int M, N, K, lda; };

struct StaticOrder {
    int nM, nN, nwg, G, c;
    __host__ __device__ void init(int M, int N, int G_, int c_) { nM = M / BM; nN = N / BM; nwg = nM * nN; G = G_; c = c_; }
    __host__ __device__ bool next(int i, Unit& u) const {
        const long L = (long)i * G + c; if (L >= nwg) return false;
        int wgid = (int)L; { const int q = nwg / NXCD, r = nwg % NXCD, xcd = wgid % NXCD, off = wgid / NXCD; wgid = (xcd < r ? xcd * (q + 1) : r * (q + 1) + (xcd - r) * q) + off; }
        const int nig = WGM * nN, gid = wgid / nig, fm = gid * WGM, gsz = (nM - fm) < WGM ? (nM - fm) : WGM;
        u.pm = fm + ((wgid % nig) % gsz); u.pn = (wgid % nig) / gsz; return true;
    }
    __device__ __forceinline__ void a_ready(const Unit&) const {}
    __device__ __forceinline__ void done(const Unit&) const {}
};

struct KvOrder : StaticOrder {
    __host__ __device__ bool next(int i, Unit& u) const {
        if (G != 256 || nwg != 512) return StaticOrder::next(i, u);
        StaticOrder t = *this; t.G = 1 << 30;
        if (c < 128) { if (i > 0) return false; t.c = c; } else { if (i > 2) return false; t.c = (i == 0) ? c : 256 + 2 * (c - 128) + (i - 1); }
        return t.next(0, u);
    }
};
__device__ __forceinline__ unsigned cvt_pk_bf16(float lo, float hi) { unsigned r; asm volatile("v_cvt_pk_bf16_f32 %0, %1, %2" : "=v"(r) : "v"(lo), "v"(hi)); return r; }
__device__ __forceinline__ u32x4 pack8(const f32x4& a, const f32x4& b) { u32x4 w; w.x = cvt_pk_bf16(a[0], a[1]); w.y = cvt_pk_bf16(a[2], a[3]); w.z = cvt_pk_bf16(b[0], b[1]); w.w = cvt_pk_bf16(b[2], b[3]); return w; }
__device__ __forceinline__ u32x2 pack4(const f32x4& a) { u32x2 w; w.x = cvt_pk_bf16(a[0], a[1]); w.y = cvt_pk_bf16(a[2], a[3]); return w; }
__device__ __forceinline__ float hsum4(const f32x4& a) { return (a[0] + a[1]) + (a[2] + a[3]); }
__device__ __forceinline__ float hsq4(const f32x4& a) { return (a[0] * a[0] + a[1] * a[1]) + (a[2] * a[2] + a[3] * a[3]); }
__device__ __forceinline__ float ld_sum16(const float* p) { const f32x4* q = (const f32x4*)p; return (hsum4(q[0]) + hsum4(q[1])) + (hsum4(q[2]) + hsum4(q[3])); }
__device__ __forceinline__ float ld_sum8(const float* p) { const f32x4* q = (const f32x4*)p; return hsum4(q[0]) + hsum4(q[1]); }
__device__ __forceinline__ float ld_sum4(const float* p) { return hsum4(*(const f32x4*)p); }
__device__ __forceinline__ float quad_sum(float s) { s += swz_xor16(s); auto rr = __builtin_amdgcn_permlane32_swap(__float_as_uint(s), __float_as_uint(s), false, false); return __uint_as_float(rr[0]) + __uint_as_float(rr[1]); }
__device__ __forceinline__ float row_sum16(const float* ssq, int row, int fq) { return quad_sum(hsum4(*(const f32x4*)(ssq + (size_t)row * 16 + 4 * fq))); }
__device__ __forceinline__ void row_sum8x2(const float* ssq, int row, int fq, float& sg, float& sa) {
    float s = hsum4(*(const f32x4*)(ssq + (size_t)row * 16 + 4 * fq)); s += swz_xor16(s);
    auto rr = __builtin_amdgcn_permlane32_swap(__float_as_uint(s), __float_as_uint(s), false, false); sg = __uint_as_float(rr[0]); sa = __uint_as_float(rr[1]); }
#define PG8_FENCE() asm volatile("" ::: "memory")
#define PG8_RSTD8(rsv, ssqp, invn) do { f32x4 q_[2][4]; \
    _Pragma("unroll") for (int ai = 0; ai < 2; ++ai) _Pragma("unroll") for (int m = 0; m < 4; ++m) q_[ai][m] = *(const f32x4*)((ssqp) + (size_t)PG8_ROW(u, ai, m) * 16 + 4 * fq); \
    _Pragma("unroll") for (int ai = 0; ai < 2; ++ai) _Pragma("unroll") for (int m = 0; m < 4; ++m) rsv[ai][m] = rsqrtf(quad_sum(hsum4(q_[ai][m])) * (invn) + EPS); \
    PG8_FENCE(); } while (0)
__device__ __forceinline__ f32x4 gelu4(const f32x4& v) { f32x4 o; o[0] = gelu_tanh(v[0]); o[1] = gelu_tanh(v[1]); o[2] = gelu_tanh(v[2]); o[3] = gelu_tanh(v[3]); return o; }

#define PG8_ROW(u, ai, m) ((u).pm * BM + (ai) * HALF + wr * 64 + (m) * 16 + fr)

template <class V, class P> __device__ __forceinline__ V ldb(const P* p, unsigned boff) { return *(const V*)((const char*)p + boff); }
template <class V, class P> __device__ __forceinline__ void stb(P* p, unsigned boff, const V& v) { *(V*)((char*)p + boff) = v; }
#undef PG8_RSTD8
#define PG8_RSTD8(rsv, ssqp, invn) do { f32x4 q_[2][4]; \
    _Pragma("unroll") for (int ai = 0; ai < 2; ++ai) _Pragma("unroll") for (int m = 0; m < 4; ++m) q_[ai][m] = ldb<f32x4>((ssqp), (unsigned)(PG8_ROW(u, ai, m) * 64 + 16 * fq)); \
    _Pragma("unroll") for (int ai = 0; ai < 2; ++ai) _Pragma("unroll") for (int m = 0; m < 4; ++m) rsv[ai][m] = rsqrtf(quad_sum(hsum4(q_[ai][m])) * (invn) + EPS); \
    PG8_FENCE(); } while (0)

struct EpiIn {
    static constexpr bool PERM = true, AFTER_DRAIN = false, HAS_MID = false; static constexpr int MID_T = -1;
    const float* ssq1; const float* shw1; const float* gq; const float* gkv; const float* rope;
    bf16_t* U; bf16_t* VN; bf16_t* CQ; bf16_t* CKV; bf16_t* KR; float* ssqq;
    __device__ __forceinline__ void mid(f32x4 (&)[2][2][4][2], const Unit&, int, int) const {}
    __device__ __forceinline__ void operator()(const f32x4 (&acc)[2][2][4][2], const Unit& u, int wr, int wc, int fr, int fq) const {
        { const int l_ = lane_id(); fr = l_ & 15; fq = l_ >> 4; }
        const int b = u.pm >> 3, pc0 = u.pn * BM + wc * 32 + 8 * fq;
        f32x4 sh[2][2];
#pragma unroll
        for (int bj = 0; bj < 2; ++bj)
#pragma unroll
            for (int n = 0; n < 2; ++n) sh[bj][n] = ldb<f32x4>(shw1, (unsigned)((b * NIN + pc0 + bj * HALF + 4 * n) * 4));
        float rsv[2][4]; PG8_RSTD8(rsv, ssq1, 1.f / DM);
        if (u.pn < 2) {
#pragma unroll
            for (int ai = 0; ai < 2; ++ai)
#pragma unroll
                for (int m = 0; m < 4; ++m) { const int row = PG8_ROW(u, ai, m); const float rs = rsv[ai][m];
#pragma unroll
                    for (int bj = 0; bj < 2; ++bj) { const f32x4 v0 = gelu4(acc[ai][bj][m][0] * rs + sh[bj][0]), v1 = gelu4(acc[ai][bj][m][1] * rs + sh[bj][1]);
                        stb(U, (unsigned)((row * 512 + pc0 + bj * HALF) * 2), pack8(v0, v1)); } }
        } else if (u.pn < 4) {
#pragma unroll
            for (int ai = 0; ai < 2; ++ai)
#pragma unroll
                for (int m = 0; m < 4; ++m) { const int row = PG8_ROW(u, ai, m); const float rs = rsv[ai][m];
                    f32x4 g[2][2]; float s = 0.f;
#pragma unroll
                    for (int bj = 0; bj < 2; ++bj)
#pragma unroll
                        for (int n = 0; n < 2; ++n) { g[bj][n] = gelu4(acc[ai][bj][m][n] * rs + sh[bj][n]); s += hsum4(g[bj][n]); }
                    const float mu = quad_sum(s) * (1.f / 64); float q = 0.f;
#pragma unroll
                    for (int bj = 0; bj < 2; ++bj)
#pragma unroll
                        for (int n = 0; n < 2; ++n) { g[bj][n] = g[bj][n] - mu; q += hsq4(g[bj][n]); }
                    const float rstd = rsqrtf(quad_sum(q) * (1.f / 64) + EPS);
#pragma unroll
                    for (int bj = 0; bj < 2; ++bj) stb(VN, (unsigned)((row * 512 + (u.pn - 2) * 256 + 64 * wc + 32 * bj + 8 * fq) * 2), pack8(g[bj][0] * rstd, g[bj][1] * rstd)); }
        } else if (u.pn == 4) {
            f32x4 gv[2][2];
#pragma unroll
            for (int bj = 0; bj < 2; ++bj)
#pragma unroll
                for (int n = 0; n < 2; ++n) gv[bj][n] = ldb<f32x4>(gq, (unsigned)((bj * HALF + wc * 32 + 8 * fq + 4 * n) * 4));
#pragma unroll
            for (int ai = 0; ai < 2; ++ai)
#pragma unroll
                for (int m = 0; m < 4; ++m) { const int row = PG8_ROW(u, ai, m); const float rs = rsv[ai][m];
                    float ss = 0.f;
#pragma unroll
                    for (int bj = 0; bj < 2; ++bj) { const f32x4 v0 = acc[ai][bj][m][0] * rs + sh[bj][0], v1 = acc[ai][bj][m][1] * rs + sh[bj][1]; ss += hsq4(v0) + hsq4(v1);
                        stb(CQ, (unsigned)((row * QR + bj * HALF + wc * 32 + 8 * fq) * 2), pack8(v0 * gv[bj][0], v1 * gv[bj][1])); }
                    ss = quad_sum(ss); if (fq == 0) stb(ssqq, (unsigned)((row * 8 + wc) * 4), ss); }
        } else {
            const f32x4 gk0 = ldb<f32x4>(gkv, (unsigned)((wc * 32 + 8 * fq) * 4)), gk1 = ldb<f32x4>(gkv, (unsigned)((wc * 32 + 8 * fq + 4) * 4));
#pragma unroll
            for (int ai = 0; ai < 2; ++ai)
#pragma unroll
                for (int m = 0; m < 4; ++m) { const int row = PG8_ROW(u, ai, m); const float rs = rsv[ai][m];
                    const f32x4 v0 = acc[ai][0][m][0] * rs + sh[0][0], v1 = acc[ai][0][m][1] * rs + sh[0][1];
                    float ss = quad_sum(hsq4(v0) + hsq4(v1)); if (fq == 0) stb(ssqq, (unsigned)((row * 8 + 4 + wc) * 4), ss);
                    stb(CKV, (unsigned)((row * KVR + wc * 32 + 8 * fq) * 2), pack8(v0 * gk0, v1 * gk1));
                    if (wc == 0) { const f32x4 x1 = acc[ai][1][m][0] * rs + sh[1][0], x2 = acc[ai][1][m][1] * rs + sh[1][1];
                        const f32x4 c = ldb<f32x4>(rope, (unsigned)((row * 32 + 4 * fq) * 4)), s = ldb<f32x4>(rope, (unsigned)((row * 32 + 16 + 4 * fq) * 4));
                        stb(KR, (unsigned)((row * 32 + 4 * fq) * 2), pack4(x1 * c - x2 * s)); stb(KR, (unsigned)((row * 32 + 16 + 4 * fq) * 2), pack4(x1 * s + x2 * c)); } }
        }
    }
};
template <bool KVP> struct EpiUp {
    static constexpr bool PROBE2 = false;
    static constexpr bool PERM = true, AFTER_DRAIN = false, HAS_MID = false; static constexpr int MID_T = -1;
    const float* ssqq; const float* rope; bf16_t* Q; bf16_t* KN; bf16_t* V;
    __device__ __forceinline__ void mid(f32x4 (&)[2][2][4][2], const Unit&, int, int) const {}
    __device__ __forceinline__ void operator()(const f32x4 (&acc)[2][2][4][2], const Unit& u, int wr, int wc, int fr, int fq) const {
        { const int l_ = lane_id(); fr = l_ & 15; fq = l_ >> 4; }
        float sq[2][4];
        { f32x4 q_[2][4];
#pragma unroll
        for (int ai = 0; ai < 2; ++ai)
#pragma unroll
            for (int m = 0; m < 4; ++m) q_[ai][m] = ldb<f32x4>(ssqq, (unsigned)((PG8_ROW(u, ai, m) * 8 + (KVP ? 4 : 0)) * 4));
#pragma unroll
        for (int ai = 0; ai < 2; ++ai)
#pragma unroll
            for (int m = 0; m < 4; ++m) sq[ai][m] = hsum4(q_[ai][m]);
        PG8_FENCE(); }
        if (!KVP) {
#pragma unroll
            for (int ai = 0; ai < 2; ++ai)
#pragma unroll
                for (int m = 0; m < 4; ++m) { const int row = PG8_ROW(u, ai, m); const float rq = rsqrtf(sq[ai][m] * (1.f / QR) + EPS) * QSCALE;
#pragma unroll
                    for (int bj = 0; bj < 2; ++bj) { const int G = 8 * u.pn + 4 * bj + wc, h = G / 3, gi = G - 3 * h;
                        const f32x4 v0 = acc[ai][bj][m][0] * rq, v1 = acc[ai][bj][m][1] * rq;
                        if (gi < 2) stb(Q, (unsigned)((row * 768 + 32 * G + 8 * fq) * 2), pack8(v0, v1));
                        else { const f32x4 c = ldb<f32x4>(rope, (unsigned)((row * 32 + 4 * fq) * 4)), s = ldb<f32x4>(rope, (unsigned)((row * 32 + 16 + 4 * fq) * 4));
                            stb(Q, (unsigned)((row * 768 + 96 * h + 64 + 4 * fq) * 2), pack4(v0 * c - v1 * s)); stb(Q, (unsigned)((row * 768 + 96 * h + 80 + 4 * fq) * 2), pack4(v0 * s + v1 * c)); } } }
        } else {
#pragma unroll
            for (int ai = 0; ai < 2; ++ai)
#pragma unroll
                for (int m = 0; m < 4; ++m) { const int row = PG8_ROW(u, ai, m); const float rk = rsqrtf(sq[ai][m] * (1.f / KVR) + EPS);
#pragma unroll
                    for (int bj = 0; bj < 2; ++bj) { const int h = 2 * u.pn + bj;
                        const u32x4 w = pack8(acc[ai][bj][m][0] * rk, acc[ai][bj][m][1] * rk);
                        if (wc < 2) stb(KN, (unsigned)((row * 512 + 64 * h + 32 * wc + 8 * fq) * 2), w); else stb(V, (unsigned)((row * 512 + 64 * h + 32 * (wc - 2) + 8 * fq) * 2), w); } }
        }
    }
};
__device__ __forceinline__ f32x4 bf_lo4(const u32x4& w) { f32x4 r; r[0] = __uint_as_float(w.x << 16); r[1] = __uint_as_float(w.x & 0xffff0000u); r[2] = __uint_as_float(w.y << 16); r[3] = __uint_as_float(w.y & 0xffff0000u); return r; }
__device__ __forceinline__ f32x4 bf_hi4(const u32x4& w) { f32x4 r; r[0] = __uint_as_float(w.z << 16); r[1] = __uint_as_float(w.z & 0xffff0000u); r[2] = __uint_as_float(w.w << 16); r[3] = __uint_as_float(w.w & 0xffff0000u); return r; }
template <bool MIDS, bool XF32> struct EpiRes {
    static constexpr bool PROBE2 = false;
    static constexpr bool PERM = true, AFTER_DRAIN = false, HAS_MID = MIDS; static constexpr int MID_T = 8;
    const float* ssqy; const void* xin; bf16_t* xout; const float* gate  ; const float* gm  ; bf16_t* A; float* ssqo;
    __device__ __forceinline__ void mid(f32x4 (&acc)[2][2][4][2], const Unit& u, int wr, int fr) const {
        const int l_ = lane_id(); fr = l_ & 15; const int fq = l_ >> 4;
        f32x4 q_[2][4];
#pragma unroll
        for (int ai = 0; ai < 2; ++ai)
#pragma unroll
            for (int m = 0; m < 4; ++m) q_[ai][m] = ldb<f32x4>(ssqy, (unsigned)(PG8_ROW(u, ai, m) * 64 + 16 * fq));
#pragma unroll
        for (int ai = 0; ai < 2; ++ai)
#pragma unroll
            for (int m = 0; m < 4; ++m) { float s = hsum4(q_[ai][m]); s += swz_xor16(s);
                auto rr = __builtin_amdgcn_permlane32_swap(__float_as_uint(s), __float_as_uint(s), false, false); const float sg = __uint_as_float(rr[0]), sa = __uint_as_float(rr[1]);
                const float ratio = sqrtf((sa * (1.f / 512) + EPS) / (sg * (1.f / 512) + EPS));
#pragma unroll
                for (int bj = 0; bj < 2; ++bj)
#pragma unroll
                    for (int n = 0; n < 2; ++n) acc[ai][bj][m][n] = acc[ai][bj][m][n] * ratio; }
    }
    __device__ __forceinline__ void operator()(const f32x4 (&acc)[2][2][4][2], const Unit& u, int wr, int wc, int fr, int fq) const {
        { const int l_ = lane_id(); fr = l_ & 15; fq = l_ >> 4; }
        const int b = u.pm >> 3, c0 = u.pn * BM + wc * 32 + 8 * fq;
        float rs[2][4], ss[2][4];
#pragma unroll
        for (int ai = 0; ai < 2; ++ai)
#pragma unroll
            for (int m = 0; m < 4; ++m) { ss[ai][m] = 0.f; rs[ai][m] = 1.f; }
        if (MIDS) { f32x4 q_[2][4];
#pragma unroll
            for (int ai = 0; ai < 2; ++ai)
#pragma unroll
                for (int m = 0; m < 4; ++m) q_[ai][m] = ldb<f32x4>(ssqy, (unsigned)(PG8_ROW(u, ai, m) * 64 + 32 + 16 * (fq & 1)));
#pragma unroll
            for (int ai = 0; ai < 2; ++ai)
#pragma unroll
                for (int m = 0; m < 4; ++m) { float s = hsum4(q_[ai][m]); s += swz_xor16(s); rs[ai][m] = rsqrtf(s * (1.f / 512) + EPS); }
            PG8_FENCE(); }
#pragma unroll
        for (int bj = 0; bj < 2; ++bj) { const int cb = c0 + bj * HALF;
            const f32x4 g0 = ldb<f32x4>(gate, (unsigned)((b * NMOD + cb) * 4)), g1 = ldb<f32x4>(gate, (unsigned)((b * NMOD + cb + 4) * 4));
            f32x4 m0 = (f32x4){0.f, 0.f, 0.f, 0.f}, m1 = m0; if (gm) { m0 = ldb<f32x4>(gm, (unsigned)((b * DM + cb) * 4)); m1 = ldb<f32x4>(gm, (unsigned)((b * DM + cb + 4) * 4)); }
            if (XF32) {
#pragma unroll
                for (int ai = 0; ai < 2; ++ai) {
                    f32x4 xv[4][2];
#pragma unroll
                    for (int m = 0; m < 4; ++m) { const unsigned off = (unsigned)((PG8_ROW(u, ai, m) * DM + cb) * 4); xv[m][0] = ldb<f32x4>(xin, off); xv[m][1] = ldb<f32x4>(xin, off + 16); }
                    PG8_FENCE();
#pragma unroll
                    for (int m = 0; m < 4; ++m) { const unsigned off = (unsigned)((PG8_ROW(u, ai, m) * DM + cb) * 2), offx = (unsigned)(PG8_ROW(u, ai, m) * (DM * 4) + DM * 2 + cb * 2);
                        const f32x4 x0 = xv[m][0] + g0 * (acc[ai][bj][m][0] * rs[ai][m]), x1 = xv[m][1] + g1 * (acc[ai][bj][m][1] * rs[ai][m]);
                        stb(xout, offx, pack8(x0, x1));
                        if (gm) { ss[ai][m] += hsq4(x0) + hsq4(x1); stb(A, off, pack8(x0 * m0, x1 * m1)); } }
                    PG8_FENCE(); }
            } else {
                u32x4 xw[2][4];
#pragma unroll
                for (int ai = 0; ai < 2; ++ai)
#pragma unroll
                    for (int m = 0; m < 4; ++m) xw[ai][m] = ldb<u32x4>(xin, (unsigned)(PG8_ROW(u, ai, m) * (DM * 4) + DM * 2 + cb * 2));
                PG8_FENCE();
#pragma unroll
                for (int ai = 0; ai < 2; ++ai)
#pragma unroll
                    for (int m = 0; m < 4; ++m) { const unsigned off = (unsigned)((PG8_ROW(u, ai, m) * DM + cb) * 2), offx = (unsigned)(PG8_ROW(u, ai, m) * (DM * 4) + DM * 2 + cb * 2);
                        const f32x4 x0 = bf_lo4(xw[ai][m]) + g0 * (acc[ai][bj][m][0] * rs[ai][m]), x1 = bf_hi4(xw[ai][m]) + g1 * (acc[ai][bj][m][1] * rs[ai][m]);
                        stb(xout, offx, pack8(x0, x1));
                        if (gm) { ss[ai][m] += hsq4(x0) + hsq4(x1); stb(A, off, pack8(x0 * m0, x1 * m1)); } }
                PG8_FENCE(); } }
        if (gm) {
#pragma unroll
            for (int ai = 0; ai < 2; ++ai)
#pragma unroll
                for (int m = 0; m < 4; ++m) { const float s = quad_sum(ss[ai][m]); if (fq == 0) stb(ssqo, (unsigned)((PG8_ROW(u, ai, m) * 16 + u.pn * 4 + wc) * 4), s); } }
    }
};
struct EpiFf1 {
    static constexpr bool PERM = true, AFTER_DRAIN = false, HAS_MID = false; static constexpr int MID_T = -1;
    const float* ssq2; const float* shw2; bf16_t* H;
    __device__ __forceinline__ void mid(f32x4 (&)[2][2][4][2], const Unit&, int, int) const {}
    __device__ __forceinline__ void operator()(const f32x4 (&acc)[2][2][4][2], const Unit& u, int wr, int wc, int fr, int fq) const {
        { const int l_ = lane_id(); fr = l_ & 15; fq = l_ >> 4; }
        const int b = u.pm >> 3, c0 = u.pn * BM + wc * 32 + 8 * fq;
        f32x4 sh[2][2];
#pragma unroll
        for (int bj = 0; bj < 2; ++bj)
#pragma unroll
            for (int n = 0; n < 2; ++n) sh[bj][n] = ldb<f32x4>(shw2, (unsigned)((b * DFF + c0 + bj * HALF + 4 * n) * 4));
        float rsv[2][4]; PG8_RSTD8(rsv, ssq2, 1.f / DM);
#pragma unroll
        for (int ai = 0; ai < 2; ++ai)
#pragma unroll
            for (int m = 0; m < 4; ++m) { const int row = PG8_ROW(u, ai, m); const float rs = rsv[ai][m];
#pragma unroll
                for (int bj = 0; bj < 2; ++bj) { f32x4 v0 = acc[ai][bj][m][0] * rs + sh[bj][0], v1 = acc[ai][bj][m][1] * rs + sh[bj][1];
#pragma unroll
                    for (int i = 0; i < 4; ++i) { const float a = fmaxf(v0[i], 0.f), c = fmaxf(v1[i], 0.f); v0[i] = a * a; v1[i] = c * c; }
                    stb(H, (unsigned)((row * DFF + c0 + bj * HALF) * 2), pack8(v0, v1)); } }
    }
};

template <class Epi, class Sched, bool ALIGN_EPI = false, bool SP2 = false>
__device__ __forceinline__ void gemm_phase(PG8_LAS unsigned char* lds, const Gemm g, const Sched& S, const Epi& E, int wid0) {
    int tid_ = wid0 * 64 + lane_id(); asm volatile("" : "+v"(tid_));
    const int tid = tid_, wid = __builtin_amdgcn_readfirstlane(tid >> 6), lane = tid & 63, wr = wid >> 2, wc = wid & 3, fr = lane & 15, fq = lane >> 4;
    const int K = g.K, nt = K / BK;
    unsigned voffA[2], voffB[2];
#pragma unroll
    for (int i = 0; i < 2; ++i) { int R, C; stage_rc(tid * 16 + i * 8192, R, C); const int Rb = Epi::PERM ? ((R & ~31) + perm32(R & 31)) : R;
        voffA[i] = (unsigned)(R * g.lda + C) * 2u; voffB[i] = (unsigned)(Rb * K + C) * 2u; }
    const size_t kstep = (size_t)(BK * 2);
    const size_t hstep = (size_t)HALF * K * 2;
    const size_t tstep = 2 * hstep;
    const size_t hstepA = (size_t)HALF * g.lda * 2, tstepA = 2 * hstepA;
    const unsigned ldsw = (unsigned)wid * 1024u;
    const int aoff = lds_byte(wr * 64 + fr, fq * 8), boff = lds_byte(wc * 32 + fr, fq * 8);
#define PG8_SA(b, h) (((b) * 2 + (h)) * HTB)
#define PG8_SB(b, h) ((4 + (b) * 2 + (h)) * HTB)
#define PG8_STAGE(bufoff, gbase, voff) do { _Pragma("unroll") for (int _i = 0; _i < 2; ++_i) \
        __builtin_amdgcn_global_load_lds((const unsigned*)((const char*)(gbase) + (voff)[_i]), (PG8_LAS unsigned*)(lds + (bufoff) + ldsw + _i * 8192), 16, 0, 0); } while (0)
#define PG8_LDA(dst, b, h) do { _Pragma("unroll") for (int m = 0; m < 4; ++m) _Pragma("unroll") for (int k = 0; k < 2; ++k) dst[m][k] = *(const PG8_LAS bf16x8*)(lds + PG8_SA(b, h) + aoff + m * 2048 + k * 1024); } while (0)
#define PG8_LDB(dst, b, h) do { _Pragma("unroll") for (int n = 0; n < 2; ++n) _Pragma("unroll") for (int k = 0; k < 2; ++k) dst[n][k] = *(const PG8_LAS bf16x8*)(lds + PG8_SB(b, h) + boff + n * 2048 + k * 1024); } while (0)
#define PG8_MMA(ai, bj, At, Bt) do { __builtin_amdgcn_s_setprio(1); _Pragma("unroll") for (int m = 0; m < 4; ++m) _Pragma("unroll") for (int n = 0; n < 2; ++n) _Pragma("unroll") for (int k = 0; k < 2; ++k) \
        acc[ai][bj][m][n] = __builtin_amdgcn_mfma_f32_16x16x32_bf16(Bt[n][k], At[m][k], acc[ai][bj][m][n], 0, 0, 0); __builtin_amdgcn_s_setprio(0); } while (0)
#define PG8_WAIT_V(n) asm volatile("s_waitcnt vmcnt(" #n ")" ::: "memory")
#define PG8_WAIT_L(n) asm volatile("s_waitcnt lgkmcnt(" #n ")" ::: "memory")
#define PG8_BAR __builtin_amdgcn_s_barrier()
#define PG8_SCHED __builtin_amdgcn_sched_barrier(0)
    Unit cur, nxt; int ui = 0;
    if (!S.next(0, cur)) return;
    f32x4 acc[2][2][4][2];
#pragma unroll
    for (int a = 0; a < 2; ++a)
#pragma unroll
        for (int b = 0; b < 2; ++b)
#pragma unroll
            for (int m = 0; m < 4; ++m)
#pragma unroll
                for (int n = 0; n < 2; ++n) acc[a][b][m][n] = (f32x4){0.f, 0.f, 0.f, 0.f};
    bf16x8 At[4][2], B0[2][2], B1[2][2];
    const char* cA = (const char*)g.A + (size_t)cur.pm * tstepA; const char* cB = (const char*)g.Bt + (size_t)cur.pn * tstep;
    S.a_ready(cur);
    if constexpr (SP2) {
        PG8_STAGE(PG8_SB(0, 0), cB, voffB); PG8_STAGE(PG8_SB(0, 1), cB + hstep, voffB); PG8_STAGE(PG8_SA(0, 0), cA, voffA); PG8_STAGE(PG8_SA(0, 1), cA + hstepA, voffA);
        if (wr == 1) PG8_BAR;
        PG8_WAIT_V(2); PG8_BAR;
        PG8_STAGE(PG8_SB(1, 0), cB + kstep, voffB); PG8_STAGE(PG8_SA(1, 0), cA + kstep, voffA); PG8_STAGE(PG8_SB(1, 1), cB + hstep + kstep, voffB);
        PG8_WAIT_V(6); PG8_BAR;
    } else {
        PG8_STAGE(PG8_SB(0, 0), cB, voffB); PG8_STAGE(PG8_SA(0, 0), cA, voffA); PG8_STAGE(PG8_SB(0, 1), cB + hstep, voffB); PG8_STAGE(PG8_SA(0, 1), cA + hstepA, voffA);
        if (wr == 1) PG8_BAR;
        PG8_WAIT_V(4); PG8_BAR;
        PG8_STAGE(PG8_SB(1, 0), cB + kstep, voffB); PG8_STAGE(PG8_SA(1, 0), cA + kstep, voffA); PG8_STAGE(PG8_SB(1, 1), cB + hstep + kstep, voffB);
        PG8_WAIT_V(6); PG8_BAR;
    }
    for (;;) {
        const bool has_next = S.next(ui + 1, nxt);
        const char* nA = has_next ? (const char*)g.A + (size_t)nxt.pm * tstepA : cA; const char* nB = has_next ? (const char*)g.Bt + (size_t)nxt.pn * tstep : cB;
        for (int t = 0; t < nt; t += 2) {
            const bool last = (t == nt - 2);
            const char* a1 = cA + (size_t)(t + 1) * kstep;
            const char* a2 = last ? nA : cA + (size_t)(t + 2) * kstep; const char* b2 = last ? nB : cB + (size_t)(t + 2) * kstep;
            const char* a3 = a2 + kstep; const char* b3 = b2 + kstep;
            if (last && has_next) S.a_ready(nxt);
            if constexpr (Epi::HAS_MID) { if (t == Epi::MID_T) E.mid(acc, cur, wr, fr); }
            if constexpr (SP2) {
            PG8_LDB(B0, 0, 0); PG8_LDB(B1, 0, 1); PG8_SCHED; PG8_LDA(At, 0, 0); PG8_STAGE(PG8_SA(1, 1), a1 + hstepA, voffA);
            PG8_WAIT_V(8); PG8_WAIT_L(0); PG8_BAR; PG8_MMA(0, 0, At, B0); PG8_MMA(0, 1, At, B1); PG8_BAR; PG8_SCHED;
            PG8_LDA(At, 0, 1); PG8_STAGE(PG8_SB(0, 0), b2, voffB); PG8_STAGE(PG8_SB(0, 1), b2 + hstep, voffB); PG8_STAGE(PG8_SA(0, 0), a2, voffA);
            PG8_WAIT_V(8); PG8_WAIT_L(0); PG8_BAR; PG8_MMA(1, 0, At, B0); PG8_MMA(1, 1, At, B1); PG8_BAR; PG8_SCHED;
            PG8_LDB(B0, 1, 0); PG8_LDB(B1, 1, 1); PG8_SCHED; PG8_LDA(At, 1, 0); PG8_STAGE(PG8_SA(0, 1), a2 + hstepA, voffA);
            PG8_WAIT_V(8); PG8_WAIT_L(0); PG8_BAR; PG8_MMA(0, 0, At, B0); PG8_MMA(0, 1, At, B1); PG8_BAR; PG8_SCHED;
            PG8_LDA(At, 1, 1); PG8_STAGE(PG8_SB(1, 0), b3, voffB); PG8_STAGE(PG8_SB(1, 1), b3 + hstep, voffB); PG8_STAGE(PG8_SA(1, 0), a3, voffA);
            PG8_WAIT_V(8); PG8_WAIT_L(0); PG8_BAR; PG8_MMA(1, 0, At, B0); PG8_MMA(1, 1, At, B1); PG8_BAR; PG8_SCHED;
            } else {
            PG8_LDB(B0, 0, 0); PG8_SCHED; PG8_LDA(At, 0, 0); PG8_STAGE(PG8_SA(1, 1), a1 + hstepA, voffA);
            PG8_WAIT_L(8); PG8_BAR; PG8_WAIT_L(0); PG8_MMA(0, 0, At, B0); PG8_BAR; PG8_SCHED;
            PG8_LDB(B1, 0, 1); PG8_STAGE(PG8_SB(0, 0), b2, voffB);
            PG8_BAR; PG8_WAIT_L(0); PG8_MMA(0, 1, At, B1); PG8_BAR;
            PG8_LDA(At, 0, 1); PG8_STAGE(PG8_SA(0, 0), a2, voffA);
            PG8_BAR; PG8_WAIT_L(0); PG8_MMA(1, 0, At, B0); PG8_BAR; PG8_SCHED;
            PG8_STAGE(PG8_SB(0, 1), b2 + hstep, voffB);
            PG8_WAIT_V(6); PG8_BAR; PG8_MMA(1, 1, At, B1); PG8_BAR;
            PG8_LDB(B0, 1, 0); PG8_SCHED; PG8_LDA(At, 1, 0); PG8_STAGE(PG8_SA(0, 1), a2 + hstepA, voffA);
            PG8_WAIT_L(8); PG8_BAR; PG8_WAIT_L(0); PG8_MMA(0, 0, At, B0); PG8_BAR; PG8_SCHED;
            PG8_LDB(B1, 1, 1); PG8_STAGE(PG8_SB(1, 0), b3, voffB);
            PG8_BAR; PG8_WAIT_L(0); PG8_MMA(0, 1, At, B1); PG8_BAR;
            PG8_LDA(At, 1, 1); PG8_STAGE(PG8_SA(1, 0), a3, voffA);
            PG8_BAR; PG8_WAIT_L(0); PG8_MMA(1, 0, At, B0); PG8_BAR; PG8_SCHED;
            PG8_STAGE(PG8_SB(1, 1), b3 + hstep, voffB);
            PG8_WAIT_V(6); PG8_BAR; PG8_MMA(1, 1, At, B1); PG8_BAR;
            }
        }
        if constexpr (ALIGN_EPI) { if (wr == 0) PG8_BAR; }
        if constexpr (!Epi::AFTER_DRAIN) { E(acc, cur, wr, wc, fr, fq); S.done(cur); }
        if (!has_next) break;
#pragma unroll
        for (int a = 0; a < 2; ++a)
#pragma unroll
            for (int b = 0; b < 2; ++b)
#pragma unroll
                for (int m = 0; m < 4; ++m)
#pragma unroll
                    for (int n = 0; n < 2; ++n) acc[a][b][m][n] = (f32x4){0.f, 0.f, 0.f, 0.f};
        cur = nxt; cA = nA; cB = nB; ++ui;
        if constexpr (ALIGN_EPI) { if (wr == 1) PG8_BAR; }
    }
    PG8_WAIT_V(0);
    if constexpr (!ALIGN_EPI) { if (wr == 0) PG8_BAR; }
    PG8_BAR;
    if constexpr (Epi::AFTER_DRAIN) { E.fused(acc, cur, wr, wc, fr, fq, lds, wid, lane); S.done(cur); }
#undef PG8_SA
#undef PG8_SB
#undef PG8_STAGE
#undef PG8_LDA
#undef PG8_LDB
#undef PG8_MMA
#undef PG8_WAIT_V
#undef PG8_WAIT_L
#undef PG8_BAR
#undef PG8_SCHED
}
}

namespace gm {
#define GM_LAS __attribute__((address_space(3)))
typedef short v4i16_t __attribute__((ext_vector_type(4)));
__device__ __forceinline__ int swz(int s) { return ((s >> 1) & 1) + 2 * ((s >> 3) & 1); }
__device__ __forceinline__ void gmlp_phase(GM_LAS unsigned char* lds, int wid0, int vcu, const bf16_t* U, const bf16_t* VN, const bf16_t* GW  , const float* bs  , const float* gog  , bf16_t* Y, float* ssqy) {
    int tid_ = wid0 * 64 + lane_id(); asm volatile("" : "+v"(tid_));
    const int tid = tid_, lane = tid & 63, wid = __builtin_amdgcn_readfirstlane(tid >> 6), fr = lane & 15, fq = lane >> 4;
    const int g = vcu & 7, nks = (wid >> 1) + 1;
    bf16x8 wf[4];
#pragma unroll
    for (int ks = 0; ks < 4; ++ks) wf[ks] = *(const bf16x8*)(GW + ((size_t)(g * CHUNK + 16 * wid + fr)) * CHUNK + 32 * ks + 8 * fq);
    const float bias = bs[g * CHUNK + 16 * wid + fr];
    f32x4 gv[4];
#pragma unroll
    for (int nt = 0; nt < 4; ++nt) gv[nt] = *(const f32x4*)(gog + g * 64 + 16 * nt + 4 * fq);
    for (int i = 0; i < 8; ++i) {
        const int un = (vcu >> 3) + 32 * i; const size_t t0 = (size_t)un * CHUNK;
        pg8::u32x4 st[2];
#pragma unroll
        for (int k = 0; k < 2; ++k) { const int idx = tid + 512 * k, s = idx >> 3, c16 = idx & 7; st[k] = *(const pg8::u32x4*)(VN + (t0 + s) * 512 + g * 64 + c16 * 8); }
        __syncthreads();
#pragma unroll
        for (int k = 0; k < 2; ++k) { const int idx = tid + 512 * k, s = idx >> 3, c16 = idx & 7; *(GM_LAS pg8::u32x4*)(lds + s * 128 + (((c16 >> 1) ^ swz(s)) * 32) + (c16 & 1) * 16) = st[k]; }
        __syncthreads();
        f32x4 acc[4];
#pragma unroll
        for (int nt = 0; nt < 4; ++nt) acc[nt] = (f32x4){0.f, 0.f, 0.f, 0.f};
#pragma unroll
        for (int ks = 0; ks < 4; ++ks) { if (ks < nks) {
#pragma unroll
            for (int nt = 0; nt < 4; ++nt) {
                const int q = fr >> 2, p = fr & 3;
                const int s0 = 32 * ks + 8 * fq + q, s1 = s0 + 4;
                const v4i16_t lo = __builtin_amdgcn_ds_read_tr16_b64_v4i16((GM_LAS v4i16_t*)(lds + s0 * 128 + ((nt ^ swz(s0)) * 32) + p * 8));
                const v4i16_t hi = __builtin_amdgcn_ds_read_tr16_b64_v4i16((GM_LAS v4i16_t*)(lds + s1 * 128 + ((nt ^ swz(s1)) * 32) + p * 8));
                const bf16x8 vf = (bf16x8){lo[0], lo[1], lo[2], lo[3], hi[0], hi[1], hi[2], hi[3]};
                acc[nt] = __builtin_amdgcn_mfma_f32_16x16x32_bf16(vf, wf[ks], acc[nt], 0, 0, 0);
            } } }
        const size_t row = t0 + 16 * wid + fr; float ss = 0.f;
#pragma unroll
        for (int nt = 0; nt < 4; ++nt) { const int c = g * 64 + 16 * nt + 4 * fq;
            const uint2 uu = *(const uint2*)(U + row * 512 + c);
            f32x4 y; y[0] = bf2f((bf16_t)(uu.x & 0xffff)) * (acc[nt][0] + bias); y[1] = bf2f((bf16_t)(uu.x >> 16)) * (acc[nt][1] + bias);
            y[2] = bf2f((bf16_t)(uu.y & 0xffff)) * (acc[nt][2] + bias); y[3] = bf2f((bf16_t)(uu.y >> 16)) * (acc[nt][3] + bias);
            ss += pg8::hsq4(y); *(pg8::u32x2*)(Y + row * YLD + c) = pg8::pack4(y * gv[nt]); }
        ss = pg8::quad_sum(ss); if (fq == 0) ssqy[row * 16 + g] = ss;
    }
    __syncthreads();
}
}

namespace att {
#define AT_LAS __attribute__((address_space(3)))
using f32x16 = __attribute__((ext_vector_type(16))) float;
using s16x4 = __attribute__((ext_vector_type(4))) short;
using u32x4 = __attribute__((ext_vector_type(4))) unsigned;
constexpr int KVBLK = 64, KSLOTB = 12288, VSLOTB = 8192, NKS = 4, NVS = 4;
constexpr int LDS_V = NKS * KSLOTB  , LDS_WS = LDS_V + NVS * VSLOTB  , LDS_OST = LDS_WS + 8 * 256  , OROW = 144, LDS_BYTES = LDS_OST + 8 * 32 * OROW  ;
__device__ __forceinline__ int crow(int r, int hi) { return (r & 3) + 8 * (r >> 2) + 4 * hi; }
__device__ __forceinline__ void glds16(const void* gsrc, unsigned lds_dst) { unsigned keep;
    asm volatile("s_mov_b32 %0, m0\n\ts_mov_b32 m0, %2\n\ts_nop 0\n\tglobal_load_lds_dwordx4 %1, off\n\ts_mov_b32 m0, %0" : "=&s"(keep) : "v"(gsrc), "s"(lds_dst) : "memory"); }
typedef float f32x2_t __attribute__((ext_vector_type(2))); typedef __bf16 bf16x2_t __attribute__((ext_vector_type(2)));
__device__ __forceinline__ unsigned cvtpk_s(float lo, float hi) { f32x2_t v = {lo, hi}; bf16x2_t b = __builtin_convertvector(v, bf16x2_t); return __builtin_bit_cast(unsigned, b); }
__device__ __forceinline__ float max3f(float a, float b, float c) { float r; asm("v_max3_f32 %0, %1, %2, %3" : "=v"(r) : "v"(a), "v"(b), "v"(c)); return r; }
#define AT_WAIT_BAR(N) asm volatile("s_waitcnt vmcnt(" #N ") lgkmcnt(0)\n\ts_barrier" ::: "memory")
typedef short v4i16_t __attribute__((ext_vector_type(4)));
__device__ __forceinline__ s16x4 vtr(AT_LAS const char* p) { return __builtin_bit_cast(s16x4, __builtin_amdgcn_ds_read_tr16_b64_v4i16((AT_LAS v4i16_t*)p)); }
__device__ __forceinline__ void pv(f32x16 (&o)[2], AT_LAS const char* vp, const u32x4& pw0, const u32x4& pw1, const u32x4& pw2, const u32x4& pw3) {
#pragma unroll
    for (int d0 = 0; d0 < 2; ++d0) { s16x4 lo[4], hh[4];
#pragma unroll
        for (int ks = 0; ks < 4; ++ks) { lo[ks] = vtr(vp + d0 * 4096 + ks * 1024); hh[ks] = vtr(vp + d0 * 4096 + ks * 1024 + 512); }
#define AT_VF(k) (bf16x8){lo[k][0], lo[k][1], lo[k][2], lo[k][3], hh[k][0], hh[k][1], hh[k][2], hh[k][3]}
        o[d0] = __builtin_amdgcn_mfma_f32_32x32x16_bf16(__builtin_bit_cast(bf16x8, pw0), AT_VF(0), o[d0], 0, 0, 0);
        o[d0] = __builtin_amdgcn_mfma_f32_32x32x16_bf16(__builtin_bit_cast(bf16x8, pw1), AT_VF(1), o[d0], 0, 0, 0);
        o[d0] = __builtin_amdgcn_mfma_f32_32x32x16_bf16(__builtin_bit_cast(bf16x8, pw2), AT_VF(2), o[d0], 0, 0, 0);
        o[d0] = __builtin_amdgcn_mfma_f32_32x32x16_bf16(__builtin_bit_cast(bf16x8, pw3), AT_VF(3), o[d0], 0, 0, 0);
#undef AT_VF
    }
}
__device__ __forceinline__ void qkt(f32x16& p0, f32x16& p1, AT_LAS const char* kb, const bf16x8 (&qr)[6], const f32x16& negm) {
    bf16x8 kf[12];
#pragma unroll
    for (int d0 = 0; d0 < 6; ++d0) { kf[2 * d0] = *(AT_LAS const bf16x8*)(kb + d0 * 2048); kf[2 * d0 + 1] = *(AT_LAS const bf16x8*)(kb + d0 * 2048 + 512); }
    __builtin_amdgcn_sched_barrier(0);
    p0 = __builtin_amdgcn_mfma_f32_32x32x16_bf16(kf[0], qr[0], negm, 0, 0, 0); p1 = __builtin_amdgcn_mfma_f32_32x32x16_bf16(kf[1], qr[0], negm, 0, 0, 0);
#pragma unroll
    for (int d0 = 1; d0 < 6; ++d0) { p0 = __builtin_amdgcn_mfma_f32_32x32x16_bf16(kf[2 * d0], qr[d0], p0, 0, 0, 0); p1 = __builtin_amdgcn_mfma_f32_32x32x16_bf16(kf[2 * d0 + 1], qr[d0], p1, 0, 0, 0); }
    asm volatile("s_nop 15\n\ts_nop 7" : "+v"(p0), "+v"(p1));
}
template <int THRL>
__device__ __forceinline__ void attn_unit(int b, int h, int qb, const bf16_t* Q, const bf16_t* KN, const bf16_t* KR, const bf16_t* V, const float* goa  , bf16_t* Y, float* ssqy, AT_LAS char* shm, int wid0) {
    int tid_ = wid0 * 64 + lane_id(); asm volatile("" : "+v"(tid_));
    const int tid = tid_, lane = tid & 63, r32 = lane & 31, hi = lane >> 5; const int wid = __builtin_amdgcn_readfirstlane(tid >> 6);
    const bool late = wid >= 4;
    const size_t rowbase = (size_t)b * SEQ; const int q0 = qb * 256;
    const bf16_t* Qw = Q + (rowbase + q0 + wid * 32) * 768 + h * 96;
    const unsigned lds0 = (unsigned)(uintptr_t)shm;
    AT_LAS float* wsf = (AT_LAS float*)(shm + LDS_WS) + wid * 64;
    const bf16_t* ksrc = KN + (rowbase + lane) * 512 + h * 64 + wid * 8;
    const bf16_t* rsrc = KR + (rowbase + lane) * 32 + (wid & 3) * 8;
    const bf16_t* vsrc = V + (rowbase + 16 * (wid & 3) + (lane >> 2)) * 512 + h * 64 + (wid >> 2) * 32 + (lane & 3) * 8;
    const unsigned kdst = lds0 + wid * 1024, rdst = lds0 + (8 + (wid & 3)) * 1024, vdst = lds0 + LDS_V + wid * 1024;
    const int NT = (q0 + 256) / KVBLK;
#define AT_DMA(jk, jv) do { const int jk_ = (jk) < NT ? (jk) : NT - 1, jv_ = (jv) < NT ? (jv) : NT - 1; \
        glds16(ksrc + (size_t)jk_ * KVBLK * 512, (unsigned)__builtin_amdgcn_readfirstlane(kdst + (jk_ & 3) * KSLOTB)); \
        glds16(rsrc + (size_t)jk_ * KVBLK * 32, (unsigned)__builtin_amdgcn_readfirstlane(rdst + (jk_ & 3) * KSLOTB)); \
        glds16(vsrc + (size_t)jv_ * KVBLK * 512, (unsigned)__builtin_amdgcn_readfirstlane(vdst + (jv_ & 3) * VSLOTB)); } while (0)
    bf16x8 qr[6];
#pragma unroll
    for (int d0 = 0; d0 < 6; ++d0) qr[d0] = *(const bf16x8*)(Qw + (size_t)r32 * 768 + d0 * 16 + hi * 8);
    AT_DMA(0, 0); AT_DMA(1, 1); AT_DMA(2, 1);
    float mhat = 0.f, l_reg = 0.f; f32x16 o[2]; o[0] = f32x16{}; o[1] = f32x16{};
    f32x16 negm = f32x16{}; asm volatile("" : "+v"(negm));
    const int qrel = wid * 32 + r32, wq = wid >> 1;
    AT_LAS const char* kp0 = shm + hi * 1024 + r32 * 16;
    AT_LAS const char* vp0 = shm + LDS_V + ((lane >> 4) & 1) * 32 + (lane & 3) * 8 + (4 * hi + ((lane & 15) >> 2)) * 64;
    u32x4 pw0 = u32x4{}, pw1 = u32x4{}, pw2 = u32x4{}, pw3 = u32x4{}; bool have = false;
    f32x16 p0 = f32x16{}, p1 = f32x16{};
    AT_WAIT_BAR(6);
    if (!late) qkt(p0, p1, kp0, qr, negm);
    for (int t = 0; t < NT; ++t) {
        AT_WAIT_BAR(3);
        AT_DMA(t + 3, t + 2);
        const int jb = t - (NT - 4);
        const bool need = jb <= wq;
        if (late) { if (have) pv(o, vp0 + ((t - 1) & 3) * VSLOTB, pw0, pw1, pw2, pw3);
                    have = false; if (need) qkt(p0, p1, kp0 + (t & 3) * KSLOTB, qr, negm); }
        if (need) {
            if (jb == wq) { const int kb = 64 * jb + 4 * hi;
#pragma unroll
                for (int r = 0; r < 16; ++r) { const int kv = kb + (r & 3) + 8 * (r >> 2); if (kv > qrel) p0[r] = -INFINITY; if (kv + 32 > qrel) p1[r] = -INFINITY; } }
            float ma = max3f(p0[0], p0[1], p1[0]), mb = max3f(p0[2], p0[3], p1[1]); ma = max3f(ma, p1[2], p1[3]);
#pragma unroll
            for (int r = 4; r < 16; r += 4) { ma = max3f(ma, p0[r], p0[r + 1]); mb = max3f(mb, p0[r + 2], p0[r + 3]); ma = max3f(ma, p1[r], p1[r + 1]); mb = max3f(mb, p1[r + 2], p1[r + 3]); }
            float rm = fmaxf(ma, mb);
            { auto rr = __builtin_amdgcn_permlane32_swap(__float_as_uint(rm), __float_as_uint(rm), false, false); rm = fmaxf(__uint_as_float(rr[0]), __uint_as_float(rr[1])); }
            if (t == 0 || __any(rm > (float)THRL)) {
                const float dl = (t == 0) ? rm : fmaxf(rm, 0.f); mhat += dl;
#pragma unroll
                for (int r = 0; r < 16; ++r) { p0[r] -= dl; p1[r] -= dl; negm[r] = -mhat; }
                asm volatile("" : "+v"(negm));
                if (t > 0) { const float f = __builtin_amdgcn_exp2f(-dl); l_reg *= f; if (hi == 0) wsf[r32] = f; asm volatile("s_waitcnt lgkmcnt(0)" ::: "memory");
#pragma unroll
                    for (int r = 0; r < 16; ++r) { const float fr_ = wsf[crow(r, hi)]; o[0][r] *= fr_; o[1][r] *= fr_; } }
            }
            float sacc = 0.f;
#pragma unroll
            for (int r = 0; r < 16; ++r) { p0[r] = __builtin_amdgcn_exp2f(p0[r]); p1[r] = __builtin_amdgcn_exp2f(p1[r]); sacc += p0[r] + p1[r]; }
            l_reg += sacc;
#define AT_PK(P, B) cvtpk_s(P[B], P[B + 1])
            pw0 = (u32x4){AT_PK(p0, 0), AT_PK(p0, 2), AT_PK(p0, 4), AT_PK(p0, 6)}; pw1 = (u32x4){AT_PK(p0, 8), AT_PK(p0, 10), AT_PK(p0, 12), AT_PK(p0, 14)};
            pw2 = (u32x4){AT_PK(p1, 0), AT_PK(p1, 2), AT_PK(p1, 4), AT_PK(p1, 6)}; pw3 = (u32x4){AT_PK(p1, 8), AT_PK(p1, 10), AT_PK(p1, 12), AT_PK(p1, 14)};
#undef AT_PK
            if (late) have = true;
            else pv(o, vp0 + (t & 3) * VSLOTB, pw0, pw1, pw2, pw3);
        }
        if (!late) { if (t + 1 < NT && (jb + 1) <= wq) qkt(p0, p1, kp0 + ((t + 1) & 3) * KSLOTB, qr, negm); }
    }
    if (late && have) pv(o, vp0 + ((NT - 1) & 3) * VSLOTB, pw0, pw1, pw2, pw3);
    { auto rr = __builtin_amdgcn_permlane32_swap(__float_as_uint(l_reg), __float_as_uint(l_reg), false, false); l_reg = __uint_as_float(rr[0]) + __uint_as_float(rr[1]); }
    if (hi == 0) wsf[32 + r32] = __builtin_amdgcn_rcpf(l_reg);
    asm volatile("s_waitcnt lgkmcnt(0)" ::: "memory");
    AT_LAS char* stg = shm + LDS_OST + wid * (32 * OROW);
    { const int row = lane >> 1, half = lane & 1; const size_t grow = rowbase + q0 + wid * 32 + row; float ss = 0.f;
#pragma unroll
      for (int d0 = 0; d0 < 2; ++d0) {
#pragma unroll
        for (int r = 0; r < 16; ++r) { const int orow = crow(r, hi); *(AT_LAS float*)(stg + orow * OROW + r32 * 4) = o[d0][r] * wsf[32 + orow]; }
        asm volatile("s_waitcnt lgkmcnt(0)" ::: "memory");
        const float* gp = goa + h * 64 + d0 * 32 + half * 16; bf16_t* yp = Y + grow * YLD + 512 + h * 64 + d0 * 32 + half * 16;
#pragma unroll
        for (int i = 0; i < 2; ++i) { const f32x4 a = *(AT_LAS const f32x4*)(stg + row * OROW + half * 64 + i * 32), c = *(AT_LAS const f32x4*)(stg + row * OROW + half * 64 + i * 32 + 16);
            ss += pg8::hsq4(a) + pg8::hsq4(c);
            *(u32x4*)(yp + i * 8) = pg8::pack8(a * *(const f32x4*)(gp + i * 8), c * *(const f32x4*)(gp + i * 8 + 4)); }
        asm volatile("s_waitcnt lgkmcnt(0)" ::: "memory"); }
      ss += swz_xor1(ss); if (half == 0) ssqy[grow * 16 + 8 + h] = ss; }
    asm volatile("s_waitcnt vmcnt(0) lgkmcnt(0)\n\ts_barrier" ::: "memory");
#undef AT_DMA
}
__device__ __forceinline__ void attn_phase(AT_LAS char* lds, int wid0, int vcu, const bf16_t* Q, const bf16_t* KN, const bf16_t* KR, const bf16_t* V, const float* goa, bf16_t* Y, float* ssqy) {
    const int bh = vcu >> 1, s = vcu & 1;
    for (int i = 0; i < 4; ++i) { const int qb = (i == 0) ? s : (i == 1) ? 7 - s : (i == 2) ? 2 + s : 5 - s;
        attn_unit<8>(bh >> 3, bh & 7, qb, Q, KN, KR, V, goa, Y, ssqy, lds, wid0); }
}
}

constexpr int NWAVES = 8;
struct Args { const void* in[20]; float* out; unsigned char* ws; int ph_lo, ph_hi, li, flags; };
namespace pro {
#define PR_LAS __attribute__((address_space(3)))
__device__ __forceinline__ unsigned pk2(float lo, float hi) { return (unsigned)f2bf(lo) | ((unsigned)f2bf(hi) << 16); }
template <int MODE  >
__device__ __forceinline__ void tr_item(const float* W, int ldw, bf16_t* WT, int out_ld, int out_koff, int nblk, PR_LAS float* scr, int item, int lane) {
    const int kb = item / nblk, nb = item - kb * nblk, k0 = 64 * kb, n0 = 32 * nb;
    const int pn = n0 + (lane & 31); const int sc0 = MODE == 0 ? pn : (MODE == 1 ? win_src(pn) : wup_qcol(pn));
    const int sc = sc0 >= 0 ? sc0 : 0; const float msk = sc0 >= 0 ? 1.f : 0.f;
    const float* wp = W + (size_t)(k0 + (lane >> 5)) * ldw + sc;
    float v[32];
#pragma unroll
    for (int i = 0; i < 32; ++i) v[i] = wp[(size_t)(2 * i) * ldw];
#pragma unroll
    for (int i = 0; i < 32; ++i) scr[(2 * i + (lane >> 5)) * 33 + (lane & 31)] = v[i] * msk;
    asm volatile("s_waitcnt lgkmcnt(0)" ::: "memory");
    const int c = lane & 7;
#pragma unroll
    for (int j = 0; j < 4; ++j) { const int n = (lane >> 3) + 8 * j; const PR_LAS float* s = scr + (8 * c) * 33 + n;
        pg8::u32x4 o; o.x = pk2(s[0 * 33], s[1 * 33]); o.y = pk2(s[2 * 33], s[3 * 33]); o.z = pk2(s[4 * 33], s[5 * 33]); o.w = pk2(s[6 * 33], s[7 * 33]);
        *(pg8::u32x4*)(WT + (size_t)(n0 + n) * out_ld + out_koff + k0 + 8 * c) = o; }
    asm volatile("s_waitcnt lgkmcnt(0)" ::: "memory");
}
__device__ __forceinline__ void smallm_unit(PR_LAS unsigned char* lds, int tid, const float* in, int in_stride, bool act, const float* W, int ldw, int N, bool winmap, const float* bias, float* out, int out_stride, int p0, int ucols) {
    PR_LAS float* sin_ = (PR_LAS float*)lds; PR_LAS float* red = (PR_LAS float*)(lds + 65536);
    const int lane = tid & 63, wave = tid >> 6;
#pragma unroll 8
    for (int e = tid; e < 16 * 1024; e += 512) { const int b = e >> 10, k = e & 1023; float v = in[(size_t)b * in_stride + k]; if (act) v = v * __builtin_amdgcn_rcpf(1.f + __expf(-v)); sin_[k * 16 + b] = v; }
    __syncthreads();
    const int p = p0 + lane; const int s0 = winmap ? win_src(p) : p; const bool ok = (lane < ucols && s0 >= 0 && s0 < N);
    const int sc = ok ? s0 : 0; const float msk = ok ? 1.f : 0.f;
    const float* wp = W + (size_t)(wave * 128) * ldw + sc;
    float acc[16];
#pragma unroll
    for (int b = 0; b < 16; ++b) acc[b] = 0.f;
    for (int k0 = 0; k0 < 128; k0 += 16) {
        float w[16];
#pragma unroll
        for (int j = 0; j < 16; ++j) w[j] = wp[(size_t)(k0 + j) * ldw];
#pragma unroll
        for (int j = 0; j < 16; ++j) { const PR_LAS f32x4* sp = (const PR_LAS f32x4*)(sin_ + (wave * 128 + k0 + j) * 16);
#pragma unroll
            for (int q = 0; q < 4; ++q) { const f32x4 v = sp[q]; acc[4 * q] += v[0] * w[j]; acc[4 * q + 1] += v[1] * w[j]; acc[4 * q + 2] += v[2] * w[j]; acc[4 * q + 3] += v[3] * w[j]; } }
    }
#pragma unroll
    for (int b = 0; b < 16; ++b) red[(wave * 64 + lane) * 16 + b] = acc[b] * msk;
    __syncthreads();
    for (int e = tid; e < 64 * 16; e += 512) { const int l = e >> 4, b = e & 15; float sum = 0.f;
#pragma unroll
        for (int w = 0; w < 8; ++w) sum += red[(w * 64 + l) * 16 + b];
        if (l < ucols) out[(size_t)b * out_stride + p0 + l] = sum + (bias ? bias[p0 + l] : 0.f); }
    __syncthreads();
}
__device__ __forceinline__ float wsum(float v) {
    v += __int_as_float(__builtin_amdgcn_ds_swizzle(__float_as_int(v), 0x041F)); v += __int_as_float(__builtin_amdgcn_ds_swizzle(__float_as_int(v), 0x081F));
    v += __int_as_float(__builtin_amdgcn_ds_swizzle(__float_as_int(v), 0x101F)); v += __int_as_float(__builtin_amdgcn_ds_swizzle(__float_as_int(v), 0x201F));
    v += __int_as_float(__builtin_amdgcn_ds_swizzle(__float_as_int(v), 0x401F));
    auto rr = __builtin_amdgcn_permlane32_swap(__float_as_uint(v), __float_as_uint(v), false, false); return __uint_as_float(rr[0]) + __uint_as_float(rr[1]);
}
__device__ __forceinline__ void phase0a(PR_LAS unsigned char* lds, int wid0, int vcu, int G, const Args& args, int zi, unsigned char* ws) {
    int tid_ = wid0 * 64 + lane_id(); asm volatile("" : "+v"(tid_));
    const int tid = tid_, lane = tid & 63, wave = tid >> 6;
#define PIN(i) ((const float*)args.in[(i) + zi])
    for (int un = vcu; un < DEPTH * (NMOD / 48); un += G) { const int l = un / (NMOD / 48), p0 = (un % (NMOD / 48)) * 48;
        smallm_unit(lds, tid, PIN(1), DM, true, PIN(3) + (size_t)l * DM * NMOD, NMOD, NMOD, false, PIN(4) + (size_t)l * NMOD, (float*)(ws + WS_MOD) + (size_t)l * NB * NMOD, NMOD, p0, 48); }
    { const int* pos = (const int*)args.in[2 + zi]; float* rope = (float*)(ws + WS_ROPE);
      for (int idx = vcu * 512 + tid; idx < T * 16; idx += G * 512) { const int t = idx >> 4, i = idx & 15;
          const float freq = exp2f(-(float)i * (13.287712379549449f / 16.0f)); const float ang = (float)pos[t] * freq;
          rope[t * 32 + i] = cosf(ang); rope[t * 32 + 16 + i] = sinf(ang); } }
    { const float* gws = PIN(7); bf16_t* gw = (bf16_t*)(ws + WS_GW);
      for (int idx = vcu * 512 + tid; idx < DEPTH * NGRP * CHUNK * CHUNK; idx += G * 512) { const int s = idx & 127, t = (idx >> 7) & 127; gw[idx] = (s <= t) ? f2bf(gws[idx]) : (bf16_t)0; } }
    PR_LAS float* scr = (PR_LAS float*)(lds + wave * 16384);
    const int gw_ = vcu * NWAVES + wave, NGW = G * NWAVES;
    constexpr int I_IN = (DM / 64) * (NIN / 32), I_UQ = (QR / 64) * (768 / 32), I_UKV = (KVR / 64) * (1024 / 32), I_OUT = (DM / 64) * (DM / 32), I_1 = (DM / 64) * (DFF / 32), I_2 = (DFF / 64) * (DM / 32);
    constexpr int I_LAYER = I_IN + I_UQ + I_UKV + I_OUT + I_1 + I_2;
    for (int it = gw_; it < DEPTH * I_LAYER; it += NGW) {
        const int l = it / I_LAYER; int r = it - l * I_LAYER; unsigned char* wl = ws + WS_W + (size_t)l * WL_STRIDE;
        if (r < I_IN) { tr_item<1>(PIN(6) + (size_t)l * DM * DIN, DIN, (bf16_t*)(wl + WL_IN), DM, 0, NIN / 32, scr, r, lane); continue; } r -= I_IN;
        if (r < I_UQ) { tr_item<2>(PIN(11) + (size_t)l * QR * 768, 768, (bf16_t*)(wl + WL_UQ), QR, 0, 768 / 32, scr, r, lane); continue; } r -= I_UQ;
        if (r < I_UKV) { tr_item<0>(PIN(12) + (size_t)l * KVR * 1024, 1024, (bf16_t*)(wl + WL_UKV), KVR, 0, 1024 / 32, scr, r, lane); continue; } r -= I_UKV;
        if (r < I_OUT) { tr_item<0>(PIN(15) + (size_t)l * DM * DM, DM, (bf16_t*)(wl + WL_OUT), DM, 0, DM / 32, scr, r, lane); continue; } r -= I_OUT;
        if (r < I_1) { tr_item<0>(PIN(17) + (size_t)l * DM * DFF, DFF, (bf16_t*)(wl + WL_1), DM, 0, DFF / 32, scr, r, lane); continue; } r -= I_1;
        tr_item<0>(PIN(18) + (size_t)l * DFF * DM, DM, (bf16_t*)(wl + WL_2), DFF, 0, DM / 32, scr, r, lane);
    }
#undef PIN
}
__device__ __forceinline__ void phase0b(PR_LAS unsigned char* lds, int wid0, int vcu, int G, const Args& args, int zi, unsigned char* ws) {
    int tid_ = wid0 * 64 + lane_id(); asm volatile("" : "+v"(tid_));
    const int tid = tid_, lane = tid & 63, wave = tid >> 6;
#define PIN(i) ((const float*)args.in[(i) + zi])
    float* MOD = (float*)(ws + WS_MOD);
    constexpr int U1 = NIN / 48, U2 = DFF / 64, NUNITS = DEPTH * (U1 + U2);
    for (int un = vcu; un < NUNITS; un += G) { const int l = un / (U1 + U2), r = un % (U1 + U2); const float* modl = MOD + (size_t)l * NB * NMOD;
        if (r < U1) smallm_unit(lds, tid, modl, NMOD, false, PIN(6) + (size_t)l * DM * DIN, DIN, DIN, true, nullptr, (float*)(ws + WS_SHW1) + (size_t)l * NB * NIN, NIN, r * 48, 48);
        else smallm_unit(lds, tid, modl + 3 * DM, NMOD, false, PIN(17) + (size_t)l * DM * DFF, DFF, DFF, false, nullptr, (float*)(ws + WS_SHW2) + (size_t)l * NB * DFF, DFF, (r - U1) * 64, 64); }
    for (int idx = vcu * 512 + tid; idx < DEPTH * NB * DM; idx += G * 512) { const int c = idx & 1023, b = (idx >> 10) & 15, l = idx >> 14; const float* m = MOD + ((size_t)l * NB + b) * NMOD;
        ((float*)(ws + WS_GM1))[idx] = PIN(5)[l * DM + c] * (1.f + m[1 * DM + c]); ((float*)(ws + WS_GM2))[idx] = PIN(16)[l * DM + c] * (1.f + m[4 * DM + c]); }
    { const float* x = PIN(0); const float* g = PIN(5); bf16_t* A = (bf16_t*)(ws + WS_A); float* ssq = (float*)(ws + WS_SSQ1);
      const int nun = NUNITS < G ? NUNITS : G; const int wgt = vcu < nun ? 7 : 12, slot0 = vcu < nun ? 7 * vcu : 7 * nun + 12 * (vcu - nun), nslot = 7 * nun + 12 * (G - nun);
      for (int sl = 0; sl < wgt; ++sl)
      for (int row = (slot0 + sl) * NWAVES + wave; row < T; row += nslot * NWAVES) { const int b = row / SEQ; const f32x4* xr = (const f32x4*)(x + (size_t)row * DM); const float* sc = MOD + (size_t)b * NMOD + DM; float s = 0.f;
#pragma unroll
          for (int j = 0; j < 4; ++j) { const f32x4 v = xr[lane + 64 * j]; s += pg8::hsq4(v); const int c = 4 * (lane + 64 * j); const f32x4 gv = *(const f32x4*)(g + c), sv = *(const f32x4*)(sc + c);
              *(pg8::u32x2*)(A + (size_t)row * DM + c) = pg8::pack4(v * gv * (sv + 1.f)); }
          s = wsum(s); if (lane < 16) ssq[(size_t)row * 16 + lane] = (lane == 0) ? s : 0.f; } }
#undef PIN
}
__device__ __forceinline__ void phase_final(int wid0, int vcu, int G, const float* g, const bf16_t* xb, float* dst) {
    int tid_ = wid0 * 64 + lane_id(); asm volatile("" : "+v"(tid_));
    const int lane = tid_ & 63, wave = tid_ >> 6;
    for (int row = vcu * NWAVES + wave; row < T; row += G * NWAVES) { const pg8::u32x4* xr = (const pg8::u32x4*)(xb + (size_t)row * (2 * DM) + DM); f32x4* yr = (f32x4*)(dst + (size_t)row * DM); f32x4 v[4]; float s = 0.f;
#pragma unroll
        for (int j = 0; j < 2; ++j) { const pg8::u32x4 w = xr[lane + 64 * j]; v[2 * j] = pg8::bf_lo4(w); v[2 * j + 1] = pg8::bf_hi4(w); s += pg8::hsq4(v[2 * j]) + pg8::hsq4(v[2 * j + 1]); }
        const float rstd = rsqrtf(wsum(s) * (1.f / DM) + EPS);
#pragma unroll
        for (int j = 0; j < 2; ++j) { const int c = 8 * (lane + 64 * j); const f32x4 g0 = *(const f32x4*)(g + c), g1 = *(const f32x4*)(g + c + 4); yr[2 * (lane + 64 * j)] = v[2 * j] * rstd * g0; yr[2 * (lane + 64 * j) + 1] = v[2 * j + 1] * rstd * g1; } }
}
}

constexpr int RING_BYTES = 131072;
constexpr int LDSCTL_OFF = 135168, MISC_OFF = LDSCTL_OFF + 320;
constexpr int LDS_BYTES = 147456;
static_assert(att::LDS_BYTES <= LDSCTL_OFF, "attention scratch below the control words");
constexpr int CW_BAR = 4096;
constexpr size_t CTL_ZERO_BYTES = 64 * 1024;

#define GAS __attribute__((address_space(1)))
#define LAS __attribute__((address_space(3)))
typedef GAS unsigned gu32;
#define RLX_AGENT __ATOMIC_RELAXED, __HIP_MEMORY_SCOPE_AGENT
#define XB_TMO      128
#define XB_XCNT(j)  (256  + 64 * (j))
#define XB_XSUB(j)  (1280 + 64 * (j))
#define XB_XGEN(j)  (2304 + 64 * (j))
#define XB_TOP      3328
#define XB_TOPGEN   3392
#define XCD_BAR_WORDS 3456
#define XB_SPIN_CAP (1u << 18)
__device__ __forceinline__ unsigned xb_ld(unsigned* p)              { return __hip_atomic_load(p, __ATOMIC_RELAXED, __HIP_MEMORY_SCOPE_AGENT); }
__device__ __forceinline__ unsigned xb_add(unsigned* p, unsigned v) { return __hip_atomic_fetch_add(p, v, __ATOMIC_RELAXED, __HIP_MEMORY_SCOPE_AGENT); }
__device__ __forceinline__ unsigned xb_xcc_id() { return (unsigned)__builtin_amdgcn_s_getreg((3 << 11) | 20) & 0xFu; }
#define XB_SPIN(cond, bar) do { unsigned _sp = 0; while (cond) { __builtin_amdgcn_s_sleep(1); \
    if ((++_sp & 255u) == 0u) { if (xb_ld(&(bar)[XB_TMO])) break; if (_sp > XB_SPIN_CAP) { atomicAdd(&(bar)[XB_TMO], 1u); break; } } } } while (0)
struct XcdBarrier { unsigned* bar; unsigned x; volatile LAS unsigned* st; };
__device__ __forceinline__ XcdBarrier xcd_barrier_post(unsigned* bar, volatile LAS unsigned* st, int wid0) {
    XcdBarrier b; b.bar = bar; b.x = xb_xcc_id(); b.st = st;
    if (wid0 == 0 && lane_id() == 0) (void)xb_add(&bar[XB_XCNT(b.x)], 1u);
    return b;
}
__device__ __forceinline__ void xcd_barrier_complete(unsigned* bar, unsigned x, unsigned& nloc, unsigned& nx) {
    const unsigned G = gridDim.x * gridDim.y * gridDim.z;
    unsigned sum, cnt, mine, sp = 0u;
    for (;;) {
        sum = 0u; cnt = 0u; mine = 0u;
#pragma unroll
        for (unsigned j = 0; j < 16; ++j) { const unsigned c = xb_ld(&bar[XB_XCNT(j)]); sum += c; cnt += (c > 0u) ? 1u : 0u; mine = (j == x) ? c : mine; }
        if (sum == G) break;
        __builtin_amdgcn_s_sleep(1);
        if ((++sp & 255u) == 0u) { if (xb_ld(&bar[XB_TMO])) break; if (sp > XB_SPIN_CAP) { atomicAdd(&bar[XB_TMO], 1u); break; } }
    }
    nloc = mine > 0u ? mine : 1u; nx = cnt > 0u ? cnt : 1u;
}
__device__ __forceinline__ void xcd_barrier(const XcdBarrier& b, int wid0) {
    asm volatile("s_waitcnt vmcnt(0)" ::: "memory");
    __syncthreads();
    if (wid0 == 0 && lane_id() == 0) {
        unsigned zo = 0; asm volatile("" : "+s"(zo));
        unsigned* bar = b.bar + zo;
        __builtin_amdgcn_s_waitcnt(0);
        unsigned nloc = b.st[0], nx = b.st[1];
        if (nloc == 0u) { xcd_barrier_complete(bar, b.x, nloc, nx); b.st[0] = nloc; b.st[1] = nx; }
        const unsigned old = xb_add(&bar[XB_XSUB(b.x)], 1u);
        const unsigned gen = old / nloc;
        if (old + 1u == (gen + 1u) * nloc) {
            __builtin_amdgcn_fence(__ATOMIC_RELEASE, "agent");
            asm volatile("s_waitcnt vmcnt(0)" ::: "memory");
            const unsigned og = xb_add(&bar[XB_TOP], 1u);
            const unsigned tg = og / nx;
            if (og + 1u == (tg + 1u) * nx) xb_add(&bar[XB_TOPGEN], 1u);
            else XB_SPIN(xb_ld(&bar[XB_TOPGEN]) == tg, bar);
            __builtin_amdgcn_fence(__ATOMIC_ACQUIRE, "agent");
            xb_add(&bar[XB_XGEN(b.x)], 1u);
            asm volatile("s_waitcnt vmcnt(0)" ::: "memory");
        } else {
            XB_SPIN(xb_ld(&bar[XB_XGEN(b.x)]) == gen, bar);
            __builtin_amdgcn_fence(__ATOMIC_ACQUIRE, "agent");
            asm volatile("s_waitcnt vmcnt(0)" ::: "memory");
        }
    }
    __syncthreads();
}

constexpr int PH_P0A = 0, PH_P0B = 1, PH_L0 = 2, PH_PER_LAYER = 7, PH_FINAL = PH_L0 + DEPTH * PH_PER_LAYER, PH_END = PH_FINAL + 1;

#ifdef PROBE_SEL
#define MK_STAMP(i) do { if (wid0 == 0 && lane_id() == 0) ((volatile LAS unsigned long long*)(L + LDSCTL_OFF + 1024))[(i)] = __builtin_amdgcn_s_memrealtime(); } while (0)
#else
#define MK_STAMP(i) do {} while (0)
#endif
#define MK_IN_(k) (lo <= (k) && (k) < hi)
#define MK_SEAM(k) do { if (MK_IN_(k) && MK_IN_((k) + 1)) xcd_barrier(bar, wid0); } while (0)
#define MK_PTRS() int zi = 0; asm volatile("" : "+s"(zi)); unsigned char* ws = args.ws + zi; float* out = args.out + zi; (void)out; (void)ws
#define INP(i) ((const float*)args.in[(i) + zi])
template <int l>
__device__ __forceinline__ void layer_phases(const Args& args, LAS unsigned char* L, const XcdBarrier& bar, int wid0, int vcu, int G, int bx, int lo, int hi) {
    constexpr int P = PH_L0 + l * PH_PER_LAYER;
    if (MK_IN_(P + 0)) { MK_STAMP(2 * (P + 0)); MK_PTRS();
        pg8::Gemm g{(bf16_t*)(ws + WS_A), (const bf16_t*)(ws + WS_W + (size_t)l * WL_STRIDE + WL_IN), T, NIN, DM, DM}; pg8::StaticOrder S; S.init(T, NIN, G, bx);
        pg8::EpiIn E{(float*)(ws + WS_SSQ1), (float*)(ws + WS_SHW1) + (size_t)l * NB * NIN, INP(9) + l * QR, INP(10) + l * KVR, (float*)(ws + WS_ROPE), (bf16_t*)(ws + WS_U), (bf16_t*)(ws + WS_VN), (bf16_t*)(ws + WS_CQ), (bf16_t*)(ws + WS_CKV), (bf16_t*)(ws + WS_KR), (float*)(ws + WS_SSQQ)};
        pg8::gemm_phase<pg8::EpiIn, pg8::StaticOrder, true, true>(L, g, S, E, wid0); }
    MK_STAMP(2 * (P + 0) + 1); MK_SEAM(P + 0);
    if (MK_IN_(P + 1)) { MK_STAMP(2 * (P + 1)); MK_PTRS();
        { pg8::Gemm g{(bf16_t*)(ws + WS_CQ), (const bf16_t*)(ws + WS_W + (size_t)l * WL_STRIDE + WL_UQ), T, 768, QR, QR}; pg8::StaticOrder S; S.init(T, 768, G, bx);
          pg8::EpiUp<false> E{(float*)(ws + WS_SSQQ), (float*)(ws + WS_ROPE), (bf16_t*)(ws + WS_Q), (bf16_t*)(ws + WS_KN), (bf16_t*)(ws + WS_V)};
          pg8::gemm_phase<pg8::EpiUp<false>, pg8::StaticOrder, true, true>(L, g, S, E, wid0); }
        { pg8::Gemm g{(bf16_t*)(ws + WS_CKV), (const bf16_t*)(ws + WS_W + (size_t)l * WL_STRIDE + WL_UKV), T, 1024, KVR, KVR}; pg8::KvOrder S; S.init(T, 1024, G, bx);
          pg8::EpiUp<true> E{(float*)(ws + WS_SSQQ), (float*)(ws + WS_ROPE), (bf16_t*)(ws + WS_Q), (bf16_t*)(ws + WS_KN), (bf16_t*)(ws + WS_V)};
          pg8::gemm_phase<pg8::EpiUp<true>, pg8::KvOrder, true, true>(L, g, S, E, wid0); }
        MK_STAMP(2 * (P + 1) + 1); }
    if (MK_IN_(P + 2)) { MK_STAMP(2 * (P + 2)); MK_PTRS();
        gm::gmlp_phase(L, wid0, vcu, (bf16_t*)(ws + WS_U), (bf16_t*)(ws + WS_VN), (bf16_t*)(ws + WS_GW) + (size_t)l * NGRP * CHUNK * CHUNK, INP(8) + l * NGRP * CHUNK, INP(13) + l * DG, (bf16_t*)out, (float*)(ws + WS_SSQY)); }
    MK_STAMP(2 * (P + 2) + 1); MK_SEAM(P + 2);
    if (MK_IN_(P + 3)) { MK_STAMP(2 * (P + 3)); MK_PTRS();
        att::attn_phase((LAS char*)L, wid0, vcu, (bf16_t*)(ws + WS_Q), (bf16_t*)(ws + WS_KN), (bf16_t*)(ws + WS_KR), (bf16_t*)(ws + WS_V), INP(14) + l * DG, (bf16_t*)out, (float*)(ws + WS_SSQY)); }
    MK_STAMP(2 * (P + 3) + 1); MK_SEAM(P + 3);
    if (MK_IN_(P + 4)) { MK_STAMP(2 * (P + 4)); MK_PTRS();
        pg8::Gemm g{(const bf16_t*)out, (const bf16_t*)(ws + WS_W + (size_t)l * WL_STRIDE + WL_OUT), T, DM, DM, YLD};   pg8::StaticOrder S; S.init(T, DM, G, bx);
        pg8::EpiRes<true, l == 0> E{(float*)(ws + WS_SSQY), l == 0 ? (const void*)INP(0) : (const void*)out, (bf16_t*)out, (float*)(ws + WS_MOD) + (size_t)l * NB * NMOD + 2 * DM, (float*)(ws + WS_GM2) + (size_t)l * NB * DM, (bf16_t*)(ws + WS_A), (float*)(ws + WS_SSQ2)};
        pg8::gemm_phase<pg8::EpiRes<true, l == 0>, pg8::StaticOrder, true, true>(L, g, S, E, wid0); }
    MK_STAMP(2 * (P + 4) + 1); MK_SEAM(P + 4);
    if (MK_IN_(P + 5)) { MK_STAMP(2 * (P + 5)); MK_PTRS();
        pg8::Gemm g{(bf16_t*)(ws + WS_A), (const bf16_t*)(ws + WS_W + (size_t)l * WL_STRIDE + WL_1), T, DFF, DM, DM}; pg8::StaticOrder S; S.init(T, DFF, G, bx);
        pg8::EpiFf1 E{(float*)(ws + WS_SSQ2), (float*)(ws + WS_SHW2) + (size_t)l * NB * DFF, (bf16_t*)(ws + WS_H)};
        pg8::gemm_phase<pg8::EpiFf1, pg8::StaticOrder, true, true>(L, g, S, E, wid0); }
    MK_STAMP(2 * (P + 5) + 1); MK_SEAM(P + 5);
    if (MK_IN_(P + 6)) { MK_STAMP(2 * (P + 6)); MK_PTRS();
        pg8::Gemm g{(bf16_t*)(ws + WS_H), (const bf16_t*)(ws + WS_W + (size_t)l * WL_STRIDE + WL_2), T, DM, DFF, DFF}; pg8::StaticOrder S; S.init(T, DM, G, bx);
        pg8::EpiRes<false, false> E{nullptr, (const void*)out, (bf16_t*)out, (float*)(ws + WS_MOD) + (size_t)l * NB * NMOD + 5 * DM, (l + 1 < DEPTH) ? (float*)(ws + WS_GM1) + (size_t)(l + 1) * NB * DM : nullptr, (bf16_t*)(ws + WS_A), (float*)(ws + WS_SSQ1)};
        pg8::gemm_phase<pg8::EpiRes<false, false>, pg8::StaticOrder, true, true>(L, g, S, E, wid0); }
    MK_STAMP(2 * (P + 6) + 1); MK_SEAM(P + 6);
}
__global__ void __launch_bounds__(NWAVES * 64, 2) mk_fwd(Args args) {
    extern __shared__ __attribute__((aligned(16))) unsigned char lds[];
    LAS unsigned char* L = (LAS unsigned char*)lds;
    volatile LAS unsigned* MISC = (volatile LAS unsigned*)(L + MISC_OFF);
    const int wid0 = __builtin_amdgcn_readfirstlane((int)threadIdx.x >> 6);
    const int G = gridDim.x, bx = blockIdx.x, vcu = (G % 8 == 0) ? (bx % 8) * (G / 8) + bx / 8 : bx;
    { const int t0 = wid0 * 64 + lane_id(); for (int u = t0; u < (LDS_BYTES - LDSCTL_OFF) / 4; u += NWAVES * 64) ((LAS unsigned*)(L + LDSCTL_OFF))[u] = 0u; }
    __syncthreads();
    const int lo = __builtin_amdgcn_readfirstlane(args.ph_lo), hi = __builtin_amdgcn_readfirstlane(args.ph_hi);
    unsigned* barw = (unsigned*)(args.ws + WS_CTL) + CW_BAR + __builtin_amdgcn_readfirstlane(args.li) * XCD_BAR_WORDS;
    XcdBarrier bar; bar.bar = barw; bar.x = 0; bar.st = nullptr;
    if (hi - lo > 1) bar = xcd_barrier_post(barw, MISC + 8, wid0);
    if (MK_IN_(PH_P0A)) { MK_STAMP(2 * (PH_P0A)); MK_PTRS(); pro::phase0a(L, wid0, vcu, G, args, zi, ws); }
    MK_STAMP(2 * PH_P0A + 1); MK_SEAM(PH_P0A);
    if (MK_IN_(PH_P0B)) { MK_STAMP(2 * (PH_P0B)); MK_PTRS(); pro::phase0b(L, wid0, vcu, G, args, zi, ws); }
    MK_STAMP(2 * PH_P0B + 1); MK_SEAM(PH_P0B);
    layer_phases<0>(args, L, bar, wid0, vcu, G, bx, lo, hi);
    layer_phases<1>(args, L, bar, wid0, vcu, G, bx, lo, hi);
    if (MK_IN_(PH_FINAL)) { MK_STAMP(2 * (PH_FINAL)); MK_PTRS(); pro::phase_final(wid0, vcu, G, INP(19), (const bf16_t*)out, out); }
    MK_STAMP(2 * PH_FINAL + 1);
#ifdef PROBE_SEL
    if (bx == 0 && wid0 == 0 && lane_id() == 0) {
        volatile LAS unsigned long long* st = (volatile LAS unsigned long long*)(L + LDSCTL_OFF + 1024); unsigned long long sel = 0;
        if (PROBE_SEL >= 0) sel = st[2 * PROBE_SEL + 1] - st[2 * PROBE_SEL];
        else { for (int k = 0; k < PH_FINAL; ++k) if (k != PH_L0 + 1 && k != PH_L0 + PH_PER_LAYER + 1) { int nx = k + 1; sel += st[2 * nx] - st[2 * k + 1]; } }
        const unsigned long long t0 = __builtin_amdgcn_s_memrealtime(), t1 = t0 + PROBE_MULT * sel;
        while (__builtin_amdgcn_s_memrealtime() < t1) __builtin_amdgcn_s_sleep(8);
    }
#endif
}

#ifndef ONE_LAUNCH
#define ONE_LAUNCH 1
#endif
#ifndef MK_PRO
#define MK_PRO 1
#endif
#ifndef MK_IN
#define MK_IN 1
#endif
#ifndef MK_UP
#define MK_UP 1
#endif
#ifndef MK_GMLP
#define MK_GMLP 1
#endif
#ifndef MK_ATTN
#define MK_ATTN 1
#endif
#ifndef MK_OUT
#define MK_OUT 1
#endif
#ifndef MK_FF1
#define MK_FF1 1
#endif
#ifndef MK_FF2
#define MK_FF2 1
#endif
template <class Epi> static void gemm_naive(hipStream_t st, const bf16_t* A, int lda, const bf16_t* Bt, int ldb, int M, int N, int K, const Epi& e) {
    hipLaunchKernelGGL((k_gemm_naive<Epi>), dim3(N / 64, M / 64), dim3(256), 0, st, A, lda, Bt, ldb, K, e);
}
static int g_grid = 0;
static void launch_mk(hipStream_t st, Args a, int lo, int hi, int li = 0, int flags = 0) {
    a.ph_lo = lo; a.ph_hi = hi; a.li = li; a.flags = flags;
    hipLaunchKernelGGL(mk_fwd, dim3(g_grid), dim3(NWAVES * 64), LDS_BYTES, st, a);
}
extern "C" void kernel_launch(void* const* d_in, const int* in_sizes, int n_in, void* d_out, int out_size, void* d_ws, size_t ws_size, hipStream_t stream) {
    if (n_in != 20 || out_size != T * DM || ws_size < WS_END) { fprintf(stderr, "kernel_launch: unexpected sizes n_in %d out %d ws %zu\n", n_in, out_size, ws_size); return; }
    if (g_grid == 0) {
        int dev = 0, cus = 0; hipGetDevice(&dev); hipDeviceGetAttribute(&cus, hipDeviceAttributeMultiprocessorCount, dev);
        if (hipFuncSetAttribute((const void*)mk_fwd, hipFuncAttributeMaxDynamicSharedMemorySize, LDS_BYTES) != hipSuccess) fprintf(stderr, "kernel_launch: hipFuncSetAttribute failed\n");
        g_grid = cus > 0 ? cus : 256;
    }
    const float* x = (const float*)d_in[0]; const float* c = (const float*)d_in[1]; const int* pos = (const int*)d_in[2];
    const float* w_ada = (const float*)d_in[3]; const float* b_ada = (const float*)d_in[4]; const float* g_mix = (const float*)d_in[5];
    const float* w_in = (const float*)d_in[6]; const float* g_ws = (const float*)d_in[7]; const float* g_bs = (const float*)d_in[8];
    const float* g_q = (const float*)d_in[9]; const float* g_kv = (const float*)d_in[10]; const float* w_uq = (const float*)d_in[11]; const float* w_ukv = (const float*)d_in[12];
    const float* g_og = (const float*)d_in[13]; const float* g_oa = (const float*)d_in[14]; const float* w_out = (const float*)d_in[15];
    const float* g_ffn = (const float*)d_in[16]; const float* w_ff1 = (const float*)d_in[17]; const float* w_ff2 = (const float*)d_in[18]; const float* g_fin = (const float*)d_in[19];
    unsigned char* ws = (unsigned char*)d_ws; float* out = (float*)d_out;
    float* MOD = (float*)(ws + WS_MOD); float* SHW1 = (float*)(ws + WS_SHW1); float* SHW2 = (float*)(ws + WS_SHW2); float* RT = (float*)(ws + WS_ROPE);
    float* GM1 = (float*)(ws + WS_GM1); float* GM2 = (float*)(ws + WS_GM2);
    float* SSQ1 = (float*)(ws + WS_SSQ1); float* SSQ2 = (float*)(ws + WS_SSQ2); float* SSQY = (float*)(ws + WS_SSQY); float* SSQQ = (float*)(ws + WS_SSQQ);
    bf16_t* GW = (bf16_t*)(ws + WS_GW); bf16_t* A = (bf16_t*)(ws + WS_A); bf16_t* U = (bf16_t*)(ws + WS_U); bf16_t* VN = (bf16_t*)(ws + WS_VN);
    bf16_t* CQKV = (bf16_t*)(ws + WS_CQKV); bf16_t* KR = (bf16_t*)(ws + WS_KR); bf16_t* Q = (bf16_t*)(ws + WS_Q); bf16_t* KN = (bf16_t*)(ws + WS_KN); bf16_t* V = (bf16_t*)(ws + WS_V);
    bf16_t* Y = (bf16_t*)(ws + WS_Y); bf16_t* H = (bf16_t*)(ws + WS_H); float* GV = (float*)(ws + WS_GV); float* ZL = (float*)(ws + WS_ZL); float* QRT = (float*)(ws + WS_QRT);
    auto WL = [&](int l, size_t off) { return (bf16_t*)(ws + WS_W + (size_t)l * WL_STRIDE + off); };
    Args a{}; for (int i = 0; i < 20; ++i) a.in[i] = d_in[i]; a.out = out; a.ws = ws;
    hipMemsetAsync(ws + WS_CTL, 0, CTL_ZERO_BYTES, stream);

#if ONE_LAUNCH
#ifdef PROBE_DUP
    launch_mk(stream, a, 0, PROBE_DUP + 1, 0); launch_mk(stream, a, PROBE_DUP, PROBE_DUP + 1, 1); launch_mk(stream, a, PROBE_DUP + 1, PH_END, 2);
#elif defined(PROBE_FFN2)
    launch_mk(stream, a, 0, PH_FINAL, 0); launch_mk(stream, a, PH_FINAL - 1, PH_FINAL, 1, 1); launch_mk(stream, a, PH_FINAL, PH_END, 2);
#elif defined(PROBE_FINAL)
    launch_mk(stream, a, 0, PH_FINAL, 0); launch_mk(stream, a, PH_FINAL, PH_END, 1, 2); launch_mk(stream, a, PH_FINAL, PH_END, 2);
#else
    launch_mk(stream, a, 0, PH_END);
#endif
    return;
#endif
#if MK_PRO
    launch_mk(stream, a, PH_P0A, PH_P0A + 1);
    launch_mk(stream, a, PH_P0B, PH_P0B + 1);
#else
    hipLaunchKernelGGL(k_rope_table, dim3(T * 16 / 256), dim3(256), 0, stream, pos, RT);
    hipLaunchKernelGGL(k_prep_gw, dim3(DEPTH * NGRP * CHUNK * CHUNK / 256), dim3(256), 0, stream, g_ws, GW);
    for (int l = 0; l < DEPTH; ++l) {
        hipLaunchKernelGGL(k_prep_w, dim3((NIN * DM + 255) / 256), dim3(256), 0, stream, w_in + (size_t)l * DM * DIN, DM, DIN, WL(l, WL_IN), NIN, 1);
        hipLaunchKernelGGL(k_prep_wup, dim3((NUP * KUP + 255) / 256), dim3(256), 0, stream, w_uq + (size_t)l * QR * 768, w_ukv + (size_t)l * KVR * 1024, WL(l, WL_UP));
        hipLaunchKernelGGL(k_prep_w, dim3(DM * DM / 256), dim3(256), 0, stream, w_out + (size_t)l * DM * DM, DM, DM, WL(l, WL_OUT), DM, 0);
        hipLaunchKernelGGL(k_prep_w, dim3(DFF * DM / 256), dim3(256), 0, stream, w_ff1 + (size_t)l * DM * DFF, DM, DFF, WL(l, WL_1), DFF, 0);
        hipLaunchKernelGGL(k_prep_w, dim3(DFF * DM / 256), dim3(256), 0, stream, w_ff2 + (size_t)l * DFF * DM, DFF, DM, WL(l, WL_2), DM, 0);
        hipLaunchKernelGGL(k_smallm, dim3(NMOD / 64), dim3(512), 0, stream, c, DM, 1, w_ada + (size_t)l * DM * NMOD, NMOD, NMOD, 0, b_ada + (size_t)l * NMOD, MOD + (size_t)l * NB * NMOD, NMOD, NMOD);
    }
    for (int l = 0; l < DEPTH; ++l) {
        hipLaunchKernelGGL(k_smallm, dim3(NIN / 64), dim3(512), 0, stream, MOD + (size_t)l * NB * NMOD + 0, NMOD, 0, w_in + (size_t)l * DM * DIN, DIN, DIN, 1, (const float*)nullptr, SHW1 + (size_t)l * NB * NIN, NIN, NIN);
        hipLaunchKernelGGL(k_smallm, dim3(DFF / 64), dim3(512), 0, stream, MOD + (size_t)l * NB * NMOD + 3 * DM, NMOD, 0, w_ff1 + (size_t)l * DM * DFF, DFF, DFF, 0, (const float*)nullptr, SHW2 + (size_t)l * NB * DFF, DFF, DFF);
    }
    hipLaunchKernelGGL(k_gm, dim3(DEPTH * NB * DM / 256), dim3(256), 0, stream, g_mix, MOD, 1, GM1);
    hipLaunchKernelGGL(k_gm, dim3(DEPTH * NB * DM / 256), dim3(256), 0, stream, g_ffn, MOD, 4, GM2);
    hipLaunchKernelGGL(k_modx, dim3(T / 4), dim3(256), 0, stream, x, g_mix, MOD + 1 * DM, NMOD, A, SSQ1);

#endif
    for (int l = 0; l < DEPTH; ++l) {
        const float* modl = MOD + (size_t)l * NB * NMOD; const int P = PH_L0 + l * PH_PER_LAYER;
#if MK_IN
        launch_mk(stream, a, P + 0, P + 1);
#else
        { EpiInNaive e{0, SSQ1, SHW1 + (size_t)l * NB * NIN, U, GV, ZL}; gemm_naive(stream, A, DM, WL(l, WL_IN), DM, T, NIN, DM, e); }
        hipLaunchKernelGGL(k_vn, dim3(T * NGRP / 4), dim3(256), 0, stream, GV, VN);
        hipLaunchKernelGGL(k_lat, dim3(T / 4), dim3(256), 0, stream, ZL, g_q + l * QR, g_kv + l * KVR, RT, CQKV, SSQQ, KR);
#endif
#if MK_UP
        launch_mk(stream, a, P + 1, P + 2);
#else
        { EpiUpNaive e{0, SSQQ, Q, QRT, KN, V}; gemm_naive(stream, CQKV, KUP, WL(l, WL_UP), KUP, T, NUP, KUP, e); }
        hipLaunchKernelGGL(k_rope_q, dim3(T * NH * 16 / 256), dim3(256), 0, stream, QRT, RT, Q);
#endif
#if MK_GMLP
        launch_mk(stream, a, P + 2, P + 3);
#else
        hipLaunchKernelGGL(k_gmlp_naive, dim3(T), dim3(512), 0, stream, U, VN, GW + (size_t)l * NGRP * CHUNK * CHUNK, g_bs + l * NGRP * CHUNK, g_og + l * DG, Y, SSQY);
#endif
#if MK_ATTN
        launch_mk(stream, a, P + 3, P + 4);
#else
        hipLaunchKernelGGL(k_attn_naive, dim3(T / 64, NH), dim3(64), 0, stream, Q, KN, KR, V, g_oa + l * DG, Y, SSQY);
#endif
#if MK_OUT
        launch_mk(stream, a, P + 4, P + 5);
#else
        { EpiOutNaive e{512, SSQY, l == 0 ? x : out, out, modl + 2 * DM}; gemm_naive(stream, Y, DM, WL(l, WL_OUT), DM, T, DM, DM, e); }
        hipLaunchKernelGGL(k_modx, dim3(T / 4), dim3(256), 0, stream, out, g_ffn + l * DM, modl + 4 * DM, NMOD, A, SSQ2);
#endif
#if MK_FF1
        launch_mk(stream, a, P + 5, P + 6);
#else
        { EpiFf1Naive e{0, SSQ2, SHW2 + (size_t)l * NB * DFF, H}; gemm_naive(stream, A, DM, WL(l, WL_1), DM, T, DFF, DM, e); }
#endif
#if MK_FF2
        launch_mk(stream, a, P + 6, P + 7);
#else
        { EpiFf2Naive e{0, out, modl + 5 * DM}; gemm_naive(stream, H, DFF, WL(l, WL_2), DFF, T, DM, DFF, e); }
        if (l + 1 < DEPTH) hipLaunchKernelGGL(k_modx, dim3(T / 4), dim3(256), 0, stream, out, g_mix + (l + 1) * DM, MOD + (size_t)(l + 1) * NB * NMOD + 1 * DM, NMOD, A, SSQ1);
#endif
    }
#if MK_PRO
    launch_mk(stream, a, PH_FINAL, PH_FINAL + 1);
#else
    hipLaunchKernelGGL(k_final, dim3(T / 4), dim3(256), 0, stream, out, g_fin, out);
#endif
}
```

```cpp
#include <hip/hip_runtime.h>
#define PROBE_MULT 8
#include <cstdint>
#include <cstdio>
#include <cmath>

typedef unsigned short bf16_t;
typedef short bf16x8 __attribute__((ext_vector_type(8)));
typedef float f32x4 __attribute__((ext_vector_type(4)));

constexpr int DM = 1024, NB = 16, SEQ = 2048, DEPTH = 2, T = NB * SEQ;
constexpr int DG = 512, NGRP = 8, GD = 64, CHUNK = 128, NH = 8, NOPE = 64, ROPE = 32, VD = 64;
constexpr int QR = 256, KVR = 128, DFF = 4096, DIN = 1440, NMOD = 6 * DM;
constexpr int NIN = 1536;
constexpr int NUP = 1792, KUP = 384;
constexpr float EPS = 1e-6f;
constexpr int YLD = 2 * DM;
constexpr float QSCALE = 0.10206207261596577f * 1.4426950408889634f;

constexpr size_t MiB = 1u << 20;
constexpr size_t WS_CTL = 0;
constexpr size_t WS_MOD = 1 * MiB;
constexpr size_t WS_SHW1 = 2 * MiB;
constexpr size_t WS_GM1 = 2 * MiB + 512 * 1024;
constexpr size_t WS_GM2 = 2 * MiB + 768 * 1024;
constexpr size_t WS_SHW2 = 3 * MiB;
constexpr size_t WS_ROPE = 4 * MiB;
constexpr size_t WS_SSQ1 = 8 * MiB;
constexpr size_t WS_SSQ2 = 10 * MiB;
constexpr size_t WS_SSQY = 12 * MiB;
constexpr size_t WS_SSQQ = 14 * MiB;
constexpr size_t WS_GW = 15 * MiB;
constexpr size_t WS_W = 16 * MiB;
constexpr size_t WL_IN = 0, WL_UP = 3 * MiB, WL_OUT = 4 * MiB + MiB / 2, WL_1 = 6 * MiB + MiB / 2, WL_2 = 14 * MiB + MiB / 2, WL_STRIDE = 22 * MiB + MiB / 2;
constexpr size_t WS_A = 64 * MiB;
constexpr size_t WS_U = 128 * MiB;
constexpr size_t WS_VN = 160 * MiB;
constexpr size_t WS_CQKV = 192 * MiB;
constexpr size_t WS_CQ = 192 * MiB;
constexpr size_t WS_CKV = 208 * MiB;
constexpr size_t WL_UQ = 3 * MiB, WL_UKV = 3 * MiB + MiB / 2;
constexpr size_t WS_KR = 216 * MiB;
constexpr size_t WS_Q = 218 * MiB;
constexpr size_t WS_KN = 266 * MiB;
constexpr size_t WS_V = 298 * MiB;
constexpr size_t WS_Y = 330 * MiB;
constexpr size_t WS_H = 128 * MiB;
constexpr size_t WS_GV = 394 * MiB;
constexpr size_t WS_ZL = 458 * MiB;
constexpr size_t WS_QRT = 394 * MiB;
constexpr size_t WS_DUMMY = 448 * MiB;
constexpr size_t WS_END = 512 * MiB;

__device__ __forceinline__ bf16_t f2bf(float f) { unsigned u = __float_as_uint(f); return (bf16_t)((u + 0x7fffu + ((u >> 16) & 1u)) >> 16); }
__device__ __forceinline__ float bf2f(bf16_t h) { return __uint_as_float(((unsigned)h) << 16); }
__device__ __forceinline__ float gelu_tanh(float x) { const float y2 = -2.302208198f * (x + 0.044715f * x * x * x); return x * __builtin_amdgcn_rcpf(1.f + __builtin_amdgcn_exp2f(y2)); }
__device__ __forceinline__ float wave_sum(float v) {
#pragma unroll
    for (int o = 1; o < 64; o <<= 1) v += __shfl_xor(v, o);
    return v;
}
__host__ __device__ __forceinline__ int win_src(int p) {
    if (p < 512) return p;
    if (p < 1024) { const int q = p - 512, tile = q >> 8, r = q & 255, bj = r >> 7, wc = (r >> 5) & 3, j = r & 31; return 512 + tile * 256 + 64 * wc + 32 * bj + j; }
    if (p < 1408) return p;
    if (p < 1440) { const int j = p - 1408, fq = j >> 3, n = (j >> 2) & 1, i = j & 3; return 1408 + 16 * n + 4 * fq + i; }
    return -1;
}
__host__ __device__ __forceinline__ int wup_qcol(int p) {
    const int G = p >> 5, h = G / 3, gi = G - 3 * h, j = p & 31;
    if (gi < 2) return p;
    const int fq = j >> 3, n = (j >> 2) & 1, i = j & 3; return h * 96 + 64 + 16 * n + 4 * fq + i;
}

__global__ void k_rope_table(const int* pos, float* rope) {
    const int idx = blockIdx.x * blockDim.x + threadIdx.x; if (idx >= T * 16) return;
    const int t = idx >> 4, i = idx & 15;
    const float freq = powf(10000.0f, -(float)(2 * i) / 32.0f);
    const float ang = (float)pos[t] * freq;
    rope[t * 32 + i] = cosf(ang); rope[t * 32 + 16 + i] = sinf(ang);
}
__global__ void k_prep_w(const float* W, int K, int N, bf16_t* out, int Nphys, int mode) {
    const size_t idx = (size_t)blockIdx.x * blockDim.x + threadIdx.x; if (idx >= (size_t)Nphys * K) return;
    const int p = (int)(idx / K), k = (int)(idx % K);
    const int s = mode == 1 ? win_src(p) : p;
    out[idx] = (s >= 0 && s < N) ? f2bf(W[(size_t)k * N + s]) : (bf16_t)0;
}
__global__ void k_prep_wup(const float* wuq, const float* wukv, bf16_t* out) {
    const int idx = blockIdx.x * blockDim.x + threadIdx.x; if (idx >= NUP * KUP) return;
    const int p = idx / KUP, k = idx % KUP; float v = 0.f;
    if (p < 768) { if (k < 256) v = wuq[(size_t)k * 768 + wup_qcol(p)]; }
    else { if (k >= 256) v = wukv[(size_t)(k - 256) * 1024 + (p - 768)]; }
    out[idx] = f2bf(v);
}
__global__ void k_prep_gw(const float* ws, bf16_t* gw) {
    const int idx = blockIdx.x * blockDim.x + threadIdx.x; if (idx >= DEPTH * NGRP * CHUNK * CHUNK) return;
    const int s = idx & 127, t = (idx >> 7) & 127;
    gw[idx] = (s <= t) ? f2bf(ws[idx]) : (bf16_t)0;
}
__global__ __launch_bounds__(512) void k_smallm(const float* in, int in_stride, int act, const float* W, int ldw, int N, int mode, const float* bias, float* out, int out_stride, int Nphys) {
    __shared__ float sin_[1024 * 16];
    __shared__ float red[8 * 64 * 16];
    const int tid = threadIdx.x, lane = tid & 63, wave = tid >> 6;
    for (int e = tid; e < 16 * 1024; e += 512) { const int b = e >> 10, k = e & 1023; float v = in[(size_t)b * in_stride + k]; if (act) v = v / (1.f + __expf(-v)); sin_[k * 16 + b] = v; }
    __syncthreads();
    const int p = blockIdx.x * 64 + lane; const int s = (p < Nphys) ? (mode == 1 ? win_src(p) : p) : -1; const bool ok = (s >= 0 && s < N);
    float acc[16];
#pragma unroll
    for (int b = 0; b < 16; ++b) acc[b] = 0.f;
    for (int k = wave * 128; k < wave * 128 + 128; ++k) {
        const float w = ok ? W[(size_t)k * ldw + s] : 0.f;
        const f32x4* sp = (const f32x4*)(sin_ + k * 16);
#pragma unroll
        for (int q = 0; q < 4; ++q) { const f32x4 v = sp[q]; acc[4 * q] += v[0] * w; acc[4 * q + 1] += v[1] * w; acc[4 * q + 2] += v[2] * w; acc[4 * q + 3] += v[3] * w; }
    }
#pragma unroll
    for (int b = 0; b < 16; ++b) red[(wave * 64 + lane) * 16 + b] = acc[b];
    __syncthreads();
    for (int e = tid; e < 64 * 16; e += 512) { const int l = e >> 4, b = e & 15; float sum = 0.f;
#pragma unroll
        for (int w = 0; w < 8; ++w) sum += red[(w * 64 + l) * 16 + b];
        const int pp = blockIdx.x * 64 + l; if (pp < Nphys) out[(size_t)b * out_stride + pp] = sum + (bias ? bias[pp] : 0.f); }
}
__global__ __launch_bounds__(256) void k_modx(const float* x, const float* g, const float* sc  , int sc_stride, bf16_t* A, float* ssq) {
    const int row = blockIdx.x * 4 + (threadIdx.x >> 6), lane = threadIdx.x & 63; if (row >= T) return;
    const int b = row / SEQ; const f32x4* xr = (const f32x4*)(x + (size_t)row * DM); float s = 0.f;
#pragma unroll
    for (int j = 0; j < 4; ++j) { const f32x4 v = xr[lane + 64 * j]; s += v[0] * v[0] + v[1] * v[1] + v[2] * v[2] + v[3] * v[3];
        const int c = 4 * (lane + 64 * j); const f32x4 gv = *(const f32x4*)(g + c), sv = *(const f32x4*)(sc + (size_t)b * sc_stride + c);
        unsigned lo = f2bf(v[0] * gv[0] * (1.f + sv[0])) | ((unsigned)f2bf(v[1] * gv[1] * (1.f + sv[1])) << 16);
        unsigned hi = f2bf(v[2] * gv[2] * (1.f + sv[2])) | ((unsigned)f2bf(v[3] * gv[3] * (1.f + sv[3])) << 16);
        *(uint2*)(A + (size_t)row * DM + c) = make_uint2(lo, hi); }
    s = wave_sum(s);
    if (lane < 16) ssq[(size_t)row * 16 + lane] = (lane == 0) ? s : 0.f;
}
__global__ __launch_bounds__(256) void k_final(const float* x, const float* g, float* out) {
    const int row = blockIdx.x * 4 + (threadIdx.x >> 6), lane = threadIdx.x & 63; if (row >= T) return;
    const f32x4* xr = (const f32x4*)(x + (size_t)row * DM); f32x4 v[4]; float s = 0.f;
#pragma unroll
    for (int j = 0; j < 4; ++j) { v[j] = xr[lane + 64 * j]; s += v[j][0] * v[j][0] + v[j][1] * v[j][1] + v[j][2] * v[j][2] + v[j][3] * v[j][3]; }
    const float rstd = rsqrtf(wave_sum(s) * (1.f / DM) + EPS);
#pragma unroll
    for (int j = 0; j < 4; ++j) { const int c = 4 * (lane + 64 * j); const f32x4 gv = *(const f32x4*)(g + c); *(f32x4*)(out + (size_t)row * DM + c) = v[j] * rstd * gv; }
}

template <class Epi>
__global__ __launch_bounds__(256) void k_gemm_naive(const bf16_t* A, int lda, const bf16_t* Bt, int ldb, int K, Epi epi) {
    const int wave = threadIdx.x >> 6, lane = threadIdx.x & 63, fr = lane & 15, fq = lane >> 4;
    const int row0 = blockIdx.y * 64 + wave * 16, col0 = blockIdx.x * 64;
    f32x4 acc[4];
#pragma unroll
    for (int n = 0; n < 4; ++n) acc[n] = (f32x4){0.f, 0.f, 0.f, 0.f};
    const bf16_t* ap = A + (size_t)(row0 + fr) * lda + 8 * fq;
    const bf16_t* bp = Bt + (size_t)(col0 + fr) * ldb + 8 * fq;
    for (int k0 = 0; k0 < K; k0 += 32) {
        if (Epi::HAS_MID) { if (k0 == epi.ksplit) {
#pragma unroll
            for (int r = 0; r < 4; ++r) { const float m = epi.mid(row0 + 4 * fq + r);
#pragma unroll
                for (int n = 0; n < 4; ++n) acc[n][r] *= m; } } }
        const bf16x8 a = *(const bf16x8*)(ap + k0);
#pragma unroll
        for (int n = 0; n < 4; ++n) { const bf16x8 b = *(const bf16x8*)(bp + (size_t)n * 16 * ldb + k0); acc[n] = __builtin_amdgcn_mfma_f32_16x16x32_bf16(a, b, acc[n], 0, 0, 0); }
    }
#pragma unroll
    for (int r = 0; r < 4; ++r) { const int row = row0 + 4 * fq + r; const float rs = epi.rowscale(row);
#pragma unroll
        for (int n = 0; n < 4; ++n) epi(row, col0 + 16 * n + fr, acc[n][r], rs); }
}
__device__ __forceinline__ float sum16(const float* p) { float s = 0.f;
#pragma unroll
    for (int i = 0; i < 16; ++i) s += p[i]; return s; }
__device__ __forceinline__ float sum8(const float* p) { float s = 0.f;
#pragma unroll
    for (int i = 0; i < 8; ++i) s += p[i]; return s; }
__device__ __forceinline__ float sum4(const float* p) { return (p[0] + p[1]) + (p[2] + p[3]); }

struct EpiInNaive {
    static constexpr bool HAS_MID = false; int ksplit;
    const float* ssq1; const float* shw1; bf16_t* U; float* GV; float* ZL;
    __device__ float mid(int) const { return 1.f; }
    __device__ float rowscale(int row) const { return rsqrtf(sum16(ssq1 + (size_t)row * 16) * (1.f / DM) + EPS); }
    __device__ void operator()(int row, int p, float acc, float rs) const {
        const int L = win_src(p); if (L < 0) return;
        const float z = rs * acc + shw1[(row / SEQ) * NIN + p];
        if (L < 512) U[(size_t)row * 512 + L] = f2bf(gelu_tanh(z));
        else if (L < 1024) GV[(size_t)row * 512 + (L - 512)] = gelu_tanh(z);
        else ZL[(size_t)row * 416 + (L - 1024)] = z;
    }
};
struct EpiUpNaive {
    static constexpr bool HAS_MID = false; int ksplit;
    const float* ssqq; bf16_t* Q; float* QRT; bf16_t* KN; bf16_t* V;
    __device__ float mid(int) const { return 1.f; }
    __device__ float rowscale(int) const { return 1.f; }
    __device__ void operator()(int row, int p, float acc, float) const {
        if (p < 768) { const float rq = rsqrtf(sum4(ssqq + (size_t)row * 8) * (1.f / QR) + EPS); const float v = acc * rq * QSCALE;
            const int L = wup_qcol(p), h = L / 96, d = L - 96 * h;
            if (d < 64) Q[(size_t)row * 768 + L] = f2bf(v); else QRT[(size_t)row * 256 + h * 32 + (d - 64)] = v; }
        else { const float rk = rsqrtf(sum4(ssqq + (size_t)row * 8 + 4) * (1.f / KVR) + EPS); const float v = acc * rk;
            const int c = p - 768, h = c >> 7, d = c & 127;
            if (d < 64) KN[(size_t)row * 512 + h * 64 + d] = f2bf(v); else V[(size_t)row * 512 + h * 64 + (d - 64)] = f2bf(v); }
    }
};
struct EpiOutNaive {
    static constexpr bool HAS_MID = true; int ksplit;
    const float* ssqy; const float* xin; float* xout; const float* gate;
    __device__ float rg(int row) const { return rsqrtf(sum8(ssqy + (size_t)row * 16) * (1.f / 512) + EPS); }
    __device__ float ra(int row) const { return rsqrtf(sum8(ssqy + (size_t)row * 16 + 8) * (1.f / 512) + EPS); }
    __device__ float mid(int row) const { return rg(row) / ra(row); }
    __device__ float rowscale(int row) const { return ra(row); }
    __device__ void operator()(int row, int n, float acc, float rs) const {
        const size_t i = (size_t)row * DM + n; xout[i] = xin[i] + gate[(size_t)(row / SEQ) * NMOD + n] * (rs * acc);
    }
};
struct EpiFf1Naive {
    static constexpr bool HAS_MID = false; int ksplit;
    const float* ssq2; const float* shw2; bf16_t* H;
    __device__ float mid(int) const { return 1.f; }
    __device__ float rowscale(int row) const { return rsqrtf(sum16(ssq2 + (size_t)row * 16) * (1.f / DM) + EPS); }
    __device__ void operator()(int row, int n, float acc, float rs) const {
        const float z = rs * acc + shw2[(row / SEQ) * DFF + n]; const float r = fmaxf(z, 0.f); H[(size_t)row * DFF + n] = f2bf(r * r);
    }
};
struct EpiFf2Naive {
    static constexpr bool HAS_MID = false; int ksplit;
    float* x; const float* gate;
    __device__ float mid(int) const { return 1.f; }
    __device__ float rowscale(int) const { return 1.f; }
    __device__ void operator()(int row, int n, float acc, float) const {
        const size_t i = (size_t)row * DM + n; x[i] = x[i] + gate[(size_t)(row / SEQ) * NMOD + n] * acc;
    }
};

__global__ __launch_bounds__(256) void k_vn(const float* GV, bf16_t* VN) {
    const int w = blockIdx.x * 4 + (threadIdx.x >> 6), lane = threadIdx.x & 63; if (w >= T * NGRP) return;
    const int row = w >> 3, g = w & 7; const float v = GV[(size_t)row * 512 + g * 64 + lane];
    const float mu = wave_sum(v) * (1.f / 64); const float d = v - mu; const float var = wave_sum(d * d) * (1.f / 64);
    VN[(size_t)row * 512 + g * 64 + lane] = f2bf(d * rsqrtf(var + EPS));
}
__global__ __launch_bounds__(256) void k_lat(const float* ZL, const float* gq, const float* gkv, const float* rope, bf16_t* CQKV, float* ssqq, bf16_t* KR) {
    const int row = blockIdx.x * 4 + (threadIdx.x >> 6), lane = threadIdx.x & 63; if (row >= T) return;
    const float* z = ZL + (size_t)row * 416; float sq = 0.f, sk = 0.f;
#pragma unroll
    for (int j = 0; j < 4; ++j) { const int c = lane + 64 * j; const float v = z[c]; sq += v * v; CQKV[(size_t)row * KUP + c] = f2bf(v * gq[c]); }
#pragma unroll
    for (int j = 0; j < 2; ++j) { const int c = lane + 64 * j; const float v = z[256 + c]; sk += v * v; CQKV[(size_t)row * KUP + 256 + c] = f2bf(v * gkv[c]); }
    sq = wave_sum(sq); sk = wave_sum(sk);
    if (lane < 8) ssqq[(size_t)row * 8 + lane] = (lane == 0) ? sq : (lane == 4) ? sk : 0.f;
    if (lane < 16) { const float x1 = z[384 + lane], x2 = z[384 + 16 + lane], c = rope[(size_t)row * 32 + lane], s = rope[(size_t)row * 32 + 16 + lane];
        KR[(size_t)row * 32 + lane] = f2bf(x1 * c - x2 * s); KR[(size_t)row * 32 + 16 + lane] = f2bf(x1 * s + x2 * c); }
}
__global__ void k_rope_q(const float* QRT, const float* rope, bf16_t* Q) {
    const int idx = blockIdx.x * blockDim.x + threadIdx.x; if (idx >= T * NH * 16) return;
    const int r = idx & 15, h = (idx >> 4) & 7, row = idx >> 7;
    const float x1 = QRT[(size_t)row * 256 + h * 32 + r], x2 = QRT[(size_t)row * 256 + h * 32 + 16 + r], c = rope[(size_t)row * 32 + r], s = rope[(size_t)row * 32 + 16 + r];
    Q[(size_t)row * 768 + h * 96 + 64 + r] = f2bf(x1 * c - x2 * s); Q[(size_t)row * 768 + h * 96 + 80 + r] = f2bf(x1 * s + x2 * c);
}
__global__ __launch_bounds__(512) void k_gmlp_naive(const bf16_t* U, const bf16_t* VN, const bf16_t* GW  , const float* bs  , const float* gog, bf16_t* Y, float* ssqy) {
    const int row = blockIdx.x, g = threadIdx.x >> 6, d = threadIdx.x & 63, c = g * 64 + d;
    const int tt = row & 127, t0 = row - tt;
    const bf16_t* w = GW + ((size_t)g * CHUNK + tt) * CHUNK; float sum = 0.f;
    for (int s = 0; s <= tt; ++s) sum += bf2f(w[s]) * bf2f(VN[(size_t)(t0 + s) * 512 + c]);
    const float y = bf2f(U[(size_t)row * 512 + c]) * (sum + bs[g * CHUNK + tt]);
    Y[(size_t)row * DM + c] = f2bf(y * gog[c]);
    const float q = wave_sum(y * y); if (d == 0) ssqy[(size_t)row * 16 + g] = q;
}
__global__ __launch_bounds__(64) void k_attn_naive(const bf16_t* Q, const bf16_t* KN, const bf16_t* KR, const bf16_t* V, const float* goa, bf16_t* Y, float* ssqy) {
    const int h = blockIdx.y, row = blockIdx.x * 64 + threadIdx.x, b = row / SEQ, i = row - b * SEQ;
    const int iend = (blockIdx.x * 64 % SEQ) + 63;
    float q[96];
#pragma unroll
    for (int d8 = 0; d8 < 12; ++d8) { const bf16x8 v = *(const bf16x8*)(Q + (size_t)row * 768 + h * 96 + d8 * 8);
#pragma unroll
        for (int j = 0; j < 8; ++j) q[d8 * 8 + j] = bf2f((bf16_t)v[j]); }
    float o[64];
#pragma unroll
    for (int d = 0; d < 64; ++d) o[d] = 0.f;
    float m = -1e30f, l = 0.f;
    const size_t kb = (size_t)b * SEQ;
    for (int j = 0; j <= iend; ++j) {
        const bf16_t* kn = KN + (kb + j) * 512 + h * 64; const bf16_t* kr = KR + (kb + j) * 32; const bf16_t* vv = V + (kb + j) * 512 + h * 64;
        float s = 0.f;
#pragma unroll
        for (int d8 = 0; d8 < 8; ++d8) { const bf16x8 kv = *(const bf16x8*)(kn + d8 * 8);
#pragma unroll
            for (int jj = 0; jj < 8; ++jj) s += q[d8 * 8 + jj] * bf2f((bf16_t)kv[jj]); }
#pragma unroll
        for (int d8 = 0; d8 < 4; ++d8) { const bf16x8 kv = *(const bf16x8*)(kr + d8 * 8);
#pragma unroll
            for (int jj = 0; jj < 8; ++jj) s += q[64 + d8 * 8 + jj] * bf2f((bf16_t)kv[jj]); }
        if (j > i) s = -1e30f;
        const float mn = fmaxf(m, s), alpha = exp2f(m - mn), p = (j > i) ? 0.f : exp2f(s - mn);
        l = l * alpha + p; m = mn;
#pragma unroll
        for (int d8 = 0; d8 < 8; ++d8) { const bf16x8 v8 = *(const bf16x8*)(vv + d8 * 8);
#pragma unroll
            for (int jj = 0; jj < 8; ++jj) o[d8 * 8 + jj] = o[d8 * 8 + jj] * alpha + p * bf2f((bf16_t)v8[jj]); }
    }
    const float inv = 1.f / l; float sq = 0.f;
#pragma unroll
    for (int d8 = 0; d8 < 8; ++d8) { unsigned w[4];
#pragma unroll
        for (int jj = 0; jj < 8; jj += 2) { const float y0 = o[d8 * 8 + jj] * inv, y1 = o[d8 * 8 + jj + 1] * inv; sq += y0 * y0 + y1 * y1;
            w[jj >> 1] = f2bf(y0 * goa[h * 64 + d8 * 8 + jj]) | ((unsigned)f2bf(y1 * goa[h * 64 + d8 * 8 + jj + 1]) << 16); }
        *(uint4*)(Y + (size_t)row * DM + 512 + h * 64 + d8 * 8) = make_uint4(w[0], w[1], w[2], w[3]); }
    ssqy[(size_t)row * 16 + 8 + h] = sq;
}

__global__ void k_gm(const float* g  , const float* mod, int chunk, float* gmt) {
    const int idx = blockIdx.x * blockDim.x + threadIdx.x; if (idx >= DEPTH * NB * DM) return;
    const int c = idx & 1023, b = (idx >> 10) & 15, l = idx >> 14;
    gmt[idx] = g[l * DM + c] * (1.f + mod[((size_t)l * NB + b) * NMOD + chunk * DM + c]);
}
__device__ __forceinline__ int lane_id() { int l; asm volatile("v_mbcnt_lo_u32_b32 %0, -1, 0\n\tv_mbcnt_hi_u32_b32 %0, -1, %0" : "=v"(l)); return l; }
__device__ __forceinline__ float swz_xor16(float v) { return __int_as_float(__builtin_amdgcn_ds_swizzle(__float_as_int(v), 0x401F)); }
__device__ __forceinline__ float swz_xor1(float v) { return __int_as_float(__builtin_amdgcn_ds_swizzle(__float_as_int(v), 0x041F)); }
namespace pg8 {
#define PG8_LAS __attribute__((address_space(3)))
typedef unsigned u32x4 __attribute__((ext_vector_type(4)));
typedef unsigned u32x2 __attribute__((ext_vector_type(2)));
constexpr int BM = 256, BK = 64, HALF = 128, HTB = HALF * BK * 2  , STAGE_BYTES = 8 * HTB, NXCD = 8, WGM = 8;

__host__ __device__ __forceinline__ int lds_byte(int r, int c) { const int st = (r >> 4) * 2 + (c >> 5), rr = r & 15, cc = c & 31, ob = rr * 64 + cc * 2; return st * 1024 + (ob ^ (((ob >> 9) & 1) << 5)); }
__host__ __device__ __forceinline__ void stage_rc(int b, int& R, int& C) { const int st = b / 1024, sb = b % 1024, swz = sb ^ (((sb >> 9) & 1) << 5); R = (st >> 1) * 16 + swz / 64; C = (st & 1) * 32 + (swz % 64) / 2; }
__host__ __device__ __forceinline__ int perm32(int rho) { const int n = rho >> 4, i = rho & 15; return 8 * (i >> 2) + 4 * n + (i & 3); }

struct Unit { int pm, pn; };
struct Gemm { const bf16_t* A; const bf16_t* Bt; int M, N, K, lda; };

struct StaticOrder {
    int nM, nN, nwg, G, c;
    __host__ __device__ void init(int M, int N, int G_, int c_) { nM = M / BM; nN = N / BM; nwg = nM * nN; G = G_; c = c_; }
    __host__ __device__ bool next(int i, Unit& u) const {
        const long L = (long)i * G + c; if (L >= nwg) return false;
        int wgid = (int)L; { const int q = nwg / NXCD, r = nwg % NXCD, xcd = wgid % NXCD, off = wgid / NXCD; wgid = (xcd < r ? xcd * (q + 1) : r * (q + 1) + (xcd - r) * q) + off; }
        const int nig = WGM * nN, gid = wgid / nig, fm = gid * WGM, gsz = (nM - fm) < WGM ? (nM - fm) : WGM;
        u.pm = fm + ((wgid % nig) % gsz); u.pn = (wgid % nig) / gsz; return true;
    }
    __device__ __forceinline__ void a_ready(const Unit&) const {}
    __device__ __forceinline__ void done(const Unit&) const {}
};

struct KvOrder : StaticOrder {
    __host__ __device__ bool next(int i, Unit& u) const {
        if (G != 256 || nwg != 512) return StaticOrder::next(i, u);
        StaticOrder t = *this; t.G = 1 << 30;
        if (c < 128) { if (i > 0) return false; t.c = c; } else { if (i > 2) return false; t.c = (i == 0) ? c : 256 + 2 * (c - 128) + (i - 1); }
        return t.next(0, u);
    }
};
struct Place { int jx, nx, rank, nloc; };
template <int NN> struct XcdOrder {
    int p0, nunits, rank, nloc;
    __device__ __forceinline__ void init(const Place& p) { p0 = p.jx * (128 / p.nx); nunits = (128 / p.nx) * NN; rank = p.rank; nloc = p.nloc; }
    __device__ __forceinline__ bool map(int idx, Unit& u) const { if (idx >= nunits) return false; const int gi = idx / (8 * NN), w = idx - gi * (8 * NN); u.pm = p0 + 8 * gi + (w & 7); u.pn = w >> 3; return true; }
    __device__ __forceinline__ bool next(int i, Unit& u) const { return map(rank + i * nloc, u); }
    __device__ __forceinline__ void a_ready(const Unit&) const {}
    __device__ __forceinline__ void done(const Unit&) const {}
};
struct LdsOrder {
    volatile PG8_LAS int* tab;
    __device__ __forceinline__ bool next(int i, Unit& u) const { if (i >= __builtin_amdgcn_readfirstlane(tab[0])) return false; u.pm = __builtin_amdgcn_readfirstlane(tab[1 + 2 * i]); u.pn = __builtin_amdgcn_readfirstlane(tab[2 + 2 * i]); return true; }
    __device__ __forceinline__ void a_ready(const Unit&) const {}
    __device__ __forceinline__ void done(const Unit&) const {}
};
template <class Src> __device__ __forceinline__ LdsOrder fill_order(volatile PG8_LAS int* tab, const Src& S, int wid0) {
    __syncthreads();
    if (wid0 == 0 && lane_id() == 0) { Unit u; int n = 0; while (n < 15 && S.next(n, u)) { tab[1 + 2 * n] = u.pm; tab[2 + 2 * n] = u.pn; ++n; } tab[0] = n; }
    __syncthreads();
    LdsOrder o; o.tab = tab; return o;
}
struct XcdKvOrder : XcdOrder<4> {
    __device__ __forceinline__ bool next(int i, Unit& u) const {
        if (nloc != 32 || nunits != 64) return XcdOrder<4>::next(i, u);
        if (rank < 16) return i == 0 ? map(rank, u) : false;
        if (i > 2) return false; return map(i == 0 ? rank : 32 + 2 * (rank - 16) + (i - 1), u);
    }
};
__device__ __forceinline__ unsigned cvt_pk_bf16(float lo, float hi) { unsigned r; asm volatile("v_cvt_pk_bf16_f32 %0, %1, %2" : "=v"(r) : "v"(lo), "v"(hi)); return r; }
__device__ __forceinline__ u32x4 pack8(const f32x4& a, const f32x4& b) { u32x4 w; w.x = cvt_pk_bf16(a[0], a[1]); w.y = cvt_pk_bf16(a[2], a[3]); w.z = cvt_pk_bf16(b[0], b[1]); w.w = cvt_pk_bf16(b[2], b[3]); return w; }
__device__ __forceinline__ u32x2 pack4(const f32x4& a) { u32x2 w; w.x = cvt_pk_bf16(a[0], a[1]); w.y = cvt_pk_bf16(a[2], a[3]); return w; }
__device__ __forceinline__ float hsum4(const f32x4& a) { return (a[0] + a[1]) + (a[2] + a[3]); }
__device__ __forceinline__ float hsq4(const f32x4& a) { return (a[0] * a[0] + a[1] * a[1]) + (a[2] * a[2] + a[3] * a[3]); }
__device__ __forceinline__ float ld_sum16(const float* p) { const f32x4* q = (const f32x4*)p; return (hsum4(q[0]) + hsum4(q[1])) + (hsum4(q[2]) + hsum4(q[3])); }
__device__ __forceinline__ float ld_sum8(const float* p) { const f32x4* q = (const f32x4*)p; return hsum4(q[0]) + hsum4(q[1]); }
__device__ __forceinline__ float ld_sum4(const float* p) { return hsum4(*(const f32x4*)p); }
__device__ __forceinline__ float quad_sum(float s) { s += swz_xor16(s); auto rr = __builtin_amdgcn_permlane32_swap(__float_as_uint(s), __float_as_uint(s), false, false); return __uint_as_float(rr[0]) + __uint_as_float(rr[1]); }
__device__ __forceinline__ float row_sum16(const float* ssq, int row, int fq) { return quad_sum(hsum4(*(const f32x4*)(ssq + (size_t)row * 16 + 4 * fq))); }
__device__ __forceinline__ void row_sum8x2(const float* ssq, int row, int fq, float& sg, float& sa) {
    float s = hsum4(*(const f32x4*)(ssq + (size_t)row * 16 + 4 * fq)); s += swz_xor16(s);
    auto rr = __builtin_amdgcn_permlane32_swap(__float_as_uint(s), __float_as_uint(s), false, false); sg = __uint_as_float(rr[0]); sa = __uint_as_float(rr[1]); }
#define PG8_FENCE() asm volatile("" ::: "memory")
#define PG8_RSTD8(rsv, ssqp, invn) do { f32x4 q_[2][4]; \
    _Pragma("unroll") for (int ai = 0; ai < 2; ++ai) _Pragma("unroll") for (int m = 0; m < 4; ++m) q_[ai][m] = *(const f32x4*)((ssqp) + (size_t)PG8_ROW(u, ai, m) * 16 + 4 * fq); \
    _Pragma("unroll") for (int ai = 0; ai < 2; ++ai) _Pragma("unroll") for (int m = 0; m < 4; ++m) rsv[ai][m] = rsqrtf(quad_sum(hsum4(q_[ai][m])) * (invn) + EPS); \
    PG8_FENCE(); } while (0)
__device__ __forceinline__ f32x4 gelu4(const f32x4& v) { f32x4 o; o[0] = gelu_tanh(v[0]); o[1] = gelu_tanh(v[1]); o[2] = gelu_tanh(v[2]); o[3] = gelu_tanh(v[3]); return o; }

#define PG8_ROW(u, ai, m) ((u).pm * BM + (ai) * HALF + wr * 64 + (m) * 16 + fr)

template <class V, class P> __device__ __forceinline__ V ldb(const P* p, unsigned boff) { return *(const V*)((const char*)p + boff); }
template <class V, class P> __device__ __forceinline__ void stb(P* p, unsigned boff, const V& v) { *(V*)((char*)p + boff) = v; }
#undef PG8_RSTD8
#define PG8_RSTD8(rsv, ssqp, invn) do { f32x4 q_[2][4]; \
    _Pragma("unroll") for (int ai = 0; ai < 2; ++ai) _Pragma("unroll") for (int m = 0; m < 4; ++m) q_[ai][m] = ldb<f32x4>((ssqp), (unsigned)(PG8_ROW(u, ai, m) * 64 + 16 * fq)); \
    _Pragma("unroll") for (int ai = 0; ai < 2; ++ai) _Pragma("unroll") for (int m = 0; m < 4; ++m) rsv[ai][m] = rsqrtf(quad_sum(hsum4(q_[ai][m])) * (invn) + EPS); \
    PG8_FENCE(); } while (0)

struct EpiIn {
    static constexpr int K = DM, LDA = DM;
    static constexpr bool PERM = true, AFTER_DRAIN = false, HAS_MID = false; static constexpr int MID_T = -1;
    const float* ssq1; const float* shw1; const float* gq; const float* gkv; const float* rope;
    bf16_t* U; bf16_t* VN; bf16_t* CQ; bf16_t* CKV; bf16_t* KR; float* ssqq;
    __device__ __forceinline__ void mid(f32x4 (&)[2][2][4][2], const Unit&, int, int) const {}
    __device__ __forceinline__ void operator()(const f32x4 (&acc)[2][2][4][2], const Unit& u, int wr, int wc, int fr, int fq) const {
        { const int l_ = lane_id(); fr = l_ & 15; fq = l_ >> 4; }
        const int b = u.pm >> 3, pc0 = u.pn * BM + wc * 32 + 8 * fq;
        f32x4 sh[2][2];
#pragma unroll
        for (int bj = 0; bj < 2; ++bj)
#pragma unroll
            for (int n = 0; n < 2; ++n) sh[bj][n] = ldb<f32x4>(shw1, (unsigned)((b * NIN + pc0 + bj * HALF + 4 * n) * 4));
        float rsv[2][4]; PG8_RSTD8(rsv, ssq1, 1.f / DM);
        if (u.pn < 2) {
#pragma unroll
            for (int ai = 0; ai < 2; ++ai)
#pragma unroll
                for (int m = 0; m < 4; ++m) { const int row = PG8_ROW(u, ai, m); const float rs = rsv[ai][m];
#pragma unroll
                    for (int bj = 0; bj < 2; ++bj) { const f32x4 v0 = gelu4(acc[ai][bj][m][0] * rs + sh[bj][0]), v1 = gelu4(acc[ai][bj][m][1] * rs + sh[bj][1]);
                        stb(U, (unsigned)((row * 512 + pc0 + bj * HALF) * 2), pack8(v0, v1)); } }
        } else if (u.pn < 4) {
#pragma unroll
            for (int ai = 0; ai < 2; ++ai)
#pragma unroll
                for (int m = 0; m < 4; ++m) { const int row = PG8_ROW(u, ai, m); const float rs = rsv[ai][m];
                    f32x4 g[2][2]; float s = 0.f;
#pragma unroll
                    for (int bj = 0; bj < 2; ++bj)
#pragma unroll
                        for (int n = 0; n < 2; ++n) { g[bj][n] = gelu4(acc[ai][bj][m][n] * rs + sh[bj][n]); s += hsum4(g[bj][n]); }
                    const float mu = quad_sum(s) * (1.f / 64); float q = 0.f;
#pragma unroll
                    for (int bj = 0; bj < 2; ++bj)
#pragma unroll
                        for (int n = 0; n < 2; ++n) { g[bj][n] = g[bj][n] - mu; q += hsq4(g[bj][n]); }
                    const float rstd = rsqrtf(quad_sum(q) * (1.f / 64) + EPS);
#pragma unroll
                    for (int bj = 0; bj < 2; ++bj) stb(VN, (unsigned)((row * 512 + (u.pn - 2) * 256 + 64 * wc + 32 * bj + 8 * fq) * 2), pack8(g[bj][0] * rstd, g[bj][1] * rstd)); }
        } else if (u.pn == 4) {
            f32x4 gv[2][2];
#pragma unroll
            for (int bj = 0; bj < 2; ++bj)
#pragma unroll
                for (int n = 0; n < 2; ++n) gv[bj][n] = ldb<f32x4>(gq, (unsigned)((bj * HALF + wc * 32 + 8 * fq + 4 * n) * 4));
#pragma unroll
            for (int ai = 0; ai < 2; ++ai)
#pragma unroll
                for (int m = 0; m < 4; ++m) { const int row = PG8_ROW(u, ai, m); const float rs = rsv[ai][m];
                    float ss = 0.f;
#pragma unroll
                    for (int bj = 0; bj < 2; ++bj) { const f32x4 v0 = acc[ai][bj][m][0] * rs + sh[bj][0], v1 = acc[ai][bj][m][1] * rs + sh[bj][1]; ss += hsq4(v0) + hsq4(v1);
                        stb(CQ, (unsigned)((row * QR + bj * HALF + wc * 32 + 8 * fq) * 2), pack8(v0 * gv[bj][0], v1 * gv[bj][1])); }
                    ss = quad_sum(ss); if (fq == 0) stb(ssqq, (unsigned)((row * 8 + wc) * 4), ss); }
        } else {
            const f32x4 gk0 = ldb<f32x4>(gkv, (unsigned)((wc * 32 + 8 * fq) * 4)), gk1 = ldb<f32x4>(gkv, (unsigned)((wc * 32 + 8 * fq + 4) * 4));
#pragma unroll
            for (int ai = 0; ai < 2; ++ai)
#pragma unroll
                for (int m = 0; m < 4; ++m) { const int row = PG8_ROW(u, ai, m); const float rs = rsv[ai][m];
                    const f32x4 v0 = acc[ai][0][m][0] * rs + sh[0][0], v1 = acc[ai][0][m][1] * rs + sh[0][1];
                    float ss = quad_sum(hsq4(v0) + hsq4(v1)); if (fq == 0) stb(ssqq, (unsigned)((row * 8 + 4 + wc) * 4), ss);
                    stb(CKV, (unsigned)((row * KVR + wc * 32 + 8 * fq) * 2), pack8(v0 * gk0, v1 * gk1));
                    if (wc == 0) { const f32x4 x1 = acc[ai][1][m][0] * rs + sh[1][0], x2 = acc[ai][1][m][1] * rs + sh[1][1];
                        const f32x4 c = ldb<f32x4>(rope, (unsigned)((row * 32 + 4 * fq) * 4)), s = ldb<f32x4>(rope, (unsigned)((row * 32 + 16 + 4 * fq) * 4));
                        stb(KR, (unsigned)((row * 32 + 4 * fq) * 2), pack4(x1 * c - x2 * s)); stb(KR, (unsigned)((row * 32 + 16 + 4 * fq) * 2), pack4(x1 * s + x2 * c)); } }
        }
    }
};
template <bool KVP> struct EpiUp {
    static constexpr int K = KVP ? KVR : QR, LDA = K;
    static constexpr bool PROBE2 = false;
    static constexpr bool PERM = true, AFTER_DRAIN = false, HAS_MID = false; static constexpr int MID_T = -1;
    const float* ssqq; const float* rope; bf16_t* Q; bf16_t* KN; bf16_t* V;
    __device__ __forceinline__ void mid(f32x4 (&)[2][2][4][2], const Unit&, int, int) const {}
    __device__ __forceinline__ void operator()(const f32x4 (&acc)[2][2][4][2], const Unit& u, int wr, int wc, int fr, int fq) const {
        { const int l_ = lane_id(); fr = l_ & 15; fq = l_ >> 4; }
        float sq[2][4];
        { f32x4 q_[2][4];
#pragma unroll
        for (int ai = 0; ai < 2; ++ai)
#pragma unroll
            for (int m = 0; m < 4; ++m) q_[ai][m] = ldb<f32x4>(ssqq, (unsigned)((PG8_ROW(u, ai, m) * 8 + (KVP ? 4 : 0)) * 4));
#pragma unroll
        for (int ai = 0; ai < 2; ++ai)
#pragma unroll
            for (int m = 0; m < 4; ++m) sq[ai][m] = hsum4(q_[ai][m]);
        PG8_FENCE(); }
        if (!KVP) {
#pragma unroll
            for (int ai = 0; ai < 2; ++ai)
#pragma unroll
                for (int m = 0; m < 4; ++m) { const int row = PG8_ROW(u, ai, m); const float rq = rsqrtf(sq[ai][m] * (1.f / QR) + EPS) * QSCALE;
#pragma unroll
                    for (int bj = 0; bj < 2; ++bj) { const int G = 8 * u.pn + 4 * bj + wc, h = G / 3, gi = G - 3 * h;
                        const f32x4 v0 = acc[ai][bj][m][0] * rq, v1 = acc[ai][bj][m][1] * rq;
                        if (gi < 2) stb(Q, (unsigned)((row * 768 + 32 * G + 8 * fq) * 2), pack8(v0, v1));
                        else { const f32x4 c = ldb<f32x4>(rope, (unsigned)((row * 32 + 4 * fq) * 4)), s = ldb<f32x4>(rope, (unsigned)((row * 32 + 16 + 4 * fq) * 4));
                            stb(Q, (unsigned)((row * 768 + 96 * h + 64 + 4 * fq) * 2), pack4(v0 * c - v1 * s)); stb(Q, (unsigned)((row * 768 + 96 * h + 80 + 4 * fq) * 2), pack4(v0 * s + v1 * c)); } }
                    if (m & 1) PG8_FENCE(); }
        } else {
#pragma unroll
            for (int ai = 0; ai < 2; ++ai)
#pragma unroll
                for (int m = 0; m < 4; ++m) { const int row = PG8_ROW(u, ai, m); const float rk = rsqrtf(sq[ai][m] * (1.f / KVR) + EPS);
#pragma unroll
                    for (int bj = 0; bj < 2; ++bj) { const int h = 2 * u.pn + bj;
                        const u32x4 w = pack8(acc[ai][bj][m][0] * rk, acc[ai][bj][m][1] * rk);
                        if (wc < 2) stb(KN, (unsigned)((row * 512 + 64 * h + 32 * wc + 8 * fq) * 2), w); else stb(V, (unsigned)((row * 512 + 64 * h + 32 * (wc - 2) + 8 * fq) * 2), w); } }
        }
    }
};
__device__ __forceinline__ f32x4 bf_lo4(const u32x4& w) { f32x4 r; r[0] = __uint_as_float(w.x << 16); r[1] = __uint_as_float(w.x & 0xffff0000u); r[2] = __uint_as_float(w.y << 16); r[3] = __uint_as_float(w.y & 0xffff0000u); return r; }
__device__ __forceinline__ f32x4 bf_hi4(const u32x4& w) { f32x4 r; r[0] = __uint_as_float(w.z << 16); r[1] = __uint_as_float(w.z & 0xffff0000u); r[2] = __uint_as_float(w.w << 16); r[3] = __uint_as_float(w.w & 0xffff0000u); return r; }
template <bool MIDS, bool XF32> struct EpiRes {
    static constexpr int K = MIDS ? DM : DFF, LDA = MIDS ? YLD : DFF;
    static constexpr bool PROBE2 = false;
    static constexpr bool PERM = true, AFTER_DRAIN = false, HAS_MID = MIDS; static constexpr int MID_T = 8;
    const float* ssqy; const void* xin; bf16_t* xout; const float* gate  ; const float* gm  ; bf16_t* A; float* ssqo;
    __device__ __forceinline__ void mid(f32x4 (&acc)[2][2][4][2], const Unit& u, int wr, int fr) const {
        const int l_ = lane_id(); fr = l_ & 15; const int fq = l_ >> 4;
        f32x4 q_[2][4];
#pragma unroll
        for (int ai = 0; ai < 2; ++ai)
#pragma unroll
            for (int m = 0; m < 4; ++m) q_[ai][m] = ldb<f32x4>(ssqy, (unsigned)(PG8_ROW(u, ai, m) * 64 + 16 * fq));
#pragma unroll
        for (int ai = 0; ai < 2; ++ai)
#pragma unroll
            for (int m = 0; m < 4; ++m) { float s = hsum4(q_[ai][m]); s += swz_xor16(s);
                auto rr = __builtin_amdgcn_permlane32_swap(__float_as_uint(s), __float_as_uint(s), false, false); const float sg = __uint_as_float(rr[0]), sa = __uint_as_float(rr[1]);
                const float ratio = sqrtf((sa * (1.f / 512) + EPS) / (sg * (1.f / 512) + EPS));
#pragma unroll
                for (int bj = 0; bj < 2; ++bj)
#pragma unroll
                    for (int n = 0; n < 2; ++n) acc[ai][bj][m][n] = acc[ai][bj][m][n] * ratio; }
    }
    __device__ __forceinline__ void operator()(const f32x4 (&acc)[2][2][4][2], const Unit& u, int wr, int wc, int fr, int fq) const {
        { const int l_ = lane_id(); fr = l_ & 15; fq = l_ >> 4; }
        const int b = u.pm >> 3, c0 = u.pn * BM + wc * 32 + 8 * fq;
        float rs[2][4], ss[2][4];
#pragma unroll
        for (int ai = 0; ai < 2; ++ai)
#pragma unroll
            for (int m = 0; m < 4; ++m) { ss[ai][m] = 0.f; rs[ai][m] = 1.f; }
        if (MIDS) { f32x4 q_[2][4];
#pragma unroll
            for (int ai = 0; ai < 2; ++ai)
#pragma unroll
                for (int m = 0; m < 4; ++m) q_[ai][m] = ldb<f32x4>(ssqy, (unsigned)(PG8_ROW(u, ai, m) * 64 + 32 + 16 * (fq & 1)));
#pragma unroll
            for (int ai = 0; ai < 2; ++ai)
#pragma unroll
                for (int m = 0; m < 4; ++m) { float s = hsum4(q_[ai][m]); s += swz_xor16(s); rs[ai][m] = rsqrtf(s * (1.f / 512) + EPS); }
            PG8_FENCE(); }
#pragma unroll
        for (int bj = 0; bj < 2; ++bj) { const int cb = c0 + bj * HALF;
            const f32x4 g0 = ldb<f32x4>(gate, (unsigned)((b * NMOD + cb) * 4)), g1 = ldb<f32x4>(gate, (unsigned)((b * NMOD + cb + 4) * 4));
            f32x4 m0 = (f32x4){0.f, 0.f, 0.f, 0.f}, m1 = m0; if (gm) { m0 = ldb<f32x4>(gm, (unsigned)((b * DM + cb) * 4)); m1 = ldb<f32x4>(gm, (unsigned)((b * DM + cb + 4) * 4)); }
            if (XF32) {
#pragma unroll
                for (int ai = 0; ai < 2; ++ai) {
                    f32x4 xv[4][2];
#pragma unroll
                    for (int m = 0; m < 4; ++m) { const unsigned off = (unsigned)((PG8_ROW(u, ai, m) * DM + cb) * 4); xv[m][0] = ldb<f32x4>(xin, off); xv[m][1] = ldb<f32x4>(xin, off + 16); }
                    PG8_FENCE();
#pragma unroll
                    for (int m = 0; m < 4; ++m) { const unsigned off = (unsigned)((PG8_ROW(u, ai, m) * DM + cb) * 2), offx = (unsigned)(PG8_ROW(u, ai, m) * (DM * 4) + DM * 2 + cb * 2);
                        const f32x4 x0 = xv[m][0] + g0 * (acc[ai][bj][m][0] * rs[ai][m]), x1 = xv[m][1] + g1 * (acc[ai][bj][m][1] * rs[ai][m]);
                        stb(xout, offx, pack8(x0, x1));
                        if (gm) { ss[ai][m] += hsq4(x0) + hsq4(x1); stb(A, off, pack8(x0 * m0, x1 * m1)); } }
                    PG8_FENCE(); }
            } else {
                u32x4 xw[2][4];
#pragma unroll
                for (int ai = 0; ai < 2; ++ai)
#pragma unroll
                    for (int m = 0; m < 4; ++m) xw[ai][m] = ldb<u32x4>(xin, (unsigned)(PG8_ROW(u, ai, m) * (DM * 4) + DM * 2 + cb * 2));
                PG8_FENCE();
#pragma unroll
                for (int ai = 0; ai < 2; ++ai)
#pragma unroll
                    for (int m = 0; m < 4; ++m) { const unsigned off = (unsigned)((PG8_ROW(u, ai, m) * DM + cb) * 2), offx = (unsigned)(PG8_ROW(u, ai, m) * (DM * 4) + DM * 2 + cb * 2);
                        const f32x4 x0 = bf_lo4(xw[ai][m]) + g0 * (acc[ai][bj][m][0] * rs[ai][m]), x1 = bf_hi4(xw[ai][m]) + g1 * (acc[ai][bj][m][1] * rs[ai][m]);
                        stb(xout, offx, pack8(x0, x1));
                        if (gm) { ss[ai][m] += hsq4(x0) + hsq4(x1); stb(A, off, pack8(x0 * m0, x1 * m1)); } }
                PG8_FENCE(); } }
        if (gm) {
#pragma unroll
            for (int ai = 0; ai < 2; ++ai)
#pragma unroll
                for (int m = 0; m < 4; ++m) { const float s = quad_sum(ss[ai][m]); if (fq == 0) stb(ssqo, (unsigned)((PG8_ROW(u, ai, m) * 16 + u.pn * 4 + wc) * 4), s); } }
    }
};
struct EpiFf1 {
    static constexpr int K = DM, LDA = DM;
    static constexpr bool PERM = true, AFTER_DRAIN = false, HAS_MID = false; static constexpr int MID_T = -1;
    const float* ssq2; const float* shw2; bf16_t* H;
    __device__ __forceinline__ void mid(f32x4 (&)[2][2][4][2], const Unit&, int, int) const {}
    __device__ __forceinline__ void operator()(const f32x4 (&acc)[2][2][4][2], const Unit& u, int wr, int wc, int fr, int fq) const {
        { const int l_ = lane_id(); fr = l_ & 15; fq = l_ >> 4; }
        const int b = u.pm >> 3, c0 = u.pn * BM + wc * 32 + 8 * fq;
        f32x4 sh[2][2];
#pragma unroll
        for (int bj = 0; bj < 2; ++bj)
#pragma unroll
            for (int n = 0; n < 2; ++n) sh[bj][n] = ldb<f32x4>(shw2, (unsigned)((b * DFF + c0 + bj * HALF + 4 * n) * 4));
        float rsv[2][4]; PG8_RSTD8(rsv, ssq2, 1.f / DM);
#pragma unroll
        for (int ai = 0; ai < 2; ++ai)
#pragma unroll
            for (int m = 0; m < 4; ++m) { const int row = PG8_ROW(u, ai, m); const float rs = rsv[ai][m];
#pragma unroll
                for (int bj = 0; bj < 2; ++bj) { f32x4 v0 = acc[ai][bj][m][0] * rs + sh[bj][0], v1 = acc[ai][bj][m][1] * rs + sh[bj][1];
#pragma unroll
                    for (int i = 0; i < 4; ++i) { const float a = fmaxf(v0[i], 0.f), c = fmaxf(v1[i], 0.f); v0[i] = a * a; v1[i] = c * c; }
                    stb(H, (unsigned)((row * DFF + c0 + bj * HALF) * 2), pack8(v0, v1)); } }
    }
};

template <class Epi, class Sched, bool ALIGN_EPI = false, bool SP2 = false>
__device__ __forceinline__ void gemm_phase(PG8_LAS unsigned char* lds, const Gemm g, const Sched& S, const Epi& E, int wid0) {
    int tid_ = wid0 * 64 + lane_id(); asm volatile("" : "+v"(tid_));
    const int tid = tid_, wid = __builtin_amdgcn_readfirstlane(tid >> 6), lane = tid & 63, wr = wid >> 2, wc = wid & 3, fr = lane & 15, fq = lane >> 4;
    constexpr int K = Epi::K, LDA = Epi::LDA, nt = K / BK;
    unsigned voffA[2], voffB[2];
#pragma unroll
    for (int i = 0; i < 2; ++i) { int R, C; stage_rc(tid * 16 + i * 8192, R, C); const int Rb = Epi::PERM ? ((R & ~31) + perm32(R & 31)) : R;
        voffA[i] = (unsigned)(R * LDA + C) * 2u; voffB[i] = (unsigned)(Rb * K + C) * 2u; }
    const size_t kstep = (size_t)(BK * 2);
    const size_t hstep = (size_t)HALF * K * 2;
    const size_t tstep = 2 * hstep;
    const size_t hstepA = (size_t)HALF * LDA * 2, tstepA = 2 * hstepA;
    const unsigned ldsw = (unsigned)wid * 1024u;
    const int aoff = lds_byte(wr * 64 + fr, fq * 8), boff = lds_byte(wc * 32 + fr, fq * 8);
#define PG8_SA(b, h) (((b) * 2 + (h)) * HTB)
#define PG8_SB(b, h) ((4 + (b) * 2 + (h)) * HTB)
#define PG8_STAGE(bufoff, gbase, voff) do { _Pragma("unroll") for (int _i = 0; _i < 2; ++_i) \
        __builtin_amdgcn_global_load_lds((const unsigned*)((const char*)(gbase) + (voff)[_i]), (PG8_LAS unsigned*)(lds + (bufoff) + ldsw + _i * 8192), 16, 0, 0); } while (0)
#define PG8_LDA(dst, b, h) do { _Pragma("unroll") for (int m = 0; m < 4; ++m) _Pragma("unroll") for (int k = 0; k < 2; ++k) dst[m][k] = *(const PG8_LAS bf16x8*)(lds + PG8_SA(b, h) + aoff + m * 2048 + k * 1024); } while (0)
#define PG8_LDB(dst, b, h) do { _Pragma("unroll") for (int n = 0; n < 2; ++n) _Pragma("unroll") for (int k = 0; k < 2; ++k) dst[n][k] = *(const PG8_LAS bf16x8*)(lds + PG8_SB(b, h) + boff + n * 2048 + k * 1024); } while (0)
#define PG8_MMA(ai, bj, At, Bt) do { __builtin_amdgcn_s_setprio(1); _Pragma("unroll") for (int m = 0; m < 4; ++m) _Pragma("unroll") for (int n = 0; n < 2; ++n) _Pragma("unroll") for (int k = 0; k < 2; ++k) \
        acc[ai][bj][m][n] = __builtin_amdgcn_mfma_f32_16x16x32_bf16(Bt[n][k], At[m][k], acc[ai][bj][m][n], 0, 0, 0); __builtin_amdgcn_s_setprio(0); } while (0)
#define PG8_WAIT_V(n) asm volatile("s_waitcnt vmcnt(" #n ")" ::: "memory")
#define PG8_WAIT_L(n) asm volatile("s_waitcnt lgkmcnt(" #n ")" ::: "memory")
#define PG8_BAR __builtin_amdgcn_s_barrier()
#define PG8_SCHED __builtin_amdgcn_sched_barrier(0)
    Unit cur, nxt; int ui = 0;
    if (!S.next(0, cur)) return;
    f32x4 acc[2][2][4][2];
#pragma unroll
    for (int a = 0; a < 2; ++a)
#pragma unroll
        for (int b = 0; b < 2; ++b)
#pragma unroll
            for (int m = 0; m < 4; ++m)
#pragma unroll
                for (int n = 0; n < 2; ++n) acc[a][b][m][n] = (f32x4){0.f, 0.f, 0.f, 0.f};
    bf16x8 At[4][2], B0[2][2], B1[2][2];
    const char* cA = (const char*)g.A + (size_t)cur.pm * tstepA; const char* cB = (const char*)g.Bt + (size_t)cur.pn * tstep;
    S.a_ready(cur);
    if constexpr (SP2) {
        PG8_STAGE(PG8_SB(0, 0), cB, voffB); PG8_STAGE(PG8_SB(0, 1), cB + hstep, voffB); PG8_STAGE(PG8_SA(0, 0), cA, voffA); PG8_STAGE(PG8_SA(0, 1), cA + hstepA, voffA);
        if (wr == 1) PG8_BAR;
        PG8_WAIT_V(2); PG8_BAR;
        PG8_STAGE(PG8_SB(1, 0), cB + kstep, voffB); PG8_STAGE(PG8_SA(1, 0), cA + kstep, voffA); PG8_STAGE(PG8_SB(1, 1), cB + hstep + kstep, voffB);
        PG8_WAIT_V(6); PG8_BAR;
    } else {
        PG8_STAGE(PG8_SB(0, 0), cB, voffB); PG8_STAGE(PG8_SA(0, 0), cA, voffA); PG8_STAGE(PG8_SB(0, 1), cB + hstep, voffB); PG8_STAGE(PG8_SA(0, 1), cA + hstepA, voffA);
        if (wr == 1) PG8_BAR;
        PG8_WAIT_V(4); PG8_BAR;
        PG8_STAGE(PG8_SB(1, 0), cB + kstep, voffB); PG8_STAGE(PG8_SA(1, 0), cA + kstep, voffA); PG8_STAGE(PG8_SB(1, 1), cB + hstep + kstep, voffB);
        PG8_WAIT_V(6); PG8_BAR;
    }
    for (;;) {
        const bool has_next = S.next(ui + 1, nxt);
        const char* nA = has_next ? (const char*)g.A + (size_t)nxt.pm * tstepA : cA; const char* nB = has_next ? (const char*)g.Bt + (size_t)nxt.pn * tstep : cB;
#pragma nounroll
        for (int t = 0; t < nt; t += 2) {
            const bool last = (t == nt - 2);
            const char* a1 = cA + (size_t)(t + 1) * kstep;
            const char* a2 = last ? nA : cA + (size_t)(t + 2) * kstep; const char* b2 = last ? nB : cB + (size_t)(t + 2) * kstep;
            const char* a3 = a2 + kstep; const char* b3 = b2 + kstep;
            if (last && has_next) S.a_ready(nxt);
            if constexpr (Epi::HAS_MID) { if (t == Epi::MID_T) E.mid(acc, cur, wr, fr); }
            if constexpr (SP2) {
            PG8_LDB(B0, 0, 0); PG8_LDB(B1, 0, 1); PG8_SCHED; PG8_LDA(At, 0, 0); PG8_STAGE(PG8_SA(1, 1), a1 + hstepA, voffA);
            PG8_WAIT_V(8); PG8_WAIT_L(0); PG8_BAR; PG8_MMA(0, 0, At, B0); PG8_MMA(0, 1, At, B1); PG8_BAR; PG8_SCHED;
            PG8_LDA(At, 0, 1); PG8_STAGE(PG8_SB(0, 0), b2, voffB); PG8_STAGE(PG8_SB(0, 1), b2 + hstep, voffB); PG8_STAGE(PG8_SA(0, 0), a2, voffA);
            PG8_WAIT_V(8); PG8_WAIT_L(0); PG8_BAR; PG8_MMA(1, 0, At, B0); PG8_MMA(1, 1, At, B1); PG8_BAR; PG8_SCHED;
            PG8_LDB(B0, 1, 0); PG8_LDB(B1, 1, 1); PG8_SCHED; PG8_LDA(At, 1, 0); PG8_STAGE(PG8_SA(0, 1), a2 + hstepA, voffA);
            PG8_WAIT_V(8); PG8_WAIT_L(0); PG8_BAR; PG8_MMA(0, 0, At, B0); PG8_MMA(0, 1, At, B1); PG8_BAR; PG8_SCHED;
            PG8_LDA(At, 1, 1); PG8_STAGE(PG8_SB(1, 0), b3, voffB); PG8_STAGE(PG8_SB(1, 1), b3 + hstep, voffB); PG8_STAGE(PG8_SA(1, 0), a3, voffA);
            PG8_WAIT_V(8); PG8_WAIT_L(0); PG8_BAR; PG8_MMA(1, 0, At, B0); PG8_MMA(1, 1, At, B1); PG8_BAR; PG8_SCHED;
            } else {
            PG8_LDB(B0, 0, 0); PG8_SCHED; PG8_LDA(At, 0, 0); PG8_STAGE(PG8_SA(1, 1), a1 + hstepA, voffA);
            PG8_WAIT_L(8); PG8_BAR; PG8_WAIT_L(0); PG8_MMA(0, 0, At, B0); PG8_BAR; PG8_SCHED;
            PG8_LDB(B1, 0, 1); PG8_STAGE(PG8_SB(0, 0), b2, voffB);
            PG8_BAR; PG8_WAIT_L(0); PG8_MMA(0, 1, At, B1); PG8_BAR;
            PG8_LDA(At, 0, 1); PG8_STAGE(PG8_SA(0, 0), a2, voffA);
            PG8_BAR; PG8_WAIT_L(0); PG8_MMA(1, 0, At, B0); PG8_BAR; PG8_SCHED;
            PG8_STAGE(PG8_SB(0, 1), b2 + hstep, voffB);
            PG8_WAIT_V(6); PG8_BAR; PG8_MMA(1, 1, At, B1); PG8_BAR;
            PG8_LDB(B0, 1, 0); PG8_SCHED; PG8_LDA(At, 1, 0); PG8_STAGE(PG8_SA(0, 1), a2 + hstepA, voffA);
            PG8_WAIT_L(8); PG8_BAR; PG8_WAIT_L(0); PG8_MMA(0, 0, At, B0); PG8_BAR; PG8_SCHED;
            PG8_LDB(B1, 1, 1); PG8_STAGE(PG8_SB(1, 0), b3, voffB);
            PG8_BAR; PG8_WAIT_L(0); PG8_MMA(0, 1, At, B1); PG8_BAR;
            PG8_LDA(At, 1, 1); PG8_STAGE(PG8_SA(1, 0), a3, voffA);
            PG8_BAR; PG8_WAIT_L(0); PG8_MMA(1, 0, At, B0); PG8_BAR; PG8_SCHED;
            PG8_STAGE(PG8_SB(1, 1), b3 + hstep, voffB);
            PG8_WAIT_V(6); PG8_BAR; PG8_MMA(1, 1, At, B1); PG8_BAR;
            }
        }
        if constexpr (ALIGN_EPI) { if (wr == 0) PG8_BAR; }
        if constexpr (!Epi::AFTER_DRAIN) { E(acc, cur, wr, wc, fr, fq); S.done(cur); }
        if (!has_next) break;
#pragma unroll
        for (int a = 0; a < 2; ++a)
#pragma unroll
            for (int b = 0; b < 2; ++b)
#pragma unroll
                for (int m = 0; m < 4; ++m)
#pragma unroll
                    for (int n = 0; n < 2; ++n) acc[a][b][m][n] = (f32x4){0.f, 0.f, 0.f, 0.f};
        cur = nxt; cA = nA; cB = nB; ++ui;
        if constexpr (ALIGN_EPI) { if (wr == 1) PG8_BAR; }
    }
    PG8_WAIT_V(0);
    if constexpr (!ALIGN_EPI) { if (wr == 0) PG8_BAR; }
    PG8_BAR;
    if constexpr (Epi::AFTER_DRAIN) { E.fused(acc, cur, wr, wc, fr, fq, lds, wid, lane); S.done(cur); }
#undef PG8_SA
#undef PG8_SB
#undef PG8_STAGE
#undef PG8_LDA
#undef PG8_LDB
#undef PG8_MMA
#undef PG8_WAIT_V
#undef PG8_WAIT_L
#undef PG8_BAR
#undef PG8_SCHED
}
}

namespace gm {
#define GM_LAS __attribute__((address_space(3)))
typedef short v4i16_t __attribute__((ext_vector_type(4)));
__device__ __forceinline__ int swz(int s) { return ((s >> 1) & 1) + 2 * ((s >> 3) & 1); }
__device__ __forceinline__ void gmlp_phase(GM_LAS unsigned char* lds, int wid0, const pg8::Place& pl, const bf16_t* U, const bf16_t* VN, const bf16_t* GW  , const float* bs  , const float* gog  , bf16_t* Y, float* ssqy) {
    int tid_ = wid0 * 64 + lane_id(); asm volatile("" : "+v"(tid_));
    const int tid = tid_, lane = tid & 63, wid = __builtin_amdgcn_readfirstlane(tid >> 6), fr = lane & 15, fq = lane >> 4;
    const int nks = (wid >> 1) + 1, nu = 256 / pl.nx, u0 = pl.jx * nu;
    int gcur = -1; bf16x8 wf[4]; float bias = 0.f; f32x4 gv[4];
    for (int idx = pl.rank; idx < 8 * nu; idx += pl.nloc) {
        const int g = idx & 7, un = u0 + (idx >> 3); const size_t t0 = (size_t)un * CHUNK;
        if (g != gcur) { gcur = g;
#pragma unroll
            for (int ks = 0; ks < 4; ++ks) wf[ks] = *(const bf16x8*)(GW + ((size_t)(g * CHUNK + 16 * wid + fr)) * CHUNK + 32 * ks + 8 * fq);
            bias = bs[g * CHUNK + 16 * wid + fr];
#pragma unroll
            for (int nt = 0; nt < 4; ++nt) gv[nt] = *(const f32x4*)(gog + g * 64 + 16 * nt + 4 * fq); }
        pg8::u32x4 st[2];
#pragma unroll
        for (int k = 0; k < 2; ++k) { const int ix = tid + 512 * k, s = ix >> 3, c16 = ix & 7; st[k] = *(const pg8::u32x4*)(VN + (t0 + s) * 512 + g * 64 + c16 * 8); }
        __syncthreads();
#pragma unroll
        for (int k = 0; k < 2; ++k) { const int ix = tid + 512 * k, s = ix >> 3, c16 = ix & 7; *(GM_LAS pg8::u32x4*)(lds + s * 128 + (((c16 >> 1) ^ swz(s)) * 32) + (c16 & 1) * 16) = st[k]; }
        __syncthreads();
        f32x4 acc[4];
#pragma unroll
        for (int nt = 0; nt < 4; ++nt) acc[nt] = (f32x4){0.f, 0.f, 0.f, 0.f};
#pragma unroll
        for (int ks = 0; ks < 4; ++ks) { if (ks < nks) {
#pragma unroll
            for (int nt = 0; nt < 4; ++nt) {
                const int q = fr >> 2, p = fr & 3;
                const int s0 = 32 * ks + 8 * fq + q, s1 = s0 + 4;
                const v4i16_t lo = __builtin_amdgcn_ds_read_tr16_b64_v4i16((GM_LAS v4i16_t*)(lds + s0 * 128 + ((nt ^ swz(s0)) * 32) + p * 8));
                const v4i16_t hi = __builtin_amdgcn_ds_read_tr16_b64_v4i16((GM_LAS v4i16_t*)(lds + s1 * 128 + ((nt ^ swz(s1)) * 32) + p * 8));
                const bf16x8 vf = (bf16x8){lo[0], lo[1], lo[2], lo[3], hi[0], hi[1], hi[2], hi[3]};
                acc[nt] = __builtin_amdgcn_mfma_f32_16x16x32_bf16(vf, wf[ks], acc[nt], 0, 0, 0);
            } } }
        const size_t row = t0 + 16 * wid + fr; float ss = 0.f;
#pragma unroll
        for (int nt = 0; nt < 4; ++nt) { const int c = g * 64 + 16 * nt + 4 * fq;
            const uint2 uu = *(const uint2*)(U + row * 512 + c);
            f32x4 y; y[0] = bf2f((bf16_t)(uu.x & 0xffff)) * (acc[nt][0] + bias); y[1] = bf2f((bf16_t)(uu.x >> 16)) * (acc[nt][1] + bias);
            y[2] = bf2f((bf16_t)(uu.y & 0xffff)) * (acc[nt][2] + bias); y[3] = bf2f((bf16_t)(uu.y >> 16)) * (acc[nt][3] + bias);
            ss += pg8::hsq4(y); *(pg8::u32x2*)(Y + row * YLD + c) = pg8::pack4(y * gv[nt]); }
        ss = pg8::quad_sum(ss); if (fq == 0) ssqy[row * 16 + g] = ss;
    }
    __syncthreads();
}
}

namespace att {
#define AT_LAS __attribute__((address_space(3)))
using f32x16 = __attribute__((ext_vector_type(16))) float;
using s16x4 = __attribute__((ext_vector_type(4))) short;
using u32x4 = __attribute__((ext_vector_type(4))) unsigned;
constexpr int KVBLK = 64, KSLOTB = 12288, VSLOTB = 8192, NKS = 4, NVS = 4;
constexpr int LDS_V = NKS * KSLOTB  , LDS_WS = LDS_V + NVS * VSLOTB  , LDS_OST = LDS_WS + 8 * 256  , OROW = 144, LDS_BYTES = LDS_OST + 8 * 32 * OROW  ;
__device__ __forceinline__ int crow(int r, int hi) { return (r & 3) + 8 * (r >> 2) + 4 * hi; }
__device__ __forceinline__ void glds16(const void* gsrc, unsigned lds_dst) { unsigned keep;
    asm volatile("s_mov_b32 %0, m0\n\ts_mov_b32 m0, %2\n\ts_nop 0\n\tglobal_load_lds_dwordx4 %1, off\n\ts_mov_b32 m0, %0" : "=&s"(keep) : "v"(gsrc), "s"(lds_dst) : "memory"); }
typedef float f32x2_t __attribute__((ext_vector_type(2))); typedef __bf16 bf16x2_t __attribute__((ext_vector_type(2)));
__device__ __forceinline__ unsigned cvtpk_s(float lo, float hi) { f32x2_t v = {lo, hi}; bf16x2_t b = __builtin_convertvector(v, bf16x2_t); return __builtin_bit_cast(unsigned, b); }
__device__ __forceinline__ float max3f(float a, float b, float c) { float r; asm("v_max3_f32 %0, %1, %2, %3" : "=v"(r) : "v"(a), "v"(b), "v"(c)); return r; }
#define AT_WAIT_BAR(N) asm volatile("s_waitcnt vmcnt(" #N ") lgkmcnt(0)\n\ts_barrier" ::: "memory")
typedef short v4i16_t __attribute__((ext_vector_type(4)));
__device__ __forceinline__ s16x4 vtr(AT_LAS const char* p) { return __builtin_bit_cast(s16x4, __builtin_amdgcn_ds_read_tr16_b64_v4i16((AT_LAS v4i16_t*)p)); }
__device__ __forceinline__ void pv(f32x16 (&o)[2], AT_LAS const char* vp, const u32x4& pw0, const u32x4& pw1, const u32x4& pw2, const u32x4& pw3) {
#pragma unroll
    for (int d0 = 0; d0 < 2; ++d0) { s16x4 lo[4], hh[4];
#pragma unroll
        for (int ks = 0; ks < 4; ++ks) { lo[ks] = vtr(vp + d0 * 4096 + ks * 1024); hh[ks] = vtr(vp + d0 * 4096 + ks * 1024 + 512); }
#define AT_VF(k) (bf16x8){lo[k][0], lo[k][1], lo[k][2], lo[k][3], hh[k][0], hh[k][1], hh[k][2], hh[k][3]}
        o[d0] = __builtin_amdgcn_mfma_f32_32x32x16_bf16(__builtin_bit_cast(bf16x8, pw0), AT_VF(0), o[d0], 0, 0, 0);
        o[d0] = __builtin_amdgcn_mfma_f32_32x32x16_bf16(__builtin_bit_cast(bf16x8, pw1), AT_VF(1), o[d0], 0, 0, 0);
        o[d0] = __builtin_amdgcn_mfma_f32_32x32x16_bf16(__builtin_bit_cast(bf16x8, pw2), AT_VF(2), o[d0], 0, 0, 0);
        o[d0] = __builtin_amdgcn_mfma_f32_32x32x16_bf16(__builtin_bit_cast(bf16x8, pw3), AT_VF(3), o[d0], 0, 0, 0);
#undef AT_VF
    }
}
__device__ __forceinline__ void qkt(f32x16& p0, f32x16& p1, AT_LAS const char* kb, const bf16x8 (&qr)[6], const f32x16& negm) {
    bf16x8 kf[12];
#pragma unroll
    for (int d0 = 0; d0 < 6; ++d0) { kf[2 * d0] = *(AT_LAS const bf16x8*)(kb + d0 * 2048); kf[2 * d0 + 1] = *(AT_LAS const bf16x8*)(kb + d0 * 2048 + 512); }
    __builtin_amdgcn_sched_barrier(0);
    p0 = __builtin_amdgcn_mfma_f32_32x32x16_bf16(kf[0], qr[0], negm, 0, 0, 0); p1 = __builtin_amdgcn_mfma_f32_32x32x16_bf16(kf[1], qr[0], negm, 0, 0, 0);
#pragma unroll
    for (int d0 = 1; d0 < 6; ++d0) { p0 = __builtin_amdgcn_mfma_f32_32x32x16_bf16(kf[2 * d0], qr[d0], p0, 0, 0, 0); p1 = __builtin_amdgcn_mfma_f32_32x32x16_bf16(kf[2 * d0 + 1], qr[d0], p1, 0, 0, 0); }
    asm volatile("s_nop 15\n\ts_nop 7" : "+v"(p0), "+v"(p1));
}
template <int THRL>
__device__ __forceinline__ void attn_unit(int b, int h, int qb, const bf16_t* Q, const bf16_t* KN, const bf16_t* KR, const bf16_t* V, const float* goa  , bf16_t* Y, float* ssqy, AT_LAS char* shm, int wid0) {
    int tid_ = wid0 * 64 + lane_id(); asm volatile("" : "+v"(tid_));
    const int tid = tid_, lane = tid & 63, r32 = lane & 31, hi = lane >> 5; const int wid = __builtin_amdgcn_readfirstlane(tid >> 6);
    const bool late = wid >= 4;
    const size_t rowbase = (size_t)b * SEQ; const int q0 = qb * 256;
    const bf16_t* Qw = Q + (rowbase + q0 + wid * 32) * 768 + h * 96;
    const unsigned lds0 = (unsigned)(uintptr_t)shm;
    AT_LAS float* wsf = (AT_LAS float*)(shm + LDS_WS) + wid * 64;
    const bf16_t* ksrc = KN + (rowbase + lane) * 512 + h * 64 + wid * 8;
    const bf16_t* rsrc = KR + (rowbase + lane) * 32 + (wid & 3) * 8;
    const bf16_t* vsrc = V + (rowbase + 16 * (wid & 3) + (lane >> 2)) * 512 + h * 64 + (wid >> 2) * 32 + (lane & 3) * 8;
    const unsigned kdst = lds0 + wid * 1024, rdst = lds0 + (8 + (wid & 3)) * 1024, vdst = lds0 + LDS_V + wid * 1024;
    const int NT = (q0 + 256) / KVBLK;
#define AT_DMA(jk, jv) do { const int jk_ = (jk) < NT ? (jk) : NT - 1, jv_ = (jv) < NT ? (jv) : NT - 1; \
        glds16(ksrc + (size_t)jk_ * KVBLK * 512, (unsigned)__builtin_amdgcn_readfirstlane(kdst + (jk_ & 3) * KSLOTB)); \
        glds16(rsrc + (size_t)jk_ * KVBLK * 32, (unsigned)__builtin_amdgcn_readfirstlane(rdst + (jk_ & 3) * KSLOTB)); \
        glds16(vsrc + (size_t)jv_ * KVBLK * 512, (unsigned)__builtin_amdgcn_readfirstlane(vdst + (jv_ & 3) * VSLOTB)); } while (0)
    bf16x8 qr[6];
#pragma unroll
    for (int d0 = 0; d0 < 6; ++d0) qr[d0] = *(const bf16x8*)(Qw + (size_t)r32 * 768 + d0 * 16 + hi * 8);
    AT_DMA(0, 0); AT_DMA(1, 1); AT_DMA(2, 1);
    float mhat = 0.f, l_reg = 0.f; f32x16 o[2]; o[0] = f32x16{}; o[1] = f32x16{};
    f32x16 negm = f32x16{}; asm volatile("" : "+v"(negm));
    const int qrel = wid * 32 + r32, wq = wid >> 1;
    AT_LAS const char* kp0 = shm + hi * 1024 + r32 * 16;
    AT_LAS const char* vp0 = shm + LDS_V + ((lane >> 4) & 1) * 32 + (lane & 3) * 8 + (4 * hi + ((lane & 15) >> 2)) * 64;
    u32x4 pw0 = u32x4{}, pw1 = u32x4{}, pw2 = u32x4{}, pw3 = u32x4{}; bool have = false;
    f32x16 p0 = f32x16{}, p1 = f32x16{};
    AT_WAIT_BAR(6);
    if (!late) qkt(p0, p1, kp0, qr, negm);
    for (int t = 0; t < NT; ++t) {
        AT_WAIT_BAR(3);
        AT_DMA(t + 3, t + 2);
        const int jb = t - (NT - 4);
        const bool need = jb <= wq;
        if (late) { if (have) pv(o, vp0 + ((t - 1) & 3) * VSLOTB, pw0, pw1, pw2, pw3);
                    have = false; if (need) qkt(p0, p1, kp0 + (t & 3) * KSLOTB, qr, negm); }
        if (need) {
            if (jb == wq) { const int kb = 64 * jb + 4 * hi;
#pragma unroll
                for (int r = 0; r < 16; ++r) { const int kv = kb + (r & 3) + 8 * (r >> 2); if (kv > qrel) p0[r] = -INFINITY; if (kv + 32 > qrel) p1[r] = -INFINITY; } }
            float ma = max3f(p0[0], p0[1], p1[0]), mb = max3f(p0[2], p0[3], p1[1]); ma = max3f(ma, p1[2], p1[3]);
#pragma unroll
            for (int r = 4; r < 16; r += 4) { ma = max3f(ma, p0[r], p0[r + 1]); mb = max3f(mb, p0[r + 2], p0[r + 3]); ma = max3f(ma, p1[r], p1[r + 1]); mb = max3f(mb, p1[r + 2], p1[r + 3]); }
            float rm = fmaxf(ma, mb);
            { auto rr = __builtin_amdgcn_permlane32_swap(__float_as_uint(rm), __float_as_uint(rm), false, false); rm = fmaxf(__uint_as_float(rr[0]), __uint_as_float(rr[1])); }
            if (t == 0 || __any(rm > (float)THRL)) {
                const float dl = (t == 0) ? rm : fmaxf(rm, 0.f); mhat += dl;
#pragma unroll
                for (int r = 0; r < 16; ++r) { p0[r] -= dl; p1[r] -= dl; negm[r] = -mhat; }
                asm volatile("" : "+v"(negm));
                if (t > 0) { const float f = __builtin_amdgcn_exp2f(-dl); l_reg *= f; if (hi == 0) wsf[r32] = f; asm volatile("s_waitcnt lgkmcnt(0)" ::: "memory");
#pragma unroll
                    for (int r = 0; r < 16; ++r) { const float fr_ = wsf[crow(r, hi)]; o[0][r] *= fr_; o[1][r] *= fr_; } }
            }
            float sacc = 0.f;
#pragma unroll
            for (int r = 0; r < 16; ++r) { p0[r] = __builtin_amdgcn_exp2f(p0[r]); p1[r] = __builtin_amdgcn_exp2f(p1[r]); sacc += p0[r] + p1[r]; }
            l_reg += sacc;
#define AT_PK(P, B) cvtpk_s(P[B], P[B + 1])
            pw0 = (u32x4){AT_PK(p0, 0), AT_PK(p0, 2), AT_PK(p0, 4), AT_PK(p0, 6)}; pw1 = (u32x4){AT_PK(p0, 8), AT_PK(p0, 10), AT_PK(p0, 12), AT_PK(p0, 14)};
            pw2 = (u32x4){AT_PK(p1, 0), AT_PK(p1, 2), AT_PK(p1, 4), AT_PK(p1, 6)}; pw3 = (u32x4){AT_PK(p1, 8), AT_PK(p1, 10), AT_PK(p1, 12), AT_PK(p1, 14)};
#undef AT_PK
            if (late) have = true;
            else pv(o, vp0 + (t & 3) * VSLOTB, pw0, pw1, pw2, pw3);
        }
        if (!late) { if (t + 1 < NT && (jb + 1) <= wq) qkt(p0, p1, kp0 + ((t + 1) & 3) * KSLOTB, qr, negm); }
    }
    if (late && have) pv(o, vp0 + ((NT - 1) & 3) * VSLOTB, pw0, pw1, pw2, pw3);
    { auto rr = __builtin_amdgcn_permlane32_swap(__float_as_uint(l_reg), __float_as_uint(l_reg), false, false); l_reg = __uint_as_float(rr[0]) + __uint_as_float(rr[1]); }
    if (hi == 0) wsf[32 + r32] = __builtin_amdgcn_rcpf(l_reg);
    asm volatile("s_waitcnt lgkmcnt(0)" ::: "memory");
    AT_LAS char* stg = shm + LDS_OST + wid * (32 * OROW);
    { const int row = lane >> 1, half = lane & 1; const size_t grow = rowbase + q0 + wid * 32 + row; float ss = 0.f;
#pragma unroll
      for (int d0 = 0; d0 < 2; ++d0) {
#pragma unroll
        for (int r = 0; r < 16; ++r) { const int orow = crow(r, hi); *(AT_LAS float*)(stg + orow * OROW + r32 * 4) = o[d0][r] * wsf[32 + orow]; }
        asm volatile("s_waitcnt lgkmcnt(0)" ::: "memory");
        const float* gp = goa + h * 64 + d0 * 32 + half * 16; bf16_t* yp = Y + grow * YLD + 512 + h * 64 + d0 * 32 + half * 16;
#pragma unroll
        for (int i = 0; i < 2; ++i) { const f32x4 a = *(AT_LAS const f32x4*)(stg + row * OROW + half * 64 + i * 32), c = *(AT_LAS const f32x4*)(stg + row * OROW + half * 64 + i * 32 + 16);
            ss += pg8::hsq4(a) + pg8::hsq4(c);
            *(u32x4*)(yp + i * 8) = pg8::pack8(a * *(const f32x4*)(gp + i * 8), c * *(const f32x4*)(gp + i * 8 + 4)); }
        asm volatile("s_waitcnt lgkmcnt(0)" ::: "memory"); }
      ss += swz_xor1(ss); if (half == 0) ssqy[grow * 16 + 8 + h] = ss; }
    asm volatile("s_waitcnt vmcnt(0) lgkmcnt(0)\n\ts_barrier" ::: "memory");
#undef AT_DMA
}
__device__ __forceinline__ void attn_phase(AT_LAS char* lds, int wid0, const pg8::Place& pl, const bf16_t* Q, const bf16_t* KN, const bf16_t* KR, const bf16_t* V, const float* goa, bf16_t* Y, float* ssqy) {
    const int nbh = 128 / pl.nx, bh0 = pl.jx * nbh;
    for (int idx = pl.rank; idx < 2 * nbh; idx += pl.nloc) { const int bh = bh0 + (idx >> 1), s = idx & 1;
        for (int i = 0; i < 4; ++i) { const int qb = (i == 0) ? s : (i == 1) ? 7 - s : (i == 2) ? 2 + s : 5 - s;
            attn_unit<8>(bh >> 3, bh & 7, qb, Q, KN, KR, V, goa, Y, ssqy, lds, wid0); } }
}
}

constexpr int NWAVES = 8;
struct Args { const void* in[20]; float* out; unsigned char* ws; int ph_lo, ph_hi, li, flags; };
namespace pro {
#define PR_LAS __attribute__((address_space(3)))
__device__ __forceinline__ unsigned pk2(float lo, float hi) { return (unsigned)f2bf(lo) | ((unsigned)f2bf(hi) << 16); }
template <int MODE  >
__device__ __forceinline__ void tr_item(const float* W, int ldw, bf16_t* WT, int out_ld, int out_koff, int nblk, PR_LAS float* scr, int item, int lane) {
    const int kb = item / nblk, nb = item - kb * nblk, k0 = 64 * kb, n0 = 32 * nb;
    const int pn = n0 + (lane & 31); const int sc0 = MODE == 0 ? pn : (MODE == 1 ? win_src(pn) : wup_qcol(pn));
    const int sc = sc0 >= 0 ? sc0 : 0; const float msk = sc0 >= 0 ? 1.f : 0.f;
    const float* wp = W + (size_t)(k0 + (lane >> 5)) * ldw + sc;
    float v[32];
#pragma unroll
    for (int i = 0; i < 32; ++i) v[i] = wp[(size_t)(2 * i) * ldw];
#pragma unroll
    for (int i = 0; i < 32; ++i) scr[(2 * i + (lane >> 5)) * 33 + (lane & 31)] = v[i] * msk;
    asm volatile("s_waitcnt lgkmcnt(0)" ::: "memory");
    const int c = lane & 7;
#pragma unroll
    for (int j = 0; j < 4; ++j) { const int n = (lane >> 3) + 8 * j; const PR_LAS float* s = scr + (8 * c) * 33 + n;
        pg8::u32x4 o; o.x = pk2(s[0 * 33], s[1 * 33]); o.y = pk2(s[2 * 33], s[3 * 33]); o.z = pk2(s[4 * 33], s[5 * 33]); o.w = pk2(s[6 * 33], s[7 * 33]);
        *(pg8::u32x4*)(WT + (size_t)(n0 + n) * out_ld + out_koff + k0 + 8 * c) = o; }
    asm volatile("s_waitcnt lgkmcnt(0)" ::: "memory");
}
__device__ __forceinline__ void smallm_unit(PR_LAS unsigned char* lds, int tid, const float* in, int in_stride, bool act, const float* W, int ldw, int N, bool winmap, const float* bias, float* out, int out_stride, int p0, int ucols) {
    PR_LAS float* sin_ = (PR_LAS float*)lds; PR_LAS float* red = (PR_LAS float*)(lds + 65536);
    const int lane = tid & 63, wave = tid >> 6;
#pragma unroll 8
    for (int e = tid; e < 16 * 1024; e += 512) { const int b = e >> 10, k = e & 1023; float v = in[(size_t)b * in_stride + k]; if (act) v = v * __builtin_amdgcn_rcpf(1.f + __expf(-v)); sin_[k * 16 + b] = v; }
    __syncthreads();
    const int p = p0 + lane; const int s0 = winmap ? win_src(p) : p; const bool ok = (lane < ucols && s0 >= 0 && s0 < N);
    const int sc = ok ? s0 : 0; const float msk = ok ? 1.f : 0.f;
    const float* wp = W + (size_t)(wave * 128) * ldw + sc;
    float acc[16];
#pragma unroll
    for (int b = 0; b < 16; ++b) acc[b] = 0.f;
    for (int k0 = 0; k0 < 128; k0 += 32) {
        float w[32];
#pragma unroll
        for (int j = 0; j < 32; ++j) w[j] = wp[(size_t)(k0 + j) * ldw];
#pragma unroll
        for (int j = 0; j < 32; ++j) { const PR_LAS f32x4* sp = (const PR_LAS f32x4*)(sin_ + (wave * 128 + k0 + j) * 16);
#pragma unroll
            for (int q = 0; q < 4; ++q) { const f32x4 v = sp[q]; acc[4 * q] += v[0] * w[j]; acc[4 * q + 1] += v[1] * w[j]; acc[4 * q + 2] += v[2] * w[j]; acc[4 * q + 3] += v[3] * w[j]; } }
    }
#pragma unroll
    for (int b = 0; b < 16; ++b) red[(wave * 64 + lane) * 16 + b] = acc[b] * msk;
    __syncthreads();
    for (int e = tid; e < 64 * 16; e += 512) { const int l = e >> 4, b = e & 15; float sum = 0.f;
#pragma unroll
        for (int w = 0; w < 8; ++w) sum += red[(w * 64 + l) * 16 + b];
        if (l < ucols) out[(size_t)b * out_stride + p0 + l] = sum + (bias ? bias[p0 + l] : 0.f); }
    __syncthreads();
}
__device__ __forceinline__ float wsum(float v) {
    v += __int_as_float(__builtin_amdgcn_ds_swizzle(__float_as_int(v), 0x041F)); v += __int_as_float(__builtin_amdgcn_ds_swizzle(__float_as_int(v), 0x081F));
    v += __int_as_float(__builtin_amdgcn_ds_swizzle(__float_as_int(v), 0x101F)); v += __int_as_float(__builtin_amdgcn_ds_swizzle(__float_as_int(v), 0x201F));
    v += __int_as_float(__builtin_amdgcn_ds_swizzle(__float_as_int(v), 0x401F));
    auto rr = __builtin_amdgcn_permlane32_swap(__float_as_uint(v), __float_as_uint(v), false, false); return __uint_as_float(rr[0]) + __uint_as_float(rr[1]);
}
__device__ __forceinline__ void phase0a(PR_LAS unsigned char* lds, int wid0, int vcu, int G, const Args& args, int zi, unsigned char* ws) {
    int tid_ = wid0 * 64 + lane_id(); asm volatile("" : "+v"(tid_));
    const int tid = tid_, lane = tid & 63, wave = tid >> 6;
#define PIN(i) ((const float*)args.in[(i) + zi])
    for (int un = vcu; un < DEPTH * (NMOD / 48); un += G) { const int l = un / (NMOD / 48), p0 = (un % (NMOD / 48)) * 48;
        smallm_unit(lds, tid, PIN(1), DM, true, PIN(3) + (size_t)l * DM * NMOD, NMOD, NMOD, false, PIN(4) + (size_t)l * NMOD, (float*)(ws + WS_MOD) + (size_t)l * NB * NMOD, NMOD, p0, 48); }
    { const int* pos = (const int*)args.in[2 + zi]; float* rope = (float*)(ws + WS_ROPE);
      for (int idx = vcu * 512 + tid; idx < T * 16; idx += G * 512) { const int t = idx >> 4, i = idx & 15;
          const float freq = exp2f(-(float)i * (13.287712379549449f / 16.0f)); const float ang = (float)pos[t] * freq;
          rope[t * 32 + i] = cosf(ang); rope[t * 32 + 16 + i] = sinf(ang); } }
    { const float* gws = PIN(7); bf16_t* gw = (bf16_t*)(ws + WS_GW);
      for (int idx = vcu * 512 + tid; idx < DEPTH * NGRP * CHUNK * CHUNK; idx += G * 512) { const int s = idx & 127, t = (idx >> 7) & 127; gw[idx] = (s <= t) ? f2bf(gws[idx]) : (bf16_t)0; } }
    PR_LAS float* scr = (PR_LAS float*)(lds + wave * 16384);
    const int gw_ = vcu * NWAVES + wave, NGW = G * NWAVES;
    constexpr int I_IN = (DM / 64) * (NIN / 32), I_UQ = (QR / 64) * (768 / 32), I_UKV = (KVR / 64) * (1024 / 32), I_OUT = (DM / 64) * (DM / 32), I_1 = (DM / 64) * (DFF / 32), I_2 = (DFF / 64) * (DM / 32);
    constexpr int I_LAYER = I_IN + I_UQ + I_UKV + I_OUT + I_1 + I_2;
    for (int it = gw_; it < DEPTH * I_LAYER; it += NGW) {
        const int l = it / I_LAYER; int r = it - l * I_LAYER; unsigned char* wl = ws + WS_W + (size_t)l * WL_STRIDE;
        if (r < I_IN) { tr_item<1>(PIN(6) + (size_t)l * DM * DIN, DIN, (bf16_t*)(wl + WL_IN), DM, 0, NIN / 32, scr, r, lane); continue; } r -= I_IN;
        if (r < I_UQ) { tr_item<2>(PIN(11) + (size_t)l * QR * 768, 768, (bf16_t*)(wl + WL_UQ), QR, 0, 768 / 32, scr, r, lane); continue; } r -= I_UQ;
        if (r < I_UKV) { tr_item<0>(PIN(12) + (size_t)l * KVR * 1024, 1024, (bf16_t*)(wl + WL_UKV), KVR, 0, 1024 / 32, scr, r, lane); continue; } r -= I_UKV;
        if (r < I_OUT) { tr_item<0>(PIN(15) + (size_t)l * DM * DM, DM, (bf16_t*)(wl + WL_OUT), DM, 0, DM / 32, scr, r, lane); continue; } r -= I_OUT;
        if (r < I_1) { tr_item<0>(PIN(17) + (size_t)l * DM * DFF, DFF, (bf16_t*)(wl + WL_1), DM, 0, DFF / 32, scr, r, lane); continue; } r -= I_1;
        tr_item<0>(PIN(18) + (size_t)l * DFF * DM, DM, (bf16_t*)(wl + WL_2), DFF, 0, DM / 32, scr, r, lane);
    }
#undef PIN
}
__device__ __forceinline__ void phase0b(PR_LAS unsigned char* lds, int wid0, int vcu, int G, const Args& args, int zi, unsigned char* ws) {
    int tid_ = wid0 * 64 + lane_id(); asm volatile("" : "+v"(tid_));
    const int tid = tid_, lane = tid & 63, wave = tid >> 6;
#define PIN(i) ((const float*)args.in[(i) + zi])
    float* MOD = (float*)(ws + WS_MOD);
    constexpr int U1 = NIN / 48, U2 = DFF / 64, NUNITS = DEPTH * (U1 + U2);
    for (int un = vcu; un < NUNITS; un += G) { const int l = un / (U1 + U2), r = un % (U1 + U2); const float* modl = MOD + (size_t)l * NB * NMOD;
        if (r < U1) smallm_unit(lds, tid, modl, NMOD, false, PIN(6) + (size_t)l * DM * DIN, DIN, DIN, true, nullptr, (float*)(ws + WS_SHW1) + (size_t)l * NB * NIN, NIN, r * 48, 48);
        else smallm_unit(lds, tid, modl + 3 * DM, NMOD, false, PIN(17) + (size_t)l * DM * DFF, DFF, DFF, false, nullptr, (float*)(ws + WS_SHW2) + (size_t)l * NB * DFF, DFF, (r - U1) * 64, 64); }
    for (int idx = vcu * 512 + tid; idx < DEPTH * NB * DM; idx += G * 512) { const int c = idx & 1023, b = (idx >> 10) & 15, l = idx >> 14; const float* m = MOD + ((size_t)l * NB + b) * NMOD;
        ((float*)(ws + WS_GM1))[idx] = PIN(5)[l * DM + c] * (1.f + m[1 * DM + c]); ((float*)(ws + WS_GM2))[idx] = PIN(16)[l * DM + c] * (1.f + m[4 * DM + c]); }
    { const float* x = PIN(0); const float* g = PIN(5); bf16_t* A = (bf16_t*)(ws + WS_A); float* ssq = (float*)(ws + WS_SSQ1);
      const int nun = NUNITS < G ? NUNITS : G; const int wgt = vcu < nun ? 7 : 12, slot0 = vcu < nun ? 7 * vcu : 7 * nun + 12 * (vcu - nun), nslot = 7 * nun + 12 * (G - nun);
      for (int sl = 0; sl < wgt; ++sl)
      for (int row0 = (slot0 + sl) * NWAVES + wave; row0 < T; row0 += 2 * nslot * NWAVES) {
          const int row1 = row0 + nslot * NWAVES; const bool two = row1 < T; const int rowb = two ? row1 : row0;
          f32x4 va[4], vb[4];
#pragma unroll
          for (int j = 0; j < 4; ++j) { va[j] = ((const f32x4*)(x + (size_t)row0 * DM))[lane + 64 * j]; vb[j] = ((const f32x4*)(x + (size_t)rowb * DM))[lane + 64 * j]; }
#pragma unroll
          for (int rr = 0; rr < 2; ++rr) { if (rr == 1 && !two) break; const int row = rr ? row1 : row0; const int b = row / SEQ; const float* sc = MOD + (size_t)b * NMOD + DM; float s = 0.f;
#pragma unroll
              for (int j = 0; j < 4; ++j) { const f32x4 v = rr ? vb[j] : va[j]; s += pg8::hsq4(v); const int c = 4 * (lane + 64 * j); const f32x4 gv = *(const f32x4*)(g + c), sv = *(const f32x4*)(sc + c);
                  *(pg8::u32x2*)(A + (size_t)row * DM + c) = pg8::pack4(v * gv * (sv + 1.f)); }
              s = wsum(s); if (lane < 16) ssq[(size_t)row * 16 + lane] = (lane == 0) ? s : 0.f; } } }
#undef PIN
}
__device__ __forceinline__ void phase_final(int wid0, const pg8::Place& pl, const float* g, const bf16_t* xb, float* dst) {
    int tid_ = wid0 * 64 + lane_id(); asm volatile("" : "+v"(tid_));
    const int lane = tid_ & 63, wave = tid_ >> 6, nr = T / pl.nx, r0 = pl.jx * nr;
    for (int lr = pl.rank * NWAVES + wave; lr < nr; lr += pl.nloc * NWAVES) { const int row = r0 + lr;
        const pg8::u32x4* xr = (const pg8::u32x4*)(xb + (size_t)row * (2 * DM) + DM); f32x4* yr = (f32x4*)(dst + (size_t)row * DM); f32x4 v[4]; float s = 0.f;
#pragma unroll
        for (int j = 0; j < 2; ++j) { const pg8::u32x4 w = xr[lane + 64 * j]; v[2 * j] = pg8::bf_lo4(w); v[2 * j + 1] = pg8::bf_hi4(w); s += pg8::hsq4(v[2 * j]) + pg8::hsq4(v[2 * j + 1]); }
        const float rstd = rsqrtf(wsum(s) * (1.f / DM) + EPS);
#pragma unroll
        for (int j = 0; j < 2; ++j) { const int c = 8 * (lane + 64 * j); const f32x4 g0 = *(const f32x4*)(g + c), g1 = *(const f32x4*)(g + c + 4); yr[2 * (lane + 64 * j)] = v[2 * j] * rstd * g0; yr[2 * (lane + 64 * j) + 1] = v[2 * j + 1] * rstd * g1; } }
}
}

constexpr int RING_BYTES = 131072;
constexpr int LDSCTL_OFF = 135168, MISC_OFF = LDSCTL_OFF + 320;
constexpr int LDS_BYTES = 147456;
static_assert(att::LDS_BYTES <= LDSCTL_OFF, "attention scratch below the control words");
constexpr int CW_BAR = 4096;
constexpr size_t CTL_ZERO_BYTES = 128 * 1024;

#define GAS __attribute__((address_space(1)))
#define LAS __attribute__((address_space(3)))
typedef GAS unsigned gu32;
#define RLX_AGENT __ATOMIC_RELAXED, __HIP_MEMORY_SCOPE_AGENT
#define XB_TMO      128
#define XB_XCNT(j)  (256  + 64 * (j))
#define XB_XSUB(j)  (1280 + 64 * (j))
#define XB_XGEN(j)  (2304 + 64 * (j))
#define XB_TOP      3328
#define XB_TOPGEN   3392
#define XCD_BAR_WORDS 3456
#define XB_SPIN_CAP (1u << 18)
__device__ __forceinline__ unsigned xb_ld(unsigned* p)              { return __hip_atomic_load(p, __ATOMIC_RELAXED, __HIP_MEMORY_SCOPE_AGENT); }
__device__ __forceinline__ unsigned xb_add(unsigned* p, unsigned v) { return __hip_atomic_fetch_add(p, v, __ATOMIC_RELAXED, __HIP_MEMORY_SCOPE_AGENT); }
__device__ __forceinline__ unsigned xb_xcc_id() { return (unsigned)__builtin_amdgcn_s_getreg((3 << 11) | 20) & 0xFu; }
#define XB_SPIN(cond, bar) do { unsigned _sp = 0; while (cond) { __builtin_amdgcn_s_sleep(1); \
    if ((++_sp & 255u) == 0u) { if (xb_ld(&(bar)[XB_TMO])) break; if (_sp > XB_SPIN_CAP) { atomicAdd(&(bar)[XB_TMO], 1u); break; } } } } while (0)
struct XcdBarrier { unsigned* bar; unsigned x; volatile LAS unsigned* st; };
__device__ __forceinline__ XcdBarrier xcd_barrier_post(unsigned* bar, volatile LAS unsigned* st, int wid0) {
    XcdBarrier b; b.bar = bar; b.x = xb_xcc_id(); b.st = st;
    if (wid0 == 0 && lane_id() == 0) (void)xb_add(&bar[XB_XCNT(b.x)], 1u);
    return b;
}
__device__ __forceinline__ void xcd_barrier_complete(unsigned* bar, unsigned x, unsigned& nloc, unsigned& nx) {
    const unsigned G = gridDim.x * gridDim.y * gridDim.z;
    unsigned sum, cnt, mine, sp = 0u;
    for (;;) {
        sum = 0u; cnt = 0u; mine = 0u;
#pragma unroll
        for (unsigned j = 0; j < 16; ++j) { const unsigned c = xb_ld(&bar[XB_XCNT(j)]); sum += c; cnt += (c > 0u) ? 1u : 0u; mine = (j == x) ? c : mine; }
        if (sum == G) break;
        __builtin_amdgcn_s_sleep(1);
        if ((++sp & 255u) == 0u) { if (xb_ld(&bar[XB_TMO])) break; if (sp > XB_SPIN_CAP) { atomicAdd(&bar[XB_TMO], 1u); break; } }
    }
    nloc = mine > 0u ? mine : 1u; nx = cnt > 0u ? cnt : 1u;
}
__device__ __forceinline__ void xcd_barrier(const XcdBarrier& b, int wid0) {
    asm volatile("s_waitcnt vmcnt(0)" ::: "memory");
    __syncthreads();
    if (wid0 == 0 && lane_id() == 0) {
        unsigned zo = 0; asm volatile("" : "+s"(zo));
        unsigned* bar = b.bar + zo;
        __builtin_amdgcn_s_waitcnt(0);
        unsigned nloc = b.st[0], nx = b.st[1];
        if (nloc == 0u) { xcd_barrier_complete(bar, b.x, nloc, nx); b.st[0] = nloc; b.st[1] = nx; }
        const unsigned old = xb_add(&bar[XB_XSUB(b.x)], 1u);
        const unsigned gen = old / nloc;
        if (old + 1u == (gen + 1u) * nloc) {
            __builtin_amdgcn_fence(__ATOMIC_RELEASE, "agent");
            asm volatile("s_waitcnt vmcnt(0)" ::: "memory");
            const unsigned og = xb_add(&bar[XB_TOP], 1u);
            const unsigned tg = og / nx;
            if (og + 1u == (tg + 1u) * nx) xb_add(&bar[XB_TOPGEN], 1u);
            else XB_SPIN(xb_ld(&bar[XB_TOPGEN]) == tg, bar);
            __builtin_amdgcn_fence(__ATOMIC_ACQUIRE, "agent");
            xb_add(&bar[XB_XGEN(b.x)], 1u);
            asm volatile("s_waitcnt vmcnt(0)" ::: "memory");
        } else {
            XB_SPIN(xb_ld(&bar[XB_XGEN(b.x)]) == gen, bar);
            __builtin_amdgcn_fence(__ATOMIC_ACQUIRE, "agent");
            asm volatile("s_waitcnt vmcnt(0)" ::: "memory");
        }
    }
    __syncthreads();
}

#define XB_LCNT(j)  (3 * XCD_BAR_WORDS + 64 * (j))
__device__ __forceinline__ void placement_init(unsigned* bar, volatile LAS unsigned* st  , int wid0) {
    if (wid0 == 0 && lane_id() == 0) {
        const unsigned x = xb_xcc_id(), G = gridDim.x;
        const unsigned rank = xb_add(&bar[XB_XCNT(x)], 1u);
        unsigned c[16], sum, sp = 0u;
        for (;;) { sum = 0u;
#pragma unroll
            for (unsigned j = 0; j < 16; ++j) { c[j] = xb_ld(&bar[XB_XCNT(j)]); sum += c[j]; }
            if (sum == G) break;
            __builtin_amdgcn_s_sleep(1);
            if ((++sp & 255u) == 0u) { if (xb_ld(&bar[XB_TMO])) break; if (sp > XB_SPIN_CAP) { atomicAdd(&bar[XB_TMO], 1u); break; } } }
        unsigned nx = 0u, jx = 0u, mine = 1u; bool even = true;
#pragma unroll
        for (unsigned j = 0; j < 16; ++j) { if (c[j] > 0u) { if (j < x) ++jx; ++nx; } if (j == x) mine = c[j] > 0u ? c[j] : 1u; }
#pragma unroll
        for (unsigned j = 0; j < 16; ++j) if (c[j] > 0u && c[j] != mine) even = false;
        if (nx == 0u) nx = 1u;
        st[0] = mine; st[1] = nx;
        const bool local = even && (mine % 8u == 0u) && (16u % nx == 0u) && sum == G;
        st[2] = local ? jx : 0u; st[3] = local ? rank : blockIdx.x; st[4] = local ? mine : G; st[5] = local ? nx : 1u; st[6] = 0u; st[7] = local ? 1u : 0u;
    }
    __syncthreads();
}
__device__ __forceinline__ void xcd_local_barrier(unsigned* bar, volatile LAS unsigned* st, int wid0) {
    asm volatile("s_waitcnt vmcnt(0)" ::: "memory");
    __syncthreads();
    if (wid0 == 0 && lane_id() == 0) {
        unsigned zo = 0; asm volatile("" : "+s"(zo));
        unsigned* cnt = bar + zo + XB_LCNT(xb_xcc_id());
        const unsigned e = st[6] + 1u; st[6] = e; const unsigned target = e * st[4];
        xb_add(cnt, 1u);
        XB_SPIN(xb_ld(cnt) < target, bar);
        __builtin_amdgcn_fence(__ATOMIC_ACQUIRE, "agent");
        asm volatile("s_waitcnt vmcnt(0)" ::: "memory");
    }
    __syncthreads();
}

constexpr int PH_P0A = 0, PH_P0B = 1, PH_L0 = 2, PH_PER_LAYER = 7, PH_FINAL = PH_L0 + DEPTH * PH_PER_LAYER, PH_END = PH_FINAL + 1;

#ifdef PROBE_SEL
#define MK_STAMP(i) do { if (wid0 == 0 && lane_id() == 0) ((volatile LAS unsigned long long*)(L + LDSCTL_OFF + 1024))[(i)] = __builtin_amdgcn_s_memrealtime(); } while (0)
#else
#define MK_STAMP(i) do {} while (0)
#endif
#define MK_IN_(k) (lo <= (k) && (k) < hi)
#define MK_BAR() XcdBarrier bar; bar.bar = (unsigned*)(args.ws + WS_CTL) + CW_BAR + __builtin_amdgcn_readfirstlane(args.li) * XCD_BAR_WORDS; bar.x = xb_xcc_id(); bar.st = MISC + 8
#define MK_SEAM(k) do { if (MK_IN_(k) && MK_IN_((k) + 1)) { MK_BAR(); xcd_barrier(bar, wid0); } } while (0)
#define MK_SEAM_L(k) do { if (MK_IN_(k) && MK_IN_((k) + 1)) { MK_BAR(); if (__builtin_amdgcn_readfirstlane((int)MISC[15]) != 0) xcd_local_barrier(bar.bar, bar.st, wid0); else xcd_barrier(bar, wid0); } } while (0)
#define MK_PLACE() pg8::Place pl; pl.jx = __builtin_amdgcn_readfirstlane((int)MISC[10]); pl.rank = __builtin_amdgcn_readfirstlane((int)MISC[11]); pl.nloc = __builtin_amdgcn_readfirstlane((int)MISC[12]); pl.nx = __builtin_amdgcn_readfirstlane((int)MISC[13])
#define MK_TAB ((volatile LAS int*)(L + LDSCTL_OFF + 512))
#define MK_PTRS() int zi = 0; asm volatile("" : "+s"(zi)); unsigned char* ws = args.ws + zi; float* out = args.out + zi; (void)out; (void)ws
#define INP(i) ((const float*)args.in[(i) + zi])
#define MK_RB(o, p) (ws + WS_U + (size_t)pl.jx * ((size_t)(T / pl.nx) * 8192) + (size_t)(T / pl.nx) * (o) - (size_t)pl.jx * (T / pl.nx) * (p))
#define RB_U MK_RB(0, 1024)
#define RB_VN MK_RB(1024, 1024)
#define RB_CQ MK_RB(2048, 512)
#define RB_CKV MK_RB(2560, 256)
#define RB_KR MK_RB(2816, 64)
#define RB_Q MK_RB(2880, 1536)
#define RB_KN MK_RB(4416, 1024)
#define RB_V MK_RB(5440, 1024)
#define RB_H MK_RB(0, 8192)
template <int l>
__device__ __forceinline__ void layer_phases(const Args& args, LAS unsigned char* L, volatile LAS unsigned* MISC, int wid0, int lo, int hi) {
    constexpr int P = PH_L0 + l * PH_PER_LAYER;
    if (MK_IN_(P + 0)) { MK_STAMP(2 * (P + 0)); MK_PTRS(); MK_PLACE();
        pg8::Gemm g{(bf16_t*)(ws + WS_A), (const bf16_t*)(ws + WS_W + (size_t)l * WL_STRIDE + WL_IN), T, NIN, DM, DM}; pg8::XcdOrder<NIN / 256> S0; S0.init(pl); const pg8::LdsOrder S = pg8::fill_order(MK_TAB, S0, wid0);
        pg8::EpiIn E{(float*)(ws + WS_SSQ1), (float*)(ws + WS_SHW1) + (size_t)l * NB * NIN, INP(9) + l * QR, INP(10) + l * KVR, (float*)(ws + WS_ROPE), (bf16_t*)RB_U, (bf16_t*)RB_VN, (bf16_t*)RB_CQ, (bf16_t*)RB_CKV, (bf16_t*)RB_KR, (float*)(ws + WS_SSQQ)};
        pg8::gemm_phase<pg8::EpiIn, pg8::LdsOrder, true, true>(L, g, S, E, wid0); }
    MK_STAMP(2 * (P + 0) + 1); MK_SEAM_L(P + 0);
    if (MK_IN_(P + 1)) { MK_STAMP(2 * (P + 1));
        { MK_PTRS(); MK_PLACE(); pg8::Gemm g{(bf16_t*)RB_CQ, (const bf16_t*)(ws + WS_W + (size_t)l * WL_STRIDE + WL_UQ), T, 768, QR, QR}; pg8::XcdOrder<3> S0; S0.init(pl); const pg8::LdsOrder S = pg8::fill_order(MK_TAB, S0, wid0);
          pg8::EpiUp<false> E{(float*)(ws + WS_SSQQ), (float*)(ws + WS_ROPE), (bf16_t*)RB_Q, nullptr, nullptr};
          pg8::gemm_phase<pg8::EpiUp<false>, pg8::LdsOrder, true, true>(L, g, S, E, wid0); }
        { MK_PTRS(); MK_PLACE(); pg8::Gemm g{(bf16_t*)RB_CKV, (const bf16_t*)(ws + WS_W + (size_t)l * WL_STRIDE + WL_UKV), T, 1024, KVR, KVR}; pg8::XcdKvOrder S0; S0.init(pl); const pg8::LdsOrder S = pg8::fill_order(MK_TAB, S0, wid0);
          pg8::EpiUp<true> E{(float*)(ws + WS_SSQQ), nullptr, nullptr, (bf16_t*)RB_KN, (bf16_t*)RB_V};
          pg8::gemm_phase<pg8::EpiUp<true>, pg8::LdsOrder, true, true>(L, g, S, E, wid0); }
        MK_STAMP(2 * (P + 1) + 1); }
    if (MK_IN_(P + 2)) { MK_STAMP(2 * (P + 2)); MK_PTRS(); MK_PLACE();
        gm::gmlp_phase(L, wid0, pl, (bf16_t*)RB_U, (bf16_t*)RB_VN, (bf16_t*)(ws + WS_GW) + (size_t)l * NGRP * CHUNK * CHUNK, INP(8) + l * NGRP * CHUNK, INP(13) + l * DG, (bf16_t*)out, (float*)(ws + WS_SSQY)); }
    MK_STAMP(2 * (P + 2) + 1); MK_SEAM_L(P + 2);
    if (MK_IN_(P + 3)) { MK_STAMP(2 * (P + 3)); MK_PTRS(); MK_PLACE();
        att::attn_phase((LAS char*)L, wid0, pl, (bf16_t*)RB_Q, (bf16_t*)RB_KN, (bf16_t*)RB_KR, (bf16_t*)RB_V, INP(14) + l * DG, (bf16_t*)out, (float*)(ws + WS_SSQY)); }
    MK_STAMP(2 * (P + 3) + 1); MK_SEAM_L(P + 3);
    if (MK_IN_(P + 4)) { MK_STAMP(2 * (P + 4)); MK_PTRS(); MK_PLACE();
        pg8::Gemm g{(const bf16_t*)out, (const bf16_t*)(ws + WS_W + (size_t)l * WL_STRIDE + WL_OUT), T, DM, DM, YLD};   pg8::XcdOrder<4> S0; S0.init(pl); const pg8::LdsOrder S = pg8::fill_order(MK_TAB, S0, wid0);
        pg8::EpiRes<true, l == 0> E{(float*)(ws + WS_SSQY), l == 0 ? (const void*)INP(0) : (const void*)out, (bf16_t*)out, (float*)(ws + WS_MOD) + (size_t)l * NB * NMOD + 2 * DM, (float*)(ws + WS_GM2) + (size_t)l * NB * DM, (bf16_t*)(ws + WS_A), (float*)(ws + WS_SSQ2)};
        pg8::gemm_phase<pg8::EpiRes<true, l == 0>, pg8::LdsOrder, true, true>(L, g, S, E, wid0); }
    MK_STAMP(2 * (P + 4) + 1); MK_SEAM_L(P + 4);
    if (MK_IN_(P + 5)) { MK_STAMP(2 * (P + 5)); MK_PTRS(); MK_PLACE();
        pg8::Gemm g{(bf16_t*)(ws + WS_A), (const bf16_t*)(ws + WS_W + (size_t)l * WL_STRIDE + WL_1), T, DFF, DM, DM}; pg8::XcdOrder<16> S0; S0.init(pl); const pg8::LdsOrder S = pg8::fill_order(MK_TAB, S0, wid0);
        pg8::EpiFf1 E{(float*)(ws + WS_SSQ2), (float*)(ws + WS_SHW2) + (size_t)l * NB * DFF, (bf16_t*)RB_H};
        pg8::gemm_phase<pg8::EpiFf1, pg8::LdsOrder, true, true>(L, g, S, E, wid0); }
    MK_STAMP(2 * (P + 5) + 1); MK_SEAM_L(P + 5);
    if (MK_IN_(P + 6)) { MK_STAMP(2 * (P + 6)); MK_PTRS(); MK_PLACE();
        pg8::Gemm g{(bf16_t*)RB_H, (const bf16_t*)(ws + WS_W + (size_t)l * WL_STRIDE + WL_2), T, DM, DFF, DFF}; pg8::XcdOrder<4> S0; S0.init(pl); const pg8::LdsOrder S = pg8::fill_order(MK_TAB, S0, wid0);
        pg8::EpiRes<false, false> E{nullptr, (const void*)out, (bf16_t*)out, (float*)(ws + WS_MOD) + (size_t)l * NB * NMOD + 5 * DM, (l + 1 < DEPTH) ? (float*)(ws + WS_GM1) + (size_t)(l + 1) * NB * DM : nullptr, (bf16_t*)(ws + WS_A), (float*)(ws + WS_SSQ1)};
        pg8::gemm_phase<pg8::EpiRes<false, false>, pg8::LdsOrder, true, true>(L, g, S, E, wid0); }
    MK_STAMP(2 * (P + 6) + 1); MK_SEAM_L(P + 6);
}
__global__ void __launch_bounds__(NWAVES * 64, 2) mk_fwd(Args args) {
    extern __shared__ __attribute__((aligned(16))) unsigned char lds[];
    LAS unsigned char* L = (LAS unsigned char*)lds;
    volatile LAS unsigned* MISC = (volatile LAS unsigned*)(L + MISC_OFF);
    const int wid0 = __builtin_amdgcn_readfirstlane((int)threadIdx.x >> 6);
    const int G = gridDim.x, bx = blockIdx.x;
    { const int t0 = wid0 * 64 + lane_id(); for (int u = t0; u < (LDS_BYTES - LDSCTL_OFF) / 4; u += NWAVES * 64) ((LAS unsigned*)(L + LDSCTL_OFF))[u] = 0u; }
    __syncthreads();
    const int lo = __builtin_amdgcn_readfirstlane(args.ph_lo), hi = __builtin_amdgcn_readfirstlane(args.ph_hi);
    unsigned* barw = (unsigned*)(args.ws + WS_CTL) + CW_BAR + __builtin_amdgcn_readfirstlane(args.li) * XCD_BAR_WORDS;
    placement_init(barw, MISC + 8, wid0);
    if (MK_IN_(PH_P0A)) { MK_STAMP(2 * (PH_P0A)); MK_PTRS(); MK_PLACE(); pro::phase0a(L, wid0, pl.jx * pl.nloc + pl.rank, G, args, zi, ws); }
    MK_STAMP(2 * PH_P0A + 1); MK_SEAM(PH_P0A);
    if (MK_IN_(PH_P0B)) { MK_STAMP(2 * (PH_P0B)); MK_PTRS(); MK_PLACE(); pro::phase0b(L, wid0, pl.jx * pl.nloc + pl.rank, G, args, zi, ws); }
    MK_STAMP(2 * PH_P0B + 1); MK_SEAM(PH_P0B);
    layer_phases<0>(args, L, MISC, wid0, lo, hi);
    layer_phases<1>(args, L, MISC, wid0, lo, hi);
    if (MK_IN_(PH_FINAL)) { MK_STAMP(2 * (PH_FINAL)); MK_PTRS(); MK_PLACE(); pro::phase_final(wid0, pl, INP(19), (const bf16_t*)out, out); }
    MK_STAMP(2 * PH_FINAL + 1);
#ifdef PROBE_SEL
    if (bx == 0 && wid0 == 0 && lane_id() == 0) {
        volatile LAS unsigned long long* st = (volatile LAS unsigned long long*)(L + LDSCTL_OFF + 1024); unsigned long long sel = 0;
        if (PROBE_SEL >= 0) sel = st[2 * PROBE_SEL + 1] - st[2 * PROBE_SEL];
        else { for (int k = 0; k < PH_FINAL; ++k) if (k != PH_L0 + 1 && k != PH_L0 + PH_PER_LAYER + 1) { int nx = k + 1; sel += st[2 * nx] - st[2 * k + 1]; } }
        const unsigned long long t0 = __builtin_amdgcn_s_memrealtime(), t1 = t0 + PROBE_MULT * sel;
        while (__builtin_amdgcn_s_memrealtime() < t1) __builtin_amdgcn_s_sleep(8);
    }
#endif
}

#ifndef ONE_LAUNCH
#define ONE_LAUNCH 1
#endif
#ifndef MK_PRO
#define MK_PRO 1
#endif
#ifndef MK_IN
#define MK_IN 1
#endif
#ifndef MK_UP
#define MK_UP 1
#endif
#ifndef MK_GMLP
#define MK_GMLP 1
#endif
#ifndef MK_ATTN
#define MK_ATTN 1
#endif
#ifndef MK_OUT
#define MK_OUT 1
#endif
#ifndef MK_FF1
#define MK_FF1 1
#endif
#ifndef MK_FF2
#define MK_FF2 1
#endif
template <class Epi> static void gemm_naive(hipStream_t st, const bf16_t* A, int lda, const bf16_t* Bt, int ldb, int M, int N, int K, const Epi& e) {
    hipLaunchKernelGGL((k_gemm_naive<Epi>), dim3(N / 64, M / 64), dim3(256), 0, st, A, lda, Bt, ldb, K, e);
}
static int g_grid = 0;
static void launch_mk(hipStream_t st, Args a, int lo, int hi, int li = 0, int flags = 0) {
    a.ph_lo = lo; a.ph_hi = hi; a.li = li; a.flags = flags;
    hipLaunchKernelGGL(mk_fwd, dim3(g_grid), dim3(NWAVES * 64), LDS_BYTES, st, a);
}
extern "C" void kernel_launch(void* const* d_in, const int* in_sizes, int n_in, void* d_out, int out_size, void* d_ws, size_t ws_size, hipStream_t stream) {
    if (n_in != 20 || out_size != T * DM || ws_size < WS_END) { fprintf(stderr, "kernel_launch: unexpected sizes n_in %d out %d ws %zu\n", n_in, out_size, ws_size); return; }
    if (g_grid == 0) {
        int dev = 0, cus = 0; hipGetDevice(&dev); hipDeviceGetAttribute(&cus, hipDeviceAttributeMultiprocessorCount, dev);
        if (hipFuncSetAttribute((const void*)mk_fwd, hipFuncAttributeMaxDynamicSharedMemorySize, LDS_BYTES) != hipSuccess) fprintf(stderr, "kernel_launch: hipFuncSetAttribute failed\n");
        g_grid = cus > 0 ? cus : 256;
    }
    const float* x = (const float*)d_in[0]; const float* c = (const float*)d_in[1]; const int* pos = (const int*)d_in[2];
    const float* w_ada = (const float*)d_in[3]; const float* b_ada = (const float*)d_in[4]; const float* g_mix = (const float*)d_in[5];
    const float* w_in = (const float*)d_in[6]; const float* g_ws = (const float*)d_in[7]; const float* g_bs = (const float*)d_in[8];
    const float* g_q = (const float*)d_in[9]; const float* g_kv = (const float*)d_in[10]; const float* w_uq = (const float*)d_in[11]; const float* w_ukv = (const float*)d_in[12];
    const float* g_og = (const float*)d_in[13]; const float* g_oa = (const float*)d_in[14]; const float* w_out = (const float*)d_in[15];
    const float* g_ffn = (const float*)d_in[16]; const float* w_ff1 = (const float*)d_in[17]; const float* w_ff2 = (const float*)d_in[18]; const float* g_fin = (const float*)d_in[19];
    unsigned char* ws = (unsigned char*)d_ws; float* out = (float*)d_out;
    float* MOD = (float*)(ws + WS_MOD); float* SHW1 = (float*)(ws + WS_SHW1); float* SHW2 = (float*)(ws + WS_SHW2); float* RT = (float*)(ws + WS_ROPE);
    float* GM1 = (float*)(ws + WS_GM1); float* GM2 = (float*)(ws + WS_GM2);
    float* SSQ1 = (float*)(ws + WS_SSQ1); float* SSQ2 = (float*)(ws + WS_SSQ2); float* SSQY = (float*)(ws + WS_SSQY); float* SSQQ = (float*)(ws + WS_SSQQ);
    bf16_t* GW = (bf16_t*)(ws + WS_GW); bf16_t* A = (bf16_t*)(ws + WS_A); bf16_t* U = (bf16_t*)(ws + WS_U); bf16_t* VN = (bf16_t*)(ws + WS_VN);
    bf16_t* CQKV = (bf16_t*)(ws + WS_CQKV); bf16_t* KR = (bf16_t*)(ws + WS_KR); bf16_t* Q = (bf16_t*)(ws + WS_Q); bf16_t* KN = (bf16_t*)(ws + WS_KN); bf16_t* V = (bf16_t*)(ws + WS_V);
    bf16_t* Y = (bf16_t*)(ws + WS_Y); bf16_t* H = (bf16_t*)(ws + WS_H); float* GV = (float*)(ws + WS_GV); float* ZL = (float*)(ws + WS_ZL); float* QRT = (float*)(ws + WS_QRT);
    auto WL = [&](int l, size_t off) { return (bf16_t*)(ws + WS_W + (size_t)l * WL_STRIDE + off); };
    Args a{}; for (int i = 0; i < 20; ++i) a.in[i] = d_in[i]; a.out = out; a.ws = ws;
    hipMemsetAsync(ws + WS_CTL, 0, CTL_ZERO_BYTES, stream);

#if ONE_LAUNCH
#ifdef PROBE_DUP
    launch_mk(stream, a, 0, PROBE_DUP + 1, 0); launch_mk(stream, a, PROBE_DUP, PROBE_DUP + 1, 1); launch_mk(stream, a, PROBE_DUP + 1, PH_END, 2);
#elif defined(PROBE_FFN2)
    launch_mk(stream, a, 0, PH_FINAL, 0); launch_mk(stream, a, PH_FINAL - 1, PH_FINAL, 1, 1); launch_mk(stream, a, PH_FINAL, PH_END, 2);
#elif defined(PROBE_FINAL)
    launch_mk(stream, a, 0, PH_FINAL, 0); launch_mk(stream, a, PH_FINAL, PH_END, 1, 2); launch_mk(stream, a, PH_FINAL, PH_END, 2);
#else
    launch_mk(stream, a, 0, PH_END);
#endif
    return;
#endif
#if MK_PRO
    launch_mk(stream, a, PH_P0A, PH_P0A + 1);
    launch_mk(stream, a, PH_P0B, PH_P0B + 1);
#else
    hipLaunchKernelGGL(k_rope_table, dim3(T * 16 / 256), dim3(256), 0, stream, pos, RT);
    hipLaunchKernelGGL(k_prep_gw, dim3(DEPTH * NGRP * CHUNK * CHUNK / 256), dim3(256), 0, stream, g_ws, GW);
    for (int l = 0; l < DEPTH; ++l) {
        hipLaunchKernelGGL(k_prep_w, dim3((NIN * DM + 255) / 256), dim3(256), 0, stream, w_in + (size_t)l * DM * DIN, DM, DIN, WL(l, WL_IN), NIN, 1);
        hipLaunchKernelGGL(k_prep_wup, dim3((NUP * KUP + 255) / 256), dim3(256), 0, stream, w_uq + (size_t)l * QR * 768, w_ukv + (size_t)l * KVR * 1024, WL(l, WL_UP));
        hipLaunchKernelGGL(k_prep_w, dim3(DM * DM / 256), dim3(256), 0, stream, w_out + (size_t)l * DM * DM, DM, DM, WL(l, WL_OUT), DM, 0);
        hipLaunchKernelGGL(k_prep_w, dim3(DFF * DM / 256), dim3(256), 0, stream, w_ff1 + (size_t)l * DM * DFF, DM, DFF, WL(l, WL_1), DFF, 0);
        hipLaunchKernelGGL(k_prep_w, dim3(DFF * DM / 256), dim3(256), 0, stream, w_ff2 + (size_t)l * DFF * DM, DFF, DM, WL(l, WL_2), DM, 0);
        hipLaunchKernelGGL(k_smallm, dim3(NMOD / 64), dim3(512), 0, stream, c, DM, 1, w_ada + (size_t)l * DM * NMOD, NMOD, NMOD, 0, b_ada + (size_t)l * NMOD, MOD + (size_t)l * NB * NMOD, NMOD, NMOD);
    }
    for (int l = 0; l < DEPTH; ++l) {
        hipLaunchKernelGGL(k_smallm, dim3(NIN / 64), dim3(512), 0, stream, MOD + (size_t)l * NB * NMOD + 0, NMOD, 0, w_in + (size_t)l * DM * DIN, DIN, DIN, 1, (const float*)nullptr, SHW1 + (size_t)l * NB * NIN, NIN, NIN);
        hipLaunchKernelGGL(k_smallm, dim3(DFF / 64), dim3(512), 0, stream, MOD + (size_t)l * NB * NMOD + 3 * DM, NMOD, 0, w_ff1 + (size_t)l * DM * DFF, DFF, DFF, 0, (const float*)nullptr, SHW2 + (size_t)l * NB * DFF, DFF, DFF);
    }
    hipLaunchKernelGGL(k_gm, dim3(DEPTH * NB * DM / 256), dim3(256), 0, stream, g_mix, MOD, 1, GM1);
    hipLaunchKernelGGL(k_gm, dim3(DEPTH * NB * DM / 256), dim3(256), 0, stream, g_ffn, MOD, 4, GM2);
    hipLaunchKernelGGL(k_modx, dim3(T / 4), dim3(256), 0, stream, x, g_mix, MOD + 1 * DM, NMOD, A, SSQ1);

#endif
    for (int l = 0; l < DEPTH; ++l) {
        const float* modl = MOD + (size_t)l * NB * NMOD; const int P = PH_L0 + l * PH_PER_LAYER;
#if MK_IN
        launch_mk(stream, a, P + 0, P + 1);
#else
        { EpiInNaive e{0, SSQ1, SHW1 + (size_t)l * NB * NIN, U, GV, ZL}; gemm_naive(stream, A, DM, WL(l, WL_IN), DM, T, NIN, DM, e); }
        hipLaunchKernelGGL(k_vn, dim3(T * NGRP / 4), dim3(256), 0, stream, GV, VN);
        hipLaunchKernelGGL(k_lat, dim3(T / 4), dim3(256), 0, stream, ZL, g_q + l * QR, g_kv + l * KVR, RT, CQKV, SSQQ, KR);
#endif
#if MK_UP
        launch_mk(stream, a, P + 1, P + 2);
#else
        { EpiUpNaive e{0, SSQQ, Q, QRT, KN, V}; gemm_naive(stream, CQKV, KUP, WL(l, WL_UP), KUP, T, NUP, KUP, e); }
        hipLaunchKernelGGL(k_rope_q, dim3(T * NH * 16 / 256), dim3(256), 0, stream, QRT, RT, Q);
#endif
#if MK_GMLP
        launch_mk(stream, a, P + 2, P + 3);
#else
        hipLaunchKernelGGL(k_gmlp_naive, dim3(T), dim3(512), 0, stream, U, VN, GW + (size_t)l * NGRP * CHUNK * CHUNK, g_bs + l * NGRP * CHUNK, g_og + l * DG, Y, SSQY);
#endif
#if MK_ATTN
        launch_mk(stream, a, P + 3, P + 4);
#else
        hipLaunchKernelGGL(k_attn_naive, dim3(T / 64, NH), dim3(64), 0, stream, Q, KN, KR, V, g_oa + l * DG, Y, SSQY);
#endif
#if MK_OUT
        launch_mk(stream, a, P + 4, P + 5);
#else
        { EpiOutNaive e{512, SSQY, l == 0 ? x : out, out, modl + 2 * DM}; gemm_naive(stream, Y, DM, WL(l, WL_OUT), DM, T, DM, DM, e); }
        hipLaunchKernelGGL(k_modx, dim3(T / 4), dim3(256), 0, stream, out, g_ffn + l * DM, modl + 4 * DM, NMOD, A, SSQ2);
#endif
#if MK_FF1
        launch_mk(stream, a, P + 5, P + 6);
#else
        { EpiFf1Naive e{0, SSQ2, SHW2 + (size_t)l * NB * DFF, H}; gemm_naive(stream, A, DM, WL(l, WL_1), DM, T, DFF, DM, e); }
#endif
#if MK_FF2
        launch_mk(stream, a, P + 6, P + 7);
#else
        { EpiFf2Naive e{0, out, modl + 5 * DM}; gemm_naive(stream, H, DFF, WL(l, WL_2), DFF, T, DM, DFF, e); }
        if (l + 1 < DEPTH) hipLaunchKernelGGL(k_modx, dim3(T / 4), dim3(256), 0, stream, out, g_mix + (l + 1) * DM, MOD + (size_t)(l + 1) * NB * NMOD + 1 * DM, NMOD, A, SSQ1);
#endif
    }
#if MK_PRO
    launch_mk(stream, a, PH_FINAL, PH_FINAL + 1);
#else
    hipLaunchKernelGGL(k_final, dim3(T / 4), dim3(256), 0, stream, out, g_fin, out);
#endif
}
```

```cpp
#include <hip/hip_runtime.h>
#define PROBE_MULT 8
#include <cstdint>
#include <cstdio>
#include <cmath>

typedef unsigned short bf16_t;
typedef short bf16x8 __attribute__((ext_vector_type(8)));
typedef float f32x4 __attribute__((ext_vector_type(4)));

constexpr int DM = 1024, NB = 16, SEQ = 2048, DEPTH = 2, T = NB * SEQ;
constexpr int DG = 512, NGRP = 8, GD = 64, CHUNK = 128, NH = 8, NOPE = 64, ROPE = 32, VD = 64;
constexpr int QR = 256, KVR = 128, DFF = 4096, DIN = 1440, NMOD = 6 * DM;
constexpr int NIN = 1536;
constexpr int NUP = 1792, KUP = 384;
constexpr float EPS = 1e-6f;
constexpr int YLD = 2 * DM;
constexpr float QSCALE = 0.10206207261596577f * 1.4426950408889634f;

constexpr size_t MiB = 1u << 20;
constexpr size_t WS_CTL = 0;
constexpr size_t WS_MOD = 1 * MiB;
constexpr size_t WS_SHW1 = 2 * MiB;
constexpr size_t WS_GM1 = 2 * MiB + 512 * 1024;
constexpr size_t WS_GM2 = 2 * MiB + 768 * 1024;
constexpr size_t WS_SHW2 = 3 * MiB;
constexpr size_t WS_ROPE = 4 * MiB;
constexpr size_t WS_SSQ1 = 8 * MiB;
constexpr size_t WS_SSQ2 = 10 * MiB;
constexpr size_t WS_SSQY = 12 * MiB;
constexpr size_t WS_SSQQ = 14 * MiB;
constexpr size_t WS_GW = 15 * MiB;
constexpr size_t WS_W = 16 * MiB;
constexpr size_t WL_IN = 0, WL_UP = 3 * MiB, WL_OUT = 4 * MiB + MiB / 2, WL_1 = 6 * MiB + MiB / 2, WL_2 = 14 * MiB + MiB / 2, WL_STRIDE = 22 * MiB + MiB / 2;
constexpr size_t WS_A = 64 * MiB;
constexpr size_t WS_U = 128 * MiB;
constexpr size_t WS_VN = 160 * MiB;
constexpr size_t WS_CQKV = 192 * MiB;
constexpr size_t WS_CQ = 192 * MiB;
constexpr size_t WS_CKV = 208 * MiB;
constexpr size_t WL_UQ = 3 * MiB, WL_UKV = 3 * MiB + MiB / 2;
constexpr size_t WS_KR = 216 * MiB;
constexpr size_t WS_Q = 218 * MiB;
constexpr size_t WS_KN = 266 * MiB;
constexpr size_t WS_V = 298 * MiB;
constexpr size_t WS_Y = 330 * MiB;
constexpr size_t WS_H = 128 * MiB;
constexpr size_t WS_GV = 394 * MiB;
constexpr size_t WS_ZL = 458 * MiB;
constexpr size_t WS_QRT = 394 * MiB;
constexpr size_t WS_DUMMY = 448 * MiB;
constexpr size_t WS_END = 512 * MiB;

__device__ __forceinline__ bf16_t f2bf(float f) { unsigned u = __float_as_uint(f); return (bf16_t)((u + 0x7fffu + ((u >> 16) & 1u)) >> 16); }
__device__ __forceinline__ float bf2f(bf16_t h) { return __uint_as_float(((unsigned)h) << 16); }
__device__ __forceinline__ float gelu_tanh(float x) { const float y2 = -2.302208198f * (x + 0.044715f * x * x * x); return x * __builtin_amdgcn_rcpf(1.f + __builtin_amdgcn_exp2f(y2)); }
__device__ __forceinline__ float wave_sum(float v) {
#pragma unroll
    for (int o = 1; o < 64; o <<= 1) v += __shfl_xor(v, o);
    return v;
}
__host__ __device__ __forceinline__ int win_src(int p) {
    if (p < 512) return p;
    if (p < 1024) { const int q = p - 512, tile = q >> 8, r = q & 255, bj = r >> 7, wc = (r >> 5) & 3, j = r & 31; return 512 + tile * 256 + 64 * wc + 32 * bj + j; }
    if (p < 1408) return p;
    if (p < 1440) { const int j = p - 1408, fq = j >> 3, n = (j >> 2) & 1, i = j & 3; return 1408 + 16 * n + 4 * fq + i; }
    return -1;
}
__host__ __device__ __forceinline__ int wup_qcol(int p) {
    const int G = p >> 5, h = G / 3, gi = G - 3 * h, j = p & 31;
    if (gi < 2) return p;
    const int fq = j >> 3, n = (j >> 2) & 1, i = j & 3; return h * 96 + 64 + 16 * n + 4 * fq + i;
}

__global__ void k_rope_table(const int* pos, float* rope) {
    const int idx = blockIdx.x * blockDim.x + threadIdx.x; if (idx >= T * 16) return;
    const int t = idx >> 4, i = idx & 15;
    const float freq = powf(10000.0f, -(float)(2 * i) / 32.0f);
    const float ang = (float)pos[t] * freq;
    rope[t * 32 + i] = cosf(ang); rope[t * 32 + 16 + i] = sinf(ang);
}
__global__ void k_prep_w(const float* W, int K, int N, bf16_t* out, int Nphys, int mode) {
    const size_t idx = (size_t)blockIdx.x * blockDim.x + threadIdx.x; if (idx >= (size_t)Nphys * K) return;
    const int p = (int)(idx / K), k = (int)(idx % K);
    const int s = mode == 1 ? win_src(p) : p;
    out[idx] = (s >= 0 && s < N) ? f2bf(W[(size_t)k * N + s]) : (bf16_t)0;
}
__global__ void k_prep_wup(const float* wuq, const float* wukv, bf16_t* out) {
    const int idx = blockIdx.x * blockDim.x + threadIdx.x; if (idx >= NUP * KUP) return;
    const int p = idx / KUP, k = idx % KUP; float v = 0.f;
    if (p < 768) { if (k < 256) v = wuq[(size_t)k * 768 + wup_qcol(p)]; }
    else { if (k >= 256) v = wukv[(size_t)(k - 256) * 1024 + (p - 768)]; }
    out[idx] = f2bf(v);
}
__global__ void k_prep_gw(const float* ws, bf16_t* gw) {
    const int idx = blockIdx.x * blockDim.x + threadIdx.x; if (idx >= DEPTH * NGRP * CHUNK * CHUNK) return;
    const int s = idx & 127, t = (idx >> 7) & 127;
    gw[idx] = (s <= t) ? f2bf(ws[idx]) : (bf16_t)0;
}
__global__ __launch_bounds__(512) void k_smallm(const float* in, int in_stride, int act, const float* W, int ldw, int N, int mode, const float* bias, float* out, int out_stride, int Nphys) {
    __shared__ float sin_[1024 * 16];
    __shared__ float red[8 * 64 * 16];
    const int tid = threadIdx.x, lane = tid & 63, wave = tid >> 6;
    for (int e = tid; e < 16 * 1024; e += 512) { const int b = e >> 10, k = e & 1023; float v = in[(size_t)b * in_stride + k]; if (act) v = v / (1.f + __expf(-v)); sin_[k * 16 + b] = v; }
    __syncthreads();
    const int p = blockIdx.x * 64 + lane; const int s = (p < Nphys) ? (mode == 1 ? win_src(p) : p) : -1; const bool ok = (s >= 0 && s < N);
    float acc[16];
#pragma unroll
    for (int b = 0; b < 16; ++b) acc[b] = 0.f;
    for (int k = wave * 128; k < wave * 128 + 128; ++k) {
        const float w = ok ? W[(size_t)k * ldw + s] : 0.f;
        const f32x4* sp = (const f32x4*)(sin_ + k * 16);
#pragma unroll
        for (int q = 0; q < 4; ++q) { const f32x4 v = sp[q]; acc[4 * q] += v[0] * w; acc[4 * q + 1] += v[1] * w; acc[4 * q + 2] += v[2] * w; acc[4 * q + 3] += v[3] * w; }
    }
#pragma unroll
    for (int b = 0; b < 16; ++b) red[(wave * 64 + lane) * 16 + b] = acc[b];
    __syncthreads();
    for (int e = tid; e < 64 * 16; e += 512) { const int l = e >> 4, b = e & 15; float sum = 0.f;
#pragma unroll
        for (int w = 0; w < 8; ++w) sum += red[(w * 64 + l) * 16 + b];
        const int pp = blockIdx.x * 64 + l; if (pp < Nphys) out[(size_t)b * out_stride + pp] = sum + (bias ? bias[pp] : 0.f); }
}
__global__ __launch_bounds__(256) void k_modx(const float* x, const float* g, const float* sc  , int sc_stride, bf16_t* A, float* ssq) {
    const int row = blockIdx.x * 4 + (threadIdx.x >> 6), lane = threadIdx.x & 63; if (row >= T) return;
    const int b = row / SEQ; const f32x4* xr = (const f32x4*)(x + (size_t)row * DM); float s = 0.f;
#pragma unroll
    for (int j = 0; j < 4; ++j) { const f32x4 v = xr[lane + 64 * j]; s += v[0] * v[0] + v[1] * v[1] + v[2] * v[2] + v[3] * v[3];
        const int c = 4 * (lane + 64 * j); const f32x4 gv = *(const f32x4*)(g + c), sv = *(const f32x4*)(sc + (size_t)b * sc_stride + c);
        unsigned lo = f2bf(v[0] * gv[0] * (1.f + sv[0])) | ((unsigned)f2bf(v[1] * gv[1] * (1.f + sv[1])) << 16);
        unsigned hi = f2bf(v[2] * gv[2] * (1.f + sv[2])) | ((unsigned)f2bf(v[3] * gv[3] * (1.f + sv[3])) << 16);
        *(uint2*)(A + (size_t)row * DM + c) = make_uint2(lo, hi); }
    s = wave_sum(s);
    if (lane < 16) ssq[(size_t)row * 16 + lane] = (lane == 0) ? s : 0.f;
}
__global__ __launch_bounds__(256) void k_final(const float* x, const float* g, float* out) {
    const int row = blockIdx.x * 4 + (threadIdx.x >> 6), lane = threadIdx.x & 63; if (row >= T) return;
    const f32x4* xr = (const f32x4*)(x + (size_t)row * DM); f32x4 v[4]; float s = 0.f;
#pragma unroll
    for (int j = 0; j < 4; ++j) { v[j] = xr[lane + 64 * j]; s += v[j][0] * v[j][0] + v[j][1] * v[j][1] + v[j][2] * v[j][2] + v[j][3] * v[j][3]; }
    const float rstd = rsqrtf(wave_sum(s) * (1.f / DM) + EPS);
#pragma unroll
    for (int j = 0; j < 4; ++j) { const int c = 4 * (lane + 64 * j); const f32x4 gv = *(const f32x4*)(g + c); *(f32x4*)(out + (size_t)row * DM + c) = v[j] * rstd * gv; }
}

template <class Epi>
__global__ __launch_bounds__(256) void k_gemm_naive(const bf16_t* A, int lda, const bf16_t* Bt, int ldb, int K, Epi epi) {
    const int wave = threadIdx.x >> 6, lane = threadIdx.x & 63, fr = lane & 15, fq = lane >> 4;
    const int row0 = blockIdx.y * 64 + wave * 16, col0 = blockIdx.x * 64;
    f32x4 acc[4];
#pragma unroll
    for (int n = 0; n < 4; ++n) acc[n] = (f32x4){0.f, 0.f, 0.f, 0.f};
    const bf16_t* ap = A + (size_t)(row0 + fr) * lda + 8 * fq;
    const bf16_t* bp = Bt + (size_t)(col0 + fr) * ldb + 8 * fq;
    for (int k0 = 0; k0 < K; k0 += 32) {
        if (Epi::HAS_MID) { if (k0 == epi.ksplit) {
#pragma unroll
            for (int r = 0; r < 4; ++r) { const float m = epi.mid(row0 + 4 * fq + r);
#pragma unroll
                for (int n = 0; n < 4; ++n) acc[n][r] *= m; } } }
        const bf16x8 a = *(const bf16x8*)(ap + k0);
#pragma unroll
        for (int n = 0; n < 4; ++n) { const bf16x8 b = *(const bf16x8*)(bp + (size_t)n * 16 * ldb + k0); acc[n] = __builtin_amdgcn_mfma_f32_16x16x32_bf16(a, b, acc[n], 0, 0, 0); }
    }
#pragma unroll
    for (int r = 0; r < 4; ++r) { const int row = row0 + 4 * fq + r; const float rs = epi.rowscale(row);
#pragma unroll
        for (int n = 0; n < 4; ++n) epi(row, col0 + 16 * n + fr, acc[n][r], rs); }
}
__device__ __forceinline__ float sum16(const float* p) { float s = 0.f;
#pragma unroll
    for (int i = 0; i < 16; ++i) s += p[i]; return s; }
__device__ __forceinline__ float sum8(const float* p) { float s = 0.f;
#pragma unroll
    for (int i = 0; i < 8; ++i) s += p[i]; return s; }
__device__ __forceinline__ float sum4(const float* p) { return (p[0] + p[1]) + (p[2] + p[3]); }

struct EpiInNaive {
    static constexpr bool HAS_MID = false; int ksplit;
    const float* ssq1; const float* shw1; bf16_t* U; float* GV; float* ZL;
    __device__ float mid(int) const { return 1.f; }
    __device__ float rowscale(int row) const { return rsqrtf(sum16(ssq1 + (size_t)row * 16) * (1.f / DM) + EPS); }
    __device__ void operator()(int row, int p, float acc, float rs) const {
        const int L = win_src(p); if (L < 0) return;
        const float z = rs * acc + shw1[(row / SEQ) * NIN + p];
        if (L < 512) U[(size_t)row * 512 + L] = f2bf(gelu_tanh(z));
        else if (L < 1024) GV[(size_t)row * 512 + (L - 512)] = gelu_tanh(z);
        else ZL[(size_t)row * 416 + (L - 1024)] = z;
    }
};
struct EpiUpNaive {
    static constexpr bool HAS_MID = false; int ksplit;
    const float* ssqq; bf16_t* Q; float* QRT; bf16_t* KN; bf16_t* V;
    __device__ float mid(int) const { return 1.f; }
    __device__ float rowscale(int) const { return 1.f; }
    __device__ void operator()(int row, int p, float acc, float) const {
        if (p < 768) { const float rq = rsqrtf(sum4(ssqq + (size_t)row * 8) * (1.f / QR) + EPS); const float v = acc * rq * QSCALE;
            const int L = wup_qcol(p), h = L / 96, d = L - 96 * h;
            if (d < 64) Q[(size_t)row * 768 + L] = f2bf(v); else QRT[(size_t)row * 256 + h * 32 + (d - 64)] = v; }
        else { const float rk = rsqrtf(sum4(ssqq + (size_t)row * 8 + 4) * (1.f / KVR) + EPS); const float v = acc * rk;
            const int c = p - 768, h = c >> 7, d = c & 127;
            if (d < 64) KN[(size_t)row * 512 + h * 64 + d] = f2bf(v); else V[(size_t)row * 512 + h * 64 + (d - 64)] = f2bf(v); }
    }
};
struct EpiOutNaive {
    static constexpr bool HAS_MID = true; int ksplit;
    const float* ssqy; const float* xin; float* xout; const float* gate;
    __device__ float rg(int row) const { return rsqrtf(sum8(ssqy + (size_t)row * 16) * (1.f / 512) + EPS); }
    __device__ float ra(int row) const { return rsqrtf(sum8(ssqy + (size_t)row * 16 + 8) * (1.f / 512) + EPS); }
    __device__ float mid(int row) const { return rg(row) / ra(row); }
    __device__ float rowscale(int row) const { return ra(row); }
    __device__ void operator()(int row, int n, float acc, float rs) const {
        const size_t i = (size_t)row * DM + n; xout[i] = xin[i] + gate[(size_t)(row / SEQ) * NMOD + n] * (rs * acc);
    }
};
struct EpiFf1Naive {
    static constexpr bool HAS_MID = false; int ksplit;
    const float* ssq2; const float* shw2; bf16_t* H;
    __device__ float mid(int) const { return 1.f; }
    __device__ float rowscale(int row) const { return rsqrtf(sum16(ssq2 + (size_t)row * 16) * (1.f / DM) + EPS); }
    __device__ void operator()(int row, int n, float acc, float rs) const {
        const float z = rs * acc + shw2[(row / SEQ) * DFF + n]; const float r = fmaxf(z, 0.f); H[(size_t)row * DFF + n] = f2bf(r * r);
    }
};
struct EpiFf2Naive {
    static constexpr bool HAS_MID = false; int ksplit;
    float* x; const float* gate;
    __device__ float mid(int) const { return 1.f; }
    __device__ float rowscale(int) const { return 1.f; }
    __device__ void operator()(int row, int n, float acc, float) const {
        const size_t i = (size_t)row * DM + n; x[i] = x[i] + gate[(size_t)(row / SEQ) * NMOD + n] * acc;
    }
};

__global__ __launch_bounds__(256) void k_vn(const float* GV, bf16_t* VN) {
    const int w = blockIdx.x * 4 + (threadIdx.x >> 6), lane = threadIdx.x & 63; if (w >= T * NGRP) return;
    const int row = w >> 3, g = w & 7; const float v = GV[(size_t)row * 512 + g * 64 + lane];
    const float mu = wave_sum(v) * (1.f / 64); const float d = v - mu; const float var = wave_sum(d * d) * (1.f / 64);
    VN[(size_t)row * 512 + g * 64 + lane] = f2bf(d * rsqrtf(var + EPS));
}
__global__ __launch_bounds__(256) void k_lat(const float* ZL, const float* gq, const float* gkv, const float* rope, bf16_t* CQKV, float* ssqq, bf16_t* KR) {
    const int row = blockIdx.x * 4 + (threadIdx.x >> 6), lane = threadIdx.x & 63; if (row >= T) return;
    const float* z = ZL + (size_t)row * 416; float sq = 0.f, sk = 0.f;
#pragma unroll
    for (int j = 0; j < 4; ++j) { const int c = lane + 64 * j; const float v = z[c]; sq += v * v; CQKV[(size_t)row * KUP + c] = f2bf(v * gq[c]); }
#pragma unroll
    for (int j = 0; j < 2; ++j) { const int c = lane + 64 * j; const float v = z[256 + c]; sk += v * v; CQKV[(size_t)row * KUP + 256 + c] = f2bf(v * gkv[c]); }
    sq = wave_sum(sq); sk = wave_sum(sk);
    if (lane < 8) ssqq[(size_t)row * 8 + lane] = (lane == 0) ? sq : (lane == 4) ? sk : 0.f;
    if (lane < 16) { const float x1 = z[384 + lane], x2 = z[384 + 16 + lane], c = rope[(size_t)row * 32 + lane], s = rope[(size_t)row * 32 + 16 + lane];
        KR[(size_t)row * 32 + lane] = f2bf(x1 * c - x2 * s); KR[(size_t)row * 32 + 16 + lane] = f2bf(x1 * s + x2 * c); }
}
__global__ void k_rope_q(const float* QRT, const float* rope, bf16_t* Q) {
    const int idx = blockIdx.x * blockDim.x + threadIdx.x; if (idx >= T * NH * 16) return;
    const int r = idx & 15, h = (idx >> 4) & 7, row = idx >> 7;
    const float x1 = QRT[(size_t)row * 256 + h * 32 + r], x2 = QRT[(size_t)row * 256 + h * 32 + 16 + r], c = rope[(size_t)row * 32 + r], s = rope[(size_t)row * 32 + 16 + r];
    Q[(size_t)row * 768 + h * 96 + 64 + r] = f2bf(x1 * c - x2 * s); Q[(size_t)row * 768 + h * 96 + 80 + r] = f2bf(x1 * s + x2 * c);
}
__global__ __launch_bounds__(512) void k_gmlp_naive(const bf16_t* U, const bf16_t* VN, const bf16_t* GW  , const float* bs  , const float* gog, bf16_t* Y, float* ssqy) {
    const int row = blockIdx.x, g = threadIdx.x >> 6, d = threadIdx.x & 63, c = g * 64 + d;
    const int tt = row & 127, t0 = row - tt;
    const bf16_t* w = GW + ((size_t)g * CHUNK + tt) * CHUNK; float sum = 0.f;
    for (int s = 0; s <= tt; ++s) sum += bf2f(w[s]) * bf2f(VN[(size_t)(t0 + s) * 512 + c]);
    const float y = bf2f(U[(size_t)row * 512 + c]) * (sum + bs[g * CHUNK + tt]);
    Y[(size_t)row * DM + c] = f2bf(y * gog[c]);
    const float q = wave_sum(y * y); if (d == 0) ssqy[(size_t)row * 16 + g] = q;
}
__global__ __launch_bounds__(64) void k_attn_naive(const bf16_t* Q, const bf16_t* KN, const bf16_t* KR, const bf16_t* V, const float* goa, bf16_t* Y, float* ssqy) {
    const int h = blockIdx.y, row = blockIdx.x * 64 + threadIdx.x, b = row / SEQ, i = row - b * SEQ;
    const int iend = (blockIdx.x * 64 % SEQ) + 63;
    float q[96];
#pragma unroll
    for (int d8 = 0; d8 < 12; ++d8) { const bf16x8 v = *(const bf16x8*)(Q + (size_t)row * 768 + h * 96 + d8 * 8);
#pragma unroll
        for (int j = 0; j < 8; ++j) q[d8 * 8 + j] = bf2f((bf16_t)v[j]); }
    float o[64];
#pragma unroll
    for (int d = 0; d < 64; ++d) o[d] = 0.f;
    float m = -1e30f, l = 0.f;
    const size_t kb = (size_t)b * SEQ;
    for (int j = 0; j <= iend; ++j) {
        const bf16_t* kn = KN + (kb + j) * 512 + h * 64; const bf16_t* kr = KR + (kb + j) * 32; const bf16_t* vv = V + (kb + j) * 512 + h * 64;
        float s = 0.f;
#pragma unroll
        for (int d8 = 0; d8 < 8; ++d8) { const bf16x8 kv = *(const bf16x8*)(kn + d8 * 8);
#pragma unroll
            for (int jj = 0; jj < 8; ++jj) s += q[d8 * 8 + jj] * bf2f((bf16_t)kv[jj]); }
#pragma unroll
        for (int d8 = 0; d8 < 4; ++d8) { const bf16x8 kv = *(const bf16x8*)(kr + d8 * 8);
#pragma unroll
            for (int jj = 0; jj < 8; ++jj) s += q[64 + d8 * 8 + jj] * bf2f((bf16_t)kv[jj]); }
        if (j > i) s = -1e30f;
        const float mn = fmaxf(m, s), alpha = exp2f(m - mn), p = (j > i) ? 0.f : exp2f(s - mn);
        l = l * alpha + p; m = mn;
#pragma unroll
        for (int d8 = 0; d8 < 8; ++d8) { const bf16x8 v8 = *(const bf16x8*)(vv + d8 * 8);
#pragma unroll
            for (int jj = 0; jj < 8; ++jj) o[d8 * 8 + jj] = o[d8 * 8 + jj] * alpha + p * bf2f((bf16_t)v8[jj]); }
    }
    const float inv = 1.f / l; float sq = 0.f;
#pragma unroll
    for (int d8 = 0; d8 < 8; ++d8) { unsigned w[4];
#pragma unroll
        for (int jj = 0; jj < 8; jj += 2) { const float y0 = o[d8 * 8 + jj] * inv, y1 = o[d8 * 8 + jj + 1] * inv; sq += y0 * y0 + y1 * y1;
            w[jj >> 1] = f2bf(y0 * goa[h * 64 + d8 * 8 + jj]) | ((unsigned)f2bf(y1 * goa[h * 64 + d8 * 8 + jj + 1]) << 16); }
        *(uint4*)(Y + (size_t)row * DM + 512 + h * 64 + d8 * 8) = make_uint4(w[0], w[1], w[2], w[3]); }
    ssqy[(size_t)row * 16 + 8 + h] = sq;
}

__global__ void k_gm(const float* g  , const float* mod, int chunk, float* gmt) {
    const int idx = blockIdx.x * blockDim.x + threadIdx.x; if (idx >= DEPTH * NB * DM) return;
    const int c = idx & 1023, b = (idx >> 10) & 15, l = idx >> 14;
    gmt[idx] = g[l * DM + c] * (1.f + mod[((size_t)l * NB + b) * NMOD + chunk * DM + c]);
}
__device__ __forceinline__ int lane_id() { int l; asm volatile("v_mbcnt_lo_u32_b32 %0, -1, 0\n\tv_mbcnt_hi_u32_b32 %0, -1, %0" : "=v"(l)); return l; }
__device__ __forceinline__ float swz_xor16(float v) { return __int_as_float(__builtin_amdgcn_ds_swizzle(__float_as_int(v), 0x401F)); }
__device__ __forceinline__ float swz_xor1(float v) { return __int_as_float(__builtin_amdgcn_ds_swizzle(__float_as_int(v), 0x041F)); }
namespace pg8 {
#define PG8_LAS __attribute__((address_space(3)))
typedef unsigned u32x4 __attribute__((ext_vector_type(4)));
typedef unsigned u32x2 __attribute__((ext_vector_type(2)));
constexpr int BM = 256, BK = 64, HALF = 128, HTB = HALF * BK * 2  , STAGE_BYTES = 8 * HTB, NXCD = 8, WGM = 8;

__host__ __device__ __forceinline__ int lds_byte(int r, int c) { const int st = (r >> 4) * 2 + (c >> 5), rr = r & 15, cc = c & 31, ob = rr * 64 + cc * 2; return st * 1024 + (ob ^ (((ob >> 9) & 1) << 5)); }
__host__ __device__ __forceinline__ void stage_rc(int b, int& R, int& C) { const int st = b / 1024, sb = b % 1024, swz = sb ^ (((sb >> 9) & 1) << 5); R = (st >> 1) * 16 + swz / 64; C = (st & 1) * 32 + (swz % 64) / 2; }
__host__ __device__ __forceinline__ int perm32(int rho) { const int n = rho >> 4, i = rho & 15; return 8 * (i >> 2) + 4 * n + (i & 3); }

struct Unit { int pm, pn; };
struct Gemm { const bf16_t* A; const bf16_t* Bt; int M, N, K, lda; };

struct StaticOrder {
    int nM, nN, nwg, G, c;
    __host__ __device__ void init(int M, int N, int G_, int c_) { nM = M / BM; nN = N / BM; nwg = nM * nN; G = G_; c = c_; }
    __host__ __device__ bool next(int i, Unit& u) const {
        const long L = (long)i * G + c; if (L >= nwg) return false;
        int wgid = (int)L; { const int q = nwg / NXCD, r = nwg % NXCD, xcd = wgid % NXCD, off = wgid / NXCD; wgid = (xcd < r ? xcd * (q + 1) : r * (q + 1) + (xcd - r) * q) + off; }
        const int nig = WGM * nN, gid = wgid / nig, fm = gid * WGM, gsz = (nM - fm) < WGM ? (nM - fm) : WGM;
        u.pm = fm + ((wgid % nig) % gsz); u.pn = (wgid % nig) / gsz; return true;
    }
    __device__ __forceinline__ void a_ready(const Unit&) const {}
    __device__ __forceinline__ void done(const Unit&) const {}
};

struct KvOrder : StaticOrder {
    __host__ __device__ bool next(int i, Unit& u) const {
        if (G != 256 || nwg != 512) return StaticOrder::next(i, u);
        StaticOrder t = *this; t.G = 1 << 30;
        if (c < 128) { if (i > 0) return false; t.c = c; } else { if (i > 2) return false; t.c = (i == 0) ? c : 256 + 2 * (c - 128) + (i - 1); }
        return t.next(0, u);
    }
};
struct Place { int jx, nx, rank, nloc; };
template <int NN> struct XcdOrder {
    int p0, nunits, rank, nloc;
    __device__ __forceinline__ void init(const Place& p) { p0 = p.jx * (128 / p.nx); nunits = (128 / p.nx) * NN; rank = p.rank; nloc = p.nloc; }
    __device__ __forceinline__ bool map(int idx, Unit& u) const { if (idx >= nunits) return false; const int gi = idx / (8 * NN), w = idx - gi * (8 * NN); u.pm = p0 + 8 * gi + (w & 7); u.pn = w >> 3; return true; }
    __device__ __forceinline__ bool next(int i, Unit& u) const { return map(rank + i * nloc, u); }
    __device__ __forceinline__ void a_ready(const Unit&) const {}
    __device__ __forceinline__ void done(const Unit&) const {}
};
struct LdsOrder {
    volatile PG8_LAS int* tab;
    __device__ __forceinline__ bool next(int i, Unit& u) const { if (i >= __builtin_amdgcn_readfirstlane(tab[0])) return false; u.pm = __builtin_amdgcn_readfirstlane(tab[1 + 2 * i]); u.pn = __builtin_amdgcn_readfirstlane(tab[2 + 2 * i]); return true; }
    __device__ __forceinline__ void a_ready(const Unit&) const {}
    __device__ __forceinline__ void done(const Unit&) const {}
};
template <class Src> __device__ __forceinline__ LdsOrder fill_order(volatile PG8_LAS int* tab, const Src& S, int wid0) {
    __syncthreads();
    if (wid0 == 0 && lane_id() == 0) { Unit u; int n = 0; while (n < 15 && S.next(n, u)) { tab[1 + 2 * n] = u.pm; tab[2 + 2 * n] = u.pn; ++n; } tab[0] = n; }
    __syncthreads();
    LdsOrder o; o.tab = tab; return o;
}
struct XcdKvOrder : XcdOrder<4> {
    __device__ __forceinline__ bool next(int i, Unit& u) const {
        if (nloc != 32 || nunits != 64) return XcdOrder<4>::next(i, u);
        if (rank < 16) return i == 0 ? map(rank, u) : false;
        if (i > 2) return false; return map(i == 0 ? rank : 32 + 2 * (rank - 16) + (i - 1), u);
    }
};
struct FusedPlace { int p0, rank; bool ok; __device__ __forceinline__ void init(const Place& p) { p0 = p.jx * (128 / p.nx); rank = p.rank; ok = (p.nloc == 32 && p.nx == 8); } };
struct FusedInOrder : FusedPlace { __device__ __forceinline__ bool next(int i, Unit& u) const {
        if (i == 0) { u.pm = p0 + (rank & 15); u.pn = 4 + (rank >> 4); return true; }
        if (i > 2) return false; const int w = rank + 32 * (i - 1); u.pm = p0 + 8 * (w >> 5) + (w & 7); u.pn = (w & 31) >> 3; return true; } };
struct FusedUqOrder : FusedPlace { __device__ __forceinline__ bool next(int i, Unit& u) const { if (rank >= 16 || i > 2) return false; u.pm = p0 + rank; u.pn = i; return true; } };
struct FusedUkvOrder : FusedPlace { __device__ __forceinline__ bool next(int i, Unit& u) const { if (rank < 16 || i > 3) return false; u.pm = p0 + rank - 16; u.pn = i; return true; } };
__device__ __forceinline__ unsigned cvt_pk_bf16(float lo, float hi) { unsigned r; asm volatile("v_cvt_pk_bf16_f32 %0, %1, %2" : "=v"(r) : "v"(lo), "v"(hi)); return r; }
__device__ __forceinline__ u32x4 pack8(const f32x4& a, const f32x4& b) { u32x4 w; w.x = cvt_pk_bf16(a[0], a[1]); w.y = cvt_pk_bf16(a[2], a[3]); w.z = cvt_pk_bf16(b[0], b[1]); w.w = cvt_pk_bf16(b[2], b[3]); return w; }
__device__ __forceinline__ u32x2 pack4(const f32x4& a) { u32x2 w; w.x = cvt_pk_bf16(a[0], a[1]); w.y = cvt_pk_bf16(a[2], a[3]); return w; }
__device__ __forceinline__ float hsum4(const f32x4& a) { return (a[0] + a[1]) + (a[2] + a[3]); }
__device__ __forceinline__ float hsq4(const f32x4& a) { return (a[0] * a[0] + a[1] * a[1]) + (a[2] * a[2] + a[3] * a[3]); }
__device__ __forceinline__ float ld_sum16(const float* p) { const f32x4* q = (const f32x4*)p; return (hsum4(q[0]) + hsum4(q[1])) + (hsum4(q[2]) + hsum4(q[3])); }
__device__ __forceinline__ float ld_sum8(const float* p) { const f32x4* q = (const f32x4*)p; return hsum4(q[0]) + hsum4(q[1]); }
__device__ __forceinline__ float ld_sum4(const float* p) { return hsum4(*(const f32x4*)p); }
__device__ __forceinline__ float quad_sum(float s) { s += swz_xor16(s); auto rr = __builtin_amdgcn_permlane32_swap(__float_as_uint(s), __float_as_uint(s), false, false); return __uint_as_float(rr[0]) + __uint_as_float(rr[1]); }
__device__ __forceinline__ float row_sum16(const float* ssq, int row, int fq) { return quad_sum(hsum4(*(const f32x4*)(ssq + (size_t)row * 16 + 4 * fq))); }
__device__ __forceinline__ void row_sum8x2(const float* ssq, int row, int fq, float& sg, float& sa) {
    float s = hsum4(*(const f32x4*)(ssq + (size_t)row * 16 + 4 * fq)); s += swz_xor16(s);
    auto rr = __builtin_amdgcn_permlane32_swap(__float_as_uint(s), __float_as_uint(s), false, false); sg = __uint_as_float(rr[0]); sa = __uint_as_float(rr[1]); }
#define PG8_FENCE() asm volatile("" ::: "memory")
#define PG8_RSTD8(rsv, ssqp, invn) do { f32x4 q_[2][4]; \
    _Pragma("unroll") for (int ai = 0; ai < 2; ++ai) _Pragma("unroll") for (int m = 0; m < 4; ++m) q_[ai][m] = *(const f32x4*)((ssqp) + (size_t)PG8_ROW(u, ai, m) * 16 + 4 * fq); \
    _Pragma("unroll") for (int ai = 0; ai < 2; ++ai) _Pragma("unroll") for (int m = 0; m < 4; ++m) rsv[ai][m] = rsqrtf(quad_sum(hsum4(q_[ai][m])) * (invn) + EPS); \
    PG8_FENCE(); } while (0)
__device__ __forceinline__ f32x4 gelu4(const f32x4& v) { f32x4 o; o[0] = gelu_tanh(v[0]); o[1] = gelu_tanh(v[1]); o[2] = gelu_tanh(v[2]); o[3] = gelu_tanh(v[3]); return o; }

#define PG8_ROW(u, ai, m) ((u).pm * BM + (ai) * HALF + wr * 64 + (m) * 16 + fr)

template <class V, class P> __device__ __forceinline__ V ldb(const P* p, unsigned boff) { return *(const V*)((const char*)p + boff); }
template <class V, class P> __device__ __forceinline__ void stb(P* p, unsigned boff, const V& v) { *(V*)((char*)p + boff) = v; }
#undef PG8_RSTD8
#define PG8_RSTD8(rsv, ssqp, invn) do { f32x4 q_[2][4]; \
    _Pragma("unroll") for (int ai = 0; ai < 2; ++ai) _Pragma("unroll") for (int m = 0; m < 4; ++m) q_[ai][m] = ldb<f32x4>((ssqp), (unsigned)(PG8_ROW(u, ai, m) * 64 + 16 * fq)); \
    _Pragma("unroll") for (int ai = 0; ai < 2; ++ai) _Pragma("unroll") for (int m = 0; m < 4; ++m) rsv[ai][m] = rsqrtf(quad_sum(hsum4(q_[ai][m])) * (invn) + EPS); \
    PG8_FENCE(); } while (0)

struct EpiIn {
    static constexpr int K = DM, LDA = DM;
    static constexpr bool PERM = true, AFTER_DRAIN = false, HAS_MID = false; static constexpr int MID_T = -1;
    const float* ssq1; const float* shw1; const float* gq; const float* gkv; const float* rope;
    bf16_t* U; bf16_t* VN; bf16_t* CQ; bf16_t* CKV; bf16_t* KR; float* ssqq;
    __device__ __forceinline__ void mid(f32x4 (&)[2][2][4][2], const Unit&, int, int) const {}
    __device__ __forceinline__ void operator()(const f32x4 (&acc)[2][2][4][2], const Unit& u, int wr, int wc, int fr, int fq) const {
        { const int l_ = lane_id(); fr = l_ & 15; fq = l_ >> 4; }
        const int b = u.pm >> 3, pc0 = u.pn * BM + wc * 32 + 8 * fq;
        f32x4 sh[2][2];
#pragma unroll
        for (int bj = 0; bj < 2; ++bj)
#pragma unroll
            for (int n = 0; n < 2; ++n) sh[bj][n] = ldb<f32x4>(shw1, (unsigned)((b * NIN + pc0 + bj * HALF + 4 * n) * 4));
        float rsv[2][4]; PG8_RSTD8(rsv, ssq1, 1.f / DM);
        if (u.pn < 2) {
#pragma unroll
            for (int ai = 0; ai < 2; ++ai)
#pragma unroll
                for (int m = 0; m < 4; ++m) { const int row = PG8_ROW(u, ai, m); const float rs = rsv[ai][m];
#pragma unroll
                    for (int bj = 0; bj < 2; ++bj) { const f32x4 v0 = gelu4(acc[ai][bj][m][0] * rs + sh[bj][0]), v1 = gelu4(acc[ai][bj][m][1] * rs + sh[bj][1]);
                        stb(U, (unsigned)((row * 512 + pc0 + bj * HALF) * 2), pack8(v0, v1)); } }
        } else if (u.pn < 4) {
#pragma unroll
            for (int ai = 0; ai < 2; ++ai)
#pragma unroll
                for (int m = 0; m < 4; ++m) { const int row = PG8_ROW(u, ai, m); const float rs = rsv[ai][m];
                    f32x4 g[2][2]; float s = 0.f;
#pragma unroll
                    for (int bj = 0; bj < 2; ++bj)
#pragma unroll
                        for (int n = 0; n < 2; ++n) { g[bj][n] = gelu4(acc[ai][bj][m][n] * rs + sh[bj][n]); s += hsum4(g[bj][n]); }
                    const float mu = quad_sum(s) * (1.f / 64); float q = 0.f;
#pragma unroll
                    for (int bj = 0; bj < 2; ++bj)
#pragma unroll
                        for (int n = 0; n < 2; ++n) { g[bj][n] = g[bj][n] - mu; q += hsq4(g[bj][n]); }
                    const float rstd = rsqrtf(quad_sum(q) * (1.f / 64) + EPS);
#pragma unroll
                    for (int bj = 0; bj < 2; ++bj) stb(VN, (unsigned)((row * 512 + (u.pn - 2) * 256 + 64 * wc + 32 * bj + 8 * fq) * 2), pack8(g[bj][0] * rstd, g[bj][1] * rstd)); }
        } else if (u.pn == 4) {
            f32x4 gv[2][2];
#pragma unroll
            for (int bj = 0; bj < 2; ++bj)
#pragma unroll
                for (int n = 0; n < 2; ++n) gv[bj][n] = ldb<f32x4>(gq, (unsigned)((bj * HALF + wc * 32 + 8 * fq + 4 * n) * 4));
#pragma unroll
            for (int ai = 0; ai < 2; ++ai)
#pragma unroll
                for (int m = 0; m < 4; ++m) { const int row = PG8_ROW(u, ai, m); const float rs = rsv[ai][m];
                    float ss = 0.f;
#pragma unroll
                    for (int bj = 0; bj < 2; ++bj) { const f32x4 v0 = acc[ai][bj][m][0] * rs + sh[bj][0], v1 = acc[ai][bj][m][1] * rs + sh[bj][1]; ss += hsq4(v0) + hsq4(v1);
                        stb(CQ, (unsigned)((row * QR + bj * HALF + wc * 32 + 8 * fq) * 2), pack8(v0 * gv[bj][0], v1 * gv[bj][1])); }
                    ss = quad_sum(ss); if (fq == 0) stb(ssqq, (unsigned)((row * 8 + wc) * 4), ss); }
        } else {
            const f32x4 gk0 = ldb<f32x4>(gkv, (unsigned)((wc * 32 + 8 * fq) * 4)), gk1 = ldb<f32x4>(gkv, (unsigned)((wc * 32 + 8 * fq + 4) * 4));
#pragma unroll
            for (int ai = 0; ai < 2; ++ai)
#pragma unroll
                for (int m = 0; m < 4; ++m) { const int row = PG8_ROW(u, ai, m); const float rs = rsv[ai][m];
                    const f32x4 v0 = acc[ai][0][m][0] * rs + sh[0][0], v1 = acc[ai][0][m][1] * rs + sh[0][1];
                    float ss = quad_sum(hsq4(v0) + hsq4(v1)); if (fq == 0) stb(ssqq, (unsigned)((row * 8 + 4 + wc) * 4), ss);
                    stb(CKV, (unsigned)((row * KVR + wc * 32 + 8 * fq) * 2), pack8(v0 * gk0, v1 * gk1));
                    if (wc == 0) { const f32x4 x1 = acc[ai][1][m][0] * rs + sh[1][0], x2 = acc[ai][1][m][1] * rs + sh[1][1];
                        const f32x4 c = ldb<f32x4>(rope, (unsigned)((row * 32 + 4 * fq) * 4)), s = ldb<f32x4>(rope, (unsigned)((row * 32 + 16 + 4 * fq) * 4));
                        stb(KR, (unsigned)((row * 32 + 4 * fq) * 2), pack4(x1 * c - x2 * s)); stb(KR, (unsigned)((row * 32 + 16 + 4 * fq) * 2), pack4(x1 * s + x2 * c)); } }
        }
    }
};
template <bool KVP> struct EpiUp {
    static constexpr int K = KVP ? KVR : QR, LDA = K;
    static constexpr bool PROBE2 = false;
    static constexpr bool PERM = true, AFTER_DRAIN = false, HAS_MID = false; static constexpr int MID_T = -1;
    const float* ssqq; const float* rope; bf16_t* Q; bf16_t* KN; bf16_t* V;
    __device__ __forceinline__ void mid(f32x4 (&)[2][2][4][2], const Unit&, int, int) const {}
    __device__ __forceinline__ void operator()(const f32x4 (&acc)[2][2][4][2], const Unit& u, int wr, int wc, int fr, int fq) const {
        { const int l_ = lane_id(); fr = l_ & 15; fq = l_ >> 4; }
        float sq[2][4];
        { f32x4 q_[2][4];
#pragma unroll
        for (int ai = 0; ai < 2; ++ai)
#pragma unroll
            for (int m = 0; m < 4; ++m) q_[ai][m] = ldb<f32x4>(ssqq, (unsigned)((PG8_ROW(u, ai, m) * 8 + (KVP ? 4 : 0)) * 4));
#pragma unroll
        for (int ai = 0; ai < 2; ++ai)
#pragma unroll
            for (int m = 0; m < 4; ++m) sq[ai][m] = hsum4(q_[ai][m]);
        PG8_FENCE(); }
        if (!KVP) {
#pragma unroll
            for (int ai = 0; ai < 2; ++ai)
#pragma unroll
                for (int m = 0; m < 4; ++m) { const int row = PG8_ROW(u, ai, m); const float rq = rsqrtf(sq[ai][m] * (1.f / QR) + EPS) * QSCALE;
#pragma unroll
                    for (int bj = 0; bj < 2; ++bj) { const int G = 8 * u.pn + 4 * bj + wc, h = G / 3, gi = G - 3 * h;
                        const f32x4 v0 = acc[ai][bj][m][0] * rq, v1 = acc[ai][bj][m][1] * rq;
                        if (gi < 2) stb(Q, (unsigned)((row * 768 + 32 * G + 8 * fq) * 2), pack8(v0, v1));
                        else { const f32x4 c = ldb<f32x4>(rope, (unsigned)((row * 32 + 4 * fq) * 4)), s = ldb<f32x4>(rope, (unsigned)((row * 32 + 16 + 4 * fq) * 4));
                            stb(Q, (unsigned)((row * 768 + 96 * h + 64 + 4 * fq) * 2), pack4(v0 * c - v1 * s)); stb(Q, (unsigned)((row * 768 + 96 * h + 80 + 4 * fq) * 2), pack4(v0 * s + v1 * c)); } }
                    if (m & 1) PG8_FENCE(); }
        } else {
#pragma unroll
            for (int ai = 0; ai < 2; ++ai)
#pragma unroll
                for (int m = 0; m < 4; ++m) { const int row = PG8_ROW(u, ai, m); const float rk = rsqrtf(sq[ai][m] * (1.f / KVR) + EPS);
#pragma unroll
                    for (int bj = 0; bj < 2; ++bj) { const int h = 2 * u.pn + bj;
                        const u32x4 w = pack8(acc[ai][bj][m][0] * rk, acc[ai][bj][m][1] * rk);
                        if (wc < 2) stb(KN, (unsigned)((row * 512 + 64 * h + 32 * wc + 8 * fq) * 2), w); else stb(V, (unsigned)((row * 512 + 64 * h + 32 * (wc - 2) + 8 * fq) * 2), w); } }
        }
    }
};
__device__ __forceinline__ f32x4 bf_lo4(const u32x4& w) { f32x4 r; r[0] = __uint_as_float(w.x << 16); r[1] = __uint_as_float(w.x & 0xffff0000u); r[2] = __uint_as_float(w.y << 16); r[3] = __uint_as_float(w.y & 0xffff0000u); return r; }
__device__ __forceinline__ f32x4 bf_hi4(const u32x4& w) { f32x4 r; r[0] = __uint_as_float(w.z << 16); r[1] = __uint_as_float(w.z & 0xffff0000u); r[2] = __uint_as_float(w.w << 16); r[3] = __uint_as_float(w.w & 0xffff0000u); return r; }
template <bool MIDS, bool XF32> struct EpiRes {
    static constexpr int K = MIDS ? DM : DFF, LDA = MIDS ? YLD : DFF;
    static constexpr bool PROBE2 = false;
    static constexpr bool PERM = true, AFTER_DRAIN = false, HAS_MID = MIDS; static constexpr int MID_T = 8;
    const float* ssqy; const void* xin; bf16_t* xout; const float* gate  ; const float* gm  ; bf16_t* A; float* ssqo;
    __device__ __forceinline__ void mid(f32x4 (&acc)[2][2][4][2], const Unit& u, int wr, int fr) const {
        const int l_ = lane_id(); fr = l_ & 15; const int fq = l_ >> 4;
        f32x4 q_[2][4];
#pragma unroll
        for (int ai = 0; ai < 2; ++ai)
#pragma unroll
            for (int m = 0; m < 4; ++m) q_[ai][m] = ldb<f32x4>(ssqy, (unsigned)(PG8_ROW(u, ai, m) * 64 + 16 * fq));
#pragma unroll
        for (int ai = 0; ai < 2; ++ai)
#pragma unroll
            for (int m = 0; m < 4; ++m) { float s = hsum4(q_[ai][m]); s += swz_xor16(s);
                auto rr = __builtin_amdgcn_permlane32_swap(__float_as_uint(s), __float_as_uint(s), false, false); const float sg = __uint_as_float(rr[0]), sa = __uint_as_float(rr[1]);
                const float ratio = sqrtf((sa * (1.f / 512) + EPS) / (sg * (1.f / 512) + EPS));
#pragma unroll
                for (int bj = 0; bj < 2; ++bj)
#pragma unroll
                    for (int n = 0; n < 2; ++n) acc[ai][bj][m][n] = acc[ai][bj][m][n] * ratio; }
    }
    __device__ __forceinline__ void operator()(const f32x4 (&acc)[2][2][4][2], const Unit& u, int wr, int wc, int fr, int fq) const {
        { const int l_ = lane_id(); fr = l_ & 15; fq = l_ >> 4; }
        const int b = u.pm >> 3, c0 = u.pn * BM + wc * 32 + 8 * fq;
        float rs[2][4], ss[2][4];
#pragma unroll
        for (int ai = 0; ai < 2; ++ai)
#pragma unroll
            for (int m = 0; m < 4; ++m) { ss[ai][m] = 0.f; rs[ai][m] = 1.f; }
        if (MIDS) { f32x4 q_[2][4];
#pragma unroll
            for (int ai = 0; ai < 2; ++ai)
#pragma unroll
                for (int m = 0; m < 4; ++m) q_[ai][m] = ldb<f32x4>(ssqy, (unsigned)(PG8_ROW(u, ai, m) * 64 + 32 + 16 * (fq & 1)));
#pragma unroll
            for (int ai = 0; ai < 2; ++ai)
#pragma unroll
                for (int m = 0; m < 4; ++m) { float s = hsum4(q_[ai][m]); s += swz_xor16(s); rs[ai][m] = rsqrtf(s * (1.f / 512) + EPS); }
            PG8_FENCE(); }
#pragma unroll
        for (int bj = 0; bj < 2; ++bj) { const int cb = c0 + bj * HALF;
            const f32x4 g0 = ldb<f32x4>(gate, (unsigned)((b * NMOD + cb) * 4)), g1 = ldb<f32x4>(gate, (unsigned)((b * NMOD + cb + 4) * 4));
            f32x4 m0 = (f32x4){0.f, 0.f, 0.f, 0.f}, m1 = m0; if (gm) { m0 = ldb<f32x4>(gm, (unsigned)((b * DM + cb) * 4)); m1 = ldb<f32x4>(gm, (unsigned)((b * DM + cb + 4) * 4)); }
            if (XF32) {
#pragma unroll
                for (int ai = 0; ai < 2; ++ai) {
                    f32x4 xv[4][2];
#pragma unroll
                    for (int m = 0; m < 4; ++m) { const unsigned off = (unsigned)((PG8_ROW(u, ai, m) * DM + cb) * 4); xv[m][0] = ldb<f32x4>(xin, off); xv[m][1] = ldb<f32x4>(xin, off + 16); }
                    PG8_FENCE();
#pragma unroll
                    for (int m = 0; m < 4; ++m) { const unsigned off = (unsigned)((PG8_ROW(u, ai, m) * DM + cb) * 2), offx = (unsigned)(PG8_ROW(u, ai, m) * (DM * 4) + DM * 2 + cb * 2);
                        const f32x4 x0 = xv[m][0] + g0 * (acc[ai][bj][m][0] * rs[ai][m]), x1 = xv[m][1] + g1 * (acc[ai][bj][m][1] * rs[ai][m]);
                        stb(xout, offx, pack8(x0, x1));
                        if (gm) { ss[ai][m] += hsq4(x0) + hsq4(x1); stb(A, off, pack8(x0 * m0, x1 * m1)); } }
                    PG8_FENCE(); }
            } else {
                u32x4 xw[2][4];
#pragma unroll
                for (int ai = 0; ai < 2; ++ai)
#pragma unroll
                    for (int m = 0; m < 4; ++m) xw[ai][m] = ldb<u32x4>(xin, (unsigned)(PG8_ROW(u, ai, m) * (DM * 4) + DM * 2 + cb * 2));
                PG8_FENCE();
#pragma unroll
                for (int ai = 0; ai < 2; ++ai)
#pragma unroll
                    for (int m = 0; m < 4; ++m) { const unsigned off = (unsigned)((PG8_ROW(u, ai, m) * DM + cb) * 2), offx = (unsigned)(PG8_ROW(u, ai, m) * (DM * 4) + DM * 2 + cb * 2);
                        const f32x4 x0 = bf_lo4(xw[ai][m]) + g0 * (acc[ai][bj][m][0] * rs[ai][m]), x1 = bf_hi4(xw[ai][m]) + g1 * (acc[ai][bj][m][1] * rs[ai][m]);
                        stb(xout, offx, pack8(x0, x1));
                        if (gm) { ss[ai][m] += hsq4(x0) + hsq4(x1); stb(A, off, pack8(x0 * m0, x1 * m1)); } }
                PG8_FENCE(); } }
        if (gm) {
#pragma unroll
            for (int ai = 0; ai < 2; ++ai)
#pragma unroll
                for (int m = 0; m < 4; ++m) { const float s = quad_sum(ss[ai][m]); if (fq == 0) stb(ssqo, (unsigned)((PG8_ROW(u, ai, m) * 16 + u.pn * 4 + wc) * 4), s); } }
    }
};
struct EpiFf1 {
    static constexpr int K = DM, LDA = DM;
    static constexpr bool PERM = true, AFTER_DRAIN = false, HAS_MID = false; static constexpr int MID_T = -1;
    const float* ssq2; const float* shw2; bf16_t* H;
    __device__ __forceinline__ void mid(f32x4 (&)[2][2][4][2], const Unit&, int, int) const {}
    __device__ __forceinline__ void operator()(const f32x4 (&acc)[2][2][4][2], const Unit& u, int wr, int wc, int fr, int fq) const {
        { const int l_ = lane_id(); fr = l_ & 15; fq = l_ >> 4; }
        const int b = u.pm >> 3, c0 = u.pn * BM + wc * 32 + 8 * fq;
        f32x4 sh[2][2];
#pragma unroll
        for (int bj = 0; bj < 2; ++bj)
#pragma unroll
            for (int n = 0; n < 2; ++n) sh[bj][n] = ldb<f32x4>(shw2, (unsigned)((b * DFF + c0 + bj * HALF + 4 * n) * 4));
        float rsv[2][4]; PG8_RSTD8(rsv, ssq2, 1.f / DM);
#pragma unroll
        for (int ai = 0; ai < 2; ++ai)
#pragma unroll
            for (int m = 0; m < 4; ++m) { const int row = PG8_ROW(u, ai, m); const float rs = rsv[ai][m];
#pragma unroll
                for (int bj = 0; bj < 2; ++bj) { f32x4 v0 = acc[ai][bj][m][0] * rs + sh[bj][0], v1 = acc[ai][bj][m][1] * rs + sh[bj][1];
#pragma unroll
                    for (int i = 0; i < 4; ++i) { const float a = fmaxf(v0[i], 0.f), c = fmaxf(v1[i], 0.f); v0[i] = a * a; v1[i] = c * c; }
                    stb(H, (unsigned)((row * DFF + c0 + bj * HALF) * 2), pack8(v0, v1)); } }
    }
};

template <class Epi, class Sched, bool ALIGN_EPI = false, bool SP2 = false>
__device__ __forceinline__ void gemm_phase(PG8_LAS unsigned char* lds, const Gemm g, const Sched& S, const Epi& E, int wid0) {
    int tid_ = wid0 * 64 + lane_id(); asm volatile("" : "+v"(tid_));
    const int tid = tid_, wid = __builtin_amdgcn_readfirstlane(tid >> 6), lane = tid & 63, wr = wid >> 2, wc = wid & 3, fr = lane & 15, fq = lane >> 4;
    constexpr int K = Epi::K, LDA = Epi::LDA, nt = K / BK;
    unsigned voffA[2], voffB[2];
#pragma unroll
    for (int i = 0; i < 2; ++i) { int R, C; stage_rc(tid * 16 + i * 8192, R, C); const int Rb = Epi::PERM ? ((R & ~31) + perm32(R & 31)) : R;
        voffA[i] = (unsigned)(R * LDA + C) * 2u; voffB[i] = (unsigned)(Rb * K + C) * 2u; }
    const size_t kstep = (size_t)(BK * 2);
    const size_t hstep = (size_t)HALF * K * 2;
    const size_t tstep = 2 * hstep;
    const size_t hstepA = (size_t)HALF * LDA * 2, tstepA = 2 * hstepA;
    const unsigned ldsw = (unsigned)wid * 1024u;
    const int aoff = lds_byte(wr * 64 + fr, fq * 8), boff = lds_byte(wc * 32 + fr, fq * 8);
#define PG8_SA(b, h) (((b) * 2 + (h)) * HTB)
#define PG8_SB(b, h) ((4 + (b) * 2 + (h)) * HTB)
#define PG8_STAGE(bufoff, gbase, voff) do { _Pragma("unroll") for (int _i = 0; _i < 2; ++_i) \
        __builtin_amdgcn_global_load_lds((const unsigned*)((const char*)(gbase) + (voff)[_i]), (PG8_LAS unsigned*)(lds + (bufoff) + ldsw + _i * 8192), 16, 0, 0); } while (0)
#define PG8_LDA(dst, b, h) do { _Pragma("unroll") for (int m = 0; m < 4; ++m) _Pragma("unroll") for (int k = 0; k < 2; ++k) dst[m][k] = *(const PG8_LAS bf16x8*)(lds + PG8_SA(b, h) + aoff + m * 2048 + k * 1024); } while (0)
#define PG8_LDB(dst, b, h) do { _Pragma("unroll") for (int n = 0; n < 2; ++n) _Pragma("unroll") for (int k = 0; k < 2; ++k) dst[n][k] = *(const PG8_LAS bf16x8*)(lds + PG8_SB(b, h) + boff + n * 2048 + k * 1024); } while (0)
#define PG8_MMA(ai, bj, At, Bt) do { __builtin_amdgcn_s_setprio(1); _Pragma("unroll") for (int m = 0; m < 4; ++m) _Pragma("unroll") for (int n = 0; n < 2; ++n) _Pragma("unroll") for (int k = 0; k < 2; ++k) \
        acc[ai][bj][m][n] = __builtin_amdgcn_mfma_f32_16x16x32_bf16(Bt[n][k], At[m][k], acc[ai][bj][m][n], 0, 0, 0); __builtin_amdgcn_s_setprio(0); } while (0)
#define PG8_WAIT_V(n) asm volatile("s_waitcnt vmcnt(" #n ")" ::: "memory")
#define PG8_WAIT_L(n) asm volatile("s_waitcnt lgkmcnt(" #n ")" ::: "memory")
#define PG8_BAR __builtin_amdgcn_s_barrier()
#define PG8_SCHED __builtin_amdgcn_sched_barrier(0)
    Unit cur, nxt; int ui = 0;
    if (!S.next(0, cur)) return;
    f32x4 acc[2][2][4][2];
#pragma unroll
    for (int a = 0; a < 2; ++a)
#pragma unroll
        for (int b = 0; b < 2; ++b)
#pragma unroll
            for (int m = 0; m < 4; ++m)
#pragma unroll
                for (int n = 0; n < 2; ++n) acc[a][b][m][n] = (f32x4){0.f, 0.f, 0.f, 0.f};
    bf16x8 At[4][2], B0[2][2], B1[2][2];
    const char* cA = (const char*)g.A + (size_t)cur.pm * tstepA; const char* cB = (const char*)g.Bt + (size_t)cur.pn * tstep;
    S.a_ready(cur);
    if constexpr (SP2) {
        PG8_STAGE(PG8_SB(0, 0), cB, voffB); PG8_STAGE(PG8_SB(0, 1), cB + hstep, voffB); PG8_STAGE(PG8_SA(0, 0), cA, voffA); PG8_STAGE(PG8_SA(0, 1), cA + hstepA, voffA);
        if (wr == 1) PG8_BAR;
        PG8_WAIT_V(2); PG8_BAR;
        PG8_STAGE(PG8_SB(1, 0), cB + kstep, voffB); PG8_STAGE(PG8_SA(1, 0), cA + kstep, voffA); PG8_STAGE(PG8_SB(1, 1), cB + hstep + kstep, voffB);
        PG8_WAIT_V(6); PG8_BAR;
    } else {
        PG8_STAGE(PG8_SB(0, 0), cB, voffB); PG8_STAGE(PG8_SA(0, 0), cA, voffA); PG8_STAGE(PG8_SB(0, 1), cB + hstep, voffB); PG8_STAGE(PG8_SA(0, 1), cA + hstepA, voffA);
        if (wr == 1) PG8_BAR;
        PG8_WAIT_V(4); PG8_BAR;
        PG8_STAGE(PG8_SB(1, 0), cB + kstep, voffB); PG8_STAGE(PG8_SA(1, 0), cA + kstep, voffA); PG8_STAGE(PG8_SB(1, 1), cB + hstep + kstep, voffB);
        PG8_WAIT_V(6); PG8_BAR;
    }
    for (;;) {
        const bool has_next = S.next(ui + 1, nxt);
        const char* nA = has_next ? (const char*)g.A + (size_t)nxt.pm * tstepA : cA; const char* nB = has_next ? (const char*)g.Bt + (size_t)nxt.pn * tstep : cB;
#pragma nounroll
        for (int t = 0; t < nt; t += 2) {
            const bool last = (t == nt - 2);
            const char* a1 = cA + (size_t)(t + 1) * kstep;
            const char* a2 = last ? nA : cA + (size_t)(t + 2) * kstep; const char* b2 = last ? nB : cB + (size_t)(t + 2) * kstep;
            const char* a3 = a2 + kstep; const char* b3 = b2 + kstep;
            if (last && has_next) S.a_ready(nxt);
            if constexpr (Epi::HAS_MID) { if (t == Epi::MID_T) E.mid(acc, cur, wr, fr); }
            if constexpr (SP2) {
            PG8_LDB(B0, 0, 0); PG8_LDB(B1, 0, 1); PG8_SCHED; PG8_LDA(At, 0, 0); PG8_STAGE(PG8_SA(1, 1), a1 + hstepA, voffA);
            PG8_WAIT_V(8); PG8_WAIT_L(0); PG8_BAR; PG8_MMA(0, 0, At, B0); PG8_MMA(0, 1, At, B1); PG8_BAR; PG8_SCHED;
            PG8_LDA(At, 0, 1); PG8_STAGE(PG8_SB(0, 0), b2, voffB); PG8_STAGE(PG8_SB(0, 1), b2 + hstep, voffB); PG8_STAGE(PG8_SA(0, 0), a2, voffA);
            PG8_WAIT_V(8); PG8_WAIT_L(0); PG8_BAR; PG8_MMA(1, 0, At, B0); PG8_MMA(1, 1, At, B1); PG8_BAR; PG8_SCHED;
            PG8_LDB(B0, 1, 0); PG8_LDB(B1, 1, 1); PG8_SCHED; PG8_LDA(At, 1, 0); PG8_STAGE(PG8_SA(0, 1), a2 + hstepA, voffA);
            PG8_WAIT_V(8); PG8_WAIT_L(0); PG8_BAR; PG8_MMA(0, 0, At, B0); PG8_MMA(0, 1, At, B1); PG8_BAR; PG8_SCHED;
            PG8_LDA(At, 1, 1); PG8_STAGE(PG8_SB(1, 0), b3, voffB); PG8_STAGE(PG8_SB(1, 1), b3 + hstep, voffB); PG8_STAGE(PG8_SA(1, 0), a3, voffA);
            PG8_WAIT_V(8); PG8_WAIT_L(0); PG8_BAR; PG8_MMA(1, 0, At, B0); PG8_MMA(1, 1, At, B1); PG8_BAR; PG8_SCHED;
            } else {
            PG8_LDB(B0, 0, 0); PG8_SCHED; PG8_LDA(At, 0, 0); PG8_STAGE(PG8_SA(1, 1), a1 + hstepA, voffA);
            PG8_WAIT_L(8); PG8_BAR; PG8_WAIT_L(0); PG8_MMA(0, 0, At, B0); PG8_BAR; PG8_SCHED;
            PG8_LDB(B1, 0, 1); PG8_STAGE(PG8_SB(0, 0), b2, voffB);
            PG8_BAR; PG8_WAIT_L(0); PG8_MMA(0, 1, At, B1); PG8_BAR;
            PG8_LDA(At, 0, 1); PG8_STAGE(PG8_SA(0, 0), a2, voffA);
            PG8_BAR; PG8_WAIT_L(0); PG8_MMA(1, 0, At, B0); PG8_BAR; PG8_SCHED;
            PG8_STAGE(PG8_SB(0, 1), b2 + hstep, voffB);
            PG8_WAIT_V(6); PG8_BAR; PG8_MMA(1, 1, At, B1); PG8_BAR;
            PG8_LDB(B0, 1, 0); PG8_SCHED; PG8_LDA(At, 1, 0); PG8_STAGE(PG8_SA(0, 1), a2 + hstepA, voffA);
            PG8_WAIT_L(8); PG8_BAR; PG8_WAIT_L(0); PG8_MMA(0, 0, At, B0); PG8_BAR; PG8_SCHED;
            PG8_LDB(B1, 1, 1); PG8_STAGE(PG8_SB(1, 0), b3, voffB);
            PG8_BAR; PG8_WAIT_L(0); PG8_MMA(0, 1, At, B1); PG8_BAR;
            PG8_LDA(At, 1, 1); PG8_STAGE(PG8_SA(1, 0), a3, voffA);
            PG8_BAR; PG8_WAIT_L(0); PG8_MMA(1, 0, At, B0); PG8_BAR; PG8_SCHED;
            PG8_STAGE(PG8_SB(1, 1), b3 + hstep, voffB);
            PG8_WAIT_V(6); PG8_BAR; PG8_MMA(1, 1, At, B1); PG8_BAR;
            }
        }
        if constexpr (ALIGN_EPI) { if (wr == 0) PG8_BAR; }
        if constexpr (!Epi::AFTER_DRAIN) { E(acc, cur, wr, wc, fr, fq); S.done(cur); }
        if (!has_next) break;
#pragma unroll
        for (int a = 0; a < 2; ++a)
#pragma unroll
            for (int b = 0; b < 2; ++b)
#pragma unroll
                for (int m = 0; m < 4; ++m)
#pragma unroll
                    for (int n = 0; n < 2; ++n) acc[a][b][m][n] = (f32x4){0.f, 0.f, 0.f, 0.f};
        cur = nxt; cA = nA; cB = nB; ++ui;
        if constexpr (ALIGN_EPI) { if (wr == 1) PG8_BAR; }
    }
    PG8_WAIT_V(0);
    if constexpr (!ALIGN_EPI) { if (wr == 0) PG8_BAR; }
    PG8_BAR;
    if constexpr (Epi::AFTER_DRAIN) { E.fused(acc, cur, wr, wc, fr, fq, lds, wid, lane); S.done(cur); }
#undef PG8_SA
#undef PG8_SB
#undef PG8_STAGE
#undef PG8_LDA
#undef PG8_LDB
#undef PG8_MMA
#undef PG8_WAIT_V
#undef PG8_WAIT_L
#undef PG8_BAR
#undef PG8_SCHED
}
}

namespace gm {
#define GM_LAS __attribute__((address_space(3)))
typedef short v4i16_t __attribute__((ext_vector_type(4)));
__device__ __forceinline__ int swz(int s) { return ((s >> 1) & 1) + 2 * ((s >> 3) & 1); }
__device__ __forceinline__ void gmlp_phase(GM_LAS unsigned char* lds, int wid0, const pg8::Place& pl, const bf16_t* U, const bf16_t* VN, const bf16_t* GW  , const float* bs  , const float* gog  , bf16_t* Y, float* ssqy) {
    int tid_ = wid0 * 64 + lane_id(); asm volatile("" : "+v"(tid_));
    const int tid = tid_, lane = tid & 63, wid = __builtin_amdgcn_readfirstlane(tid >> 6), fr = lane & 15, fq = lane >> 4;
    const int nks = (wid >> 1) + 1, nu = 256 / pl.nx, u0 = pl.jx * nu;
    int gcur = -1; bf16x8 wf[4]; float bias = 0.f; f32x4 gv[4];
    for (int idx = pl.rank; idx < 8 * nu; idx += pl.nloc) {
        const int g = idx & 7, un = u0 + (idx >> 3); const size_t t0 = (size_t)un * CHUNK;
        if (g != gcur) { gcur = g;
#pragma unroll
            for (int ks = 0; ks < 4; ++ks) wf[ks] = *(const bf16x8*)(GW + ((size_t)(g * CHUNK + 16 * wid + fr)) * CHUNK + 32 * ks + 8 * fq);
            bias = bs[g * CHUNK + 16 * wid + fr];
#pragma unroll
            for (int nt = 0; nt < 4; ++nt) gv[nt] = *(const f32x4*)(gog + g * 64 + 16 * nt + 4 * fq); }
        pg8::u32x4 st[2];
#pragma unroll
        for (int k = 0; k < 2; ++k) { const int ix = tid + 512 * k, s = ix >> 3, c16 = ix & 7; st[k] = *(const pg8::u32x4*)(VN + (t0 + s) * 512 + g * 64 + c16 * 8); }
        __syncthreads();
#pragma unroll
        for (int k = 0; k < 2; ++k) { const int ix = tid + 512 * k, s = ix >> 3, c16 = ix & 7; *(GM_LAS pg8::u32x4*)(lds + s * 128 + (((c16 >> 1) ^ swz(s)) * 32) + (c16 & 1) * 16) = st[k]; }
        __syncthreads();
        f32x4 acc[4];
#pragma unroll
        for (int nt = 0; nt < 4; ++nt) acc[nt] = (f32x4){0.f, 0.f, 0.f, 0.f};
#pragma unroll
        for (int ks = 0; ks < 4; ++ks) { if (ks < nks) {
#pragma unroll
            for (int nt = 0; nt < 4; ++nt) {
                const int q = fr >> 2, p = fr & 3;
                const int s0 = 32 * ks + 8 * fq + q, s1 = s0 + 4;
                const v4i16_t lo = __builtin_amdgcn_ds_read_tr16_b64_v4i16((GM_LAS v4i16_t*)(lds + s0 * 128 + ((nt ^ swz(s0)) * 32) + p * 8));
                const v4i16_t hi = __builtin_amdgcn_ds_read_tr16_b64_v4i16((GM_LAS v4i16_t*)(lds + s1 * 128 + ((nt ^ swz(s1)) * 32) + p * 8));
                const bf16x8 vf = (bf16x8){lo[0], lo[1], lo[2], lo[3], hi[0], hi[1], hi[2], hi[3]};
                acc[nt] = __builtin_amdgcn_mfma_f32_16x16x32_bf16(vf, wf[ks], acc[nt], 0, 0, 0);
            } } }
        const size_t row = t0 + 16 * wid + fr; float ss = 0.f;
#pragma unroll
        for (int nt = 0; nt < 4; ++nt) { const int c = g * 64 + 16 * nt + 4 * fq;
            const uint2 uu = *(const uint2*)(U + row * 512 + c);
            f32x4 y; y[0] = bf2f((bf16_t)(uu.x & 0xffff)) * (acc[nt][0] + bias); y[1] = bf2f((bf16_t)(uu.x >> 16)) * (acc[nt][1] + bias);
            y[2] = bf2f((bf16_t)(uu.y & 0xffff)) * (acc[nt][2] + bias); y[3] = bf2f((bf16_t)(uu.y >> 16)) * (acc[nt][3] + bias);
            ss += pg8::hsq4(y); *(pg8::u32x2*)(Y + row * YLD + c) = pg8::pack4(y * gv[nt]); }
        ss = pg8::quad_sum(ss); if (fq == 0) ssqy[row * 16 + g] = ss;
    }
    __syncthreads();
}
}

namespace att {
#define AT_LAS __attribute__((address_space(3)))
using f32x16 = __attribute__((ext_vector_type(16))) float;
using s16x4 = __attribute__((ext_vector_type(4))) short;
using u32x4 = __attribute__((ext_vector_type(4))) unsigned;
constexpr int KVBLK = 64, KSLOTB = 12288, VSLOTB = 8192, NKS = 4, NVS = 4;
constexpr int LDS_V = NKS * KSLOTB  , LDS_WS = LDS_V + NVS * VSLOTB  , LDS_OST = LDS_WS + 8 * 256  , OROW = 144, LDS_BYTES = LDS_OST + 8 * 32 * OROW  ;
__device__ __forceinline__ int crow(int r, int hi) { return (r & 3) + 8 * (r >> 2) + 4 * hi; }
__device__ __forceinline__ void glds16(const void* gsrc, unsigned lds_dst) { unsigned keep;
    asm volatile("s_mov_b32 %0, m0\n\ts_mov_b32 m0, %2\n\ts_nop 0\n\tglobal_load_lds_dwordx4 %1, off\n\ts_mov_b32 m0, %0" : "=&s"(keep) : "v"(gsrc), "s"(lds_dst) : "memory"); }
typedef float f32x2_t __attribute__((ext_vector_type(2))); typedef __bf16 bf16x2_t __attribute__((ext_vector_type(2)));
__device__ __forceinline__ unsigned cvtpk_s(float lo, float hi) { f32x2_t v = {lo, hi}; bf16x2_t b = __builtin_convertvector(v, bf16x2_t); return __builtin_bit_cast(unsigned, b); }
__device__ __forceinline__ float max3f(float a, float b, float c) { float r; asm("v_max3_f32 %0, %1, %2, %3" : "=v"(r) : "v"(a), "v"(b), "v"(c)); return r; }
#define AT_WAIT_BAR(N) asm volatile("s_waitcnt vmcnt(" #N ") lgkmcnt(0)\n\ts_barrier" ::: "memory")
typedef short v4i16_t __attribute__((ext_vector_type(4)));
__device__ __forceinline__ s16x4 vtr(AT_LAS const char* p) { return __builtin_bit_cast(s16x4, __builtin_amdgcn_ds_read_tr16_b64_v4i16((AT_LAS v4i16_t*)p)); }
__device__ __forceinline__ void pv(f32x16 (&o)[2], AT_LAS const char* vp, const u32x4& pw0, const u32x4& pw1, const u32x4& pw2, const u32x4& pw3) {
#pragma unroll
    for (int d0 = 0; d0 < 2; ++d0) { s16x4 lo[4], hh[4];
#pragma unroll
        for (int ks = 0; ks < 4; ++ks) { lo[ks] = vtr(vp + d0 * 4096 + ks * 1024); hh[ks] = vtr(vp + d0 * 4096 + ks * 1024 + 512); }
#define AT_VF(k) (bf16x8){lo[k][0], lo[k][1], lo[k][2], lo[k][3], hh[k][0], hh[k][1], hh[k][2], hh[k][3]}
        o[d0] = __builtin_amdgcn_mfma_f32_32x32x16_bf16(__builtin_bit_cast(bf16x8, pw0), AT_VF(0), o[d0], 0, 0, 0);
        o[d0] = __builtin_amdgcn_mfma_f32_32x32x16_bf16(__builtin_bit_cast(bf16x8, pw1), AT_VF(1), o[d0], 0, 0, 0);
        o[d0] = __builtin_amdgcn_mfma_f32_32x32x16_bf16(__builtin_bit_cast(bf16x8, pw2), AT_VF(2), o[d0], 0, 0, 0);
        o[d0] = __builtin_amdgcn_mfma_f32_32x32x16_bf16(__builtin_bit_cast(bf16x8, pw3), AT_VF(3), o[d0], 0, 0, 0);
#undef AT_VF
    }
}
__device__ __forceinline__ void qkt(f32x16& p0, f32x16& p1, AT_LAS const char* kb, const bf16x8 (&qr)[6], const f32x16& negm) {
    bf16x8 kf[12];
#pragma unroll
    for (int d0 = 0; d0 < 6; ++d0) { kf[2 * d0] = *(AT_LAS const bf16x8*)(kb + d0 * 2048); kf[2 * d0 + 1] = *(AT_LAS const bf16x8*)(kb + d0 * 2048 + 512); }
    __builtin_amdgcn_sched_barrier(0);
    p0 = __builtin_amdgcn_mfma_f32_32x32x16_bf16(kf[0], qr[0], negm, 0, 0, 0); p1 = __builtin_amdgcn_mfma_f32_32x32x16_bf16(kf[1], qr[0], negm, 0, 0, 0);
#pragma unroll
    for (int d0 = 1; d0 < 6; ++d0) { p0 = __builtin_amdgcn_mfma_f32_32x32x16_bf16(kf[2 * d0], qr[d0], p0, 0, 0, 0); p1 = __builtin_amdgcn_mfma_f32_32x32x16_bf16(kf[2 * d0 + 1], qr[d0], p1, 0, 0, 0); }
    asm volatile("s_nop 15\n\ts_nop 7" : "+v"(p0), "+v"(p1));
}
template <int THRL>
__device__ __forceinline__ void attn_unit(int b, int h, int qb, const bf16_t* Q, const bf16_t* KN, const bf16_t* KR, const bf16_t* V, const float* goa  , bf16_t* Y, float* ssqy, AT_LAS char* shm, int wid0) {
    int tid_ = wid0 * 64 + lane_id(); asm volatile("" : "+v"(tid_));
    const int tid = tid_, lane = tid & 63, r32 = lane & 31, hi = lane >> 5; const int wid = __builtin_amdgcn_readfirstlane(tid >> 6);
    const bool late = wid >= 4;
    const size_t rowbase = (size_t)b * SEQ; const int q0 = qb * 256;
    const bf16_t* Qw = Q + (rowbase + q0 + wid * 32) * 768 + h * 96;
    const unsigned lds0 = (unsigned)(uintptr_t)shm;
    AT_LAS float* wsf = (AT_LAS float*)(shm + LDS_WS) + wid * 64;
    const bf16_t* ksrc = KN + (rowbase + lane) * 512 + h * 64 + wid * 8;
    const bf16_t* rsrc = KR + (rowbase + lane) * 32 + (wid & 3) * 8;
    const bf16_t* vsrc = V + (rowbase + 16 * (wid & 3) + (lane >> 2)) * 512 + h * 64 + (wid >> 2) * 32 + (lane & 3) * 8;
    const unsigned kdst = lds0 + wid * 1024, rdst = lds0 + (8 + (wid & 3)) * 1024, vdst = lds0 + LDS_V + wid * 1024;
    const int NT = (q0 + 256) / KVBLK;
#define AT_DMA(jk, jv) do { const int jk_ = (jk) < NT ? (jk) : NT - 1, jv_ = (jv) < NT ? (jv) : NT - 1; \
        glds16(ksrc + (size_t)jk_ * KVBLK * 512, (unsigned)__builtin_amdgcn_readfirstlane(kdst + (jk_ & 3) * KSLOTB)); \
        glds16(rsrc + (size_t)jk_ * KVBLK * 32, (unsigned)__builtin_amdgcn_readfirstlane(rdst + (jk_ & 3) * KSLOTB)); \
        glds16(vsrc + (size_t)jv_ * KVBLK * 512, (unsigned)__builtin_amdgcn_readfirstlane(vdst + (jv_ & 3) * VSLOTB)); } while (0)
    bf16x8 qr[6];
#pragma unroll
    for (int d0 = 0; d0 < 6; ++d0) qr[d0] = *(const bf16x8*)(Qw + (size_t)r32 * 768 + d0 * 16 + hi * 8);
    AT_DMA(0, 0); AT_DMA(1, 1); AT_DMA(2, 1);
    float mhat = 0.f, l_reg = 0.f; f32x16 o[2]; o[0] = f32x16{}; o[1] = f32x16{};
    f32x16 negm = f32x16{}; asm volatile("" : "+v"(negm));
    const int qrel = wid * 32 + r32, wq = wid >> 1;
    AT_LAS const char* kp0 = shm + hi * 1024 + r32 * 16;
    AT_LAS const char* vp0 = shm + LDS_V + ((lane >> 4) & 1) * 32 + (lane & 3) * 8 + (4 * hi + ((lane & 15) >> 2)) * 64;
    u32x4 pw0 = u32x4{}, pw1 = u32x4{}, pw2 = u32x4{}, pw3 = u32x4{}; bool have = false;
    f32x16 p0 = f32x16{}, p1 = f32x16{};
    AT_WAIT_BAR(6);
    if (!late) qkt(p0, p1, kp0, qr, negm);
    for (int t = 0; t < NT; ++t) {
        AT_WAIT_BAR(3);
        AT_DMA(t + 3, t + 2);
        const int jb = t - (NT - 4);
        const bool need = jb <= wq;
        if (late) { if (have) pv(o, vp0 + ((t - 1) & 3) * VSLOTB, pw0, pw1, pw2, pw3);
                    have = false; if (need) qkt(p0, p1, kp0 + (t & 3) * KSLOTB, qr, negm); }
        if (need) {
            if (jb == wq) { const int kb = 64 * jb + 4 * hi;
#pragma unroll
                for (int r = 0; r < 16; ++r) { const int kv = kb + (r & 3) + 8 * (r >> 2); if (kv > qrel) p0[r] = -INFINITY; if (kv + 32 > qrel) p1[r] = -INFINITY; } }
            float ma = max3f(p0[0], p0[1], p1[0]), mb = max3f(p0[2], p0[3], p1[1]); ma = max3f(ma, p1[2], p1[3]);
#pragma unroll
            for (int r = 4; r < 16; r += 4) { ma = max3f(ma, p0[r], p0[r + 1]); mb = max3f(mb, p0[r + 2], p0[r + 3]); ma = max3f(ma, p1[r], p1[r + 1]); mb = max3f(mb, p1[r + 2], p1[r + 3]); }
            float rm = fmaxf(ma, mb);
            { auto rr = __builtin_amdgcn_permlane32_swap(__float_as_uint(rm), __float_as_uint(rm), false, false); rm = fmaxf(__uint_as_float(rr[0]), __uint_as_float(rr[1])); }
            if (t == 0 || __any(rm > (float)THRL)) {
                const float dl = (t == 0) ? rm : fmaxf(rm, 0.f); mhat += dl;
#pragma unroll
                for (int r = 0; r < 16; ++r) { p0[r] -= dl; p1[r] -= dl; negm[r] = -mhat; }
                asm volatile("" : "+v"(negm));
                if (t > 0) { const float f = __builtin_amdgcn_exp2f(-dl); l_reg *= f; if (hi == 0) wsf[r32] = f; asm volatile("s_waitcnt lgkmcnt(0)" ::: "memory");
#pragma unroll
                    for (int r = 0; r < 16; ++r) { const float fr_ = wsf[crow(r, hi)]; o[0][r] *= fr_; o[1][r] *= fr_; } }
            }
            float sacc = 0.f;
#pragma unroll
            for (int r = 0; r < 16; ++r) { p0[r] = __builtin_amdgcn_exp2f(p0[r]); p1[r] = __builtin_amdgcn_exp2f(p1[r]); sacc += p0[r] + p1[r]; }
            l_reg += sacc;
#define AT_PK(P, B) cvtpk_s(P[B], P[B + 1])
            pw0 = (u32x4){AT_PK(p0, 0), AT_PK(p0, 2), AT_PK(p0, 4), AT_PK(p0, 6)}; pw1 = (u32x4){AT_PK(p0, 8), AT_PK(p0, 10), AT_PK(p0, 12), AT_PK(p0, 14)};
            pw2 = (u32x4){AT_PK(p1, 0), AT_PK(p1, 2), AT_PK(p1, 4), AT_PK(p1, 6)}; pw3 = (u32x4){AT_PK(p1, 8), AT_PK(p1, 10), AT_PK(p1, 12), AT_PK(p1, 14)};
#undef AT_PK
            if (late) have = true;
            else pv(o, vp0 + (t & 3) * VSLOTB, pw0, pw1, pw2, pw3);
        }
        if (!late) { if (t + 1 < NT && (jb + 1) <= wq) qkt(p0, p1, kp0 + ((t + 1) & 3) * KSLOTB, qr, negm); }
    }
    if (late && have) pv(o, vp0 + ((NT - 1) & 3) * VSLOTB, pw0, pw1, pw2, pw3);
    { auto rr = __builtin_amdgcn_permlane32_swap(__float_as_uint(l_reg), __float_as_uint(l_reg), false, false); l_reg = __uint_as_float(rr[0]) + __uint_as_float(rr[1]); }
    if (hi == 0) wsf[32 + r32] = __builtin_amdgcn_rcpf(l_reg);
    asm volatile("s_waitcnt lgkmcnt(0)" ::: "memory");
    AT_LAS char* stg = shm + LDS_OST + wid * (32 * OROW);
    { const int row = lane >> 1, half = lane & 1; const size_t grow = rowbase + q0 + wid * 32 + row; float ss = 0.f;
#pragma unroll
      for (int d0 = 0; d0 < 2; ++d0) {
#pragma unroll
        for (int r = 0; r < 16; ++r) { const int orow = crow(r, hi); *(AT_LAS float*)(stg + orow * OROW + r32 * 4) = o[d0][r] * wsf[32 + orow]; }
        asm volatile("s_waitcnt lgkmcnt(0)" ::: "memory");
        const float* gp = goa + h * 64 + d0 * 32 + half * 16; bf16_t* yp = Y + grow * YLD + 512 + h * 64 + d0 * 32 + half * 16;
#pragma unroll
        for (int i = 0; i < 2; ++i) { const f32x4 a = *(AT_LAS const f32x4*)(stg + row * OROW + half * 64 + i * 32), c = *(AT_LAS const f32x4*)(stg + row * OROW + half * 64 + i * 32 + 16);
            ss += pg8::hsq4(a) + pg8::hsq4(c);
            *(u32x4*)(yp + i * 8) = pg8::pack8(a * *(const f32x4*)(gp + i * 8), c * *(const f32x4*)(gp + i * 8 + 4)); }
        asm volatile("s_waitcnt lgkmcnt(0)" ::: "memory"); }
      ss += swz_xor1(ss); if (half == 0) ssqy[grow * 16 + 8 + h] = ss; }
    asm volatile("s_waitcnt vmcnt(0) lgkmcnt(0)\n\ts_barrier" ::: "memory");
#undef AT_DMA
}
__device__ __forceinline__ void attn_phase(AT_LAS char* lds, int wid0, const pg8::Place& pl, const bf16_t* Q, const bf16_t* KN, const bf16_t* KR, const bf16_t* V, const float* goa, bf16_t* Y, float* ssqy) {
    const int nbh = 128 / pl.nx, bh0 = pl.jx * nbh;
    for (int idx = pl.rank; idx < 2 * nbh; idx += pl.nloc) { const int bh = bh0 + (idx >> 1), s = idx & 1;
        for (int i = 0; i < 4; ++i) { const int qb = (i == 0) ? s : (i == 1) ? 7 - s : (i == 2) ? 2 + s : 5 - s;
            attn_unit<8>(bh >> 3, bh & 7, qb, Q, KN, KR, V, goa, Y, ssqy, lds, wid0); } }
}
}

constexpr int NWAVES = 8;
struct Args { const void* in[20]; float* out; unsigned char* ws; int ph_lo, ph_hi, li, flags; };
namespace pro {
#define PR_LAS __attribute__((address_space(3)))
__device__ __forceinline__ unsigned pk2(float lo, float hi) { return (unsigned)f2bf(lo) | ((unsigned)f2bf(hi) << 16); }
template <int MODE  >
__device__ __forceinline__ void tr_item(const float* W, int ldw, bf16_t* WT, int out_ld, int out_koff, int nblk, PR_LAS float* scr, int item, int lane) {
    const int kb = item / nblk, nb = item - kb * nblk, k0 = 64 * kb, n0 = 32 * nb;
    const int pn = n0 + (lane & 31); const int sc0 = MODE == 0 ? pn : (MODE == 1 ? win_src(pn) : wup_qcol(pn));
    const int sc = sc0 >= 0 ? sc0 : 0; const float msk = sc0 >= 0 ? 1.f : 0.f;
    const float* wp = W + (size_t)(k0 + (lane >> 5)) * ldw + sc;
    float v[32];
#pragma unroll
    for (int i = 0; i < 32; ++i) v[i] = wp[(size_t)(2 * i) * ldw];
#pragma unroll
    for (int i = 0; i < 32; ++i) scr[(2 * i + (lane >> 5)) * 33 + (lane & 31)] = v[i] * msk;
    asm volatile("s_waitcnt lgkmcnt(0)" ::: "memory");
    const int c = lane & 7;
#pragma unroll
    for (int j = 0; j < 4; ++j) { const int n = (lane >> 3) + 8 * j; const PR_LAS float* s = scr + (8 * c) * 33 + n;
        pg8::u32x4 o; o.x = pk2(s[0 * 33], s[1 * 33]); o.y = pk2(s[2 * 33], s[3 * 33]); o.z = pk2(s[4 * 33], s[5 * 33]); o.w = pk2(s[6 * 33], s[7 * 33]);
        *(pg8::u32x4*)(WT + (size_t)(n0 + n) * out_ld + out_koff + k0 + 8 * c) = o; }
    asm volatile("s_waitcnt lgkmcnt(0)" ::: "memory");
}
__device__ __forceinline__ void smallm_unit(PR_LAS unsigned char* lds, int tid, const float* in, int in_stride, bool act, const float* W, int ldw, int N, bool winmap, const float* bias, float* out, int out_stride, int p0, int ucols) {
    PR_LAS float* sin_ = (PR_LAS float*)lds; PR_LAS float* red = (PR_LAS float*)(lds + 65536);
    const int lane = tid & 63, wave = tid >> 6;
#pragma unroll 8
    for (int e = tid; e < 16 * 1024; e += 512) { const int b = e >> 10, k = e & 1023; float v = in[(size_t)b * in_stride + k]; if (act) v = v * __builtin_amdgcn_rcpf(1.f + __expf(-v)); sin_[k * 16 + b] = v; }
    __syncthreads();
    const int p = p0 + lane; const int s0 = winmap ? win_src(p) : p; const bool ok = (lane < ucols && s0 >= 0 && s0 < N);
    const int sc = ok ? s0 : 0; const float msk = ok ? 1.f : 0.f;
    const float* wp = W + (size_t)(wave * 128) * ldw + sc;
    float acc[16];
#pragma unroll
    for (int b = 0; b < 16; ++b) acc[b] = 0.f;
    for (int k0 = 0; k0 < 128; k0 += 32) {
        float w[32];
#pragma unroll
        for (int j = 0; j < 32; ++j) w[j] = wp[(size_t)(k0 + j) * ldw];
#pragma unroll
        for (int j = 0; j < 32; ++j) { const PR_LAS f32x4* sp = (const PR_LAS f32x4*)(sin_ + (wave * 128 + k0 + j) * 16);
#pragma unroll
            for (int q = 0; q < 4; ++q) { const f32x4 v = sp[q]; acc[4 * q] += v[0] * w[j]; acc[4 * q + 1] += v[1] * w[j]; acc[4 * q + 2] += v[2] * w[j]; acc[4 * q + 3] += v[3] * w[j]; } }
    }
#pragma unroll
    for (int b = 0; b < 16; ++b) red[(wave * 64 + lane) * 16 + b] = acc[b] * msk;
    __syncthreads();
    for (int e = tid; e < 64 * 16; e += 512) { const int l = e >> 4, b = e & 15; float sum = 0.f;
#pragma unroll
        for (int w = 0; w < 8; ++w) sum += red[(w * 64 + l) * 16 + b];
        if (l < ucols) out[(size_t)b * out_stride + p0 + l] = sum + (bias ? bias[p0 + l] : 0.f); }
    __syncthreads();
}
__device__ __forceinline__ float wsum(float v) {
    v += __int_as_float(__builtin_amdgcn_ds_swizzle(__float_as_int(v), 0x041F)); v += __int_as_float(__builtin_amdgcn_ds_swizzle(__float_as_int(v), 0x081F));
    v += __int_as_float(__builtin_amdgcn_ds_swizzle(__float_as_int(v), 0x101F)); v += __int_as_float(__builtin_amdgcn_ds_swizzle(__float_as_int(v), 0x201F));
    v += __int_as_float(__builtin_amdgcn_ds_swizzle(__float_as_int(v), 0x401F));
    auto rr = __builtin_amdgcn_permlane32_swap(__float_as_uint(v), __float_as_uint(v), false, false); return __uint_as_float(rr[0]) + __uint_as_float(rr[1]);
}
__device__ __forceinline__ void phase0a(PR_LAS unsigned char* lds, int wid0, int vcu, int G, const Args& args, int zi, unsigned char* ws) {
    int tid_ = wid0 * 64 + lane_id(); asm volatile("" : "+v"(tid_));
    const int tid = tid_, lane = tid & 63, wave = tid >> 6;
#define PIN(i) ((const float*)args.in[(i) + zi])
    for (int un = vcu; un < DEPTH * (NMOD / 48); un += G) { const int l = un / (NMOD / 48), p0 = (un % (NMOD / 48)) * 48;
        smallm_unit(lds, tid, PIN(1), DM, true, PIN(3) + (size_t)l * DM * NMOD, NMOD, NMOD, false, PIN(4) + (size_t)l * NMOD, (float*)(ws + WS_MOD) + (size_t)l * NB * NMOD, NMOD, p0, 48); }
    { const int* pos = (const int*)args.in[2 + zi]; float* rope = (float*)(ws + WS_ROPE);
      for (int idx = vcu * 512 + tid; idx < T * 16; idx += G * 512) { const int t = idx >> 4, i = idx & 15;
          const float freq = exp2f(-(float)i * (13.287712379549449f / 16.0f)); const float ang = (float)pos[t] * freq;
          rope[t * 32 + i] = cosf(ang); rope[t * 32 + 16 + i] = sinf(ang); } }
    { const float* gws = PIN(7); bf16_t* gw = (bf16_t*)(ws + WS_GW);
      for (int idx = vcu * 512 + tid; idx < DEPTH * NGRP * CHUNK * CHUNK; idx += G * 512) { const int s = idx & 127, t = (idx >> 7) & 127; gw[idx] = (s <= t) ? f2bf(gws[idx]) : (bf16_t)0; } }
    PR_LAS float* scr = (PR_LAS float*)(lds + wave * 16384);
    const int gw_ = vcu * NWAVES + wave, NGW = G * NWAVES;
    constexpr int I_IN = (DM / 64) * (NIN / 32), I_UQ = (QR / 64) * (768 / 32), I_UKV = (KVR / 64) * (1024 / 32), I_OUT = (DM / 64) * (DM / 32), I_1 = (DM / 64) * (DFF / 32), I_2 = (DFF / 64) * (DM / 32);
    constexpr int I_LAYER = I_IN + I_UQ + I_UKV + I_OUT + I_1 + I_2;
    for (int it = gw_; it < DEPTH * I_LAYER; it += NGW) {
        const int l = it / I_LAYER; int r = it - l * I_LAYER; unsigned char* wl = ws + WS_W + (size_t)l * WL_STRIDE;
        if (r < I_IN) { tr_item<1>(PIN(6) + (size_t)l * DM * DIN, DIN, (bf16_t*)(wl + WL_IN), DM, 0, NIN / 32, scr, r, lane); continue; } r -= I_IN;
        if (r < I_UQ) { tr_item<2>(PIN(11) + (size_t)l * QR * 768, 768, (bf16_t*)(wl + WL_UQ), QR, 0, 768 / 32, scr, r, lane); continue; } r -= I_UQ;
        if (r < I_UKV) { tr_item<0>(PIN(12) + (size_t)l * KVR * 1024, 1024, (bf16_t*)(wl + WL_UKV), KVR, 0, 1024 / 32, scr, r, lane); continue; } r -= I_UKV;
        if (r < I_OUT) { tr_item<0>(PIN(15) + (size_t)l * DM * DM, DM, (bf16_t*)(wl + WL_OUT), DM, 0, DM / 32, scr, r, lane); continue; } r -= I_OUT;
        if (r < I_1) { tr_item<0>(PIN(17) + (size_t)l * DM * DFF, DFF, (bf16_t*)(wl + WL_1), DM, 0, DFF / 32, scr, r, lane); continue; } r -= I_1;
        tr_item<0>(PIN(18) + (size_t)l * DFF * DM, DM, (bf16_t*)(wl + WL_2), DFF, 0, DM / 32, scr, r, lane);
    }
#undef PIN
}
__device__ __forceinline__ void phase0b(PR_LAS unsigned char* lds, int wid0, int vcu, int G, const Args& args, int zi, unsigned char* ws) {
    int tid_ = wid0 * 64 + lane_id(); asm volatile("" : "+v"(tid_));
    const int tid = tid_, lane = tid & 63, wave = tid >> 6;
#define PIN(i) ((const float*)args.in[(i) + zi])
    float* MOD = (float*)(ws + WS_MOD);
    constexpr int U1 = NIN / 48, U2 = DFF / 64, NUNITS = DEPTH * (U1 + U2);
    for (int un = vcu; un < NUNITS; un += G) { const int l = un / (U1 + U2), r = un % (U1 + U2); const float* modl = MOD + (size_t)l * NB * NMOD;
        if (r < U1) smallm_unit(lds, tid, modl, NMOD, false, PIN(6) + (size_t)l * DM * DIN, DIN, DIN, true, nullptr, (float*)(ws + WS_SHW1) + (size_t)l * NB * NIN, NIN, r * 48, 48);
        else smallm_unit(lds, tid, modl + 3 * DM, NMOD, false, PIN(17) + (size_t)l * DM * DFF, DFF, DFF, false, nullptr, (float*)(ws + WS_SHW2) + (size_t)l * NB * DFF, DFF, (r - U1) * 64, 64); }
    for (int idx = vcu * 512 + tid; idx < DEPTH * NB * DM; idx += G * 512) { const int c = idx & 1023, b = (idx >> 10) & 15, l = idx >> 14; const float* m = MOD + ((size_t)l * NB + b) * NMOD;
        ((float*)(ws + WS_GM1))[idx] = PIN(5)[l * DM + c] * (1.f + m[1 * DM + c]); ((float*)(ws + WS_GM2))[idx] = PIN(16)[l * DM + c] * (1.f + m[4 * DM + c]); }
    { const float* x = PIN(0); const float* g = PIN(5); bf16_t* A = (bf16_t*)(ws + WS_A); float* ssq = (float*)(ws + WS_SSQ1);
      const int nun = NUNITS < G ? NUNITS : G; const int wgt = vcu < nun ? 7 : 12, slot0 = vcu < nun ? 7 * vcu : 7 * nun + 12 * (vcu - nun), nslot = 7 * nun + 12 * (G - nun);
      for (int sl = 0; sl < wgt; ++sl)
      for (int row0 = (slot0 + sl) * NWAVES + wave; row0 < T; row0 += 2 * nslot * NWAVES) {
          const int row1 = row0 + nslot * NWAVES; const bool two = row1 < T; const int rowb = two ? row1 : row0;
          f32x4 va[4], vb[4];
#pragma unroll
          for (int j = 0; j < 4; ++j) { va[j] = ((const f32x4*)(x + (size_t)row0 * DM))[lane + 64 * j]; vb[j] = ((const f32x4*)(x + (size_t)rowb * DM))[lane + 64 * j]; }
#pragma unroll
          for (int rr = 0; rr < 2; ++rr) { if (rr == 1 && !two) break; const int row = rr ? row1 : row0; const int b = row / SEQ; const float* sc = MOD + (size_t)b * NMOD + DM; float s = 0.f;
#pragma unroll
              for (int j = 0; j < 4; ++j) { const f32x4 v = rr ? vb[j] : va[j]; s += pg8::hsq4(v); const int c = 4 * (lane + 64 * j); const f32x4 gv = *(const f32x4*)(g + c), sv = *(const f32x4*)(sc + c);
                  *(pg8::u32x2*)(A + (size_t)row * DM + c) = pg8::pack4(v * gv * (sv + 1.f)); }
              s = wsum(s); if (lane < 16) ssq[(size_t)row * 16 + lane] = (lane == 0) ? s : 0.f; } } }
#undef PIN
}
__device__ __forceinline__ void phase_final(int wid0, const pg8::Place& pl, const float* g, const bf16_t* xb, float* dst) {
    int tid_ = wid0 * 64 + lane_id(); asm volatile("" : "+v"(tid_));
    const int lane = tid_ & 63, wave = tid_ >> 6, nr = T / pl.nx, r0 = pl.jx * nr;
    for (int lr = pl.rank * NWAVES + wave; lr < nr; lr += pl.nloc * NWAVES) { const int row = r0 + lr;
        const pg8::u32x4* xr = (const pg8::u32x4*)(xb + (size_t)row * (2 * DM) + DM); f32x4* yr = (f32x4*)(dst + (size_t)row * DM); f32x4 v[4]; float s = 0.f;
#pragma unroll
        for (int j = 0; j < 2; ++j) { const pg8::u32x4 w = xr[lane + 64 * j]; v[2 * j] = pg8::bf_lo4(w); v[2 * j + 1] = pg8::bf_hi4(w); s += pg8::hsq4(v[2 * j]) + pg8::hsq4(v[2 * j + 1]); }
        const float rstd = rsqrtf(wsum(s) * (1.f / DM) + EPS);
#pragma unroll
        for (int j = 0; j < 2; ++j) { const int c = 8 * (lane + 64 * j); const f32x4 g0 = *(const f32x4*)(g + c), g1 = *(const f32x4*)(g + c + 4); yr[2 * (lane + 64 * j)] = v[2 * j] * rstd * g0; yr[2 * (lane + 64 * j) + 1] = v[2 * j + 1] * rstd * g1; } }
}
}

constexpr int RING_BYTES = 131072;
constexpr int LDSCTL_OFF = 135168, MISC_OFF = LDSCTL_OFF + 320;
constexpr int LDS_BYTES = 147456;
static_assert(att::LDS_BYTES <= LDSCTL_OFF, "attention scratch below the control words");
constexpr int CW_BAR = 4096;
constexpr size_t CTL_ZERO_BYTES = 128 * 1024;

#define GAS __attribute__((address_space(1)))
#define LAS __attribute__((address_space(3)))
typedef GAS unsigned gu32;
#define RLX_AGENT __ATOMIC_RELAXED, __HIP_MEMORY_SCOPE_AGENT
#define XB_TMO      128
#define XB_XCNT(j)  (256  + 64 * (j))
#define XB_XSUB(j)  (1280 + 64 * (j))
#define XB_XGEN(j)  (2304 + 64 * (j))
#define XB_TOP      3328
#define XB_TOPGEN   3392
#define XCD_BAR_WORDS 3456
#define XB_SPIN_CAP (1u << 18)
__device__ __forceinline__ unsigned xb_ld(unsigned* p)              { return __hip_atomic_load(p, __ATOMIC_RELAXED, __HIP_MEMORY_SCOPE_AGENT); }
__device__ __forceinline__ unsigned xb_add(unsigned* p, unsigned v) { return __hip_atomic_fetch_add(p, v, __ATOMIC_RELAXED, __HIP_MEMORY_SCOPE_AGENT); }
__device__ __forceinline__ unsigned xb_xcc_id() { return (unsigned)__builtin_amdgcn_s_getreg((3 << 11) | 20) & 0xFu; }
#define XB_SPIN(cond, bar) do { unsigned _sp = 0; while (cond) { __builtin_amdgcn_s_sleep(1); \
    if ((++_sp & 255u) == 0u) { if (xb_ld(&(bar)[XB_TMO])) break; if (_sp > XB_SPIN_CAP) { atomicAdd(&(bar)[XB_TMO], 1u); break; } } } } while (0)
struct XcdBarrier { unsigned* bar; unsigned x; volatile LAS unsigned* st; };
__device__ __forceinline__ XcdBarrier xcd_barrier_post(unsigned* bar, volatile LAS unsigned* st, int wid0) {
    XcdBarrier b; b.bar = bar; b.x = xb_xcc_id(); b.st = st;
    if (wid0 == 0 && lane_id() == 0) (void)xb_add(&bar[XB_XCNT(b.x)], 1u);
    return b;
}
__device__ __forceinline__ void xcd_barrier_complete(unsigned* bar, unsigned x, unsigned& nloc, unsigned& nx) {
    const unsigned G = gridDim.x * gridDim.y * gridDim.z;
    unsigned sum, cnt, mine, sp = 0u;
    for (;;) {
        sum = 0u; cnt = 0u; mine = 0u;
#pragma unroll
        for (unsigned j = 0; j < 16; ++j) { const unsigned c = xb_ld(&bar[XB_XCNT(j)]); sum += c; cnt += (c > 0u) ? 1u : 0u; mine = (j == x) ? c : mine; }
        if (sum == G) break;
        __builtin_amdgcn_s_sleep(1);
        if ((++sp & 255u) == 0u) { if (xb_ld(&bar[XB_TMO])) break; if (sp > XB_SPIN_CAP) { atomicAdd(&bar[XB_TMO], 1u); break; } }
    }
    nloc = mine > 0u ? mine : 1u; nx = cnt > 0u ? cnt : 1u;
}
__device__ __forceinline__ void xcd_barrier(const XcdBarrier& b, int wid0) {
    asm volatile("s_waitcnt vmcnt(0)" ::: "memory");
    __syncthreads();
    if (wid0 == 0 && lane_id() == 0) {
        unsigned zo = 0; asm volatile("" : "+s"(zo));
        unsigned* bar = b.bar + zo;
        __builtin_amdgcn_s_waitcnt(0);
        unsigned nloc = b.st[0], nx = b.st[1];
        if (nloc == 0u) { xcd_barrier_complete(bar, b.x, nloc, nx); b.st[0] = nloc; b.st[1] = nx; }
        const unsigned old = xb_add(&bar[XB_XSUB(b.x)], 1u);
        const unsigned gen = old / nloc;
        if (old + 1u == (gen + 1u) * nloc) {
            __builtin_amdgcn_fence(__ATOMIC_RELEASE, "agent");
            asm volatile("s_waitcnt vmcnt(0)" ::: "memory");
            const unsigned og = xb_add(&bar[XB_TOP], 1u);
            const unsigned tg = og / nx;
            if (og + 1u == (tg + 1u) * nx) xb_add(&bar[XB_TOPGEN], 1u);
            else XB_SPIN(xb_ld(&bar[XB_TOPGEN]) == tg, bar);
            __builtin_amdgcn_fence(__ATOMIC_ACQUIRE, "agent");
            xb_add(&bar[XB_XGEN(b.x)], 1u);
            asm volatile("s_waitcnt vmcnt(0)" ::: "memory");
        } else {
            XB_SPIN(xb_ld(&bar[XB_XGEN(b.x)]) == gen, bar);
            __builtin_amdgcn_fence(__ATOMIC_ACQUIRE, "agent");
            asm volatile("s_waitcnt vmcnt(0)" ::: "memory");
        }
    }
    __syncthreads();
}

#define XB_LCNT(j)  (3 * XCD_BAR_WORDS + 64 * (j))
__device__ __forceinline__ void placement_init(unsigned* bar, volatile LAS unsigned* st  , int wid0) {
    if (wid0 == 0 && lane_id() == 0) {
        const unsigned x = xb_xcc_id(), G = gridDim.x;
        const unsigned rank = xb_add(&bar[XB_XCNT(x)], 1u);
        unsigned c[16], sum, sp = 0u;
        for (;;) { sum = 0u;
#pragma unroll
            for (unsigned j = 0; j < 16; ++j) { c[j] = xb_ld(&bar[XB_XCNT(j)]); sum += c[j]; }
            if (sum == G) break;
            __builtin_amdgcn_s_sleep(1);
            if ((++sp & 255u) == 0u) { if (xb_ld(&bar[XB_TMO])) break; if (sp > XB_SPIN_CAP) { atomicAdd(&bar[XB_TMO], 1u); break; } } }
        unsigned nx = 0u, jx = 0u, mine = 1u; bool even = true;
#pragma unroll
        for (unsigned j = 0; j < 16; ++j) { if (c[j] > 0u) { if (j < x) ++jx; ++nx; } if (j == x) mine = c[j] > 0u ? c[j] : 1u; }
#pragma unroll
        for (unsigned j = 0; j < 16; ++j) if (c[j] > 0u && c[j] != mine) even = false;
        if (nx == 0u) nx = 1u;
        st[0] = mine; st[1] = nx;
        const bool local = even && (mine % 8u == 0u) && (16u % nx == 0u) && sum == G;
        st[2] = local ? jx : 0u; st[3] = local ? rank : blockIdx.x; st[4] = local ? mine : G; st[5] = local ? nx : 1u; st[6] = 0u; st[7] = local ? 1u : 0u;
    }
    __syncthreads();
}
__device__ __forceinline__ void xcd_local_barrier(unsigned* bar, volatile LAS unsigned* st, int wid0) {
    asm volatile("s_waitcnt vmcnt(0)" ::: "memory");
    __syncthreads();
    if (wid0 == 0 && lane_id() == 0) {
        unsigned zo = 0; asm volatile("" : "+s"(zo));
        unsigned* cnt = bar + zo + XB_LCNT(xb_xcc_id());
        const unsigned e = st[6] + 1u; st[6] = e; const unsigned target = e * st[4];
        xb_add(cnt, 1u);
        XB_SPIN(xb_ld(cnt) < target, bar);
        __builtin_amdgcn_fence(__ATOMIC_ACQUIRE, "agent");
        asm volatile("s_waitcnt vmcnt(0)" ::: "memory");
    }
    __syncthreads();
}

constexpr int PH_P0A = 0, PH_P0B = 1, PH_L0 = 2, PH_PER_LAYER = 7, PH_FINAL = PH_L0 + DEPTH * PH_PER_LAYER, PH_END = PH_FINAL + 1;

#ifdef PROBE_SEL
#define MK_STAMP(i) do { if (wid0 == 0 && lane_id() == 0) ((volatile LAS unsigned long long*)(L + LDSCTL_OFF + 1024))[(i)] = __builtin_amdgcn_s_memrealtime(); } while (0)
#else
#define MK_STAMP(i) do {} while (0)
#endif
#define MK_IN_(k) (lo <= (k) && (k) < hi)
#define MK_BAR() XcdBarrier bar; bar.bar = (unsigned*)(args.ws + WS_CTL) + CW_BAR + __builtin_amdgcn_readfirstlane(args.li) * XCD_BAR_WORDS; bar.x = xb_xcc_id(); bar.st = MISC + 8
#define MK_SEAM(k) do { if (MK_IN_(k) && MK_IN_((k) + 1)) { MK_BAR(); xcd_barrier(bar, wid0); } } while (0)
#define MK_SEAM_L(k) do { if (MK_IN_(k) && MK_IN_((k) + 1)) { MK_BAR(); if (__builtin_amdgcn_readfirstlane((int)MISC[15]) != 0) xcd_local_barrier(bar.bar, bar.st, wid0); else xcd_barrier(bar, wid0); } } while (0)
#define MK_PLACE() pg8::Place pl; pl.jx = __builtin_amdgcn_readfirstlane((int)MISC[10]); pl.rank = __builtin_amdgcn_readfirstlane((int)MISC[11]); pl.nloc = __builtin_amdgcn_readfirstlane((int)MISC[12]); pl.nx = __builtin_amdgcn_readfirstlane((int)MISC[13])
#define MK_TAB ((volatile LAS int*)(L + LDSCTL_OFF + 512))
#define MK_PTRS() int zi = 0; asm volatile("" : "+s"(zi)); unsigned char* ws = args.ws + zi; float* out = args.out + zi; (void)out; (void)ws
#define INP(i) ((const float*)args.in[(i) + zi])
#define MK_RB(o, p) (ws + WS_U + (size_t)pl.jx * ((size_t)(T / pl.nx) * 8192) + (size_t)(T / pl.nx) * (o) - (size_t)pl.jx * (T / pl.nx) * (p))
#define RB_U MK_RB(0, 1024)
#define RB_VN MK_RB(1024, 1024)
#define RB_CQ MK_RB(2048, 512)
#define RB_CKV MK_RB(2560, 256)
#define RB_KR MK_RB(2816, 64)
#define RB_Q MK_RB(2880, 1536)
#define RB_KN MK_RB(4416, 1024)
#define RB_V MK_RB(5440, 1024)
#define RB_H MK_RB(0, 8192)
template <int l>
__device__ __forceinline__ void layer_phases(const Args& args, LAS unsigned char* L, volatile LAS unsigned* MISC, int wid0, int lo, int hi) {
    constexpr int P = PH_L0 + l * PH_PER_LAYER;
    if (MK_IN_(P + 0)) { MK_STAMP(2 * (P + 0)); MK_PTRS(); MK_PLACE();
        pg8::Gemm g{(bf16_t*)(ws + WS_A), (const bf16_t*)(ws + WS_W + (size_t)l * WL_STRIDE + WL_IN), T, NIN, DM, DM};
        pg8::FusedInOrder SF; SF.init(pl); pg8::XcdOrder<NIN / 256> S0; S0.init(pl); const pg8::LdsOrder S = SF.ok ? pg8::fill_order(MK_TAB, SF, wid0) : pg8::fill_order(MK_TAB, S0, wid0);
        pg8::EpiIn E{(float*)(ws + WS_SSQ1), (float*)(ws + WS_SHW1) + (size_t)l * NB * NIN, INP(9) + l * QR, INP(10) + l * KVR, (float*)(ws + WS_ROPE), (bf16_t*)RB_U, (bf16_t*)RB_VN, (bf16_t*)RB_CQ, (bf16_t*)RB_CKV, (bf16_t*)RB_KR, (float*)(ws + WS_SSQQ)};
        pg8::gemm_phase<pg8::EpiIn, pg8::LdsOrder, true, true>(L, g, S, E, wid0); }
    MK_STAMP(2 * (P + 0) + 1);
    if (MK_IN_(P + 0) && MK_IN_(P + 1)) { MK_PLACE(); if (!(pl.nloc == 32 && pl.nx == 8)) { MK_BAR(); if (__builtin_amdgcn_readfirstlane((int)MISC[15]) != 0) xcd_local_barrier(bar.bar, bar.st, wid0); else xcd_barrier(bar, wid0); } }
    if (MK_IN_(P + 1)) { MK_STAMP(2 * (P + 1));
        { MK_PTRS(); MK_PLACE(); pg8::Gemm g{(bf16_t*)RB_CQ, (const bf16_t*)(ws + WS_W + (size_t)l * WL_STRIDE + WL_UQ), T, 768, QR, QR};
          pg8::FusedUqOrder SF; SF.init(pl); pg8::XcdOrder<3> S0; S0.init(pl); const pg8::LdsOrder S = SF.ok ? pg8::fill_order(MK_TAB, SF, wid0) : pg8::fill_order(MK_TAB, S0, wid0);
          pg8::EpiUp<false> E{(float*)(ws + WS_SSQQ), (float*)(ws + WS_ROPE), (bf16_t*)RB_Q, nullptr, nullptr};
          pg8::gemm_phase<pg8::EpiUp<false>, pg8::LdsOrder, true, true>(L, g, S, E, wid0); }
        { MK_PTRS(); MK_PLACE(); pg8::Gemm g{(bf16_t*)RB_CKV, (const bf16_t*)(ws + WS_W + (size_t)l * WL_STRIDE + WL_UKV), T, 1024, KVR, KVR};
          pg8::FusedUkvOrder SF; SF.init(pl); pg8::XcdKvOrder S0; S0.init(pl); const pg8::LdsOrder S = SF.ok ? pg8::fill_order(MK_TAB, SF, wid0) : pg8::fill_order(MK_TAB, S0, wid0);
          pg8::EpiUp<true> E{(float*)(ws + WS_SSQQ), nullptr, nullptr, (bf16_t*)RB_KN, (bf16_t*)RB_V};
          pg8::gemm_phase<pg8::EpiUp<true>, pg8::LdsOrder, true, true>(L, g, S, E, wid0); }
        MK_STAMP(2 * (P + 1) + 1); }
    MK_SEAM_L(P + 1);
    if (MK_IN_(P + 2)) { MK_STAMP(2 * (P + 2)); MK_PTRS(); MK_PLACE();
        gm::gmlp_phase(L, wid0, pl, (bf16_t*)RB_U, (bf16_t*)RB_VN, (bf16_t*)(ws + WS_GW) + (size_t)l * NGRP * CHUNK * CHUNK, INP(8) + l * NGRP * CHUNK, INP(13) + l * DG, (bf16_t*)out, (float*)(ws + WS_SSQY)); }
    MK_STAMP(2 * (P + 2) + 1);
    if (MK_IN_(P + 3)) { MK_STAMP(2 * (P + 3)); MK_PTRS(); MK_PLACE();
        att::attn_phase((LAS char*)L, wid0, pl, (bf16_t*)RB_Q, (bf16_t*)RB_KN, (bf16_t*)RB_KR, (bf16_t*)RB_V, INP(14) + l * DG, (bf16_t*)out, (float*)(ws + WS_SSQY)); }
    MK_STAMP(2 * (P + 3) + 1); MK_SEAM_L(P + 3);
    if (MK_IN_(P + 4)) { MK_STAMP(2 * (P + 4)); MK_PTRS(); MK_PLACE();
        pg8::Gemm g{(const bf16_t*)out, (const bf16_t*)(ws + WS_W + (size_t)l * WL_STRIDE + WL_OUT), T, DM, DM, YLD};   pg8::XcdOrder<4> S0; S0.init(pl); const pg8::LdsOrder S = pg8::fill_order(MK_TAB, S0, wid0);
        pg8::EpiRes<true, l == 0> E{(float*)(ws + WS_SSQY), l == 0 ? (const void*)INP(0) : (const void*)out, (bf16_t*)out, (float*)(ws + WS_MOD) + (size_t)l * NB * NMOD + 2 * DM, (float*)(ws + WS_GM2) + (size_t)l * NB * DM, (bf16_t*)(ws + WS_A), (float*)(ws + WS_SSQ2)};
        pg8::gemm_phase<pg8::EpiRes<true, l == 0>, pg8::LdsOrder, true, true>(L, g, S, E, wid0); }
    MK_STAMP(2 * (P + 4) + 1); MK_SEAM_L(P + 4);
    if (MK_IN_(P + 5)) { MK_STAMP(2 * (P + 5)); MK_PTRS(); MK_PLACE();
        pg8::Gemm g{(bf16_t*)(ws + WS_A), (const bf16_t*)(ws + WS_W + (size_t)l * WL_STRIDE + WL_1), T, DFF, DM, DM}; pg8::XcdOrder<16> S0; S0.init(pl); const pg8::LdsOrder S = pg8::fill_order(MK_TAB, S0, wid0);
        pg8::EpiFf1 E{(float*)(ws + WS_SSQ2), (float*)(ws + WS_SHW2) + (size_t)l * NB * DFF, (bf16_t*)RB_H};
        pg8::gemm_phase<pg8::EpiFf1, pg8::LdsOrder, true, true>(L, g, S, E, wid0); }
    MK_STAMP(2 * (P + 5) + 1); MK_SEAM_L(P + 5);
    if (MK_IN_(P + 6)) { MK_STAMP(2 * (P + 6)); MK_PTRS(); MK_PLACE();
        pg8::Gemm g{(bf16_t*)RB_H, (const bf16_t*)(ws + WS_W + (size_t)l * WL_STRIDE + WL_2), T, DM, DFF, DFF}; pg8::XcdOrder<4> S0; S0.init(pl); const pg8::LdsOrder S = pg8::fill_order(MK_TAB, S0, wid0);
        pg8::EpiRes<false, false> E{nullptr, (const void*)out, (bf16_t*)out, (float*)(ws + WS_MOD) + (size_t)l * NB * NMOD + 5 * DM, (l + 1 < DEPTH) ? (float*)(ws + WS_GM1) + (size_t)(l + 1) * NB * DM : nullptr, (bf16_t*)(ws + WS_A), (float*)(ws + WS_SSQ1)};
        pg8::gemm_phase<pg8::EpiRes<false, false>, pg8::LdsOrder, true, true>(L, g, S, E, wid0); }
    MK_STAMP(2 * (P + 6) + 1); MK_SEAM_L(P + 6);
}
__global__ void __launch_bounds__(NWAVES * 64, 2) mk_fwd(Args args) {
    extern __shared__ __attribute__((aligned(16))) unsigned char lds[];
    LAS unsigned char* L = (LAS unsigned char*)lds;
    volatile LAS unsigned* MISC = (volatile LAS unsigned*)(L + MISC_OFF);
    const int wid0 = __builtin_amdgcn_readfirstlane((int)threadIdx.x >> 6);
    const int G = gridDim.x, bx = blockIdx.x;
    { const int t0 = wid0 * 64 + lane_id(); for (int u = t0; u < (LDS_BYTES - LDSCTL_OFF) / 4; u += NWAVES * 64) ((LAS unsigned*)(L + LDSCTL_OFF))[u] = 0u; }
    __syncthreads();
    const int lo = __builtin_amdgcn_readfirstlane(args.ph_lo), hi = __builtin_amdgcn_readfirstlane(args.ph_hi);
    unsigned* barw = (unsigned*)(args.ws + WS_CTL) + CW_BAR + __builtin_amdgcn_readfirstlane(args.li) * XCD_BAR_WORDS;
    placement_init(barw, MISC + 8, wid0);
    if (MK_IN_(PH_P0A)) { MK_STAMP(2 * (PH_P0A)); MK_PTRS(); MK_PLACE(); pro::phase0a(L, wid0, pl.jx * pl.nloc + pl.rank, G, args, zi, ws); }
    MK_STAMP(2 * PH_P0A + 1); MK_SEAM(PH_P0A);
    if (MK_IN_(PH_P0B)) { MK_STAMP(2 * (PH_P0B)); MK_PTRS(); MK_PLACE(); pro::phase0b(L, wid0, pl.jx * pl.nloc + pl.rank, G, args, zi, ws); }
    MK_STAMP(2 * PH_P0B + 1); MK_SEAM(PH_P0B);
    layer_phases<0>(args, L, MISC, wid0, lo, hi);
    layer_phases<1>(args, L, MISC, wid0, lo, hi);
    if (MK_IN_(PH_FINAL)) { MK_STAMP(2 * (PH_FINAL)); MK_PTRS(); MK_PLACE(); pro::phase_final(wid0, pl, INP(19), (const bf16_t*)out, out); }
    MK_STAMP(2 * PH_FINAL + 1);
#ifdef PROBE_SEL
    if (bx == 0 && wid0 == 0 && lane_id() == 0) {
        volatile LAS unsigned long long* st = (volatile LAS unsigned long long*)(L + LDSCTL_OFF + 1024); unsigned long long sel = 0;
        if (PROBE_SEL >= 0) sel = st[2 * PROBE_SEL + 1] - st[2 * PROBE_SEL];
        else { for (int k = 0; k < PH_FINAL; ++k) if (k != PH_L0 + 2 && k != PH_L0 + PH_PER_LAYER + 2) { int nx = k + 1; sel += st[2 * nx] - st[2 * k + 1]; } }
        const unsigned long long t0 = __builtin_amdgcn_s_memrealtime(), t1 = t0 + PROBE_MULT * sel;
        while (__builtin_amdgcn_s_memrealtime() < t1) __builtin_amdgcn_s_sleep(8);
    }
#endif
}

#ifndef ONE_LAUNCH
#define ONE_LAUNCH 1
#endif
#ifndef MK_PRO
#define MK_PRO 1
#endif
#ifndef MK_IN
#define MK_IN 1
#endif
#ifndef MK_UP
#define MK_UP 1
#endif
#ifndef MK_GMLP
#define MK_GMLP 1
#endif
#ifndef MK_ATTN
#define MK_ATTN 1
#endif
#ifndef MK_OUT
#define MK_OUT 1
#endif
#ifndef MK_FF1
#define MK_FF1 1
#endif
#ifndef MK_FF2
#define MK_FF2 1
#endif
template <class Epi> static void gemm_naive(hipStream_t st, const bf16_t* A, int lda, const bf16_t* Bt, int ldb, int M, int N, int K, const Epi& e) {
    hipLaunchKernelGGL((k_gemm_naive<Epi>), dim3(N / 64, M / 64), dim3(256), 0, st, A, lda, Bt, ldb, K, e);
}
static int g_grid = 0;
static void launch_mk(hipStream_t st, Args a, int lo, int hi, int li = 0, int flags = 0) {
    a.ph_lo = lo; a.ph_hi = hi; a.li = li; a.flags = flags;
    hipLaunchKernelGGL(mk_fwd, dim3(g_grid), dim3(NWAVES * 64), LDS_BYTES, st, a);
}
extern "C" void kernel_launch(void* const* d_in, const int* in_sizes, int n_in, void* d_out, int out_size, void* d_ws, size_t ws_size, hipStream_t stream) {
    if (n_in != 20 || out_size != T * DM || ws_size < WS_END) { fprintf(stderr, "kernel_launch: unexpected sizes n_in %d out %d ws %zu\n", n_in, out_size, ws_size); return; }
    if (g_grid == 0) {
        int dev = 0, cus = 0; hipGetDevice(&dev); hipDeviceGetAttribute(&cus, hipDeviceAttributeMultiprocessorCount, dev);
        if (hipFuncSetAttribute((const void*)mk_fwd, hipFuncAttributeMaxDynamicSharedMemorySize, LDS_BYTES) != hipSuccess) fprintf(stderr, "kernel_launch: hipFuncSetAttribute failed\n");
        g_grid = cus > 0 ? cus : 256;
    }
    const float* x = (const float*)d_in[0]; const float* c = (const float*)d_in[1]; const int* pos = (const int*)d_in[2];
    const float* w_ada = (const float*)d_in[3]; const float* b_ada = (const float*)d_in[4]; const float* g_mix = (const float*)d_in[5];
    const float* w_in = (const float*)d_in[6]; const float* g_ws = (const float*)d_in[7]; const float* g_bs = (const float*)d_in[8];
    const float* g_q = (const float*)d_in[9]; const float* g_kv = (const float*)d_in[10]; const float* w_uq = (const float*)d_in[11]; const float* w_ukv = (const float*)d_in[12];
    const float* g_og = (const float*)d_in[13]; const float* g_oa = (const float*)d_in[14]; const float* w_out = (const float*)d_in[15];
    const float* g_ffn = (const float*)d_in[16]; const float* w_ff1 = (const float*)d_in[17]; const float* w_ff2 = (const float*)d_in[18]; const float* g_fin = (const float*)d_in[19];
    unsigned char* ws = (unsigned char*)d_ws; float* out = (float*)d_out;
    float* MOD = (float*)(ws + WS_MOD); float* SHW1 = (float*)(ws + WS_SHW1); float* SHW2 = (float*)(ws + WS_SHW2); float* RT = (float*)(ws + WS_ROPE);
    float* GM1 = (float*)(ws + WS_GM1); float* GM2 = (float*)(ws + WS_GM2);
    float* SSQ1 = (float*)(ws + WS_SSQ1); float* SSQ2 = (float*)(ws + WS_SSQ2); float* SSQY = (float*)(ws + WS_SSQY); float* SSQQ = (float*)(ws + WS_SSQQ);
    bf16_t* GW = (bf16_t*)(ws + WS_GW); bf16_t* A = (bf16_t*)(ws + WS_A); bf16_t* U = (bf16_t*)(ws + WS_U); bf16_t* VN = (bf16_t*)(ws + WS_VN);
    bf16_t* CQKV = (bf16_t*)(ws + WS_CQKV); bf16_t* KR = (bf16_t*)(ws + WS_KR); bf16_t* Q = (bf16_t*)(ws + WS_Q); bf16_t* KN = (bf16_t*)(ws + WS_KN); bf16_t* V = (bf16_t*)(ws + WS_V);
    bf16_t* Y = (bf16_t*)(ws + WS_Y); bf16_t* H = (bf16_t*)(ws + WS_H); float* GV = (float*)(ws + WS_GV); float* ZL = (float*)(ws + WS_ZL); float* QRT = (float*)(ws + WS_QRT);
    auto WL = [&](int l, size_t off) { return (bf16_t*)(ws + WS_W + (size_t)l * WL_STRIDE + off); };
    Args a{}; for (int i = 0; i < 20; ++i) a.in[i] = d_in[i]; a.out = out; a.ws = ws;
    hipMemsetAsync(ws + WS_CTL, 0, CTL_ZERO_BYTES, stream);

#if ONE_LAUNCH
#ifdef PROBE_DUP
    launch_mk(stream, a, 0, PROBE_DUP + 1, 0); launch_mk(stream, a, PROBE_DUP, PROBE_DUP + 1, 1); launch_mk(stream, a, PROBE_DUP + 1, PH_END, 2);
#elif defined(PROBE_FFN2)
    launch_mk(stream, a, 0, PH_FINAL, 0); launch_mk(stream, a, PH_FINAL - 1, PH_FINAL, 1, 1); launch_mk(stream, a, PH_FINAL, PH_END, 2);
#elif defined(PROBE_FINAL)
    launch_mk(stream, a, 0, PH_FINAL, 0); launch_mk(stream, a, PH_FINAL, PH_END, 1, 2); launch_mk(stream, a, PH_FINAL, PH_END, 2);
#else
    launch_mk(stream, a, 0, PH_END);
#endif
    return;
#endif
#if MK_PRO
    launch_mk(stream, a, PH_P0A, PH_P0A + 1);
    launch_mk(stream, a, PH_P0B, PH_P0B + 1);
#else
    hipLaunchKernelGGL(k_rope_table, dim3(T * 16 / 256), dim3(256), 0, stream, pos, RT);
    hipLaunchKernelGGL(k_prep_gw, dim3(DEPTH * NGRP * CHUNK * CHUNK / 256), dim3(256), 0, stream, g_ws, GW);
    for (int l = 0; l < DEPTH; ++l) {
        hipLaunchKernelGGL(k_prep_w, dim3((NIN * DM + 255) / 256), dim3(256), 0, stream, w_in + (size_t)l * DM * DIN, DM, DIN, WL(l, WL_IN), NIN, 1);
        hipLaunchKernelGGL(k_prep_wup, dim3((NUP * KUP + 255) / 256), dim3(256), 0, stream, w_uq + (size_t)l * QR * 768, w_ukv + (size_t)l * KVR * 1024, WL(l, WL_UP));
        hipLaunchKernelGGL(k_prep_w, dim3(DM * DM / 256), dim3(256), 0, stream, w_out + (size_t)l * DM * DM, DM, DM, WL(l, WL_OUT), DM, 0);
        hipLaunchKernelGGL(k_prep_w, dim3(DFF * DM / 256), dim3(256), 0, stream, w_ff1 + (size_t)l * DM * DFF, DM, DFF, WL(l, WL_1), DFF, 0);
        hipLaunchKernelGGL(k_prep_w, dim3(DFF * DM / 256), dim3(256), 0, stream, w_ff2 + (size_t)l * DFF * DM, DFF, DM, WL(l, WL_2), DM, 0);
        hipLaunchKernelGGL(k_smallm, dim3(NMOD / 64), dim3(512), 0, stream, c, DM, 1, w_ada + (size_t)l * DM * NMOD, NMOD, NMOD, 0, b_ada + (size_t)l * NMOD, MOD + (size_t)l * NB * NMOD, NMOD, NMOD);
    }
    for (int l = 0; l < DEPTH; ++l) {
        hipLaunchKernelGGL(k_smallm, dim3(NIN / 64), dim3(512), 0, stream, MOD + (size_t)l * NB * NMOD + 0, NMOD, 0, w_in + (size_t)l * DM * DIN, DIN, DIN, 1, (const float*)nullptr, SHW1 + (size_t)l * NB * NIN, NIN, NIN);
        hipLaunchKernelGGL(k_smallm, dim3(DFF / 64), dim3(512), 0, stream, MOD + (size_t)l * NB * NMOD + 3 * DM, NMOD, 0, w_ff1 + (size_t)l * DM * DFF, DFF, DFF, 0, (const float*)nullptr, SHW2 + (size_t)l * NB * DFF, DFF, DFF);
    }
    hipLaunchKernelGGL(k_gm, dim3(DEPTH * NB * DM / 256), dim3(256), 0, stream, g_mix, MOD, 1, GM1);
    hipLaunchKernelGGL(k_gm, dim3(DEPTH * NB * DM / 256), dim3(256), 0, stream, g_ffn, MOD, 4, GM2);
    hipLaunchKernelGGL(k_modx, dim3(T / 4), dim3(256), 0, stream, x, g_mix, MOD + 1 * DM, NMOD, A, SSQ1);

#endif
    for (int l = 0; l < DEPTH; ++l) {
        const float* modl = MOD + (size_t)l * NB * NMOD; const int P = PH_L0 + l * PH_PER_LAYER;
#if MK_IN
        launch_mk(stream, a, P + 0, P + 1);
#else
        { EpiInNaive e{0, SSQ1, SHW1 + (size_t)l * NB * NIN, U, GV, ZL}; gemm_naive(stream, A, DM, WL(l, WL_IN), DM, T, NIN, DM, e); }
        hipLaunchKernelGGL(k_vn, dim3(T * NGRP / 4), dim3(256), 0, stream, GV, VN);
        hipLaunchKernelGGL(k_lat, dim3(T / 4), dim3(256), 0, stream, ZL, g_q + l * QR, g_kv + l * KVR, RT, CQKV, SSQQ, KR);
#endif
#if MK_UP
        launch_mk(stream, a, P + 1, P + 2);
#else
        { EpiUpNaive e{0, SSQQ, Q, QRT, KN, V}; gemm_naive(stream, CQKV, KUP, WL(l, WL_UP), KUP, T, NUP, KUP, e); }
        hipLaunchKernelGGL(k_rope_q, dim3(T * NH * 16 / 256), dim3(256), 0, stream, QRT, RT, Q);
#endif
#if MK_GMLP
        launch_mk(stream, a, P + 2, P + 3);
#else
        hipLaunchKernelGGL(k_gmlp_naive, dim3(T), dim3(512), 0, stream, U, VN, GW + (size_t)l * NGRP * CHUNK * CHUNK, g_bs + l * NGRP * CHUNK, g_og + l * DG, Y, SSQY);
#endif
#if MK_ATTN
        launch_mk(stream, a, P + 3, P + 4);
#else
        hipLaunchKernelGGL(k_attn_naive, dim3(T / 64, NH), dim3(64), 0, stream, Q, KN, KR, V, g_oa + l * DG, Y, SSQY);
#endif
#if MK_OUT
        launch_mk(stream, a, P + 4, P + 5);
#else
        { EpiOutNaive e{512, SSQY, l == 0 ? x : out, out, modl + 2 * DM}; gemm_naive(stream, Y, DM, WL(l, WL_OUT), DM, T, DM, DM, e); }
        hipLaunchKernelGGL(k_modx, dim3(T / 4), dim3(256), 0, stream, out, g_ffn + l * DM, modl + 4 * DM, NMOD, A, SSQ2);
#endif
#if MK_FF1
        launch_mk(stream, a, P + 5, P + 6);
#else
        { EpiFf1Naive e{0, SSQ2, SHW2 + (size_t)l * NB * DFF, H}; gemm_naive(stream, A, DM, WL(l, WL_1), DM, T, DFF, DM, e); }
#endif
#if MK_FF2
        launch_mk(stream, a, P + 6, P + 7);
#else
        { EpiFf2Naive e{0, out, modl + 5 * DM}; gemm_naive(stream, H, DFF, WL(l, WL_2), DFF, T, DM, DFF, e); }
        if (l + 1 < DEPTH) hipLaunchKernelGGL(k_modx, dim3(T / 4), dim3(256), 0, stream, out, g_mix + (l + 1) * DM, MOD + (size_t)(l + 1) * NB * NMOD + 1 * DM, NMOD, A, SSQ1);
#endif
    }
#if MK_PRO
    launch_mk(stream, a, PH_FINAL, PH_FINAL + 1);
#else
    hipLaunchKernelGGL(k_final, dim3(T / 4), dim3(256), 0, stream, out, g_fin, out);
#endif
}
```

```cpp
#include <hip/hip_runtime.h>
#define PROBE_MULT 8
#include <cstdint>
#include <cstdio>
#include <cmath>

typedef unsigned short bf16_t;
typedef short bf16x8 __attribute__((ext_vector_type(8)));
typedef float f32x4 __attribute__((ext_vector_type(4)));

constexpr int DM = 1024, NB = 16, SEQ = 2048, DEPTH = 2, T = NB * SEQ;
constexpr int DG = 512, NGRP = 8, GD = 64, CHUNK = 128, NH = 8, NOPE = 64, ROPE = 32, VD = 64;
constexpr int QR = 256, KVR = 128, DFF = 4096, DIN = 1440, NMOD = 6 * DM;
constexpr int NIN = 1536;
constexpr int NUP = 1792, KUP = 384;
constexpr float EPS = 1e-6f;
constexpr int YLD = 2 * DM;
constexpr float QSCALE = 0.10206207261596577f * 1.4426950408889634f;

constexpr size_t MiB = 1u << 20;
constexpr size_t WS_CTL = 0;
constexpr size_t WS_MOD = 1 * MiB;
constexpr size_t WS_SHW1 = 2 * MiB;
constexpr size_t WS_GM1 = 2 * MiB + 512 * 1024;
constexpr size_t WS_GM2 = 2 * MiB + 768 * 1024;
constexpr size_t WS_SHW2 = 3 * MiB;
constexpr size_t WS_ROPE = 4 * MiB;
constexpr size_t WS_SSQ1 = 8 * MiB;
constexpr size_t WS_SSQ2 = 10 * MiB;
constexpr size_t WS_SSQY = 12 * MiB;
constexpr size_t WS_SSQQ = 14 * MiB;
constexpr size_t WS_GW = 15 * MiB;
constexpr size_t WS_W = 16 * MiB;
constexpr size_t WL_IN = 0, WL_UP = 3 * MiB, WL_OUT = 4 * MiB + MiB / 2, WL_1 = 6 * MiB + MiB / 2, WL_2 = 14 * MiB + MiB / 2, WL_STRIDE = 22 * MiB + MiB / 2;
constexpr size_t WS_A = 64 * MiB;
constexpr size_t WS_U = 128 * MiB;
constexpr size_t WS_VN = 160 * MiB;
constexpr size_t WS_CQKV = 192 * MiB;
constexpr size_t WS_CQ = 192 * MiB;
constexpr size_t WS_CKV = 208 * MiB;
constexpr size_t WL_UQ = 3 * MiB, WL_UKV = 3 * MiB + MiB / 2;
constexpr size_t WS_KR = 216 * MiB;
constexpr size_t WS_Q = 218 * MiB;
constexpr size_t WS_KN = 266 * MiB;
constexpr size_t WS_V = 298 * MiB;
constexpr size_t WS_Y = 330 * MiB;
constexpr size_t WS_H = 128 * MiB;
constexpr size_t WS_GV = 394 * MiB;
constexpr size_t WS_ZL = 458 * MiB;
constexpr size_t WS_QRT = 394 * MiB;
constexpr size_t WS_DUMMY = 448 * MiB;
constexpr size_t WS_END = 512 * MiB;

__device__ __forceinline__ bf16_t f2bf(float f) { unsigned u = __float_as_uint(f); return (bf16_t)((u + 0x7fffu + ((u >> 16) & 1u)) >> 16); }
__device__ __forceinline__ float bf2f(bf16_t h) { return __uint_as_float(((unsigned)h) << 16); }
__device__ __forceinline__ float gelu_tanh(float x) { const float y2 = -2.302208198f * (x + 0.044715f * x * x * x); return x * __builtin_amdgcn_rcpf(1.f + __builtin_amdgcn_exp2f(y2)); }
__device__ __forceinline__ float wave_sum(float v) {
#pragma unroll
    for (int o = 1; o < 64; o <<= 1) v += __shfl_xor(v, o);
    return v;
}
__host__ __device__ __forceinline__ int win_src(int p) {
    if (p < 512) return p;
    if (p < 1024) { const int q = p - 512, tile = q >> 8, r = q & 255, bj = r >> 7, wc = (r >> 5) & 3, j = r & 31; return 512 + tile * 256 + 64 * wc + 32 * bj + j; }
    if (p < 1408) return p;
    if (p < 1440) { const int j = p - 1408, fq = j >> 3, n = (j >> 2) & 1, i = j & 3; return 1408 + 16 * n + 4 * fq + i; }
    return -1;
}
__host__ __device__ __forceinline__ int wup_qcol(int p) {
    const int G = p >> 5, h = G / 3, gi = G - 3 * h, j = p & 31;
    if (gi < 2) return p;
    const int fq = j >> 3, n = (j >> 2) & 1, i = j & 3; return h * 96 + 64 + 16 * n + 4 * fq + i;
}

__global__ void k_rope_table(const int* pos, float* rope) {
    const int idx = blockIdx.x * blockDim.x + threadIdx.x; if (idx >= T * 16) return;
    const int t = idx >> 4, i = idx & 15;
    const float freq = powf(10000.0f, -(float)(2 * i) / 32.0f);
    const float ang = (float)pos[t] * freq;
    rope[t * 32 + i] = cosf(ang); rope[t * 32 + 16 + i] = sinf(ang);
}
__global__ void k_prep_w(const float* W, int K, int N, bf16_t* out, int Nphys, int mode) {
    const size_t idx = (size_t)blockIdx.x * blockDim.x + threadIdx.x; if (idx >= (size_t)Nphys * K) return;
    const int p = (int)(idx / K), k = (int)(idx % K);
    const int s = mode == 1 ? win_src(p) : p;
    out[idx] = (s >= 0 && s < N) ? f2bf(W[(size_t)k * N + s]) : (bf16_t)0;
}
__global__ void k_prep_wup(const float* wuq, const float* wukv, bf16_t* out) {
    const int idx = blockIdx.x * blockDim.x + threadIdx.x; if (idx >= NUP * KUP) return;
    const int p = idx / KUP, k = idx % KUP; float v = 0.f;
    if (p < 768) { if (k < 256) v = wuq[(size_t)k * 768 + wup_qcol(p)]; }
    else { if (k >= 256) v = wukv[(size_t)(k - 256) * 1024 + (p - 768)]; }
    out[idx] = f2bf(v);
}
__global__ void k_prep_gw(const float* ws, bf16_t* gw) {
    const int idx = blockIdx.x * blockDim.x + threadIdx.x; if (idx >= DEPTH * NGRP * CHUNK * CHUNK) return;
    const int s = idx & 127, t = (idx >> 7) & 127;
    gw[idx] = (s <= t) ? f2bf(ws[idx]) : (bf16_t)0;
}
__global__ __launch_bounds__(512) void k_smallm(const float* in, int in_stride, int act, const float* W, int ldw, int N, int mode, const float* bias, float* out, int out_stride, int Nphys) {
    __shared__ float sin_[1024 * 16];
    __shared__ float red[8 * 64 * 16];
    const int tid = threadIdx.x, lane = tid & 63, wave = tid >> 6;
    for (int e = tid; e < 16 * 1024; e += 512) { const int b = e >> 10, k = e & 1023; float v = in[(size_t)b * in_stride + k]; if (act) v = v / (1.f + __expf(-v)); sin_[k * 16 + b] = v; }
    __syncthreads();
    const int p = blockIdx.x * 64 + lane; const int s = (p < Nphys) ? (mode == 1 ? win_src(p) : p) : -1; const bool ok = (s >= 0 && s < N);
    float acc[16];
#pragma unroll
    for (int b = 0; b < 16; ++b) acc[b] = 0.f;
    for (int k = wave * 128; k < wave * 128 + 128; ++k) {
        const float w = ok ? W[(size_t)k * ldw + s] : 0.f;
        const f32x4* sp = (const f32x4*)(sin_ + k * 16);
#pragma unroll
        for (int q = 0; q < 4; ++q) { const f32x4 v = sp[q]; acc[4 * q] += v[0] * w; acc[4 * q + 1] += v[1] * w; acc[4 * q + 2] += v[2] * w; acc[4 * q + 3] += v[3] * w; }
    }
#pragma unroll
    for (int b = 0; b < 16; ++b) red[(wave * 64 + lane) * 16 + b] = acc[b];
    __syncthreads();
    for (int e = tid; e < 64 * 16; e += 512) { const int l = e >> 4, b = e & 15; float sum = 0.f;
#pragma unroll
        for (int w = 0; w < 8; ++w) sum += red[(w * 64 + l) * 16 + b];
        const int pp = blockIdx.x * 64 + l; if (pp < Nphys) out[(size_t)b * out_stride + pp] = sum + (bias ? bias[pp] : 0.f); }
}
__global__ __launch_bounds__(256) void k_modx(const float* x, const float* g, const float* sc  , int sc_stride, bf16_t* A, float* ssq) {
    const int row = blockIdx.x * 4 + (threadIdx.x >> 6), lane = threadIdx.x & 63; if (row >= T) return;
    const int b = row / SEQ; const f32x4* xr = (const f32x4*)(x + (size_t)row * DM); float s = 0.f;
#pragma unroll
    for (int j = 0; j < 4; ++j) { const f32x4 v = xr[lane + 64 * j]; s += v[0] * v[0] + v[1] * v[1] + v[2] * v[2] + v[3] * v[3];
        const int c = 4 * (lane + 64 * j); const f32x4 gv = *(const f32x4*)(g + c), sv = *(const f32x4*)(sc + (size_t)b * sc_stride + c);
        unsigned lo = f2bf(v[0] * gv[0] * (1.f + sv[0])) | ((unsigned)f2bf(v[1] * gv[1] * (1.f + sv[1])) << 16);
        unsigned hi = f2bf(v[2] * gv[2] * (1.f + sv[2])) | ((unsigned)f2bf(v[3] * gv[3] * (1.f + sv[3])) << 16);
        *(uint2*)(A + (size_t)row * DM + c) = make_uint2(lo, hi); }
    s = wave_sum(s);
    if (lane < 16) ssq[(size_t)row * 16 + lane] = (lane == 0) ? s : 0.f;
}
__global__ __launch_bounds__(256) void k_final(const float* x, const float* g, float* out) {
    const int row = blockIdx.x * 4 + (threadIdx.x >> 6), lane = threadIdx.x & 63; if (row >= T) return;
    const f32x4* xr = (const f32x4*)(x + (size_t)row * DM); f32x4 v[4]; float s = 0.f;
#pragma unroll
    for (int j = 0; j < 4; ++j) { v[j] = xr[lane + 64 * j]; s += v[j][0] * v[j][0] + v[j][1] * v[j][1] + v[j][2] * v[j][2] + v[j][3] * v[j][3]; }
    const float rstd = rsqrtf(wave_sum(s) * (1.f / DM) + EPS);
#pragma unroll
    for (int j = 0; j < 4; ++j) { const int c = 4 * (lane + 64 * j); const f32x4 gv = *(const f32x4*)(g + c); *(f32x4*)(out + (size_t)row * DM + c) = v[j] * rstd * gv; }
}

template <class Epi>
__global__ __launch_bounds__(256) void k_gemm_naive(const bf16_t* A, int lda, const bf16_t* Bt, int ldb, int K, Epi epi) {
    const int wave = threadIdx.x >> 6, lane = threadIdx.x & 63, fr = lane & 15, fq = lane >> 4;
    const int row0 = blockIdx.y * 64 + wave * 16, col0 = blockIdx.x * 64;
    f32x4 acc[4];
#pragma unroll
    for (int n = 0; n < 4; ++n) acc[n] = (f32x4){0.f, 0.f, 0.f, 0.f};
    const bf16_t* ap = A + (size_t)(row0 + fr) * lda + 8 * fq;
    const bf16_t* bp = Bt + (size_t)(col0 + fr) * ldb + 8 * fq;
    for (int k0 = 0; k0 < K; k0 += 32) {
        if (Epi::HAS_MID) { if (k0 == epi.ksplit) {
#pragma unroll
            for (int r = 0; r < 4; ++r) { const float m = epi.mid(row0 + 4 * fq + r);
#pragma unroll
                for (int n = 0; n < 4; ++n) acc[n][r] *= m; } } }
        const bf16x8 a = *(const bf16x8*)(ap + k0);
#pragma unroll
        for (int n = 0; n < 4; ++n) { const bf16x8 b = *(const bf16x8*)(bp + (size_t)n * 16 * ldb + k0); acc[n] = __builtin_amdgcn_mfma_f32_16x16x32_bf16(a, b, acc[n], 0, 0, 0); }
    }
#pragma unroll
    for (int r = 0; r < 4; ++r) { const int row = row0 + 4 * fq + r; const float rs = epi.rowscale(row);
#pragma unroll
        for (int n = 0; n < 4; ++n) epi(row, col0 + 16 * n + fr, acc[n][r], rs); }
}
__device__ __forceinline__ float sum16(const float* p) { float s = 0.f;
#pragma unroll
    for (int i = 0; i < 16; ++i) s += p[i]; return s; }
__device__ __forceinline__ float sum8(const float* p) { float s = 0.f;
#pragma unroll
    for (int i = 0; i < 8; ++i) s += p[i]; return s; }
__device__ __forceinline__ float sum4(const float* p) { return (p[0] + p[1]) + (p[2] + p[3]); }

struct EpiInNaive {
    static constexpr bool HAS_MID = false; int ksplit;
    const float* ssq1; const float* shw1; bf16_t* U; float* GV; float* ZL;
    __device__ float mid(int) const { return 1.f; }
    __device__ float rowscale(int row) const { return rsqrtf(sum16(ssq1 + (size_t)row * 16) * (1.f / DM) + EPS); }
    __device__ void operator()(int row, int p, float acc, float rs) const {
        const int L = win_src(p); if (L < 0) return;
        const float z = rs * acc + shw1[(row / SEQ) * NIN + p];
        if (L < 512) U[(size_t)row * 512 + L] = f2bf(gelu_tanh(z));
        else if (L < 1024) GV[(size_t)row * 512 + (L - 512)] = gelu_tanh(z);
        else ZL[(size_t)row * 416 + (L - 1024)] = z;
    }
};
struct EpiUpNaive {
    static constexpr bool HAS_MID = false; int ksplit;
    const float* ssqq; bf16_t* Q; float* QRT; bf16_t* KN; bf16_t* V;
    __device__ float mid(int) const { return 1.f; }
    __device__ float rowscale(int) const { return 1.f; }
    __device__ void operator()(int row, int p, float acc, float) const {
        if (p < 768) { const float rq = rsqrtf(sum4(ssqq + (size_t)row * 8) * (1.f / QR) + EPS); const float v = acc * rq * QSCALE;
            const int L = wup_qcol(p), h = L / 96, d = L - 96 * h;
            if (d < 64) Q[(size_t)row * 768 + L] = f2bf(v); else QRT[(size_t)row * 256 + h * 32 + (d - 64)] = v; }
        else { const float rk = rsqrtf(sum4(ssqq + (size_t)row * 8 + 4) * (1.f / KVR) + EPS); const float v = acc * rk;
            const int c = p - 768, h = c >> 7, d = c & 127;
            if (d < 64) KN[(size_t)row * 512 + h * 64 + d] = f2bf(v); else V[(size_t)row * 512 + h * 64 + (d - 64)] = f2bf(v); }
    }
};
struct EpiOutNaive {
    static constexpr bool HAS_MID = true; int ksplit;
    const float* ssqy; const float* xin; float* xout; const float* gate;
    __device__ float rg(int row) const { return rsqrtf(sum8(ssqy + (size_t)row * 16) * (1.f / 512) + EPS); }
    __device__ float ra(int row) const { return rsqrtf(sum8(ssqy + (size_t)row * 16 + 8) * (1.f / 512) + EPS); }
    __device__ float mid(int row) const { return rg(row) / ra(row); }
    __device__ float rowscale(int row) const { return ra(row); }
    __device__ void operator()(int row, int n, float acc, float rs) const {
        const size_t i = (size_t)row * DM + n; xout[i] = xin[i] + gate[(size_t)(row / SEQ) * NMOD + n] * (rs * acc);
    }
};
struct EpiFf1Naive {
    static constexpr bool HAS_MID = false; int ksplit;
    const float* ssq2; const float* shw2; bf16_t* H;
    __device__ float mid(int) const { return 1.f; }
    __device__ float rowscale(int row) const { return rsqrtf(sum16(ssq2 + (size_t)row * 16) * (1.f / DM) + EPS); }
    __device__ void operator()(int row, int n, float acc, float rs) const {
        const float z = rs * acc + shw2[(row / SEQ) * DFF + n]; const float r = fmaxf(z, 0.f); H[(size_t)row * DFF + n] = f2bf(r * r);
    }
};
struct EpiFf2Naive {
    static constexpr bool HAS_MID = false; int ksplit;
    float* x; const float* gate;
    __device__ float mid(int) const { return 1.f; }
    __device__ float rowscale(int) const { return 1.f; }
    __device__ void operator()(int row, int n, float acc, float) const {
        const size_t i = (size_t)row * DM + n; x[i] = x[i] + gate[(size_t)(row / SEQ) * NMOD + n] * acc;
    }
};

__global__ __launch_bounds__(256) void k_vn(const float* GV, bf16_t* VN) {
    const int w = blockIdx.x * 4 + (threadIdx.x >> 6), lane = threadIdx.x & 63; if (w >= T * NGRP) return;
    const int row = w >> 3, g = w & 7; const float v = GV[(size_t)row * 512 + g * 64 + lane];
    const float mu = wave_sum(v) * (1.f / 64); const float d = v - mu; const float var = wave_sum(d * d) * (1.f / 64);
    VN[(size_t)row * 512 + g * 64 + lane] = f2bf(d * rsqrtf(var + EPS));
}
__global__ __launch_bounds__(256) void k_lat(const float* ZL, const float* gq, const float* gkv, const float* rope, bf16_t* CQKV, float* ssqq, bf16_t* KR) {
    const int row = blockIdx.x * 4 + (threadIdx.x >> 6), lane = threadIdx.x & 63; if (row >= T) return;
    const float* z = ZL + (size_t)row * 416; float sq = 0.f, sk = 0.f;
#pragma unroll
    for (int j = 0; j < 4; ++j) { const int c = lane + 64 * j; const float v = z[c]; sq += v * v; CQKV[(size_t)row * KUP + c] = f2bf(v * gq[c]); }
#pragma unroll
    for (int j = 0; j < 2; ++j) { const int c = lane + 64 * j; const float v = z[256 + c]; sk += v * v; CQKV[(size_t)row * KUP + 256 + c] = f2bf(v * gkv[c]); }
    sq = wave_sum(sq); sk = wave_sum(sk);
    if (lane < 8) ssqq[(size_t)row * 8 + lane] = (lane == 0) ? sq : (lane == 4) ? sk : 0.f;
    if (lane < 16) { const float x1 = z[384 + lane], x2 = z[384 + 16 + lane], c = rope[(size_t)row * 32 + lane], s = rope[(size_t)row * 32 + 16 + lane];
        KR[(size_t)row * 32 + lane] = f2bf(x1 * c - x2 * s); KR[(size_t)row * 32 + 16 + lane] = f2bf(x1 * s + x2 * c); }
}
__global__ void k_rope_q(const float* QRT, const float* rope, bf16_t* Q) {
    const int idx = blockIdx.x * blockDim.x + threadIdx.x; if (idx >= T * NH * 16) return;
    const int r = idx & 15, h = (idx >> 4) & 7, row = idx >> 7;
    const float x1 = QRT[(size_t)row * 256 + h * 32 + r], x2 = QRT[(size_t)row * 256 + h * 32 + 16 + r], c = rope[(size_t)row * 32 + r], s = rope[(size_t)row * 32 + 16 + r];
    Q[(size_t)row * 768 + h * 96 + 64 + r] = f2bf(x1 * c - x2 * s); Q[(size_t)row * 768 + h * 96 + 80 + r] = f2bf(x1 * s + x2 * c);
}
__global__ __launch_bounds__(512) void k_gmlp_naive(const bf16_t* U, const bf16_t* VN, const bf16_t* GW  , const float* bs  , const float* gog, bf16_t* Y, float* ssqy) {
    const int row = blockIdx.x, g = threadIdx.x >> 6, d = threadIdx.x & 63, c = g * 64 + d;
    const int tt = row & 127, t0 = row - tt;
    const bf16_t* w = GW + ((size_t)g * CHUNK + tt) * CHUNK; float sum = 0.f;
    for (int s = 0; s <= tt; ++s) sum += bf2f(w[s]) * bf2f(VN[(size_t)(t0 + s) * 512 + c]);
    const float y = bf2f(U[(size_t)row * 512 + c]) * (sum + bs[g * CHUNK + tt]);
    Y[(size_t)row * DM + c] = f2bf(y * gog[c]);
    const float q = wave_sum(y * y); if (d == 0) ssqy[(size_t)row * 16 + g] = q;
}
__global__ __launch_bounds__(64) void k_attn_naive(const bf16_t* Q, const bf16_t* KN, const bf16_t* KR, const bf16_t* V, const float* goa, bf16_t* Y, float* ssqy) {
    const int h = blockIdx.y, row = blockIdx.x * 64 + threadIdx.x, b = row / SEQ, i = row - b * SEQ;
    const int iend = (blockIdx.x * 64 % SEQ) + 63;
    float q[96];
#pragma unroll
    for (int d8 = 0; d8 < 12; ++d8) { const bf16x8 v = *(const bf16x8*)(Q + (size_t)row * 768 + h * 96 + d8 * 8);
#pragma unroll
        for (int j = 0; j < 8; ++j) q[d8 * 8 + j] = bf2f((bf16_t)v[j]); }
    float o[64];
#pragma unroll
    for (int d = 0; d < 64; ++d) o[d] = 0.f;
    float m = -1e30f, l = 0.f;
    const size_t kb = (size_t)b * SEQ;
    for (int j = 0; j <= iend; ++j) {
        const bf16_t* kn = KN + (kb + j) * 512 + h * 64; const bf16_t* kr = KR + (kb + j) * 32; const bf16_t* vv = V + (kb + j) * 512 + h * 64;
        float s = 0.f;
#pragma unroll
        for (int d8 = 0; d8 < 8; ++d8) { const bf16x8 kv = *(const bf16x8*)(kn + d8 * 8);
#pragma unroll
            for (int jj = 0; jj < 8; ++jj) s += q[d8 * 8 + jj] * bf2f((bf16_t)kv[jj]); }
#pragma unroll
        for (int d8 = 0; d8 < 4; ++d8) { const bf16x8 kv = *(const bf16x8*)(kr + d8 * 8);
#pragma unroll
            for (int jj = 0; jj < 8; ++jj) s += q[64 + d8 * 8 + jj] * bf2f((bf16_t)kv[jj]); }
        if (j > i) s = -1e30f;
        const float mn = fmaxf(m, s), alpha = exp2f(m - mn), p = (j > i) ? 0.f : exp2f(s - mn);
        l = l * alpha + p; m = mn;
#pragma unroll
        for (int d8 = 0; d8 < 8; ++d8) { const bf16x8 v8 = *(const bf16x8*)(vv + d8 * 8);
#pragma unroll
            for (int jj = 0; jj < 8; ++jj) o[d8 * 8 + jj] = o[d8 * 8 + jj] * alpha + p * bf2f((bf16_t)v8[jj]); }
    }
    const float inv = 1.f / l; float sq = 0.f;
#pragma unroll
    for (int d8 = 0; d8 < 8; ++d8) { unsigned w[4];
#pragma unroll
        for (int jj = 0; jj < 8; jj += 2) { const float y0 = o[d8 * 8 + jj] * inv, y1 = o[d8 * 8 + jj + 1] * inv; sq += y0 * y0 + y1 * y1;
            w[jj >> 1] = f2bf(y0 * goa[h * 64 + d8 * 8 + jj]) | ((unsigned)f2bf(y1 * goa[h * 64 + d8 * 8 + jj + 1]) << 16); }
        *(uint4*)(Y + (size_t)row * DM + 512 + h * 64 + d8 * 8) = make_uint4(w[0], w[1], w[2], w[3]); }
    ssqy[(size_t)row * 16 + 8 + h] = sq;
}

__global__ void k_gm(const float* g  , const float* mod, int chunk, float* gmt) {
    const int idx = blockIdx.x * blockDim.x + threadIdx.x; if (idx >= DEPTH * NB * DM) return;
    const int c = idx & 1023, b = (idx >> 10) & 15, l = idx >> 14;
    gmt[idx] = g[l * DM + c] * (1.f + mod[((size_t)l * NB + b) * NMOD + chunk * DM + c]);
}
__device__ __forceinline__ int lane_id() { int l; asm volatile("v_mbcnt_lo_u32_b32 %0, -1, 0\n\tv_mbcnt_hi_u32_b32 %0, -1, %0" : "=v"(l)); return l; }
__device__ __forceinline__ float swz_xor16(float v) { return __int_as_float(__builtin_amdgcn_ds_swizzle(__float_as_int(v), 0x401F)); }
__device__ __forceinline__ float swz_xor1(float v) { return __int_as_float(__builtin_amdgcn_ds_swizzle(__float_as_int(v), 0x041F)); }
namespace pg8 {
#define PG8_LAS __attribute__((address_space(3)))
typedef unsigned u32x4 __attribute__((ext_vector_type(4)));
typedef unsigned u32x2 __attribute__((ext_vector_type(2)));
constexpr int BM = 256, BK = 64, HALF = 128, HTB = HALF * BK * 2  , STAGE_BYTES = 8 * HTB, NXCD = 8, WGM = 8;

__host__ __device__ __forceinline__ int lds_byte(int r, int c) { const int st = (r >> 4) * 2 + (c >> 5), rr = r & 15, cc = c & 31, ob = rr * 64 + cc * 2; return st * 1024 + (ob ^ (((ob >> 9) & 1) << 5)); }
__host__ __device__ __forceinline__ void stage_rc(int b, int& R, int& C) { const int st = b / 1024, sb = b % 1024, swz = sb ^ (((sb >> 9) & 1) << 5); R = (st >> 1) * 16 + swz / 64; C = (st & 1) * 32 + (swz % 64) / 2; }
__host__ __device__ __forceinline__ int perm32(int rho) { const int n = rho >> 4, i = rho & 15; return 8 * (i >> 2) + 4 * n + (i & 3); }

struct Unit { int pm, pn; };
struct Gemm { const bf16_t* A; const bf16_t* Bt; int M, N, K, lda; };

struct StaticOrder {
    int nM, nN, nwg, G, c;
    __host__ __device__ void init(int M, int N, int G_, int c_) { nM = M / BM; nN = N / BM; nwg = nM * nN; G = G_; c = c_; }
    __host__ __device__ bool next(int i, Unit& u) const {
        const long L = (long)i * G + c; if (L >= nwg) return false;
        int wgid = (int)L; { const int q = nwg / NXCD, r = nwg % NXCD, xcd = wgid % NXCD, off = wgid / NXCD; wgid = (xcd < r ? xcd * (q + 1) : r * (q + 1) + (xcd - r) * q) + off; }
        const int nig = WGM * nN, gid = wgid / nig, fm = gid * WGM, gsz = (nM - fm) < WGM ? (nM - fm) : WGM;
        u.pm = fm + ((wgid % nig) % gsz); u.pn = (wgid % nig) / gsz; return true;
    }
    __device__ __forceinline__ void a_ready(const Unit&) const {}
    __device__ __forceinline__ void done(const Unit&) const {}
};

struct KvOrder : StaticOrder {
    __host__ __device__ bool next(int i, Unit& u) const {
        if (G != 256 || nwg != 512) return StaticOrder::next(i, u);
        StaticOrder t = *this; t.G = 1 << 30;
        if (c < 128) { if (i > 0) return false; t.c = c; } else { if (i > 2) return false; t.c = (i == 0) ? c : 256 + 2 * (c - 128) + (i - 1); }
        return t.next(0, u);
    }
};
struct Place { int jx, nx, rank, nloc; };
template <int NN> struct XcdOrder {
    int p0, nunits, rank, nloc;
    __device__ __forceinline__ void init(const Place& p) { p0 = p.jx * (128 / p.nx); nunits = (128 / p.nx) * NN; rank = p.rank; nloc = p.nloc; }
    __device__ __forceinline__ bool map(int idx, Unit& u) const { if (idx >= nunits) return false; const int gi = idx / (8 * NN), w = idx - gi * (8 * NN); u.pm = p0 + 8 * gi + (w & 7); u.pn = w >> 3; return true; }
    __device__ __forceinline__ bool next(int i, Unit& u) const { return map(rank + i * nloc, u); }
    __device__ __forceinline__ void a_ready(const Unit&) const {}
    __device__ __forceinline__ void done(const Unit&) const {}
};
struct LdsOrder {
    volatile PG8_LAS int* tab;
    __device__ __forceinline__ bool next(int i, Unit& u) const { if (i >= __builtin_amdgcn_readfirstlane(tab[0])) return false; u.pm = __builtin_amdgcn_readfirstlane(tab[1 + 2 * i]); u.pn = __builtin_amdgcn_readfirstlane(tab[2 + 2 * i]); return true; }
    __device__ __forceinline__ void a_ready(const Unit&) const {}
    __device__ __forceinline__ void done(const Unit&) const {}
};
template <class Src> __device__ __forceinline__ LdsOrder fill_order(volatile PG8_LAS int* tab, const Src& S, int wid0) {
    __syncthreads();
    if (wid0 == 0 && lane_id() == 0) { Unit u; int n = 0; while (n < 15 && S.next(n, u)) { tab[1 + 2 * n] = u.pm; tab[2 + 2 * n] = u.pn; ++n; } tab[0] = n; }
    __syncthreads();
    LdsOrder o; o.tab = tab; return o;
}
struct XcdKvOrder : XcdOrder<4> {
    __device__ __forceinline__ bool next(int i, Unit& u) const {
        if (nloc != 32 || nunits != 64) return XcdOrder<4>::next(i, u);
        if (rank < 16) return i == 0 ? map(rank, u) : false;
        if (i > 2) return false; return map(i == 0 ? rank : 32 + 2 * (rank - 16) + (i - 1), u);
    }
};
struct FusedPlace { int p0, rank; bool ok; __device__ __forceinline__ void init(const Place& p) { p0 = p.jx * (128 / p.nx); rank = p.rank; ok = (p.nloc == 32 && p.nx == 8); } };
struct FusedInOrder : FusedPlace { __device__ __forceinline__ bool next(int i, Unit& u) const {
        if (i == 0) { u.pm = p0 + (rank & 15); u.pn = 4 + (rank >> 4); return true; }
        if (i > 2) return false; const int w = rank + 32 * (i - 1); u.pm = p0 + 8 * (w >> 5) + (w & 7); u.pn = (w & 31) >> 3; return true; } };
struct FusedUqOrder : FusedPlace { __device__ __forceinline__ bool next(int i, Unit& u) const { if (rank >= 16 || i > 2) return false; u.pm = p0 + rank; u.pn = i; return true; } };
struct FusedUkvOrder : FusedPlace { __device__ __forceinline__ bool next(int i, Unit& u) const { if (rank < 16 || i > 3) return false; u.pm = p0 + rank - 16; u.pn = i; return true; } };
__device__ __forceinline__ unsigned cvt_pk_bf16(float lo, float hi) { unsigned r; asm volatile("v_cvt_pk_bf16_f32 %0, %1, %2" : "=v"(r) : "v"(lo), "v"(hi)); return r; }
__device__ __forceinline__ u32x4 pack8(const f32x4& a, const f32x4& b) { u32x4 w; w.x = cvt_pk_bf16(a[0], a[1]); w.y = cvt_pk_bf16(a[2], a[3]); w.z = cvt_pk_bf16(b[0], b[1]); w.w = cvt_pk_bf16(b[2], b[3]); return w; }
__device__ __forceinline__ u32x2 pack4(const f32x4& a) { u32x2 w; w.x = cvt_pk_bf16(a[0], a[1]); w.y = cvt_pk_bf16(a[2], a[3]); return w; }
__device__ __forceinline__ float hsum4(const f32x4& a) { return (a[0] + a[1]) + (a[2] + a[3]); }
__device__ __forceinline__ float hsq4(const f32x4& a) { return (a[0] * a[0] + a[1] * a[1]) + (a[2] * a[2] + a[3] * a[3]); }
__device__ __forceinline__ float ld_sum16(const float* p) { const f32x4* q = (const f32x4*)p; return (hsum4(q[0]) + hsum4(q[1])) + (hsum4(q[2]) + hsum4(q[3])); }
__device__ __forceinline__ float ld_sum8(const float* p) { const f32x4* q = (const f32x4*)p; return hsum4(q[0]) + hsum4(q[1]); }
__device__ __forceinline__ float ld_sum4(const float* p) { return hsum4(*(const f32x4*)p); }
__device__ __forceinline__ float quad_sum(float s) { s += swz_xor16(s); auto rr = __builtin_amdgcn_permlane32_swap(__float_as_uint(s), __float_as_uint(s), false, false); return __uint_as_float(rr[0]) + __uint_as_float(rr[1]); }
__device__ __forceinline__ float row_sum16(const float* ssq, int row, int fq) { return quad_sum(hsum4(*(const f32x4*)(ssq + (size_t)row * 16 + 4 * fq))); }
__device__ __forceinline__ void row_sum8x2(const float* ssq, int row, int fq, float& sg, float& sa) {
    float s = hsum4(*(const f32x4*)(ssq + (size_t)row * 16 + 4 * fq)); s += swz_xor16(s);
    auto rr = __builtin_amdgcn_permlane32_swap(__float_as_uint(s), __float_as_uint(s), false, false); sg = __uint_as_float(rr[0]); sa = __uint_as_float(rr[1]); }
#define PG8_FENCE() asm volatile("" ::: "memory")
#define PG8_RSTD8(rsv, ssqp, invn) do { f32x4 q_[2][4]; \
    _Pragma("unroll") for (int ai = 0; ai < 2; ++ai) _Pragma("unroll") for (int m = 0; m < 4; ++m) q_[ai][m] = *(const f32x4*)((ssqp) + (size_t)PG8_ROW(u, ai, m) * 16 + 4 * fq); \
    _Pragma("unroll") for (int ai = 0; ai < 2; ++ai) _Pragma("unroll") for (int m = 0; m < 4; ++m) rsv[ai][m] = rsqrtf(quad_sum(hsum4(q_[ai][m])) * (invn) + EPS); \
    PG8_FENCE(); } while (0)
__device__ __forceinline__ f32x4 gelu4(const f32x4& v) { f32x4 o; o[0] = gelu_tanh(v[0]); o[1] = gelu_tanh(v[1]); o[2] = gelu_tanh(v[2]); o[3] = gelu_tanh(v[3]); return o; }

#define PG8_ROW(u, ai, m) ((u).pm * BM + (ai) * HALF + wr * 64 + (m) * 16 + fr)

template <class V, class P> __device__ __forceinline__ V ldb(const P* p, unsigned boff) { return *(const V*)((const char*)p + boff); }
template <class V, class P> __device__ __forceinline__ void stb(P* p, unsigned boff, const V& v) { *(V*)((char*)p + boff) = v; }
#undef PG8_RSTD8
#define PG8_RSTD8(rsv, ssqp, invn) do { f32x4 q_[2][4]; \
    _Pragma("unroll") for (int ai = 0; ai < 2; ++ai) _Pragma("unroll") for (int m = 0; m < 4; ++m) q_[ai][m] = ldb<f32x4>((ssqp), (unsigned)(PG8_ROW(u, ai, m) * 64 + 16 * fq)); \
    _Pragma("unroll") for (int ai = 0; ai < 2; ++ai) _Pragma("unroll") for (int m = 0; m < 4; ++m) rsv[ai][m] = rsqrtf(quad_sum(hsum4(q_[ai][m])) * (invn) + EPS); \
    PG8_FENCE(); } while (0)

struct EpiIn {
    static constexpr int K = DM, LDA = DM;
    static constexpr bool PERM = true, AFTER_DRAIN = false, HAS_MID = false; static constexpr int MID_T = -1;
    const float* ssq1; const float* shw1; const float* gq; const float* gkv; const float* rope;
    bf16_t* U; bf16_t* VN; bf16_t* CQ; bf16_t* CKV; bf16_t* KR; float* ssqq;
    __device__ __forceinline__ void mid(f32x4 (&)[2][2][4][2], const Unit&, int, int) const {}
    __device__ __forceinline__ void operator()(const f32x4 (&acc)[2][2][4][2], const Unit& u, int wr, int wc, int fr, int fq) const {
        { const int l_ = lane_id(); fr = l_ & 15; fq = l_ >> 4; }
        const int b = u.pm >> 3, pc0 = u.pn * BM + wc * 32 + 8 * fq;
        f32x4 sh[2][2];
#pragma unroll
        for (int bj = 0; bj < 2; ++bj)
#pragma unroll
            for (int n = 0; n < 2; ++n) sh[bj][n] = ldb<f32x4>(shw1, (unsigned)((b * NIN + pc0 + bj * HALF + 4 * n) * 4));
        float rsv[2][4]; PG8_RSTD8(rsv, ssq1, 1.f / DM);
        if (u.pn < 2) {
#pragma unroll
            for (int ai = 0; ai < 2; ++ai)
#pragma unroll
                for (int m = 0; m < 4; ++m) { const int row = PG8_ROW(u, ai, m); const float rs = rsv[ai][m];
#pragma unroll
                    for (int bj = 0; bj < 2; ++bj) { const f32x4 v0 = gelu4(acc[ai][bj][m][0] * rs + sh[bj][0]), v1 = gelu4(acc[ai][bj][m][1] * rs + sh[bj][1]);
                        stb(U, (unsigned)((row * 512 + pc0 + bj * HALF) * 2), pack8(v0, v1)); } }
        } else if (u.pn < 4) {
#pragma unroll
            for (int ai = 0; ai < 2; ++ai)
#pragma unroll
                for (int m = 0; m < 4; ++m) { const int row = PG8_ROW(u, ai, m); const float rs = rsv[ai][m];
                    f32x4 g[2][2]; float s = 0.f;
#pragma unroll
                    for (int bj = 0; bj < 2; ++bj)
#pragma unroll
                        for (int n = 0; n < 2; ++n) { g[bj][n] = gelu4(acc[ai][bj][m][n] * rs + sh[bj][n]); s += hsum4(g[bj][n]); }
                    const float mu = quad_sum(s) * (1.f / 64); float q = 0.f;
#pragma unroll
                    for (int bj = 0; bj < 2; ++bj)
#pragma unroll
                        for (int n = 0; n < 2; ++n) { g[bj][n] = g[bj][n] - mu; q += hsq4(g[bj][n]); }
                    const float rstd = rsqrtf(quad_sum(q) * (1.f / 64) + EPS);
#pragma unroll
                    for (int bj = 0; bj < 2; ++bj) stb(VN, (unsigned)((row * 512 + (u.pn - 2) * 256 + 64 * wc + 32 * bj + 8 * fq) * 2), pack8(g[bj][0] * rstd, g[bj][1] * rstd)); }
        } else if (u.pn == 4) {
            f32x4 gv[2][2];
#pragma unroll
            for (int bj = 0; bj < 2; ++bj)
#pragma unroll
                for (int n = 0; n < 2; ++n) gv[bj][n] = ldb<f32x4>(gq, (unsigned)((bj * HALF + wc * 32 + 8 * fq + 4 * n) * 4));
#pragma unroll
            for (int ai = 0; ai < 2; ++ai)
#pragma unroll
                for (int m = 0; m < 4; ++m) { const int row = PG8_ROW(u, ai, m); const float rs = rsv[ai][m];
                    float ss = 0.f;
#pragma unroll
                    for (int bj = 0; bj < 2; ++bj) { const f32x4 v0 = acc[ai][bj][m][0] * rs + sh[bj][0], v1 = acc[ai][bj][m][1] * rs + sh[bj][1]; ss += hsq4(v0) + hsq4(v1);
                        stb(CQ, (unsigned)((row * QR + bj * HALF + wc * 32 + 8 * fq) * 2), pack8(v0 * gv[bj][0], v1 * gv[bj][1])); }
                    ss = quad_sum(ss); if (fq == 0) stb(ssqq, (unsigned)((row * 8 + wc) * 4), ss); }
        } else {
            const f32x4 gk0 = ldb<f32x4>(gkv, (unsigned)((wc * 32 + 8 * fq) * 4)), gk1 = ldb<f32x4>(gkv, (unsigned)((wc * 32 + 8 * fq + 4) * 4));
#pragma unroll
            for (int ai = 0; ai < 2; ++ai)
#pragma unroll
                for (int m = 0; m < 4; ++m) { const int row = PG8_ROW(u, ai, m); const float rs = rsv[ai][m];
                    const f32x4 v0 = acc[ai][0][m][0] * rs + sh[0][0], v1 = acc[ai][0][m][1] * rs + sh[0][1];
                    float ss = quad_sum(hsq4(v0) + hsq4(v1)); if (fq == 0) stb(ssqq, (unsigned)((row * 8 + 4 + wc) * 4), ss);
                    stb(CKV, (unsigned)((row * KVR + wc * 32 + 8 * fq) * 2), pack8(v0 * gk0, v1 * gk1));
                    if (wc == 0) { const f32x4 x1 = acc[ai][1][m][0] * rs + sh[1][0], x2 = acc[ai][1][m][1] * rs + sh[1][1];
                        const f32x4 c = ldb<f32x4>(rope, (unsigned)((row * 32 + 4 * fq) * 4)), s = ldb<f32x4>(rope, (unsigned)((row * 32 + 16 + 4 * fq) * 4));
                        stb(KR, (unsigned)((row * 32 + 4 * fq) * 2), pack4(x1 * c - x2 * s)); stb(KR, (unsigned)((row * 32 + 16 + 4 * fq) * 2), pack4(x1 * s + x2 * c)); } }
        }
    }
};
template <bool KVP> struct EpiUp {
    static constexpr int K = KVP ? KVR : QR, LDA = K;
    static constexpr bool PROBE2 = false;
    static constexpr bool PERM = true, AFTER_DRAIN = false, HAS_MID = false; static constexpr int MID_T = -1;
    const float* ssqq; const float* rope; bf16_t* Q; bf16_t* KN; bf16_t* V;
    __device__ __forceinline__ void mid(f32x4 (&)[2][2][4][2], const Unit&, int, int) const {}
    __device__ __forceinline__ void operator()(const f32x4 (&acc)[2][2][4][2], const Unit& u, int wr, int wc, int fr, int fq) const {
        { const int l_ = lane_id(); fr = l_ & 15; fq = l_ >> 4; }
        float sq[2][4];
        { f32x4 q_[2][4];
#pragma unroll
        for (int ai = 0; ai < 2; ++ai)
#pragma unroll
            for (int m = 0; m < 4; ++m) q_[ai][m] = ldb<f32x4>(ssqq, (unsigned)((PG8_ROW(u, ai, m) * 8 + (KVP ? 4 : 0)) * 4));
#pragma unroll
        for (int ai = 0; ai < 2; ++ai)
#pragma unroll
            for (int m = 0; m < 4; ++m) sq[ai][m] = hsum4(q_[ai][m]);
        PG8_FENCE(); }
        if (!KVP) {
#pragma unroll
            for (int ai = 0; ai < 2; ++ai)
#pragma unroll
                for (int m = 0; m < 4; ++m) { const int row = PG8_ROW(u, ai, m); const float rq = rsqrtf(sq[ai][m] * (1.f / QR) + EPS) * QSCALE;
#pragma unroll
                    for (int bj = 0; bj < 2; ++bj) { const int G = 8 * u.pn + 4 * bj + wc, h = G / 3, gi = G - 3 * h;
                        const f32x4 v0 = acc[ai][bj][m][0] * rq, v1 = acc[ai][bj][m][1] * rq;
                        if (gi < 2) stb(Q, (unsigned)((row * 768 + 32 * G + 8 * fq) * 2), pack8(v0, v1));
                        else { const f32x4 c = ldb<f32x4>(rope, (unsigned)((row * 32 + 4 * fq) * 4)), s = ldb<f32x4>(rope, (unsigned)((row * 32 + 16 + 4 * fq) * 4));
                            stb(Q, (unsigned)((row * 768 + 96 * h + 64 + 4 * fq) * 2), pack4(v0 * c - v1 * s)); stb(Q, (unsigned)((row * 768 + 96 * h + 80 + 4 * fq) * 2), pack4(v0 * s + v1 * c)); } }
                    if (m & 1) PG8_FENCE(); }
        } else {
#pragma unroll
            for (int ai = 0; ai < 2; ++ai)
#pragma unroll
                for (int m = 0; m < 4; ++m) { const int row = PG8_ROW(u, ai, m); const float rk = rsqrtf(sq[ai][m] * (1.f / KVR) + EPS);
#pragma unroll
                    for (int bj = 0; bj < 2; ++bj) { const int h = 2 * u.pn + bj;
                        const u32x4 w = pack8(acc[ai][bj][m][0] * rk, acc[ai][bj][m][1] * rk);
                        if (wc < 2) stb(KN, (unsigned)((row * 512 + 64 * h + 32 * wc + 8 * fq) * 2), w); else stb(V, (unsigned)((row * 512 + 64 * h + 32 * (wc - 2) + 8 * fq) * 2), w); } }
        }
    }
};
__device__ __forceinline__ f32x4 bf_lo4(const u32x4& w) { f32x4 r; r[0] = __uint_as_float(w.x << 16); r[1] = __uint_as_float(w.x & 0xffff0000u); r[2] = __uint_as_float(w.y << 16); r[3] = __uint_as_float(w.y & 0xffff0000u); return r; }
__device__ __forceinline__ f32x4 bf_hi4(const u32x4& w) { f32x4 r; r[0] = __uint_as_float(w.z << 16); r[1] = __uint_as_float(w.z & 0xffff0000u); r[2] = __uint_as_float(w.w << 16); r[3] = __uint_as_float(w.w & 0xffff0000u); return r; }
template <bool MIDS, bool XF32> struct EpiRes {
    static constexpr int K = MIDS ? DM : DFF, LDA = MIDS ? YLD : DFF;
    static constexpr bool PROBE2 = false;
    static constexpr bool PERM = true, AFTER_DRAIN = false, HAS_MID = MIDS; static constexpr int MID_T = 8;
    const float* ssqy; const void* xin; bf16_t* xout; const float* gate  ; const float* gm  ; bf16_t* A; float* ssqo;
    __device__ __forceinline__ void mid(f32x4 (&acc)[2][2][4][2], const Unit& u, int wr, int fr) const {
        const int l_ = lane_id(); fr = l_ & 15; const int fq = l_ >> 4;
        f32x4 q_[2][4];
#pragma unroll
        for (int ai = 0; ai < 2; ++ai)
#pragma unroll
            for (int m = 0; m < 4; ++m) q_[ai][m] = ldb<f32x4>(ssqy, (unsigned)(PG8_ROW(u, ai, m) * 64 + 16 * fq));
#pragma unroll
        for (int ai = 0; ai < 2; ++ai)
#pragma unroll
            for (int m = 0; m < 4; ++m) { float s = hsum4(q_[ai][m]); s += swz_xor16(s);
                auto rr = __builtin_amdgcn_permlane32_swap(__float_as_uint(s), __float_as_uint(s), false, false); const float sg = __uint_as_float(rr[0]), sa = __uint_as_float(rr[1]);
                const float ratio = sqrtf((sa * (1.f / 512) + EPS) / (sg * (1.f / 512) + EPS));
#pragma unroll
                for (int bj = 0; bj < 2; ++bj)
#pragma unroll
                    for (int n = 0; n < 2; ++n) acc[ai][bj][m][n] = acc[ai][bj][m][n] * ratio; }
    }
    __device__ __forceinline__ void operator()(const f32x4 (&acc)[2][2][4][2], const Unit& u, int wr, int wc, int fr, int fq) const {
        { const int l_ = lane_id(); fr = l_ & 15; fq = l_ >> 4; }
        const int b = u.pm >> 3, c0 = u.pn * BM + wc * 32 + 8 * fq;
        float rs[2][4], ss[2][4];
#pragma unroll
        for (int ai = 0; ai < 2; ++ai)
#pragma unroll
            for (int m = 0; m < 4; ++m) { ss[ai][m] = 0.f; rs[ai][m] = 1.f; }
        if (MIDS) { f32x4 q_[2][4];
#pragma unroll
            for (int ai = 0; ai < 2; ++ai)
#pragma unroll
                for (int m = 0; m < 4; ++m) q_[ai][m] = ldb<f32x4>(ssqy, (unsigned)(PG8_ROW(u, ai, m) * 64 + 32 + 16 * (fq & 1)));
#pragma unroll
            for (int ai = 0; ai < 2; ++ai)
#pragma unroll
                for (int m = 0; m < 4; ++m) { float s = hsum4(q_[ai][m]); s += swz_xor16(s); rs[ai][m] = rsqrtf(s * (1.f / 512) + EPS); }
            PG8_FENCE(); }
#pragma unroll
        for (int bj = 0; bj < 2; ++bj) { const int cb = c0 + bj * HALF;
            const f32x4 g0 = ldb<f32x4>(gate, (unsigned)((b * NMOD + cb) * 4)), g1 = ldb<f32x4>(gate, (unsigned)((b * NMOD + cb + 4) * 4));
            f32x4 m0 = (f32x4){0.f, 0.f, 0.f, 0.f}, m1 = m0; if (gm) { m0 = ldb<f32x4>(gm, (unsigned)((b * DM + cb) * 4)); m1 = ldb<f32x4>(gm, (unsigned)((b * DM + cb + 4) * 4)); }
            if (XF32) {
#pragma unroll
                for (int ai = 0; ai < 2; ++ai) {
                    f32x4 xv[4][2];
#pragma unroll
                    for (int m = 0; m < 4; ++m) { const unsigned off = (unsigned)((PG8_ROW(u, ai, m) * DM + cb) * 4); xv[m][0] = ldb<f32x4>(xin, off); xv[m][1] = ldb<f32x4>(xin, off + 16); }
                    PG8_FENCE();
#pragma unroll
                    for (int m = 0; m < 4; ++m) { const unsigned off = (unsigned)((PG8_ROW(u, ai, m) * DM + cb) * 2), offx = (unsigned)(PG8_ROW(u, ai, m) * (DM * 4) + DM * 2 + cb * 2);
                        const f32x4 x0 = xv[m][0] + g0 * (acc[ai][bj][m][0] * rs[ai][m]), x1 = xv[m][1] + g1 * (acc[ai][bj][m][1] * rs[ai][m]);
                        stb(xout, offx, pack8(x0, x1));
                        if (gm) { ss[ai][m] += hsq4(x0) + hsq4(x1); stb(A, off, pack8(x0 * m0, x1 * m1)); } }
                    PG8_FENCE(); }
            } else {
                u32x4 xw[2][4];
#pragma unroll
                for (int ai = 0; ai < 2; ++ai)
#pragma unroll
                    for (int m = 0; m < 4; ++m) xw[ai][m] = ldb<u32x4>(xin, (unsigned)(PG8_ROW(u, ai, m) * (DM * 4) + DM * 2 + cb * 2));
                PG8_FENCE();
#pragma unroll
                for (int ai = 0; ai < 2; ++ai)
#pragma unroll
                    for (int m = 0; m < 4; ++m) { const unsigned off = (unsigned)((PG8_ROW(u, ai, m) * DM + cb) * 2), offx = (unsigned)(PG8_ROW(u, ai, m) * (DM * 4) + DM * 2 + cb * 2);
                        const f32x4 x0 = bf_lo4(xw[ai][m]) + g0 * (acc[ai][bj][m][0] * rs[ai][m]), x1 = bf_hi4(xw[ai][m]) + g1 * (acc[ai][bj][m][1] * rs[ai][m]);
                        stb(xout, offx, pack8(x0, x1));
                        if (gm) { ss[ai][m] += hsq4(x0) + hsq4(x1); stb(A, off, pack8(x0 * m0, x1 * m1)); } }
                PG8_FENCE(); } }
        if (gm) {
#pragma unroll
            for (int ai = 0; ai < 2; ++ai)
#pragma unroll
                for (int m = 0; m < 4; ++m) { const float s = quad_sum(ss[ai][m]); if (fq == 0) stb(ssqo, (unsigned)((PG8_ROW(u, ai, m) * 16 + u.pn * 4 + wc) * 4), s); } }
    }
};
struct EpiFf1 {
    static constexpr int K = DM, LDA = DM;
    static constexpr bool PERM = true, AFTER_DRAIN = false, HAS_MID = false; static constexpr int MID_T = -1;
    const float* ssq2; const float* shw2; bf16_t* H;
    __device__ __forceinline__ void mid(f32x4 (&)[2][2][4][2], const Unit&, int, int) const {}
    __device__ __forceinline__ void operator()(const f32x4 (&acc)[2][2][4][2], const Unit& u, int wr, int wc, int fr, int fq) const {
        { const int l_ = lane_id(); fr = l_ & 15; fq = l_ >> 4; }
        const int b = u.pm >> 3, c0 = u.pn * BM + wc * 32 + 8 * fq;
        f32x4 sh[2][2];
#pragma unroll
        for (int bj = 0; bj < 2; ++bj)
#pragma unroll
            for (int n = 0; n < 2; ++n) sh[bj][n] = ldb<f32x4>(shw2, (unsigned)((b * DFF + c0 + bj * HALF + 4 * n) * 4));
        float rsv[2][4]; PG8_RSTD8(rsv, ssq2, 1.f / DM);
#pragma unroll
        for (int ai = 0; ai < 2; ++ai)
#pragma unroll
            for (int m = 0; m < 4; ++m) { const int row = PG8_ROW(u, ai, m); const float rs = rsv[ai][m];
#pragma unroll
                for (int bj = 0; bj < 2; ++bj) { f32x4 v0 = acc[ai][bj][m][0] * rs + sh[bj][0], v1 = acc[ai][bj][m][1] * rs + sh[bj][1];
#pragma unroll
                    for (int i = 0; i < 4; ++i) { const float a = fmaxf(v0[i], 0.f), c = fmaxf(v1[i], 0.f); v0[i] = a * a; v1[i] = c * c; }
                    stb(H, (unsigned)((row * DFF + c0 + bj * HALF) * 2), pack8(v0, v1)); } }
    }
};

template <class Epi, class Sched, bool ALIGN_EPI = false, bool SP2 = false>
__device__ __forceinline__ void gemm_phase(PG8_LAS unsigned char* lds, const Gemm g, const Sched& S, const Epi& E, int wid0) {
    int tid_ = wid0 * 64 + lane_id(); asm volatile("" : "+v"(tid_));
    const int tid = tid_, wid = __builtin_amdgcn_readfirstlane(tid >> 6), lane = tid & 63, wr = wid >> 2, wc = wid & 3, fr = lane & 15, fq = lane >> 4;
    constexpr int K = Epi::K, LDA = Epi::LDA, nt = K / BK;
    unsigned voffA[2], voffB[2];
#pragma unroll
    for (int i = 0; i < 2; ++i) { int R, C; stage_rc(tid * 16 + i * 8192, R, C); const int Rb = Epi::PERM ? ((R & ~31) + perm32(R & 31)) : R;
        voffA[i] = (unsigned)(R * LDA + C) * 2u; voffB[i] = (unsigned)(Rb * K + C) * 2u; }
    const size_t kstep = (size_t)(BK * 2);
    const size_t hstep = (size_t)HALF * K * 2;
    const size_t tstep = 2 * hstep;
    const size_t hstepA = (size_t)HALF * LDA * 2, tstepA = 2 * hstepA;
    const unsigned ldsw = (unsigned)wid * 1024u;
    const int aoff = lds_byte(wr * 64 + fr, fq * 8), boff = lds_byte(wc * 32 + fr, fq * 8);
#define PG8_SA(b, h) (((b) * 2 + (h)) * HTB)
#define PG8_SB(b, h) ((4 + (b) * 2 + (h)) * HTB)
#define PG8_STAGE(bufoff, gbase, voff) do { _Pragma("unroll") for (int _i = 0; _i < 2; ++_i) \
        __builtin_amdgcn_global_load_lds((const unsigned*)((const char*)(gbase) + (voff)[_i]), (PG8_LAS unsigned*)(lds + (bufoff) + ldsw + _i * 8192), 16, 0, 0); } while (0)
#define PG8_LDA(dst, b, h) do { _Pragma("unroll") for (int m = 0; m < 4; ++m) _Pragma("unroll") for (int k = 0; k < 2; ++k) dst[m][k] = *(const PG8_LAS bf16x8*)(lds + PG8_SA(b, h) + aoff + m * 2048 + k * 1024); } while (0)
#define PG8_LDB(dst, b, h) do { _Pragma("unroll") for (int n = 0; n < 2; ++n) _Pragma("unroll") for (int k = 0; k < 2; ++k) dst[n][k] = *(const PG8_LAS bf16x8*)(lds + PG8_SB(b, h) + boff + n * 2048 + k * 1024); } while (0)
#define PG8_MMA(ai, bj, At, Bt) do { __builtin_amdgcn_s_setprio(1); _Pragma("unroll") for (int m = 0; m < 4; ++m) _Pragma("unroll") for (int n = 0; n < 2; ++n) _Pragma("unroll") for (int k = 0; k < 2; ++k) \
        acc[ai][bj][m][n] = __builtin_amdgcn_mfma_f32_16x16x32_bf16(Bt[n][k], At[m][k], acc[ai][bj][m][n], 0, 0, 0); __builtin_amdgcn_s_setprio(0); } while (0)
#define PG8_WAIT_V(n) asm volatile("s_waitcnt vmcnt(" #n ")" ::: "memory")
#define PG8_WAIT_L(n) asm volatile("s_waitcnt lgkmcnt(" #n ")" ::: "memory")
#define PG8_BAR __builtin_amdgcn_s_barrier()
#define PG8_SCHED __builtin_amdgcn_sched_barrier(0)
    Unit cur, nxt; int ui = 0;
    if (!S.next(0, cur)) return;
    f32x4 acc[2][2][4][2];
#pragma unroll
    for (int a = 0; a < 2; ++a)
#pragma unroll
        for (int b = 0; b < 2; ++b)
#pragma unroll
            for (int m = 0; m < 4; ++m)
#pragma unroll
                for (int n = 0; n < 2; ++n) acc[a][b][m][n] = (f32x4){0.f, 0.f, 0.f, 0.f};
    bf16x8 At[4][2], B0[2][2], B1[2][2];
    const char* cA = (const char*)g.A + (size_t)cur.pm * tstepA; const char* cB = (const char*)g.Bt + (size_t)cur.pn * tstep;
    S.a_ready(cur);
    if constexpr (SP2) {
        PG8_STAGE(PG8_SB(0, 0), cB, voffB); PG8_STAGE(PG8_SB(0, 1), cB + hstep, voffB); PG8_STAGE(PG8_SA(0, 0), cA, voffA); PG8_STAGE(PG8_SA(0, 1), cA + hstepA, voffA);
        if (wr == 1) PG8_BAR;
        PG8_WAIT_V(2); PG8_BAR;
        PG8_STAGE(PG8_SB(1, 0), cB + kstep, voffB); PG8_STAGE(PG8_SA(1, 0), cA + kstep, voffA); PG8_STAGE(PG8_SB(1, 1), cB + hstep + kstep, voffB);
        PG8_WAIT_V(6); PG8_BAR;
    } else {
        PG8_STAGE(PG8_SB(0, 0), cB, voffB); PG8_STAGE(PG8_SA(0, 0), cA, voffA); PG8_STAGE(PG8_SB(0, 1), cB + hstep, voffB); PG8_STAGE(PG8_SA(0, 1), cA + hstepA, voffA);
        if (wr == 1) PG8_BAR;
        PG8_WAIT_V(4); PG8_BAR;
        PG8_STAGE(PG8_SB(1, 0), cB + kstep, voffB); PG8_STAGE(PG8_SA(1, 0), cA + kstep, voffA); PG8_STAGE(PG8_SB(1, 1), cB + hstep + kstep, voffB);
        PG8_WAIT_V(6); PG8_BAR;
    }
    for (;;) {
        const bool has_next = S.next(ui + 1, nxt);
        const char* nA = has_next ? (const char*)g.A + (size_t)nxt.pm * tstepA : cA; const char* nB = has_next ? (const char*)g.Bt + (size_t)nxt.pn * tstep : cB;
#pragma nounroll
        for (int t = 0; t < nt; t += 2) {
            const bool last = (t == nt - 2);
            const char* a1 = cA + (size_t)(t + 1) * kstep;
            const char* a2 = last ? nA : cA + (size_t)(t + 2) * kstep; const char* b2 = last ? nB : cB + (size_t)(t + 2) * kstep;
            const char* a3 = a2 + kstep; const char* b3 = b2 + kstep;
            if (last && has_next) S.a_ready(nxt);
            if constexpr (Epi::HAS_MID) { if (t == Epi::MID_T) E.mid(acc, cur, wr, fr); }
            if constexpr (SP2) {
            PG8_LDB(B0, 0, 0); PG8_LDB(B1, 0, 1); PG8_SCHED; PG8_LDA(At, 0, 0); PG8_STAGE(PG8_SA(1, 1), a1 + hstepA, voffA);
            PG8_WAIT_V(8); PG8_WAIT_L(0); PG8_BAR; PG8_MMA(0, 0, At, B0); PG8_MMA(0, 1, At, B1); PG8_BAR; PG8_SCHED;
            PG8_LDA(At, 0, 1); PG8_STAGE(PG8_SB(0, 0), b2, voffB); PG8_STAGE(PG8_SB(0, 1), b2 + hstep, voffB); PG8_STAGE(PG8_SA(0, 0), a2, voffA);
            PG8_WAIT_V(8); PG8_WAIT_L(0); PG8_BAR; PG8_MMA(1, 0, At, B0); PG8_MMA(1, 1, At, B1); PG8_BAR; PG8_SCHED;
            PG8_LDB(B0, 1, 0); PG8_LDB(B1, 1, 1); PG8_SCHED; PG8_LDA(At, 1, 0); PG8_STAGE(PG8_SA(0, 1), a2 + hstepA, voffA);
            PG8_WAIT_V(8); PG8_WAIT_L(0); PG8_BAR; PG8_MMA(0, 0, At, B0); PG8_MMA(0, 1, At, B1); PG8_BAR; PG8_SCHED;
            PG8_LDA(At, 1, 1); PG8_STAGE(PG8_SB(1, 0), b3, voffB); PG8_STAGE(PG8_SB(1, 1), b3 + hstep, voffB); PG8_STAGE(PG8_SA(1, 0), a3, voffA);
            PG8_WAIT_V(8); PG8_WAIT_L(0); PG8_BAR; PG8_MMA(1, 0, At, B0); PG8_MMA(1, 1, At, B1); PG8_BAR; PG8_SCHED;
            } else {
            PG8_LDB(B0, 0, 0); PG8_SCHED; PG8_LDA(At, 0, 0); PG8_STAGE(PG8_SA(1, 1), a1 + hstepA, voffA);
            PG8_WAIT_L(8); PG8_BAR; PG8_WAIT_L(0); PG8_MMA(0, 0, At, B0); PG8_BAR; PG8_SCHED;
            PG8_LDB(B1, 0, 1); PG8_STAGE(PG8_SB(0, 0), b2, voffB);
            PG8_BAR; PG8_WAIT_L(0); PG8_MMA(0, 1, At, B1); PG8_BAR;
            PG8_LDA(At, 0, 1); PG8_STAGE(PG8_SA(0, 0), a2, voffA);
            PG8_BAR; PG8_WAIT_L(0); PG8_MMA(1, 0, At, B0); PG8_BAR; PG8_SCHED;
            PG8_STAGE(PG8_SB(0, 1), b2 + hstep, voffB);
            PG8_WAIT_V(6); PG8_BAR; PG8_MMA(1, 1, At, B1); PG8_BAR;
            PG8_LDB(B0, 1, 0); PG8_SCHED; PG8_LDA(At, 1, 0); PG8_STAGE(PG8_SA(0, 1), a2 + hstepA, voffA);
            PG8_WAIT_L(8); PG8_BAR; PG8_WAIT_L(0); PG8_MMA(0, 0, At, B0); PG8_BAR; PG8_SCHED;
            PG8_LDB(B1, 1, 1); PG8_STAGE(PG8_SB(1, 0), b3, voffB);
            PG8_BAR; PG8_WAIT_L(0); PG8_MMA(0, 1, At, B1); PG8_BAR;
            PG8_LDA(At, 1, 1); PG8_STAGE(PG8_SA(1, 0), a3, voffA);
            PG8_BAR; PG8_WAIT_L(0); PG8_MMA(1, 0, At, B0); PG8_BAR; PG8_SCHED;
            PG8_STAGE(PG8_SB(1, 1), b3 + hstep, voffB);
            PG8_WAIT_V(6); PG8_BAR; PG8_MMA(1, 1, At, B1); PG8_BAR;
            }
        }
        if constexpr (ALIGN_EPI) { if (wr == 0) PG8_BAR; }
        if constexpr (!Epi::AFTER_DRAIN) { E(acc, cur, wr, wc, fr, fq); S.done(cur); }
        if (!has_next) break;
#pragma unroll
        for (int a = 0; a < 2; ++a)
#pragma unroll
            for (int b = 0; b < 2; ++b)
#pragma unroll
                for (int m = 0; m < 4; ++m)
#pragma unroll
                    for (int n = 0; n < 2; ++n) acc[a][b][m][n] = (f32x4){0.f, 0.f, 0.f, 0.f};
        cur = nxt; cA = nA; cB = nB; ++ui;
        if constexpr (ALIGN_EPI) { if (wr == 1) PG8_BAR; }
    }
    PG8_WAIT_V(0);
    if constexpr (!ALIGN_EPI) { if (wr == 0) PG8_BAR; }
    PG8_BAR;
    if constexpr (Epi::AFTER_DRAIN) { E.fused(acc, cur, wr, wc, fr, fq, lds, wid, lane); S.done(cur); }
#undef PG8_SA
#undef PG8_SB
#undef PG8_STAGE
#undef PG8_LDA
#undef PG8_LDB
#undef PG8_MMA
#undef PG8_WAIT_V
#undef PG8_WAIT_L
#undef PG8_BAR
#undef PG8_SCHED
}
}

namespace gm {
#define GM_LAS __attribute__((address_space(3)))
typedef short v4i16_t __attribute__((ext_vector_type(4)));
__device__ __forceinline__ int swz(int s) { return ((s >> 1) & 1) + 2 * ((s >> 3) & 1); }
__device__ __forceinline__ void gmlp_phase(GM_LAS unsigned char* lds, int wid0, const pg8::Place& pl, const bf16_t* U, const bf16_t* VN, const bf16_t* GW  , const float* bs  , const float* gog  , bf16_t* Y, float* ssqy) {
    int tid_ = wid0 * 64 + lane_id(); asm volatile("" : "+v"(tid_));
    const int tid = tid_, lane = tid & 63, wid = __builtin_amdgcn_readfirstlane(tid >> 6), fr = lane & 15, fq = lane >> 4;
    const int nks = (wid >> 1) + 1, nu = 256 / pl.nx, u0 = pl.jx * nu;
    int gcur = -1; bf16x8 wf[4]; float bias = 0.f; f32x4 gv[4];
    pg8::u32x4 st[2]; uint2 uu[4];
#define GM_LOAD(IDX) do { const int g_ = (IDX) & 7; const size_t t0_ = (size_t)(u0 + ((IDX) >> 3)) * CHUNK; \
        _Pragma("unroll") for (int k = 0; k < 2; ++k) { const int ix = tid + 512 * k, s_ = ix >> 3, c16 = ix & 7; st[k] = *(const pg8::u32x4*)(VN + (t0_ + s_) * 512 + g_ * 64 + c16 * 8); } \
        _Pragma("unroll") for (int nt = 0; nt < 4; ++nt) uu[nt] = *(const uint2*)(U + (t0_ + 16 * wid + fr) * 512 + g_ * 64 + 16 * nt + 4 * fq); } while (0)
    if (pl.rank < 8 * nu) GM_LOAD(pl.rank);
    for (int idx = pl.rank; idx < 8 * nu; idx += pl.nloc) {
        const int g = idx & 7, un = u0 + (idx >> 3); const size_t t0 = (size_t)un * CHUNK;
        if (g != gcur) { gcur = g;
#pragma unroll
            for (int ks = 0; ks < 4; ++ks) wf[ks] = *(const bf16x8*)(GW + ((size_t)(g * CHUNK + 16 * wid + fr)) * CHUNK + 32 * ks + 8 * fq);
            bias = bs[g * CHUNK + 16 * wid + fr];
#pragma unroll
            for (int nt = 0; nt < 4; ++nt) gv[nt] = *(const f32x4*)(gog + g * 64 + 16 * nt + 4 * fq); }
        __syncthreads();
#pragma unroll
        for (int k = 0; k < 2; ++k) { const int ix = tid + 512 * k, s = ix >> 3, c16 = ix & 7; *(GM_LAS pg8::u32x4*)(lds + s * 128 + (((c16 >> 1) ^ swz(s)) * 32) + (c16 & 1) * 16) = st[k]; }
        uint2 uc[4];
#pragma unroll
        for (int nt = 0; nt < 4; ++nt) uc[nt] = uu[nt];
        __syncthreads();
        if (idx + pl.nloc < 8 * nu) GM_LOAD(idx + pl.nloc);
        f32x4 acc[4];
#pragma unroll
        for (int nt = 0; nt < 4; ++nt) acc[nt] = (f32x4){0.f, 0.f, 0.f, 0.f};
#pragma unroll
        for (int ks = 0; ks < 4; ++ks) { if (ks < nks) {
#pragma unroll
            for (int nt = 0; nt < 4; ++nt) {
                const int q = fr >> 2, p = fr & 3;
                const int s0 = 32 * ks + 8 * fq + q, s1 = s0 + 4;
                const v4i16_t lo = __builtin_amdgcn_ds_read_tr16_b64_v4i16((GM_LAS v4i16_t*)(lds + s0 * 128 + ((nt ^ swz(s0)) * 32) + p * 8));
                const v4i16_t hi = __builtin_amdgcn_ds_read_tr16_b64_v4i16((GM_LAS v4i16_t*)(lds + s1 * 128 + ((nt ^ swz(s1)) * 32) + p * 8));
                const bf16x8 vf = (bf16x8){lo[0], lo[1], lo[2], lo[3], hi[0], hi[1], hi[2], hi[3]};
                acc[nt] = __builtin_amdgcn_mfma_f32_16x16x32_bf16(vf, wf[ks], acc[nt], 0, 0, 0);
            } } }
        const size_t row = t0 + 16 * wid + fr; float ss = 0.f;
#pragma unroll
        for (int nt = 0; nt < 4; ++nt) { const int c = g * 64 + 16 * nt + 4 * fq;
            f32x4 y; y[0] = bf2f((bf16_t)(uc[nt].x & 0xffff)) * (acc[nt][0] + bias); y[1] = bf2f((bf16_t)(uc[nt].x >> 16)) * (acc[nt][1] + bias);
            y[2] = bf2f((bf16_t)(uc[nt].y & 0xffff)) * (acc[nt][2] + bias); y[3] = bf2f((bf16_t)(uc[nt].y >> 16)) * (acc[nt][3] + bias);
            ss += pg8::hsq4(y); *(pg8::u32x2*)(Y + row * YLD + c) = pg8::pack4(y * gv[nt]); }
        ss = pg8::quad_sum(ss); if (fq == 0) ssqy[row * 16 + g] = ss;
    }
#undef GM_LOAD
    __syncthreads();
}
}

namespace att {
#define AT_LAS __attribute__((address_space(3)))
using f32x16 = __attribute__((ext_vector_type(16))) float;
using s16x4 = __attribute__((ext_vector_type(4))) short;
using u32x4 = __attribute__((ext_vector_type(4))) unsigned;
constexpr int KVBLK = 64, KSLOTB = 12288, VSLOTB = 8192, NKS = 4, NVS = 4;
constexpr int LDS_V = NKS * KSLOTB  , LDS_WS = LDS_V + NVS * VSLOTB  , LDS_OST = LDS_WS + 8 * 256  , OROW = 144, LDS_BYTES = LDS_OST + 8 * 32 * OROW  ;
__device__ __forceinline__ int crow(int r, int hi) { return (r & 3) + 8 * (r >> 2) + 4 * hi; }
__device__ __forceinline__ void glds16(const void* gsrc, unsigned lds_dst) { unsigned keep;
    asm volatile("s_mov_b32 %0, m0\n\ts_mov_b32 m0, %2\n\ts_nop 0\n\tglobal_load_lds_dwordx4 %1, off\n\ts_mov_b32 m0, %0" : "=&s"(keep) : "v"(gsrc), "s"(lds_dst) : "memory"); }
typedef float f32x2_t __attribute__((ext_vector_type(2))); typedef __bf16 bf16x2_t __attribute__((ext_vector_type(2)));
__device__ __forceinline__ unsigned cvtpk_s(float lo, float hi) { f32x2_t v = {lo, hi}; bf16x2_t b = __builtin_convertvector(v, bf16x2_t); return __builtin_bit_cast(unsigned, b); }
__device__ __forceinline__ float max3f(float a, float b, float c) { float r; asm("v_max3_f32 %0, %1, %2, %3" : "=v"(r) : "v"(a), "v"(b), "v"(c)); return r; }
#define AT_WAIT_BAR(N) asm volatile("s_waitcnt vmcnt(" #N ") lgkmcnt(0)\n\ts_barrier" ::: "memory")
typedef short v4i16_t __attribute__((ext_vector_type(4)));
__device__ __forceinline__ s16x4 vtr(AT_LAS const char* p) { return __builtin_bit_cast(s16x4, __builtin_amdgcn_ds_read_tr16_b64_v4i16((AT_LAS v4i16_t*)p)); }
__device__ __forceinline__ void pv(f32x16 (&o)[2], AT_LAS const char* vp, const u32x4& pw0, const u32x4& pw1, const u32x4& pw2, const u32x4& pw3) {
#pragma unroll
    for (int d0 = 0; d0 < 2; ++d0) { s16x4 lo[4], hh[4];
#pragma unroll
        for (int ks = 0; ks < 4; ++ks) { lo[ks] = vtr(vp + d0 * 4096 + ks * 1024); hh[ks] = vtr(vp + d0 * 4096 + ks * 1024 + 512); }
#define AT_VF(k) (bf16x8){lo[k][0], lo[k][1], lo[k][2], lo[k][3], hh[k][0], hh[k][1], hh[k][2], hh[k][3]}
        o[d0] = __builtin_amdgcn_mfma_f32_32x32x16_bf16(__builtin_bit_cast(bf16x8, pw0), AT_VF(0), o[d0], 0, 0, 0);
        o[d0] = __builtin_amdgcn_mfma_f32_32x32x16_bf16(__builtin_bit_cast(bf16x8, pw1), AT_VF(1), o[d0], 0, 0, 0);
        o[d0] = __builtin_amdgcn_mfma_f32_32x32x16_bf16(__builtin_bit_cast(bf16x8, pw2), AT_VF(2), o[d0], 0, 0, 0);
        o[d0] = __builtin_amdgcn_mfma_f32_32x32x16_bf16(__builtin_bit_cast(bf16x8, pw3), AT_VF(3), o[d0], 0, 0, 0);
#undef AT_VF
    }
}
__device__ __forceinline__ void qkt(f32x16& p0, f32x16& p1, AT_LAS const char* kb, const bf16x8 (&qr)[6], const f32x16& negm) {
    bf16x8 kf[12];
#pragma unroll
    for (int d0 = 0; d0 < 6; ++d0) { kf[2 * d0] = *(AT_LAS const bf16x8*)(kb + d0 * 2048); kf[2 * d0 + 1] = *(AT_LAS const bf16x8*)(kb + d0 * 2048 + 512); }
    __builtin_amdgcn_sched_barrier(0);
    p0 = __builtin_amdgcn_mfma_f32_32x32x16_bf16(kf[0], qr[0], negm, 0, 0, 0); p1 = __builtin_amdgcn_mfma_f32_32x32x16_bf16(kf[1], qr[0], negm, 0, 0, 0);
#pragma unroll
    for (int d0 = 1; d0 < 6; ++d0) { p0 = __builtin_amdgcn_mfma_f32_32x32x16_bf16(kf[2 * d0], qr[d0], p0, 0, 0, 0); p1 = __builtin_amdgcn_mfma_f32_32x32x16_bf16(kf[2 * d0 + 1], qr[d0], p1, 0, 0, 0); }
    asm volatile("s_nop 15\n\ts_nop 7" : "+v"(p0), "+v"(p1));
}
template <int THRL>
__device__ __forceinline__ void attn_unit(int b, int h, int qb, const bf16_t* Q, const bf16_t* KN, const bf16_t* KR, const bf16_t* V, const float* goa  , bf16_t* Y, float* ssqy, AT_LAS char* shm, int wid0) {
    int tid_ = wid0 * 64 + lane_id(); asm volatile("" : "+v"(tid_));
    const int tid = tid_, lane = tid & 63, r32 = lane & 31, hi = lane >> 5; const int wid = __builtin_amdgcn_readfirstlane(tid >> 6);
    const bool late = wid >= 4;
    const size_t rowbase = (size_t)b * SEQ; const int q0 = qb * 256;
    const bf16_t* Qw = Q + (rowbase + q0 + wid * 32) * 768 + h * 96;
    const unsigned lds0 = (unsigned)(uintptr_t)shm;
    AT_LAS float* wsf = (AT_LAS float*)(shm + LDS_WS) + wid * 64;
    const bf16_t* ksrc = KN + (rowbase + lane) * 512 + h * 64 + wid * 8;
    const bf16_t* rsrc = KR + (rowbase + lane) * 32 + (wid & 3) * 8;
    const bf16_t* vsrc = V + (rowbase + 16 * (wid & 3) + (lane >> 2)) * 512 + h * 64 + (wid >> 2) * 32 + (lane & 3) * 8;
    const unsigned kdst = lds0 + wid * 1024, rdst = lds0 + (8 + (wid & 3)) * 1024, vdst = lds0 + LDS_V + wid * 1024;
    const int NT = (q0 + 256) / KVBLK;
#define AT_DMA(jk, jv) do { const int jk_ = (jk) < NT ? (jk) : NT - 1, jv_ = (jv) < NT ? (jv) : NT - 1; \
        glds16(ksrc + (size_t)jk_ * KVBLK * 512, (unsigned)__builtin_amdgcn_readfirstlane(kdst + (jk_ & 3) * KSLOTB)); \
        glds16(rsrc + (size_t)jk_ * KVBLK * 32, (unsigned)__builtin_amdgcn_readfirstlane(rdst + (jk_ & 3) * KSLOTB)); \
        glds16(vsrc + (size_t)jv_ * KVBLK * 512, (unsigned)__builtin_amdgcn_readfirstlane(vdst + (jv_ & 3) * VSLOTB)); } while (0)
    bf16x8 qr[6];
#pragma unroll
    for (int d0 = 0; d0 < 6; ++d0) qr[d0] = *(const bf16x8*)(Qw + (size_t)r32 * 768 + d0 * 16 + hi * 8);
    AT_DMA(0, 0); AT_DMA(1, 1); AT_DMA(2, 1);
    float mhat = 0.f, l_reg = 0.f; f32x16 o[2]; o[0] = f32x16{}; o[1] = f32x16{};
    f32x16 negm = f32x16{}; asm volatile("" : "+v"(negm));
    const int qrel = wid * 32 + r32, wq = wid >> 1;
    AT_LAS const char* kp0 = shm + hi * 1024 + r32 * 16;
    AT_LAS const char* vp0 = shm + LDS_V + ((lane >> 4) & 1) * 32 + (lane & 3) * 8 + (4 * hi + ((lane & 15) >> 2)) * 64;
    u32x4 pw0 = u32x4{}, pw1 = u32x4{}, pw2 = u32x4{}, pw3 = u32x4{}; bool have = false;
    f32x16 p0 = f32x16{}, p1 = f32x16{};
    AT_WAIT_BAR(6);
    if (!late) qkt(p0, p1, kp0, qr, negm);
    for (int t = 0; t < NT; ++t) {
        AT_WAIT_BAR(3);
        AT_DMA(t + 3, t + 2);
        const int jb = t - (NT - 4);
        const bool need = jb <= wq;
        if (late) { if (have) pv(o, vp0 + ((t - 1) & 3) * VSLOTB, pw0, pw1, pw2, pw3);
                    have = false; if (need) qkt(p0, p1, kp0 + (t & 3) * KSLOTB, qr, negm); }
        if (need) {
            if (jb == wq) { const int kb = 64 * jb + 4 * hi;
#pragma unroll
                for (int r = 0; r < 16; ++r) { const int kv = kb + (r & 3) + 8 * (r >> 2); if (kv > qrel) p0[r] = -INFINITY; if (kv + 32 > qrel) p1[r] = -INFINITY; } }
            float ma = max3f(p0[0], p0[1], p1[0]), mb = max3f(p0[2], p0[3], p1[1]); ma = max3f(ma, p1[2], p1[3]);
#pragma unroll
            for (int r = 4; r < 16; r += 4) { ma = max3f(ma, p0[r], p0[r + 1]); mb = max3f(mb, p0[r + 2], p0[r + 3]); ma = max3f(ma, p1[r], p1[r + 1]); mb = max3f(mb, p1[r + 2], p1[r + 3]); }
            float rm = fmaxf(ma, mb);
            { auto rr = __builtin_amdgcn_permlane32_swap(__float_as_uint(rm), __float_as_uint(rm), false, false); rm = fmaxf(__uint_as_float(rr[0]), __uint_as_float(rr[1])); }
            if (t == 0 || __any(rm > (float)THRL)) {
                const float dl = (t == 0) ? rm : fmaxf(rm, 0.f); mhat += dl;
#pragma unroll
                for (int r = 0; r < 16; ++r) { p0[r] -= dl; p1[r] -= dl; negm[r] = -mhat; }
                asm volatile("" : "+v"(negm));
                if (t > 0) { const float f = __builtin_amdgcn_exp2f(-dl); l_reg *= f; if (hi == 0) wsf[r32] = f; asm volatile("s_waitcnt lgkmcnt(0)" ::: "memory");
#pragma unroll
                    for (int r = 0; r < 16; ++r) { const float fr_ = wsf[crow(r, hi)]; o[0][r] *= fr_; o[1][r] *= fr_; } }
            }
            float sacc = 0.f;
#pragma unroll
            for (int r = 0; r < 16; ++r) { p0[r] = __builtin_amdgcn_exp2f(p0[r]); p1[r] = __builtin_amdgcn_exp2f(p1[r]); sacc += p0[r] + p1[r]; }
            l_reg += sacc;
#define AT_PK(P, B) cvtpk_s(P[B], P[B + 1])
            pw0 = (u32x4){AT_PK(p0, 0), AT_PK(p0, 2), AT_PK(p0, 4), AT_PK(p0, 6)}; pw1 = (u32x4){AT_PK(p0, 8), AT_PK(p0, 10), AT_PK(p0, 12), AT_PK(p0, 14)};
            pw2 = (u32x4){AT_PK(p1, 0), AT_PK(p1, 2), AT_PK(p1, 4), AT_PK(p1, 6)}; pw3 = (u32x4){AT_PK(p1, 8), AT_PK(p1, 10), AT_PK(p1, 12), AT_PK(p1, 14)};
#undef AT_PK
            if (late) have = true;
            else pv(o, vp0 + (t & 3) * VSLOTB, pw0, pw1, pw2, pw3);
        }
        if (!late) { if (t + 1 < NT && (jb + 1) <= wq) qkt(p0, p1, kp0 + ((t + 1) & 3) * KSLOTB, qr, negm); }
    }
    if (late && have) pv(o, vp0 + ((NT - 1) & 3) * VSLOTB, pw0, pw1, pw2, pw3);
    { auto rr = __builtin_amdgcn_permlane32_swap(__float_as_uint(l_reg), __float_as_uint(l_reg), false, false); l_reg = __uint_as_float(rr[0]) + __uint_as_float(rr[1]); }
    if (hi == 0) wsf[32 + r32] = __builtin_amdgcn_rcpf(l_reg);
    asm volatile("s_waitcnt lgkmcnt(0)" ::: "memory");
    AT_LAS char* stg = shm + LDS_OST + wid * (32 * OROW);
    { const int row = lane >> 1, half = lane & 1; const size_t grow = rowbase + q0 + wid * 32 + row; float ss = 0.f;
#pragma unroll
      for (int d0 = 0; d0 < 2; ++d0) {
#pragma unroll
        for (int r = 0; r < 16; ++r) { const int orow = crow(r, hi); *(AT_LAS float*)(stg + orow * OROW + r32 * 4) = o[d0][r] * wsf[32 + orow]; }
        asm volatile("s_waitcnt lgkmcnt(0)" ::: "memory");
        const float* gp = goa + h * 64 + d0 * 32 + half * 16; bf16_t* yp = Y + grow * YLD + 512 + h * 64 + d0 * 32 + half * 16;
#pragma unroll
        for (int i = 0; i < 2; ++i) { const f32x4 a = *(AT_LAS const f32x4*)(stg + row * OROW + half * 64 + i * 32), c = *(AT_LAS const f32x4*)(stg + row * OROW + half * 64 + i * 32 + 16);
            ss += pg8::hsq4(a) + pg8::hsq4(c);
            *(u32x4*)(yp + i * 8) = pg8::pack8(a * *(const f32x4*)(gp + i * 8), c * *(const f32x4*)(gp + i * 8 + 4)); }
        asm volatile("s_waitcnt lgkmcnt(0)" ::: "memory"); }
      ss += swz_xor1(ss); if (half == 0) ssqy[grow * 16 + 8 + h] = ss; }
    asm volatile("s_waitcnt vmcnt(0) lgkmcnt(0)\n\ts_barrier" ::: "memory");
#undef AT_DMA
}
__device__ __forceinline__ void attn_phase(AT_LAS char* lds, int wid0, const pg8::Place& pl, const bf16_t* Q, const bf16_t* KN, const bf16_t* KR, const bf16_t* V, const float* goa, bf16_t* Y, float* ssqy) {
    const int nbh = 128 / pl.nx, bh0 = pl.jx * nbh;
    for (int idx = pl.rank; idx < 2 * nbh; idx += pl.nloc) { const int bh = bh0 + (idx >> 1), s = idx & 1;
        for (int i = 0; i < 4; ++i) { const int qb = (i == 0) ? s : (i == 1) ? 7 - s : (i == 2) ? 2 + s : 5 - s;
            attn_unit<8>(bh >> 3, bh & 7, qb, Q, KN, KR, V, goa, Y, ssqy, lds, wid0); } }
}
}

constexpr int NWAVES = 8;
struct Args { const void* in[20]; float* out; unsigned char* ws; int ph_lo, ph_hi, li, flags; };
namespace pro {
#define PR_LAS __attribute__((address_space(3)))
__device__ __forceinline__ unsigned pk2(float lo, float hi) { return (unsigned)f2bf(lo) | ((unsigned)f2bf(hi) << 16); }
template <int MODE  >
__device__ __forceinline__ void tr_item(const float* W, int ldw, bf16_t* WT, int out_ld, int out_koff, int nblk, PR_LAS float* scr, int item, int lane) {
    const int kb = item / nblk, nb = item - kb * nblk, k0 = 64 * kb, n0 = 32 * nb;
    const int pn = n0 + (lane & 31); const int sc0 = MODE == 0 ? pn : (MODE == 1 ? win_src(pn) : wup_qcol(pn));
    const int sc = sc0 >= 0 ? sc0 : 0; const float msk = sc0 >= 0 ? 1.f : 0.f;
    const float* wp = W + (size_t)(k0 + (lane >> 5)) * ldw + sc;
    float v[32];
#pragma unroll
    for (int i = 0; i < 32; ++i) v[i] = wp[(size_t)(2 * i) * ldw];
#pragma unroll
    for (int i = 0; i < 32; ++i) scr[(2 * i + (lane >> 5)) * 33 + (lane & 31)] = v[i] * msk;
    asm volatile("s_waitcnt lgkmcnt(0)" ::: "memory");
    const int c = lane & 7;
#pragma unroll
    for (int j = 0; j < 4; ++j) { const int n = (lane >> 3) + 8 * j; const PR_LAS float* s = scr + (8 * c) * 33 + n;
        pg8::u32x4 o; o.x = pk2(s[0 * 33], s[1 * 33]); o.y = pk2(s[2 * 33], s[3 * 33]); o.z = pk2(s[4 * 33], s[5 * 33]); o.w = pk2(s[6 * 33], s[7 * 33]);
        *(pg8::u32x4*)(WT + (size_t)(n0 + n) * out_ld + out_koff + k0 + 8 * c) = o; }
    asm volatile("s_waitcnt lgkmcnt(0)" ::: "memory");
}
__device__ __forceinline__ void smallm_unit(PR_LAS unsigned char* lds, int tid, const float* in, int in_stride, bool act, const float* W, int ldw, int N, bool winmap, const float* bias, float* out, int out_stride, int p0, int ucols) {
    PR_LAS float* sin_ = (PR_LAS float*)lds; PR_LAS float* red = (PR_LAS float*)(lds + 65536);
    const int lane = tid & 63, wave = tid >> 6;
#pragma unroll 8
    for (int e = tid; e < 16 * 1024; e += 512) { const int b = e >> 10, k = e & 1023; float v = in[(size_t)b * in_stride + k]; if (act) v = v * __builtin_amdgcn_rcpf(1.f + __expf(-v)); sin_[k * 16 + b] = v; }
    __syncthreads();
    const int p = p0 + lane; const int s0 = winmap ? win_src(p) : p; const bool ok = (lane < ucols && s0 >= 0 && s0 < N);
    const int sc = ok ? s0 : 0; const float msk = ok ? 1.f : 0.f;
    const float* wp = W + (size_t)(wave * 128) * ldw + sc;
    float acc[16];
#pragma unroll
    for (int b = 0; b < 16; ++b) acc[b] = 0.f;
    for (int k0 = 0; k0 < 128; k0 += 32) {
        float w[32];
#pragma unroll
        for (int j = 0; j < 32; ++j) w[j] = wp[(size_t)(k0 + j) * ldw];
#pragma unroll
        for (int j = 0; j < 32; ++j) { const PR_LAS f32x4* sp = (const PR_LAS f32x4*)(sin_ + (wave * 128 + k0 + j) * 16);
#pragma unroll
            for (int q = 0; q < 4; ++q) { const f32x4 v = sp[q]; acc[4 * q] += v[0] * w[j]; acc[4 * q + 1] += v[1] * w[j]; acc[4 * q + 2] += v[2] * w[j]; acc[4 * q + 3] += v[3] * w[j]; } }
    }
#pragma unroll
    for (int b = 0; b < 16; ++b) red[(wave * 64 + lane) * 16 + b] = acc[b] * msk;
    __syncthreads();
    for (int e = tid; e < 64 * 16; e += 512) { const int l = e >> 4, b = e & 15; float sum = 0.f;
#pragma unroll
        for (int w = 0; w < 8; ++w) sum += red[(w * 64 + l) * 16 + b];
        if (l < ucols) out[(size_t)b * out_stride + p0 + l] = sum + (bias ? bias[p0 + l] : 0.f); }
    __syncthreads();
}
__device__ __forceinline__ float wsum(float v) {
    v += __int_as_float(__builtin_amdgcn_ds_swizzle(__float_as_int(v), 0x041F)); v += __int_as_float(__builtin_amdgcn_ds_swizzle(__float_as_int(v), 0x081F));
    v += __int_as_float(__builtin_amdgcn_ds_swizzle(__float_as_int(v), 0x101F)); v += __int_as_float(__builtin_amdgcn_ds_swizzle(__float_as_int(v), 0x201F));
    v += __int_as_float(__builtin_amdgcn_ds_swizzle(__float_as_int(v), 0x401F));
    auto rr = __builtin_amdgcn_permlane32_swap(__float_as_uint(v), __float_as_uint(v), false, false); return __uint_as_float(rr[0]) + __uint_as_float(rr[1]);
}
__device__ __forceinline__ void phase0a(PR_LAS unsigned char* lds, int wid0, int vcu, int G, const Args& args, int zi, unsigned char* ws) {
    int tid_ = wid0 * 64 + lane_id(); asm volatile("" : "+v"(tid_));
    const int tid = tid_, lane = tid & 63, wave = tid >> 6;
#define PIN(i) ((const float*)args.in[(i) + zi])
    for (int un = vcu; un < DEPTH * (NMOD / 48); un += G) { const int l = un / (NMOD / 48), p0 = (un % (NMOD / 48)) * 48;
        smallm_unit(lds, tid, PIN(1), DM, true, PIN(3) + (size_t)l * DM * NMOD, NMOD, NMOD, false, PIN(4) + (size_t)l * NMOD, (float*)(ws + WS_MOD) + (size_t)l * NB * NMOD, NMOD, p0, 48); }
    { const int* pos = (const int*)args.in[2 + zi]; float* rope = (float*)(ws + WS_ROPE);
      for (int idx = vcu * 512 + tid; idx < T * 16; idx += G * 512) { const int t = idx >> 4, i = idx & 15;
          const float freq = exp2f(-(float)i * (13.287712379549449f / 16.0f)); const float ang = (float)pos[t] * freq;
          rope[t * 32 + i] = cosf(ang); rope[t * 32 + 16 + i] = sinf(ang); } }
    { const float* gws = PIN(7); bf16_t* gw = (bf16_t*)(ws + WS_GW);
      for (int idx = vcu * 512 + tid; idx < DEPTH * NGRP * CHUNK * CHUNK; idx += G * 512) { const int s = idx & 127, t = (idx >> 7) & 127; gw[idx] = (s <= t) ? f2bf(gws[idx]) : (bf16_t)0; } }
    PR_LAS float* scr = (PR_LAS float*)(lds + wave * 16384);
    const int gw_ = vcu * NWAVES + wave, NGW = G * NWAVES;
    constexpr int I_IN = (DM / 64) * (NIN / 32), I_UQ = (QR / 64) * (768 / 32), I_UKV = (KVR / 64) * (1024 / 32), I_OUT = (DM / 64) * (DM / 32), I_1 = (DM / 64) * (DFF / 32), I_2 = (DFF / 64) * (DM / 32);
    constexpr int I_LAYER = I_IN + I_UQ + I_UKV + I_OUT + I_1 + I_2;
    for (int it = gw_; it < DEPTH * I_LAYER; it += NGW) {
        const int l = it / I_LAYER; int r = it - l * I_LAYER; unsigned char* wl = ws + WS_W + (size_t)l * WL_STRIDE;
        if (r < I_IN) { tr_item<1>(PIN(6) + (size_t)l * DM * DIN, DIN, (bf16_t*)(wl + WL_IN), DM, 0, NIN / 32, scr, r, lane); continue; } r -= I_IN;
        if (r < I_UQ) { tr_item<2>(PIN(11) + (size_t)l * QR * 768, 768, (bf16_t*)(wl + WL_UQ), QR, 0, 768 / 32, scr, r, lane); continue; } r -= I_UQ;
        if (r < I_UKV) { tr_item<0>(PIN(12) + (size_t)l * KVR * 1024, 1024, (bf16_t*)(wl + WL_UKV), KVR, 0, 1024 / 32, scr, r, lane); continue; } r -= I_UKV;
        if (r < I_OUT) { tr_item<0>(PIN(15) + (size_t)l * DM * DM, DM, (bf16_t*)(wl + WL_OUT), DM, 0, DM / 32, scr, r, lane); continue; } r -= I_OUT;
        if (r < I_1) { tr_item<0>(PIN(17) + (size_t)l * DM * DFF, DFF, (bf16_t*)(wl + WL_1), DM, 0, DFF / 32, scr, r, lane); continue; } r -= I_1;
        tr_item<0>(PIN(18) + (size_t)l * DFF * DM, DM, (bf16_t*)(wl + WL_2), DFF, 0, DM / 32, scr, r, lane);
    }
#undef PIN
}
__device__ __forceinline__ void phase0b(PR_LAS unsigned char* lds, int wid0, int vcu, int G, const Args& args, int zi, unsigned char* ws) {
    int tid_ = wid0 * 64 + lane_id(); asm volatile("" : "+v"(tid_));
    const int tid = tid_, lane = tid & 63, wave = tid >> 6;
#define PIN(i) ((const float*)args.in[(i) + zi])
    float* MOD = (float*)(ws + WS_MOD);
    constexpr int U1 = NIN / 48, U2 = DFF / 64, NUNITS = DEPTH * (U1 + U2);
    for (int un = vcu; un < NUNITS; un += G) { const int l = un / (U1 + U2), r = un % (U1 + U2); const float* modl = MOD + (size_t)l * NB * NMOD;
        if (r < U1) smallm_unit(lds, tid, modl, NMOD, false, PIN(6) + (size_t)l * DM * DIN, DIN, DIN, true, nullptr, (float*)(ws + WS_SHW1) + (size_t)l * NB * NIN, NIN, r * 48, 48);
        else smallm_unit(lds, tid, modl + 3 * DM, NMOD, false, PIN(17) + (size_t)l * DM * DFF, DFF, DFF, false, nullptr, (float*)(ws + WS_SHW2) + (size_t)l * NB * DFF, DFF, (r - U1) * 64, 64); }
    for (int idx = vcu * 512 + tid; idx < DEPTH * NB * DM; idx += G * 512) { const int c = idx & 1023, b = (idx >> 10) & 15, l = idx >> 14; const float* m = MOD + ((size_t)l * NB + b) * NMOD;
        ((float*)(ws + WS_GM1))[idx] = PIN(5)[l * DM + c] * (1.f + m[1 * DM + c]); ((float*)(ws + WS_GM2))[idx] = PIN(16)[l * DM + c] * (1.f + m[4 * DM + c]); }
    { const float* x = PIN(0); const float* g = PIN(5); bf16_t* A = (bf16_t*)(ws + WS_A); float* ssq = (float*)(ws + WS_SSQ1);
      const int nun = NUNITS < G ? NUNITS : G; const int wgt = vcu < nun ? 7 : 12, slot0 = vcu < nun ? 7 * vcu : 7 * nun + 12 * (vcu - nun), nslot = 7 * nun + 12 * (G - nun);
      for (int sl = 0; sl < wgt; ++sl)
      for (int row0 = (slot0 + sl) * NWAVES + wave; row0 < T; row0 += 2 * nslot * NWAVES) {
          const int row1 = row0 + nslot * NWAVES; const bool two = row1 < T; const int rowb = two ? row1 : row0;
          f32x4 va[4], vb[4];
#pragma unroll
          for (int j = 0; j < 4; ++j) { va[j] = ((const f32x4*)(x + (size_t)row0 * DM))[lane + 64 * j]; vb[j] = ((const f32x4*)(x + (size_t)rowb * DM))[lane + 64 * j]; }
#pragma unroll
          for (int rr = 0; rr < 2; ++rr) { if (rr == 1 && !two) break; const int row = rr ? row1 : row0; const int b = row / SEQ; const float* sc = MOD + (size_t)b * NMOD + DM; float s = 0.f;
#pragma unroll
              for (int j = 0; j < 4; ++j) { const f32x4 v = rr ? vb[j] : va[j]; s += pg8::hsq4(v); const int c = 4 * (lane + 64 * j); const f32x4 gv = *(const f32x4*)(g + c), sv = *(const f32x4*)(sc + c);
                  *(pg8::u32x2*)(A + (size_t)row * DM + c) = pg8::pack4(v * gv * (sv + 1.f)); }
              s = wsum(s); if (lane < 16) ssq[(size_t)row * 16 + lane] = (lane == 0) ? s : 0.f; } } }
#undef PIN
}
__device__ __forceinline__ void phase_final(int wid0, const pg8::Place& pl, const float* g, const bf16_t* xb, float* dst) {
    int tid_ = wid0 * 64 + lane_id(); asm volatile("" : "+v"(tid_));
    const int lane = tid_ & 63, wave = tid_ >> 6, nr = T / pl.nx, r0 = pl.jx * nr;
    for (int lr = pl.rank * NWAVES + wave; lr < nr; lr += pl.nloc * NWAVES) { const int row = r0 + lr;
        const pg8::u32x4* xr = (const pg8::u32x4*)(xb + (size_t)row * (2 * DM) + DM); f32x4* yr = (f32x4*)(dst + (size_t)row * DM); f32x4 v[4]; float s = 0.f;
#pragma unroll
        for (int j = 0; j < 2; ++j) { const pg8::u32x4 w = xr[lane + 64 * j]; v[2 * j] = pg8::bf_lo4(w); v[2 * j + 1] = pg8::bf_hi4(w); s += pg8::hsq4(v[2 * j]) + pg8::hsq4(v[2 * j + 1]); }
        const float rstd = rsqrtf(wsum(s) * (1.f / DM) + EPS);
#pragma unroll
        for (int j = 0; j < 2; ++j) { const int c = 8 * (lane + 64 * j); const f32x4 g0 = *(const f32x4*)(g + c), g1 = *(const f32x4*)(g + c + 4); yr[2 * (lane + 64 * j)] = v[2 * j] * rstd * g0; yr[2 * (lane + 64 * j) + 1] = v[2 * j + 1] * rstd * g1; } }
}
}

constexpr int RING_BYTES = 131072;
constexpr int LDSCTL_OFF = 135168, MISC_OFF = LDSCTL_OFF + 320;
constexpr int LDS_BYTES = 147456;
static_assert(att::LDS_BYTES <= LDSCTL_OFF, "attention scratch below the control words");
constexpr int CW_BAR = 4096;
constexpr size_t CTL_ZERO_BYTES = 128 * 1024;

#define GAS __attribute__((address_space(1)))
#define LAS __attribute__((address_space(3)))
typedef GAS unsigned gu32;
#define RLX_AGENT __ATOMIC_RELAXED, __HIP_MEMORY_SCOPE_AGENT
#define XB_TMO      128
#define XB_XCNT(j)  (256  + 64 * (j))
#define XB_XSUB(j)  (1280 + 64 * (j))
#define XB_XGEN(j)  (2304 + 64 * (j))
#define XB_TOP      3328
#define XB_TOPGEN   3392
#define XCD_BAR_WORDS 3456
#define XB_SPIN_CAP (1u << 18)
__device__ __forceinline__ unsigned xb_ld(unsigned* p)              { return __hip_atomic_load(p, __ATOMIC_RELAXED, __HIP_MEMORY_SCOPE_AGENT); }
__device__ __forceinline__ unsigned xb_add(unsigned* p, unsigned v) { return __hip_atomic_fetch_add(p, v, __ATOMIC_RELAXED, __HIP_MEMORY_SCOPE_AGENT); }
__device__ __forceinline__ unsigned xb_xcc_id() { return (unsigned)__builtin_amdgcn_s_getreg((3 << 11) | 20) & 0xFu; }
#define XB_SPIN(cond, bar) do { unsigned _sp = 0; while (cond) { __builtin_amdgcn_s_sleep(1); \
    if ((++_sp & 255u) == 0u) { if (xb_ld(&(bar)[XB_TMO])) break; if (_sp > XB_SPIN_CAP) { atomicAdd(&(bar)[XB_TMO], 1u); break; } } } } while (0)
struct XcdBarrier { unsigned* bar; unsigned x; volatile LAS unsigned* st; };
__device__ __forceinline__ XcdBarrier xcd_barrier_post(unsigned* bar, volatile LAS unsigned* st, int wid0) {
    XcdBarrier b; b.bar = bar; b.x = xb_xcc_id(); b.st = st;
    if (wid0 == 0 && lane_id() == 0) (void)xb_add(&bar[XB_XCNT(b.x)], 1u);
    return b;
}
__device__ __forceinline__ void xcd_barrier_complete(unsigned* bar, unsigned x, unsigned& nloc, unsigned& nx) {
    const unsigned G = gridDim.x * gridDim.y * gridDim.z;
    unsigned sum, cnt, mine, sp = 0u;
    for (;;) {
        sum = 0u; cnt = 0u; mine = 0u;
#pragma unroll
        for (unsigned j = 0; j < 16; ++j) { const unsigned c = xb_ld(&bar[XB_XCNT(j)]); sum += c; cnt += (c > 0u) ? 1u : 0u; mine = (j == x) ? c : mine; }
        if (sum == G) break;
        __builtin_amdgcn_s_sleep(1);
        if ((++sp & 255u) == 0u) { if (xb_ld(&bar[XB_TMO])) break; if (sp > XB_SPIN_CAP) { atomicAdd(&bar[XB_TMO], 1u); break; } }
    }
    nloc = mine > 0u ? mine : 1u; nx = cnt > 0u ? cnt : 1u;
}
__device__ __forceinline__ void xcd_barrier(const XcdBarrier& b, int wid0) {
    asm volatile("s_waitcnt vmcnt(0)" ::: "memory");
    __syncthreads();
    if (wid0 == 0 && lane_id() == 0) {
        unsigned zo = 0; asm volatile("" : "+s"(zo));
        unsigned* bar = b.bar + zo;
        __builtin_amdgcn_s_waitcnt(0);
        unsigned nloc = b.st[0], nx = b.st[1];
        if (nloc == 0u) { xcd_barrier_complete(bar, b.x, nloc, nx); b.st[0] = nloc; b.st[1] = nx; }
        const unsigned old = xb_add(&bar[XB_XSUB(b.x)], 1u);
        const unsigned gen = old / nloc;
        if (old + 1u == (gen + 1u) * nloc) {
            __builtin_amdgcn_fence(__ATOMIC_RELEASE, "agent");
            asm volatile("s_waitcnt vmcnt(0)" ::: "memory");
            const unsigned og = xb_add(&bar[XB_TOP], 1u);
            const unsigned tg = og / nx;
            if (og + 1u == (tg + 1u) * nx) xb_add(&bar[XB_TOPGEN], 1u);
            else XB_SPIN(xb_ld(&bar[XB_TOPGEN]) == tg, bar);
            __builtin_amdgcn_fence(__ATOMIC_ACQUIRE, "agent");
            xb_add(&bar[XB_XGEN(b.x)], 1u);
            asm volatile("s_waitcnt vmcnt(0)" ::: "memory");
        } else {
            XB_SPIN(xb_ld(&bar[XB_XGEN(b.x)]) == gen, bar);
            __builtin_amdgcn_fence(__ATOMIC_ACQUIRE, "agent");
            asm volatile("s_waitcnt vmcnt(0)" ::: "memory");
        }
    }
    __syncthreads();
}

#define XB_LCNT(j)  (3 * XCD_BAR_WORDS + 64 * (j))
__device__ __forceinline__ void placement_init(unsigned* bar, volatile LAS unsigned* st  , int wid0) {
    if (wid0 == 0 && lane_id() == 0) {
        const unsigned x = xb_xcc_id(), G = gridDim.x;
        const unsigned rank = xb_add(&bar[XB_XCNT(x)], 1u);
        unsigned c[16], sum, sp = 0u;
        for (;;) { sum = 0u;
#pragma unroll
            for (unsigned j = 0; j < 16; ++j) { c[j] = xb_ld(&bar[XB_XCNT(j)]); sum += c[j]; }
            if (sum == G) break;
            __builtin_amdgcn_s_sleep(1);
            if ((++sp & 255u) == 0u) { if (xb_ld(&bar[XB_TMO])) break; if (sp > XB_SPIN_CAP) { atomicAdd(&bar[XB_TMO], 1u); break; } } }
        unsigned nx = 0u, jx = 0u, mine = 1u; bool even = true;
#pragma unroll
        for (unsigned j = 0; j < 16; ++j) { if (c[j] > 0u) { if (j < x) ++jx; ++nx; } if (j == x) mine = c[j] > 0u ? c[j] : 1u; }
#pragma unroll
        for (unsigned j = 0; j < 16; ++j) if (c[j] > 0u && c[j] != mine) even = false;
        if (nx == 0u) nx = 1u;
        st[0] = mine; st[1] = nx;
        const bool local = even && (mine % 8u == 0u) && (16u % nx == 0u) && sum == G;
        st[2] = local ? jx : 0u; st[3] = local ? rank : blockIdx.x; st[4] = local ? mine : G; st[5] = local ? nx : 1u; st[6] = 0u; st[7] = local ? 1u : 0u;
    }
    __syncthreads();
}
__device__ __forceinline__ void xcd_local_barrier(unsigned* bar, volatile LAS unsigned* st, int wid0) {
    asm volatile("s_waitcnt vmcnt(0)" ::: "memory");
    __syncthreads();
    if (wid0 == 0 && lane_id() == 0) {
        unsigned zo = 0; asm volatile("" : "+s"(zo));
        unsigned* cnt = bar + zo + XB_LCNT(xb_xcc_id());
        const unsigned e = st[6] + 1u; st[6] = e; const unsigned target = e * st[4];
        xb_add(cnt, 1u);
        XB_SPIN(xb_ld(cnt) < target, bar);
        __builtin_amdgcn_fence(__ATOMIC_ACQUIRE, "agent");
        asm volatile("s_waitcnt vmcnt(0)" ::: "memory");
    }
    __syncthreads();
}

constexpr int PH_P0A = 0, PH_P0B = 1, PH_L0 = 2, PH_PER_LAYER = 7, PH_FINAL = PH_L0 + DEPTH * PH_PER_LAYER, PH_END = PH_FINAL + 1;

#ifdef PROBE_SEL
#define MK_STAMP(i) do { if (wid0 == 0 && lane_id() == 0) ((volatile LAS unsigned long long*)(L + LDSCTL_OFF + 1024))[(i)] = __builtin_amdgcn_s_memrealtime(); } while (0)
#else
#define MK_STAMP(i) do {} while (0)
#endif
#define MK_IN_(k) (lo <= (k) && (k) < hi)
#define MK_BAR() XcdBarrier bar; bar.bar = (unsigned*)(args.ws + WS_CTL) + CW_BAR + __builtin_amdgcn_readfirstlane(args.li) * XCD_BAR_WORDS; bar.x = xb_xcc_id(); bar.st = MISC + 8
#define MK_SEAM(k) do { if (MK_IN_(k) && MK_IN_((k) + 1)) { MK_BAR(); xcd_barrier(bar, wid0); } } while (0)
#define MK_SEAM_L(k) do { if (MK_IN_(k) && MK_IN_((k) + 1)) { MK_BAR(); if (__builtin_amdgcn_readfirstlane((int)MISC[15]) != 0) xcd_local_barrier(bar.bar, bar.st, wid0); else xcd_barrier(bar, wid0); } } while (0)
#define MK_PLACE() pg8::Place pl; pl.jx = __builtin_amdgcn_readfirstlane((int)MISC[10]); pl.rank = __builtin_amdgcn_readfirstlane((int)MISC[11]); pl.nloc = __builtin_amdgcn_readfirstlane((int)MISC[12]); pl.nx = __builtin_amdgcn_readfirstlane((int)MISC[13])
#define MK_TAB ((volatile LAS int*)(L + LDSCTL_OFF + 512))
#define MK_PTRS() int zi = 0; asm volatile("" : "+s"(zi)); unsigned char* ws = args.ws + zi; float* out = args.out + zi; (void)out; (void)ws
#define INP(i) ((const float*)args.in[(i) + zi])
#define MK_RB(o, p) (ws + WS_U + (size_t)pl.jx * ((size_t)(T / pl.nx) * 8192) + (size_t)(T / pl.nx) * (o) - (size_t)pl.jx * (T / pl.nx) * (p))
#define RB_U MK_RB(0, 1024)
#define RB_VN MK_RB(1024, 1024)
#define RB_CQ MK_RB(2048, 512)
#define RB_CKV MK_RB(2560, 256)
#define RB_KR MK_RB(2816, 64)
#define RB_Q MK_RB(2880, 1536)
#define RB_KN MK_RB(4416, 1024)
#define RB_V MK_RB(5440, 1024)
#define RB_H MK_RB(0, 8192)
template <int l>
__device__ __forceinline__ void layer_phases(const Args& args, LAS unsigned char* L, volatile LAS unsigned* MISC, int wid0, int lo, int hi) {
    constexpr int P = PH_L0 + l * PH_PER_LAYER;
    if (MK_IN_(P + 0)) { MK_STAMP(2 * (P + 0)); MK_PTRS(); MK_PLACE();
        pg8::Gemm g{(bf16_t*)(ws + WS_A), (const bf16_t*)(ws + WS_W + (size_t)l * WL_STRIDE + WL_IN), T, NIN, DM, DM};
        pg8::FusedInOrder SF; SF.init(pl); pg8::XcdOrder<NIN / 256> S0; S0.init(pl); const pg8::LdsOrder S = SF.ok ? pg8::fill_order(MK_TAB, SF, wid0) : pg8::fill_order(MK_TAB, S0, wid0);
        pg8::EpiIn E{(float*)(ws + WS_SSQ1), (float*)(ws + WS_SHW1) + (size_t)l * NB * NIN, INP(9) + l * QR, INP(10) + l * KVR, (float*)(ws + WS_ROPE), (bf16_t*)RB_U, (bf16_t*)RB_VN, (bf16_t*)RB_CQ, (bf16_t*)RB_CKV, (bf16_t*)RB_KR, (float*)(ws + WS_SSQQ)};
        pg8::gemm_phase<pg8::EpiIn, pg8::LdsOrder, true, true>(L, g, S, E, wid0); }
    MK_STAMP(2 * (P + 0) + 1);
    if (MK_IN_(P + 0) && MK_IN_(P + 1)) { MK_PLACE(); if (!(pl.nloc == 32 && pl.nx == 8)) { MK_BAR(); if (__builtin_amdgcn_readfirstlane((int)MISC[15]) != 0) xcd_local_barrier(bar.bar, bar.st, wid0); else xcd_barrier(bar, wid0); } }
    if (MK_IN_(P + 1)) { MK_STAMP(2 * (P + 1));
        { MK_PTRS(); MK_PLACE(); pg8::Gemm g{(bf16_t*)RB_CQ, (const bf16_t*)(ws + WS_W + (size_t)l * WL_STRIDE + WL_UQ), T, 768, QR, QR};
          pg8::FusedUqOrder SF; SF.init(pl); pg8::XcdOrder<3> S0; S0.init(pl); const pg8::LdsOrder S = SF.ok ? pg8::fill_order(MK_TAB, SF, wid0) : pg8::fill_order(MK_TAB, S0, wid0);
          pg8::EpiUp<false> E{(float*)(ws + WS_SSQQ), (float*)(ws + WS_ROPE), (bf16_t*)RB_Q, nullptr, nullptr};
          pg8::gemm_phase<pg8::EpiUp<false>, pg8::LdsOrder, true, true>(L, g, S, E, wid0); }
        { MK_PTRS(); MK_PLACE(); pg8::Gemm g{(bf16_t*)RB_CKV, (const bf16_t*)(ws + WS_W + (size_t)l * WL_STRIDE + WL_UKV), T, 1024, KVR, KVR};
          pg8::FusedUkvOrder SF; SF.init(pl); pg8::XcdKvOrder S0; S0.init(pl); const pg8::LdsOrder S = SF.ok ? pg8::fill_order(MK_TAB, SF, wid0) : pg8::fill_order(MK_TAB, S0, wid0);
          pg8::EpiUp<true> E{(float*)(ws + WS_SSQQ), nullptr, nullptr, (bf16_t*)RB_KN, (bf16_t*)RB_V};
          pg8::gemm_phase<pg8::EpiUp<true>, pg8::LdsOrder, true, true>(L, g, S, E, wid0); }
        MK_STAMP(2 * (P + 1) + 1); }
    MK_SEAM_L(P + 1);
    if (MK_IN_(P + 2)) { MK_STAMP(2 * (P + 2)); MK_PTRS(); MK_PLACE();
        gm::gmlp_phase(L, wid0, pl, (bf16_t*)RB_U, (bf16_t*)RB_VN, (bf16_t*)(ws + WS_GW) + (size_t)l * NGRP * CHUNK * CHUNK, INP(8) + l * NGRP * CHUNK, INP(13) + l * DG, (bf16_t*)out, (float*)(ws + WS_SSQY)); }
    MK_STAMP(2 * (P + 2) + 1);
    if (MK_IN_(P + 3)) { MK_STAMP(2 * (P + 3)); MK_PTRS(); MK_PLACE();
        att::attn_phase((LAS char*)L, wid0, pl, (bf16_t*)RB_Q, (bf16_t*)RB_KN, (bf16_t*)RB_KR, (bf16_t*)RB_V, INP(14) + l * DG, (bf16_t*)out, (float*)(ws + WS_SSQY)); }
    MK_STAMP(2 * (P + 3) + 1); MK_SEAM_L(P + 3);
    if (MK_IN_(P + 4)) { MK_STAMP(2 * (P + 4)); MK_PTRS(); MK_PLACE();
        pg8::Gemm g{(const bf16_t*)out, (const bf16_t*)(ws + WS_W + (size_t)l * WL_STRIDE + WL_OUT), T, DM, DM, YLD};   pg8::XcdOrder<4> S0; S0.init(pl); const pg8::LdsOrder S = pg8::fill_order(MK_TAB, S0, wid0);
        pg8::EpiRes<true, l == 0> E{(float*)(ws + WS_SSQY), l == 0 ? (const void*)INP(0) : (const void*)out, (bf16_t*)out, (float*)(ws + WS_MOD) + (size_t)l * NB * NMOD + 2 * DM, (float*)(ws + WS_GM2) + (size_t)l * NB * DM, (bf16_t*)(ws + WS_A), (float*)(ws + WS_SSQ2)};
        pg8::gemm_phase<pg8::EpiRes<true, l == 0>, pg8::LdsOrder, true, true>(L, g, S, E, wid0); }
    MK_STAMP(2 * (P + 4) + 1); MK_SEAM_L(P + 4);
    if (MK_IN_(P + 5)) { MK_STAMP(2 * (P + 5)); MK_PTRS(); MK_PLACE();
        pg8::Gemm g{(bf16_t*)(ws + WS_A), (const bf16_t*)(ws + WS_W + (size_t)l * WL_STRIDE + WL_1), T, DFF, DM, DM}; pg8::XcdOrder<16> S0; S0.init(pl); const pg8::LdsOrder S = pg8::fill_order(MK_TAB, S0, wid0);
        pg8::EpiFf1 E{(float*)(ws + WS_SSQ2), (float*)(ws + WS_SHW2) + (size_t)l * NB * DFF, (bf16_t*)RB_H};
        pg8::gemm_phase<pg8::EpiFf1, pg8::LdsOrder, true, true>(L, g, S, E, wid0); }
    MK_STAMP(2 * (P + 5) + 1); MK_SEAM_L(P + 5);
    if (MK_IN_(P + 6)) { MK_STAMP(2 * (P + 6)); MK_PTRS(); MK_PLACE();
        pg8::Gemm g{(bf16_t*)RB_H, (const bf16_t*)(ws + WS_W + (size_t)l * WL_STRIDE + WL_2), T, DM, DFF, DFF}; pg8::XcdOrder<4> S0; S0.init(pl); const pg8::LdsOrder S = pg8::fill_order(MK_TAB, S0, wid0);
        pg8::EpiRes<false, false> E{nullptr, (const void*)out, (bf16_t*)out, (float*)(ws + WS_MOD) + (size_t)l * NB * NMOD + 5 * DM, (l + 1 < DEPTH) ? (float*)(ws + WS_GM1) + (size_t)(l + 1) * NB * DM : nullptr, (bf16_t*)(ws + WS_A), (float*)(ws + WS_SSQ1)};
        pg8::gemm_phase<pg8::EpiRes<false, false>, pg8::LdsOrder, true, true>(L, g, S, E, wid0); }
    MK_STAMP(2 * (P + 6) + 1); MK_SEAM_L(P + 6);
}
__global__ void __launch_bounds__(NWAVES * 64, 2) mk_fwd(Args args) {
    extern __shared__ __attribute__((aligned(16))) unsigned char lds[];
    LAS unsigned char* L = (LAS unsigned char*)lds;
    volatile LAS unsigned* MISC = (volatile LAS unsigned*)(L + MISC_OFF);
    const int wid0 = __builtin_amdgcn_readfirstlane((int)threadIdx.x >> 6);
    const int G = gridDim.x, bx = blockIdx.x;
    { const int t0 = wid0 * 64 + lane_id(); for (int u = t0; u < (LDS_BYTES - LDSCTL_OFF) / 4; u += NWAVES * 64) ((LAS unsigned*)(L + LDSCTL_OFF))[u] = 0u; }
    __syncthreads();
    const int lo = __builtin_amdgcn_readfirstlane(args.ph_lo), hi = __builtin_amdgcn_readfirstlane(args.ph_hi);
    unsigned* barw = (unsigned*)(args.ws + WS_CTL) + CW_BAR + __builtin_amdgcn_readfirstlane(args.li) * XCD_BAR_WORDS;
    placement_init(barw, MISC + 8, wid0);
    if (MK_IN_(PH_P0A)) { MK_STAMP(2 * (PH_P0A)); MK_PTRS(); MK_PLACE(); pro::phase0a(L, wid0, pl.jx * pl.nloc + pl.rank, G, args, zi, ws); }
    MK_STAMP(2 * PH_P0A + 1); MK_SEAM(PH_P0A);
    if (MK_IN_(PH_P0B)) { MK_STAMP(2 * (PH_P0B)); MK_PTRS(); MK_PLACE(); pro::phase0b(L, wid0, pl.jx * pl.nloc + pl.rank, G, args, zi, ws); }
    MK_STAMP(2 * PH_P0B + 1); MK_SEAM(PH_P0B);
    layer_phases<0>(args, L, MISC, wid0, lo, hi);
    layer_phases<1>(args, L, MISC, wid0, lo, hi);
    if (MK_IN_(PH_FINAL)) { MK_STAMP(2 * (PH_FINAL)); MK_PTRS(); MK_PLACE(); pro::phase_final(wid0, pl, INP(19), (const bf16_t*)out, out); }
    MK_STAMP(2 * PH_FINAL + 1);
#ifdef PROBE_SEL
    if (bx == 0 && wid0 == 0 && lane_id() == 0) {
        volatile LAS unsigned long long* st = (volatile LAS unsigned long long*)(L + LDSCTL_OFF + 1024); unsigned long long sel = 0;
        if (PROBE_SEL >= 0) sel = st[2 * PROBE_SEL + 1] - st[2 * PROBE_SEL];
        else { for (int k = 0; k < PH_FINAL; ++k) if (k != PH_L0 + 2 && k != PH_L0 + PH_PER_LAYER + 2) { int nx = k + 1; sel += st[2 * nx] - st[2 * k + 1]; } }
        const unsigned long long t0 = __builtin_amdgcn_s_memrealtime(), t1 = t0 + PROBE_MULT * sel;
        while (__builtin_amdgcn_s_memrealtime() < t1) __builtin_amdgcn_s_sleep(8);
    }
#endif
}

#ifndef ONE_LAUNCH
#define ONE_LAUNCH 1
#endif
#ifndef MK_PRO
#define MK_PRO 1
#endif
#ifndef MK_IN
#define MK_IN 1
#endif
#ifndef MK_UP
#define MK_UP 1
#endif
#ifndef MK_GMLP
#define MK_GMLP 1
#endif
#ifndef MK_ATTN
#define MK_ATTN 1
#endif
#ifndef MK_OUT
#define MK_OUT 1
#endif
#ifndef MK_FF1
#define MK_FF1 1
#endif
#ifndef MK_FF2
#define MK_FF2 1
#endif
template <class Epi> static void gemm_naive(hipStream_t st, const bf16_t* A, int lda, const bf16_t* Bt, int ldb, int M, int N, int K, const Epi& e) {
    hipLaunchKernelGGL((k_gemm_naive<Epi>), dim3(N / 64, M / 64), dim3(256), 0, st, A, lda, Bt, ldb, K, e);
}
static int g_grid = 0;
static void launch_mk(hipStream_t st, Args a, int lo, int hi, int li = 0, int flags = 0) {
    a.ph_lo = lo; a.ph_hi = hi; a.li = li; a.flags = flags;
    hipLaunchKernelGGL(mk_fwd, dim3(g_grid), dim3(NWAVES * 64), LDS_BYTES, st, a);
}
extern "C" void kernel_launch(void* const* d_in, const int* in_sizes, int n_in, void* d_out, int out_size, void* d_ws, size_t ws_size, hipStream_t stream) {
    if (n_in != 20 || out_size != T * DM || ws_size < WS_END) { fprintf(stderr, "kernel_launch: unexpected sizes n_in %d out %d ws %zu\n", n_in, out_size, ws_size); return; }
    if (g_grid == 0) {
        int dev = 0, cus = 0; hipGetDevice(&dev); hipDeviceGetAttribute(&cus, hipDeviceAttributeMultiprocessorCount, dev);
        if (hipFuncSetAttribute((const void*)mk_fwd, hipFuncAttributeMaxDynamicSharedMemorySize, LDS_BYTES) != hipSuccess) fprintf(stderr, "kernel_launch: hipFuncSetAttribute failed\n");
        g_grid = cus > 0 ? cus : 256;
    }
    const float* x = (const float*)d_in[0]; const float* c = (const float*)d_in[1]; const int* pos = (const int*)d_in[2];
    const float* w_ada = (const float*)d_in[3]; const float* b_ada = (const float*)d_in[4]; const float* g_mix = (const float*)d_in[5];
    const float* w_in = (const float*)d_in[6]; const float* g_ws = (const float*)d_in[7]; const float* g_bs = (const float*)d_in[8];
    const float* g_q = (const float*)d_in[9]; const float* g_kv = (const float*)d_in[10]; const float* w_uq = (const float*)d_in[11]; const float* w_ukv = (const float*)d_in[12];
    const float* g_og = (const float*)d_in[13]; const float* g_oa = (const float*)d_in[14]; const float* w_out = (const float*)d_in[15];
    const float* g_ffn = (const float*)d_in[16]; const float* w_ff1 = (const float*)d_in[17]; const float* w_ff2 = (const float*)d_in[18]; const float* g_fin = (const float*)d_in[19];
    unsigned char* ws = (unsigned char*)d_ws; float* out = (float*)d_out;
    float* MOD = (float*)(ws + WS_MOD); float* SHW1 = (float*)(ws + WS_SHW1); float* SHW2 = (float*)(ws + WS_SHW2); float* RT = (float*)(ws + WS_ROPE);
    float* GM1 = (float*)(ws + WS_GM1); float* GM2 = (float*)(ws + WS_GM2);
    float* SSQ1 = (float*)(ws + WS_SSQ1); float* SSQ2 = (float*)(ws + WS_SSQ2); float* SSQY = (float*)(ws + WS_SSQY); float* SSQQ = (float*)(ws + WS_SSQQ);
    bf16_t* GW = (bf16_t*)(ws + WS_GW); bf16_t* A = (bf16_t*)(ws + WS_A); bf16_t* U = (bf16_t*)(ws + WS_U); bf16_t* VN = (bf16_t*)(ws + WS_VN);
    bf16_t* CQKV = (bf16_t*)(ws + WS_CQKV); bf16_t* KR = (bf16_t*)(ws + WS_KR); bf16_t* Q = (bf16_t*)(ws + WS_Q); bf16_t* KN = (bf16_t*)(ws + WS_KN); bf16_t* V = (bf16_t*)(ws + WS_V);
    bf16_t* Y = (bf16_t*)(ws + WS_Y); bf16_t* H = (bf16_t*)(ws + WS_H); float* GV = (float*)(ws + WS_GV); float* ZL = (float*)(ws + WS_ZL); float* QRT = (float*)(ws + WS_QRT);
    auto WL = [&](int l, size_t off) { return (bf16_t*)(ws + WS_W + (size_t)l * WL_STRIDE + off); };
    Args a{}; for (int i = 0; i < 20; ++i) a.in[i] = d_in[i]; a.out = out; a.ws = ws;
    hipMemsetAsync(ws + WS_CTL, 0, CTL_ZERO_BYTES, stream);

#if ONE_LAUNCH
#ifdef PROBE_DUP
    launch_mk(stream, a, 0, PROBE_DUP + 1, 0); launch_mk(stream, a, PROBE_DUP, PROBE_DUP + 1, 1); launch_mk(stream, a, PROBE_DUP + 1, PH_END, 2);
#elif defined(PROBE_FFN2)
    launch_mk(stream, a, 0, PH_FINAL, 0); launch_mk(stream, a, PH_FINAL - 1, PH_FINAL, 1, 1); launch_mk(stream, a, PH_FINAL, PH_END, 2);
#elif defined(PROBE_FINAL)
    launch_mk(stream, a, 0, PH_FINAL, 0); launch_mk(stream, a, PH_FINAL, PH_END, 1, 2); launch_mk(stream, a, PH_FINAL, PH_END, 2);
#else
    launch_mk(stream, a, 0, PH_END);
#endif
    return;
#endif
#if MK_PRO
    launch_mk(stream, a, PH_P0A, PH_P0A + 1);
    launch_mk(stream, a, PH_P0B, PH_P0B + 1);
#else
    hipLaunchKernelGGL(k_rope_table, dim3(T * 16 / 256), dim3(256), 0, stream, pos, RT);
    hipLaunchKernelGGL(k_prep_gw, dim3(DEPTH * NGRP * CHUNK * CHUNK / 256), dim3(256), 0, stream, g_ws, GW);
    for (int l = 0; l < DEPTH; ++l) {
        hipLaunchKernelGGL(k_prep_w, dim3((NIN * DM + 255) / 256), dim3(256), 0, stream, w_in + (size_t)l * DM * DIN, DM, DIN, WL(l, WL_IN), NIN, 1);
        hipLaunchKernelGGL(k_prep_wup, dim3((NUP * KUP + 255) / 256), dim3(256), 0, stream, w_uq + (size_t)l * QR * 768, w_ukv + (size_t)l * KVR * 1024, WL(l, WL_UP));
        hipLaunchKernelGGL(k_prep_w, dim3(DM * DM / 256), dim3(256), 0, stream, w_out + (size_t)l * DM * DM, DM, DM, WL(l, WL_OUT), DM, 0);
        hipLaunchKernelGGL(k_prep_w, dim3(DFF * DM / 256), dim3(256), 0, stream, w_ff1 + (size_t)l * DM * DFF, DM, DFF, WL(l, WL_1), DFF, 0);
        hipLaunchKernelGGL(k_prep_w, dim3(DFF * DM / 256), dim3(256), 0, stream, w_ff2 + (size_t)l * DFF * DM, DFF, DM, WL(l, WL_2), DM, 0);
        hipLaunchKernelGGL(k_smallm, dim3(NMOD / 64), dim3(512), 0, stream, c, DM, 1, w_ada + (size_t)l * DM * NMOD, NMOD, NMOD, 0, b_ada + (size_t)l * NMOD, MOD + (size_t)l * NB * NMOD, NMOD, NMOD);
    }
    for (int l = 0; l < DEPTH; ++l) {
        hipLaunchKernelGGL(k_smallm, dim3(NIN / 64), dim3(512), 0, stream, MOD + (size_t)l * NB * NMOD + 0, NMOD, 0, w_in + (size_t)l * DM * DIN, DIN, DIN, 1, (const float*)nullptr, SHW1 + (size_t)l * NB * NIN, NIN, NIN);
        hipLaunchKernelGGL(k_smallm, dim3(DFF / 64), dim3(512), 0, stream, MOD + (size_t)l * NB * NMOD + 3 * DM, NMOD, 0, w_ff1 + (size_t)l * DM * DFF, DFF, DFF, 0, (const float*)nullptr, SHW2 + (size_t)l * NB * DFF, DFF, DFF);
    }
    hipLaunchKernelGGL(k_gm, dim3(DEPTH * NB * DM / 256), dim3(256), 0, stream, g_mix, MOD, 1, GM1);
    hipLaunchKernelGGL(k_gm, dim3(DEPTH * NB * DM / 256), dim3(256), 0, stream, g_ffn, MOD, 4, GM2);
    hipLaunchKernelGGL(k_modx, dim3(T / 4), dim3(256), 0, stream, x, g_mix, MOD + 1 * DM, NMOD, A, SSQ1);

#endif
    for (int l = 0; l < DEPTH; ++l) {
        const float* modl = MOD + (size_t)l * NB * NMOD; const int P = PH_L0 + l * PH_PER_LAYER;
#if MK_IN
        launch_mk(stream, a, P + 0, P + 1);
#else
        { EpiInNaive e{0, SSQ1, SHW1 + (size_t)l * NB * NIN, U, GV, ZL}; gemm_naive(stream, A, DM, WL(l, WL_IN), DM, T, NIN, DM, e); }
        hipLaunchKernelGGL(k_vn, dim3(T * NGRP / 4), dim3(256), 0, stream, GV, VN);
        hipLaunchKernelGGL(k_lat, dim3(T / 4), dim3(256), 0, stream, ZL, g_q + l * QR, g_kv + l * KVR, RT, CQKV, SSQQ, KR);
#endif
#if MK_UP
        launch_mk(stream, a, P + 1, P + 2);
#else
        { EpiUpNaive e{0, SSQQ, Q, QRT, KN, V}; gemm_naive(stream, CQKV, KUP, WL(l, WL_UP), KUP, T, NUP, KUP, e); }
        hipLaunchKernelGGL(k_rope_q, dim3(T * NH * 16 / 256), dim3(256), 0, stream, QRT, RT, Q);
#endif
#if MK_GMLP
        launch_mk(stream, a, P + 2, P + 3);
#else
        hipLaunchKernelGGL(k_gmlp_naive, dim3(T), dim3(512), 0, stream, U, VN, GW + (size_t)l * NGRP * CHUNK * CHUNK, g_bs + l * NGRP * CHUNK, g_og + l * DG, Y, SSQY);
#endif
#if MK_ATTN
        launch_mk(stream, a, P + 3, P + 4);
#else
        hipLaunchKernelGGL(k_attn_naive, dim3(T / 64, NH), dim3(64), 0, stream, Q, KN, KR, V, g_oa + l * DG, Y, SSQY);
#endif
#if MK_OUT
        launch_mk(stream, a, P + 4, P + 5);
#else
        { EpiOutNaive e{512, SSQY, l == 0 ? x : out, out, modl + 2 * DM}; gemm_naive(stream, Y, DM, WL(l, WL_OUT), DM, T, DM, DM, e); }
        hipLaunchKernelGGL(k_modx, dim3(T / 4), dim3(256), 0, stream, out, g_ffn + l * DM, modl + 4 * DM, NMOD, A, SSQ2);
#endif
#if MK_FF1
        launch_mk(stream, a, P + 5, P + 6);
#else
        { EpiFf1Naive e{0, SSQ2, SHW2 + (size_t)l * NB * DFF, H}; gemm_naive(stream, A, DM, WL(l, WL_1), DM, T, DFF, DM, e); }
#endif
#if MK_FF2
        launch_mk(stream, a, P + 6, P + 7);
#else
        { EpiFf2Naive e{0, out, modl + 5 * DM}; gemm_naive(stream, H, DFF, WL(l, WL_2), DFF, T, DM, DFF, e); }
        if (l + 1 < DEPTH) hipLaunchKernelGGL(k_modx, dim3(T / 4), dim3(256), 0, stream, out, g_mix + (l + 1) * DM, MOD + (size_t)(l + 1) * NB * NMOD + 1 * DM, NMOD, A, SSQ1);
#endif
    }
#if MK_PRO
    launch_mk(stream, a, PH_FINAL, PH_FINAL + 1);
#else
    hipLaunchKernelGGL(k_final, dim3(T / 4), dim3(256), 0, stream, out, g_fin, out);
#endif
}
```

```cpp
#include <hip/hip_runtime.h>
#define PROBE_MULT 8
#include <cstdint>
#include <cstdio>
#include <cmath>

typedef unsigned short bf16_t;
typedef short bf16x8 __attribute__((ext_vector_type(8)));
typedef float f32x4 __attribute__((ext_vector_type(4)));

constexpr int DM = 1024, NB = 16, SEQ = 2048, DEPTH = 2, T = NB * SEQ;
constexpr int DG = 512, NGRP = 8, GD = 64, CHUNK = 128, NH = 8, NOPE = 64, ROPE = 32, VD = 64;
constexpr int QR = 256, KVR = 128, DFF = 4096, DIN = 1440, NMOD = 6 * DM;
constexpr int NIN = 1536;
constexpr int NUP = 1792, KUP = 384;
constexpr float EPS = 1e-6f;
constexpr int YLD = 2 * DM;
constexpr float QSCALE = 0.10206207261596577f * 1.4426950408889634f;

constexpr size_t MiB = 1u << 20;
constexpr size_t WS_CTL = 0;
constexpr size_t WS_MOD = 1 * MiB;
constexpr size_t WS_SHW1 = 2 * MiB;
constexpr size_t WS_GM1 = 2 * MiB + 512 * 1024;
constexpr size_t WS_GM2 = 2 * MiB + 768 * 1024;
constexpr size_t WS_SHW2 = 3 * MiB;
constexpr size_t WS_ROPE = 4 * MiB;
constexpr size_t WS_SSQ1 = 8 * MiB;
constexpr size_t WS_SSQ2 = 10 * MiB;
constexpr size_t WS_SSQY = 12 * MiB;
constexpr size_t WS_SSQQ = 14 * MiB;
constexpr size_t WS_GW = 15 * MiB;
constexpr size_t WS_W = 16 * MiB;
constexpr size_t WL_IN = 0, WL_UP = 3 * MiB, WL_OUT = 4 * MiB + MiB / 2, WL_1 = 6 * MiB + MiB / 2, WL_2 = 14 * MiB + MiB / 2, WL_STRIDE = 22 * MiB + MiB / 2;
constexpr size_t WS_A = 64 * MiB;
constexpr size_t WS_U = 128 * MiB;
constexpr size_t WS_VN = 160 * MiB;
constexpr size_t WS_CQKV = 192 * MiB;
constexpr size_t WS_CQ = 192 * MiB;
constexpr size_t WS_CKV = 208 * MiB;
constexpr size_t WL_UQ = 3 * MiB, WL_UKV = 3 * MiB + MiB / 2;
constexpr size_t WS_KR = 216 * MiB;
constexpr size_t WS_Q = 218 * MiB;
constexpr size_t WS_KN = 266 * MiB;
constexpr size_t WS_V = 298 * MiB;
constexpr size_t WS_Y = 330 * MiB;
constexpr size_t WS_H = 128 * MiB;
constexpr size_t WS_GV = 394 * MiB;
constexpr size_t WS_ZL = 458 * MiB;
constexpr size_t WS_QRT = 394 * MiB;
constexpr size_t WS_DUMMY = 448 * MiB;
constexpr size_t WS_END = 512 * MiB;

__device__ __forceinline__ bf16_t f2bf(float f) { unsigned u = __float_as_uint(f); return (bf16_t)((u + 0x7fffu + ((u >> 16) & 1u)) >> 16); }
__device__ __forceinline__ float bf2f(bf16_t h) { return __uint_as_float(((unsigned)h) << 16); }
__device__ __forceinline__ float gelu_tanh(float x) { const float y2 = -2.302208198f * (x + 0.044715f * x * x * x); return x * __builtin_amdgcn_rcpf(1.f + __builtin_amdgcn_exp2f(y2)); }
__device__ __forceinline__ float wave_sum(float v) {
#pragma unroll
    for (int o = 1; o < 64; o <<= 1) v += __shfl_xor(v, o);
    return v;
}
__host__ __device__ __forceinline__ int win_src(int p) {
    if (p < 512) return p;
    if (p < 1024) { const int q = p - 512, tile = q >> 8, r = q & 255, bj = r >> 7, wc = (r >> 5) & 3, j = r & 31; return 512 + tile * 256 + 64 * wc + 32 * bj + j; }
    if (p < 1408) return p;
    if (p < 1440) { const int j = p - 1408, fq = j >> 3, n = (j >> 2) & 1, i = j & 3; return 1408 + 16 * n + 4 * fq + i; }
    return -1;
}
__host__ __device__ __forceinline__ int wup_qcol(int p) {
    const int G = p >> 5, h = G / 3, gi = G - 3 * h, j = p & 31;
    if (gi < 2) return p;
    const int fq = j >> 3, n = (j >> 2) & 1, i = j & 3; return h * 96 + 64 + 16 * n + 4 * fq + i;
}

__global__ void k_rope_table(const int* pos, float* rope) {
    const int idx = blockIdx.x * blockDim.x + threadIdx.x; if (idx >= T * 16) return;
    const int t = idx >> 4, i = idx & 15;
    const float freq = powf(10000.0f, -(float)(2 * i) / 32.0f);
    const float ang = (float)pos[t] * freq;
    rope[t * 32 + i] = cosf(ang); rope[t * 32 + 16 + i] = sinf(ang);
}
__global__ void k_prep_w(const float* W, int K, int N, bf16_t* out, int Nphys, int mode) {
    const size_t idx = (size_t)blockIdx.x * blockDim.x + threadIdx.x; if (idx >= (size_t)Nphys * K) return;
    const int p = (int)(idx / K), k = (int)(idx % K);
    const int s = mode == 1 ? win_src(p) : p;
    out[idx] = (s >= 0 && s < N) ? f2bf(W[(size_t)k * N + s]) : (bf16_t)0;
}
__global__ void k_prep_wup(const float* wuq, const float* wukv, bf16_t* out) {
    const int idx = blockIdx.x * blockDim.x + threadIdx.x; if (idx >= NUP * KUP) return;
    const int p = idx / KUP, k = idx % KUP; float v = 0.f;
    if (p < 768) { if (k < 256) v = wuq[(size_t)k * 768 + wup_qcol(p)]; }
    else { if (k >= 256) v = wukv[(size_t)(k - 256) * 1024 + (p - 768)]; }
    out[idx] = f2bf(v);
}
__global__ void k_prep_gw(const float* ws, bf16_t* gw) {
    const int idx = blockIdx.x * blockDim.x + threadIdx.x; if (idx >= DEPTH * NGRP * CHUNK * CHUNK) return;
    const int s = idx & 127, t = (idx >> 7) & 127;
    gw[idx] = (s <= t) ? f2bf(ws[idx]) : (bf16_t)0;
}
__global__ __launch_bounds__(512) void k_smallm(const float* in, int in_stride, int act, const float* W, int ldw, int N, int mode, const float* bias, float* out, int out_stride, int Nphys) {
    __shared__ float sin_[1024 * 16];
    __shared__ float red[8 * 64 * 16];
    const int tid = threadIdx.x, lane = tid & 63, wave = tid >> 6;
    for (int e = tid; e < 16 * 1024; e += 512) { const int b = e >> 10, k = e & 1023; float v = in[(size_t)b * in_stride + k]; if (act) v = v / (1.f + __expf(-v)); sin_[k * 16 + b] = v; }
    __syncthreads();
    const int p = blockIdx.x * 64 + lane; const int s = (p < Nphys) ? (mode == 1 ? win_src(p) : p) : -1; const bool ok = (s >= 0 && s < N);
    float acc[16];
#pragma unroll
    for (int b = 0; b < 16; ++b) acc[b] = 0.f;
    for (int k = wave * 128; k < wave * 128 + 128; ++k) {
        const float w = ok ? W[(size_t)k * ldw + s] : 0.f;
        const f32x4* sp = (const f32x4*)(sin_ + k * 16);
#pragma unroll
        for (int q = 0; q < 4; ++q) { const f32x4 v = sp[q]; acc[4 * q] += v[0] * w; acc[4 * q + 1] += v[1] * w; acc[4 * q + 2] += v[2] * w; acc[4 * q + 3] += v[3] * w; }
    }
#pragma unroll
    for (int b = 0; b < 16; ++b) red[(wave * 64 + lane) * 16 + b] = acc[b];
    __syncthreads();
    for (int e = tid; e < 64 * 16; e += 512) { const int l = e >> 4, b = e & 15; float sum = 0.f;
#pragma unroll
        for (int w = 0; w < 8; ++w) sum += red[(w * 64 + l) * 16 + b];
        const int pp = blockIdx.x * 64 + l; if (pp < Nphys) out[(size_t)b * out_stride + pp] = sum + (bias ? bias[pp] : 0.f); }
}
__global__ __launch_bounds__(256) void k_modx(const float* x, const float* g, const float* sc  , int sc_stride, bf16_t* A, float* ssq) {
    const int row = blockIdx.x * 4 + (threadIdx.x >> 6), lane = threadIdx.x & 63; if (row >= T) return;
    const int b = row / SEQ; const f32x4* xr = (const f32x4*)(x + (size_t)row * DM); float s = 0.f;
#pragma unroll
    for (int j = 0; j < 4; ++j) { const f32x4 v = xr[lane + 64 * j]; s += v[0] * v[0] + v[1] * v[1] + v[2] * v[2] + v[3] * v[3];
        const int c = 4 * (lane + 64 * j); const f32x4 gv = *(const f32x4*)(g + c), sv = *(const f32x4*)(sc + (size_t)b * sc_stride + c);
        unsigned lo = f2bf(v[0] * gv[0] * (1.f + sv[0])) | ((unsigned)f2bf(v[1] * gv[1] * (1.f + sv[1])) << 16);
        unsigned hi = f2bf(v[2] * gv[2] * (1.f + sv[2])) | ((unsigned)f2bf(v[3] * gv[3] * (1.f + sv[3])) << 16);
        *(uint2*)(A + (size_t)row * DM + c) = make_uint2(lo, hi); }
    s = wave_sum(s);
    if (lane < 16) ssq[(size_t)row * 16 + lane] = (lane == 0) ? s : 0.f;
}
__global__ __launch_bounds__(256) void k_final(const float* x, const float* g, float* out) {
    const int row = blockIdx.x * 4 + (threadIdx.x >> 6), lane = threadIdx.x & 63; if (row >= T) return;
    const f32x4* xr = (const f32x4*)(x + (size_t)row * DM); f32x4 v[4]; float s = 0.f;
#pragma unroll
    for (int j = 0; j < 4; ++j) { v[j] = xr[lane + 64 * j]; s += v[j][0] * v[j][0] + v[j][1] * v[j][1] + v[j][2] * v[j][2] + v[j][3] * v[j][3]; }
    const float rstd = rsqrtf(wave_sum(s) * (1.f / DM) + EPS);
#pragma unroll
    for (int j = 0; j < 4; ++j) { const int c = 4 * (lane + 64 * j); const f32x4 gv = *(const f32x4*)(g + c); *(f32x4*)(out + (size_t)row * DM + c) = v[j] * rstd * gv; }
}

template <class Epi>
__global__ __launch_bounds__(256) void k_gemm_naive(const bf16_t* A, int lda, const bf16_t* Bt, int ldb, int K, Epi epi) {
    const int wave = threadIdx.x >> 6, lane = threadIdx.x & 63, fr = lane & 15, fq = lane >> 4;
    const int row0 = blockIdx.y * 64 + wave * 16, col0 = blockIdx.x * 64;
    f32x4 acc[4];
#pragma unroll
    for (int n = 0; n < 4; ++n) acc[n] = (f32x4){0.f, 0.f, 0.f, 0.f};
    const bf16_t* ap = A + (size_t)(row0 + fr) * lda + 8 * fq;
    const bf16_t* bp = Bt + (size_t)(col0 + fr) * ldb + 8 * fq;
    for (int k0 = 0; k0 < K; k0 += 32) {
        if (Epi::HAS_MID) { if (k0 == epi.ksplit) {
#pragma unroll
            for (int r = 0; r < 4; ++r) { const float m = epi.mid(row0 + 4 * fq + r);
#pragma unroll
                for (int n = 0; n < 4; ++n) acc[n][r] *= m; } } }
        const bf16x8 a = *(const bf16x8*)(ap + k0);
#pragma unroll
        for (int n = 0; n < 4; ++n) { const bf16x8 b = *(const bf16x8*)(bp + (size_t)n * 16 * ldb + k0); acc[n] = __builtin_amdgcn_mfma_f32_16x16x32_bf16(a, b, acc[n], 0, 0, 0); }
    }
#pragma unroll
    for (int r = 0; r < 4; ++r) { const int row = row0 + 4 * fq + r; const float rs = epi.rowscale(row);
#pragma unroll
        for (int n = 0; n < 4; ++n) epi(row, col0 + 16 * n + fr, acc[n][r], rs); }
}
__device__ __forceinline__ float sum16(const float* p) { float s = 0.f;
#pragma unroll
    for (int i = 0; i < 16; ++i) s += p[i]; return s; }
__device__ __forceinline__ float sum8(const float* p) { float s = 0.f;
#pragma unroll
    for (int i = 0; i < 8; ++i) s += p[i]; return s; }
__device__ __forceinline__ float sum4(const float* p) { return (p[0] + p[1]) + (p[2] + p[3]); }

struct EpiInNaive {
    static constexpr bool HAS_MID = false; int ksplit;
    const float* ssq1; const float* shw1; bf16_t* U; float* GV; float* ZL;
    __device__ float mid(int) const { return 1.f; }
    __device__ float rowscale(int row) const { return rsqrtf(sum16(ssq1 + (size_t)row * 16) * (1.f / DM) + EPS); }
    __device__ void operator()(int row, int p, float acc, float rs) const {
        const int L = win_src(p); if (L < 0) return;
        const float z = rs * acc + shw1[(row / SEQ) * NIN + p];
        if (L < 512) U[(size_t)row * 512 + L] = f2bf(gelu_tanh(z));
        else if (L < 1024) GV[(size_t)row * 512 + (L - 512)] = gelu_tanh(z);
        else ZL[(size_t)row * 416 + (L - 1024)] = z;
    }
};
struct EpiUpNaive {
    static constexpr bool HAS_MID = false; int ksplit;
    const float* ssqq; bf16_t* Q; float* QRT; bf16_t* KN; bf16_t* V;
    __device__ float mid(int) const { return 1.f; }
    __device__ float rowscale(int) const { return 1.f; }
    __device__ void operator()(int row, int p, float acc, float) const {
        if (p < 768) { const float rq = rsqrtf(sum4(ssqq + (size_t)row * 8) * (1.f / QR) + EPS); const float v = acc * rq * QSCALE;
            const int L = wup_qcol(p), h = L / 96, d = L - 96 * h;
            if (d < 64) Q[(size_t)row * 768 + L] = f2bf(v); else QRT[(size_t)row * 256 + h * 32 + (d - 64)] = v; }
        else { const float rk = rsqrtf(sum4(ssqq + (size_t)row * 8 + 4) * (1.f / KVR) + EPS); const float v = acc * rk;
            const int c = p - 768, h = c >> 7, d = c & 127;
            if (d < 64) KN[(size_t)row * 512 + h * 64 + d] = f2bf(v); else V[(size_t)row * 512 + h * 64 + (d - 64)] = f2bf(v); }
    }
};
struct EpiOutNaive {
    static constexpr bool HAS_MID = true; int ksplit;
    const float* ssqy; const float* xin; float* xout; const float* gate;
    __device__ float rg(int row) const { return rsqrtf(sum8(ssqy + (size_t)row * 16) * (1.f / 512) + EPS); }
    __device__ float ra(int row) const { return rsqrtf(sum8(ssqy + (size_t)row * 16 + 8) * (1.f / 512) + EPS); }
    __device__ float mid(int row) const { return rg(row) / ra(row); }
    __device__ float rowscale(int row) const { return ra(row); }
    __device__ void operator()(int row, int n, float acc, float rs) const {
        const size_t i = (size_t)row * DM + n; xout[i] = xin[i] + gate[(size_t)(row / SEQ) * NMOD + n] * (rs * acc);
    }
};
struct EpiFf1Naive {
    static constexpr bool HAS_MID = false; int ksplit;
    const float* ssq2; const float* shw2; bf16_t* H;
    __device__ float mid(int) const { return 1.f; }
    __device__ float rowscale(int row) const { return rsqrtf(sum16(ssq2 + (size_t)row * 16) * (1.f / DM) + EPS); }
    __device__ void operator()(int row, int n, float acc, float rs) const {
        const float z = rs * acc + shw2[(row / SEQ) * DFF + n]; const float r = fmaxf(z, 0.f); H[(size_t)row * DFF + n] = f2bf(r * r);
    }
};
struct EpiFf2Naive {
    static constexpr bool HAS_MID = false; int ksplit;
    float* x; const float* gate;
    __device__ float mid(int) const { return 1.f; }
    __device__ float rowscale(int) const { return 1.f; }
    __device__ void operator()(int row, int n, float acc, float) const {
        const size_t i = (size_t)row * DM + n; x[i] = x[i] + gate[(size_t)(row / SEQ) * NMOD + n] * acc;
    }
};

__global__ __launch_bounds__(256) void k_vn(const float* GV, bf16_t* VN) {
    const int w = blockIdx.x * 4 + (threadIdx.x >> 6), lane = threadIdx.x & 63; if (w >= T * NGRP) return;
    const int row = w >> 3, g = w & 7; const float v = GV[(size_t)row * 512 + g * 64 + lane];
    const float mu = wave_sum(v) * (1.f / 64); const float d = v - mu; const float var = wave_sum(d * d) * (1.f / 64);
    VN[(size_t)row * 512 + g * 64 + lane] = f2bf(d * rsqrtf(var + EPS));
}
__global__ __launch_bounds__(256) void k_lat(const float* ZL, const float* gq, const float* gkv, const float* rope, bf16_t* CQKV, float* ssqq, bf16_t* KR) {
    const int row = blockIdx.x * 4 + (threadIdx.x >> 6), lane = threadIdx.x & 63; if (row >= T) return;
    const float* z = ZL + (size_t)row * 416; float sq = 0.f, sk = 0.f;
#pragma unroll
    for (int j = 0; j < 4; ++j) { const int c = lane + 64 * j; const float v = z[c]; sq += v * v; CQKV[(size_t)row * KUP + c] = f2bf(v * gq[c]); }
#pragma unroll
    for (int j = 0; j < 2; ++j) { const int c = lane + 64 * j; const float v = z[256 + c]; sk += v * v; CQKV[(size_t)row * KUP + 256 + c] = f2bf(v * gkv[c]); }
    sq = wave_sum(sq); sk = wave_sum(sk);
    if (lane < 8) ssqq[(size_t)row * 8 + lane] = (lane == 0) ? sq : (lane == 4) ? sk : 0.f;
    if (lane < 16) { const float x1 = z[384 + lane], x2 = z[384 + 16 + lane], c = rope[(size_t)row * 32 + lane], s = rope[(size_t)row * 32 + 16 + lane];
        KR[(size_t)row * 32 + lane] = f2bf(x1 * c - x2 * s); KR[(size_t)row * 32 + 16 + lane] = f2bf(x1 * s + x2 * c); }
}
__global__ void k_rope_q(const float* QRT, const float* rope, bf16_t* Q) {
    const int idx = blockIdx.x * blockDim.x + threadIdx.x; if (idx >= T * NH * 16) return;
    const int r = idx & 15, h = (idx >> 4) & 7, row = idx >> 7;
    const float x1 = QRT[(size_t)row * 256 + h * 32 + r], x2 = QRT[(size_t)row * 256 + h * 32 + 16 + r], c = rope[(size_t)row * 32 + r], s = rope[(size_t)row * 32 + 16 + r];
    Q[(size_t)row * 768 + h * 96 + 64 + r] = f2bf(x1 * c - x2 * s); Q[(size_t)row * 768 + h * 96 + 80 + r] = f2bf(x1 * s + x2 * c);
}
__global__ __launch_bounds__(512) void k_gmlp_naive(const bf16_t* U, const bf16_t* VN, const bf16_t* GW  , const float* bs  , const float* gog, bf16_t* Y, float* ssqy) {
    const int row = blockIdx.x, g = threadIdx.x >> 6, d = threadIdx.x & 63, c = g * 64 + d;
    const int tt = row & 127, t0 = row - tt;
    const bf16_t* w = GW + ((size_t)g * CHUNK + tt) * CHUNK; float sum = 0.f;
    for (int s = 0; s <= tt; ++s) sum += bf2f(w[s]) * bf2f(VN[(size_t)(t0 + s) * 512 + c]);
    const float y = bf2f(U[(size_t)row * 512 + c]) * (sum + bs[g * CHUNK + tt]);
    Y[(size_t)row * DM + c] = f2bf(y * gog[c]);
    const float q = wave_sum(y * y); if (d == 0) ssqy[(size_t)row * 16 + g] = q;
}
__global__ __launch_bounds__(64) void k_attn_naive(const bf16_t* Q, const bf16_t* KN, const bf16_t* KR, const bf16_t* V, const float* goa, bf16_t* Y, float* ssqy) {
    const int h = blockIdx.y, row = blockIdx.x * 64 + threadIdx.x, b = row / SEQ, i = row - b * SEQ;
    const int iend = (blockIdx.x * 64 % SEQ) + 63;
    float q[96];
#pragma unroll
    for (int d8 = 0; d8 < 12; ++d8) { const bf16x8 v = *(const bf16x8*)(Q + (size_t)row * 768 + h * 96 + d8 * 8);
#pragma unroll
        for (int j = 0; j < 8; ++j) q[d8 * 8 + j] = bf2f((bf16_t)v[j]); }
    float o[64];
#pragma unroll
    for (int d = 0; d < 64; ++d) o[d] = 0.f;
    float m = -1e30f, l = 0.f;
    const size_t kb = (size_t)b * SEQ;
    for (int j = 0; j <= iend; ++j) {
        const bf16_t* kn = KN + (kb + j) * 512 + h * 64; const bf16_t* kr = KR + (kb + j) * 32; const bf16_t* vv = V + (kb + j) * 512 + h * 64;
        float s = 0.f;
#pragma unroll
        for (int d8 = 0; d8 < 8; ++d8) { const bf16x8 kv = *(const bf16x8*)(kn + d8 * 8);
#pragma unroll
            for (int jj = 0; jj < 8; ++jj) s += q[d8 * 8 + jj] * bf2f((bf16_t)kv[jj]); }
#pragma unroll
        for (int d8 = 0; d8 < 4; ++d8) { const bf16x8 kv = *(const bf16x8*)(kr + d8 * 8);
#pragma unroll
            for (int jj = 0; jj < 8; ++jj) s += q[64 + d8 * 8 + jj] * bf2f((bf16_t)kv[jj]); }
        if (j > i) s = -1e30f;
        const float mn = fmaxf(m, s), alpha = exp2f(m - mn), p = (j > i) ? 0.f : exp2f(s - mn);
        l = l * alpha + p; m = mn;
#pragma unroll
        for (int d8 = 0; d8 < 8; ++d8) { const bf16x8 v8 = *(const bf16x8*)(vv + d8 * 8);
#pragma unroll
            for (int jj = 0; jj < 8; ++jj) o[d8 * 8 + jj] = o[d8 * 8 + jj] * alpha + p * bf2f((bf16_t)v8[jj]); }
    }
    const float inv = 1.f / l; float sq = 0.f;
#pragma unroll
    for (int d8 = 0; d8 < 8; ++d8) { unsigned w[4];
#pragma unroll
        for (int jj = 0; jj < 8; jj += 2) { const float y0 = o[d8 * 8 + jj] * inv, y1 = o[d8 * 8 + jj + 1] * inv; sq += y0 * y0 + y1 * y1;
            w[jj >> 1] = f2bf(y0 * goa[h * 64 + d8 * 8 + jj]) | ((unsigned)f2bf(y1 * goa[h * 64 + d8 * 8 + jj + 1]) << 16); }
        *(uint4*)(Y + (size_t)row * DM + 512 + h * 64 + d8 * 8) = make_uint4(w[0], w[1], w[2], w[3]); }
    ssqy[(size_t)row * 16 + 8 + h] = sq;
}

__global__ void k_gm(const float* g  , const float* mod, int chunk, float* gmt) {
    const int idx = blockIdx.x * blockDim.x + threadIdx.x; if (idx >= DEPTH * NB * DM) return;
    const int c = idx & 1023, b = (idx >> 10) & 15, l = idx >> 14;
    gmt[idx] = g[l * DM + c] * (1.f + mod[((size_t)l * NB + b) * NMOD + chunk * DM + c]);
}
__device__ __forceinline__ int lane_id() { int l; asm volatile("v_mbcnt_lo_u32_b32 %0, -1, 0\n\tv_mbcnt_hi_u32_b32 %0, -1, %0" : "=v"(l)); return l; }
__device__ __forceinline__ float swz_xor16(float v) { return __int_as_float(__builtin_amdgcn_ds_swizzle(__float_as_int(v), 0x401F)); }
__device__ __forceinline__ float swz_xor1(float v) { return __int_as_float(__builtin_amdgcn_ds_swizzle(__float_as_int(v), 0x041F)); }
namespace pg8 {
#define PG8_LAS __attribute__((address_space(3)))
typedef unsigned u32x4 __attribute__((ext_vector_type(4)));
typedef unsigned u32x2 __attribute__((ext_vector_type(2)));
constexpr int BM = 256, BK = 64, HALF = 128, HTB = HALF * BK * 2  , STAGE_BYTES = 8 * HTB, NXCD = 8, WGM = 8;

__host__ __device__ __forceinline__ int lds_byte(int r, int c) { const int st = (r >> 4) * 2 + (c >> 5), rr = r & 15, cc = c & 31, ob = rr * 64 + cc * 2; return st * 1024 + (ob ^ (((ob >> 9) & 1) << 5)); }
__host__ __device__ __forceinline__ void stage_rc(int b, int& R, int& C) { const int st = b / 1024, sb = b % 1024, swz = sb ^ (((sb >> 9) & 1) << 5); R = (st >> 1) * 16 + swz / 64; C = (st & 1) * 32 + (swz % 64) / 2; }
__host__ __device__ __forceinline__ int perm32(int rho) { const int n = rho >> 4, i = rho & 15; return 8 * (i >> 2) + 4 * n + (i & 3); }

struct Unit { int pm, pn; };
struct Gemm { const bf16_t* A; const bf16_t* Bt; int M, N, K, lda; };

struct StaticOrder {
    int nM, nN, nwg, G, c;
    __host__ __device__ void init(int M, int N, int G_, int c_) { nM = M / BM; nN = N / BM; nwg = nM * nN; G = G_; c = c_; }
    __host__ __device__ bool next(int i, Unit& u) const {
        const long L = (long)i * G + c; if (L >= nwg) return false;
        int wgid = (int)L; { const int q = nwg / NXCD, r = nwg % NXCD, xcd = wgid % NXCD, off = wgid / NXCD; wgid = (xcd < r ? xcd * (q + 1) : r * (q + 1) + (xcd - r) * q) + off; }
        const int nig = WGM * nN, gid = wgid / nig, fm = gid * WGM, gsz = (nM - fm) < WGM ? (nM - fm) : WGM;
        u.pm = fm + ((wgid % nig) % gsz); u.pn = (wgid % nig) / gsz; return true;
    }
    __device__ __forceinline__ void a_ready(const Unit&) const {}
    __device__ __forceinline__ void done(const Unit&) const {}
};

struct KvOrder : StaticOrder {
    __host__ __device__ bool next(int i, Unit& u) const {
        if (G != 256 || nwg != 512) return StaticOrder::next(i, u);
        StaticOrder t = *this; t.G = 1 << 30;
        if (c < 128) { if (i > 0) return false; t.c = c; } else { if (i > 2) return false; t.c = (i == 0) ? c : 256 + 2 * (c - 128) + (i - 1); }
        return t.next(0, u);
    }
};
struct Place { int jx, nx, rank, nloc; };
template <int NN> struct XcdOrder {
    int p0, nunits, rank, nloc;
    __device__ __forceinline__ void init(const Place& p) { p0 = p.jx * (128 / p.nx); nunits = (128 / p.nx) * NN; rank = p.rank; nloc = p.nloc; }
    __device__ __forceinline__ bool map(int idx, Unit& u) const { if (idx >= nunits) return false; const int gi = idx / (8 * NN), w = idx - gi * (8 * NN); u.pm = p0 + 8 * gi + (w & 7); u.pn = w >> 3; return true; }
    __device__ __forceinline__ bool next(int i, Unit& u) const { return map(rank + i * nloc, u); }
    __device__ __forceinline__ void a_ready(const Unit&) const {}
    __device__ __forceinline__ void done(const Unit&) const {}
};
struct LdsOrder {
    volatile PG8_LAS int* tab;
    __device__ __forceinline__ bool next(int i, Unit& u) const { if (i >= __builtin_amdgcn_readfirstlane(tab[0])) return false; u.pm = __builtin_amdgcn_readfirstlane(tab[1 + 2 * i]); u.pn = __builtin_amdgcn_readfirstlane(tab[2 + 2 * i]); return true; }
    __device__ __forceinline__ void a_ready(const Unit&) const {}
    __device__ __forceinline__ void done(const Unit&) const {}
};
template <class Src> __device__ __forceinline__ LdsOrder fill_order(volatile PG8_LAS int* tab, const Src& S, int wid0) {
    __syncthreads();
    if (wid0 == 0 && lane_id() == 0) { Unit u; int n = 0; while (n < 15 && S.next(n, u)) { tab[1 + 2 * n] = u.pm; tab[2 + 2 * n] = u.pn; ++n; } tab[0] = n; }
    __syncthreads();
    LdsOrder o; o.tab = tab; return o;
}
struct XcdKvOrder : XcdOrder<4> {
    __device__ __forceinline__ bool next(int i, Unit& u) const {
        if (nloc != 32 || nunits != 64) return XcdOrder<4>::next(i, u);
        if (rank < 16) return i == 0 ? map(rank, u) : false;
        if (i > 2) return false; return map(i == 0 ? rank : 32 + 2 * (rank - 16) + (i - 1), u);
    }
};
struct FusedPlace { int p0, rank; bool ok; __device__ __forceinline__ void init(const Place& p) { p0 = p.jx * (128 / p.nx); rank = p.rank; ok = (p.nloc == 32 && p.nx == 8); } };
struct FusedInOrder : FusedPlace { __device__ __forceinline__ bool next(int i, Unit& u) const {
        if (i == 0) { u.pm = p0 + (rank & 15); u.pn = 4 + (rank >> 4); return true; }
        if (i > 2) return false; const int w = rank + 32 * (i - 1); u.pm = p0 + 8 * (w >> 5) + (w & 7); u.pn = (w & 31) >> 3; return true; } };
struct FusedUqOrder : FusedPlace { __device__ __forceinline__ bool next(int i, Unit& u) const { if (rank >= 16 || i > 2) return false; u.pm = p0 + rank; u.pn = i; return true; } };
struct FusedUkvOrder : FusedPlace { __device__ __forceinline__ bool next(int i, Unit& u) const { if (rank < 16 || i > 3) return false; u.pm = p0 + rank - 16; u.pn = i; return true; } };
__device__ __forceinline__ unsigned cvt_pk_bf16(float lo, float hi) { unsigned r; asm volatile("v_cvt_pk_bf16_f32 %0, %1, %2" : "=v"(r) : "v"(lo), "v"(hi)); return r; }
__device__ __forceinline__ u32x4 pack8(const f32x4& a, const f32x4& b) { u32x4 w; w.x = cvt_pk_bf16(a[0], a[1]); w.y = cvt_pk_bf16(a[2], a[3]); w.z = cvt_pk_bf16(b[0], b[1]); w.w = cvt_pk_bf16(b[2], b[3]); return w; }
__device__ __forceinline__ u32x2 pack4(const f32x4& a) { u32x2 w; w.x = cvt_pk_bf16(a[0], a[1]); w.y = cvt_pk_bf16(a[2], a[3]); return w; }
__device__ __forceinline__ float hsum4(const f32x4& a) { return (a[0] + a[1]) + (a[2] + a[3]); }
__device__ __forceinline__ float hsq4(const f32x4& a) { return (a[0] * a[0] + a[1] * a[1]) + (a[2] * a[2] + a[3] * a[3]); }
__device__ __forceinline__ float ld_sum16(const float* p) { const f32x4* q = (const f32x4*)p; return (hsum4(q[0]) + hsum4(q[1])) + (hsum4(q[2]) + hsum4(q[3])); }
__device__ __forceinline__ float ld_sum8(const float* p) { const f32x4* q = (const f32x4*)p; return hsum4(q[0]) + hsum4(q[1]); }
__device__ __forceinline__ float ld_sum4(const float* p) { return hsum4(*(const f32x4*)p); }
__device__ __forceinline__ float quad_sum(float s) { s += swz_xor16(s); auto rr = __builtin_amdgcn_permlane32_swap(__float_as_uint(s), __float_as_uint(s), false, false); return __uint_as_float(rr[0]) + __uint_as_float(rr[1]); }
__device__ __forceinline__ float row_sum16(const float* ssq, int row, int fq) { return quad_sum(hsum4(*(const f32x4*)(ssq + (size_t)row * 16 + 4 * fq))); }
__device__ __forceinline__ void row_sum8x2(const float* ssq, int row, int fq, float& sg, float& sa) {
    float s = hsum4(*(const f32x4*)(ssq + (size_t)row * 16 + 4 * fq)); s += swz_xor16(s);
    auto rr = __builtin_amdgcn_permlane32_swap(__float_as_uint(s), __float_as_uint(s), false, false); sg = __uint_as_float(rr[0]); sa = __uint_as_float(rr[1]); }
#define PG8_FENCE() asm volatile("" ::: "memory")
#define PG8_RSTD8(rsv, ssqp, invn) do { f32x4 q_[2][4]; \
    _Pragma("unroll") for (int ai = 0; ai < 2; ++ai) _Pragma("unroll") for (int m = 0; m < 4; ++m) q_[ai][m] = *(const f32x4*)((ssqp) + (size_t)PG8_ROW(u, ai, m) * 16 + 4 * fq); \
    _Pragma("unroll") for (int ai = 0; ai < 2; ++ai) _Pragma("unroll") for (int m = 0; m < 4; ++m) rsv[ai][m] = rsqrtf(quad_sum(hsum4(q_[ai][m])) * (invn) + EPS); \
    PG8_FENCE(); } while (0)
__device__ __forceinline__ f32x4 gelu4(const f32x4& v) { f32x4 o; o[0] = gelu_tanh(v[0]); o[1] = gelu_tanh(v[1]); o[2] = gelu_tanh(v[2]); o[3] = gelu_tanh(v[3]); return o; }

#define PG8_ROW(u, ai, m) ((u).pm * BM + (ai) * HALF + wr * 64 + (m) * 16 + fr)

template <class V, class P> __device__ __forceinline__ V ldb(const P* p, unsigned boff) { return *(const V*)((const char*)p + boff); }
template <class V, class P> __device__ __forceinline__ void stb(P* p, unsigned boff, const V& v) { *(V*)((char*)p + boff) = v; }
#undef PG8_RSTD8
#define PG8_RSTD8(rsv, ssqp, invn) do { f32x4 q_[2][4]; \
    _Pragma("unroll") for (int ai = 0; ai < 2; ++ai) _Pragma("unroll") for (int m = 0; m < 4; ++m) q_[ai][m] = ldb<f32x4>((ssqp), (unsigned)(PG8_ROW(u, ai, m) * 64 + 16 * fq)); \
    _Pragma("unroll") for (int ai = 0; ai < 2; ++ai) _Pragma("unroll") for (int m = 0; m < 4; ++m) rsv[ai][m] = rsqrtf(quad_sum(hsum4(q_[ai][m])) * (invn) + EPS); \
    PG8_FENCE(); } while (0)

struct EpiIn {
    static constexpr int K = DM, LDA = DM;
    static constexpr bool PERM = true, AFTER_DRAIN = false, HAS_MID = false; static constexpr int MID_T = -1;
    const float* ssq1; const float* shw1; const float* gq; const float* gkv; const float* rope;
    bf16_t* U; bf16_t* VN; bf16_t* CQ; bf16_t* CKV; bf16_t* KR; float* ssqq;
    __device__ __forceinline__ void mid(f32x4 (&)[2][2][4][2], const Unit&, int, int) const {}
    __device__ __forceinline__ void operator()(const f32x4 (&acc)[2][2][4][2], const Unit& u, int wr, int wc, int fr, int fq) const {
        { const int l_ = lane_id(); fr = l_ & 15; fq = l_ >> 4; }
        const int b = u.pm >> 3, pc0 = u.pn * BM + wc * 32 + 8 * fq;
        f32x4 sh[2][2];
#pragma unroll
        for (int bj = 0; bj < 2; ++bj)
#pragma unroll
            for (int n = 0; n < 2; ++n) sh[bj][n] = ldb<f32x4>(shw1, (unsigned)((b * NIN + pc0 + bj * HALF + 4 * n) * 4));
        float rsv[2][4]; PG8_RSTD8(rsv, ssq1, 1.f / DM);
        if (u.pn < 2) {
#pragma unroll
            for (int ai = 0; ai < 2; ++ai)
#pragma unroll
                for (int m = 0; m < 4; ++m) { const int row = PG8_ROW(u, ai, m); const float rs = rsv[ai][m];
#pragma unroll
                    for (int bj = 0; bj < 2; ++bj) { const f32x4 v0 = gelu4(acc[ai][bj][m][0] * rs + sh[bj][0]), v1 = gelu4(acc[ai][bj][m][1] * rs + sh[bj][1]);
                        stb(U, (unsigned)((row * 512 + pc0 + bj * HALF) * 2), pack8(v0, v1)); } }
        } else if (u.pn < 4) {
#pragma unroll
            for (int ai = 0; ai < 2; ++ai)
#pragma unroll
                for (int m = 0; m < 4; ++m) { const int row = PG8_ROW(u, ai, m); const float rs = rsv[ai][m];
                    f32x4 g[2][2]; float s = 0.f;
#pragma unroll
                    for (int bj = 0; bj < 2; ++bj)
#pragma unroll
                        for (int n = 0; n < 2; ++n) { g[bj][n] = gelu4(acc[ai][bj][m][n] * rs + sh[bj][n]); s += hsum4(g[bj][n]); }
                    const float mu = quad_sum(s) * (1.f / 64); float q = 0.f;
#pragma unroll
                    for (int bj = 0; bj < 2; ++bj)
#pragma unroll
                        for (int n = 0; n < 2; ++n) { g[bj][n] = g[bj][n] - mu; q += hsq4(g[bj][n]); }
                    const float rstd = rsqrtf(quad_sum(q) * (1.f / 64) + EPS);
#pragma unroll
                    for (int bj = 0; bj < 2; ++bj) stb(VN, (unsigned)((row * 512 + (u.pn - 2) * 256 + 64 * wc + 32 * bj + 8 * fq) * 2), pack8(g[bj][0] * rstd, g[bj][1] * rstd)); }
        } else if (u.pn == 4) {
            f32x4 gv[2][2];
#pragma unroll
            for (int bj = 0; bj < 2; ++bj)
#pragma unroll
                for (int n = 0; n < 2; ++n) gv[bj][n] = ldb<f32x4>(gq, (unsigned)((bj * HALF + wc * 32 + 8 * fq + 4 * n) * 4));
#pragma unroll
            for (int ai = 0; ai < 2; ++ai)
#pragma unroll
                for (int m = 0; m < 4; ++m) { const int row = PG8_ROW(u, ai, m); const float rs = rsv[ai][m];
                    float ss = 0.f;
#pragma unroll
                    for (int bj = 0; bj < 2; ++bj) { const f32x4 v0 = acc[ai][bj][m][0] * rs + sh[bj][0], v1 = acc[ai][bj][m][1] * rs + sh[bj][1]; ss += hsq4(v0) + hsq4(v1);
                        stb(CQ, (unsigned)((row * QR + bj * HALF + wc * 32 + 8 * fq) * 2), pack8(v0 * gv[bj][0], v1 * gv[bj][1])); }
                    ss = quad_sum(ss); if (fq == 0) stb(ssqq, (unsigned)((row * 8 + wc) * 4), ss); }
        } else {
            const f32x4 gk0 = ldb<f32x4>(gkv, (unsigned)((wc * 32 + 8 * fq) * 4)), gk1 = ldb<f32x4>(gkv, (unsigned)((wc * 32 + 8 * fq + 4) * 4));
#pragma unroll
            for (int ai = 0; ai < 2; ++ai)
#pragma unroll
                for (int m = 0; m < 4; ++m) { const int row = PG8_ROW(u, ai, m); const float rs = rsv[ai][m];
                    const f32x4 v0 = acc[ai][0][m][0] * rs + sh[0][0], v1 = acc[ai][0][m][1] * rs + sh[0][1];
                    float ss = quad_sum(hsq4(v0) + hsq4(v1)); if (fq == 0) stb(ssqq, (unsigned)((row * 8 + 4 + wc) * 4), ss);
                    stb(CKV, (unsigned)((row * KVR + wc * 32 + 8 * fq) * 2), pack8(v0 * gk0, v1 * gk1));
                    if (wc == 0) { const f32x4 x1 = acc[ai][1][m][0] * rs + sh[1][0], x2 = acc[ai][1][m][1] * rs + sh[1][1];
                        const f32x4 c = ldb<f32x4>(rope, (unsigned)((row * 32 + 4 * fq) * 4)), s = ldb<f32x4>(rope, (unsigned)((row * 32 + 16 + 4 * fq) * 4));
                        stb(KR, (unsigned)((row * 32 + 4 * fq) * 2), pack4(x1 * c - x2 * s)); stb(KR, (unsigned)((row * 32 + 16 + 4 * fq) * 2), pack4(x1 * s + x2 * c)); } }
        }
    }
};
template <bool KVP> struct EpiUp {
    static constexpr int K = KVP ? KVR : QR, LDA = K;
    static constexpr bool PROBE2 = false;
    static constexpr bool PERM = true, AFTER_DRAIN = false, HAS_MID = false; static constexpr int MID_T = -1;
    const float* ssqq; const float* rope; bf16_t* Q; bf16_t* KN; bf16_t* V;
    __device__ __forceinline__ void mid(f32x4 (&)[2][2][4][2], const Unit&, int, int) const {}
    __device__ __forceinline__ void operator()(const f32x4 (&acc)[2][2][4][2], const Unit& u, int wr, int wc, int fr, int fq) const {
        { const int l_ = lane_id(); fr = l_ & 15; fq = l_ >> 4; }
        float sq[2][4];
        { f32x4 q_[2][4];
#pragma unroll
        for (int ai = 0; ai < 2; ++ai)
#pragma unroll
            for (int m = 0; m < 4; ++m) q_[ai][m] = ldb<f32x4>(ssqq, (unsigned)((PG8_ROW(u, ai, m) * 8 + (KVP ? 4 : 0)) * 4));
#pragma unroll
        for (int ai = 0; ai < 2; ++ai)
#pragma unroll
            for (int m = 0; m < 4; ++m) sq[ai][m] = hsum4(q_[ai][m]);
        PG8_FENCE(); }
        if (!KVP) {
#pragma unroll
            for (int ai = 0; ai < 2; ++ai)
#pragma unroll
                for (int m = 0; m < 4; ++m) { const int row = PG8_ROW(u, ai, m); const float rq = rsqrtf(sq[ai][m] * (1.f / QR) + EPS) * QSCALE;
#pragma unroll
                    for (int bj = 0; bj < 2; ++bj) { const int G = 8 * u.pn + 4 * bj + wc, h = G / 3, gi = G - 3 * h;
                        const f32x4 v0 = acc[ai][bj][m][0] * rq, v1 = acc[ai][bj][m][1] * rq;
                        if (gi < 2) stb(Q, (unsigned)((row * 768 + 32 * G + 8 * fq) * 2), pack8(v0, v1));
                        else { const f32x4 c = ldb<f32x4>(rope, (unsigned)((row * 32 + 4 * fq) * 4)), s = ldb<f32x4>(rope, (unsigned)((row * 32 + 16 + 4 * fq) * 4));
                            stb(Q, (unsigned)((row * 768 + 96 * h + 64 + 4 * fq) * 2), pack4(v0 * c - v1 * s)); stb(Q, (unsigned)((row * 768 + 96 * h + 80 + 4 * fq) * 2), pack4(v0 * s + v1 * c)); } }
                    if (m & 1) PG8_FENCE(); }
        } else {
#pragma unroll
            for (int ai = 0; ai < 2; ++ai)
#pragma unroll
                for (int m = 0; m < 4; ++m) { const int row = PG8_ROW(u, ai, m); const float rk = rsqrtf(sq[ai][m] * (1.f / KVR) + EPS);
#pragma unroll
                    for (int bj = 0; bj < 2; ++bj) { const int h = 2 * u.pn + bj;
                        const u32x4 w = pack8(acc[ai][bj][m][0] * rk, acc[ai][bj][m][1] * rk);
                        if (wc < 2) stb(KN, (unsigned)((row * 512 + 64 * h + 32 * wc + 8 * fq) * 2), w); else stb(V, (unsigned)((row * 512 + 64 * h + 32 * (wc - 2) + 8 * fq) * 2), w); } }
        }
    }
};
__device__ __forceinline__ f32x4 bf_lo4(const u32x4& w) { f32x4 r; r[0] = __uint_as_float(w.x << 16); r[1] = __uint_as_float(w.x & 0xffff0000u); r[2] = __uint_as_float(w.y << 16); r[3] = __uint_as_float(w.y & 0xffff0000u); return r; }
__device__ __forceinline__ f32x4 bf_hi4(const u32x4& w) { f32x4 r; r[0] = __uint_as_float(w.z << 16); r[1] = __uint_as_float(w.z & 0xffff0000u); r[2] = __uint_as_float(w.w << 16); r[3] = __uint_as_float(w.w & 0xffff0000u); return r; }
template <bool MIDS, bool XF32> struct EpiRes {
    static constexpr int K = MIDS ? DM : DFF, LDA = MIDS ? YLD : DFF;
    static constexpr bool PROBE2 = false;
    static constexpr bool PERM = true, AFTER_DRAIN = false, HAS_MID = MIDS; static constexpr int MID_T = 8;
    const float* ssqy; const void* xin; bf16_t* xout; const float* gate  ; const float* gm  ; bf16_t* A; float* ssqo;
    __device__ __forceinline__ void mid(f32x4 (&acc)[2][2][4][2], const Unit& u, int wr, int fr) const {
        const int l_ = lane_id(); fr = l_ & 15; const int fq = l_ >> 4;
        f32x4 q_[2][4];
#pragma unroll
        for (int ai = 0; ai < 2; ++ai)
#pragma unroll
            for (int m = 0; m < 4; ++m) q_[ai][m] = ldb<f32x4>(ssqy, (unsigned)(PG8_ROW(u, ai, m) * 64 + 16 * fq));
#pragma unroll
        for (int ai = 0; ai < 2; ++ai)
#pragma unroll
            for (int m = 0; m < 4; ++m) { float s = hsum4(q_[ai][m]); s += swz_xor16(s);
                auto rr = __builtin_amdgcn_permlane32_swap(__float_as_uint(s), __float_as_uint(s), false, false); const float sg = __uint_as_float(rr[0]), sa = __uint_as_float(rr[1]);
                const float ratio = sqrtf((sa * (1.f / 512) + EPS) / (sg * (1.f / 512) + EPS));
#pragma unroll
                for (int bj = 0; bj < 2; ++bj)
#pragma unroll
                    for (int n = 0; n < 2; ++n) acc[ai][bj][m][n] = acc[ai][bj][m][n] * ratio; }
    }
    __device__ __forceinline__ void operator()(const f32x4 (&acc)[2][2][4][2], const Unit& u, int wr, int wc, int fr, int fq) const {
        { const int l_ = lane_id(); fr = l_ & 15; fq = l_ >> 4; }
        const int b = u.pm >> 3, c0 = u.pn * BM + wc * 32 + 8 * fq;
        float rs[2][4], ss[2][4];
#pragma unroll
        for (int ai = 0; ai < 2; ++ai)
#pragma unroll
            for (int m = 0; m < 4; ++m) { ss[ai][m] = 0.f; rs[ai][m] = 1.f; }
        if (MIDS) { f32x4 q_[2][4];
#pragma unroll
            for (int ai = 0; ai < 2; ++ai)
#pragma unroll
                for (int m = 0; m < 4; ++m) q_[ai][m] = ldb<f32x4>(ssqy, (unsigned)(PG8_ROW(u, ai, m) * 64 + 32 + 16 * (fq & 1)));
#pragma unroll
            for (int ai = 0; ai < 2; ++ai)
#pragma unroll
                for (int m = 0; m < 4; ++m) { float s = hsum4(q_[ai][m]); s += swz_xor16(s); rs[ai][m] = rsqrtf(s * (1.f / 512) + EPS); }
            PG8_FENCE(); }
#pragma unroll
        for (int bj = 0; bj < 2; ++bj) { const int cb = c0 + bj * HALF;
            const f32x4 g0 = ldb<f32x4>(gate, (unsigned)((b * NMOD + cb) * 4)), g1 = ldb<f32x4>(gate, (unsigned)((b * NMOD + cb + 4) * 4));
            f32x4 m0 = (f32x4){0.f, 0.f, 0.f, 0.f}, m1 = m0; if (gm) { m0 = ldb<f32x4>(gm, (unsigned)((b * DM + cb) * 4)); m1 = ldb<f32x4>(gm, (unsigned)((b * DM + cb + 4) * 4)); }
            if (XF32) {
#pragma unroll
                for (int ai = 0; ai < 2; ++ai) {
                    f32x4 xv[4][2];
#pragma unroll
                    for (int m = 0; m < 4; ++m) { const unsigned off = (unsigned)((PG8_ROW(u, ai, m) * DM + cb) * 4); xv[m][0] = ldb<f32x4>(xin, off); xv[m][1] = ldb<f32x4>(xin, off + 16); }
                    PG8_FENCE();
#pragma unroll
                    for (int m = 0; m < 4; ++m) { const unsigned off = (unsigned)((PG8_ROW(u, ai, m) * DM + cb) * 2), offx = (unsigned)(PG8_ROW(u, ai, m) * (DM * 4) + DM * 2 + cb * 2);
                        const f32x4 x0 = xv[m][0] + g0 * (acc[ai][bj][m][0] * rs[ai][m]), x1 = xv[m][1] + g1 * (acc[ai][bj][m][1] * rs[ai][m]);
                        stb(xout, offx, pack8(x0, x1));
                        if (gm) { ss[ai][m] += hsq4(x0) + hsq4(x1); stb(A, off, pack8(x0 * m0, x1 * m1)); } }
                    PG8_FENCE(); }
            } else {
                u32x4 xw[2][4];
#pragma unroll
                for (int ai = 0; ai < 2; ++ai)
#pragma unroll
                    for (int m = 0; m < 4; ++m) xw[ai][m] = ldb<u32x4>(xin, (unsigned)(PG8_ROW(u, ai, m) * (DM * 4) + DM * 2 + cb * 2));
                PG8_FENCE();
#pragma unroll
                for (int ai = 0; ai < 2; ++ai)
#pragma unroll
                    for (int m = 0; m < 4; ++m) { const unsigned off = (unsigned)((PG8_ROW(u, ai, m) * DM + cb) * 2), offx = (unsigned)(PG8_ROW(u, ai, m) * (DM * 4) + DM * 2 + cb * 2);
                        const f32x4 x0 = bf_lo4(xw[ai][m]) + g0 * (acc[ai][bj][m][0] * rs[ai][m]), x1 = bf_hi4(xw[ai][m]) + g1 * (acc[ai][bj][m][1] * rs[ai][m]);
                        stb(xout, offx, pack8(x0, x1));
                        if (gm) { ss[ai][m] += hsq4(x0) + hsq4(x1); stb(A, off, pack8(x0 * m0, x1 * m1)); } }
                PG8_FENCE(); } }
        if (gm) {
#pragma unroll
            for (int ai = 0; ai < 2; ++ai)
#pragma unroll
                for (int m = 0; m < 4; ++m) { const float s = quad_sum(ss[ai][m]); if (fq == 0) stb(ssqo, (unsigned)((PG8_ROW(u, ai, m) * 16 + u.pn * 4 + wc) * 4), s); } }
    }
};
struct EpiFf1 {
    static constexpr int K = DM, LDA = DM;
    static constexpr bool PERM = true, AFTER_DRAIN = false, HAS_MID = false; static constexpr int MID_T = -1;
    const float* ssq2; const float* shw2; bf16_t* H;
    __device__ __forceinline__ void mid(f32x4 (&)[2][2][4][2], const Unit&, int, int) const {}
    __device__ __forceinline__ void operator()(const f32x4 (&acc)[2][2][4][2], const Unit& u, int wr, int wc, int fr, int fq) const {
        { const int l_ = lane_id(); fr = l_ & 15; fq = l_ >> 4; }
        const int b = u.pm >> 3, c0 = u.pn * BM + wc * 32 + 8 * fq;
        f32x4 sh[2][2];
#pragma unroll
        for (int bj = 0; bj < 2; ++bj)
#pragma unroll
            for (int n = 0; n < 2; ++n) sh[bj][n] = ldb<f32x4>(shw2, (unsigned)((b * DFF + c0 + bj * HALF + 4 * n) * 4));
        float rsv[2][4]; PG8_RSTD8(rsv, ssq2, 1.f / DM);
#pragma unroll
        for (int ai = 0; ai < 2; ++ai)
#pragma unroll
            for (int m = 0; m < 4; ++m) { const int row = PG8_ROW(u, ai, m); const float rs = rsv[ai][m];
#pragma unroll
                for (int bj = 0; bj < 2; ++bj) { f32x4 v0 = acc[ai][bj][m][0] * rs + sh[bj][0], v1 = acc[ai][bj][m][1] * rs + sh[bj][1];
#pragma unroll
                    for (int i = 0; i < 4; ++i) { const float a = fmaxf(v0[i], 0.f), c = fmaxf(v1[i], 0.f); v0[i] = a * a; v1[i] = c * c; }
                    stb(H, (unsigned)((row * DFF + c0 + bj * HALF) * 2), pack8(v0, v1)); } }
    }
};

template <class Epi, class Sched, bool ALIGN_EPI = false, bool SP2 = false>
__device__ __forceinline__ void gemm_phase(PG8_LAS unsigned char* lds, const Gemm g, const Sched& S, const Epi& E, int wid0) {
    int tid_ = wid0 * 64 + lane_id(); asm volatile("" : "+v"(tid_));
    const int tid = tid_, wid = __builtin_amdgcn_readfirstlane(tid >> 6), lane = tid & 63, wr = wid >> 2, wc = wid & 3, fr = lane & 15, fq = lane >> 4;
    constexpr int K = Epi::K, LDA = Epi::LDA, nt = K / BK;
    unsigned voffA[2], voffB[2];
#pragma unroll
    for (int i = 0; i < 2; ++i) { int R, C; stage_rc(tid * 16 + i * 8192, R, C); const int Rb = Epi::PERM ? ((R & ~31) + perm32(R & 31)) : R;
        voffA[i] = (unsigned)(R * LDA + C) * 2u; voffB[i] = (unsigned)(Rb * K + C) * 2u; }
    const size_t kstep = (size_t)(BK * 2);
    const size_t hstep = (size_t)HALF * K * 2;
    const size_t tstep = 2 * hstep;
    const size_t hstepA = (size_t)HALF * LDA * 2, tstepA = 2 * hstepA;
    const unsigned ldsw = (unsigned)wid * 1024u;
    const int aoff = lds_byte(wr * 64 + fr, fq * 8), boff = lds_byte(wc * 32 + fr, fq * 8);
#define PG8_SA(b, h) (((b) * 2 + (h)) * HTB)
#define PG8_SB(b, h) ((4 + (b) * 2 + (h)) * HTB)
#define PG8_STAGE(bufoff, gbase, voff) do { _Pragma("unroll") for (int _i = 0; _i < 2; ++_i) \
        __builtin_amdgcn_global_load_lds((const unsigned*)((const char*)(gbase) + (voff)[_i]), (PG8_LAS unsigned*)(lds + (bufoff) + ldsw + _i * 8192), 16, 0, 0); } while (0)
#define PG8_LDA(dst, b, h) do { _Pragma("unroll") for (int m = 0; m < 4; ++m) _Pragma("unroll") for (int k = 0; k < 2; ++k) dst[m][k] = *(const PG8_LAS bf16x8*)(lds + PG8_SA(b, h) + aoff + m * 2048 + k * 1024); } while (0)
#define PG8_LDB(dst, b, h) do { _Pragma("unroll") for (int n = 0; n < 2; ++n) _Pragma("unroll") for (int k = 0; k < 2; ++k) dst[n][k] = *(const PG8_LAS bf16x8*)(lds + PG8_SB(b, h) + boff + n * 2048 + k * 1024); } while (0)
#define PG8_MMA(ai, bj, At, Bt) do { __builtin_amdgcn_s_setprio(1); _Pragma("unroll") for (int m = 0; m < 4; ++m) _Pragma("unroll") for (int n = 0; n < 2; ++n) _Pragma("unroll") for (int k = 0; k < 2; ++k) \
        acc[ai][bj][m][n] = __builtin_amdgcn_mfma_f32_16x16x32_bf16(Bt[n][k], At[m][k], acc[ai][bj][m][n], 0, 0, 0); __builtin_amdgcn_s_setprio(0); } while (0)
#define PG8_WAIT_V(n) asm volatile("s_waitcnt vmcnt(" #n ")" ::: "memory")
#define PG8_WAIT_L(n) asm volatile("s_waitcnt lgkmcnt(" #n ")" ::: "memory")
#define PG8_BAR __builtin_amdgcn_s_barrier()
#define PG8_SCHED __builtin_amdgcn_sched_barrier(0)
    Unit cur, nxt; int ui = 0;
    if (!S.next(0, cur)) return;
    f32x4 acc[2][2][4][2];
#pragma unroll
    for (int a = 0; a < 2; ++a)
#pragma unroll
        for (int b = 0; b < 2; ++b)
#pragma unroll
            for (int m = 0; m < 4; ++m)
#pragma unroll
                for (int n = 0; n < 2; ++n) acc[a][b][m][n] = (f32x4){0.f, 0.f, 0.f, 0.f};
    bf16x8 At[4][2], B0[2][2], B1[2][2];
    const char* cA = (const char*)g.A + (size_t)cur.pm * tstepA; const char* cB = (const char*)g.Bt + (size_t)cur.pn * tstep;
    S.a_ready(cur);
    if constexpr (SP2) {
        PG8_STAGE(PG8_SB(0, 0), cB, voffB); PG8_STAGE(PG8_SB(0, 1), cB + hstep, voffB); PG8_STAGE(PG8_SA(0, 0), cA, voffA); PG8_STAGE(PG8_SA(0, 1), cA + hstepA, voffA);
        if (wr == 1) PG8_BAR;
        PG8_WAIT_V(2); PG8_BAR;
        PG8_STAGE(PG8_SB(1, 0), cB + kstep, voffB); PG8_STAGE(PG8_SA(1, 0), cA + kstep, voffA); PG8_STAGE(PG8_SB(1, 1), cB + hstep + kstep, voffB);
        PG8_WAIT_V(6); PG8_BAR;
    } else {
        PG8_STAGE(PG8_SB(0, 0), cB, voffB); PG8_STAGE(PG8_SA(0, 0), cA, voffA); PG8_STAGE(PG8_SB(0, 1), cB + hstep, voffB); PG8_STAGE(PG8_SA(0, 1), cA + hstepA, voffA);
        if (wr == 1) PG8_BAR;
        PG8_WAIT_V(4); PG8_BAR;
        PG8_STAGE(PG8_SB(1, 0), cB + kstep, voffB); PG8_STAGE(PG8_SA(1, 0), cA + kstep, voffA); PG8_STAGE(PG8_SB(1, 1), cB + hstep + kstep, voffB);
        PG8_WAIT_V(6); PG8_BAR;
    }
    for (;;) {
        const bool has_next = S.next(ui + 1, nxt);
        const char* nA = has_next ? (const char*)g.A + (size_t)nxt.pm * tstepA : cA; const char* nB = has_next ? (const char*)g.Bt + (size_t)nxt.pn * tstep : cB;
#pragma nounroll
        for (int t = 0; t < nt; t += 2) {
            const bool last = (t == nt - 2);
            const char* a1 = cA + (size_t)(t + 1) * kstep;
            const char* a2 = last ? nA : cA + (size_t)(t + 2) * kstep; const char* b2 = last ? nB : cB + (size_t)(t + 2) * kstep;
            const char* a3 = a2 + kstep; const char* b3 = b2 + kstep;
            if (last && has_next) S.a_ready(nxt);
            if constexpr (Epi::HAS_MID) { if (t == Epi::MID_T) E.mid(acc, cur, wr, fr); }
            if constexpr (SP2) {
            PG8_LDB(B0, 0, 0); PG8_LDB(B1, 0, 1); PG8_SCHED; PG8_LDA(At, 0, 0); PG8_STAGE(PG8_SA(1, 1), a1 + hstepA, voffA);
            PG8_WAIT_V(8); PG8_WAIT_L(0); PG8_BAR; PG8_MMA(0, 0, At, B0); PG8_MMA(0, 1, At, B1); PG8_BAR; PG8_SCHED;
            PG8_LDA(At, 0, 1); PG8_STAGE(PG8_SB(0, 0), b2, voffB); PG8_STAGE(PG8_SB(0, 1), b2 + hstep, voffB); PG8_STAGE(PG8_SA(0, 0), a2, voffA);
            PG8_WAIT_V(8); PG8_WAIT_L(0); PG8_BAR; PG8_MMA(1, 0, At, B0); PG8_MMA(1, 1, At, B1); PG8_BAR; PG8_SCHED;
            PG8_LDB(B0, 1, 0); PG8_LDB(B1, 1, 1); PG8_SCHED; PG8_LDA(At, 1, 0); PG8_STAGE(PG8_SA(0, 1), a2 + hstepA, voffA);
            PG8_WAIT_V(8); PG8_WAIT_L(0); PG8_BAR; PG8_MMA(0, 0, At, B0); PG8_MMA(0, 1, At, B1); PG8_BAR; PG8_SCHED;
            PG8_LDA(At, 1, 1); PG8_STAGE(PG8_SB(1, 0), b3, voffB); PG8_STAGE(PG8_SB(1, 1), b3 + hstep, voffB); PG8_STAGE(PG8_SA(1, 0), a3, voffA);
            PG8_WAIT_V(8); PG8_WAIT_L(0); PG8_BAR; PG8_MMA(1, 0, At, B0); PG8_MMA(1, 1, At, B1); PG8_BAR; PG8_SCHED;
            } else {
            PG8_LDB(B0, 0, 0); PG8_SCHED; PG8_LDA(At, 0, 0); PG8_STAGE(PG8_SA(1, 1), a1 + hstepA, voffA);
            PG8_WAIT_L(8); PG8_BAR; PG8_WAIT_L(0); PG8_MMA(0, 0, At, B0); PG8_BAR; PG8_SCHED;
            PG8_LDB(B1, 0, 1); PG8_STAGE(PG8_SB(0, 0), b2, voffB);
            PG8_BAR; PG8_WAIT_L(0); PG8_MMA(0, 1, At, B1); PG8_BAR;
            PG8_LDA(At, 0, 1); PG8_STAGE(PG8_SA(0, 0), a2, voffA);
            PG8_BAR; PG8_WAIT_L(0); PG8_MMA(1, 0, At, B0); PG8_BAR; PG8_SCHED;
            PG8_STAGE(PG8_SB(0, 1), b2 + hstep, voffB);
            PG8_WAIT_V(6); PG8_BAR; PG8_MMA(1, 1, At, B1); PG8_BAR;
            PG8_LDB(B0, 1, 0); PG8_SCHED; PG8_LDA(At, 1, 0); PG8_STAGE(PG8_SA(0, 1), a2 + hstepA, voffA);
            PG8_WAIT_L(8); PG8_BAR; PG8_WAIT_L(0); PG8_MMA(0, 0, At, B0); PG8_BAR; PG8_SCHED;
            PG8_LDB(B1, 1, 1); PG8_STAGE(PG8_SB(1, 0), b3, voffB);
            PG8_BAR; PG8_WAIT_L(0); PG8_MMA(0, 1, At, B1); PG8_BAR;
            PG8_LDA(At, 1, 1); PG8_STAGE(PG8_SA(1, 0), a3, voffA);
            PG8_BAR; PG8_WAIT_L(0); PG8_MMA(1, 0, At, B0); PG8_BAR; PG8_SCHED;
            PG8_STAGE(PG8_SB(1, 1), b3 + hstep, voffB);
            PG8_WAIT_V(6); PG8_BAR; PG8_MMA(1, 1, At, B1); PG8_BAR;
            }
        }
        if constexpr (ALIGN_EPI) { if (wr == 0) PG8_BAR; }
        if constexpr (!Epi::AFTER_DRAIN) { E(acc, cur, wr, wc, fr, fq); S.done(cur); }
        if (!has_next) break;
#pragma unroll
        for (int a = 0; a < 2; ++a)
#pragma unroll
            for (int b = 0; b < 2; ++b)
#pragma unroll
                for (int m = 0; m < 4; ++m)
#pragma unroll
                    for (int n = 0; n < 2; ++n) acc[a][b][m][n] = (f32x4){0.f, 0.f, 0.f, 0.f};
        cur = nxt; cA = nA; cB = nB; ++ui;
        if constexpr (ALIGN_EPI) { if (wr == 1) PG8_BAR; }
    }
    PG8_WAIT_V(0);
    if constexpr (!ALIGN_EPI) { if (wr == 0) PG8_BAR; }
    PG8_BAR;
    if constexpr (Epi::AFTER_DRAIN) { E.fused(acc, cur, wr, wc, fr, fq, lds, wid, lane); S.done(cur); }
#undef PG8_SA
#undef PG8_SB
#undef PG8_STAGE
#undef PG8_LDA
#undef PG8_LDB
#undef PG8_MMA
#undef PG8_WAIT_V
#undef PG8_WAIT_L
#undef PG8_BAR
#undef PG8_SCHED
}
}

namespace gm {
#define GM_LAS __attribute__((address_space(3)))
typedef short v4i16_t __attribute__((ext_vector_type(4)));
__device__ __forceinline__ int swz(int s) { return ((s >> 1) & 1) + 2 * ((s >> 3) & 1); }
__device__ __forceinline__ void gmlp_phase(GM_LAS unsigned char* lds, int wid0, const pg8::Place& pl, const bf16_t* U, const bf16_t* VN, const bf16_t* GW  , const float* bs  , const float* gog  , bf16_t* Y, float* ssqy) {
    int tid_ = wid0 * 64 + lane_id(); asm volatile("" : "+v"(tid_));
    const int tid = tid_, lane = tid & 63, wid = __builtin_amdgcn_readfirstlane(tid >> 6), fr = lane & 15, fq = lane >> 4;
    const int nks = (wid >> 1) + 1, nu = 256 / pl.nx, u0 = pl.jx * nu;
    int gcur = -1; bf16x8 wf[4]; float bias = 0.f; f32x4 gv[4];
    pg8::u32x4 st[2]; uint2 uu[4];
#define GM_LOAD(IDX) do { const int g_ = (IDX) & 7; const size_t t0_ = (size_t)(u0 + ((IDX) >> 3)) * CHUNK; \
        _Pragma("unroll") for (int k = 0; k < 2; ++k) { const int ix = tid + 512 * k, s_ = ix >> 3, c16 = ix & 7; st[k] = *(const pg8::u32x4*)(VN + (t0_ + s_) * 512 + g_ * 64 + c16 * 8); } \
        _Pragma("unroll") for (int nt = 0; nt < 4; ++nt) uu[nt] = *(const uint2*)(U + (t0_ + 16 * wid + fr) * 512 + g_ * 64 + 16 * nt + 4 * fq); } while (0)
    if (pl.rank < 8 * nu) GM_LOAD(pl.rank);
    for (int idx = pl.rank; idx < 8 * nu; idx += pl.nloc) {
        const int g = idx & 7, un = u0 + (idx >> 3); const size_t t0 = (size_t)un * CHUNK;
        if (g != gcur) { gcur = g;
#pragma unroll
            for (int ks = 0; ks < 4; ++ks) wf[ks] = *(const bf16x8*)(GW + ((size_t)(g * CHUNK + 16 * wid + fr)) * CHUNK + 32 * ks + 8 * fq);
            bias = bs[g * CHUNK + 16 * wid + fr];
#pragma unroll
            for (int nt = 0; nt < 4; ++nt) gv[nt] = *(const f32x4*)(gog + g * 64 + 16 * nt + 4 * fq); }
        __syncthreads();
#pragma unroll
        for (int k = 0; k < 2; ++k) { const int ix = tid + 512 * k, s = ix >> 3, c16 = ix & 7; *(GM_LAS pg8::u32x4*)(lds + s * 128 + (((c16 >> 1) ^ swz(s)) * 32) + (c16 & 1) * 16) = st[k]; }
        uint2 uc[4];
#pragma unroll
        for (int nt = 0; nt < 4; ++nt) uc[nt] = uu[nt];
        __syncthreads();
        if (idx + pl.nloc < 8 * nu) GM_LOAD(idx + pl.nloc);
        f32x4 acc[4];
#pragma unroll
        for (int nt = 0; nt < 4; ++nt) acc[nt] = (f32x4){0.f, 0.f, 0.f, 0.f};
#pragma unroll
        for (int ks = 0; ks < 4; ++ks) { if (ks < nks) {
#pragma unroll
            for (int nt = 0; nt < 4; ++nt) {
                const int q = fr >> 2, p = fr & 3;
                const int s0 = 32 * ks + 8 * fq + q, s1 = s0 + 4;
                const v4i16_t lo = __builtin_amdgcn_ds_read_tr16_b64_v4i16((GM_LAS v4i16_t*)(lds + s0 * 128 + ((nt ^ swz(s0)) * 32) + p * 8));
                const v4i16_t hi = __builtin_amdgcn_ds_read_tr16_b64_v4i16((GM_LAS v4i16_t*)(lds + s1 * 128 + ((nt ^ swz(s1)) * 32) + p * 8));
                const bf16x8 vf = (bf16x8){lo[0], lo[1], lo[2], lo[3], hi[0], hi[1], hi[2], hi[3]};
                acc[nt] = __builtin_amdgcn_mfma_f32_16x16x32_bf16(vf, wf[ks], acc[nt], 0, 0, 0);
            } } }
        const size_t row = t0 + 16 * wid + fr; float ss = 0.f;
#pragma unroll
        for (int nt = 0; nt < 4; ++nt) { const int c = g * 64 + 16 * nt + 4 * fq;
            f32x4 y; y[0] = bf2f((bf16_t)(uc[nt].x & 0xffff)) * (acc[nt][0] + bias); y[1] = bf2f((bf16_t)(uc[nt].x >> 16)) * (acc[nt][1] + bias);
            y[2] = bf2f((bf16_t)(uc[nt].y & 0xffff)) * (acc[nt][2] + bias); y[3] = bf2f((bf16_t)(uc[nt].y >> 16)) * (acc[nt][3] + bias);
            ss += pg8::hsq4(y); *(pg8::u32x2*)(Y + row * YLD + c) = pg8::pack4(y * gv[nt]); }
        ss = pg8::quad_sum(ss); if (fq == 0) ssqy[row * 16 + g] = ss;
    }
#undef GM_LOAD
    __syncthreads();
}
}

namespace att {
#define AT_LAS __attribute__((address_space(3)))
using f32x16 = __attribute__((ext_vector_type(16))) float;
using s16x4 = __attribute__((ext_vector_type(4))) short;
using u32x4 = __attribute__((ext_vector_type(4))) unsigned;
constexpr int KVBLK = 64, KSLOTB = 12288, VSLOTB = 8192, NKS = 4, NVS = 4;
constexpr int LDS_V = NKS * KSLOTB  , LDS_WS = LDS_V + NVS * VSLOTB  , LDS_OST = LDS_WS + 8 * 256  , OROW = 144, LDS_BYTES = LDS_OST + 8 * 32 * OROW  ;
__device__ __forceinline__ int crow(int r, int hi) { return (r & 3) + 8 * (r >> 2) + 4 * hi; }
__device__ __forceinline__ void glds16(const void* gsrc, unsigned lds_dst) { unsigned keep;
    asm volatile("s_mov_b32 %0, m0\n\ts_mov_b32 m0, %2\n\ts_nop 0\n\tglobal_load_lds_dwordx4 %1, off\n\ts_mov_b32 m0, %0" : "=&s"(keep) : "v"(gsrc), "s"(lds_dst) : "memory"); }
typedef float f32x2_t __attribute__((ext_vector_type(2))); typedef __bf16 bf16x2_t __attribute__((ext_vector_type(2)));
__device__ __forceinline__ unsigned cvtpk_s(float lo, float hi) { f32x2_t v = {lo, hi}; bf16x2_t b = __builtin_convertvector(v, bf16x2_t); return __builtin_bit_cast(unsigned, b); }
__device__ __forceinline__ float max3f(float a, float b, float c) { float r; asm("v_max3_f32 %0, %1, %2, %3" : "=v"(r) : "v"(a), "v"(b), "v"(c)); return r; }
#define AT_WAIT_BAR(N) asm volatile("s_waitcnt vmcnt(" #N ") lgkmcnt(0)\n\ts_barrier" ::: "memory")
typedef short v4i16_t __attribute__((ext_vector_type(4)));
__device__ __forceinline__ s16x4 vtr(AT_LAS const char* p) { return __builtin_bit_cast(s16x4, __builtin_amdgcn_ds_read_tr16_b64_v4i16((AT_LAS v4i16_t*)p)); }
__device__ __forceinline__ void pv(f32x16 (&o)[2], AT_LAS const char* vp, const u32x4& pw0, const u32x4& pw1, const u32x4& pw2, const u32x4& pw3) {
#pragma unroll
    for (int d0 = 0; d0 < 2; ++d0) { s16x4 lo[4], hh[4];
#pragma unroll
        for (int ks = 0; ks < 4; ++ks) { lo[ks] = vtr(vp + d0 * 4096 + ks * 1024); hh[ks] = vtr(vp + d0 * 4096 + ks * 1024 + 512); }
#define AT_VF(k) (bf16x8){lo[k][0], lo[k][1], lo[k][2], lo[k][3], hh[k][0], hh[k][1], hh[k][2], hh[k][3]}
        o[d0] = __builtin_amdgcn_mfma_f32_32x32x16_bf16(__builtin_bit_cast(bf16x8, pw0), AT_VF(0), o[d0], 0, 0, 0);
        o[d0] = __builtin_amdgcn_mfma_f32_32x32x16_bf16(__builtin_bit_cast(bf16x8, pw1), AT_VF(1), o[d0], 0, 0, 0);
        o[d0] = __builtin_amdgcn_mfma_f32_32x32x16_bf16(__builtin_bit_cast(bf16x8, pw2), AT_VF(2), o[d0], 0, 0, 0);
        o[d0] = __builtin_amdgcn_mfma_f32_32x32x16_bf16(__builtin_bit_cast(bf16x8, pw3), AT_VF(3), o[d0], 0, 0, 0);
#undef AT_VF
    }
}
__device__ __forceinline__ void qkt(f32x16& p0, f32x16& p1, AT_LAS const char* kb, const bf16x8 (&qr)[6], const f32x16& negm) {
    bf16x8 kf[12];
#pragma unroll
    for (int d0 = 0; d0 < 6; ++d0) { kf[2 * d0] = *(AT_LAS const bf16x8*)(kb + d0 * 2048); kf[2 * d0 + 1] = *(AT_LAS const bf16x8*)(kb + d0 * 2048 + 512); }
    __builtin_amdgcn_sched_barrier(0);
    p0 = __builtin_amdgcn_mfma_f32_32x32x16_bf16(kf[0], qr[0], negm, 0, 0, 0); p1 = __builtin_amdgcn_mfma_f32_32x32x16_bf16(kf[1], qr[0], negm, 0, 0, 0);
#pragma unroll
    for (int d0 = 1; d0 < 6; ++d0) { p0 = __builtin_amdgcn_mfma_f32_32x32x16_bf16(kf[2 * d0], qr[d0], p0, 0, 0, 0); p1 = __builtin_amdgcn_mfma_f32_32x32x16_bf16(kf[2 * d0 + 1], qr[d0], p1, 0, 0, 0); }
    asm volatile("s_nop 15\n\ts_nop 7" : "+v"(p0), "+v"(p1));
}
template <int THRL>
__device__ __forceinline__ void attn_item(int b, int h, int s, const bf16_t* Q, const bf16_t* KN, const bf16_t* KR, const bf16_t* V, const float* goa  , bf16_t* Y, float* ssqy, AT_LAS char* shm, int wid0) {
    int tid_ = wid0 * 64 + lane_id(); asm volatile("" : "+v"(tid_));
    const int tid = tid_, lane = tid & 63, r32 = lane & 31, hi = lane >> 5; const int wid = __builtin_amdgcn_readfirstlane(tid >> 6);
    const bool late = wid >= 4;
    const size_t rowbase = (size_t)b * SEQ;
    const unsigned lds0 = (unsigned)(uintptr_t)shm;
    AT_LAS float* wsf = (AT_LAS float*)(shm + LDS_WS) + wid * 64;
    const bf16_t* ksrc = KN + (rowbase + lane) * 512 + h * 64 + wid * 8;
    const bf16_t* rsrc = KR + (rowbase + lane) * 32 + (wid & 3) * 8;
    const bf16_t* vsrc = V + (rowbase + 16 * (wid & 3) + (lane >> 2)) * 512 + h * 64 + (wid >> 2) * 32 + (lane & 3) * 8;
    const unsigned kdst = lds0 + wid * 1024, rdst = lds0 + (8 + (wid & 3)) * 1024, vdst = lds0 + LDS_V + wid * 1024;
#define AT_DMA(jk, jv, NT_) do { const int jk_ = (jk) < (NT_) ? (jk) : (NT_) - 1, jv_ = (jv) < (NT_) ? (jv) : (NT_) - 1; \
        glds16(ksrc + (size_t)jk_ * KVBLK * 512, (unsigned)__builtin_amdgcn_readfirstlane(kdst + (jk_ & 3) * KSLOTB)); \
        glds16(rsrc + (size_t)jk_ * KVBLK * 32, (unsigned)__builtin_amdgcn_readfirstlane(rdst + (jk_ & 3) * KSLOTB)); \
        glds16(vsrc + (size_t)jv_ * KVBLK * 512, (unsigned)__builtin_amdgcn_readfirstlane(vdst + (jv_ & 3) * VSLOTB)); } while (0)
#define AT_QLOAD(dst, qb_) do { const bf16_t* Qw_ = Q + (rowbase + (qb_) * 256 + wid * 32) * 768 + h * 96; \
        _Pragma("unroll") for (int d0 = 0; d0 < 6; ++d0) dst[d0] = *(const bf16x8*)(Qw_ + (size_t)r32 * 768 + d0 * 16 + hi * 8); } while (0)
    AT_LAS const char* kp0 = shm + hi * 1024 + r32 * 16;
    AT_LAS const char* vp0 = shm + LDS_V + ((lane >> 4) & 1) * 32 + (lane & 3) * 8 + (4 * hi + ((lane & 15) >> 2)) * 64;
    const int qrel = wid * 32 + r32, wq = wid >> 1;
    bf16x8 qr[6];
    AT_QLOAD(qr, s);
    { const int NT0 = 4 * s + 4; AT_DMA(0, 0, NT0); AT_DMA(1, 1, NT0); AT_DMA(2, 1, NT0); }
    for (int ui = 0; ui < 4; ++ui) {
        const int qb = (ui == 0) ? s : (ui == 1) ? 7 - s : (ui == 2) ? 2 + s : 5 - s; const int q0 = qb * 256;
        const int NT = (q0 + 256) / KVBLK;
        float mhat = 0.f, l_reg = 0.f; f32x16 o[2]; o[0] = f32x16{}; o[1] = f32x16{};
        f32x16 negm = f32x16{}; asm volatile("" : "+v"(negm));
        u32x4 pw0 = u32x4{}, pw1 = u32x4{}, pw2 = u32x4{}, pw3 = u32x4{}; bool have = false;
        f32x16 p0 = f32x16{}, p1 = f32x16{};
        AT_WAIT_BAR(6);
        if (!late) qkt(p0, p1, kp0, qr, negm);
        for (int t = 0; t < NT; ++t) {
            AT_WAIT_BAR(3);
            AT_DMA(t + 3, t + 2, NT);
            const int jb = t - (NT - 4);
            const bool need = jb <= wq;
            if (late) { if (have) pv(o, vp0 + ((t - 1) & 3) * VSLOTB, pw0, pw1, pw2, pw3);
                        have = false; if (need) qkt(p0, p1, kp0 + (t & 3) * KSLOTB, qr, negm); }
            if (need) {
                if (jb == wq) { const int kb = 64 * jb + 4 * hi;
#pragma unroll
                    for (int r = 0; r < 16; ++r) { const int kv = kb + (r & 3) + 8 * (r >> 2); if (kv > qrel) p0[r] = -INFINITY; if (kv + 32 > qrel) p1[r] = -INFINITY; } }
                float ma = max3f(p0[0], p0[1], p1[0]), mb = max3f(p0[2], p0[3], p1[1]); ma = max3f(ma, p1[2], p1[3]);
#pragma unroll
                for (int r = 4; r < 16; r += 4) { ma = max3f(ma, p0[r], p0[r + 1]); mb = max3f(mb, p0[r + 2], p0[r + 3]); ma = max3f(ma, p1[r], p1[r + 1]); mb = max3f(mb, p1[r + 2], p1[r + 3]); }
                float rm = fmaxf(ma, mb);
                { auto rr = __builtin_amdgcn_permlane32_swap(__float_as_uint(rm), __float_as_uint(rm), false, false); rm = fmaxf(__uint_as_float(rr[0]), __uint_as_float(rr[1])); }
                if (t == 0 || __any(rm > (float)THRL)) {
                    const float dl = (t == 0) ? rm : fmaxf(rm, 0.f); mhat += dl;
#pragma unroll
                    for (int r = 0; r < 16; ++r) { p0[r] -= dl; p1[r] -= dl; negm[r] = -mhat; }
                    asm volatile("" : "+v"(negm));
                    if (t > 0) { const float f = __builtin_amdgcn_exp2f(-dl); l_reg *= f; if (hi == 0) wsf[r32] = f; asm volatile("s_waitcnt lgkmcnt(0)" ::: "memory");
#pragma unroll
                        for (int r = 0; r < 16; ++r) { const float fr_ = wsf[crow(r, hi)]; o[0][r] *= fr_; o[1][r] *= fr_; } }
                }
                float sacc = 0.f;
#pragma unroll
                for (int r = 0; r < 16; ++r) { p0[r] = __builtin_amdgcn_exp2f(p0[r]); p1[r] = __builtin_amdgcn_exp2f(p1[r]); sacc += p0[r] + p1[r]; }
                l_reg += sacc;
#define AT_PK(P, B) cvtpk_s(P[B], P[B + 1])
                pw0 = (u32x4){AT_PK(p0, 0), AT_PK(p0, 2), AT_PK(p0, 4), AT_PK(p0, 6)}; pw1 = (u32x4){AT_PK(p0, 8), AT_PK(p0, 10), AT_PK(p0, 12), AT_PK(p0, 14)};
                pw2 = (u32x4){AT_PK(p1, 0), AT_PK(p1, 2), AT_PK(p1, 4), AT_PK(p1, 6)}; pw3 = (u32x4){AT_PK(p1, 8), AT_PK(p1, 10), AT_PK(p1, 12), AT_PK(p1, 14)};
#undef AT_PK
                if (late) have = true;
                else pv(o, vp0 + (t & 3) * VSLOTB, pw0, pw1, pw2, pw3);
            }
            if (!late) { if (t + 1 < NT && (jb + 1) <= wq) qkt(p0, p1, kp0 + ((t + 1) & 3) * KSLOTB, qr, negm); }
        }
        if (late && have) pv(o, vp0 + ((NT - 1) & 3) * VSLOTB, pw0, pw1, pw2, pw3);
        asm volatile("s_waitcnt vmcnt(0) lgkmcnt(0)\n\ts_barrier" ::: "memory");
        if (ui < 3) {
            const int qbn = (ui == 0) ? 7 - s : (ui == 1) ? 2 + s : 5 - s; const int NTn = 4 * qbn + 4;
            AT_QLOAD(qr, qbn); AT_DMA(0, 0, NTn); AT_DMA(1, 1, NTn); AT_DMA(2, 1, NTn); }
        { auto rr = __builtin_amdgcn_permlane32_swap(__float_as_uint(l_reg), __float_as_uint(l_reg), false, false); l_reg = __uint_as_float(rr[0]) + __uint_as_float(rr[1]); }
        if (hi == 0) wsf[32 + r32] = __builtin_amdgcn_rcpf(l_reg);
        asm volatile("s_waitcnt lgkmcnt(0)" ::: "memory");
        AT_LAS char* stg = shm + LDS_OST + wid * (32 * OROW);
        { const int row = lane >> 1, half = lane & 1; const size_t grow = rowbase + q0 + wid * 32 + row; float ss = 0.f;
#pragma unroll
          for (int d0 = 0; d0 < 2; ++d0) {
#pragma unroll
            for (int r = 0; r < 16; ++r) { const int orow = crow(r, hi); *(AT_LAS float*)(stg + orow * OROW + r32 * 4) = o[d0][r] * wsf[32 + orow]; }
            asm volatile("s_waitcnt lgkmcnt(0)" ::: "memory");
            const float* gp = goa + h * 64 + d0 * 32 + half * 16; bf16_t* yp = Y + grow * YLD + 512 + h * 64 + d0 * 32 + half * 16;
#pragma unroll
            for (int i = 0; i < 2; ++i) { const f32x4 a = *(AT_LAS const f32x4*)(stg + row * OROW + half * 64 + i * 32), c = *(AT_LAS const f32x4*)(stg + row * OROW + half * 64 + i * 32 + 16);
                ss += pg8::hsq4(a) + pg8::hsq4(c);
                *(u32x4*)(yp + i * 8) = pg8::pack8(a * *(const f32x4*)(gp + i * 8), c * *(const f32x4*)(gp + i * 8 + 4)); }
            asm volatile("s_waitcnt lgkmcnt(0)" ::: "memory"); }
          ss += swz_xor1(ss); if (half == 0) ssqy[grow * 16 + 8 + h] = ss; }
    }
#undef AT_DMA
#undef AT_QLOAD
}
__device__ __forceinline__ void attn_phase(AT_LAS char* lds, int wid0, const pg8::Place& pl, const bf16_t* Q, const bf16_t* KN, const bf16_t* KR, const bf16_t* V, const float* goa, bf16_t* Y, float* ssqy) {
    const int nbh = 128 / pl.nx, bh0 = pl.jx * nbh;
    for (int idx = pl.rank; idx < 2 * nbh; idx += pl.nloc) { const int bh = bh0 + (idx >> 1);
        attn_item<8>(bh >> 3, bh & 7, idx & 1, Q, KN, KR, V, goa, Y, ssqy, lds, wid0);
        asm volatile("s_waitcnt vmcnt(0)\n\ts_barrier" ::: "memory"); }
}
}

constexpr int NWAVES = 8;
struct Args { const void* in[20]; float* out; unsigned char* ws; int ph_lo, ph_hi, li, flags; };
namespace pro {
#define PR_LAS __attribute__((address_space(3)))
__device__ __forceinline__ unsigned pk2(float lo, float hi) { return (unsigned)f2bf(lo) | ((unsigned)f2bf(hi) << 16); }
template <int MODE  >
__device__ __forceinline__ void tr_item(const float* W, int ldw, bf16_t* WT, int out_ld, int out_koff, int nblk, PR_LAS float* scr, int item, int lane) {
    const int kb = item / nblk, nb = item - kb * nblk, k0 = 64 * kb, n0 = 32 * nb;
    const int pn = n0 + (lane & 31); const int sc0 = MODE == 0 ? pn : (MODE == 1 ? win_src(pn) : wup_qcol(pn));
    const int sc = sc0 >= 0 ? sc0 : 0; const float msk = sc0 >= 0 ? 1.f : 0.f;
    const float* wp = W + (size_t)(k0 + (lane >> 5)) * ldw + sc;
    float v[32];
#pragma unroll
    for (int i = 0; i < 32; ++i) v[i] = wp[(size_t)(2 * i) * ldw];
#pragma unroll
    for (int i = 0; i < 32; ++i) scr[(2 * i + (lane >> 5)) * 33 + (lane & 31)] = v[i] * msk;
    asm volatile("s_waitcnt lgkmcnt(0)" ::: "memory");
    const int c = lane & 7;
#pragma unroll
    for (int j = 0; j < 4; ++j) { const int n = (lane >> 3) + 8 * j; const PR_LAS float* s = scr + (8 * c) * 33 + n;
        pg8::u32x4 o; o.x = pk2(s[0 * 33], s[1 * 33]); o.y = pk2(s[2 * 33], s[3 * 33]); o.z = pk2(s[4 * 33], s[5 * 33]); o.w = pk2(s[6 * 33], s[7 * 33]);
        *(pg8::u32x4*)(WT + (size_t)(n0 + n) * out_ld + out_koff + k0 + 8 * c) = o; }
    asm volatile("s_waitcnt lgkmcnt(0)" ::: "memory");
}
__device__ __forceinline__ void smallm_unit(PR_LAS unsigned char* lds, int tid, const float* in, int in_stride, bool act, const float* W, int ldw, int N, bool winmap, const float* bias, float* out, int out_stride, int p0, int ucols) {
    PR_LAS float* sin_ = (PR_LAS float*)lds; PR_LAS float* red = (PR_LAS float*)(lds + 65536);
    const int lane = tid & 63, wave = tid >> 6;
#pragma unroll 8
    for (int e = tid; e < 16 * 1024; e += 512) { const int b = e >> 10, k = e & 1023; float v = in[(size_t)b * in_stride + k]; if (act) v = v * __builtin_amdgcn_rcpf(1.f + __expf(-v)); sin_[k * 16 + b] = v; }
    __syncthreads();
    const int p = p0 + lane; const int s0 = winmap ? win_src(p) : p; const bool ok = (lane < ucols && s0 >= 0 && s0 < N);
    const int sc = ok ? s0 : 0; const float msk = ok ? 1.f : 0.f;
    const float* wp = W + (size_t)(wave * 128) * ldw + sc;
    float acc[16];
#pragma unroll
    for (int b = 0; b < 16; ++b) acc[b] = 0.f;
    for (int k0 = 0; k0 < 128; k0 += 32) {
        float w[32];
#pragma unroll
        for (int j = 0; j < 32; ++j) w[j] = wp[(size_t)(k0 + j) * ldw];
#pragma unroll
        for (int j = 0; j < 32; ++j) { const PR_LAS f32x4* sp = (const PR_LAS f32x4*)(sin_ + (wave * 128 + k0 + j) * 16);
#pragma unroll
            for (int q = 0; q < 4; ++q) { const f32x4 v = sp[q]; acc[4 * q] += v[0] * w[j]; acc[4 * q + 1] += v[1] * w[j]; acc[4 * q + 2] += v[2] * w[j]; acc[4 * q + 3] += v[3] * w[j]; } }
    }
#pragma unroll
    for (int b = 0; b < 16; ++b) red[(wave * 64 + lane) * 16 + b] = acc[b] * msk;
    __syncthreads();
    for (int e = tid; e < 64 * 16; e += 512) { const int l = e >> 4, b = e & 15; float sum = 0.f;
#pragma unroll
        for (int w = 0; w < 8; ++w) sum += red[(w * 64 + l) * 16 + b];
        if (l < ucols) out[(size_t)b * out_stride + p0 + l] = sum + (bias ? bias[p0 + l] : 0.f); }
    __syncthreads();
}
__device__ __forceinline__ float wsum(float v) {
    v += __int_as_float(__builtin_amdgcn_ds_swizzle(__float_as_int(v), 0x041F)); v += __int_as_float(__builtin_amdgcn_ds_swizzle(__float_as_int(v), 0x081F));
    v += __int_as_float(__builtin_amdgcn_ds_swizzle(__float_as_int(v), 0x101F)); v += __int_as_float(__builtin_amdgcn_ds_swizzle(__float_as_int(v), 0x201F));
    v += __int_as_float(__builtin_amdgcn_ds_swizzle(__float_as_int(v), 0x401F));
    auto rr = __builtin_amdgcn_permlane32_swap(__float_as_uint(v), __float_as_uint(v), false, false); return __uint_as_float(rr[0]) + __uint_as_float(rr[1]);
}
__device__ __forceinline__ void phase0a(PR_LAS unsigned char* lds, int wid0, int vcu, int G, const Args& args, int zi, unsigned char* ws) {
    int tid_ = wid0 * 64 + lane_id(); asm volatile("" : "+v"(tid_));
    const int tid = tid_, lane = tid & 63, wave = tid >> 6;
#define PIN(i) ((const float*)args.in[(i) + zi])
    for (int un = vcu; un < DEPTH * (NMOD / 48); un += G) { const int l = un / (NMOD / 48), p0 = (un % (NMOD / 48)) * 48;
        smallm_unit(lds, tid, PIN(1), DM, true, PIN(3) + (size_t)l * DM * NMOD, NMOD, NMOD, false, PIN(4) + (size_t)l * NMOD, (float*)(ws + WS_MOD) + (size_t)l * NB * NMOD, NMOD, p0, 48); }
    { const int* pos = (const int*)args.in[2 + zi]; float* rope = (float*)(ws + WS_ROPE);
      for (int idx = vcu * 512 + tid; idx < T * 16; idx += G * 512) { const int t = idx >> 4, i = idx & 15;
          const float freq = exp2f(-(float)i * (13.287712379549449f / 16.0f)); const float ang = (float)pos[t] * freq;
          rope[t * 32 + i] = cosf(ang); rope[t * 32 + 16 + i] = sinf(ang); } }
    { const float* gws = PIN(7); bf16_t* gw = (bf16_t*)(ws + WS_GW);
      for (int idx = vcu * 512 + tid; idx < DEPTH * NGRP * CHUNK * CHUNK; idx += G * 512) { const int s = idx & 127, t = (idx >> 7) & 127; gw[idx] = (s <= t) ? f2bf(gws[idx]) : (bf16_t)0; } }
    PR_LAS float* scr = (PR_LAS float*)(lds + wave * 16384);
    const int gw_ = vcu * NWAVES + wave, NGW = G * NWAVES;
    constexpr int I_IN = (DM / 64) * (NIN / 32), I_UQ = (QR / 64) * (768 / 32), I_UKV = (KVR / 64) * (1024 / 32), I_OUT = (DM / 64) * (DM / 32), I_1 = (DM / 64) * (DFF / 32), I_2 = (DFF / 64) * (DM / 32);
    constexpr int I_LAYER = I_IN + I_UQ + I_UKV + I_OUT + I_1 + I_2;
    for (int it = gw_; it < DEPTH * I_LAYER; it += NGW) {
        const int l = it / I_LAYER; int r = it - l * I_LAYER; unsigned char* wl = ws + WS_W + (size_t)l * WL_STRIDE;
        if (r < I_IN) { tr_item<1>(PIN(6) + (size_t)l * DM * DIN, DIN, (bf16_t*)(wl + WL_IN), DM, 0, NIN / 32, scr, r, lane); continue; } r -= I_IN;
        if (r < I_UQ) { tr_item<2>(PIN(11) + (size_t)l * QR * 768, 768, (bf16_t*)(wl + WL_UQ), QR, 0, 768 / 32, scr, r, lane); continue; } r -= I_UQ;
        if (r < I_UKV) { tr_item<0>(PIN(12) + (size_t)l * KVR * 1024, 1024, (bf16_t*)(wl + WL_UKV), KVR, 0, 1024 / 32, scr, r, lane); continue; } r -= I_UKV;
        if (r < I_OUT) { tr_item<0>(PIN(15) + (size_t)l * DM * DM, DM, (bf16_t*)(wl + WL_OUT), DM, 0, DM / 32, scr, r, lane); continue; } r -= I_OUT;
        if (r < I_1) { tr_item<0>(PIN(17) + (size_t)l * DM * DFF, DFF, (bf16_t*)(wl + WL_1), DM, 0, DFF / 32, scr, r, lane); continue; } r -= I_1;
        tr_item<0>(PIN(18) + (size_t)l * DFF * DM, DM, (bf16_t*)(wl + WL_2), DFF, 0, DM / 32, scr, r, lane);
    }
#undef PIN
}
__device__ __forceinline__ void phase0b(PR_LAS unsigned char* lds, int wid0, int vcu, int G, const Args& args, int zi, unsigned char* ws) {
    int tid_ = wid0 * 64 + lane_id(); asm volatile("" : "+v"(tid_));
    const int tid = tid_, lane = tid & 63, wave = tid >> 6;
#define PIN(i) ((const float*)args.in[(i) + zi])
    float* MOD = (float*)(ws + WS_MOD);
    constexpr int U1 = NIN / 48, U2 = DFF / 64, NUNITS = DEPTH * (U1 + U2);
    for (int un = vcu; un < NUNITS; un += G) { const int l = un / (U1 + U2), r = un % (U1 + U2); const float* modl = MOD + (size_t)l * NB * NMOD;
        if (r < U1) smallm_unit(lds, tid, modl, NMOD, false, PIN(6) + (size_t)l * DM * DIN, DIN, DIN, true, nullptr, (float*)(ws + WS_SHW1) + (size_t)l * NB * NIN, NIN, r * 48, 48);
        else smallm_unit(lds, tid, modl + 3 * DM, NMOD, false, PIN(17) + (size_t)l * DM * DFF, DFF, DFF, false, nullptr, (float*)(ws + WS_SHW2) + (size_t)l * NB * DFF, DFF, (r - U1) * 64, 64); }
    for (int idx = vcu * 512 + tid; idx < DEPTH * NB * DM; idx += G * 512) { const int c = idx & 1023, b = (idx >> 10) & 15, l = idx >> 14; const float* m = MOD + ((size_t)l * NB + b) * NMOD;
        ((float*)(ws + WS_GM1))[idx] = PIN(5)[l * DM + c] * (1.f + m[1 * DM + c]); ((float*)(ws + WS_GM2))[idx] = PIN(16)[l * DM + c] * (1.f + m[4 * DM + c]); }
    { const float* x = PIN(0); const float* g = PIN(5); bf16_t* A = (bf16_t*)(ws + WS_A); float* ssq = (float*)(ws + WS_SSQ1);
      const int nun = NUNITS < G ? NUNITS : G; const int wgt = vcu < nun ? 7 : 12, slot0 = vcu < nun ? 7 * vcu : 7 * nun + 12 * (vcu - nun), nslot = 7 * nun + 12 * (G - nun);
      for (int sl = 0; sl < wgt; ++sl)
      for (int row0 = (slot0 + sl) * NWAVES + wave; row0 < T; row0 += 2 * nslot * NWAVES) {
          const int row1 = row0 + nslot * NWAVES; const bool two = row1 < T; const int rowb = two ? row1 : row0;
          f32x4 va[4], vb[4];
#pragma unroll
          for (int j = 0; j < 4; ++j) { va[j] = ((const f32x4*)(x + (size_t)row0 * DM))[lane + 64 * j]; vb[j] = ((const f32x4*)(x + (size_t)rowb * DM))[lane + 64 * j]; }
#pragma unroll
          for (int rr = 0; rr < 2; ++rr) { if (rr == 1 && !two) break; const int row = rr ? row1 : row0; const int b = row / SEQ; const float* sc = MOD + (size_t)b * NMOD + DM; float s = 0.f;
#pragma unroll
              for (int j = 0; j < 4; ++j) { const f32x4 v = rr ? vb[j] : va[j]; s += pg8::hsq4(v); const int c = 4 * (lane + 64 * j); const f32x4 gv = *(const f32x4*)(g + c), sv = *(const f32x4*)(sc + c);
                  *(pg8::u32x2*)(A + (size_t)row * DM + c) = pg8::pack4(v * gv * (sv + 1.f)); }
              s = wsum(s); if (lane < 16) ssq[(size_t)row * 16 + lane] = (lane == 0) ? s : 0.f; } } }
#undef PIN
}
__device__ __forceinline__ void phase_final(int wid0, const pg8::Place& pl, const float* g, const bf16_t* xb, float* dst) {
    int tid_ = wid0 * 64 + lane_id(); asm volatile("" : "+v"(tid_));
    const int lane = tid_ & 63, wave = tid_ >> 6, nr = T / pl.nx, r0 = pl.jx * nr;
    for (int lr = pl.rank * NWAVES + wave; lr < nr; lr += pl.nloc * NWAVES) { const int row = r0 + lr;
        const pg8::u32x4* xr = (const pg8::u32x4*)(xb + (size_t)row * (2 * DM) + DM); f32x4* yr = (f32x4*)(dst + (size_t)row * DM); f32x4 v[4]; float s = 0.f;
#pragma unroll
        for (int j = 0; j < 2; ++j) { const pg8::u32x4 w = xr[lane + 64 * j]; v[2 * j] = pg8::bf_lo4(w); v[2 * j + 1] = pg8::bf_hi4(w); s += pg8::hsq4(v[2 * j]) + pg8::hsq4(v[2 * j + 1]); }
        const float rstd = rsqrtf(wsum(s) * (1.f / DM) + EPS);
#pragma unroll
        for (int j = 0; j < 2; ++j) { const int c = 8 * (lane + 64 * j); const f32x4 g0 = *(const f32x4*)(g + c), g1 = *(const f32x4*)(g + c + 4); yr[2 * (lane + 64 * j)] = v[2 * j] * rstd * g0; yr[2 * (lane + 64 * j) + 1] = v[2 * j + 1] * rstd * g1; } }
}
}

constexpr int RING_BYTES = 131072;
constexpr int LDSCTL_OFF = 135168, MISC_OFF = LDSCTL_OFF + 320;
constexpr int LDS_BYTES = 147456;
static_assert(att::LDS_BYTES <= LDSCTL_OFF, "attention scratch below the control words");
constexpr int CW_BAR = 4096;
constexpr size_t CTL_ZERO_BYTES = 128 * 1024;

#define GAS __attribute__((address_space(1)))
#define LAS __attribute__((address_space(3)))
typedef GAS unsigned gu32;
#define RLX_AGENT __ATOMIC_RELAXED, __HIP_MEMORY_SCOPE_AGENT
#define XB_TMO      128
#define XB_XCNT(j)  (256  + 64 * (j))
#define XB_XSUB(j)  (1280 + 64 * (j))
#define XB_XGEN(j)  (2304 + 64 * (j))
#define XB_TOP      3328
#define XB_TOPGEN   3392
#define XCD_BAR_WORDS 3456
#define XB_SPIN_CAP (1u << 18)
__device__ __forceinline__ unsigned xb_ld(unsigned* p)              { return __hip_atomic_load(p, __ATOMIC_RELAXED, __HIP_MEMORY_SCOPE_AGENT); }
__device__ __forceinline__ unsigned xb_add(unsigned* p, unsigned v) { return __hip_atomic_fetch_add(p, v, __ATOMIC_RELAXED, __HIP_MEMORY_SCOPE_AGENT); }
__device__ __forceinline__ unsigned xb_xcc_id() { return (unsigned)__builtin_amdgcn_s_getreg((3 << 11) | 20) & 0xFu; }
#define XB_SPIN(cond, bar) do { unsigned _sp = 0; while (cond) { __builtin_amdgcn_s_sleep(1); \
    if ((++_sp & 255u) == 0u) { if (xb_ld(&(bar)[XB_TMO])) break; if (_sp > XB_SPIN_CAP) { atomicAdd(&(bar)[XB_TMO], 1u); break; } } } } while (0)
struct XcdBarrier { unsigned* bar; unsigned x; volatile LAS unsigned* st; };
__device__ __forceinline__ XcdBarrier xcd_barrier_post(unsigned* bar, volatile LAS unsigned* st, int wid0) {
    XcdBarrier b; b.bar = bar; b.x = xb_xcc_id(); b.st = st;
    if (wid0 == 0 && lane_id() == 0) (void)xb_add(&bar[XB_XCNT(b.x)], 1u);
    return b;
}
__device__ __forceinline__ void xcd_barrier_complete(unsigned* bar, unsigned x, unsigned& nloc, unsigned& nx) {
    const unsigned G = gridDim.x * gridDim.y * gridDim.z;
    unsigned sum, cnt, mine, sp = 0u;
    for (;;) {
        sum = 0u; cnt = 0u; mine = 0u;
#pragma unroll
        for (unsigned j = 0; j < 16; ++j) { const unsigned c = xb_ld(&bar[XB_XCNT(j)]); sum += c; cnt += (c > 0u) ? 1u : 0u; mine = (j == x) ? c : mine; }
        if (sum == G) break;
        __builtin_amdgcn_s_sleep(1);
        if ((++sp & 255u) == 0u) { if (xb_ld(&bar[XB_TMO])) break; if (sp > XB_SPIN_CAP) { atomicAdd(&bar[XB_TMO], 1u); break; } }
    }
    nloc = mine > 0u ? mine : 1u; nx = cnt > 0u ? cnt : 1u;
}
__device__ __forceinline__ void xcd_barrier(const XcdBarrier& b, int wid0) {
    asm volatile("s_waitcnt vmcnt(0)" ::: "memory");
    __syncthreads();
    if (wid0 == 0 && lane_id() == 0) {
        unsigned zo = 0; asm volatile("" : "+s"(zo));
        unsigned* bar = b.bar + zo;
        __builtin_amdgcn_s_waitcnt(0);
        unsigned nloc = b.st[0], nx = b.st[1];
        if (nloc == 0u) { xcd_barrier_complete(bar, b.x, nloc, nx); b.st[0] = nloc; b.st[1] = nx; }
        const unsigned old = xb_add(&bar[XB_XSUB(b.x)], 1u);
        const unsigned gen = old / nloc;
        if (old + 1u == (gen + 1u) * nloc) {
            __builtin_amdgcn_fence(__ATOMIC_RELEASE, "agent");
            asm volatile("s_waitcnt vmcnt(0)" ::: "memory");
            const unsigned og = xb_add(&bar[XB_TOP], 1u);
            const unsigned tg = og / nx;
            if (og + 1u == (tg + 1u) * nx) xb_add(&bar[XB_TOPGEN], 1u);
            else XB_SPIN(xb_ld(&bar[XB_TOPGEN]) == tg, bar);
            __builtin_amdgcn_fence(__ATOMIC_ACQUIRE, "agent");
            xb_add(&bar[XB_XGEN(b.x)], 1u);
            asm volatile("s_waitcnt vmcnt(0)" ::: "memory");
        } else {
            XB_SPIN(xb_ld(&bar[XB_XGEN(b.x)]) == gen, bar);
            __builtin_amdgcn_fence(__ATOMIC_ACQUIRE, "agent");
            asm volatile("s_waitcnt vmcnt(0)" ::: "memory");
        }
    }
    __syncthreads();
}

#define XB_LCNT(j)  (3 * XCD_BAR_WORDS + 64 * (j))
__device__ __forceinline__ void placement_init(unsigned* bar, volatile LAS unsigned* st  , int wid0) {
    if (wid0 == 0 && lane_id() == 0) {
        const unsigned x = xb_xcc_id(), G = gridDim.x;
        const unsigned rank = xb_add(&bar[XB_XCNT(x)], 1u);
        unsigned c[16], sum, sp = 0u;
        for (;;) { sum = 0u;
#pragma unroll
            for (unsigned j = 0; j < 16; ++j) { c[j] = xb_ld(&bar[XB_XCNT(j)]); sum += c[j]; }
            if (sum == G) break;
            __builtin_amdgcn_s_sleep(1);
            if ((++sp & 255u) == 0u) { if (xb_ld(&bar[XB_TMO])) break; if (sp > XB_SPIN_CAP) { atomicAdd(&bar[XB_TMO], 1u); break; } } }
        unsigned nx = 0u, jx = 0u, mine = 1u; bool even = true;
#pragma unroll
        for (unsigned j = 0; j < 16; ++j) { if (c[j] > 0u) { if (j < x) ++jx; ++nx; } if (j == x) mine = c[j] > 0u ? c[j] : 1u; }
#pragma unroll
        for (unsigned j = 0; j < 16; ++j) if (c[j] > 0u && c[j] != mine) even = false;
        if (nx == 0u) nx = 1u;
        st[0] = mine; st[1] = nx;
        const bool local = even && (mine % 8u == 0u) && (16u % nx == 0u) && sum == G;
        st[2] = local ? jx : 0u; st[3] = local ? rank : blockIdx.x; st[4] = local ? mine : G; st[5] = local ? nx : 1u; st[6] = 0u; st[7] = local ? 1u : 0u;
    }
    __syncthreads();
}
__device__ __forceinline__ void xcd_local_barrier(unsigned* bar, volatile LAS unsigned* st, int wid0) {
    asm volatile("s_waitcnt vmcnt(0)" ::: "memory");
    __syncthreads();
    if (wid0 == 0 && lane_id() == 0) {
        unsigned zo = 0; asm volatile("" : "+s"(zo));
        unsigned* cnt = bar + zo + XB_LCNT(xb_xcc_id());
        const unsigned e = st[6] + 1u; st[6] = e; const unsigned target = e * st[4];
        xb_add(cnt, 1u);
        XB_SPIN(xb_ld(cnt) < target, bar);
        __builtin_amdgcn_fence(__ATOMIC_ACQUIRE, "agent");
        asm volatile("s_waitcnt vmcnt(0)" ::: "memory");
    }
    __syncthreads();
}

constexpr int PH_P0A = 0, PH_P0B = 1, PH_L0 = 2, PH_PER_LAYER = 7, PH_FINAL = PH_L0 + DEPTH * PH_PER_LAYER, PH_END = PH_FINAL + 1;

#ifdef PROBE_SEL
#define MK_STAMP(i) do { if (wid0 == 0 && lane_id() == 0) ((volatile LAS unsigned long long*)(L + LDSCTL_OFF + 1024))[(i)] = __builtin_amdgcn_s_memrealtime(); } while (0)
#else
#define MK_STAMP(i) do {} while (0)
#endif
#define MK_IN_(k) (lo <= (k) && (k) < hi)
#define MK_BAR() XcdBarrier bar; bar.bar = (unsigned*)(args.ws + WS_CTL) + CW_BAR + __builtin_amdgcn_readfirstlane(args.li) * XCD_BAR_WORDS; bar.x = xb_xcc_id(); bar.st = MISC + 8
#define MK_SEAM(k) do { if (MK_IN_(k) && MK_IN_((k) + 1)) { MK_BAR(); xcd_barrier(bar, wid0); } } while (0)
#define MK_SEAM_L(k) do { if (MK_IN_(k) && MK_IN_((k) + 1)) { MK_BAR(); if (__builtin_amdgcn_readfirstlane((int)MISC[15]) != 0) xcd_local_barrier(bar.bar, bar.st, wid0); else xcd_barrier(bar, wid0); } } while (0)
#define MK_PLACE() pg8::Place pl; pl.jx = __builtin_amdgcn_readfirstlane((int)MISC[10]); pl.rank = __builtin_amdgcn_readfirstlane((int)MISC[11]); pl.nloc = __builtin_amdgcn_readfirstlane((int)MISC[12]); pl.nx = __builtin_amdgcn_readfirstlane((int)MISC[13])
#define MK_TAB ((volatile LAS int*)(L + LDSCTL_OFF + 512))
#define MK_PTRS() int zi = 0; asm volatile("" : "+s"(zi)); unsigned char* ws = args.ws + zi; float* out = args.out + zi; (void)out; (void)ws
#define INP(i) ((const float*)args.in[(i) + zi])
#define MK_RB(o, p) (ws + WS_U + (size_t)pl.jx * ((size_t)(T / pl.nx) * 8192) + (size_t)(T / pl.nx) * (o) - (size_t)pl.jx * (T / pl.nx) * (p))
#define RB_U MK_RB(0, 1024)
#define RB_VN MK_RB(1024, 1024)
#define RB_CQ MK_RB(2048, 512)
#define RB_CKV MK_RB(2560, 256)
#define RB_KR MK_RB(2816, 64)
#define RB_Q MK_RB(2880, 1536)
#define RB_KN MK_RB(4416, 1024)
#define RB_V MK_RB(5440, 1024)
#define RB_H MK_RB(0, 8192)
template <int l>
__device__ __forceinline__ void layer_phases(const Args& args, LAS unsigned char* L, volatile LAS unsigned* MISC, int wid0, int lo, int hi) {
    constexpr int P = PH_L0 + l * PH_PER_LAYER;
    if (MK_IN_(P + 0)) { MK_STAMP(2 * (P + 0)); MK_PTRS(); MK_PLACE();
        pg8::Gemm g{(bf16_t*)(ws + WS_A), (const bf16_t*)(ws + WS_W + (size_t)l * WL_STRIDE + WL_IN), T, NIN, DM, DM};
        pg8::FusedInOrder SF; SF.init(pl); pg8::XcdOrder<NIN / 256> S0; S0.init(pl); const pg8::LdsOrder S = SF.ok ? pg8::fill_order(MK_TAB, SF, wid0) : pg8::fill_order(MK_TAB, S0, wid0);
        pg8::EpiIn E{(float*)(ws + WS_SSQ1), (float*)(ws + WS_SHW1) + (size_t)l * NB * NIN, INP(9) + l * QR, INP(10) + l * KVR, (float*)(ws + WS_ROPE), (bf16_t*)RB_U, (bf16_t*)RB_VN, (bf16_t*)RB_CQ, (bf16_t*)RB_CKV, (bf16_t*)RB_KR, (float*)(ws + WS_SSQQ)};
        pg8::gemm_phase<pg8::EpiIn, pg8::LdsOrder, true, true>(L, g, S, E, wid0); }
    MK_STAMP(2 * (P + 0) + 1);
    if (MK_IN_(P + 0) && MK_IN_(P + 1)) { MK_PLACE(); if (!(pl.nloc == 32 && pl.nx == 8)) { MK_BAR(); if (__builtin_amdgcn_readfirstlane((int)MISC[15]) != 0) xcd_local_barrier(bar.bar, bar.st, wid0); else xcd_barrier(bar, wid0); } }
    if (MK_IN_(P + 1)) { MK_STAMP(2 * (P + 1));
        { MK_PTRS(); MK_PLACE(); pg8::Gemm g{(bf16_t*)RB_CQ, (const bf16_t*)(ws + WS_W + (size_t)l * WL_STRIDE + WL_UQ), T, 768, QR, QR};
          pg8::FusedUqOrder SF; SF.init(pl); pg8::XcdOrder<3> S0; S0.init(pl); const pg8::LdsOrder S = SF.ok ? pg8::fill_order(MK_TAB, SF, wid0) : pg8::fill_order(MK_TAB, S0, wid0);
          pg8::EpiUp<false> E{(float*)(ws + WS_SSQQ), (float*)(ws + WS_ROPE), (bf16_t*)RB_Q, nullptr, nullptr};
          pg8::gemm_phase<pg8::EpiUp<false>, pg8::LdsOrder, true, true>(L, g, S, E, wid0); }
        { MK_PTRS(); MK_PLACE(); pg8::Gemm g{(bf16_t*)RB_CKV, (const bf16_t*)(ws + WS_W + (size_t)l * WL_STRIDE + WL_UKV), T, 1024, KVR, KVR};
          pg8::FusedUkvOrder SF; SF.init(pl); pg8::XcdKvOrder S0; S0.init(pl); const pg8::LdsOrder S = SF.ok ? pg8::fill_order(MK_TAB, SF, wid0) : pg8::fill_order(MK_TAB, S0, wid0);
          pg8::EpiUp<true> E{(float*)(ws + WS_SSQQ), nullptr, nullptr, (bf16_t*)RB_KN, (bf16_t*)RB_V};
          pg8::gemm_phase<pg8::EpiUp<true>, pg8::LdsOrder, true, true>(L, g, S, E, wid0); }
        MK_STAMP(2 * (P + 1) + 1); }
    MK_SEAM_L(P + 1);
    if (MK_IN_(P + 2)) { MK_STAMP(2 * (P + 2)); MK_PTRS(); MK_PLACE();
        gm::gmlp_phase(L, wid0, pl, (bf16_t*)RB_U, (bf16_t*)RB_VN, (bf16_t*)(ws + WS_GW) + (size_t)l * NGRP * CHUNK * CHUNK, INP(8) + l * NGRP * CHUNK, INP(13) + l * DG, (bf16_t*)out, (float*)(ws + WS_SSQY)); }
    MK_STAMP(2 * (P + 2) + 1);
    if (MK_IN_(P + 3)) { MK_STAMP(2 * (P + 3)); MK_PTRS(); MK_PLACE();
        att::attn_phase((LAS char*)L, wid0, pl, (bf16_t*)RB_Q, (bf16_t*)RB_KN, (bf16_t*)RB_KR, (bf16_t*)RB_V, INP(14) + l * DG, (bf16_t*)out, (float*)(ws + WS_SSQY)); }
    MK_STAMP(2 * (P + 3) + 1); MK_SEAM_L(P + 3);
    if (MK_IN_(P + 4)) { MK_STAMP(2 * (P + 4)); MK_PTRS(); MK_PLACE();
        pg8::Gemm g{(const bf16_t*)out, (const bf16_t*)(ws + WS_W + (size_t)l * WL_STRIDE + WL_OUT), T, DM, DM, YLD};   pg8::XcdOrder<4> S0; S0.init(pl); const pg8::LdsOrder S = pg8::fill_order(MK_TAB, S0, wid0);
        pg8::EpiRes<true, l == 0> E{(float*)(ws + WS_SSQY), l == 0 ? (const void*)INP(0) : (const void*)out, (bf16_t*)out, (float*)(ws + WS_MOD) + (size_t)l * NB * NMOD + 2 * DM, (float*)(ws + WS_GM2) + (size_t)l * NB * DM, (bf16_t*)(ws + WS_A), (float*)(ws + WS_SSQ2)};
        pg8::gemm_phase<pg8::EpiRes<true, l == 0>, pg8::LdsOrder, true, true>(L, g, S, E, wid0); }
    MK_STAMP(2 * (P + 4) + 1); MK_SEAM_L(P + 4);
    if (MK_IN_(P + 5)) { MK_STAMP(2 * (P + 5)); MK_PTRS(); MK_PLACE();
        pg8::Gemm g{(bf16_t*)(ws + WS_A), (const bf16_t*)(ws + WS_W + (size_t)l * WL_STRIDE + WL_1), T, DFF, DM, DM}; pg8::XcdOrder<16> S0; S0.init(pl); const pg8::LdsOrder S = pg8::fill_order(MK_TAB, S0, wid0);
        pg8::EpiFf1 E{(float*)(ws + WS_SSQ2), (float*)(ws + WS_SHW2) + (size_t)l * NB * DFF, (bf16_t*)RB_H};
        pg8::gemm_phase<pg8::EpiFf1, pg8::LdsOrder, true, true>(L, g, S, E, wid0); }
    MK_STAMP(2 * (P + 5) + 1); MK_SEAM_L(P + 5);
    if (MK_IN_(P + 6)) { MK_STAMP(2 * (P + 6)); MK_PTRS(); MK_PLACE();
        pg8::Gemm g{(bf16_t*)RB_H, (const bf16_t*)(ws + WS_W + (size_t)l * WL_STRIDE + WL_2), T, DM, DFF, DFF}; pg8::XcdOrder<4> S0; S0.init(pl); const pg8::LdsOrder S = pg8::fill_order(MK_TAB, S0, wid0);
        pg8::EpiRes<false, false> E{nullptr, (const void*)out, (bf16_t*)out, (float*)(ws + WS_MOD) + (size_t)l * NB * NMOD + 5 * DM, (l + 1 < DEPTH) ? (float*)(ws + WS_GM1) + (size_t)(l + 1) * NB * DM : nullptr, (bf16_t*)(ws + WS_A), (float*)(ws + WS_SSQ1)};
        pg8::gemm_phase<pg8::EpiRes<false, false>, pg8::LdsOrder, true, true>(L, g, S, E, wid0); }
    MK_STAMP(2 * (P + 6) + 1); MK_SEAM_L(P + 6);
}
__global__ void __launch_bounds__(NWAVES * 64, 2) mk_fwd(Args args) {
    extern __shared__ __attribute__((aligned(16))) unsigned char lds[];
    LAS unsigned char* L = (LAS unsigned char*)lds;
    volatile LAS unsigned* MISC = (volatile LAS unsigned*)(L + MISC_OFF);
    const int wid0 = __builtin_amdgcn_readfirstlane((int)threadIdx.x >> 6);
    const int G = gridDim.x, bx = blockIdx.x;
    { const int t0 = wid0 * 64 + lane_id(); for (int u = t0; u < (LDS_BYTES - LDSCTL_OFF) / 4; u += NWAVES * 64) ((LAS unsigned*)(L + LDSCTL_OFF))[u] = 0u; }
    __syncthreads();
    const int lo = __builtin_amdgcn_readfirstlane(args.ph_lo), hi = __builtin_amdgcn_readfirstlane(args.ph_hi);
    unsigned* barw = (unsigned*)(args.ws + WS_CTL) + CW_BAR + __builtin_amdgcn_readfirstlane(args.li) * XCD_BAR_WORDS;
    placement_init(barw, MISC + 8, wid0);
    if (MK_IN_(PH_P0A)) { MK_STAMP(2 * (PH_P0A)); MK_PTRS(); MK_PLACE(); pro::phase0a(L, wid0, pl.jx * pl.nloc + pl.rank, G, args, zi, ws); }
    MK_STAMP(2 * PH_P0A + 1); MK_SEAM(PH_P0A);
    if (MK_IN_(PH_P0B)) { MK_STAMP(2 * (PH_P0B)); MK_PTRS(); MK_PLACE(); pro::phase0b(L, wid0, pl.jx * pl.nloc + pl.rank, G, args, zi, ws); }
    MK_STAMP(2 * PH_P0B + 1); MK_SEAM(PH_P0B);
    layer_phases<0>(args, L, MISC, wid0, lo, hi);
    layer_phases<1>(args, L, MISC, wid0, lo, hi);
    if (MK_IN_(PH_FINAL)) { MK_STAMP(2 * (PH_FINAL)); MK_PTRS(); MK_PLACE(); pro::phase_final(wid0, pl, INP(19), (const bf16_t*)out, out); }
    MK_STAMP(2 * PH_FINAL + 1);
#ifdef PROBE_SEL
    if (bx == 0 && wid0 == 0 && lane_id() == 0) {
        volatile LAS unsigned long long* st = (volatile LAS unsigned long long*)(L + LDSCTL_OFF + 1024); unsigned long long sel = 0;
        if (PROBE_SEL >= 0) sel = st[2 * PROBE_SEL + 1] - st[2 * PROBE_SEL];
        else { for (int k = 0; k < PH_FINAL; ++k) if (k != PH_L0 + 2 && k != PH_L0 + PH_PER_LAYER + 2) { int nx = k + 1; sel += st[2 * nx] - st[2 * k + 1]; } }
        const unsigned long long t0 = __builtin_amdgcn_s_memrealtime(), t1 = t0 + PROBE_MULT * sel;
        while (__builtin_amdgcn_s_memrealtime() < t1) __builtin_amdgcn_s_sleep(8);
    }
#endif
}

#ifndef ONE_LAUNCH
#define ONE_LAUNCH 1
#endif
#ifndef MK_PRO
#define MK_PRO 1
#endif
#ifndef MK_IN
#define MK_IN 1
#endif
#ifndef MK_UP
#define MK_UP 1
#endif
#ifndef MK_GMLP
#define MK_GMLP 1
#endif
#ifndef MK_ATTN
#define MK_ATTN 1
#endif
#ifndef MK_OUT
#define MK_OUT 1
#endif
#ifndef MK_FF1
#define MK_FF1 1
#endif
#ifndef MK_FF2
#define MK_FF2 1
#endif
template <class Epi> static void gemm_naive(hipStream_t st, const bf16_t* A, int lda, const bf16_t* Bt, int ldb, int M, int N, int K, const Epi& e) {
    hipLaunchKernelGGL((k_gemm_naive<Epi>), dim3(N / 64, M / 64), dim3(256), 0, st, A, lda, Bt, ldb, K, e);
}
static int g_grid = 0;
static void launch_mk(hipStream_t st, Args a, int lo, int hi, int li = 0, int flags = 0) {
    a.ph_lo = lo; a.ph_hi = hi; a.li = li; a.flags = flags;
    hipLaunchKernelGGL(mk_fwd, dim3(g_grid), dim3(NWAVES * 64), LDS_BYTES, st, a);
}
extern "C" void kernel_launch(void* const* d_in, const int* in_sizes, int n_in, void* d_out, int out_size, void* d_ws, size_t ws_size, hipStream_t stream) {
    if (n_in != 20 || out_size != T * DM || ws_size < WS_END) { fprintf(stderr, "kernel_launch: unexpected sizes n_in %d out %d ws %zu\n", n_in, out_size, ws_size); return; }
    if (g_grid == 0) {
        int dev = 0, cus = 0; hipGetDevice(&dev); hipDeviceGetAttribute(&cus, hipDeviceAttributeMultiprocessorCount, dev);
        if (hipFuncSetAttribute((const void*)mk_fwd, hipFuncAttributeMaxDynamicSharedMemorySize, LDS_BYTES) != hipSuccess) fprintf(stderr, "kernel_launch: hipFuncSetAttribute failed\n");
        g_grid = cus > 0 ? cus : 256;
    }
    const float* x = (const float*)d_in[0]; const float* c = (const float*)d_in[1]; const int* pos = (const int*)d_in[2];
    const float* w_ada = (const float*)d_in[3]; const float* b_ada = (const float*)d_in[4]; const float* g_mix = (const float*)d_in[5];
    const float* w_in = (const float*)d_in[6]; const float* g_ws = (const float*)d_in[7]; const float* g_bs = (const float*)d_in[8];
    const float* g_q = (const float*)d_in[9]; const float* g_kv = (const float*)d_in[10]; const float* w_uq = (const float*)d_in[11]; const float* w_ukv = (const float*)d_in[12];
    const float* g_og = (const float*)d_in[13]; const float* g_oa = (const float*)d_in[14]; const float* w_out = (const float*)d_in[15];
    const float* g_ffn = (const float*)d_in[16]; const float* w_ff1 = (const float*)d_in[17]; const float* w_ff2 = (const float*)d_in[18]; const float* g_fin = (const float*)d_in[19];
    unsigned char* ws = (unsigned char*)d_ws; float* out = (float*)d_out;
    float* MOD = (float*)(ws + WS_MOD); float* SHW1 = (float*)(ws + WS_SHW1); float* SHW2 = (float*)(ws + WS_SHW2); float* RT = (float*)(ws + WS_ROPE);
    float* GM1 = (float*)(ws + WS_GM1); float* GM2 = (float*)(ws + WS_GM2);
    float* SSQ1 = (float*)(ws + WS_SSQ1); float* SSQ2 = (float*)(ws + WS_SSQ2); float* SSQY = (float*)(ws + WS_SSQY); float* SSQQ = (float*)(ws + WS_SSQQ);
    bf16_t* GW = (bf16_t*)(ws + WS_GW); bf16_t* A = (bf16_t*)(ws + WS_A); bf16_t* U = (bf16_t*)(ws + WS_U); bf16_t* VN = (bf16_t*)(ws + WS_VN);
    bf16_t* CQKV = (bf16_t*)(ws + WS_CQKV); bf16_t* KR = (bf16_t*)(ws + WS_KR); bf16_t* Q = (bf16_t*)(ws + WS_Q); bf16_t* KN = (bf16_t*)(ws + WS_KN); bf16_t* V = (bf16_t*)(ws + WS_V);
    bf16_t* Y = (bf16_t*)(ws + WS_Y); bf16_t* H = (bf16_t*)(ws + WS_H); float* GV = (float*)(ws + WS_GV); float* ZL = (float*)(ws + WS_ZL); float* QRT = (float*)(ws + WS_QRT);
    auto WL = [&](int l, size_t off) { return (bf16_t*)(ws + WS_W + (size_t)l * WL_STRIDE + off); };
    Args a{}; for (int i = 0; i < 20; ++i) a.in[i] = d_in[i]; a.out = out; a.ws = ws;
    hipMemsetAsync(ws + WS_CTL, 0, CTL_ZERO_BYTES, stream);

#if ONE_LAUNCH
#ifdef PROBE_DUP
    launch_mk(stream, a, 0, PROBE_DUP + 1, 0); launch_mk(stream, a, PROBE_DUP, PROBE_DUP + 1, 1); launch_mk(stream, a, PROBE_DUP + 1, PH_END, 2);
#elif defined(PROBE_FFN2)
    launch_mk(stream, a, 0, PH_FINAL, 0); launch_mk(stream, a, PH_FINAL - 1, PH_FINAL, 1, 1); launch_mk(stream, a, PH_FINAL, PH_END, 2);
#elif defined(PROBE_FINAL)
    launch_mk(stream, a, 0, PH_FINAL, 0); launch_mk(stream, a, PH_FINAL, PH_END, 1, 2); launch_mk(stream, a, PH_FINAL, PH_END, 2);
#else
    launch_mk(stream, a, 0, PH_END);
#endif
    return;
#endif
#if MK_PRO
    launch_mk(stream, a, PH_P0A, PH_P0A + 1);
    launch_mk(stream, a, PH_P0B, PH_P0B + 1);
#else
    hipLaunchKernelGGL(k_rope_table, dim3(T * 16 / 256), dim3(256), 0, stream, pos, RT);
    hipLaunchKernelGGL(k_prep_gw, dim3(DEPTH * NGRP * CHUNK * CHUNK / 256), dim3(256), 0, stream, g_ws, GW);
    for (int l = 0; l < DEPTH; ++l) {
        hipLaunchKernelGGL(k_prep_w, dim3((NIN * DM + 255) / 256), dim3(256), 0, stream, w_in + (size_t)l * DM * DIN, DM, DIN, WL(l, WL_IN), NIN, 1);
        hipLaunchKernelGGL(k_prep_wup, dim3((NUP * KUP + 255) / 256), dim3(256), 0, stream, w_uq + (size_t)l * QR * 768, w_ukv + (size_t)l * KVR * 1024, WL(l, WL_UP));
        hipLaunchKernelGGL(k_prep_w, dim3(DM * DM / 256), dim3(256), 0, stream, w_out + (size_t)l * DM * DM, DM, DM, WL(l, WL_OUT), DM, 0);
        hipLaunchKernelGGL(k_prep_w, dim3(DFF * DM / 256), dim3(256), 0, stream, w_ff1 + (size_t)l * DM * DFF, DM, DFF, WL(l, WL_1), DFF, 0);
        hipLaunchKernelGGL(k_prep_w, dim3(DFF * DM / 256), dim3(256), 0, stream, w_ff2 + (size_t)l * DFF * DM, DFF, DM, WL(l, WL_2), DM, 0);
        hipLaunchKernelGGL(k_smallm, dim3(NMOD / 64), dim3(512), 0, stream, c, DM, 1, w_ada + (size_t)l * DM * NMOD, NMOD, NMOD, 0, b_ada + (size_t)l * NMOD, MOD + (size_t)l * NB * NMOD, NMOD, NMOD);
    }
    for (int l = 0; l < DEPTH; ++l) {
        hipLaunchKernelGGL(k_smallm, dim3(NIN / 64), dim3(512), 0, stream, MOD + (size_t)l * NB * NMOD + 0, NMOD, 0, w_in + (size_t)l * DM * DIN, DIN, DIN, 1, (const float*)nullptr, SHW1 + (size_t)l * NB * NIN, NIN, NIN);
        hipLaunchKernelGGL(k_smallm, dim3(DFF / 64), dim3(512), 0, stream, MOD + (size_t)l * NB * NMOD + 3 * DM, NMOD, 0, w_ff1 + (size_t)l * DM * DFF, DFF, DFF, 0, (const float*)nullptr, SHW2 + (size_t)l * NB * DFF, DFF, DFF);
    }
    hipLaunchKernelGGL(k_gm, dim3(DEPTH * NB * DM / 256), dim3(256), 0, stream, g_mix, MOD, 1, GM1);
    hipLaunchKernelGGL(k_gm, dim3(DEPTH * NB * DM / 256), dim3(256), 0, stream, g_ffn, MOD, 4, GM2);
    hipLaunchKernelGGL(k_modx, dim3(T / 4), dim3(256), 0, stream, x, g_mix, MOD + 1 * DM, NMOD, A, SSQ1);

#endif
    for (int l = 0; l < DEPTH; ++l) {
        const float* modl = MOD + (size_t)l * NB * NMOD; const int P = PH_L0 + l * PH_PER_LAYER;
#if MK_IN
        launch_mk(stream, a, P + 0, P + 1);
#else
        { EpiInNaive e{0, SSQ1, SHW1 + (size_t)l * NB * NIN, U, GV, ZL}; gemm_naive(stream, A, DM, WL(l, WL_IN), DM, T, NIN, DM, e); }
        hipLaunchKernelGGL(k_vn, dim3(T * NGRP / 4), dim3(256), 0, stream, GV, VN);
        hipLaunchKernelGGL(k_lat, dim3(T / 4), dim3(256), 0, stream, ZL, g_q + l * QR, g_kv + l * KVR, RT, CQKV, SSQQ, KR);
#endif
#if MK_UP
        launch_mk(stream, a, P + 1, P + 2);
#else
        { EpiUpNaive e{0, SSQQ, Q, QRT, KN, V}; gemm_naive(stream, CQKV, KUP, WL(l, WL_UP), KUP, T, NUP, KUP, e); }
        hipLaunchKernelGGL(k_rope_q, dim3(T * NH * 16 / 256), dim3(256), 0, stream, QRT, RT, Q);
#endif
#if MK_GMLP
        launch_mk(stream, a, P + 2, P + 3);
#else
        hipLaunchKernelGGL(k_gmlp_naive, dim3(T), dim3(512), 0, stream, U, VN, GW + (size_t)l * NGRP * CHUNK * CHUNK, g_bs + l * NGRP * CHUNK, g_og + l * DG, Y, SSQY);
#endif
#if MK_ATTN
        launch_mk(stream, a, P + 3, P + 4);
#else
        hipLaunchKernelGGL(k_attn_naive, dim3(T / 64, NH), dim3(64), 0, stream, Q, KN, KR, V, g_oa + l * DG, Y, SSQY);
#endif
#if MK_OUT
        launch_mk(stream, a, P + 4, P + 5);
#else
        { EpiOutNaive e{512, SSQY, l == 0 ? x : out, out, modl + 2 * DM}; gemm_naive(stream, Y, DM, WL(l, WL_OUT), DM, T, DM, DM, e); }
        hipLaunchKernelGGL(k_modx, dim3(T / 4), dim3(256), 0, stream, out, g_ffn + l * DM, modl + 4 * DM, NMOD, A, SSQ2);
#endif
#if MK_FF1
        launch_mk(stream, a, P + 5, P + 6);
#else
        { EpiFf1Naive e{0, SSQ2, SHW2 + (size_t)l * NB * DFF, H}; gemm_naive(stream, A, DM, WL(l, WL_1), DM, T, DFF, DM, e); }
#endif
#if MK_FF2
        launch_mk(stream, a, P + 6, P + 7);
#else
        { EpiFf2Naive e{0, out, modl + 5 * DM}; gemm_naive(stream, H, DFF, WL(l, WL_2), DFF, T, DM, DFF, e); }
        if (l + 1 < DEPTH) hipLaunchKernelGGL(k_modx, dim3(T / 4), dim3(256), 0, stream, out, g_mix + (l + 1) * DM, MOD + (size_t)(l + 1) * NB * NMOD + 1 * DM, NMOD, A, SSQ1);
#endif
    }
#if MK_PRO
    launch_mk(stream, a, PH_FINAL, PH_FINAL + 1);
#else
    hipLaunchKernelGGL(k_final, dim3(T / 4), dim3(256), 0, stream, out, g_fin, out);
#endif
}
```
